# Optimizing an MI355X kernel written in HIP

```python
import jax, jax.numpy as jnp
from jax import lax
import numpy as np

D_MODEL = 1024
BATCH = 8
SEQ = 2048
DEPTH = 2

CONV_WIDTH = D_MODEL // 2
CONV_GROUPS = 8
CONV_KERNEL = 31
N_HEADS = 8
HEAD_DIM = 64
N_KV_HEADS = 2
GQA = N_HEADS // N_KV_HEADS
ATTN_WIDTH = N_HEADS * HEAD_DIM
KV_WIDTH = N_KV_HEADS * HEAD_DIM
MIX_WIDTH = CONV_WIDTH + ATTN_WIDTH
N_BRANCH = 3
IN_WIDTH = 2 * CONV_WIDTH + ATTN_WIDTH + 6 * KV_WIDTH + N_HEADS * N_BRANCH
CMP_BLOCK = 32
CMP_STRIDE = 16
CMP_HIDDEN = 256
SEL_BLOCK = 64
SEL_TOPK = 8
WINDOW = 512
Q_BLOCK = 128
FORCE_BONUS = 1e4
NEG_INF = -1e30
D_FF = 2816
N_EXPERTS = 8
TOP_K = 2
D_FF_EXPERT = 3584
N_DENSE = (DEPTH + 1) // 2
N_MOE = DEPTH // 2
EPS = 1e-6

kernel_name = "hymba_conformer_nsa_moe_block"


def rms_norm(x, g):
    xf = x.astype(jnp.float32)
    xf = xf * lax.rsqrt(jnp.mean(xf * xf, axis=-1, keepdims=True) + EPS)
    return (xf * g.astype(jnp.float32)).astype(x.dtype)


def masked_softmax(s, mask):
    s = jnp.where(mask, s.astype(jnp.float32), NEG_INF)
    m = jnp.max(s, axis=-1, keepdims=True)
    p = jnp.where(mask, jnp.exp(s - m), 0.0)
    return p / jnp.maximum(jnp.sum(p, axis=-1, keepdims=True), 1e-30)


def conv_module(val, gate, dw_w, dw_b, ln_g, ln_b):
    B, S, C = val.shape
    u = val * jax.nn.sigmoid(gate)
    u = jnp.pad(u, ((0, 0), (CONV_KERNEL - 1, 0), (0, 0)))
    y = lax.conv_general_dilated(u, dw_w[:, None, :], window_strides=(1,), padding="VALID",
                                 dimension_numbers=("NWC", "WIO", "NWC"),
                                 feature_group_count=C) + dw_b
    yg = y.reshape(B, S, CONV_GROUPS, C // CONV_GROUPS).astype(jnp.float32)
    mu = jnp.mean(yg, axis=-1, keepdims=True)
    var = jnp.mean(jnp.square(yg - mu), axis=-1, keepdims=True)
    yn = ((yg - mu) * lax.rsqrt(var + EPS)).reshape(B, S, C)
    yn = yn * ln_g.astype(jnp.float32) + ln_b.astype(jnp.float32)
    return jax.nn.silu(yn).astype(val.dtype)


def nsa_attention(q, k_cmp, v_cmp, k_sel, v_sel, k_win, v_win, gate_logits, q_g, k_g,
                  pos_k, pos_v, ck_w1, ck_b1, ck_w2, ck_b2, cv_w1, cv_b1, cv_w2, cv_b2):
    dtype = q.dtype
    B, S = q.shape[:2]
    t = jnp.arange(S)

    def heads_kv(a):
        return a.reshape(B, S, N_KV_HEADS, HEAD_DIM).transpose(0, 2, 1, 3)

    qh = rms_norm(q.reshape(B, S, N_KV_HEADS, GQA, HEAD_DIM), q_g).transpose(0, 2, 3, 1, 4)
    qh = qh * (HEAD_DIM ** -0.5)
    ks = rms_norm(heads_kv(k_sel), k_g[1])
    vs = heads_kv(v_sel)
    kw = rms_norm(heads_kv(k_win), k_g[2])
    vw = heads_kv(v_win)

    n_cmp = (S - CMP_BLOCK) // CMP_STRIDE + 1
    c_start = jnp.arange(n_cmp) * CMP_STRIDE
    cidx = c_start[:, None] + jnp.arange(CMP_BLOCK)[None, :]

    def compress(a, pos, w1, b1, w2, b2):
        blk = heads_kv(a)[:, :, cidx] + pos
        blk = blk.reshape(B, N_KV_HEADS, n_cmp, CMP_BLOCK * HEAD_DIM)
        return jax.nn.silu(blk @ w1 + b1) @ w2 + b2

    kc = rms_norm(compress(k_cmp, pos_k, ck_w1, ck_b1, ck_w2, ck_b2), k_g[0])
    vc = compress(v_cmp, pos_v, cv_w1, cv_b1, cv_w2, cv_b2)
    s_c = jnp.einsum("bkgsd,bkcd->bkgsc", qh, kc)
    mask_c = (c_start + CMP_BLOCK - 1)[None, :] <= t[:, None]
    p_c = masked_softmax(s_c, mask_c)
    o_cmp = jnp.einsum("bkgsc,bkcd->bkgsd", p_c.astype(vc.dtype), vc)

    n_sel = S // SEL_BLOCK
    j = jnp.arange(n_sel)
    overlap = ((c_start[:, None] < (j[None, :] + 1) * SEL_BLOCK)
               & (c_start[:, None] + CMP_BLOCK > j[None, :] * SEL_BLOCK)).astype(jnp.float32)
    imp = jnp.einsum("bkgsc,cj->bksj", p_c, overlap)
    cur = (t // SEL_BLOCK)[:, None]
    forced = (j[None, :] == 0) | (j[None, :] == cur) | (j[None, :] == cur - 1)
    causal_blk = j[None, :] * SEL_BLOCK <= t[:, None]
    score = jnp.where(causal_blk, imp + jnp.where(forced, FORCE_BONUS, 0.0), NEG_INF)
    k_eff = min(SEL_TOPK, n_sel)
    _, sel_idx = lax.top_k(score, k_eff)

    n_qb = S // Q_BLOCK
    kblk = ks.reshape(B, N_KV_HEADS, n_sel, SEL_BLOCK, HEAD_DIM)
    vblk = vs.reshape(B, N_KV_HEADS, n_sel, SEL_BLOCK, HEAD_DIM)
    pad = ((0, 0), (0, 0), (WINDOW, 0), (0, 0))
    kw_pad = jnp.pad(kw, pad)
    vw_pad = jnp.pad(vw, pad)
    q_chunks = qh.reshape(B, N_KV_HEADS, GQA, n_qb, Q_BLOCK, HEAD_DIM).transpose(3, 0, 1, 2, 4, 5)
    idx_chunks = sel_idx.reshape(B, N_KV_HEADS, n_qb, Q_BLOCK, k_eff).transpose(2, 0, 1, 3, 4)
    bi = jnp.arange(B)[:, None, None, None]
    hi = jnp.arange(N_KV_HEADS)[None, :, None, None]
    band = jnp.arange(WINDOW + Q_BLOCK)

    def block_step(args):
        qc, ic, n = args
        start = n * Q_BLOCK
        tq = start + jnp.arange(Q_BLOCK)
        kg = kblk[bi, hi, ic]
        vg = vblk[bi, hi, ic]
        kpos = ic[..., None] * SEL_BLOCK + jnp.arange(SEL_BLOCK)
        m_s = (kpos <= tq[:, None, None]).reshape(B, N_KV_HEADS, 1, Q_BLOCK, k_eff * SEL_BLOCK)
        s_s = jnp.einsum("bkgqd,bkqnld->bkgqnl", qc, kg).reshape(
            B, N_KV_HEADS, GQA, Q_BLOCK, k_eff * SEL_BLOCK)
        p_s = masked_softmax(s_s, m_s).reshape(B, N_KV_HEADS, GQA, Q_BLOCK, k_eff, SEL_BLOCK)
        o_s = jnp.einsum("bkgqnl,bkqnld->bkgqd", p_s.astype(vg.dtype), vg)
        kb = lax.dynamic_slice_in_dim(kw_pad, start, WINDOW + Q_BLOCK, axis=2)
        vb = lax.dynamic_slice_in_dim(vw_pad, start, WINDOW + Q_BLOCK, axis=2)
        wpos = start - WINDOW + band
        m_w = ((wpos[None, :] <= tq[:, None]) & (wpos[None, :] > tq[:, None] - WINDOW)
               & (wpos[None, :] >= 0))
        s_w = jnp.einsum("bkgqd,bkjd->bkgqj", qc, kb)
        p_w = masked_softmax(s_w, m_w)
        o_w = jnp.einsum("bkgqj,bkjd->bkgqd", p_w.astype(vb.dtype), vb)
        return o_s, o_w

    o_sel, o_win = lax.map(block_step, (q_chunks, idx_chunks, jnp.arange(n_qb)))

    def unchunk(o):
        return o.transpose(1, 2, 3, 0, 4, 5).reshape(B, N_KV_HEADS, GQA, S, HEAD_DIM)

    g = jax.nn.sigmoid(gate_logits.astype(jnp.float32)).reshape(
        B, S, N_KV_HEADS, GQA, N_BRANCH).transpose(0, 2, 3, 1, 4)
    o = (g[..., 0:1] * o_cmp.astype(jnp.float32) + g[..., 1:2] * unchunk(o_sel).astype(jnp.float32)
         + g[..., 2:3] * unchunk(o_win).astype(jnp.float32))
    return o.transpose(0, 3, 1, 2, 4).reshape(B, S, ATTN_WIDTH).astype(dtype)


def swiglu(h, w1, w3, w2):
    return (jax.nn.silu(h @ w1) * (h @ w3)) @ w2


def moe_swiglu(h, router, w1, w3, w2):
    logits = (h @ router).astype(jnp.float32)
    top_vals, top_idx = lax.top_k(logits, TOP_K)
    top_w = jax.nn.softmax(top_vals, axis=-1)
    combine = jnp.sum(jax.nn.one_hot(top_idx, N_EXPERTS, dtype=jnp.float32) * top_w[..., None], axis=-2)
    y = jnp.zeros(h.shape, jnp.float32)
    for e in range(N_EXPERTS):
        y = y + combine[..., e:e + 1] * swiglu(h, w1[e], w3[e], w2[e]).astype(jnp.float32)
    return y.astype(h.dtype)


def setup_inputs(seed: int = 0) -> dict:
    key = jax.random.key(seed)
    ks = jax.random.split(key, 32)

    def nrm(k, shape, scale):
        return jax.random.normal(k, shape, jnp.float32) * scale

    L, Dh = DEPTH, HEAD_DIM
    return {
        "x": nrm(ks[0], (BATCH, SEQ, D_MODEL), 1.0),
        "attn_norm_g": 1.0 + nrm(ks[1], (L, D_MODEL), 0.02),
        "w_in": nrm(ks[2], (L, D_MODEL, IN_WIDTH), D_MODEL ** -0.5),
        "conv_dw_w": nrm(ks[3], (L, CONV_KERNEL, CONV_WIDTH), CONV_KERNEL ** -0.5),
        "conv_dw_b": nrm(ks[4], (L, CONV_WIDTH), 0.02),
        "conv_ln_g": 1.0 + nrm(ks[5], (L, CONV_WIDTH), 0.02),
        "conv_ln_b": nrm(ks[6], (L, CONV_WIDTH), 0.02),
        "q_norm_g": 1.0 + nrm(ks[7], (L, Dh), 0.02),
        "k_norm_g": 1.0 + nrm(ks[8], (L, N_BRANCH, Dh), 0.02),
        "cmp_pos_k": nrm(ks[9], (L, CMP_BLOCK, Dh), 0.1),
        "cmp_pos_v": nrm(ks[10], (L, CMP_BLOCK, Dh), 0.1),
        "cmp_k_w1": nrm(ks[11], (L, CMP_BLOCK * Dh, CMP_HIDDEN), (CMP_BLOCK * Dh) ** -0.5),
        "cmp_k_b1": nrm(ks[12], (L, CMP_HIDDEN), 0.02),
        "cmp_k_w2": nrm(ks[13], (L, CMP_HIDDEN, Dh), CMP_HIDDEN ** -0.5),
        "cmp_k_b2": nrm(ks[14], (L, Dh), 0.02),
        "cmp_v_w1": nrm(ks[15], (L, CMP_BLOCK * Dh, CMP_HIDDEN), (CMP_BLOCK * Dh) ** -0.5),
        "cmp_v_b1": nrm(ks[16], (L, CMP_HIDDEN), 0.02),
        "cmp_v_w2": nrm(ks[17], (L, CMP_HIDDEN, Dh), CMP_HIDDEN ** -0.5),
        "cmp_v_b2": nrm(ks[18], (L, Dh), 0.02),
        "w_out": nrm(ks[19], (L, MIX_WIDTH, D_MODEL), MIX_WIDTH ** -0.5),
        "ffn_norm_g": 1.0 + nrm(ks[20], (L, D_MODEL), 0.02),
        "dense_w1": nrm(ks[21], (N_DENSE, D_MODEL, D_FF), D_MODEL ** -0.5),
        "dense_w3": nrm(ks[22], (N_DENSE, D_MODEL, D_FF), D_MODEL ** -0.5),
        "dense_w2": nrm(ks[23], (N_DENSE, D_FF, D_MODEL), D_FF ** -0.5),
        "router_w": nrm(ks[24], (N_MOE, D_MODEL, N_EXPERTS), D_MODEL ** -0.5),
        "moe_w1": nrm(ks[25], (N_MOE, N_EXPERTS, D_MODEL, D_FF_EXPERT), D_MODEL ** -0.5),
        "moe_w3": nrm(ks[26], (N_MOE, N_EXPERTS, D_MODEL, D_FF_EXPERT), D_MODEL ** -0.5),
        "moe_w2": nrm(ks[27], (N_MOE, N_EXPERTS, D_FF_EXPERT, D_MODEL), D_FF_EXPERT ** -0.5),
    }


def reference(x, attn_norm_g, w_in, conv_dw_w, conv_dw_b, conv_ln_g, conv_ln_b, q_norm_g, k_norm_g,
              cmp_pos_k, cmp_pos_v, cmp_k_w1, cmp_k_b1, cmp_k_w2, cmp_k_b2,
              cmp_v_w1, cmp_v_b1, cmp_v_w2, cmp_v_b2, w_out, ffn_norm_g,
              dense_w1, dense_w3, dense_w2, router_w, moe_w1, moe_w3, moe_w2):
    sizes = [CONV_WIDTH, CONV_WIDTH, ATTN_WIDTH] + [KV_WIDTH] * 6 + [N_HEADS * N_BRANCH]
    offsets = [int(o) for o in np.cumsum(sizes)[:-1]]
    for layer in range(DEPTH):
        h = rms_norm(x, attn_norm_g[layer])
        z = h @ w_in[layer]
        c_val, c_gate, q, k_c, v_c, k_s, v_s, k_w, v_w, g_log = jnp.split(z, offsets, axis=-1)
        conv_out = conv_module(c_val, c_gate, conv_dw_w[layer], conv_dw_b[layer],
                               conv_ln_g[layer], conv_ln_b[layer])
        attn_out = nsa_attention(q, k_c, v_c, k_s, v_s, k_w, v_w, g_log,
                                 q_norm_g[layer], k_norm_g[layer], cmp_pos_k[layer], cmp_pos_v[layer],
                                 cmp_k_w1[layer], cmp_k_b1[layer], cmp_k_w2[layer], cmp_k_b2[layer],
                                 cmp_v_w1[layer], cmp_v_b1[layer], cmp_v_w2[layer], cmp_v_b2[layer])
        x = x + jnp.concatenate([conv_out, attn_out], axis=-1) @ w_out[layer]
        h = rms_norm(x, ffn_norm_g[layer])
        if layer % 2 == 0:
            i = layer // 2
            x = x + swiglu(h, dense_w1[i], dense_w3[i], dense_w2[i])
        else:
            i = layer // 2
            x = x + moe_swiglu(h, router_w[i], moe_w1[i], moe_w3[i], moe_w2[i])
    return x
```

```cpp
#include <hip/hip_runtime.h>
#include <cstdio>
#include <cstdint>

#ifndef MK_PER_PHASE
#define MK_PER_PHASE 1
#endif

#define LAS __attribute__((address_space(3)))
typedef unsigned short bf16_t;
typedef short bf16x8 __attribute__((ext_vector_type(8)));
typedef float f32x4 __attribute__((ext_vector_type(4)));
typedef float f32x2 __attribute__((ext_vector_type(2)));
typedef unsigned u32x4 __attribute__((ext_vector_type(4)));
typedef unsigned u32x2 __attribute__((ext_vector_type(2)));

constexpr int D = 1024, NB = 8, SEQ = 2048, M = NB * SEQ;
constexpr int INW = 2328, INP = 2560;
constexpr int CW = 512, CKW = 31, DH = 64, NKV = 2, NBH = NB * NKV;
constexpr int NCMP = 127, CHID = 256;
constexpr int DFF = 2816, NE = 8, DFE = 3584;
constexpr int MAXPAN = 136, MAXSLOT = MAXPAN * 256, CHUNKP = 72;
constexpr float EPS = 1e-6f;

constexpr size_t MiB = 1u << 20;
constexpr size_t WS_CTL = 0, CTL_BYTES = 2 * MiB;
constexpr size_t WS_H1 = 342 * MiB;
constexpr size_t WS_WIN = 12 * MiB;
constexpr size_t WS_WC1 = 22 * MiB;
constexpr size_t WS_WOUT = 26 * MiB;
constexpr size_t WS_WF1 = 30 * MiB;
constexpr size_t WS_WF2 = 41 * MiB;
constexpr size_t WS_RT = 47 * MiB;
constexpr size_t WS_WM1 = 48 * MiB;
constexpr size_t WS_WM2 = 160 * MiB;
constexpr size_t WS_XB = 216 * MiB;
constexpr size_t WS_RSTD = 248 * MiB;
constexpr size_t WS_GT = WS_RSTD + 65536;
constexpr size_t WS_ROUTE = WS_GT + (size_t)M * 24 * 4;
constexpr size_t WS_KC = 251 * MiB;
constexpr size_t WS_VC = WS_KC + 262144;
constexpr size_t WS_U = 252 * MiB;
constexpr size_t WS_Q = 268 * MiB;
constexpr size_t WS_KV = 284 * MiB;
constexpr size_t KVT = (size_t)NBH * SEQ * DH;
constexpr size_t WS_MIX = 310 * MiB;
constexpr size_t WS_ACT = 342 * MiB;
constexpr size_t WS_XS = 252 * MiB;
constexpr size_t WS_ACTM = 320 * MiB;
constexpr size_t WS_SLOT = 447 * MiB;
constexpr size_t WS_Y0 = WS_XB, WS_Y1 = 12 * MiB;
constexpr size_t WS_END = 448 * MiB;
constexpr int CW_BAR = 4096;
constexpr int CW_CNT = 8192;
constexpr int CW_B1P = 16384;

__device__ __forceinline__ unsigned cvt_pk_bf16(float lo, float hi) { unsigned r; asm volatile("v_cvt_pk_bf16_f32 %0, %1, %2" : "=v"(r) : "v"(lo), "v"(hi)); return r; }
__device__ __forceinline__ float bf_lo(unsigned v) { return __uint_as_float(v << 16); }
__device__ __forceinline__ float bf_hi(unsigned v) { return __uint_as_float(v & 0xffff0000u); }
__device__ __forceinline__ float bf2f(bf16_t v) { return __uint_as_float((unsigned)v << 16); }
__device__ __forceinline__ float rcpf_(float x) { return __builtin_amdgcn_rcpf(x); }
__device__ __forceinline__ float rsqf_(float x) { return __builtin_amdgcn_rsqf(x); }
__device__ __forceinline__ float sigmoidf_(float x) { return rcpf_(1.0f + __expf(-x)); }
__device__ __forceinline__ float siluf_(float x) { return x * sigmoidf_(x); }
__device__ __forceinline__ float wave_sum(float v) {
#pragma unroll
    for (int o = 1; o < 64; o <<= 1) v += __shfl_xor(v, o);
    return v;
}
__device__ __forceinline__ float wave_max(float v) {
#pragma unroll
    for (int o = 1; o < 64; o <<= 1) v = fmaxf(v, __shfl_xor(v, o));
    return v;
}
#define LDS_WAIT() asm volatile("s_waitcnt lgkmcnt(0)" ::: "memory")

namespace pg8 {
constexpr int BM = 256, BK = 64, HALF = 128, HTB = HALF * BK * 2, STAGE_BYTES = 8 * HTB, NXCD = 8, WGM = 8;
__device__ __forceinline__ int lds_byte(int r, int c) { const int st = (r >> 4) * 2 + (c >> 5), rr = r & 15, cc = c & 31, ob = rr * 64 + cc * 2; return st * 1024 + (ob ^ (((ob >> 9) & 1) << 5)); }
__device__ __forceinline__ void stage_rc(int b, int& R, int& C) { const int st = b / 1024, sb = b % 1024, swz = sb ^ (((sb >> 9) & 1) << 5); R = (st >> 1) * 16 + swz / 64; C = (st & 1) * 32 + (swz % 64) / 2; }
__device__ __forceinline__ int perm32(int rho) { const int n = rho >> 4, i = rho & 15; return 8 * (i >> 2) + 4 * n + (i & 3); }

struct Unit { int pm, pn; size_t aoff, boff; };
struct Gemm { const bf16_t* A; const bf16_t* Bt; int K, lda, ldb; };

struct SchedGrid {
    int nM, nN, nwg, G, c; size_t astr, bstr;
    __device__ __forceinline__ void init(int nM_, int nN_, int G_, int c_, int lda, int ldb) { nM = nM_; nN = nN_; nwg = nM * nN; G = G_; c = c_; astr = (size_t)BM * lda * 2; bstr = (size_t)BM * ldb * 2; }
    __device__ __forceinline__ bool next(int i, Unit& u) const {
        const long L = (long)i * G + c; if (L >= nwg) return false;
        int wgid = (int)L; { const int q = nwg / NXCD, r = nwg % NXCD, xcd = wgid % NXCD, off = wgid / NXCD; wgid = (xcd < r ? xcd * (q + 1) : r * (q + 1) + (xcd - r) * q) + off; }
        const int nig = WGM * nN, gid = wgid / nig, fm = gid * WGM, gsz = (nM - fm) < WGM ? (nM - fm) : WGM;
        u.pm = fm + ((wgid % nig) % gsz); u.pn = (wgid % nig) / gsz; u.aoff = (size_t)u.pm * astr; u.boff = (size_t)u.pn * bstr; return true;
    }
};

template <class Epi, class Sched>
__device__ __forceinline__ void gemm_phase(LAS unsigned char* lds, const Gemm g, const Sched& S, const Epi& E) {
    const int tid = threadIdx.x, wid = __builtin_amdgcn_readfirstlane(tid >> 6), lane = tid & 63, wr = wid >> 2, wc = wid & 3, fr = lane & 15, fq = lane >> 4;
    const int K = g.K, nt = K / BK;
    unsigned voffA[2], voffB[2];
#pragma unroll
    for (int i = 0; i < 2; ++i) { int R, C; stage_rc(tid * 16 + i * 8192, R, C); const int Rb = Epi::PERM ? ((R & ~31) + perm32(R & 31)) : R;
        voffA[i] = (unsigned)(R * g.lda + C) * 2u; voffB[i] = (unsigned)(Rb * g.ldb + C) * 2u; }
    const size_t kstep = (size_t)(BK * 2);
    const size_t hstepA = (size_t)HALF * g.lda * 2, hstepB = (size_t)HALF * g.ldb * 2;
    const unsigned ldsw = (unsigned)wid * 1024u;
    const int aoff = lds_byte(wr * 64 + fr, fq * 8), boff = lds_byte(wc * 32 + fr, fq * 8);
#define PG8_SA(b, h) (((b) * 2 + (h)) * HTB)
#define PG8_SB(b, h) ((4 + (b) * 2 + (h)) * HTB)
#define PG8_STAGE(bufoff, gbase, voff) do { _Pragma("unroll") for (int _i = 0; _i < 2; ++_i) \
        __builtin_amdgcn_global_load_lds((const unsigned*)((const char*)(gbase) + (voff)[_i]), (LAS unsigned*)(lds + (bufoff) + ldsw + _i * 8192), 16, 0, 0); } while (0)
#define PG8_LDA(dst, b, h) do { _Pragma("unroll") for (int m = 0; m < 4; ++m) _Pragma("unroll") for (int k = 0; k < 2; ++k) dst[m][k] = *(const LAS bf16x8*)(lds + PG8_SA(b, h) + aoff + m * 2048 + k * 1024); } while (0)
#define PG8_LDB(dst, b, h) do { _Pragma("unroll") for (int n = 0; n < 2; ++n) _Pragma("unroll") for (int k = 0; k < 2; ++k) dst[n][k] = *(const LAS bf16x8*)(lds + PG8_SB(b, h) + boff + n * 2048 + k * 1024); } while (0)
#define PG8_MMA(ai, bj, At, Bt) do { __builtin_amdgcn_s_setprio(1); _Pragma("unroll") for (int m = 0; m < 4; ++m) _Pragma("unroll") for (int n = 0; n < 2; ++n) _Pragma("unroll") for (int k = 0; k < 2; ++k) \
        acc[ai][bj][m][n] = __builtin_amdgcn_mfma_f32_16x16x32_bf16(Bt[n][k], At[m][k], acc[ai][bj][m][n], 0, 0, 0); __builtin_amdgcn_s_setprio(0); } while (0)
#define PG8_WAIT_V(n) asm volatile("s_waitcnt vmcnt(" #n ")" ::: "memory")
#define PG8_WAIT_L(n) asm volatile("s_waitcnt lgkmcnt(" #n ")" ::: "memory")
#define PG8_BAR __builtin_amdgcn_s_barrier()
#define PG8_SCHED __builtin_amdgcn_sched_barrier(0)
    Unit cur, nxt; int ui = 0;
    if (!S.next(0, cur)) return;
    f32x4 acc[2][2][4][2];
#pragma unroll
    for (int a = 0; a < 2; ++a)
#pragma unroll
        for (int b = 0; b < 2; ++b)
#pragma unroll
            for (int m = 0; m < 4; ++m)
#pragma unroll
                for (int n = 0; n < 2; ++n) acc[a][b][m][n] = (f32x4){0.f, 0.f, 0.f, 0.f};
    bf16x8 At[4][2], B0[2][2], B1[2][2];
    const char* cA = (const char*)g.A + cur.aoff; const char* cB = (const char*)g.Bt + cur.boff;
    PG8_STAGE(PG8_SB(0, 0), cB, voffB); PG8_STAGE(PG8_SA(0, 0), cA, voffA); PG8_STAGE(PG8_SB(0, 1), cB + hstepB, voffB); PG8_STAGE(PG8_SA(0, 1), cA + hstepA, voffA);
    if (wr == 1) PG8_BAR;
    PG8_WAIT_V(4); PG8_BAR;
    PG8_STAGE(PG8_SB(1, 0), cB + kstep, voffB); PG8_STAGE(PG8_SA(1, 0), cA + kstep, voffA); PG8_STAGE(PG8_SB(1, 1), cB + hstepB + kstep, voffB);
    PG8_WAIT_V(6); PG8_BAR;
    for (;;) {
        const bool has_next = S.next(ui + 1, nxt);
        const char* nA = has_next ? (const char*)g.A + nxt.aoff : cA; const char* nB = has_next ? (const char*)g.Bt + nxt.boff : cB;
        for (int t = 0; t < nt; t += 2) {
            const bool last = (t == nt - 2);
            const char* a1 = cA + (size_t)(t + 1) * kstep;
            const char* a2 = last ? nA : cA + (size_t)(t + 2) * kstep; const char* b2 = last ? nB : cB + (size_t)(t + 2) * kstep;
            const char* a3 = a2 + kstep; const char* b3 = b2 + kstep;
            PG8_LDB(B0, 0, 0); PG8_SCHED; PG8_LDA(At, 0, 0); PG8_STAGE(PG8_SA(1, 1), a1 + hstepA, voffA);
            PG8_WAIT_L(8); PG8_BAR; PG8_WAIT_L(0); PG8_MMA(0, 0, At, B0); PG8_BAR; PG8_SCHED;
            PG8_LDB(B1, 0, 1); PG8_STAGE(PG8_SB(0, 0), b2, voffB);
            PG8_BAR; PG8_WAIT_L(0); PG8_MMA(0, 1, At, B1); PG8_BAR;
            PG8_LDA(At, 0, 1); PG8_STAGE(PG8_SA(0, 0), a2, voffA);
            PG8_BAR; PG8_WAIT_L(0); PG8_MMA(1, 0, At, B0); PG8_BAR; PG8_SCHED;
            PG8_STAGE(PG8_SB(0, 1), b2 + hstepB, voffB);
            PG8_WAIT_V(6); PG8_BAR; PG8_MMA(1, 1, At, B1); PG8_BAR;
            PG8_LDB(B0, 1, 0); PG8_SCHED; PG8_LDA(At, 1, 0); PG8_STAGE(PG8_SA(0, 1), a2 + hstepA, voffA);
            PG8_WAIT_L(8); PG8_BAR; PG8_WAIT_L(0); PG8_MMA(0, 0, At, B0); PG8_BAR; PG8_SCHED;
            PG8_LDB(B1, 1, 1); PG8_STAGE(PG8_SB(1, 0), b3, voffB);
            PG8_BAR; PG8_WAIT_L(0); PG8_MMA(0, 1, At, B1); PG8_BAR;
            PG8_LDA(At, 1, 1); PG8_STAGE(PG8_SA(1, 0), a3, voffA);
            PG8_BAR; PG8_WAIT_L(0); PG8_MMA(1, 0, At, B0); PG8_BAR; PG8_SCHED;
            PG8_STAGE(PG8_SB(1, 1), b3 + hstepB, voffB);
            PG8_WAIT_V(6); PG8_BAR; PG8_MMA(1, 1, At, B1); PG8_BAR;
        }
        E(acc, cur, wr, wc, fr, fq);
        if (!has_next) break;
#pragma unroll
        for (int a = 0; a < 2; ++a)
#pragma unroll
            for (int b = 0; b < 2; ++b)
#pragma unroll
                for (int m = 0; m < 4; ++m)
#pragma unroll
                    for (int n = 0; n < 2; ++n) acc[a][b][m][n] = (f32x4){0.f, 0.f, 0.f, 0.f};
        cur = nxt; cA = nA; cB = nB; ++ui;
    }
    PG8_WAIT_V(0);
    if (wr == 0) PG8_BAR;
    PG8_BAR;
#undef PG8_SA
#undef PG8_SB
#undef PG8_STAGE
#undef PG8_LDA
#undef PG8_LDB
#undef PG8_MMA
#undef PG8_WAIT_V
#undef PG8_WAIT_L
#undef PG8_BAR
#undef PG8_SCHED
}
}
using pg8::Unit;

#define XB_TMO      128
#define XB_XCNT(j)  (256  + 64 * (j))
#define XB_XSUB(j)  (1280 + 64 * (j))
#define XB_XGEN(j)  (2304 + 64 * (j))
#define XB_TOP      3328
#define XB_TOPGEN   3392
#define XCD_BAR_WORDS 3456
#define XB_SPIN_CAP (1u << 18)
__device__ __forceinline__ unsigned xb_ld(unsigned* p)              { return __hip_atomic_load(p, __ATOMIC_RELAXED, __HIP_MEMORY_SCOPE_AGENT); }
__device__ __forceinline__ unsigned xb_add(unsigned* p, unsigned v) { return __hip_atomic_fetch_add(p, v, __ATOMIC_RELAXED, __HIP_MEMORY_SCOPE_AGENT); }
__device__ __forceinline__ unsigned xb_xcc_id() { return (unsigned)__builtin_amdgcn_s_getreg((3 << 11) | 20) & 0xFu; }
#define XB_SPIN(cond, bar) do { unsigned _sp = 0; while (cond) { __builtin_amdgcn_s_sleep(1); \
    if ((++_sp & 255u) == 0u) { if (xb_ld(&(bar)[XB_TMO])) break; if (_sp > XB_SPIN_CAP) { atomicAdd(&(bar)[XB_TMO], 1u); break; } } } } while (0)
struct XcdBarrier { unsigned* bar; unsigned x; volatile LAS unsigned* st; };
__device__ __forceinline__ XcdBarrier xcd_barrier_post(unsigned* bar, volatile LAS unsigned* st) {
    XcdBarrier b; b.bar = bar; b.x = xb_xcc_id(); b.st = st;
    if (threadIdx.x == 0) (void)xb_add(&bar[XB_XCNT(b.x)], 1u);
    return b;
}
__device__ __forceinline__ void xcd_barrier_complete(unsigned* bar, unsigned x, unsigned& nloc, unsigned& nx) {
    const unsigned G = gridDim.x * gridDim.y * gridDim.z;
    unsigned sum, cnt, mine, sp = 0u;
    for (;;) {
        sum = 0u; cnt = 0u; mine = 0u;
#pragma unroll
        for (unsigned j = 0; j < 16; ++j) { const unsigned c = xb_ld(&bar[XB_XCNT(j)]); sum += c; cnt += (c > 0u) ? 1u : 0u; mine = (j == x) ? c : mine; }
        if (sum == G) break;
        __builtin_amdgcn_s_sleep(1);
        if ((++sp & 255u) == 0u) { if (xb_ld(&bar[XB_TMO])) break; if (sp > XB_SPIN_CAP) { atomicAdd(&bar[XB_TMO], 1u); break; } }
    }
    nloc = mine > 0u ? mine : 1u; nx = cnt > 0u ? cnt : 1u;
}
__device__ __forceinline__ void xcd_barrier(const XcdBarrier& b) {
    asm volatile("s_waitcnt vmcnt(0)" ::: "memory");
    __syncthreads();
    if (threadIdx.x == 0) {
        unsigned* bar = b.bar;
        __builtin_amdgcn_s_waitcnt(0);
        unsigned nloc = b.st[0], nx = b.st[1];
        if (nloc == 0u) { xcd_barrier_complete(bar, b.x, nloc, nx); b.st[0] = nloc; b.st[1] = nx; }
        const unsigned old = xb_add(&bar[XB_XSUB(b.x)], 1u);
        const unsigned gen = old / nloc;
        if (old + 1u == (gen + 1u) * nloc) {
            __builtin_amdgcn_fence(__ATOMIC_RELEASE, "agent");
            asm volatile("s_waitcnt vmcnt(0)" ::: "memory");
            const unsigned og = xb_add(&bar[XB_TOP], 1u);
            const unsigned tg = og / nx;
            if (og + 1u == (tg + 1u) * nx) xb_add(&bar[XB_TOPGEN], 1u);
            else XB_SPIN(xb_ld(&bar[XB_TOPGEN]) == tg, bar);
            __builtin_amdgcn_fence(__ATOMIC_ACQUIRE, "agent");
            xb_add(&bar[XB_XGEN(b.x)], 1u);
            asm volatile("s_waitcnt vmcnt(0)" ::: "memory");
        } else {
            XB_SPIN(xb_ld(&bar[XB_XGEN(b.x)]) == gen, bar);
            __builtin_amdgcn_fence(__ATOMIC_ACQUIRE, "agent");
            asm volatile("s_waitcnt vmcnt(0)" ::: "memory");
        }
    }
    __syncthreads();
}

constexpr int NWAVES = 8, NTHR = 512;
constexpr int LDS_BYTES = 147456;
constexpr int MISC_OFF = 131072;
constexpr int PTAB_OFF = MISC_OFF + 512;

struct Args { const float* in[28]; float* out; unsigned char* ws; int ph_lo, ph_hi; };

struct Frame {
    LAS unsigned char* lds; int tid, lane, wave, G, c;
    const float* const* in; float* out; unsigned char* ws;
};
#define INP_(i) (F.in[i])
enum { I_X = 0, I_ANG, I_WIN, I_CDW, I_CDB, I_CLG, I_CLB, I_QG, I_KG, I_PK, I_PV, I_KW1, I_KB1, I_KW2, I_KB2, I_VW1, I_VB1, I_VW2, I_VB2, I_WOUT, I_FNG, I_DW1, I_DW3, I_DW2, I_RW, I_MW1, I_MW3, I_MW2 };

struct EpiIn {
    static constexpr bool PERM = true;
    const float* rstd; bf16_t* U; bf16_t* Q; bf16_t* KV; float* GT;
    __device__ __forceinline__ void operator()(const f32x4 (&acc)[2][2][4][2], const Unit& u, int wr, int wc, int fr, int fq) const {
        const int row0 = u.pm * 256 + wr * 64 + fr, cl = wc * 32 + 8 * fq;
        if (u.pn < 4) {
#pragma unroll
            for (int ai = 0; ai < 2; ++ai)
#pragma unroll
                for (int m = 0; m < 4; ++m) { const int r = row0 + ai * 128 + m * 16; const float rs = rstd[r];
                    const f32x4 v0 = acc[ai][0][m][0] * rs, v1 = acc[ai][0][m][1] * rs, g0 = acc[ai][1][m][0] * rs, g1 = acc[ai][1][m][1] * rs;
                    u32x4 w; w.x = cvt_pk_bf16(v0[0] * sigmoidf_(g0[0]), v0[1] * sigmoidf_(g0[1])); w.y = cvt_pk_bf16(v0[2] * sigmoidf_(g0[2]), v0[3] * sigmoidf_(g0[3]));
                    w.z = cvt_pk_bf16(v1[0] * sigmoidf_(g1[0]), v1[1] * sigmoidf_(g1[1])); w.w = cvt_pk_bf16(v1[2] * sigmoidf_(g1[2]), v1[3] * sigmoidf_(g1[3]));
                    *(u32x4*)(U + (size_t)r * CW + u.pn * 128 + cl) = w; }
        } else if (u.pn < 6) {
#pragma unroll
            for (int ai = 0; ai < 2; ++ai)
#pragma unroll
                for (int m = 0; m < 4; ++m) { const int r = row0 + ai * 128 + m * 16; const float rs = rstd[r];
#pragma unroll
                    for (int bj = 0; bj < 2; ++bj) { const f32x4 v0 = acc[ai][bj][m][0] * rs, v1 = acc[ai][bj][m][1] * rs;
                        u32x4 w; w.x = cvt_pk_bf16(v0[0], v0[1]); w.y = cvt_pk_bf16(v0[2], v0[3]); w.z = cvt_pk_bf16(v1[0], v1[1]); w.w = cvt_pk_bf16(v1[2], v1[3]);
                        *(u32x4*)(Q + (size_t)r * 512 + (u.pn - 4) * 256 + bj * 128 + cl) = w; } }
        } else if (u.pn < 9) {
            const int h = wc >> 1, d0 = 32 * (wc & 1) + 8 * fq;
#pragma unroll
            for (int ai = 0; ai < 2; ++ai)
#pragma unroll
                for (int m = 0; m < 4; ++m) { const int r = row0 + ai * 128 + m * 16; const float rs = rstd[r]; const int b = r >> 11, t = r & 2047;
#pragma unroll
                    for (int bj = 0; bj < 2; ++bj) { const int tq = 2 * (u.pn - 6) + bj; const f32x4 v0 = acc[ai][bj][m][0] * rs, v1 = acc[ai][bj][m][1] * rs;
                        u32x4 w; w.x = cvt_pk_bf16(v0[0], v0[1]); w.y = cvt_pk_bf16(v0[2], v0[3]); w.z = cvt_pk_bf16(v1[0], v1[1]); w.w = cvt_pk_bf16(v1[2], v1[3]);
                        *(u32x4*)(KV + (size_t)tq * KVT + ((size_t)(b * 2 + h) * SEQ + t) * DH + d0) = w; } }
        } else {
            if (wc == 0 && fq < 3) {
#pragma unroll
                for (int ai = 0; ai < 2; ++ai)
#pragma unroll
                    for (int m = 0; m < 4; ++m) { const int r = row0 + ai * 128 + m * 16; const float rs = rstd[r];
                        *(f32x4*)(GT + (size_t)r * 24 + 8 * fq) = acc[ai][0][m][0] * rs; *(f32x4*)(GT + (size_t)r * 24 + 8 * fq + 4) = acc[ai][0][m][1] * rs; }
            }
        }
    }
};
struct EpiH1 {
    static constexpr bool PERM = false;
    float* H;
    __device__ __forceinline__ void operator()(const f32x4 (&acc)[2][2][4][2], const Unit& u, int wr, int wc, int fr, int fq) const {
        const int row0 = u.pm * 256 + wr * 64 + fr, col0 = wc * 32 + 4 * fq; const int kv = u.pn >> 3, sp = u.pn & 7;
#pragma unroll
        for (int ai = 0; ai < 2; ++ai)
#pragma unroll
            for (int m = 0; m < 4; ++m) { float* rowp = H + (((size_t)sp * 2 + kv) * 2048 + row0 + ai * 128 + m * 16) * 256 + col0;
#pragma unroll
                for (int bj = 0; bj < 2; ++bj)
#pragma unroll
                    for (int n = 0; n < 2; ++n) *(f32x4*)(rowp + bj * 128 + n * 16) = acc[ai][bj][m][n]; }
    }
};
struct EpiRes {
    static constexpr bool PERM = false;
    const float* base; float* out;
    __device__ __forceinline__ void operator()(const f32x4 (&acc)[2][2][4][2], const Unit& u, int wr, int wc, int fr, int fq) const {
        const int row0 = u.pm * 256 + wr * 64 + fr, col0 = u.pn * 256 + wc * 32 + 4 * fq;
#pragma unroll
        for (int ai = 0; ai < 2; ++ai)
#pragma unroll
            for (int m = 0; m < 4; ++m) { const size_t off = (size_t)(row0 + ai * 128 + m * 16) * D + col0;
#pragma unroll
                for (int bj = 0; bj < 2; ++bj)
#pragma unroll
                    for (int n = 0; n < 2; ++n) { const f32x4 bs = *(const f32x4*)(base + off + bj * 128 + n * 16); *(f32x4*)(out + off + bj * 128 + n * 16) = bs + acc[ai][bj][m][n]; } }
    }
};
struct EpiGlu {
    static constexpr bool PERM = true;
    const float* rstd; bf16_t* O; int ldo; int rowbase;
    __device__ __forceinline__ void operator()(const f32x4 (&acc)[2][2][4][2], const Unit& u, int wr, int wc, int fr, int fq) const {
        const int row0 = u.pm * 256 + wr * 64 + fr, cl = u.pn * 128 + wc * 32 + 8 * fq;
#pragma unroll
        for (int ai = 0; ai < 2; ++ai)
#pragma unroll
            for (int m = 0; m < 4; ++m) { const int r = row0 + ai * 128 + m * 16; const float rs = rstd[rowbase + r];
                const f32x4 g0 = acc[ai][0][m][0] * rs, g1 = acc[ai][0][m][1] * rs, u0 = acc[ai][1][m][0] * rs, u1 = acc[ai][1][m][1] * rs;
                u32x4 w; w.x = cvt_pk_bf16(siluf_(g0[0]) * u0[0], siluf_(g0[1]) * u0[1]); w.y = cvt_pk_bf16(siluf_(g0[2]) * u0[2], siluf_(g0[3]) * u0[3]);
                w.z = cvt_pk_bf16(siluf_(g1[0]) * u1[0], siluf_(g1[1]) * u1[1]); w.w = cvt_pk_bf16(siluf_(g1[2]) * u1[2], siluf_(g1[3]) * u1[3]);
                *(u32x4*)(O + (size_t)r * ldo + cl) = w; }
    }
};
struct EpiMoe2 {
    static constexpr bool PERM = true;
    const int* stok; const float* sw; bf16_t* Y0; bf16_t* Y1; int rowbase;
    __device__ __forceinline__ void operator()(const f32x4 (&acc)[2][2][4][2], const Unit& u, int wr, int wc, int fr, int fq) const {
        const int row0 = u.pm * 256 + wr * 64 + fr, cl = u.pn * 256 + wc * 32 + 8 * fq;
#pragma unroll
        for (int ai = 0; ai < 2; ++ai)
#pragma unroll
            for (int m = 0; m < 4; ++m) { const int r = rowbase + row0 + ai * 128 + m * 16; const int tk = stok[r]; const float w = sw[r];
                if (tk >= 0) { bf16_t* dst = ((tk & 1) ? Y1 : Y0) + (size_t)(tk >> 1) * D + cl;
#pragma unroll
                    for (int bj = 0; bj < 2; ++bj) { const f32x4 v0 = acc[ai][bj][m][0] * w, v1 = acc[ai][bj][m][1] * w;
                        u32x4 o; o.x = cvt_pk_bf16(v0[0], v0[1]); o.y = cvt_pk_bf16(v0[2], v0[3]); o.z = cvt_pk_bf16(v1[0], v1[1]); o.w = cvt_pk_bf16(v1[2], v1[3]);
                        *(u32x4*)(dst + bj * 128) = o; } } }
    }
};

struct SchedCmp {
    int G, c, layer;
    __device__ __forceinline__ bool next(int i, Unit& u) const {
        const int L = i * G + c; if (L >= 128) return false;
        const int kv = L >> 6, pm = (L >> 3) & 7, s = L & 7;
        u.pm = pm; u.pn = kv * 8 + s; u.aoff = ((size_t)kv * KVT + (size_t)pm * 256 * 1024 + s * 256) * 2; u.boff = ((size_t)(layer * 2 + kv) * 256 * 2048 + s * 256) * 2; return true;
    }
};
struct SchedMoe1 {
    int G, c, p0, np; const LAS int* ptab;
    __device__ __forceinline__ bool next(int i, Unit& u) const {
        const int L = i * G + c; if (L >= np * 28) return false;
        const int j = L / np, pl = L % np, e = ptab[p0 + pl];
        u.pm = pl; u.pn = j; u.aoff = (size_t)(p0 + pl) * 256 * 1024 * 2; u.boff = ((size_t)e * 7168 + (size_t)j * 256) * 1024 * 2; return true;
    }
};
struct SchedMoe2 {
    int G, c, p0, np; const LAS int* ptab;
    __device__ __forceinline__ bool next(int i, Unit& u) const {
        const int L = i * G + c; if (L >= np * 4) return false;
        const int j = L / np, pl = L % np, e = ptab[p0 + pl];
        u.pm = pl; u.pn = j; u.aoff = (size_t)pl * 256 * DFE * 2; u.boff = ((size_t)e * 1024 + (size_t)j * 256) * DFE * 2; return true;
    }
};

__device__ __forceinline__ void tr_item(const float* W, int ldw, int n0, int nvalid, int k0, bf16_t* WT, size_t drow0, int ldk, const float* gv, LAS float* scr, int lane) {
#pragma unroll 8
    for (int i = 0; i < 32; ++i) { const int kk = 2 * i + (lane >> 5), n = n0 + (lane & 31); float v = (n < nvalid) ? W[(size_t)(k0 + kk) * ldw + n] : 0.f; if (gv) v *= gv[k0 + kk]; scr[kk * 33 + (lane & 31)] = v; }
    LDS_WAIT(); asm volatile("" ::: "memory");
    const int c = lane & 7;
#pragma unroll
    for (int j = 0; j < 4; ++j) { const int n = (lane >> 3) + 8 * j; const LAS float* s = scr + (8 * c) * 33 + n;
        u32x4 o; o.x = cvt_pk_bf16(s[0 * 33], s[1 * 33]); o.y = cvt_pk_bf16(s[2 * 33], s[3 * 33]); o.z = cvt_pk_bf16(s[4 * 33], s[5 * 33]); o.w = cvt_pk_bf16(s[6 * 33], s[7 * 33]);
        *(u32x4*)(WT + (drow0 + n) * (size_t)ldk + k0 + 8 * c) = o; }
    LDS_WAIT(); asm volatile("" ::: "memory");
}
__device__ __forceinline__ void tr_job_item(int r, const float* W, int K, int ldw, int nblk, int nvalid, bf16_t* WT, int ldk, int kind, int h, const float* gv, LAS float* scr, int lane) {
    const int kb = r / nblk, nb = r % nblk, n0 = 32 * nb; size_t drow;
    if (kind == 0) drow = n0;
    else if (kind == 1) drow = 256 * (n0 / 128) + 128 * h + (n0 % 128);
    else { if (n0 < 512) drow = 256 * (n0 / 128) + (n0 % 128); else if (n0 < 1024) { const int cc = n0 - 512; drow = 256 * (cc / 128) + 128 + (cc % 128); } else drow = n0; }
    tr_item(W, ldw, n0, nvalid, 64 * kb, WT, drow, ldk, gv, scr, lane);
}
__device__ __forceinline__ void xprep_row(const float* xrow, bf16_t* orow, float* rstd_out, int lane, f32x4 (&v)[4]) {
    const f32x4* xr = (const f32x4*)xrow + lane; float s = 0.f;
#pragma unroll
    for (int j = 0; j < 4; ++j) { v[j] = xr[64 * j]; s += (v[j].x * v[j].x + v[j].y * v[j].y) + (v[j].z * v[j].z + v[j].w * v[j].w); }
    const float rstd = rsqf_(wave_sum(s) * (1.0f / D) + EPS);
    if (orow) { u32x2* o8 = (u32x2*)orow + lane;
#pragma unroll
        for (int j = 0; j < 4; ++j) { u32x2 w; w.x = cvt_pk_bf16(v[j].x, v[j].y); w.y = cvt_pk_bf16(v[j].z, v[j].w); o8[64 * j] = w; } }
    if (lane == 0) *rstd_out = rstd;
}

__device__ __forceinline__ void phase_prologue(Frame& F) {
    LAS float* scr = (LAS float*)(F.lds + F.wave * 16384);
    const int gw = F.c * NWAVES + F.wave, NGW = F.G * NWAVES;
    bf16_t* WIN = (bf16_t*)(F.ws + WS_WIN); bf16_t* WC1 = (bf16_t*)(F.ws + WS_WC1); bf16_t* WOUT = (bf16_t*)(F.ws + WS_WOUT); bf16_t* WF1 = (bf16_t*)(F.ws + WS_WF1);
    bf16_t* WF2 = (bf16_t*)(F.ws + WS_WF2); bf16_t* WM1 = (bf16_t*)(F.ws + WS_WM1); bf16_t* WM2 = (bf16_t*)(F.ws + WS_WM2);
    constexpr int I_IN = 16 * 80, I_C1 = 32 * 8, I_OUT = 16 * 32, I_F1 = 16 * 88, I_F2 = 44 * 32, I_M1 = 16 * 112, I_M2 = 56 * 32;
    constexpr int NITEMS = 2 * I_IN + 4 * I_C1 + 2 * I_OUT + 2 * I_F1 + I_F2 + 16 * I_M1 + 8 * I_M2;
    for (int it = gw; it < NITEMS; it += NGW) {
        int r = it;
        if (r < 2 * I_IN) { const int l = r / I_IN; tr_job_item(r % I_IN, INP_(I_WIN) + (size_t)l * D * INW, D, INW, 80, INW, WIN + (size_t)l * INP * D, D, 2, 0, INP_(I_ANG) + l * D, scr, F.lane); continue; } r -= 2 * I_IN;
        if (r < 4 * I_C1) { const int q = r / I_C1, l = q >> 1, kv = q & 1; tr_job_item(r % I_C1, (kv ? INP_(I_VW1) : INP_(I_KW1)) + (size_t)l * 2048 * 256, 2048, 256, 8, 256, WC1 + (size_t)(l * 2 + kv) * 256 * 2048, 2048, 0, 0, nullptr, scr, F.lane); continue; } r -= 4 * I_C1;
        if (r < 2 * I_OUT) { const int l = r / I_OUT; tr_job_item(r % I_OUT, INP_(I_WOUT) + (size_t)l * D * D, D, D, 32, D, WOUT + (size_t)l * D * D, D, 0, 0, nullptr, scr, F.lane); continue; } r -= 2 * I_OUT;
        if (r < 2 * I_F1) { const int h = r / I_F1; tr_job_item(r % I_F1, (h ? INP_(I_DW3) : INP_(I_DW1)), D, DFF, 88, DFF, WF1, D, 1, h, INP_(I_FNG), scr, F.lane); continue; } r -= 2 * I_F1;
        if (r < I_F2) { tr_job_item(r, INP_(I_DW2), DFF, D, 32, D, WF2, DFF, 0, 0, nullptr, scr, F.lane); continue; } r -= I_F2;
        if (r < 16 * I_M1) { const int q = r / I_M1, e = q >> 1, h = q & 1; tr_job_item(r % I_M1, (h ? INP_(I_MW3) : INP_(I_MW1)) + (size_t)e * D * DFE, D, DFE, 112, DFE, WM1 + (size_t)e * 7168 * D, D, 1, h, INP_(I_FNG) + D, scr, F.lane); continue; } r -= 16 * I_M1;
        { const int e = r / I_M2; tr_job_item(r % I_M2, INP_(I_MW2) + (size_t)e * DFE * D, DFE, D, 32, D, WM2 + (size_t)e * D * DFE, DFE, 0, 0, nullptr, scr, F.lane); }
    }
    { float* RT = (float*)(F.ws + WS_RT); const int gt = F.c * NTHR + F.tid; if (gt < 8192) { const int e = gt >> 10, k = gt & 1023; RT[gt] = INP_(I_RW)[k * 8 + e] * INP_(I_FNG)[D + k]; } }
    { float* B1P = (float*)(F.ws + WS_CTL) + CW_B1P;
      for (int it = gw; it < 128; it += NGW) { const int kc = it & 7, jb = (it >> 3) & 3, kv = (it >> 5) & 1, l = it >> 6; const int j = jb * 64 + F.lane;
          const float* w1 = (kv ? INP_(I_VW1) : INP_(I_KW1)) + (size_t)l * 2048 * 256; const float* pos = (kv ? INP_(I_PV) : INP_(I_PK)) + l * 2048;
          float s = (kc == 0) ? (kv ? INP_(I_VB1) : INP_(I_KB1))[l * 256 + j] : 0.f;
          for (int k = kc * 256; k < kc * 256 + 256; ++k) s += pos[k] * w1[(size_t)k * 256 + j];
          B1P[kc * 1024 + (l * 2 + kv) * 256 + j] = s; } }
    { bf16_t* XB = (bf16_t*)(F.ws + WS_XB); float* RS = (float*)(F.ws + WS_RSTD); f32x4 v[4];
      for (int m = gw; m < M; m += NGW) xprep_row(INP_(I_X) + (size_t)m * D, XB + (size_t)m * D, RS + m, F.lane, v); }
}

__device__ __forceinline__ void norm_rows64(bf16_t* buf, int nrows, const float* g, float scale, int gw, int NGW, int lane) {
    const int sub = lane & 7; float gv[8];
#pragma unroll
    for (int j = 0; j < 8; ++j) gv[j] = g[sub * 8 + j] * scale;
    for (int it = gw; it < nrows / 8; it += NGW) { u32x4* p = (u32x4*)(buf + ((size_t)it * 8 + (lane >> 3)) * 64) + sub; const u32x4 v = *p;
        float f[8] = {bf_lo(v.x), bf_hi(v.x), bf_lo(v.y), bf_hi(v.y), bf_lo(v.z), bf_hi(v.z), bf_lo(v.w), bf_hi(v.w)}; float s = 0.f;
#pragma unroll
        for (int j = 0; j < 8; ++j) s += f[j] * f[j];
        s += __shfl_xor(s, 1); s += __shfl_xor(s, 2); s += __shfl_xor(s, 4);
        const float rs = rsqf_(s * (1.0f / 64.0f) + EPS);
        u32x4 o; o.x = cvt_pk_bf16(f[0] * rs * gv[0], f[1] * rs * gv[1]); o.y = cvt_pk_bf16(f[2] * rs * gv[2], f[3] * rs * gv[3]); o.z = cvt_pk_bf16(f[4] * rs * gv[4], f[5] * rs * gv[5]); o.w = cvt_pk_bf16(f[6] * rs * gv[6], f[7] * rs * gv[7]);
        *p = o; }
}
__device__ __forceinline__ void conv_unit(Frame& F, int layer, int cu) {
    const int b = cu >> 6, t0 = (cu & 63) * 32; int tid = F.tid; asm volatile("" : "+v"(tid));
    const bf16_t* U = (const bf16_t*)(F.ws + WS_U); bf16_t* MIX = (bf16_t*)(F.ws + WS_MIX);
    LAS u32x4* L4 = (LAS u32x4*)F.lds;
    for (int i = tid; i < 62 * 64; i += NTHR) { const int row = i >> 6, ch = i & 63, t = t0 - 30 + row; u32x4 v = (u32x4){0u, 0u, 0u, 0u}; if (t >= 0) v = *(const u32x4*)(U + (size_t)(b * SEQ + t) * CW + ch * 8); L4[i] = v; }
    __syncthreads();
    const int cp = tid & 255, th = tid >> 8; const LAS unsigned* LW = (const LAS unsigned*)F.lds;
    float w0[CKW], w1[CKW];
#pragma unroll
    for (int k = 0; k < CKW; ++k) { const f32x2 w = *(const f32x2*)(INP_(I_CDW) + (size_t)layer * CKW * CW + k * CW + 2 * cp); w0[k] = w.x; w1[k] = w.y; }
    const f32x2 cb = *(const f32x2*)(INP_(I_CDB) + layer * CW + 2 * cp), lg = *(const f32x2*)(INP_(I_CLG) + layer * CW + 2 * cp), lb = *(const f32x2*)(INP_(I_CLB) + layer * CW + 2 * cp);
#pragma nounroll
    for (int tl = th * 16; tl < th * 16 + 16; ++tl) {
        float y0 = cb.x, y1 = cb.y;
#pragma unroll
        for (int k = 0; k < CKW; ++k) { const unsigned v = LW[(tl + k) * 256 + cp]; y0 += w0[k] * bf_lo(v); y1 += w1[k] * bf_hi(v); }
        float s = y0 + y1;
#pragma unroll
        for (int o = 1; o < 32; o <<= 1) s += __shfl_xor(s, o);
        const float mu = s * (1.0f / 64.0f), d0 = y0 - mu, d1 = y1 - mu; float q = d0 * d0 + d1 * d1;
#pragma unroll
        for (int o = 1; o < 32; o <<= 1) q += __shfl_xor(q, o);
        const float rs = rsqf_(q * (1.0f / 64.0f) + EPS);
        const float a0 = d0 * rs * lg.x + lb.x, a1 = d1 * rs * lg.y + lb.y;
        *(unsigned*)(MIX + (size_t)(b * SEQ + t0 + tl) * D + 2 * cp) = cvt_pk_bf16(siluf_(a0), siluf_(a1));
    }
    __syncthreads();
}
__device__ __forceinline__ void phase_cmp2(Frame& F, int layer) {
    const int gw = F.c * NWAVES + F.wave, NGW = F.G * NWAVES, lane = F.lane;
    const float* H1 = (const float*)(F.ws + WS_H1); const float* B1P = (const float*)(F.ws + WS_CTL) + CW_B1P + layer * 512;
    for (int it = gw; it < 4096; it += NGW) { const int kv = it >> 11, R = it & 2047; if ((R & 127) == 127) continue;
        const float* Hrow = H1 + ((size_t)kv * 2048 + R) * 256; const float* w2 = (kv ? INP_(I_VW2) : INP_(I_KW2)) + (size_t)layer * 256 * 64;
        float hv[4];
#pragma unroll
        for (int q = 0; q < 4; ++q) { float x = 0.f;
#pragma unroll
            for (int sp = 0; sp < 8; ++sp) x += Hrow[(size_t)sp * 2 * 2048 * 256 + lane + 64 * q];
#pragma unroll
            for (int sp = 0; sp < 8; ++sp) x += B1P[sp * 1024 + kv * 256 + lane + 64 * q];
            hv[q] = siluf_(x); }
        float a = (kv ? INP_(I_VB2) : INP_(I_KB2))[layer * 64 + lane];
#pragma unroll
        for (int q = 0; q < 4; ++q)
#pragma unroll 16
            for (int kk = 0; kk < 64; ++kk) a += __shfl(hv[q], kk) * w2[(size_t)(64 * q + kk) * 64 + lane];
        if (kv == 0) { const float ms = wave_sum(a * a) * (1.0f / 64.0f); a = a * (rsqf_(ms + EPS)) * INP_(I_KG)[layer * 192 + lane]; }
        bf16_t* dst = (bf16_t*)(F.ws + (kv ? WS_VC : WS_KC)) + (size_t)R * 64 + lane; *dst = (bf16_t)(cvt_pk_bf16(a, 0.f) & 0xffffu);
    }
}

__device__ __forceinline__ void dots4(const bf16_t* krow, const LAS float* qs, float (&s)[4]) {
    s[0] = s[1] = s[2] = s[3] = 0.f;
#pragma nounroll
    for (int c = 0; c < 8; ++c) { const u32x4 v = *((const u32x4*)krow + c);
        const float f[8] = {bf_lo(v.x), bf_hi(v.x), bf_lo(v.y), bf_hi(v.y), bf_lo(v.z), bf_hi(v.z), bf_lo(v.w), bf_hi(v.w)};
#pragma unroll
        for (int h = 0; h < 4; ++h) { const f32x4 q0 = *(const LAS f32x4*)(qs + h * 64 + c * 8), q1 = *(const LAS f32x4*)(qs + h * 64 + c * 8 + 4);
            s[h] += (f[0] * q0.x + f[1] * q0.y) + (f[2] * q0.z + f[3] * q0.w) + (f[4] * q1.x + f[5] * q1.y) + (f[6] * q1.z + f[7] * q1.w); } }
}
__device__ __forceinline__ void softmax_pv(LAS f32x4* sb, const LAS int* kb, int nk, const bf16_t* V, int lane, float (&o)[4]) {
    float m[4] = {-1e30f, -1e30f, -1e30f, -1e30f};
#pragma nounroll
    for (int c = 0; c < nk; ++c) { const f32x4 s = sb[c * 64 + lane]; m[0] = fmaxf(m[0], s.x); m[1] = fmaxf(m[1], s.y); m[2] = fmaxf(m[2], s.z); m[3] = fmaxf(m[3], s.w); }
#pragma unroll
    for (int h = 0; h < 4; ++h) m[h] = wave_max(m[h]);
    float sum[4] = {0.f, 0.f, 0.f, 0.f};
#pragma nounroll
    for (int c = 0; c < nk; ++c) { const f32x4 s = sb[c * 64 + lane]; f32x4 p;
        p.x = s.x > -1e29f ? __expf(s.x - m[0]) : 0.f; p.y = s.y > -1e29f ? __expf(s.y - m[1]) : 0.f; p.z = s.z > -1e29f ? __expf(s.z - m[2]) : 0.f; p.w = s.w > -1e29f ? __expf(s.w - m[3]) : 0.f;
        sum[0] += p.x; sum[1] += p.y; sum[2] += p.z; sum[3] += p.w; sb[c * 64 + lane] = p; }
    float inv[4];
#pragma unroll
    for (int h = 0; h < 4; ++h) inv[h] = rcpf_(fmaxf(wave_sum(sum[h]), 1e-30f));
    LDS_WAIT(); __builtin_amdgcn_wave_barrier(); asm volatile("" ::: "memory");
    o[0] = o[1] = o[2] = o[3] = 0.f;
#pragma nounroll
    for (int c = 0; c < nk; ++c) { const int k0 = kb[c];
#pragma unroll 4
        for (int kk = 0; kk < 64; ++kk) { int key = k0 + kk; key = key < 0 ? 0 : (key > SEQ - 1 ? SEQ - 1 : key);
            const f32x4 p = sb[c * 64 + kk]; const float v = bf2f(V[(size_t)key * 64 + lane]);
            o[0] += p.x * v; o[1] += p.y * v; o[2] += p.z * v; o[3] += p.w * v; } }
#pragma unroll
    for (int h = 0; h < 4; ++h) o[h] *= inv[h];
    __builtin_amdgcn_wave_barrier(); asm volatile("" ::: "memory");
}
__device__ __forceinline__ void phase_attn_ref(Frame& F, int layer) {
    const int lane = F.lane;
    LAS unsigned char* wl = F.lds + F.wave * 12288;
    LAS float* qs = (LAS float*)wl;
    LAS f32x4* pc = (LAS f32x4*)(wl + 1024);
    LAS float* psum = (LAS float*)(wl + 3072);
    LAS int* kbl = (LAS int*)(wl + 3584);
    LAS f32x4* sb = (LAS f32x4*)(wl + 4096);
    const bf16_t* QN = (const bf16_t*)(F.ws + WS_Q); const bf16_t* KVb = (const bf16_t*)(F.ws + WS_KV);
    const bf16_t* KC = (const bf16_t*)(F.ws + WS_KC); const bf16_t* VC = (const bf16_t*)(F.ws + WS_VC);
    const float* GT = (const float*)(F.ws + WS_GT); bf16_t* MIX = (bf16_t*)(F.ws + WS_MIX);
#pragma nounroll
    for (int un = F.c; un < NBH * 64; un += F.G) {
        const int bh = un >> 6, tile = un & 63, b = bh >> 1, kvh = bh & 1;
        const bf16_t* KS = KVb + 2 * KVT + (size_t)bh * SEQ * 64; const bf16_t* VS = KVb + 3 * KVT + (size_t)bh * SEQ * 64;
        const bf16_t* KW = KVb + 4 * KVT + (size_t)bh * SEQ * 64; const bf16_t* VW = KVb + 5 * KVT + (size_t)bh * SEQ * 64;
#pragma nounroll
        for (int ti = 0; ti < 4; ++ti) {
            const int t = tile * 32 + F.wave * 4 + ti, r = b * SEQ + t;
#pragma unroll
            for (int h = 0; h < 4; ++h) qs[h * 64 + lane] = bf2f(QN[(size_t)r * 512 + (kvh * 4 + h) * 64 + lane]);
            LDS_WAIT(); __builtin_amdgcn_wave_barrier(); asm volatile("" ::: "memory");
            float sc[2][4]; bool vc[2];
#pragma unroll
            for (int u = 0; u < 2; ++u) { const int c = lane + 64 * u; vc[u] = (c < NCMP) && (16 * c + 31 <= t);
                if (vc[u]) dots4(KC + ((size_t)bh * 128 + c) * 64, qs, sc[u]); else { sc[u][0] = sc[u][1] = sc[u][2] = sc[u][3] = -1e30f; } }
            float pr[2][4];
#pragma unroll
            for (int h = 0; h < 4; ++h) { const float mx = wave_max(fmaxf(sc[0][h], sc[1][h]));
                pr[0][h] = vc[0] ? __expf(sc[0][h] - mx) : 0.f; pr[1][h] = vc[1] ? __expf(sc[1][h] - mx) : 0.f;
                const float inv = rcpf_(fmaxf(wave_sum(pr[0][h] + pr[1][h]), 1e-30f)); pr[0][h] *= inv; pr[1][h] *= inv; }
#pragma unroll
            for (int u = 0; u < 2; ++u) { pc[lane + 64 * u] = (f32x4){pr[u][0], pr[u][1], pr[u][2], pr[u][3]}; psum[lane + 64 * u] = (pr[u][0] + pr[u][1]) + (pr[u][2] + pr[u][3]); }
            LDS_WAIT(); __builtin_amdgcn_wave_barrier(); asm volatile("" ::: "memory");
            const int j = lane & 31, cur = t >> 6; float imp = 0.f;
#pragma unroll
            for (int cc = -1; cc <= 3; ++cc) { const int c = 4 * j + cc; if (c >= 0 && c < NCMP) imp += psum[c]; }
            const bool causal = (j * 64 <= t), forced = (j == 0) || (j == cur) || (j == cur - 1);
            const float score = causal ? (forced ? imp + 1e4f : imp) : -1e30f;
            int rank = 0;
#pragma unroll
            for (int i = 0; i < 32; ++i) { const float si = __shfl(score, i); rank += (si > score || (si == score && i < j)) ? 1 : 0; }
            const unsigned selmask = (unsigned)__ballot(lane < 32 && rank < 8 && causal);
            float ocmp[4] = {0.f, 0.f, 0.f, 0.f};
            { const int nvc = t >= 31 ? (((t - 31) >> 4) + 1 > NCMP ? NCMP : ((t - 31) >> 4) + 1) : 0;
#pragma unroll 4
              for (int c = 0; c < nvc; ++c) { const f32x4 p = pc[c]; const float v = bf2f(VC[((size_t)bh * 128 + c) * 64 + lane]); ocmp[0] += p.x * v; ocmp[1] += p.y * v; ocmp[2] += p.z * v; ocmp[3] += p.w * v; } }
            __builtin_amdgcn_wave_barrier(); asm volatile("" ::: "memory");
            int nk = 0; float osel[4], owin[4];
#pragma nounroll
            for (unsigned mm = selmask; mm != 0u && nk < 8; mm &= mm - 1u) { const int jj = __builtin_ctz(mm);
                const int key = jj * 64 + lane; float s[4];
                if (key <= t) dots4(KS + (size_t)key * 64, qs, s); else { s[0] = s[1] = s[2] = s[3] = -1e30f; }
                sb[nk * 64 + lane] = (f32x4){s[0], s[1], s[2], s[3]};
                if (lane == 0) kbl[nk] = jj * 64;
                ++nk; }
            LDS_WAIT(); __builtin_amdgcn_wave_barrier(); asm volatile("" ::: "memory");
            softmax_pv(sb, kbl, nk, VS, lane, osel);
            nk = 0;
#pragma nounroll
            for (int ch = 0; ch < 8; ++ch) { const int k0 = t - 511 + 64 * ch; if (k0 + 63 < 0) continue;
                const int key = k0 + lane; float s[4];
                if (key >= 0) dots4(KW + (size_t)key * 64, qs, s); else { s[0] = s[1] = s[2] = s[3] = -1e30f; }
                sb[nk * 64 + lane] = (f32x4){s[0], s[1], s[2], s[3]};
                if (lane == 0) kbl[nk] = k0;
                ++nk; }
            LDS_WAIT(); __builtin_amdgcn_wave_barrier(); asm volatile("" ::: "memory");
            softmax_pv(sb, kbl, nk, VW, lane, owin);
#pragma unroll
            for (int h = 0; h < 4; ++h) { const float* gp = GT + (size_t)r * 24 + (kvh * 4 + h) * 3;
                const float o = sigmoidf_(gp[0]) * ocmp[h] + sigmoidf_(gp[1]) * osel[h] + sigmoidf_(gp[2]) * owin[h];
                MIX[(size_t)r * D + 512 + (kvh * 4 + h) * 64 + lane] = (bf16_t)(cvt_pk_bf16(o, 0.f) & 0xffffu); }
            __builtin_amdgcn_wave_barrier(); asm volatile("" ::: "memory");
        }
    }
}

__device__ __forceinline__ int build_ptab(Frame& F) {
    LAS int* ptab = (LAS int*)(F.lds + PTAB_OFF);
    const unsigned* cnt = (const unsigned*)(F.ws + WS_CTL) + CW_CNT;
    if (F.tid == 0) { int p = 0;
        for (int e = 0; e < NE; ++e) { const int n = (int)((__hip_atomic_load(cnt + 64 * e, __ATOMIC_RELAXED, __HIP_MEMORY_SCOPE_AGENT) + 255u) >> 8); ptab[MAXPAN + 8 + e] = p * 256; for (int i = 0; i < n && p < MAXPAN; ++i) ptab[p++] = e; }
        ptab[MAXPAN] = p; }
    __syncthreads();
    return ptab[MAXPAN];
}

template <unsigned KM> __global__ void __launch_bounds__(NTHR, 2) fwd(Args args) {
    extern __shared__ __attribute__((aligned(16))) unsigned char lds_raw[];
    Frame F; F.lds = (LAS unsigned char*)lds_raw; F.tid = threadIdx.x; F.lane = F.tid & 63; F.wave = __builtin_amdgcn_readfirstlane(F.tid >> 6);
    F.G = gridDim.x; F.c = blockIdx.x; F.in = args.in; F.out = args.out; F.ws = args.ws;
    volatile LAS unsigned* MISC = (volatile LAS unsigned*)(F.lds + MISC_OFF);
    if (F.tid < 64) MISC[F.tid] = 0u;
    __syncthreads();
    unsigned* ctl = (unsigned*)(F.ws + WS_CTL);
#if MK_PER_PHASE
#define SEAM() do {} while (0)
#else
    XcdBarrier bar = xcd_barrier_post(ctl + CW_BAR, MISC);
#define SEAM() xcd_barrier(bar)
#endif
    const int lo = args.ph_lo, hi = args.ph_hi;
#define KON(kind) (((KM) >> (kind)) & 1u)
#define IN(k) (lo <= (k) && (k) < hi)
    const int gw = F.c * NWAVES + F.wave, NGW = F.G * NWAVES;
    bf16_t* XB = (bf16_t*)(F.ws + WS_XB); float* RS = (float*)(F.ws + WS_RSTD);

    if (KON(0) && IN(0)) { phase_prologue(F); SEAM(); }

    for (int layer = 0; layer < 2; ++layer) {
        const int pb = 1 + 12 * layer;
        if (KON(1) && IN(pb + 0)) {
            pg8::Gemm g{XB, (const bf16_t*)(F.ws + WS_WIN) + (size_t)layer * INP * D, D, D, D}; pg8::SchedGrid S; S.init(M / 256, INP / 256, F.G, F.c, D, D);
            EpiIn E{RS, (bf16_t*)(F.ws + WS_U), (bf16_t*)(F.ws + WS_Q), (bf16_t*)(F.ws + WS_KV), (float*)(F.ws + WS_GT)};
            pg8::gemm_phase(F.lds, g, S, E); SEAM();
        }
        if (KON(2) && IN(pb + 1)) {
            { pg8::Gemm g{(const bf16_t*)(F.ws + WS_KV), (const bf16_t*)(F.ws + WS_WC1), 256, 1024, 2048}; SchedCmp S{F.G, F.c, layer};
              EpiH1 E{(float*)(F.ws + WS_H1)}; pg8::gemm_phase(F.lds, g, S, E); }
            if (F.c < 128) conv_unit(F, layer, F.c);
            else {
#pragma nounroll
                for (int q = 0; q < 3; ++q) conv_unit(F, layer, 128 + 3 * (F.c - 128) + q); }
            norm_rows64((bf16_t*)(F.ws + WS_Q), M * 8, INP_(I_QG) + layer * 64, 0.125f, gw, NGW, F.lane);
            norm_rows64((bf16_t*)(F.ws + WS_KV) + 2 * KVT, NBH * SEQ, INP_(I_KG) + layer * 192 + 64, 1.0f, gw, NGW, F.lane);
            norm_rows64((bf16_t*)(F.ws + WS_KV) + 4 * KVT, NBH * SEQ, INP_(I_KG) + layer * 192 + 128, 1.0f, gw, NGW, F.lane);
            SEAM();
        }
        if (KON(3) && IN(pb + 2)) { phase_cmp2(F, layer); SEAM(); }
        if (KON(4) && IN(pb + 3)) { phase_attn_ref(F, layer); SEAM(); }
        if (KON(5) && IN(pb + 4)) {
            pg8::Gemm g{(const bf16_t*)(F.ws + WS_MIX), (const bf16_t*)(F.ws + WS_WOUT) + (size_t)layer * D * D, D, D, D}; pg8::SchedGrid S; S.init(M / 256, D / 256, F.G, F.c, D, D);
            EpiRes E{layer == 0 ? INP_(I_X) : (const float*)F.out, F.out}; pg8::gemm_phase(F.lds, g, S, E); SEAM();
        }
        if (KON(6) && IN(pb + 5)) {
            f32x4 v[4];
            if (layer == 0) { for (int m = gw; m < M; m += NGW) xprep_row(F.out + (size_t)m * D, XB + (size_t)m * D, RS + m, F.lane, v); }
            else {
                const float* RT = (const float*)(F.ws + WS_RT); unsigned* cnt = ctl + CW_CNT; int* ROUTE = (int*)(F.ws + WS_ROUTE);
                int* stok = (int*)(F.ws + WS_SLOT); for (int i = F.c * NTHR + F.tid; i < MAXSLOT; i += F.G * NTHR) stok[i] = -1;
                for (int m = gw; m < M; m += NGW) {
                    xprep_row(F.out + (size_t)m * D, XB + (size_t)m * D, RS + m, F.lane, v);
                    float lg[8];
#pragma unroll
                    for (int e = 0; e < 8; ++e) { const f32x4* rt = (const f32x4*)(RT + e * D) + F.lane; float s = 0.f;
#pragma unroll
                        for (int j = 0; j < 4; ++j) { const f32x4 w = rt[64 * j]; s += (v[j].x * w.x + v[j].y * w.y) + (v[j].z * w.z + v[j].w * w.w); }
                        lg[e] = wave_sum(s); }
                    if (F.lane == 0) { int e0 = 0; float l0 = lg[0];
#pragma unroll
                        for (int e = 1; e < 8; ++e) if (lg[e] > l0) { l0 = lg[e]; e0 = e; }
                        int e1 = -1; float l1 = -3.0e38f;
#pragma unroll
                        for (int e = 0; e < 8; ++e) if (e != e0 && lg[e] > l1) { l1 = lg[e]; e1 = e; }
                        const float rs = RS[m]; const float p1 = __expf((l1 - l0) * rs), w0 = rcpf_(1.0f + p1), w1 = p1 * w0;
                        const int q0 = (int)atomicAdd(cnt + 64 * e0, 1u), q1 = (int)atomicAdd(cnt + 64 * e1, 1u);
                        int* rp = ROUTE + (size_t)m * 6; rp[0] = e0; rp[1] = q0; rp[2] = e1; rp[3] = q1; rp[4] = __float_as_int(w0); rp[5] = __float_as_int(w1); }
                }
            }
            SEAM();
        }
        if (layer == 0) {
            if (KON(7) && IN(pb + 6)) {
                pg8::Gemm g{XB, (const bf16_t*)(F.ws + WS_WF1), D, D, D}; pg8::SchedGrid S; S.init(M / 256, 2 * DFF / 256, F.G, F.c, D, D);
                EpiGlu E{RS, (bf16_t*)(F.ws + WS_ACT), DFF, 0}; pg8::gemm_phase(F.lds, g, S, E); SEAM();
            }
            if (KON(8) && IN(pb + 7)) {
                pg8::Gemm g{(const bf16_t*)(F.ws + WS_ACT), (const bf16_t*)(F.ws + WS_WF2), DFF, DFF, DFF}; pg8::SchedGrid S; S.init(M / 256, D / 256, F.G, F.c, DFF, DFF);
                EpiRes E{(const float*)F.out, F.out}; pg8::gemm_phase(F.lds, g, S, E); SEAM();
            }
            if (KON(9) && IN(pb + 8)) { f32x4 v[4]; for (int m = gw; m < M; m += NGW) xprep_row(F.out + (size_t)m * D, XB + (size_t)m * D, RS + m, F.lane, v); SEAM(); }
        } else {
            if (KON(10) && IN(pb + 6)) {
                build_ptab(F); const LAS int* ptab = (const LAS int*)(F.lds + PTAB_OFF);
                const int* ROUTE = (const int*)(F.ws + WS_ROUTE); int* stok = (int*)(F.ws + WS_SLOT); float* sw = (float*)(stok + MAXSLOT); float* srs = sw + MAXSLOT; bf16_t* XS = (bf16_t*)(F.ws + WS_XS);
                for (int m = gw; m < M; m += NGW) { const int* rp = ROUTE + (size_t)m * 6; const u32x4* src = (const u32x4*)(XB + (size_t)m * D) + F.lane; const u32x4 a = src[0], b2 = src[64];
#pragma unroll
                    for (int k = 0; k < 2; ++k) { const int e = rp[2 * k], pos = rp[2 * k + 1], slot = ptab[MAXPAN + 8 + e] + pos; u32x4* dst = (u32x4*)(XS + (size_t)slot * D) + F.lane; dst[0] = a; dst[64] = b2;
                        if (F.lane == 0) { stok[slot] = m * 2 + k; sw[slot] = __int_as_float(rp[4 + k]); srs[slot] = RS[m]; } } }
                SEAM();
            }
            for (int ch = 0; ch < 2; ++ch) {
                if (KON(11) && IN(pb + 7 + 2 * ch)) {
                    const int npan = build_ptab(F); const int p0 = ch * CHUNKP, np = (npan - p0) < 0 ? 0 : ((npan - p0) > CHUNKP ? CHUNKP : (npan - p0));
                    const int* stok = (const int*)(F.ws + WS_SLOT); const float* srs = (const float*)(stok + 2 * MAXSLOT);
                    pg8::Gemm g{(const bf16_t*)(F.ws + WS_XS), (const bf16_t*)(F.ws + WS_WM1), D, D, D}; SchedMoe1 S{F.G, F.c, p0, np, (const LAS int*)(F.lds + PTAB_OFF)};
                    EpiGlu E{srs, (bf16_t*)(F.ws + WS_ACTM), DFE, 0};
                    E.rstd = srs + (size_t)p0 * 256;
                    pg8::gemm_phase(F.lds, g, S, E); SEAM();
                }
                if (KON(12) && IN(pb + 8 + 2 * ch)) {
                    const int npan = build_ptab(F); const int p0 = ch * CHUNKP, np = (npan - p0) < 0 ? 0 : ((npan - p0) > CHUNKP ? CHUNKP : (npan - p0));
                    const int* stok = (const int*)(F.ws + WS_SLOT); const float* sw = (const float*)(stok + MAXSLOT);
                    pg8::Gemm g{(const bf16_t*)(F.ws + WS_ACTM), (const bf16_t*)(F.ws + WS_WM2), DFE, DFE, DFE}; SchedMoe2 S{F.G, F.c, p0, np, (const LAS int*)(F.lds + PTAB_OFF)};
                    EpiMoe2 E{stok, sw, (bf16_t*)(F.ws + WS_Y0), (bf16_t*)(F.ws + WS_Y1), p0 * 256}; pg8::gemm_phase(F.lds, g, S, E); SEAM();
                }
            }
            if (KON(13) && IN(pb + 11)) {
                const bf16_t* Y0 = (const bf16_t*)(F.ws + WS_Y0); const bf16_t* Y1 = (const bf16_t*)(F.ws + WS_Y1);
                for (int m = gw; m < M; m += NGW) { f32x4* xr = (f32x4*)(F.out + (size_t)m * D) + F.lane; const u32x2* y0 = (const u32x2*)(Y0 + (size_t)m * D) + F.lane; const u32x2* y1 = (const u32x2*)(Y1 + (size_t)m * D) + F.lane;
#pragma unroll
                    for (int j = 0; j < 4; ++j) { f32x4 x = xr[64 * j]; const u32x2 a = y0[64 * j], b2 = y1[64 * j];
                        x.x += bf_lo(a.x) + bf_lo(b2.x); x.y += bf_hi(a.x) + bf_hi(b2.x); x.z += bf_lo(a.y) + bf_lo(b2.y); x.w += bf_hi(a.y) + bf_hi(b2.y); xr[64 * j] = x; } }
            }
        }
    }
#undef IN
}

constexpr int NPHASE = 25;
template <unsigned KM> static bool setup_kernel(int& per_cu) {
    if (hipFuncSetAttribute((const void*)fwd<KM>, hipFuncAttributeMaxDynamicSharedMemorySize, LDS_BYTES) != hipSuccess) return false;
    if (hipOccupancyMaxActiveBlocksPerMultiprocessor(&per_cu, (const void*)fwd<KM>, NTHR, LDS_BYTES) != hipSuccess) per_cu = 0;
    (void)hipGetLastError(); return true;
}
template <unsigned KM> static void launch_kind(int grid, const Args& a, hipStream_t stream) { hipLaunchKernelGGL(fwd<KM>, dim3(grid), dim3(NTHR), LDS_BYTES, stream, a); }
extern "C" void kernel_launch(void* const* d_in, const int* in_sizes, int n_in, void* d_out, int out_size, void* d_ws, size_t ws_size, hipStream_t stream) {
    static int grid = 0;
    if (grid == 0) {
        if (n_in != 28 || in_sizes[0] != M * D || out_size != M * D || ws_size < WS_END) { fprintf(stderr, "kernel_launch: unexpected shapes / workspace (n_in %d, ws %zu, need %zu)\n", n_in, ws_size, (size_t)WS_END); grid = -1; return; }
        int dev = 0, cus = 0, per_cu = 0; bool ok = true;
        if (hipGetDevice(&dev) != hipSuccess || hipDeviceGetAttribute(&cus, hipDeviceAttributeMultiprocessorCount, dev) != hipSuccess) { grid = -1; return; }
#if MK_PER_PHASE
        ok = ok && setup_kernel<1u << 0>(per_cu) && setup_kernel<1u << 1>(per_cu) && setup_kernel<1u << 2>(per_cu) && setup_kernel<1u << 3>(per_cu) && setup_kernel<1u << 4>(per_cu) && setup_kernel<1u << 5>(per_cu) && setup_kernel<1u << 6>(per_cu)
             && setup_kernel<1u << 7>(per_cu) && setup_kernel<1u << 8>(per_cu) && setup_kernel<1u << 9>(per_cu) && setup_kernel<1u << 10>(per_cu) && setup_kernel<1u << 11>(per_cu) && setup_kernel<1u << 12>(per_cu) && setup_kernel<1u << 13>(per_cu);
#else
        ok = ok && setup_kernel<0xffffffffu>(per_cu);
#endif
        if (!ok) { fprintf(stderr, "kernel_launch: hipFuncSetAttribute failed\n"); grid = -1; return; }
        if (per_cu < 1) fprintf(stderr, "kernel_launch: occupancy query says %d\n", per_cu);
        grid = cus;
    }
    if (grid < 0) return;
    (void)hipMemsetAsync((char*)d_ws + WS_CTL, 0, CTL_BYTES, stream);
    Args a{};
    for (int i = 0; i < 28; ++i) a.in[i] = (const float*)d_in[i];
    a.out = (float*)d_out; a.ws = (unsigned char*)d_ws;
#if MK_PER_PHASE
    static const int phases[] = {0, 1, 2, 3, 4, 5, 6, 7, 8, 9, 13, 14, 15, 16, 17, 18, 19, 20, 21, 22, 23, 24};
    static const int kinds[]  = {0, 1, 2, 3, 4, 5, 6, 7, 8, 9,  1,  2,  3,  4,  5,  6, 10, 11, 12, 11, 12, 13};
    for (int i = 0; i < (int)(sizeof(phases) / sizeof(int)); ++i) { a.ph_lo = phases[i]; a.ph_hi = phases[i] + 1;
        switch (kinds[i]) {
            case 0: launch_kind<1u << 0>(grid, a, stream); break; case 1: launch_kind<1u << 1>(grid, a, stream); break; case 2: launch_kind<1u << 2>(grid, a, stream); break;
            case 3: launch_kind<1u << 3>(grid, a, stream); break; case 4: launch_kind<1u << 4>(grid, a, stream); break; case 5: launch_kind<1u << 5>(grid, a, stream); break;
            case 6: launch_kind<1u << 6>(grid, a, stream); break; case 7: launch_kind<1u << 7>(grid, a, stream); break; case 8: launch_kind<1u << 8>(grid, a, stream); break;
            case 9: launch_kind<1u << 9>(grid, a, stream); break; case 10: launch_kind<1u << 10>(grid, a, stream); break; case 11: launch_kind<1u << 11>(grid, a, stream); break;
            case 12: launch_kind<1u << 12>(grid, a, stream); break; default: launch_kind<1u << 13>(grid, a, stream); break; } }
#else
    a.ph_lo = 0; a.ph_hi = NPHASE; launch_kind<0xffffffffu>(grid, a, stream);
#endif
}
```

```cpp
#include <hip/hip_runtime.h>
#include <cstdio>
#include <cstdint>

#ifndef MK_PER_PHASE
#define MK_PER_PHASE 0
#endif

#define LAS __attribute__((address_space(3)))
typedef unsigned short bf16_t;
typedef short bf16x8 __attribute__((ext_vector_type(8)));
typedef float f32x4 __attribute__((ext_vector_type(4)));
typedef float f32x2 __attribute__((ext_vector_type(2)));
typedef unsigned u32x4 __attribute__((ext_vector_type(4)));
typedef unsigned u32x2 __attribute__((ext_vector_type(2)));

constexpr int D = 1024, NB = 8, SEQ = 2048, M = NB * SEQ;
constexpr int INW = 2328, INP = 2560;
constexpr int CW = 512, CKW = 31, DH = 64, NKV = 2, NBH = NB * NKV;
constexpr int NCMP = 127, CHID = 256;
constexpr int DFF = 2816, NE = 8, DFE = 3584;
constexpr int MAXPAN = 136, MAXSLOT = MAXPAN * 256, CHUNKP = 72;
constexpr float EPS = 1e-6f;

constexpr size_t MiB = 1u << 20;
constexpr size_t WS_CTL = 0, CTL_BYTES = 2 * MiB;
constexpr size_t WS_H1 = 342 * MiB;
constexpr size_t WS_WIN = 12 * MiB;
constexpr size_t WS_WC1 = 22 * MiB;
constexpr size_t WS_WOUT = 26 * MiB;
constexpr size_t WS_WF1 = 30 * MiB;
constexpr size_t WS_WF2 = 41 * MiB;
constexpr size_t WS_RT = 47 * MiB;
constexpr size_t WS_WM1 = 48 * MiB;
constexpr size_t WS_WM2 = 160 * MiB;
constexpr size_t WS_XB = 216 * MiB;
constexpr size_t WS_RSTD = 248 * MiB;
constexpr size_t WS_GT = WS_RSTD + 65536;
constexpr size_t WS_ROUTE = WS_GT + (size_t)M * 24 * 4;
constexpr size_t WS_KC = 251 * MiB;
constexpr size_t WS_VC = WS_KC + 262144;
constexpr size_t WS_U = 252 * MiB;
constexpr size_t WS_Q = 268 * MiB;
constexpr size_t WS_KV = 284 * MiB;
constexpr size_t KVT = (size_t)NBH * SEQ * DH;
constexpr size_t WS_MIX = 310 * MiB;
constexpr size_t WS_ACT = 342 * MiB;
constexpr size_t WS_XS = 252 * MiB;
constexpr size_t WS_ACTM = 320 * MiB;
constexpr size_t WS_SLOT = 447 * MiB;
constexpr size_t WS_Y0 = WS_XB, WS_Y1 = 12 * MiB;
constexpr size_t WS_END = 448 * MiB;
constexpr int CW_BAR = 4096;
constexpr int CW_CNT = 8192;
constexpr int CW_B1P = 16384;

__device__ __forceinline__ unsigned cvt_pk_bf16(float lo, float hi) { unsigned r; asm volatile("v_cvt_pk_bf16_f32 %0, %1, %2" : "=v"(r) : "v"(lo), "v"(hi)); return r; }
__device__ __forceinline__ float bf_lo(unsigned v) { return __uint_as_float(v << 16); }
__device__ __forceinline__ float bf_hi(unsigned v) { return __uint_as_float(v & 0xffff0000u); }
__device__ __forceinline__ float bf2f(bf16_t v) { return __uint_as_float((unsigned)v << 16); }
__device__ __forceinline__ float rcpf_(float x) { return __builtin_amdgcn_rcpf(x); }
__device__ __forceinline__ float rsqf_(float x) { return __builtin_amdgcn_rsqf(x); }
__device__ __forceinline__ float sigmoidf_(float x) { return rcpf_(1.0f + __expf(-x)); }
__device__ __forceinline__ float siluf_(float x) { return x * sigmoidf_(x); }
__device__ __forceinline__ float wave_sum(float v) {
#pragma unroll
    for (int o = 1; o < 64; o <<= 1) v += __shfl_xor(v, o);
    return v;
}
__device__ __forceinline__ float wave_max(float v) {
#pragma unroll
    for (int o = 1; o < 64; o <<= 1) v = fmaxf(v, __shfl_xor(v, o));
    return v;
}
#define LDS_WAIT() asm volatile("s_waitcnt lgkmcnt(0)" ::: "memory")

namespace pg8 {
constexpr int BM = 256, BK = 64, HALF = 128, HTB = HALF * BK * 2, STAGE_BYTES = 8 * HTB, NXCD = 8, WGM = 8;
__device__ __forceinline__ int lds_byte(int r, int c) { const int st = (r >> 4) * 2 + (c >> 5), rr = r & 15, cc = c & 31, ob = rr * 64 + cc * 2; return st * 1024 + (ob ^ (((ob >> 9) & 1) << 5)); }
__device__ __forceinline__ void stage_rc(int b, int& R, int& C) { const int st = b / 1024, sb = b % 1024, swz = sb ^ (((sb >> 9) & 1) << 5); R = (st >> 1) * 16 + swz / 64; C = (st & 1) * 32 + (swz % 64) / 2; }
__device__ __forceinline__ int perm32(int rho) { const int n = rho >> 4, i = rho & 15; return 8 * (i >> 2) + 4 * n + (i & 3); }

struct Unit { int pm, pn; size_t aoff, boff; };
struct Gemm { const bf16_t* A; const bf16_t* Bt; int K, lda, ldb; };

struct SchedGrid {
    int nM, nN, nwg, G, c; size_t astr, bstr;
    __device__ __forceinline__ void init(int nM_, int nN_, int G_, int c_, int lda, int ldb) { nM = nM_; nN = nN_; nwg = nM * nN; G = G_; c = c_; astr = (size_t)BM * lda * 2; bstr = (size_t)BM * ldb * 2; }
    __device__ __forceinline__ bool next(int i, Unit& u) const {
        const long L = (long)i * G + c; if (L >= nwg) return false;
        int wgid = (int)L; { const int q = nwg / NXCD, r = nwg % NXCD, xcd = wgid % NXCD, off = wgid / NXCD; wgid = (xcd < r ? xcd * (q + 1) : r * (q + 1) + (xcd - r) * q) + off; }
        const int nig = WGM * nN, gid = wgid / nig, fm = gid * WGM, gsz = (nM - fm) < WGM ? (nM - fm) : WGM;
        u.pm = fm + ((wgid % nig) % gsz); u.pn = (wgid % nig) / gsz; u.aoff = (size_t)u.pm * astr; u.boff = (size_t)u.pn * bstr; return true;
    }
};

template <class Epi, class Sched>
__device__ __forceinline__ void gemm_phase(LAS unsigned char* lds, const Gemm g, const Sched& S, const Epi& E) {
    int tid = threadIdx.x; asm volatile("" : "+v"(tid));
    const int wid = __builtin_amdgcn_readfirstlane(tid >> 6), lane = tid & 63, wr = wid >> 2, wc = wid & 3, fr = lane & 15, fq = lane >> 4;
    const int K = g.K, nt = K / BK;
    unsigned voffA[2], voffB[2];
#pragma unroll
    for (int i = 0; i < 2; ++i) { int R, C; stage_rc(tid * 16 + i * 8192, R, C); const int Rb = Epi::PERM ? ((R & ~31) + perm32(R & 31)) : R;
        voffA[i] = (unsigned)(R * g.lda + C) * 2u; voffB[i] = (unsigned)(Rb * g.ldb + C) * 2u; }
    const size_t kstep = (size_t)(BK * 2);
    const size_t hstepA = (size_t)HALF * g.lda * 2, hstepB = (size_t)HALF * g.ldb * 2;
    const unsigned ldsw = (unsigned)wid * 1024u;
    const int aoff = lds_byte(wr * 64 + fr, fq * 8), boff = lds_byte(wc * 32 + fr, fq * 8);
#define PG8_SA(b, h) (((b) * 2 + (h)) * HTB)
#define PG8_SB(b, h) ((4 + (b) * 2 + (h)) * HTB)
#define PG8_STAGE(bufoff, gbase, voff) do { _Pragma("unroll") for (int _i = 0; _i < 2; ++_i) \
        __builtin_amdgcn_global_load_lds((const unsigned*)((const char*)(gbase) + (voff)[_i]), (LAS unsigned*)(lds + (bufoff) + ldsw + _i * 8192), 16, 0, 0); } while (0)
#define PG8_LDA(dst, b, h) do { _Pragma("unroll") for (int m = 0; m < 4; ++m) _Pragma("unroll") for (int k = 0; k < 2; ++k) dst[m][k] = *(const LAS bf16x8*)(lds + PG8_SA(b, h) + aoff + m * 2048 + k * 1024); } while (0)
#define PG8_LDB(dst, b, h) do { _Pragma("unroll") for (int n = 0; n < 2; ++n) _Pragma("unroll") for (int k = 0; k < 2; ++k) dst[n][k] = *(const LAS bf16x8*)(lds + PG8_SB(b, h) + boff + n * 2048 + k * 1024); } while (0)
#define PG8_MMA(ai, bj, At, Bt) do { __builtin_amdgcn_s_setprio(1); _Pragma("unroll") for (int m = 0; m < 4; ++m) _Pragma("unroll") for (int n = 0; n < 2; ++n) _Pragma("unroll") for (int k = 0; k < 2; ++k) \
        acc[ai][bj][m][n] = __builtin_amdgcn_mfma_f32_16x16x32_bf16(Bt[n][k], At[m][k], acc[ai][bj][m][n], 0, 0, 0); __builtin_amdgcn_s_setprio(0); } while (0)
#define PG8_WAIT_V(n) asm volatile("s_waitcnt vmcnt(" #n ")" ::: "memory")
#define PG8_WAIT_L(n) asm volatile("s_waitcnt lgkmcnt(" #n ")" ::: "memory")
#define PG8_BAR __builtin_amdgcn_s_barrier()
#define PG8_SCHED __builtin_amdgcn_sched_barrier(0)
    Unit cur, nxt; int ui = 0;
    if (!S.next(0, cur)) return;
    f32x4 acc[2][2][4][2];
#pragma unroll
    for (int a = 0; a < 2; ++a)
#pragma unroll
        for (int b = 0; b < 2; ++b)
#pragma unroll
            for (int m = 0; m < 4; ++m)
#pragma unroll
                for (int n = 0; n < 2; ++n) acc[a][b][m][n] = (f32x4){0.f, 0.f, 0.f, 0.f};
    bf16x8 At[4][2], B0[2][2], B1[2][2];
    const char* cA = (const char*)g.A + cur.aoff; const char* cB = (const char*)g.Bt + cur.boff;
    PG8_STAGE(PG8_SB(0, 0), cB, voffB); PG8_STAGE(PG8_SA(0, 0), cA, voffA); PG8_STAGE(PG8_SB(0, 1), cB + hstepB, voffB); PG8_STAGE(PG8_SA(0, 1), cA + hstepA, voffA);
    if (wr == 1) PG8_BAR;
    PG8_WAIT_V(4); PG8_BAR;
    PG8_STAGE(PG8_SB(1, 0), cB + kstep, voffB); PG8_STAGE(PG8_SA(1, 0), cA + kstep, voffA); PG8_STAGE(PG8_SB(1, 1), cB + hstepB + kstep, voffB);
    PG8_WAIT_V(6); PG8_BAR;
    for (;;) {
        const bool has_next = S.next(ui + 1, nxt);
        const char* nA = has_next ? (const char*)g.A + nxt.aoff : cA; const char* nB = has_next ? (const char*)g.Bt + nxt.boff : cB;
        for (int t = 0; t < nt; t += 2) {
            const bool last = (t == nt - 2);
            const char* a1 = cA + (size_t)(t + 1) * kstep;
            const char* a2 = last ? nA : cA + (size_t)(t + 2) * kstep; const char* b2 = last ? nB : cB + (size_t)(t + 2) * kstep;
            const char* a3 = a2 + kstep; const char* b3 = b2 + kstep;
            PG8_LDB(B0, 0, 0); PG8_SCHED; PG8_LDA(At, 0, 0); PG8_STAGE(PG8_SA(1, 1), a1 + hstepA, voffA);
            PG8_WAIT_L(8); PG8_BAR; PG8_WAIT_L(0); PG8_MMA(0, 0, At, B0); PG8_BAR; PG8_SCHED;
            PG8_LDB(B1, 0, 1); PG8_STAGE(PG8_SB(0, 0), b2, voffB);
            PG8_BAR; PG8_WAIT_L(0); PG8_MMA(0, 1, At, B1); PG8_BAR;
            PG8_LDA(At, 0, 1); PG8_STAGE(PG8_SA(0, 0), a2, voffA);
            PG8_BAR; PG8_WAIT_L(0); PG8_MMA(1, 0, At, B0); PG8_BAR; PG8_SCHED;
            PG8_STAGE(PG8_SB(0, 1), b2 + hstepB, voffB);
            PG8_WAIT_V(6); PG8_BAR; PG8_MMA(1, 1, At, B1); PG8_BAR;
            PG8_LDB(B0, 1, 0); PG8_SCHED; PG8_LDA(At, 1, 0); PG8_STAGE(PG8_SA(0, 1), a2 + hstepA, voffA);
            PG8_WAIT_L(8); PG8_BAR; PG8_WAIT_L(0); PG8_MMA(0, 0, At, B0); PG8_BAR; PG8_SCHED;
            PG8_LDB(B1, 1, 1); PG8_STAGE(PG8_SB(1, 0), b3, voffB);
            PG8_BAR; PG8_WAIT_L(0); PG8_MMA(0, 1, At, B1); PG8_BAR;
            PG8_LDA(At, 1, 1); PG8_STAGE(PG8_SA(1, 0), a3, voffA);
            PG8_BAR; PG8_WAIT_L(0); PG8_MMA(1, 0, At, B0); PG8_BAR; PG8_SCHED;
            PG8_STAGE(PG8_SB(1, 1), b3 + hstepB, voffB);
            PG8_WAIT_V(6); PG8_BAR; PG8_MMA(1, 1, At, B1); PG8_BAR;
        }
        E(acc, cur, wr, wc, fr, fq);
        if (!has_next) break;
#pragma unroll
        for (int a = 0; a < 2; ++a)
#pragma unroll
            for (int b = 0; b < 2; ++b)
#pragma unroll
                for (int m = 0; m < 4; ++m)
#pragma unroll
                    for (int n = 0; n < 2; ++n) acc[a][b][m][n] = (f32x4){0.f, 0.f, 0.f, 0.f};
        cur = nxt; cA = nA; cB = nB; ++ui;
    }
    PG8_WAIT_V(0);
    if (wr == 0) PG8_BAR;
    PG8_BAR;
#undef PG8_SA
#undef PG8_SB
#undef PG8_STAGE
#undef PG8_LDA
#undef PG8_LDB
#undef PG8_MMA
#undef PG8_WAIT_V
#undef PG8_WAIT_L
#undef PG8_BAR
#undef PG8_SCHED
}
}
using pg8::Unit;

#define XB_TMO      128
#define XB_XCNT(j)  (256  + 64 * (j))
#define XB_XSUB(j)  (1280 + 64 * (j))
#define XB_XGEN(j)  (2304 + 64 * (j))
#define XB_TOP      3328
#define XB_TOPGEN   3392
#define XCD_BAR_WORDS 3456
#define XB_SPIN_CAP (1u << 18)
__device__ __forceinline__ unsigned xb_ld(unsigned* p)              { return __hip_atomic_load(p, __ATOMIC_RELAXED, __HIP_MEMORY_SCOPE_AGENT); }
__device__ __forceinline__ unsigned xb_add(unsigned* p, unsigned v) { return __hip_atomic_fetch_add(p, v, __ATOMIC_RELAXED, __HIP_MEMORY_SCOPE_AGENT); }
__device__ __forceinline__ unsigned xb_xcc_id() { return (unsigned)__builtin_amdgcn_s_getreg((3 << 11) | 20) & 0xFu; }
#define XB_SPIN(cond, bar) do { unsigned _sp = 0; while (cond) { __builtin_amdgcn_s_sleep(1); \
    if ((++_sp & 255u) == 0u) { if (xb_ld(&(bar)[XB_TMO])) break; if (_sp > XB_SPIN_CAP) { atomicAdd(&(bar)[XB_TMO], 1u); break; } } } } while (0)
struct XcdBarrier { unsigned* bar; unsigned x; volatile LAS unsigned* st; };
__device__ __forceinline__ XcdBarrier xcd_barrier_post(unsigned* bar, volatile LAS unsigned* st) {
    XcdBarrier b; b.bar = bar; b.x = xb_xcc_id(); b.st = st;
    if (threadIdx.x == 0) (void)xb_add(&bar[XB_XCNT(b.x)], 1u);
    return b;
}
__device__ __forceinline__ void xcd_barrier_complete(unsigned* bar, unsigned x, unsigned& nloc, unsigned& nx) {
    const unsigned G = gridDim.x * gridDim.y * gridDim.z;
    unsigned sum, cnt, mine, sp = 0u;
    for (;;) {
        sum = 0u; cnt = 0u; mine = 0u;
#pragma unroll
        for (unsigned j = 0; j < 16; ++j) { const unsigned c = xb_ld(&bar[XB_XCNT(j)]); sum += c; cnt += (c > 0u) ? 1u : 0u; mine = (j == x) ? c : mine; }
        if (sum == G) break;
        __builtin_amdgcn_s_sleep(1);
        if ((++sp & 255u) == 0u) { if (xb_ld(&bar[XB_TMO])) break; if (sp > XB_SPIN_CAP) { atomicAdd(&bar[XB_TMO], 1u); break; } }
    }
    nloc = mine > 0u ? mine : 1u; nx = cnt > 0u ? cnt : 1u;
}
__device__ __forceinline__ void xcd_barrier(const XcdBarrier& b) {
    asm volatile("s_waitcnt vmcnt(0)" ::: "memory");
    __syncthreads();
    if (threadIdx.x == 0) {
        unsigned* bar = b.bar;
        __builtin_amdgcn_s_waitcnt(0);
        unsigned nloc = b.st[0], nx = b.st[1];
        if (nloc == 0u) { xcd_barrier_complete(bar, b.x, nloc, nx); b.st[0] = nloc; b.st[1] = nx; }
        const unsigned old = xb_add(&bar[XB_XSUB(b.x)], 1u);
        const unsigned gen = old / nloc;
        if (old + 1u == (gen + 1u) * nloc) {
            __builtin_amdgcn_fence(__ATOMIC_RELEASE, "agent");
            asm volatile("s_waitcnt vmcnt(0)" ::: "memory");
            const unsigned og = xb_add(&bar[XB_TOP], 1u);
            const unsigned tg = og / nx;
            if (og + 1u == (tg + 1u) * nx) xb_add(&bar[XB_TOPGEN], 1u);
            else XB_SPIN(xb_ld(&bar[XB_TOPGEN]) == tg, bar);
            __builtin_amdgcn_fence(__ATOMIC_ACQUIRE, "agent");
            xb_add(&bar[XB_XGEN(b.x)], 1u);
            asm volatile("s_waitcnt vmcnt(0)" ::: "memory");
        } else {
            XB_SPIN(xb_ld(&bar[XB_XGEN(b.x)]) == gen, bar);
            __builtin_amdgcn_fence(__ATOMIC_ACQUIRE, "agent");
            asm volatile("s_waitcnt vmcnt(0)" ::: "memory");
        }
    }
    __syncthreads();
}

constexpr int NWAVES = 8, NTHR = 512;
constexpr int LDS_BYTES = 147456;
constexpr int MISC_OFF = 131072;
constexpr int PTAB_OFF = MISC_OFF + 512;

struct Args { const float* in[28]; float* out; unsigned char* ws; int ph_lo, ph_hi; };

struct Frame {
    LAS unsigned char* lds; int tid, lane, wave, G, c;
    const float* const* in; float* out; unsigned char* ws;
};
#define INP_(i) (F.in[i])
#define FRESH_TID(F) do { int _t = threadIdx.x; asm volatile("" : "+v"(_t)); (F).tid = _t; (F).lane = _t & 63; } while (0)
enum { I_X = 0, I_ANG, I_WIN, I_CDW, I_CDB, I_CLG, I_CLB, I_QG, I_KG, I_PK, I_PV, I_KW1, I_KB1, I_KW2, I_KB2, I_VW1, I_VB1, I_VW2, I_VB2, I_WOUT, I_FNG, I_DW1, I_DW3, I_DW2, I_RW, I_MW1, I_MW3, I_MW2 };

struct EpiIn {
    static constexpr bool PERM = true;
    const float* rstd; bf16_t* U; bf16_t* Q; bf16_t* KV; float* GT;
    __device__ __forceinline__ void operator()(const f32x4 (&acc)[2][2][4][2], const Unit& u, int wr, int wc, int fr, int fq) const {
        const int row0 = u.pm * 256 + wr * 64 + fr, cl = wc * 32 + 8 * fq;
        if (u.pn < 4) {
#pragma unroll
            for (int ai = 0; ai < 2; ++ai)
#pragma unroll
                for (int m = 0; m < 4; ++m) { const int r = row0 + ai * 128 + m * 16; const float rs = rstd[r];
                    const f32x4 v0 = acc[ai][0][m][0] * rs, v1 = acc[ai][0][m][1] * rs, g0 = acc[ai][1][m][0] * rs, g1 = acc[ai][1][m][1] * rs;
                    u32x4 w; w.x = cvt_pk_bf16(v0[0] * sigmoidf_(g0[0]), v0[1] * sigmoidf_(g0[1])); w.y = cvt_pk_bf16(v0[2] * sigmoidf_(g0[2]), v0[3] * sigmoidf_(g0[3]));
                    w.z = cvt_pk_bf16(v1[0] * sigmoidf_(g1[0]), v1[1] * sigmoidf_(g1[1])); w.w = cvt_pk_bf16(v1[2] * sigmoidf_(g1[2]), v1[3] * sigmoidf_(g1[3]));
                    *(u32x4*)(U + (size_t)r * CW + u.pn * 128 + cl) = w; }
        } else if (u.pn < 6) {
#pragma unroll
            for (int ai = 0; ai < 2; ++ai)
#pragma unroll
                for (int m = 0; m < 4; ++m) { const int r = row0 + ai * 128 + m * 16; const float rs = rstd[r];
#pragma unroll
                    for (int bj = 0; bj < 2; ++bj) { const f32x4 v0 = acc[ai][bj][m][0] * rs, v1 = acc[ai][bj][m][1] * rs;
                        u32x4 w; w.x = cvt_pk_bf16(v0[0], v0[1]); w.y = cvt_pk_bf16(v0[2], v0[3]); w.z = cvt_pk_bf16(v1[0], v1[1]); w.w = cvt_pk_bf16(v1[2], v1[3]);
                        *(u32x4*)(Q + (size_t)r * 512 + (u.pn - 4) * 256 + bj * 128 + cl) = w; } }
        } else if (u.pn < 9) {
            const int h = wc >> 1, d0 = 32 * (wc & 1) + 8 * fq;
#pragma unroll
            for (int ai = 0; ai < 2; ++ai)
#pragma unroll
                for (int m = 0; m < 4; ++m) { const int r = row0 + ai * 128 + m * 16; const float rs = rstd[r]; const int b = r >> 11, t = r & 2047;
#pragma unroll
                    for (int bj = 0; bj < 2; ++bj) { const int tq = 2 * (u.pn - 6) + bj; const f32x4 v0 = acc[ai][bj][m][0] * rs, v1 = acc[ai][bj][m][1] * rs;
                        u32x4 w; w.x = cvt_pk_bf16(v0[0], v0[1]); w.y = cvt_pk_bf16(v0[2], v0[3]); w.z = cvt_pk_bf16(v1[0], v1[1]); w.w = cvt_pk_bf16(v1[2], v1[3]);
                        *(u32x4*)(KV + (size_t)tq * KVT + ((size_t)(b * 2 + h) * SEQ + t) * DH + d0) = w; } }
        } else {
            if (wc == 0 && fq < 3) {
#pragma unroll
                for (int ai = 0; ai < 2; ++ai)
#pragma unroll
                    for (int m = 0; m < 4; ++m) { const int r = row0 + ai * 128 + m * 16; const float rs = rstd[r];
                        *(f32x4*)(GT + (size_t)r * 24 + 8 * fq) = acc[ai][0][m][0] * rs; *(f32x4*)(GT + (size_t)r * 24 + 8 * fq + 4) = acc[ai][0][m][1] * rs; }
            }
        }
    }
};
struct EpiH1 {
    static constexpr bool PERM = false;
    float* H;
    __device__ __forceinline__ void operator()(const f32x4 (&acc)[2][2][4][2], const Unit& u, int wr, int wc, int fr, int fq) const {
        const int row0 = u.pm * 256 + wr * 64 + fr, col0 = wc * 32 + 4 * fq; const int kv = u.pn >> 3, sp = u.pn & 7;
#pragma unroll
        for (int ai = 0; ai < 2; ++ai)
#pragma unroll
            for (int m = 0; m < 4; ++m) { float* rowp = H + (((size_t)sp * 2 + kv) * 2048 + row0 + ai * 128 + m * 16) * 256 + col0;
#pragma unroll
                for (int bj = 0; bj < 2; ++bj)
#pragma unroll
                    for (int n = 0; n < 2; ++n) *(f32x4*)(rowp + bj * 128 + n * 16) = acc[ai][bj][m][n]; }
    }
};
struct EpiRes {
    static constexpr bool PERM = false;
    const float* base; float* out;
    __device__ __forceinline__ void operator()(const f32x4 (&acc)[2][2][4][2], const Unit& u, int wr, int wc, int fr, int fq) const {
        const int row0 = u.pm * 256 + wr * 64 + fr, col0 = u.pn * 256 + wc * 32 + 4 * fq;
#pragma unroll
        for (int ai = 0; ai < 2; ++ai)
#pragma unroll
            for (int m = 0; m < 4; ++m) { const size_t off = (size_t)(row0 + ai * 128 + m * 16) * D + col0;
#pragma unroll
                for (int bj = 0; bj < 2; ++bj)
#pragma unroll
                    for (int n = 0; n < 2; ++n) { const f32x4 bs = *(const f32x4*)(base + off + bj * 128 + n * 16); *(f32x4*)(out + off + bj * 128 + n * 16) = bs + acc[ai][bj][m][n]; } }
    }
};
struct EpiGlu {
    static constexpr bool PERM = true;
    const float* rstd; bf16_t* O; int ldo; int rowbase;
    __device__ __forceinline__ void operator()(const f32x4 (&acc)[2][2][4][2], const Unit& u, int wr, int wc, int fr, int fq) const {
        const int row0 = u.pm * 256 + wr * 64 + fr, cl = u.pn * 128 + wc * 32 + 8 * fq;
#pragma unroll
        for (int ai = 0; ai < 2; ++ai)
#pragma unroll
            for (int m = 0; m < 4; ++m) { const int r = row0 + ai * 128 + m * 16; const float rs = rstd[rowbase + r];
                const f32x4 g0 = acc[ai][0][m][0] * rs, g1 = acc[ai][0][m][1] * rs, u0 = acc[ai][1][m][0] * rs, u1 = acc[ai][1][m][1] * rs;
                u32x4 w; w.x = cvt_pk_bf16(siluf_(g0[0]) * u0[0], siluf_(g0[1]) * u0[1]); w.y = cvt_pk_bf16(siluf_(g0[2]) * u0[2], siluf_(g0[3]) * u0[3]);
                w.z = cvt_pk_bf16(siluf_(g1[0]) * u1[0], siluf_(g1[1]) * u1[1]); w.w = cvt_pk_bf16(siluf_(g1[2]) * u1[2], siluf_(g1[3]) * u1[3]);
                *(u32x4*)(O + (size_t)r * ldo + cl) = w; }
    }
};
struct EpiMoe2 {
    static constexpr bool PERM = true;
    const int* stok; const float* sw; bf16_t* Y0; bf16_t* Y1; int rowbase;
    __device__ __forceinline__ void operator()(const f32x4 (&acc)[2][2][4][2], const Unit& u, int wr, int wc, int fr, int fq) const {
        const int row0 = u.pm * 256 + wr * 64 + fr, cl = u.pn * 256 + wc * 32 + 8 * fq;
#pragma unroll
        for (int ai = 0; ai < 2; ++ai)
#pragma unroll
            for (int m = 0; m < 4; ++m) { const int r = rowbase + row0 + ai * 128 + m * 16; const int tk = stok[r]; const float w = sw[r];
                if (tk >= 0) { bf16_t* dst = ((tk & 1) ? Y1 : Y0) + (size_t)(tk >> 1) * D + cl;
#pragma unroll
                    for (int bj = 0; bj < 2; ++bj) { const f32x4 v0 = acc[ai][bj][m][0] * w, v1 = acc[ai][bj][m][1] * w;
                        u32x4 o; o.x = cvt_pk_bf16(v0[0], v0[1]); o.y = cvt_pk_bf16(v0[2], v0[3]); o.z = cvt_pk_bf16(v1[0], v1[1]); o.w = cvt_pk_bf16(v1[2], v1[3]);
                        *(u32x4*)(dst + bj * 128) = o; } } }
    }
};

struct SchedCmp {
    int G, c, layer;
    __device__ __forceinline__ bool next(int i, Unit& u) const {
        const int L = i * G + c; if (L >= 128) return false;
        const int kv = L >> 6, pm = (L >> 3) & 7, s = L & 7;
        u.pm = pm; u.pn = kv * 8 + s; u.aoff = ((size_t)kv * KVT + (size_t)pm * 256 * 1024 + s * 256) * 2; u.boff = ((size_t)(layer * 2 + kv) * 256 * 2048 + s * 256) * 2; return true;
    }
};
struct SchedMoe1 {
    int G, c, p0, np; const LAS int* ptab;
    __device__ __forceinline__ bool next(int i, Unit& u) const {
        const int L = i * G + c; if (L >= np * 28) return false;
        const int j = L / np, pl = L % np, e = ptab[p0 + pl];
        u.pm = pl; u.pn = j; u.aoff = (size_t)(p0 + pl) * 256 * 1024 * 2; u.boff = ((size_t)e * 7168 + (size_t)j * 256) * 1024 * 2; return true;
    }
};
struct SchedMoe2 {
    int G, c, p0, np; const LAS int* ptab;
    __device__ __forceinline__ bool next(int i, Unit& u) const {
        const int L = i * G + c; if (L >= np * 4) return false;
        const int j = L / np, pl = L % np, e = ptab[p0 + pl];
        u.pm = pl; u.pn = j; u.aoff = (size_t)pl * 256 * DFE * 2; u.boff = ((size_t)e * 1024 + (size_t)j * 256) * DFE * 2; return true;
    }
};

__device__ __forceinline__ void tr_item(const float* W, int ldw, int n0, int nvalid, int k0, bf16_t* WT, size_t drow0, int ldk, const float* gv, LAS float* scr, int lane) {
#pragma unroll 8
    for (int i = 0; i < 32; ++i) { const int kk = 2 * i + (lane >> 5), n = n0 + (lane & 31); float v = (n < nvalid) ? W[(size_t)(k0 + kk) * ldw + n] : 0.f; if (gv) v *= gv[k0 + kk]; scr[kk * 33 + (lane & 31)] = v; }
    LDS_WAIT(); asm volatile("" ::: "memory");
    const int c = lane & 7;
#pragma unroll
    for (int j = 0; j < 4; ++j) { const int n = (lane >> 3) + 8 * j; const LAS float* s = scr + (8 * c) * 33 + n;
        u32x4 o; o.x = cvt_pk_bf16(s[0 * 33], s[1 * 33]); o.y = cvt_pk_bf16(s[2 * 33], s[3 * 33]); o.z = cvt_pk_bf16(s[4 * 33], s[5 * 33]); o.w = cvt_pk_bf16(s[6 * 33], s[7 * 33]);
        *(u32x4*)(WT + (drow0 + n) * (size_t)ldk + k0 + 8 * c) = o; }
    LDS_WAIT(); asm volatile("" ::: "memory");
}
__device__ __forceinline__ void tr_job_item(int r, const float* W, int K, int ldw, int nblk, int nvalid, bf16_t* WT, int ldk, int kind, int h, const float* gv, LAS float* scr, int lane) {
    const int kb = r / nblk, nb = r % nblk, n0 = 32 * nb; size_t drow;
    if (kind == 0) drow = n0;
    else if (kind == 1) drow = 256 * (n0 / 128) + 128 * h + (n0 % 128);
    else { if (n0 < 512) drow = 256 * (n0 / 128) + (n0 % 128); else if (n0 < 1024) { const int cc = n0 - 512; drow = 256 * (cc / 128) + 128 + (cc % 128); } else drow = n0; }
    tr_item(W, ldw, n0, nvalid, 64 * kb, WT, drow, ldk, gv, scr, lane);
}
__device__ __forceinline__ void xprep_row(const float* xrow, bf16_t* orow, float* rstd_out, int lane, f32x4 (&v)[4]) {
    const f32x4* xr = (const f32x4*)xrow + lane; float s = 0.f;
#pragma unroll
    for (int j = 0; j < 4; ++j) { v[j] = xr[64 * j]; s += (v[j].x * v[j].x + v[j].y * v[j].y) + (v[j].z * v[j].z + v[j].w * v[j].w); }
    const float rstd = rsqf_(wave_sum(s) * (1.0f / D) + EPS);
    if (orow) { u32x2* o8 = (u32x2*)orow + lane;
#pragma unroll
        for (int j = 0; j < 4; ++j) { u32x2 w; w.x = cvt_pk_bf16(v[j].x, v[j].y); w.y = cvt_pk_bf16(v[j].z, v[j].w); o8[64 * j] = w; } }
    if (lane == 0) *rstd_out = rstd;
}

__device__ __forceinline__ void phase_prologue(Frame& F) {
    LAS float* scr = (LAS float*)(F.lds + F.wave * 16384);
    const int gw = F.c * NWAVES + F.wave, NGW = F.G * NWAVES;
    bf16_t* WIN = (bf16_t*)(F.ws + WS_WIN); bf16_t* WC1 = (bf16_t*)(F.ws + WS_WC1); bf16_t* WOUT = (bf16_t*)(F.ws + WS_WOUT); bf16_t* WF1 = (bf16_t*)(F.ws + WS_WF1);
    bf16_t* WF2 = (bf16_t*)(F.ws + WS_WF2); bf16_t* WM1 = (bf16_t*)(F.ws + WS_WM1); bf16_t* WM2 = (bf16_t*)(F.ws + WS_WM2);
    constexpr int I_IN = 16 * 80, I_C1 = 32 * 8, I_OUT = 16 * 32, I_F1 = 16 * 88, I_F2 = 44 * 32, I_M1 = 16 * 112, I_M2 = 56 * 32;
    constexpr int NITEMS = 2 * I_IN + 4 * I_C1 + 2 * I_OUT + 2 * I_F1 + I_F2 + 16 * I_M1 + 8 * I_M2;
    for (int it = gw; it < NITEMS; it += NGW) {
        int r = it;
        if (r < 2 * I_IN) { const int l = r / I_IN; tr_job_item(r % I_IN, INP_(I_WIN) + (size_t)l * D * INW, D, INW, 80, INW, WIN + (size_t)l * INP * D, D, 2, 0, INP_(I_ANG) + l * D, scr, F.lane); continue; } r -= 2 * I_IN;
        if (r < 4 * I_C1) { const int q = r / I_C1, l = q >> 1, kv = q & 1; tr_job_item(r % I_C1, (kv ? INP_(I_VW1) : INP_(I_KW1)) + (size_t)l * 2048 * 256, 2048, 256, 8, 256, WC1 + (size_t)(l * 2 + kv) * 256 * 2048, 2048, 0, 0, nullptr, scr, F.lane); continue; } r -= 4 * I_C1;
        if (r < 2 * I_OUT) { const int l = r / I_OUT; tr_job_item(r % I_OUT, INP_(I_WOUT) + (size_t)l * D * D, D, D, 32, D, WOUT + (size_t)l * D * D, D, 0, 0, nullptr, scr, F.lane); continue; } r -= 2 * I_OUT;
        if (r < 2 * I_F1) { const int h = r / I_F1; tr_job_item(r % I_F1, (h ? INP_(I_DW3) : INP_(I_DW1)), D, DFF, 88, DFF, WF1, D, 1, h, INP_(I_FNG), scr, F.lane); continue; } r -= 2 * I_F1;
        if (r < I_F2) { tr_job_item(r, INP_(I_DW2), DFF, D, 32, D, WF2, DFF, 0, 0, nullptr, scr, F.lane); continue; } r -= I_F2;
        if (r < 16 * I_M1) { const int q = r / I_M1, e = q >> 1, h = q & 1; tr_job_item(r % I_M1, (h ? INP_(I_MW3) : INP_(I_MW1)) + (size_t)e * D * DFE, D, DFE, 112, DFE, WM1 + (size_t)e * 7168 * D, D, 1, h, INP_(I_FNG) + D, scr, F.lane); continue; } r -= 16 * I_M1;
        { const int e = r / I_M2; tr_job_item(r % I_M2, INP_(I_MW2) + (size_t)e * DFE * D, DFE, D, 32, D, WM2 + (size_t)e * D * DFE, DFE, 0, 0, nullptr, scr, F.lane); }
    }
    { float* RT = (float*)(F.ws + WS_RT); const int gt = F.c * NTHR + F.tid; if (gt < 8192) { const int e = gt >> 10, k = gt & 1023; RT[gt] = INP_(I_RW)[k * 8 + e] * INP_(I_FNG)[D + k]; } }
    { float* B1P = (float*)(F.ws + WS_CTL) + CW_B1P;
      for (int it = gw; it < 128; it += NGW) { const int kc = it & 7, jb = (it >> 3) & 3, kv = (it >> 5) & 1, l = it >> 6; const int j = jb * 64 + F.lane;
          const float* w1 = (kv ? INP_(I_VW1) : INP_(I_KW1)) + (size_t)l * 2048 * 256; const float* pos = (kv ? INP_(I_PV) : INP_(I_PK)) + l * 2048;
          float s = (kc == 0) ? (kv ? INP_(I_VB1) : INP_(I_KB1))[l * 256 + j] : 0.f;
          for (int k = kc * 256; k < kc * 256 + 256; ++k) s += pos[k] * w1[(size_t)k * 256 + j];
          B1P[kc * 1024 + (l * 2 + kv) * 256 + j] = s; } }
    { bf16_t* XB = (bf16_t*)(F.ws + WS_XB); float* RS = (float*)(F.ws + WS_RSTD); f32x4 v[4];
      for (int m = gw; m < M; m += NGW) xprep_row(INP_(I_X) + (size_t)m * D, XB + (size_t)m * D, RS + m, F.lane, v); }
}

__device__ __forceinline__ void norm_rows64(bf16_t* buf, int nrows, const float* g, float scale, int gw, int NGW, int lane) {
    const int sub = lane & 7; float gv[8];
#pragma unroll
    for (int j = 0; j < 8; ++j) gv[j] = g[sub * 8 + j] * scale;
    for (int it = gw; it < nrows / 8; it += NGW) { u32x4* p = (u32x4*)(buf + ((size_t)it * 8 + (lane >> 3)) * 64) + sub; const u32x4 v = *p;
        float f[8] = {bf_lo(v.x), bf_hi(v.x), bf_lo(v.y), bf_hi(v.y), bf_lo(v.z), bf_hi(v.z), bf_lo(v.w), bf_hi(v.w)}; float s = 0.f;
#pragma unroll
        for (int j = 0; j < 8; ++j) s += f[j] * f[j];
        s += __shfl_xor(s, 1); s += __shfl_xor(s, 2); s += __shfl_xor(s, 4);
        const float rs = rsqf_(s * (1.0f / 64.0f) + EPS);
        u32x4 o; o.x = cvt_pk_bf16(f[0] * rs * gv[0], f[1] * rs * gv[1]); o.y = cvt_pk_bf16(f[2] * rs * gv[2], f[3] * rs * gv[3]); o.z = cvt_pk_bf16(f[4] * rs * gv[4], f[5] * rs * gv[5]); o.w = cvt_pk_bf16(f[6] * rs * gv[6], f[7] * rs * gv[7]);
        *p = o; }
}
__device__ __forceinline__ void conv_unit(Frame& F, int layer, int cu) {
    const int b = cu >> 6, t0 = (cu & 63) * 32; int tid = F.tid; asm volatile("" : "+v"(tid));
    const bf16_t* U = (const bf16_t*)(F.ws + WS_U); bf16_t* MIX = (bf16_t*)(F.ws + WS_MIX);
    LAS u32x4* L4 = (LAS u32x4*)F.lds;
    for (int i = tid; i < 62 * 64; i += NTHR) { const int row = i >> 6, ch = i & 63, t = t0 - 30 + row; u32x4 v = (u32x4){0u, 0u, 0u, 0u}; if (t >= 0) v = *(const u32x4*)(U + (size_t)(b * SEQ + t) * CW + ch * 8); L4[i] = v; }
    __syncthreads();
    const int cp = tid & 255, th = tid >> 8; const LAS unsigned* LW = (const LAS unsigned*)F.lds;
    float w0[CKW], w1[CKW];
#pragma unroll
    for (int k = 0; k < CKW; ++k) { const f32x2 w = *(const f32x2*)(INP_(I_CDW) + (size_t)layer * CKW * CW + k * CW + 2 * cp); w0[k] = w.x; w1[k] = w.y; }
    const f32x2 cb = *(const f32x2*)(INP_(I_CDB) + layer * CW + 2 * cp), lg = *(const f32x2*)(INP_(I_CLG) + layer * CW + 2 * cp), lb = *(const f32x2*)(INP_(I_CLB) + layer * CW + 2 * cp);
#pragma nounroll
    for (int tl = th * 16; tl < th * 16 + 16; ++tl) {
        float y0 = cb.x, y1 = cb.y;
#pragma unroll
        for (int k = 0; k < CKW; ++k) { const unsigned v = LW[(tl + k) * 256 + cp]; y0 += w0[k] * bf_lo(v); y1 += w1[k] * bf_hi(v); }
        float s = y0 + y1;
#pragma unroll
        for (int o = 1; o < 32; o <<= 1) s += __shfl_xor(s, o);
        const float mu = s * (1.0f / 64.0f), d0 = y0 - mu, d1 = y1 - mu; float q = d0 * d0 + d1 * d1;
#pragma unroll
        for (int o = 1; o < 32; o <<= 1) q += __shfl_xor(q, o);
        const float rs = rsqf_(q * (1.0f / 64.0f) + EPS);
        const float a0 = d0 * rs * lg.x + lb.x, a1 = d1 * rs * lg.y + lb.y;
        *(unsigned*)(MIX + (size_t)(b * SEQ + t0 + tl) * D + 2 * cp) = cvt_pk_bf16(siluf_(a0), siluf_(a1));
    }
    __syncthreads();
}
__device__ __forceinline__ void phase_cmp2(Frame& F, int layer) {
    const int gw = F.c * NWAVES + F.wave, NGW = F.G * NWAVES, lane = F.lane;
    const float* H1 = (const float*)(F.ws + WS_H1); const float* B1P = (const float*)(F.ws + WS_CTL) + CW_B1P + layer * 512;
    for (int it = gw; it < 4096; it += NGW) { const int kv = it >> 11, R = it & 2047; if ((R & 127) == 127) continue;
        const float* Hrow = H1 + ((size_t)kv * 2048 + R) * 256; const float* w2 = (kv ? INP_(I_VW2) : INP_(I_KW2)) + (size_t)layer * 256 * 64;
        float hv[4];
#pragma unroll
        for (int q = 0; q < 4; ++q) { float x = 0.f;
#pragma unroll
            for (int sp = 0; sp < 8; ++sp) x += Hrow[(size_t)sp * 2 * 2048 * 256 + lane + 64 * q];
#pragma unroll
            for (int sp = 0; sp < 8; ++sp) x += B1P[sp * 1024 + kv * 256 + lane + 64 * q];
            hv[q] = siluf_(x); }
        float a = (kv ? INP_(I_VB2) : INP_(I_KB2))[layer * 64 + lane];
#pragma unroll
        for (int q = 0; q < 4; ++q)
#pragma unroll 16
            for (int kk = 0; kk < 64; ++kk) a += __shfl(hv[q], kk) * w2[(size_t)(64 * q + kk) * 64 + lane];
        if (kv == 0) { const float ms = wave_sum(a * a) * (1.0f / 64.0f); a = a * (rsqf_(ms + EPS)) * INP_(I_KG)[layer * 192 + lane]; }
        bf16_t* dst = (bf16_t*)(F.ws + (kv ? WS_VC : WS_KC)) + (size_t)R * 64 + lane; *dst = (bf16_t)(cvt_pk_bf16(a, 0.f) & 0xffffu);
    }
}

__device__ __forceinline__ void dots4(const bf16_t* krow, const LAS float* qs, float (&s)[4]) {
    s[0] = s[1] = s[2] = s[3] = 0.f;
#pragma nounroll
    for (int c = 0; c < 8; ++c) { const u32x4 v = *((const u32x4*)krow + c);
        const float f[8] = {bf_lo(v.x), bf_hi(v.x), bf_lo(v.y), bf_hi(v.y), bf_lo(v.z), bf_hi(v.z), bf_lo(v.w), bf_hi(v.w)};
#pragma unroll
        for (int h = 0; h < 4; ++h) { const f32x4 q0 = *(const LAS f32x4*)(qs + h * 64 + c * 8), q1 = *(const LAS f32x4*)(qs + h * 64 + c * 8 + 4);
            s[h] += (f[0] * q0.x + f[1] * q0.y) + (f[2] * q0.z + f[3] * q0.w) + (f[4] * q1.x + f[5] * q1.y) + (f[6] * q1.z + f[7] * q1.w); } }
}
__device__ __forceinline__ void softmax_pv(LAS f32x4* sb, const LAS int* kb, int nk, const bf16_t* V, int lane, float (&o)[4]) {
    float m[4] = {-1e30f, -1e30f, -1e30f, -1e30f};
#pragma nounroll
    for (int c = 0; c < nk; ++c) { const f32x4 s = sb[c * 64 + lane]; m[0] = fmaxf(m[0], s.x); m[1] = fmaxf(m[1], s.y); m[2] = fmaxf(m[2], s.z); m[3] = fmaxf(m[3], s.w); }
#pragma unroll
    for (int h = 0; h < 4; ++h) m[h] = wave_max(m[h]);
    float sum[4] = {0.f, 0.f, 0.f, 0.f};
#pragma nounroll
    for (int c = 0; c < nk; ++c) { const f32x4 s = sb[c * 64 + lane]; f32x4 p;
        p.x = s.x > -1e29f ? __expf(s.x - m[0]) : 0.f; p.y = s.y > -1e29f ? __expf(s.y - m[1]) : 0.f; p.z = s.z > -1e29f ? __expf(s.z - m[2]) : 0.f; p.w = s.w > -1e29f ? __expf(s.w - m[3]) : 0.f;
        sum[0] += p.x; sum[1] += p.y; sum[2] += p.z; sum[3] += p.w; sb[c * 64 + lane] = p; }
    float inv[4];
#pragma unroll
    for (int h = 0; h < 4; ++h) inv[h] = rcpf_(fmaxf(wave_sum(sum[h]), 1e-30f));
    LDS_WAIT(); __builtin_amdgcn_wave_barrier(); asm volatile("" ::: "memory");
    o[0] = o[1] = o[2] = o[3] = 0.f;
#pragma nounroll
    for (int c = 0; c < nk; ++c) { const int k0 = kb[c];
#pragma unroll 4
        for (int kk = 0; kk < 64; ++kk) { int key = k0 + kk; key = key < 0 ? 0 : (key > SEQ - 1 ? SEQ - 1 : key);
            const f32x4 p = sb[c * 64 + kk]; const float v = bf2f(V[(size_t)key * 64 + lane]);
            o[0] += p.x * v; o[1] += p.y * v; o[2] += p.z * v; o[3] += p.w * v; } }
#pragma unroll
    for (int h = 0; h < 4; ++h) o[h] *= inv[h];
    __builtin_amdgcn_wave_barrier(); asm volatile("" ::: "memory");
}
__device__ __forceinline__ void phase_attn_ref(Frame& F, int layer) {
    const int lane = F.lane;
    LAS unsigned char* wl = F.lds + F.wave * 12288;
    LAS float* qs = (LAS float*)wl;
    LAS f32x4* pc = (LAS f32x4*)(wl + 1024);
    LAS float* psum = (LAS float*)(wl + 3072);
    LAS int* kbl = (LAS int*)(wl + 3584);
    LAS f32x4* sb = (LAS f32x4*)(wl + 4096);
    const bf16_t* QN = (const bf16_t*)(F.ws + WS_Q); const bf16_t* KVb = (const bf16_t*)(F.ws + WS_KV);
    const bf16_t* KC = (const bf16_t*)(F.ws + WS_KC); const bf16_t* VC = (const bf16_t*)(F.ws + WS_VC);
    const float* GT = (const float*)(F.ws + WS_GT); bf16_t* MIX = (bf16_t*)(F.ws + WS_MIX);
#pragma nounroll
    for (int un = F.c; un < NBH * 64; un += F.G) {
        const int bh = un >> 6, tile = un & 63, b = bh >> 1, kvh = bh & 1;
        const bf16_t* KS = KVb + 2 * KVT + (size_t)bh * SEQ * 64; const bf16_t* VS = KVb + 3 * KVT + (size_t)bh * SEQ * 64;
        const bf16_t* KW = KVb + 4 * KVT + (size_t)bh * SEQ * 64; const bf16_t* VW = KVb + 5 * KVT + (size_t)bh * SEQ * 64;
#pragma nounroll
        for (int ti = 0; ti < 4; ++ti) {
            const int t = tile * 32 + F.wave * 4 + ti, r = b * SEQ + t;
#pragma unroll
            for (int h = 0; h < 4; ++h) qs[h * 64 + lane] = bf2f(QN[(size_t)r * 512 + (kvh * 4 + h) * 64 + lane]);
            LDS_WAIT(); __builtin_amdgcn_wave_barrier(); asm volatile("" ::: "memory");
            float sc[2][4]; bool vc[2];
#pragma unroll
            for (int u = 0; u < 2; ++u) { const int c = lane + 64 * u; vc[u] = (c < NCMP) && (16 * c + 31 <= t);
                if (vc[u]) dots4(KC + ((size_t)bh * 128 + c) * 64, qs, sc[u]); else { sc[u][0] = sc[u][1] = sc[u][2] = sc[u][3] = -1e30f; } }
            float pr[2][4];
#pragma unroll
            for (int h = 0; h < 4; ++h) { const float mx = wave_max(fmaxf(sc[0][h], sc[1][h]));
                pr[0][h] = vc[0] ? __expf(sc[0][h] - mx) : 0.f; pr[1][h] = vc[1] ? __expf(sc[1][h] - mx) : 0.f;
                const float inv = rcpf_(fmaxf(wave_sum(pr[0][h] + pr[1][h]), 1e-30f)); pr[0][h] *= inv; pr[1][h] *= inv; }
#pragma unroll
            for (int u = 0; u < 2; ++u) { pc[lane + 64 * u] = (f32x4){pr[u][0], pr[u][1], pr[u][2], pr[u][3]}; psum[lane + 64 * u] = (pr[u][0] + pr[u][1]) + (pr[u][2] + pr[u][3]); }
            LDS_WAIT(); __builtin_amdgcn_wave_barrier(); asm volatile("" ::: "memory");
            const int j = lane & 31, cur = t >> 6; float imp = 0.f;
#pragma unroll
            for (int cc = -1; cc <= 3; ++cc) { const int c = 4 * j + cc; if (c >= 0 && c < NCMP) imp += psum[c]; }
            const bool causal = (j * 64 <= t), forced = (j == 0) || (j == cur) || (j == cur - 1);
            const float score = causal ? (forced ? imp + 1e4f : imp) : -1e30f;
            int rank = 0;
#pragma unroll
            for (int i = 0; i < 32; ++i) { const float si = __shfl(score, i); rank += (si > score || (si == score && i < j)) ? 1 : 0; }
            const unsigned selmask = (unsigned)__ballot(lane < 32 && rank < 8 && causal);
            float ocmp[4] = {0.f, 0.f, 0.f, 0.f};
            { const int nvc = t >= 31 ? (((t - 31) >> 4) + 1 > NCMP ? NCMP : ((t - 31) >> 4) + 1) : 0;
#pragma unroll 4
              for (int c = 0; c < nvc; ++c) { const f32x4 p = pc[c]; const float v = bf2f(VC[((size_t)bh * 128 + c) * 64 + lane]); ocmp[0] += p.x * v; ocmp[1] += p.y * v; ocmp[2] += p.z * v; ocmp[3] += p.w * v; } }
            __builtin_amdgcn_wave_barrier(); asm volatile("" ::: "memory");
            int nk = 0; float osel[4], owin[4];
#pragma nounroll
            for (unsigned mm = selmask; mm != 0u && nk < 8; mm &= mm - 1u) { const int jj = __builtin_ctz(mm);
                const int key = jj * 64 + lane; float s[4];
                if (key <= t) dots4(KS + (size_t)key * 64, qs, s); else { s[0] = s[1] = s[2] = s[3] = -1e30f; }
                sb[nk * 64 + lane] = (f32x4){s[0], s[1], s[2], s[3]};
                if (lane == 0) kbl[nk] = jj * 64;
                ++nk; }
            LDS_WAIT(); __builtin_amdgcn_wave_barrier(); asm volatile("" ::: "memory");
            softmax_pv(sb, kbl, nk, VS, lane, osel);
            nk = 0;
#pragma nounroll
            for (int ch = 0; ch < 8; ++ch) { const int k0 = t - 511 + 64 * ch; if (k0 + 63 < 0) continue;
                const int key = k0 + lane; float s[4];
                if (key >= 0) dots4(KW + (size_t)key * 64, qs, s); else { s[0] = s[1] = s[2] = s[3] = -1e30f; }
                sb[nk * 64 + lane] = (f32x4){s[0], s[1], s[2], s[3]};
                if (lane == 0) kbl[nk] = k0;
                ++nk; }
            LDS_WAIT(); __builtin_amdgcn_wave_barrier(); asm volatile("" ::: "memory");
            softmax_pv(sb, kbl, nk, VW, lane, owin);
#pragma unroll
            for (int h = 0; h < 4; ++h) { const float* gp = GT + (size_t)r * 24 + (kvh * 4 + h) * 3;
                const float o = sigmoidf_(gp[0]) * ocmp[h] + sigmoidf_(gp[1]) * osel[h] + sigmoidf_(gp[2]) * owin[h];
                MIX[(size_t)r * D + 512 + (kvh * 4 + h) * 64 + lane] = (bf16_t)(cvt_pk_bf16(o, 0.f) & 0xffffu); }
            __builtin_amdgcn_wave_barrier(); asm volatile("" ::: "memory");
        }
    }
}

__device__ __forceinline__ int build_ptab(Frame& F) {
    LAS int* ptab = (LAS int*)(F.lds + PTAB_OFF);
    const unsigned* cnt = (const unsigned*)(F.ws + WS_CTL) + CW_CNT;
    if (F.tid == 0) { int p = 0;
        for (int e = 0; e < NE; ++e) { const int n = (int)((__hip_atomic_load(cnt + 64 * e, __ATOMIC_RELAXED, __HIP_MEMORY_SCOPE_AGENT) + 255u) >> 8); ptab[MAXPAN + 8 + e] = p * 256; for (int i = 0; i < n && p < MAXPAN; ++i) ptab[p++] = e; }
        ptab[MAXPAN] = p; }
    __syncthreads();
    return ptab[MAXPAN];
}

template <unsigned KM> __global__ void __launch_bounds__(NTHR, 2) fwd(Args args) {
    extern __shared__ __attribute__((aligned(16))) unsigned char lds_raw[];
    Frame F; F.lds = (LAS unsigned char*)lds_raw; F.tid = threadIdx.x; F.lane = F.tid & 63; F.wave = __builtin_amdgcn_readfirstlane(F.tid >> 6);
    F.G = gridDim.x; F.c = blockIdx.x; F.in = args.in; F.out = args.out; F.ws = args.ws;
    volatile LAS unsigned* MISC = (volatile LAS unsigned*)(F.lds + MISC_OFF);
    if (F.tid < 64) MISC[F.tid] = 0u;
    __syncthreads();
    unsigned* ctl = (unsigned*)(F.ws + WS_CTL);
#if MK_PER_PHASE
#define SEAM() do {} while (0)
#else
    XcdBarrier bar = xcd_barrier_post(ctl + CW_BAR, MISC);
#define SEAM() xcd_barrier(bar)
#endif
    const int lo = args.ph_lo, hi = args.ph_hi;
#define KON(kind) (((KM) >> (kind)) & 1u)
#define IN(k) (lo <= (k) && (k) < hi)
    const int gw = F.c * NWAVES + F.wave, NGW = F.G * NWAVES;
    bf16_t* XB = (bf16_t*)(F.ws + WS_XB); float* RS = (float*)(F.ws + WS_RSTD);

    if (KON(0) && IN(0)) { FRESH_TID(F); phase_prologue(F); SEAM(); }

    for (int layer = 0; layer < 2; ++layer) {
        const int pb = 1 + 12 * layer;
        if (KON(1) && IN(pb + 0)) { FRESH_TID(F);
            pg8::Gemm g{XB, (const bf16_t*)(F.ws + WS_WIN) + (size_t)layer * INP * D, D, D, D}; pg8::SchedGrid S; S.init(M / 256, INP / 256, F.G, F.c, D, D);
            EpiIn E{RS, (bf16_t*)(F.ws + WS_U), (bf16_t*)(F.ws + WS_Q), (bf16_t*)(F.ws + WS_KV), (float*)(F.ws + WS_GT)};
            pg8::gemm_phase(F.lds, g, S, E); SEAM();
        }
        if (KON(2) && IN(pb + 1)) { FRESH_TID(F);
            { pg8::Gemm g{(const bf16_t*)(F.ws + WS_KV), (const bf16_t*)(F.ws + WS_WC1), 256, 1024, 2048}; SchedCmp S{F.G, F.c, layer};
              EpiH1 E{(float*)(F.ws + WS_H1)}; pg8::gemm_phase(F.lds, g, S, E); }
            if (F.c < 128) conv_unit(F, layer, F.c);
            else {
#pragma nounroll
                for (int q = 0; q < 3; ++q) conv_unit(F, layer, 128 + 3 * (F.c - 128) + q); }
            norm_rows64((bf16_t*)(F.ws + WS_Q), M * 8, INP_(I_QG) + layer * 64, 0.125f, gw, NGW, F.lane);
            norm_rows64((bf16_t*)(F.ws + WS_KV) + 2 * KVT, NBH * SEQ, INP_(I_KG) + layer * 192 + 64, 1.0f, gw, NGW, F.lane);
            norm_rows64((bf16_t*)(F.ws + WS_KV) + 4 * KVT, NBH * SEQ, INP_(I_KG) + layer * 192 + 128, 1.0f, gw, NGW, F.lane);
            SEAM();
        }
        if (KON(3) && IN(pb + 2)) { FRESH_TID(F); phase_cmp2(F, layer); SEAM(); }
        if (KON(4) && IN(pb + 3)) { FRESH_TID(F); phase_attn_ref(F, layer); SEAM(); }
        if (KON(5) && IN(pb + 4)) { FRESH_TID(F);
            pg8::Gemm g{(const bf16_t*)(F.ws + WS_MIX), (const bf16_t*)(F.ws + WS_WOUT) + (size_t)layer * D * D, D, D, D}; pg8::SchedGrid S; S.init(M / 256, D / 256, F.G, F.c, D, D);
            EpiRes E{layer == 0 ? INP_(I_X) : (const float*)F.out, F.out}; pg8::gemm_phase(F.lds, g, S, E); SEAM();
        }
        if (KON(6) && IN(pb + 5)) { FRESH_TID(F);
            f32x4 v[4];
            if (layer == 0) { for (int m = gw; m < M; m += NGW) xprep_row(F.out + (size_t)m * D, XB + (size_t)m * D, RS + m, F.lane, v); }
            else {
                const float* RT = (const float*)(F.ws + WS_RT); unsigned* cnt = ctl + CW_CNT; int* ROUTE = (int*)(F.ws + WS_ROUTE);
                int* stok = (int*)(F.ws + WS_SLOT); for (int i = F.c * NTHR + F.tid; i < MAXSLOT; i += F.G * NTHR) stok[i] = -1;
                for (int m = gw; m < M; m += NGW) {
                    xprep_row(F.out + (size_t)m * D, XB + (size_t)m * D, RS + m, F.lane, v);
                    float lg[8];
#pragma unroll
                    for (int e = 0; e < 8; ++e) { const f32x4* rt = (const f32x4*)(RT + e * D) + F.lane; float s = 0.f;
#pragma unroll
                        for (int j = 0; j < 4; ++j) { const f32x4 w = rt[64 * j]; s += (v[j].x * w.x + v[j].y * w.y) + (v[j].z * w.z + v[j].w * w.w); }
                        lg[e] = wave_sum(s); }
                    if (F.lane == 0) { int e0 = 0; float l0 = lg[0];
#pragma unroll
                        for (int e = 1; e < 8; ++e) if (lg[e] > l0) { l0 = lg[e]; e0 = e; }
                        int e1 = -1; float l1 = -3.0e38f;
#pragma unroll
                        for (int e = 0; e < 8; ++e) if (e != e0 && lg[e] > l1) { l1 = lg[e]; e1 = e; }
                        const float rs = RS[m]; const float p1 = __expf((l1 - l0) * rs), w0 = rcpf_(1.0f + p1), w1 = p1 * w0;
                        const int q0 = (int)atomicAdd(cnt + 64 * e0, 1u), q1 = (int)atomicAdd(cnt + 64 * e1, 1u);
                        int* rp = ROUTE + (size_t)m * 6; rp[0] = e0; rp[1] = q0; rp[2] = e1; rp[3] = q1; rp[4] = __float_as_int(w0); rp[5] = __float_as_int(w1); }
                }
            }
            SEAM();
        }
        if (layer == 0) {
            if (KON(7) && IN(pb + 6)) { FRESH_TID(F);
                pg8::Gemm g{XB, (const bf16_t*)(F.ws + WS_WF1), D, D, D}; pg8::SchedGrid S; S.init(M / 256, 2 * DFF / 256, F.G, F.c, D, D);
                EpiGlu E{RS, (bf16_t*)(F.ws + WS_ACT), DFF, 0}; pg8::gemm_phase(F.lds, g, S, E); SEAM();
            }
            if (KON(8) && IN(pb + 7)) { FRESH_TID(F);
                pg8::Gemm g{(const bf16_t*)(F.ws + WS_ACT), (const bf16_t*)(F.ws + WS_WF2), DFF, DFF, DFF}; pg8::SchedGrid S; S.init(M / 256, D / 256, F.G, F.c, DFF, DFF);
                EpiRes E{(const float*)F.out, F.out}; pg8::gemm_phase(F.lds, g, S, E); SEAM();
            }
            if (KON(9) && IN(pb + 8)) { FRESH_TID(F); f32x4 v[4]; for (int m = gw; m < M; m += NGW) xprep_row(F.out + (size_t)m * D, XB + (size_t)m * D, RS + m, F.lane, v); SEAM(); }
        } else {
            if (KON(10) && IN(pb + 6)) { FRESH_TID(F);
                build_ptab(F); const LAS int* ptab = (const LAS int*)(F.lds + PTAB_OFF);
                const int* ROUTE = (const int*)(F.ws + WS_ROUTE); int* stok = (int*)(F.ws + WS_SLOT); float* sw = (float*)(stok + MAXSLOT); float* srs = sw + MAXSLOT; bf16_t* XS = (bf16_t*)(F.ws + WS_XS);
                for (int m = gw; m < M; m += NGW) { const int* rp = ROUTE + (size_t)m * 6; const u32x4* src = (const u32x4*)(XB + (size_t)m * D) + F.lane; const u32x4 a = src[0], b2 = src[64];
#pragma unroll
                    for (int k = 0; k < 2; ++k) { const int e = rp[2 * k], pos = rp[2 * k + 1], slot = ptab[MAXPAN + 8 + e] + pos; u32x4* dst = (u32x4*)(XS + (size_t)slot * D) + F.lane; dst[0] = a; dst[64] = b2;
                        if (F.lane == 0) { stok[slot] = m * 2 + k; sw[slot] = __int_as_float(rp[4 + k]); srs[slot] = RS[m]; } } }
                SEAM();
            }
            for (int ch = 0; ch < 2; ++ch) {
                if (KON(11) && IN(pb + 7 + 2 * ch)) { FRESH_TID(F);
                    const int npan = build_ptab(F); const int p0 = ch * CHUNKP, np = (npan - p0) < 0 ? 0 : ((npan - p0) > CHUNKP ? CHUNKP : (npan - p0));
                    const int* stok = (const int*)(F.ws + WS_SLOT); const float* srs = (const float*)(stok + 2 * MAXSLOT);
                    pg8::Gemm g{(const bf16_t*)(F.ws + WS_XS), (const bf16_t*)(F.ws + WS_WM1), D, D, D}; SchedMoe1 S{F.G, F.c, p0, np, (const LAS int*)(F.lds + PTAB_OFF)};
                    EpiGlu E{srs, (bf16_t*)(F.ws + WS_ACTM), DFE, 0};
                    E.rstd = srs + (size_t)p0 * 256;
                    pg8::gemm_phase(F.lds, g, S, E); SEAM();
                }
                if (KON(12) && IN(pb + 8 + 2 * ch)) { FRESH_TID(F);
                    const int npan = build_ptab(F); const int p0 = ch * CHUNKP, np = (npan - p0) < 0 ? 0 : ((npan - p0) > CHUNKP ? CHUNKP : (npan - p0));
                    const int* stok = (const int*)(F.ws + WS_SLOT); const float* sw = (const float*)(stok + MAXSLOT);
                    pg8::Gemm g{(const bf16_t*)(F.ws + WS_ACTM), (const bf16_t*)(F.ws + WS_WM2), DFE, DFE, DFE}; SchedMoe2 S{F.G, F.c, p0, np, (const LAS int*)(F.lds + PTAB_OFF)};
                    EpiMoe2 E{stok, sw, (bf16_t*)(F.ws + WS_Y0), (bf16_t*)(F.ws + WS_Y1), p0 * 256}; pg8::gemm_phase(F.lds, g, S, E); SEAM();
                }
            }
            if (KON(13) && IN(pb + 11)) { FRESH_TID(F);
                const bf16_t* Y0 = (const bf16_t*)(F.ws + WS_Y0); const bf16_t* Y1 = (const bf16_t*)(F.ws + WS_Y1);
                for (int m = gw; m < M; m += NGW) { f32x4* xr = (f32x4*)(F.out + (size_t)m * D) + F.lane; const u32x2* y0 = (const u32x2*)(Y0 + (size_t)m * D) + F.lane; const u32x2* y1 = (const u32x2*)(Y1 + (size_t)m * D) + F.lane;
#pragma unroll
                    for (int j = 0; j < 4; ++j) { f32x4 x = xr[64 * j]; const u32x2 a = y0[64 * j], b2 = y1[64 * j];
                        x.x += bf_lo(a.x) + bf_lo(b2.x); x.y += bf_hi(a.x) + bf_hi(b2.x); x.z += bf_lo(a.y) + bf_lo(b2.y); x.w += bf_hi(a.y) + bf_hi(b2.y); xr[64 * j] = x; } }
            }
        }
    }
#undef IN
}

constexpr int NPHASE = 25;
template <unsigned KM> static bool setup_kernel(int& per_cu) {
    if (hipFuncSetAttribute((const void*)fwd<KM>, hipFuncAttributeMaxDynamicSharedMemorySize, LDS_BYTES) != hipSuccess) return false;
    if (hipOccupancyMaxActiveBlocksPerMultiprocessor(&per_cu, (const void*)fwd<KM>, NTHR, LDS_BYTES) != hipSuccess) per_cu = 0;
    (void)hipGetLastError(); return true;
}
template <unsigned KM> static void launch_kind(int grid, const Args& a, hipStream_t stream) { hipLaunchKernelGGL(fwd<KM>, dim3(grid), dim3(NTHR), LDS_BYTES, stream, a); }
extern "C" void kernel_launch(void* const* d_in, const int* in_sizes, int n_in, void* d_out, int out_size, void* d_ws, size_t ws_size, hipStream_t stream) {
    static int grid = 0;
    if (grid == 0) {
        if (n_in != 28 || in_sizes[0] != M * D || out_size != M * D || ws_size < WS_END) { fprintf(stderr, "kernel_launch: unexpected shapes / workspace (n_in %d, ws %zu, need %zu)\n", n_in, ws_size, (size_t)WS_END); grid = -1; return; }
        int dev = 0, cus = 0, per_cu = 0; bool ok = true;
        if (hipGetDevice(&dev) != hipSuccess || hipDeviceGetAttribute(&cus, hipDeviceAttributeMultiprocessorCount, dev) != hipSuccess) { grid = -1; return; }
#if MK_PER_PHASE
        ok = ok && setup_kernel<1u << 0>(per_cu) && setup_kernel<1u << 1>(per_cu) && setup_kernel<1u << 2>(per_cu) && setup_kernel<1u << 3>(per_cu) && setup_kernel<1u << 4>(per_cu) && setup_kernel<1u << 5>(per_cu) && setup_kernel<1u << 6>(per_cu)
             && setup_kernel<1u << 7>(per_cu) && setup_kernel<1u << 8>(per_cu) && setup_kernel<1u << 9>(per_cu) && setup_kernel<1u << 10>(per_cu) && setup_kernel<1u << 11>(per_cu) && setup_kernel<1u << 12>(per_cu) && setup_kernel<1u << 13>(per_cu);
#else
        ok = ok && setup_kernel<0xffffffffu>(per_cu);
#endif
        if (!ok) { fprintf(stderr, "kernel_launch: hipFuncSetAttribute failed\n"); grid = -1; return; }
        if (per_cu < 1) fprintf(stderr, "kernel_launch: occupancy query says %d\n", per_cu);
        grid = cus;
    }
    if (grid < 0) return;
    (void)hipMemsetAsync((char*)d_ws + WS_CTL, 0, CTL_BYTES, stream);
    Args a{};
    for (int i = 0; i < 28; ++i) a.in[i] = (const float*)d_in[i];
    a.out = (float*)d_out; a.ws = (unsigned char*)d_ws;
#if MK_PER_PHASE
    static const int phases[] = {0, 1, 2, 3, 4, 5, 6, 7, 8, 9, 13, 14, 15, 16, 17, 18, 19, 20, 21, 22, 23, 24};
    static const int kinds[]  = {0, 1, 2, 3, 4, 5, 6, 7, 8, 9,  1,  2,  3,  4,  5,  6, 10, 11, 12, 11, 12, 13};
    for (int i = 0; i < (int)(sizeof(phases) / sizeof(int)); ++i) { a.ph_lo = phases[i]; a.ph_hi = phases[i] + 1;
        switch (kinds[i]) {
            case 0: launch_kind<1u << 0>(grid, a, stream); break; case 1: launch_kind<1u << 1>(grid, a, stream); break; case 2: launch_kind<1u << 2>(grid, a, stream); break;
            case 3: launch_kind<1u << 3>(grid, a, stream); break; case 4: launch_kind<1u << 4>(grid, a, stream); break; case 5: launch_kind<1u << 5>(grid, a, stream); break;
            case 6: launch_kind<1u << 6>(grid, a, stream); break; case 7: launch_kind<1u << 7>(grid, a, stream); break; case 8: launch_kind<1u << 8>(grid, a, stream); break;
            case 9: launch_kind<1u << 9>(grid, a, stream); break; case 10: launch_kind<1u << 10>(grid, a, stream); break; case 11: launch_kind<1u << 11>(grid, a, stream); break;
            case 12: launch_kind<1u << 12>(grid, a, stream); break; default: launch_kind<1u << 13>(grid, a, stream); break; } }
#else
    a.ph_lo = 0; a.ph_hi = NPHASE; launch_kind<0xffffffffu>(grid, a, stream);
#endif
}
```

```cpp
#include <hip/hip_runtime.h>
#include <cstdio>
#include <cstdint>

#ifndef MK_PER_PHASE
#define MK_PER_PHASE 0
#endif

#define LAS __attribute__((address_space(3)))
typedef unsigned short bf16_t;
typedef short bf16x8 __attribute__((ext_vector_type(8)));
typedef float f32x4 __attribute__((ext_vector_type(4)));
typedef float f32x2 __attribute__((ext_vector_type(2)));
typedef unsigned u32x4 __attribute__((ext_vector_type(4)));
typedef unsigned u32x2 __attribute__((ext_vector_type(2)));

constexpr int D = 1024, NB = 8, SEQ = 2048, M = NB * SEQ;
constexpr int INW = 2328, INP = 2560;
constexpr int CW = 512, CKW = 31, DH = 64, NKV = 2, NBH = NB * NKV;
constexpr int NCMP = 127, CHID = 256;
constexpr int DFF = 2816, NE = 8, DFE = 3584;
constexpr int MAXPAN = 136, MAXSLOT = MAXPAN * 256, CHUNKP = 72;
constexpr float EPS = 1e-6f;

constexpr size_t MiB = 1u << 20;
constexpr size_t WS_CTL = 0, CTL_BYTES = 2 * MiB;
constexpr size_t WS_H1 = 342 * MiB;
constexpr size_t WS_WIN = 12 * MiB;
constexpr size_t WS_WC1 = 22 * MiB;
constexpr size_t WS_WOUT = 26 * MiB;
constexpr size_t WS_WF1 = 30 * MiB;
constexpr size_t WS_WF2 = 41 * MiB;
constexpr size_t WS_RT = 47 * MiB;
constexpr size_t WS_WM1 = 48 * MiB;
constexpr size_t WS_WM2 = 160 * MiB;
constexpr size_t WS_XB = 216 * MiB;
constexpr size_t WS_RSTD = 248 * MiB;
constexpr size_t WS_GT = WS_RSTD + 65536;
constexpr size_t WS_ROUTE = WS_GT + (size_t)M * 24 * 4;
constexpr size_t WS_KC = 251 * MiB;
constexpr size_t WS_VC = WS_KC + 262144;
constexpr size_t WS_VCT = WS_KC + 524288;
constexpr size_t WS_VST = 2 * MiB, WS_VWT = 6 * MiB;
constexpr size_t WS_U = 252 * MiB;
constexpr size_t WS_Q = 268 * MiB;
constexpr size_t WS_KV = 284 * MiB;
constexpr size_t KVT = (size_t)NBH * SEQ * DH;
constexpr size_t WS_MIX = 310 * MiB;
constexpr size_t WS_ACT = 342 * MiB;
constexpr size_t WS_XS = 252 * MiB;
constexpr size_t WS_ACTM = 320 * MiB;
constexpr size_t WS_SLOT = 447 * MiB;
constexpr size_t WS_Y0 = WS_XB, WS_Y1 = 12 * MiB;
constexpr size_t WS_END = 448 * MiB;
constexpr int CW_BAR = 4096;
constexpr int CW_CNT = 8192;
constexpr int CW_B1P = 16384;

__device__ __forceinline__ unsigned cvt_pk_bf16(float lo, float hi) { unsigned r; asm volatile("v_cvt_pk_bf16_f32 %0, %1, %2" : "=v"(r) : "v"(lo), "v"(hi)); return r; }
__device__ __forceinline__ float bf_lo(unsigned v) { return __uint_as_float(v << 16); }
__device__ __forceinline__ float bf_hi(unsigned v) { return __uint_as_float(v & 0xffff0000u); }
__device__ __forceinline__ float bf2f(bf16_t v) { return __uint_as_float((unsigned)v << 16); }
__device__ __forceinline__ float rcpf_(float x) { return __builtin_amdgcn_rcpf(x); }
__device__ __forceinline__ float rsqf_(float x) { return __builtin_amdgcn_rsqf(x); }
__device__ __forceinline__ float sigmoidf_(float x) { return rcpf_(1.0f + __expf(-x)); }
__device__ __forceinline__ float siluf_(float x) { return x * sigmoidf_(x); }
__device__ __forceinline__ float wave_sum(float v) {
#pragma unroll
    for (int o = 1; o < 64; o <<= 1) v += __shfl_xor(v, o);
    return v;
}
__device__ __forceinline__ float wave_max(float v) {
#pragma unroll
    for (int o = 1; o < 64; o <<= 1) v = fmaxf(v, __shfl_xor(v, o));
    return v;
}
#define LDS_WAIT() asm volatile("s_waitcnt lgkmcnt(0)" ::: "memory")
typedef float f32x16 __attribute__((ext_vector_type(16)));
typedef __bf16 bf16v2 __attribute__((ext_vector_type(2)));
#define MFMA32(a, b, c) __builtin_amdgcn_mfma_f32_32x32x16_bf16((a), (b), (c), 0, 0, 0)
__device__ __forceinline__ unsigned pk_bf16(float lo, float hi) { const f32x2 v = {lo, hi}; return __builtin_bit_cast(unsigned, __builtin_convertvector(v, bf16v2)); }
template <int S8> __device__ __forceinline__ bf16x8 pack8(const f32x16& p) { u32x4 w; w.x = pk_bf16(p[S8], p[S8 + 1]); w.y = pk_bf16(p[S8 + 2], p[S8 + 3]); w.z = pk_bf16(p[S8 + 4], p[S8 + 5]); w.w = pk_bf16(p[S8 + 6], p[S8 + 7]); return __builtin_bit_cast(bf16x8, w); }
__device__ __forceinline__ int swap23(int v) { return (v & ~12) | ((v & 4) << 1) | ((v & 8) >> 1); }

namespace pg8 {
constexpr int BM = 256, BK = 64, HALF = 128, HTB = HALF * BK * 2, STAGE_BYTES = 8 * HTB, NXCD = 8, WGM = 8;
__device__ __forceinline__ int lds_byte(int r, int c) { const int st = (r >> 4) * 2 + (c >> 5), rr = r & 15, cc = c & 31, ob = rr * 64 + cc * 2; return st * 1024 + (ob ^ (((ob >> 9) & 1) << 5)); }
__device__ __forceinline__ void stage_rc(int b, int& R, int& C) { const int st = b / 1024, sb = b % 1024, swz = sb ^ (((sb >> 9) & 1) << 5); R = (st >> 1) * 16 + swz / 64; C = (st & 1) * 32 + (swz % 64) / 2; }
__device__ __forceinline__ int perm32(int rho) { const int n = rho >> 4, i = rho & 15; return 8 * (i >> 2) + 4 * n + (i & 3); }

struct Unit { int pm, pn; size_t aoff, boff; };
struct Gemm { const bf16_t* A; const bf16_t* Bt; int K, lda, ldb; };

struct SchedGrid {
    int nM, nN, nwg, G, c; size_t astr, bstr;
    __device__ __forceinline__ void init(int nM_, int nN_, int G_, int c_, int lda, int ldb) { nM = nM_; nN = nN_; nwg = nM * nN; G = G_; c = c_; astr = (size_t)BM * lda * 2; bstr = (size_t)BM * ldb * 2; }
    __device__ __forceinline__ bool next(int i, Unit& u) const {
        const long L = (long)i * G + c; if (L >= nwg) return false;
        int wgid = (int)L; { const int q = nwg / NXCD, r = nwg % NXCD, xcd = wgid % NXCD, off = wgid / NXCD; wgid = (xcd < r ? xcd * (q + 1) : r * (q + 1) + (xcd - r) * q) + off; }
        const int nig = WGM * nN, gid = wgid / nig, fm = gid * WGM, gsz = (nM - fm) < WGM ? (nM - fm) : WGM;
        u.pm = fm + ((wgid % nig) % gsz); u.pn = (wgid % nig) / gsz; u.aoff = (size_t)u.pm * astr; u.boff = (size_t)u.pn * bstr; return true;
    }
};

template <class Epi, class Sched>
__device__ __forceinline__ void gemm_phase(LAS unsigned char* lds, const Gemm g, const Sched& S, const Epi& E) {
    int tid = threadIdx.x; asm volatile("" : "+v"(tid));
    const int wid = __builtin_amdgcn_readfirstlane(tid >> 6), lane = tid & 63, wr = wid >> 2, wc = wid & 3, fr = lane & 15, fq = lane >> 4;
    const int K = g.K, nt = K / BK;
    unsigned voffA[2], voffB[2];
#pragma unroll
    for (int i = 0; i < 2; ++i) { int R, C; stage_rc(tid * 16 + i * 8192, R, C); const int Rb = Epi::PERM ? ((R & ~31) + perm32(R & 31)) : R;
        voffA[i] = (unsigned)(R * g.lda + C) * 2u; voffB[i] = (unsigned)(Rb * g.ldb + C) * 2u; }
    const size_t kstep = (size_t)(BK * 2);
    const size_t hstepA = (size_t)HALF * g.lda * 2, hstepB = (size_t)HALF * g.ldb * 2;
    const unsigned ldsw = (unsigned)wid * 1024u;
    const int aoff = lds_byte(wr * 64 + fr, fq * 8), boff = lds_byte(wc * 32 + fr, fq * 8);
#define PG8_SA(b, h) (((b) * 2 + (h)) * HTB)
#define PG8_SB(b, h) ((4 + (b) * 2 + (h)) * HTB)
#define PG8_STAGE(bufoff, gbase, voff) do { _Pragma("unroll") for (int _i = 0; _i < 2; ++_i) \
        __builtin_amdgcn_global_load_lds((const unsigned*)((const char*)(gbase) + (voff)[_i]), (LAS unsigned*)(lds + (bufoff) + ldsw + _i * 8192), 16, 0, 0); } while (0)
#define PG8_LDA(dst, b, h) do { _Pragma("unroll") for (int m = 0; m < 4; ++m) _Pragma("unroll") for (int k = 0; k < 2; ++k) dst[m][k] = *(const LAS bf16x8*)(lds + PG8_SA(b, h) + aoff + m * 2048 + k * 1024); } while (0)
#define PG8_LDB(dst, b, h) do { _Pragma("unroll") for (int n = 0; n < 2; ++n) _Pragma("unroll") for (int k = 0; k < 2; ++k) dst[n][k] = *(const LAS bf16x8*)(lds + PG8_SB(b, h) + boff + n * 2048 + k * 1024); } while (0)
#define PG8_MMA(ai, bj, At, Bt) do { __builtin_amdgcn_s_setprio(1); _Pragma("unroll") for (int m = 0; m < 4; ++m) _Pragma("unroll") for (int n = 0; n < 2; ++n) _Pragma("unroll") for (int k = 0; k < 2; ++k) \
        acc[ai][bj][m][n] = __builtin_amdgcn_mfma_f32_16x16x32_bf16(Bt[n][k], At[m][k], acc[ai][bj][m][n], 0, 0, 0); __builtin_amdgcn_s_setprio(0); } while (0)
#define PG8_WAIT_V(n) asm volatile("s_waitcnt vmcnt(" #n ")" ::: "memory")
#define PG8_WAIT_L(n) asm volatile("s_waitcnt lgkmcnt(" #n ")" ::: "memory")
#define PG8_BAR __builtin_amdgcn_s_barrier()
#define PG8_SCHED __builtin_amdgcn_sched_barrier(0)
    Unit cur, nxt; int ui = 0;
    if (!S.next(0, cur)) return;
    f32x4 acc[2][2][4][2];
#pragma unroll
    for (int a = 0; a < 2; ++a)
#pragma unroll
        for (int b = 0; b < 2; ++b)
#pragma unroll
            for (int m = 0; m < 4; ++m)
#pragma unroll
                for (int n = 0; n < 2; ++n) acc[a][b][m][n] = (f32x4){0.f, 0.f, 0.f, 0.f};
    bf16x8 At[4][2], B0[2][2], B1[2][2];
    const char* cA = (const char*)g.A + cur.aoff; const char* cB = (const char*)g.Bt + cur.boff;
    PG8_STAGE(PG8_SB(0, 0), cB, voffB); PG8_STAGE(PG8_SA(0, 0), cA, voffA); PG8_STAGE(PG8_SB(0, 1), cB + hstepB, voffB); PG8_STAGE(PG8_SA(0, 1), cA + hstepA, voffA);
    if (wr == 1) PG8_BAR;
    PG8_WAIT_V(4); PG8_BAR;
    PG8_STAGE(PG8_SB(1, 0), cB + kstep, voffB); PG8_STAGE(PG8_SA(1, 0), cA + kstep, voffA); PG8_STAGE(PG8_SB(1, 1), cB + hstepB + kstep, voffB);
    PG8_WAIT_V(6); PG8_BAR;
    for (;;) {
        const bool has_next = S.next(ui + 1, nxt);
        const char* nA = has_next ? (const char*)g.A + nxt.aoff : cA; const char* nB = has_next ? (const char*)g.Bt + nxt.boff : cB;
        for (int t = 0; t < nt; t += 2) {
            const bool last = (t == nt - 2);
            const char* a1 = cA + (size_t)(t + 1) * kstep;
            const char* a2 = last ? nA : cA + (size_t)(t + 2) * kstep; const char* b2 = last ? nB : cB + (size_t)(t + 2) * kstep;
            const char* a3 = a2 + kstep; const char* b3 = b2 + kstep;
            PG8_LDB(B0, 0, 0); PG8_SCHED; PG8_LDA(At, 0, 0); PG8_STAGE(PG8_SA(1, 1), a1 + hstepA, voffA);
            PG8_WAIT_L(8); PG8_BAR; PG8_WAIT_L(0); PG8_MMA(0, 0, At, B0); PG8_BAR; PG8_SCHED;
            PG8_LDB(B1, 0, 1); PG8_STAGE(PG8_SB(0, 0), b2, voffB);
            PG8_BAR; PG8_WAIT_L(0); PG8_MMA(0, 1, At, B1); PG8_BAR;
            PG8_LDA(At, 0, 1); PG8_STAGE(PG8_SA(0, 0), a2, voffA);
            PG8_BAR; PG8_WAIT_L(0); PG8_MMA(1, 0, At, B0); PG8_BAR; PG8_SCHED;
            PG8_STAGE(PG8_SB(0, 1), b2 + hstepB, voffB);
            PG8_WAIT_V(6); PG8_BAR; PG8_MMA(1, 1, At, B1); PG8_BAR;
            PG8_LDB(B0, 1, 0); PG8_SCHED; PG8_LDA(At, 1, 0); PG8_STAGE(PG8_SA(0, 1), a2 + hstepA, voffA);
            PG8_WAIT_L(8); PG8_BAR; PG8_WAIT_L(0); PG8_MMA(0, 0, At, B0); PG8_BAR; PG8_SCHED;
            PG8_LDB(B1, 1, 1); PG8_STAGE(PG8_SB(1, 0), b3, voffB);
            PG8_BAR; PG8_WAIT_L(0); PG8_MMA(0, 1, At, B1); PG8_BAR;
            PG8_LDA(At, 1, 1); PG8_STAGE(PG8_SA(1, 0), a3, voffA);
            PG8_BAR; PG8_WAIT_L(0); PG8_MMA(1, 0, At, B0); PG8_BAR; PG8_SCHED;
            PG8_STAGE(PG8_SB(1, 1), b3 + hstepB, voffB);
            PG8_WAIT_V(6); PG8_BAR; PG8_MMA(1, 1, At, B1); PG8_BAR;
        }
        E(acc, cur, wr, wc, fr, fq);
        if (!has_next) break;
#pragma unroll
        for (int a = 0; a < 2; ++a)
#pragma unroll
            for (int b = 0; b < 2; ++b)
#pragma unroll
                for (int m = 0; m < 4; ++m)
#pragma unroll
                    for (int n = 0; n < 2; ++n) acc[a][b][m][n] = (f32x4){0.f, 0.f, 0.f, 0.f};
        cur = nxt; cA = nA; cB = nB; ++ui;
    }
    PG8_WAIT_V(0);
    if (wr == 0) PG8_BAR;
    PG8_BAR;
#undef PG8_SA
#undef PG8_SB
#undef PG8_STAGE
#undef PG8_LDA
#undef PG8_LDB
#undef PG8_MMA
#undef PG8_WAIT_V
#undef PG8_WAIT_L
#undef PG8_BAR
#undef PG8_SCHED
}
}
using pg8::Unit;

#define XB_TMO      128
#define XB_XCNT(j)  (256  + 64 * (j))
#define XB_XSUB(j)  (1280 + 64 * (j))
#define XB_XGEN(j)  (2304 + 64 * (j))
#define XB_TOP      3328
#define XB_TOPGEN   3392
#define XCD_BAR_WORDS 3456
#define XB_SPIN_CAP (1u << 18)
__device__ __forceinline__ unsigned xb_ld(unsigned* p)              { return __hip_atomic_load(p, __ATOMIC_RELAXED, __HIP_MEMORY_SCOPE_AGENT); }
__device__ __forceinline__ unsigned xb_add(unsigned* p, unsigned v) { return __hip_atomic_fetch_add(p, v, __ATOMIC_RELAXED, __HIP_MEMORY_SCOPE_AGENT); }
__device__ __forceinline__ unsigned xb_xcc_id() { return (unsigned)__builtin_amdgcn_s_getreg((3 << 11) | 20) & 0xFu; }
#define XB_SPIN(cond, bar) do { unsigned _sp = 0; while (cond) { __builtin_amdgcn_s_sleep(1); \
    if ((++_sp & 255u) == 0u) { if (xb_ld(&(bar)[XB_TMO])) break; if (_sp > XB_SPIN_CAP) { atomicAdd(&(bar)[XB_TMO], 1u); break; } } } } while (0)
struct XcdBarrier { unsigned* bar; unsigned x; volatile LAS unsigned* st; };
__device__ __forceinline__ XcdBarrier xcd_barrier_post(unsigned* bar, volatile LAS unsigned* st) {
    XcdBarrier b; b.bar = bar; b.x = xb_xcc_id(); b.st = st;
    if (threadIdx.x == 0) (void)xb_add(&bar[XB_XCNT(b.x)], 1u);
    return b;
}
__device__ __forceinline__ void xcd_barrier_complete(unsigned* bar, unsigned x, unsigned& nloc, unsigned& nx) {
    const unsigned G = gridDim.x * gridDim.y * gridDim.z;
    unsigned sum, cnt, mine, sp = 0u;
    for (;;) {
        sum = 0u; cnt = 0u; mine = 0u;
#pragma unroll
        for (unsigned j = 0; j < 16; ++j) { const unsigned c = xb_ld(&bar[XB_XCNT(j)]); sum += c; cnt += (c > 0u) ? 1u : 0u; mine = (j == x) ? c : mine; }
        if (sum == G) break;
        __builtin_amdgcn_s_sleep(1);
        if ((++sp & 255u) == 0u) { if (xb_ld(&bar[XB_TMO])) break; if (sp > XB_SPIN_CAP) { atomicAdd(&bar[XB_TMO], 1u); break; } }
    }
    nloc = mine > 0u ? mine : 1u; nx = cnt > 0u ? cnt : 1u;
}
__device__ __forceinline__ void xcd_barrier(const XcdBarrier& b) {
    asm volatile("s_waitcnt vmcnt(0)" ::: "memory");
    __syncthreads();
    if (threadIdx.x == 0) {
        unsigned* bar = b.bar;
        __builtin_amdgcn_s_waitcnt(0);
        unsigned nloc = b.st[0], nx = b.st[1];
        if (nloc == 0u) { xcd_barrier_complete(bar, b.x, nloc, nx); b.st[0] = nloc; b.st[1] = nx; }
        const unsigned old = xb_add(&bar[XB_XSUB(b.x)], 1u);
        const unsigned gen = old / nloc;
        if (old + 1u == (gen + 1u) * nloc) {
            __builtin_amdgcn_fence(__ATOMIC_RELEASE, "agent");
            asm volatile("s_waitcnt vmcnt(0)" ::: "memory");
            const unsigned og = xb_add(&bar[XB_TOP], 1u);
            const unsigned tg = og / nx;
            if (og + 1u == (tg + 1u) * nx) xb_add(&bar[XB_TOPGEN], 1u);
            else XB_SPIN(xb_ld(&bar[XB_TOPGEN]) == tg, bar);
            __builtin_amdgcn_fence(__ATOMIC_ACQUIRE, "agent");
            xb_add(&bar[XB_XGEN(b.x)], 1u);
            asm volatile("s_waitcnt vmcnt(0)" ::: "memory");
        } else {
            XB_SPIN(xb_ld(&bar[XB_XGEN(b.x)]) == gen, bar);
            __builtin_amdgcn_fence(__ATOMIC_ACQUIRE, "agent");
            asm volatile("s_waitcnt vmcnt(0)" ::: "memory");
        }
    }
    __syncthreads();
}

constexpr int NWAVES = 8, NTHR = 512;
constexpr int LDS_BYTES = 147456;
constexpr int MISC_OFF = 131072;
constexpr int PTAB_OFF = MISC_OFF + 512;

struct Args { const float* in[28]; float* out; unsigned char* ws; int ph_lo, ph_hi; };

struct Frame {
    LAS unsigned char* lds; int tid, lane, wave, G, c;
    const float* const* in; float* out; unsigned char* ws;
};
#define INP_(i) (F.in[i])
#define FRESH_TID(F) do { int _t = threadIdx.x; asm volatile("" : "+v"(_t)); (F).tid = _t; (F).lane = _t & 63; \
    unsigned char* _w = args.ws; float* _o = args.out; asm volatile("" : "+s"(_w), "+s"(_o)); (F).ws = _w; (F).out = _o; } while (0)
enum { I_X = 0, I_ANG, I_WIN, I_CDW, I_CDB, I_CLG, I_CLB, I_QG, I_KG, I_PK, I_PV, I_KW1, I_KB1, I_KW2, I_KB2, I_VW1, I_VB1, I_VW2, I_VB2, I_WOUT, I_FNG, I_DW1, I_DW3, I_DW2, I_RW, I_MW1, I_MW3, I_MW2 };

struct EpiIn {
    static constexpr bool PERM = true;
    const float* rstd; bf16_t* U; bf16_t* Q; bf16_t* KV; float* GT;
    __device__ __forceinline__ void operator()(const f32x4 (&acc)[2][2][4][2], const Unit& u, int wr, int wc, int fr, int fq) const {
        const int row0 = u.pm * 256 + wr * 64 + fr, cl = wc * 32 + 8 * fq;
        if (u.pn < 4) {
#pragma unroll
            for (int ai = 0; ai < 2; ++ai)
#pragma unroll
                for (int m = 0; m < 4; ++m) { const int r = row0 + ai * 128 + m * 16; const float rs = rstd[r];
                    const f32x4 v0 = acc[ai][0][m][0] * rs, v1 = acc[ai][0][m][1] * rs, g0 = acc[ai][1][m][0] * rs, g1 = acc[ai][1][m][1] * rs;
                    u32x4 w; w.x = cvt_pk_bf16(v0[0] * sigmoidf_(g0[0]), v0[1] * sigmoidf_(g0[1])); w.y = cvt_pk_bf16(v0[2] * sigmoidf_(g0[2]), v0[3] * sigmoidf_(g0[3]));
                    w.z = cvt_pk_bf16(v1[0] * sigmoidf_(g1[0]), v1[1] * sigmoidf_(g1[1])); w.w = cvt_pk_bf16(v1[2] * sigmoidf_(g1[2]), v1[3] * sigmoidf_(g1[3]));
                    *(u32x4*)(U + (size_t)r * CW + u.pn * 128 + cl) = w; }
        } else if (u.pn < 6) {
#pragma unroll
            for (int ai = 0; ai < 2; ++ai)
#pragma unroll
                for (int m = 0; m < 4; ++m) { const int r = row0 + ai * 128 + m * 16; const float rs = rstd[r];
#pragma unroll
                    for (int bj = 0; bj < 2; ++bj) { const f32x4 v0 = acc[ai][bj][m][0] * rs, v1 = acc[ai][bj][m][1] * rs;
                        u32x4 w; w.x = cvt_pk_bf16(v0[0], v0[1]); w.y = cvt_pk_bf16(v0[2], v0[3]); w.z = cvt_pk_bf16(v1[0], v1[1]); w.w = cvt_pk_bf16(v1[2], v1[3]);
                        *(u32x4*)(Q + (size_t)r * 512 + (u.pn - 4) * 256 + bj * 128 + cl) = w; } }
        } else if (u.pn < 9) {
            const int h = wc >> 1, d0 = 32 * (wc & 1) + 8 * fq;
#pragma unroll
            for (int ai = 0; ai < 2; ++ai)
#pragma unroll
                for (int m = 0; m < 4; ++m) { const int r = row0 + ai * 128 + m * 16; const float rs = rstd[r]; const int b = r >> 11, t = r & 2047;
#pragma unroll
                    for (int bj = 0; bj < 2; ++bj) { const int tq = 2 * (u.pn - 6) + bj; const f32x4 v0 = acc[ai][bj][m][0] * rs, v1 = acc[ai][bj][m][1] * rs;
                        u32x4 w; w.x = cvt_pk_bf16(v0[0], v0[1]); w.y = cvt_pk_bf16(v0[2], v0[3]); w.z = cvt_pk_bf16(v1[0], v1[1]); w.w = cvt_pk_bf16(v1[2], v1[3]);
                        *(u32x4*)(KV + (size_t)tq * KVT + ((size_t)(b * 2 + h) * SEQ + t) * DH + d0) = w; } }
        } else {
            if (wc == 0 && fq < 3) {
#pragma unroll
                for (int ai = 0; ai < 2; ++ai)
#pragma unroll
                    for (int m = 0; m < 4; ++m) { const int r = row0 + ai * 128 + m * 16; const float rs = rstd[r];
                        *(f32x4*)(GT + (size_t)r * 24 + 8 * fq) = acc[ai][0][m][0] * rs; *(f32x4*)(GT + (size_t)r * 24 + 8 * fq + 4) = acc[ai][0][m][1] * rs; }
            }
        }
    }
};
struct EpiH1 {
    static constexpr bool PERM = false;
    float* H;
    __device__ __forceinline__ void operator()(const f32x4 (&acc)[2][2][4][2], const Unit& u, int wr, int wc, int fr, int fq) const {
        const int row0 = u.pm * 256 + wr * 64 + fr, col0 = wc * 32 + 4 * fq; const int kv = u.pn >> 3, sp = u.pn & 7;
#pragma unroll
        for (int ai = 0; ai < 2; ++ai)
#pragma unroll
            for (int m = 0; m < 4; ++m) { float* rowp = H + (((size_t)sp * 2 + kv) * 2048 + row0 + ai * 128 + m * 16) * 256 + col0;
#pragma unroll
                for (int bj = 0; bj < 2; ++bj)
#pragma unroll
                    for (int n = 0; n < 2; ++n) *(f32x4*)(rowp + bj * 128 + n * 16) = acc[ai][bj][m][n]; }
    }
};
struct EpiRes {
    static constexpr bool PERM = false;
    const float* base; float* out;
    __device__ __forceinline__ void operator()(const f32x4 (&acc)[2][2][4][2], const Unit& u, int wr, int wc, int fr, int fq) const {
        const int row0 = u.pm * 256 + wr * 64 + fr, col0 = u.pn * 256 + wc * 32 + 4 * fq;
#pragma unroll
        for (int ai = 0; ai < 2; ++ai)
#pragma unroll
            for (int m = 0; m < 4; ++m) { const size_t off = (size_t)(row0 + ai * 128 + m * 16) * D + col0;
#pragma unroll
                for (int bj = 0; bj < 2; ++bj)
#pragma unroll
                    for (int n = 0; n < 2; ++n) { const f32x4 bs = *(const f32x4*)(base + off + bj * 128 + n * 16); *(f32x4*)(out + off + bj * 128 + n * 16) = bs + acc[ai][bj][m][n]; } }
    }
};
struct EpiGlu {
    static constexpr bool PERM = true;
    const float* rstd; bf16_t* O; int ldo; int rowbase;
    __device__ __forceinline__ void operator()(const f32x4 (&acc)[2][2][4][2], const Unit& u, int wr, int wc, int fr, int fq) const {
        const int row0 = u.pm * 256 + wr * 64 + fr, cl = u.pn * 128 + wc * 32 + 8 * fq;
#pragma unroll
        for (int ai = 0; ai < 2; ++ai)
#pragma unroll
            for (int m = 0; m < 4; ++m) { const int r = row0 + ai * 128 + m * 16; const float rs = rstd[rowbase + r];
                const f32x4 g0 = acc[ai][0][m][0] * rs, g1 = acc[ai][0][m][1] * rs, u0 = acc[ai][1][m][0] * rs, u1 = acc[ai][1][m][1] * rs;
                u32x4 w; w.x = cvt_pk_bf16(siluf_(g0[0]) * u0[0], siluf_(g0[1]) * u0[1]); w.y = cvt_pk_bf16(siluf_(g0[2]) * u0[2], siluf_(g0[3]) * u0[3]);
                w.z = cvt_pk_bf16(siluf_(g1[0]) * u1[0], siluf_(g1[1]) * u1[1]); w.w = cvt_pk_bf16(siluf_(g1[2]) * u1[2], siluf_(g1[3]) * u1[3]);
                *(u32x4*)(O + (size_t)r * ldo + cl) = w; }
    }
};
struct EpiMoe2 {
    static constexpr bool PERM = true;
    const int* stok; const float* sw; bf16_t* Y0; bf16_t* Y1; int rowbase;
    __device__ __forceinline__ void operator()(const f32x4 (&acc)[2][2][4][2], const Unit& u, int wr, int wc, int fr, int fq) const {
        const int row0 = u.pm * 256 + wr * 64 + fr, cl = u.pn * 256 + wc * 32 + 8 * fq;
#pragma unroll
        for (int ai = 0; ai < 2; ++ai)
#pragma unroll
            for (int m = 0; m < 4; ++m) { const int r = rowbase + row0 + ai * 128 + m * 16; const int tk = stok[r]; const float w = sw[r];
                if (tk >= 0) { bf16_t* dst = ((tk & 1) ? Y1 : Y0) + (size_t)(tk >> 1) * D + cl;
#pragma unroll
                    for (int bj = 0; bj < 2; ++bj) { const f32x4 v0 = acc[ai][bj][m][0] * w, v1 = acc[ai][bj][m][1] * w;
                        u32x4 o; o.x = cvt_pk_bf16(v0[0], v0[1]); o.y = cvt_pk_bf16(v0[2], v0[3]); o.z = cvt_pk_bf16(v1[0], v1[1]); o.w = cvt_pk_bf16(v1[2], v1[3]);
                        *(u32x4*)(dst + bj * 128) = o; } } }
    }
};

struct SchedCmp {
    int G, c, layer;
    __device__ __forceinline__ bool next(int i, Unit& u) const {
        const int L = i * G + c; if (L >= 128) return false;
        const int kv = L >> 6, pm = (L >> 3) & 7, s = L & 7;
        u.pm = pm; u.pn = kv * 8 + s; u.aoff = ((size_t)kv * KVT + (size_t)pm * 256 * 1024 + s * 256) * 2; u.boff = ((size_t)(layer * 2 + kv) * 256 * 2048 + s * 256) * 2; return true;
    }
};
struct SchedMoe1 {
    int G, c, p0, np; const LAS int* ptab;
    __device__ __forceinline__ bool next(int i, Unit& u) const {
        const int L = i * G + c; if (L >= np * 28) return false;
        const int j = L / np, pl = L % np, e = ptab[p0 + pl];
        u.pm = pl; u.pn = j; u.aoff = (size_t)(p0 + pl) * 256 * 1024 * 2; u.boff = ((size_t)e * 7168 + (size_t)j * 256) * 1024 * 2; return true;
    }
};
struct SchedMoe2 {
    int G, c, p0, np; const LAS int* ptab;
    __device__ __forceinline__ bool next(int i, Unit& u) const {
        const int L = i * G + c; if (L >= np * 4) return false;
        const int j = L / np, pl = L % np, e = ptab[p0 + pl];
        u.pm = pl; u.pn = j; u.aoff = (size_t)pl * 256 * DFE * 2; u.boff = ((size_t)e * 1024 + (size_t)j * 256) * DFE * 2; return true;
    }
};

__device__ __forceinline__ void tr_item(const float* W, int ldw, int n0, int nvalid, int k0, bf16_t* WT, size_t drow0, int ldk, const float* gv, LAS float* scr, int lane) {
#pragma unroll 8
    for (int i = 0; i < 32; ++i) { const int kk = 2 * i + (lane >> 5), n = n0 + (lane & 31); float v = (n < nvalid) ? W[(size_t)(k0 + kk) * ldw + n] : 0.f; if (gv) v *= gv[k0 + kk]; scr[kk * 33 + (lane & 31)] = v; }
    LDS_WAIT(); asm volatile("" ::: "memory");
    const int c = lane & 7;
#pragma unroll
    for (int j = 0; j < 4; ++j) { const int n = (lane >> 3) + 8 * j; const LAS float* s = scr + (8 * c) * 33 + n;
        u32x4 o; o.x = cvt_pk_bf16(s[0 * 33], s[1 * 33]); o.y = cvt_pk_bf16(s[2 * 33], s[3 * 33]); o.z = cvt_pk_bf16(s[4 * 33], s[5 * 33]); o.w = cvt_pk_bf16(s[6 * 33], s[7 * 33]);
        *(u32x4*)(WT + (drow0 + n) * (size_t)ldk + k0 + 8 * c) = o; }
    LDS_WAIT(); asm volatile("" ::: "memory");
}
__device__ __forceinline__ void tr_job_item(int r, const float* W, int K, int ldw, int nblk, int nvalid, bf16_t* WT, int ldk, int kind, int h, const float* gv, LAS float* scr, int lane) {
    const int kb = r / nblk, nb = r % nblk, n0 = 32 * nb; size_t drow;
    if (kind == 0) drow = n0;
    else if (kind == 1) drow = 256 * (n0 / 128) + 128 * h + (n0 % 128);
    else { if (n0 < 512) drow = 256 * (n0 / 128) + (n0 % 128); else if (n0 < 1024) { const int cc = n0 - 512; drow = 256 * (cc / 128) + 128 + (cc % 128); } else drow = n0; }
    tr_item(W, ldw, n0, nvalid, 64 * kb, WT, drow, ldk, gv, scr, lane);
}
__device__ __forceinline__ void xprep_row(const float* xrow, bf16_t* orow, float* rstd_out, int lane, f32x4 (&v)[4]) {
    const f32x4* xr = (const f32x4*)xrow + lane; float s = 0.f;
#pragma unroll
    for (int j = 0; j < 4; ++j) { v[j] = xr[64 * j]; s += (v[j].x * v[j].x + v[j].y * v[j].y) + (v[j].z * v[j].z + v[j].w * v[j].w); }
    const float rstd = rsqf_(wave_sum(s) * (1.0f / D) + EPS);
    if (orow) { u32x2* o8 = (u32x2*)orow + lane;
#pragma unroll
        for (int j = 0; j < 4; ++j) { u32x2 w; w.x = cvt_pk_bf16(v[j].x, v[j].y); w.y = cvt_pk_bf16(v[j].z, v[j].w); o8[64 * j] = w; } }
    if (lane == 0) *rstd_out = rstd;
}

__device__ __forceinline__ void phase_prologue(Frame& F) {
    LAS float* scr = (LAS float*)(F.lds + F.wave * 16384);
    const int gw = F.c * NWAVES + F.wave, NGW = F.G * NWAVES;
    bf16_t* WIN = (bf16_t*)(F.ws + WS_WIN); bf16_t* WC1 = (bf16_t*)(F.ws + WS_WC1); bf16_t* WOUT = (bf16_t*)(F.ws + WS_WOUT); bf16_t* WF1 = (bf16_t*)(F.ws + WS_WF1);
    bf16_t* WF2 = (bf16_t*)(F.ws + WS_WF2); bf16_t* WM1 = (bf16_t*)(F.ws + WS_WM1); bf16_t* WM2 = (bf16_t*)(F.ws + WS_WM2);
    constexpr int I_IN = 16 * 80, I_C1 = 32 * 8, I_OUT = 16 * 32, I_F1 = 16 * 88, I_F2 = 44 * 32, I_M1 = 16 * 112, I_M2 = 56 * 32;
    constexpr int NITEMS = 2 * I_IN + 4 * I_C1 + 2 * I_OUT + 2 * I_F1 + I_F2 + 16 * I_M1 + 8 * I_M2;
    for (int it = gw; it < NITEMS; it += NGW) {
        int r = it;
        if (r < 2 * I_IN) { const int l = r / I_IN; tr_job_item(r % I_IN, INP_(I_WIN) + (size_t)l * D * INW, D, INW, 80, INW, WIN + (size_t)l * INP * D, D, 2, 0, INP_(I_ANG) + l * D, scr, F.lane); continue; } r -= 2 * I_IN;
        if (r < 4 * I_C1) { const int q = r / I_C1, l = q >> 1, kv = q & 1; tr_job_item(r % I_C1, (kv ? INP_(I_VW1) : INP_(I_KW1)) + (size_t)l * 2048 * 256, 2048, 256, 8, 256, WC1 + (size_t)(l * 2 + kv) * 256 * 2048, 2048, 0, 0, nullptr, scr, F.lane); continue; } r -= 4 * I_C1;
        if (r < 2 * I_OUT) { const int l = r / I_OUT; tr_job_item(r % I_OUT, INP_(I_WOUT) + (size_t)l * D * D, D, D, 32, D, WOUT + (size_t)l * D * D, D, 0, 0, nullptr, scr, F.lane); continue; } r -= 2 * I_OUT;
        if (r < 2 * I_F1) { const int h = r / I_F1; tr_job_item(r % I_F1, (h ? INP_(I_DW3) : INP_(I_DW1)), D, DFF, 88, DFF, WF1, D, 1, h, INP_(I_FNG), scr, F.lane); continue; } r -= 2 * I_F1;
        if (r < I_F2) { tr_job_item(r, INP_(I_DW2), DFF, D, 32, D, WF2, DFF, 0, 0, nullptr, scr, F.lane); continue; } r -= I_F2;
        if (r < 16 * I_M1) { const int q = r / I_M1, e = q >> 1, h = q & 1; tr_job_item(r % I_M1, (h ? INP_(I_MW3) : INP_(I_MW1)) + (size_t)e * D * DFE, D, DFE, 112, DFE, WM1 + (size_t)e * 7168 * D, D, 1, h, INP_(I_FNG) + D, scr, F.lane); continue; } r -= 16 * I_M1;
        { const int e = r / I_M2; tr_job_item(r % I_M2, INP_(I_MW2) + (size_t)e * DFE * D, DFE, D, 32, D, WM2 + (size_t)e * D * DFE, DFE, 0, 0, nullptr, scr, F.lane); }
    }
    { float* RT = (float*)(F.ws + WS_RT); const int gt = F.c * NTHR + F.tid; if (gt < 8192) { const int e = gt >> 10, k = gt & 1023; RT[gt] = INP_(I_RW)[k * 8 + e] * INP_(I_FNG)[D + k]; } }
    { float* B1P = (float*)(F.ws + WS_CTL) + CW_B1P;
      for (int it = gw; it < 128; it += NGW) { const int kc = it & 7, jb = (it >> 3) & 3, kv = (it >> 5) & 1, l = it >> 6; const int j = jb * 64 + F.lane;
          const float* w1 = (kv ? INP_(I_VW1) : INP_(I_KW1)) + (size_t)l * 2048 * 256; const float* pos = (kv ? INP_(I_PV) : INP_(I_PK)) + l * 2048;
          float s = (kc == 0) ? (kv ? INP_(I_VB1) : INP_(I_KB1))[l * 256 + j] : 0.f;
          for (int k = kc * 256; k < kc * 256 + 256; ++k) s += pos[k] * w1[(size_t)k * 256 + j];
          B1P[kc * 1024 + (l * 2 + kv) * 256 + j] = s; } }
    { bf16_t* XB = (bf16_t*)(F.ws + WS_XB); float* RS = (float*)(F.ws + WS_RSTD); f32x4 v[4];
      for (int m = gw; m < M; m += NGW) xprep_row(INP_(I_X) + (size_t)m * D, XB + (size_t)m * D, RS + m, F.lane, v); }
}

__device__ __forceinline__ void norm_rows64(bf16_t* buf, int nrows, const float* g, float scale, int gw, int NGW, int lane) {
    const int sub = lane & 7; float gv[8];
#pragma unroll
    for (int j = 0; j < 8; ++j) gv[j] = g[sub * 8 + j] * scale;
    for (int it = gw; it < nrows / 8; it += NGW) { u32x4* p = (u32x4*)(buf + ((size_t)it * 8 + (lane >> 3)) * 64) + sub; const u32x4 v = *p;
        float f[8] = {bf_lo(v.x), bf_hi(v.x), bf_lo(v.y), bf_hi(v.y), bf_lo(v.z), bf_hi(v.z), bf_lo(v.w), bf_hi(v.w)}; float s = 0.f;
#pragma unroll
        for (int j = 0; j < 8; ++j) s += f[j] * f[j];
        s += __shfl_xor(s, 1); s += __shfl_xor(s, 2); s += __shfl_xor(s, 4);
        const float rs = rsqf_(s * (1.0f / 64.0f) + EPS);
        u32x4 o; o.x = cvt_pk_bf16(f[0] * rs * gv[0], f[1] * rs * gv[1]); o.y = cvt_pk_bf16(f[2] * rs * gv[2], f[3] * rs * gv[3]); o.z = cvt_pk_bf16(f[4] * rs * gv[4], f[5] * rs * gv[5]); o.w = cvt_pk_bf16(f[6] * rs * gv[6], f[7] * rs * gv[7]);
        *p = o; }
}
__device__ __forceinline__ void conv_unit(Frame& F, int layer, int cu) {
    const int b = cu >> 6, t0 = (cu & 63) * 32; int tid = F.tid; asm volatile("" : "+v"(tid));
    const bf16_t* U = (const bf16_t*)(F.ws + WS_U); bf16_t* MIX = (bf16_t*)(F.ws + WS_MIX);
    LAS u32x4* L4 = (LAS u32x4*)F.lds;
    for (int i = tid; i < 62 * 64; i += NTHR) { const int row = i >> 6, ch = i & 63, t = t0 - 30 + row; u32x4 v = (u32x4){0u, 0u, 0u, 0u}; if (t >= 0) v = *(const u32x4*)(U + (size_t)(b * SEQ + t) * CW + ch * 8); L4[i] = v; }
    __syncthreads();
    const int cp = tid & 255, th = tid >> 8; const LAS unsigned* LW = (const LAS unsigned*)F.lds;
    float w0[CKW], w1[CKW];
#pragma unroll
    for (int k = 0; k < CKW; ++k) { const f32x2 w = *(const f32x2*)(INP_(I_CDW) + (size_t)layer * CKW * CW + k * CW + 2 * cp); w0[k] = w.x; w1[k] = w.y; }
    const f32x2 cb = *(const f32x2*)(INP_(I_CDB) + layer * CW + 2 * cp), lg = *(const f32x2*)(INP_(I_CLG) + layer * CW + 2 * cp), lb = *(const f32x2*)(INP_(I_CLB) + layer * CW + 2 * cp);
#pragma nounroll
    for (int tl = th * 16; tl < th * 16 + 16; ++tl) {
        float y0 = cb.x, y1 = cb.y;
#pragma unroll
        for (int k = 0; k < CKW; ++k) { const unsigned v = LW[(tl + k) * 256 + cp]; y0 += w0[k] * bf_lo(v); y1 += w1[k] * bf_hi(v); }
        float s = y0 + y1;
#pragma unroll
        for (int o = 1; o < 32; o <<= 1) s += __shfl_xor(s, o);
        const float mu = s * (1.0f / 64.0f), d0 = y0 - mu, d1 = y1 - mu; float q = d0 * d0 + d1 * d1;
#pragma unroll
        for (int o = 1; o < 32; o <<= 1) q += __shfl_xor(q, o);
        const float rs = rsqf_(q * (1.0f / 64.0f) + EPS);
        const float a0 = d0 * rs * lg.x + lb.x, a1 = d1 * rs * lg.y + lb.y;
        *(unsigned*)(MIX + (size_t)(b * SEQ + t0 + tl) * D + 2 * cp) = cvt_pk_bf16(siluf_(a0), siluf_(a1));
    }
    __syncthreads();
}
__device__ __forceinline__ void vtrans_items(Frame& F) {
    const int gw = F.c * NWAVES + F.wave, NGW = F.G * NWAVES, lane = F.lane;
    LAS unsigned char* scr = F.lds + F.wave * 9216;
    for (int it = gw; it < 1024; it += NGW) { const int ten = it >> 9, bh = (it >> 5) & 15, kb = it & 31;
        const bf16_t* V = (const bf16_t*)(F.ws + WS_KV) + (size_t)(ten ? 5 : 3) * KVT + ((size_t)bh * SEQ + kb * 64) * 64; bf16_t* VT = (bf16_t*)(F.ws + (ten ? WS_VWT : WS_VST)) + (size_t)bh * 64 * SEQ + kb * 64;
#pragma unroll
        for (int c = 0; c < 8; ++c) *(LAS u32x4*)(scr + lane * 144 + c * 16) = *((const u32x4*)(V + (size_t)lane * 64) + c);
        LDS_WAIT(); __builtin_amdgcn_wave_barrier(); asm volatile("" ::: "memory");
#pragma unroll
        for (int c = 0; c < 8; ++c) { unsigned w[4];
#pragma unroll
            for (int q = 0; q < 4; ++q) { const int v0 = 8 * c + 2 * q, k0 = swap23(v0), k1 = swap23(v0 + 1);
                w[q] = (unsigned)*(const LAS bf16_t*)(scr + k0 * 144 + lane * 2) | ((unsigned)*(const LAS bf16_t*)(scr + k1 * 144 + lane * 2) << 16); }
            *((u32x4*)(VT + (size_t)lane * SEQ) + c) = (u32x4){w[0], w[1], w[2], w[3]}; }
        LDS_WAIT(); __builtin_amdgcn_wave_barrier(); asm volatile("" ::: "memory");
    }
}
__device__ __forceinline__ void phase_cmp2(Frame& F, int layer) {
    const int gw = F.c * NWAVES + F.wave, NGW = F.G * NWAVES, lane = F.lane;
    const float* H1 = (const float*)(F.ws + WS_H1); const float* B1P = (const float*)(F.ws + WS_CTL) + CW_B1P + layer * 512;
    for (int it = gw; it < 4096; it += NGW) { const int kv = it >> 11, R = it & 2047;
        if ((R & 127) == 127) {
            if (kv == 0) ((bf16_t*)(F.ws + WS_KC))[(size_t)R * 64 + lane] = 0; else { ((bf16_t*)(F.ws + WS_VC))[(size_t)R * 64 + lane] = 0; ((bf16_t*)(F.ws + WS_VCT))[((size_t)(R >> 7) * 64 + lane) * 128 + 127] = 0; }
            continue; }
        const float* Hrow = H1 + ((size_t)kv * 2048 + R) * 256; const float* w2 = (kv ? INP_(I_VW2) : INP_(I_KW2)) + (size_t)layer * 256 * 64;
        float hv[4];
#pragma unroll
        for (int q = 0; q < 4; ++q) { float x = 0.f;
#pragma unroll
            for (int sp = 0; sp < 8; ++sp) x += Hrow[(size_t)sp * 2 * 2048 * 256 + lane + 64 * q];
#pragma unroll
            for (int sp = 0; sp < 8; ++sp) x += B1P[sp * 1024 + kv * 256 + lane + 64 * q];
            hv[q] = siluf_(x); }
        float a = (kv ? INP_(I_VB2) : INP_(I_KB2))[layer * 64 + lane];
#pragma unroll
        for (int q = 0; q < 4; ++q)
#pragma unroll 16
            for (int kk = 0; kk < 64; ++kk) a += __shfl(hv[q], kk) * w2[(size_t)(64 * q + kk) * 64 + lane];
        if (kv == 0) { const float ms = wave_sum(a * a) * (1.0f / 64.0f); a = a * (rsqf_(ms + EPS)) * INP_(I_KG)[layer * 192 + lane]; }
        const bf16_t ab = (bf16_t)(cvt_pk_bf16(a, 0.f) & 0xffffu);
        bf16_t* dst = (bf16_t*)(F.ws + (kv ? WS_VC : WS_KC)) + (size_t)R * 64 + lane; *dst = ab;
        if (kv) ((bf16_t*)(F.ws + WS_VCT))[((size_t)(R >> 7) * 64 + lane) * 128 + swap23(R & 127)] = ab;
    }
}

__device__ __forceinline__ void dots4(const bf16_t* krow, const LAS float* qs, float (&s)[4]) {
    s[0] = s[1] = s[2] = s[3] = 0.f;
#pragma nounroll
    for (int c = 0; c < 8; ++c) { const u32x4 v = *((const u32x4*)krow + c);
        const float f[8] = {bf_lo(v.x), bf_hi(v.x), bf_lo(v.y), bf_hi(v.y), bf_lo(v.z), bf_hi(v.z), bf_lo(v.w), bf_hi(v.w)};
#pragma unroll
        for (int h = 0; h < 4; ++h) { const f32x4 q0 = *(const LAS f32x4*)(qs + h * 64 + c * 8), q1 = *(const LAS f32x4*)(qs + h * 64 + c * 8 + 4);
            s[h] += (f[0] * q0.x + f[1] * q0.y) + (f[2] * q0.z + f[3] * q0.w) + (f[4] * q1.x + f[5] * q1.y) + (f[6] * q1.z + f[7] * q1.w); } }
}
__device__ __forceinline__ void softmax_pv(LAS f32x4* sb, const LAS int* kb, int nk, const bf16_t* V, int lane, float (&o)[4]) {
    float m[4] = {-1e30f, -1e30f, -1e30f, -1e30f};
#pragma nounroll
    for (int c = 0; c < nk; ++c) { const f32x4 s = sb[c * 64 + lane]; m[0] = fmaxf(m[0], s.x); m[1] = fmaxf(m[1], s.y); m[2] = fmaxf(m[2], s.z); m[3] = fmaxf(m[3], s.w); }
#pragma unroll
    for (int h = 0; h < 4; ++h) m[h] = wave_max(m[h]);
    float sum[4] = {0.f, 0.f, 0.f, 0.f};
#pragma nounroll
    for (int c = 0; c < nk; ++c) { const f32x4 s = sb[c * 64 + lane]; f32x4 p;
        p.x = s.x > -1e29f ? __expf(s.x - m[0]) : 0.f; p.y = s.y > -1e29f ? __expf(s.y - m[1]) : 0.f; p.z = s.z > -1e29f ? __expf(s.z - m[2]) : 0.f; p.w = s.w > -1e29f ? __expf(s.w - m[3]) : 0.f;
        sum[0] += p.x; sum[1] += p.y; sum[2] += p.z; sum[3] += p.w; sb[c * 64 + lane] = p; }
    float inv[4];
#pragma unroll
    for (int h = 0; h < 4; ++h) inv[h] = rcpf_(fmaxf(wave_sum(sum[h]), 1e-30f));
    LDS_WAIT(); __builtin_amdgcn_wave_barrier(); asm volatile("" ::: "memory");
    o[0] = o[1] = o[2] = o[3] = 0.f;
#pragma nounroll
    for (int c = 0; c < nk; ++c) { const int k0 = kb[c];
#pragma unroll 4
        for (int kk = 0; kk < 64; ++kk) { int key = k0 + kk; key = key < 0 ? 0 : (key > SEQ - 1 ? SEQ - 1 : key);
            const f32x4 p = sb[c * 64 + kk]; const float v = bf2f(V[(size_t)key * 64 + lane]);
            o[0] += p.x * v; o[1] += p.y * v; o[2] += p.z * v; o[3] += p.w * v; } }
#pragma unroll
    for (int h = 0; h < 4; ++h) o[h] *= inv[h];
    __builtin_amdgcn_wave_barrier(); asm volatile("" ::: "memory");
}
__device__ __forceinline__ void phase_attn_ref(Frame& F, int layer) {
    const int lane = F.lane;
    LAS unsigned char* wl = F.lds + F.wave * 12288;
    LAS float* qs = (LAS float*)wl;
    LAS f32x4* pc = (LAS f32x4*)(wl + 1024);
    LAS float* psum = (LAS float*)(wl + 3072);
    LAS int* kbl = (LAS int*)(wl + 3584);
    LAS f32x4* sb = (LAS f32x4*)(wl + 4096);
    const bf16_t* QN = (const bf16_t*)(F.ws + WS_Q); const bf16_t* KVb = (const bf16_t*)(F.ws + WS_KV);
    const bf16_t* KC = (const bf16_t*)(F.ws + WS_KC); const bf16_t* VC = (const bf16_t*)(F.ws + WS_VC);
    const float* GT = (const float*)(F.ws + WS_GT); bf16_t* MIX = (bf16_t*)(F.ws + WS_MIX);
#pragma nounroll
    for (int un = F.c; un < NBH * 64; un += F.G) {
        const int bh = un >> 6, tile = un & 63, b = bh >> 1, kvh = bh & 1;
        const bf16_t* KS = KVb + 2 * KVT + (size_t)bh * SEQ * 64; const bf16_t* VS = KVb + 3 * KVT + (size_t)bh * SEQ * 64;
        const bf16_t* KW = KVb + 4 * KVT + (size_t)bh * SEQ * 64; const bf16_t* VW = KVb + 5 * KVT + (size_t)bh * SEQ * 64;
#pragma nounroll
        for (int ti = 0; ti < 4; ++ti) {
            const int t = tile * 32 + F.wave * 4 + ti, r = b * SEQ + t;
#pragma unroll
            for (int h = 0; h < 4; ++h) qs[h * 64 + lane] = bf2f(QN[(size_t)r * 512 + (kvh * 4 + h) * 64 + lane]);
            LDS_WAIT(); __builtin_amdgcn_wave_barrier(); asm volatile("" ::: "memory");
            float sc[2][4]; bool vc[2];
#pragma unroll
            for (int u = 0; u < 2; ++u) { const int c = lane + 64 * u; vc[u] = (c < NCMP) && (16 * c + 31 <= t);
                if (vc[u]) dots4(KC + ((size_t)bh * 128 + c) * 64, qs, sc[u]); else { sc[u][0] = sc[u][1] = sc[u][2] = sc[u][3] = -1e30f; } }
            float pr[2][4];
#pragma unroll
            for (int h = 0; h < 4; ++h) { const float mx = wave_max(fmaxf(sc[0][h], sc[1][h]));
                pr[0][h] = vc[0] ? __expf(sc[0][h] - mx) : 0.f; pr[1][h] = vc[1] ? __expf(sc[1][h] - mx) : 0.f;
                const float inv = rcpf_(fmaxf(wave_sum(pr[0][h] + pr[1][h]), 1e-30f)); pr[0][h] *= inv; pr[1][h] *= inv; }
#pragma unroll
            for (int u = 0; u < 2; ++u) { pc[lane + 64 * u] = (f32x4){pr[u][0], pr[u][1], pr[u][2], pr[u][3]}; psum[lane + 64 * u] = (pr[u][0] + pr[u][1]) + (pr[u][2] + pr[u][3]); }
            LDS_WAIT(); __builtin_amdgcn_wave_barrier(); asm volatile("" ::: "memory");
            const int j = lane & 31, cur = t >> 6; float imp = 0.f;
#pragma unroll
            for (int cc = -1; cc <= 3; ++cc) { const int c = 4 * j + cc; if (c >= 0 && c < NCMP) imp += psum[c]; }
            const bool causal = (j * 64 <= t), forced = (j == 0) || (j == cur) || (j == cur - 1);
            const float score = causal ? (forced ? imp + 1e4f : imp) : -1e30f;
            int rank = 0;
#pragma unroll
            for (int i = 0; i < 32; ++i) { const float si = __shfl(score, i); rank += (si > score || (si == score && i < j)) ? 1 : 0; }
            const unsigned selmask = (unsigned)__ballot(lane < 32 && rank < 8 && causal);
            float ocmp[4] = {0.f, 0.f, 0.f, 0.f};
            { const int nvc = t >= 31 ? (((t - 31) >> 4) + 1 > NCMP ? NCMP : ((t - 31) >> 4) + 1) : 0;
#pragma unroll 4
              for (int c = 0; c < nvc; ++c) { const f32x4 p = pc[c]; const float v = bf2f(VC[((size_t)bh * 128 + c) * 64 + lane]); ocmp[0] += p.x * v; ocmp[1] += p.y * v; ocmp[2] += p.z * v; ocmp[3] += p.w * v; } }
            __builtin_amdgcn_wave_barrier(); asm volatile("" ::: "memory");
            int nk = 0; float osel[4], owin[4];
#pragma nounroll
            for (unsigned mm = selmask; mm != 0u && nk < 8; mm &= mm - 1u) { const int jj = __builtin_ctz(mm);
                const int key = jj * 64 + lane; float s[4];
                if (key <= t) dots4(KS + (size_t)key * 64, qs, s); else { s[0] = s[1] = s[2] = s[3] = -1e30f; }
                sb[nk * 64 + lane] = (f32x4){s[0], s[1], s[2], s[3]};
                if (lane == 0) kbl[nk] = jj * 64;
                ++nk; }
            LDS_WAIT(); __builtin_amdgcn_wave_barrier(); asm volatile("" ::: "memory");
            softmax_pv(sb, kbl, nk, VS, lane, osel);
            nk = 0;
#pragma nounroll
            for (int ch = 0; ch < 8; ++ch) { const int k0 = t - 511 + 64 * ch; if (k0 + 63 < 0) continue;
                const int key = k0 + lane; float s[4];
                if (key >= 0) dots4(KW + (size_t)key * 64, qs, s); else { s[0] = s[1] = s[2] = s[3] = -1e30f; }
                sb[nk * 64 + lane] = (f32x4){s[0], s[1], s[2], s[3]};
                if (lane == 0) kbl[nk] = k0;
                ++nk; }
            LDS_WAIT(); __builtin_amdgcn_wave_barrier(); asm volatile("" ::: "memory");
            softmax_pv(sb, kbl, nk, VW, lane, owin);
#pragma unroll
            for (int h = 0; h < 4; ++h) { const float* gp = GT + (size_t)r * 24 + (kvh * 4 + h) * 3;
                const float o = sigmoidf_(gp[0]) * ocmp[h] + sigmoidf_(gp[1]) * osel[h] + sigmoidf_(gp[2]) * owin[h];
                MIX[(size_t)r * D + 512 + (kvh * 4 + h) * 64 + lane] = (bf16_t)(cvt_pk_bf16(o, 0.f) & 0xffffu); }
            __builtin_amdgcn_wave_barrier(); asm volatile("" ::: "memory");
        }
    }
}


constexpr int AT_KB = 0, AT_VB = 18432, AT_WUN = 36864, AT_OT = 40960;
__device__ __forceinline__ int crow_(int i) { return (i & 3) + 8 * (i >> 2); }
__device__ __forceinline__ void attn_tile(const LAS unsigned char* KB, const LAS unsigned char* VB, const bf16x8 (&Qf)[4], f32x16 (&O)[2], float& m, float& l, int tl, bool lowchk, int n, int h) {
    f32x16 S0, S1;
#pragma unroll
    for (int i = 0; i < 16; ++i) { S0[i] = 0.f; S1[i] = 0.f; }
#pragma unroll
    for (int s = 0; s < 4; ++s) { const bf16x8 k0 = *(const LAS bf16x8*)(KB + n * 144 + (16 * s + 8 * h) * 2), k1 = *(const LAS bf16x8*)(KB + (32 + n) * 144 + (16 * s + 8 * h) * 2);
        S0 = MFMA32(k0, Qf[s], S0); S1 = MFMA32(k1, Qf[s], S1); }
    const int lo = lowchk ? tl - 512 : -100000;
    float mx = -1e30f;
#pragma unroll
    for (int i = 0; i < 16; ++i) { const int c0 = crow_(i), c1 = 32 + crow_(i);
        S0[i] = (c0 <= tl && c0 > lo) ? S0[i] : -1e30f; S1[i] = (c1 <= tl && c1 > lo) ? S1[i] : -1e30f; mx = fmaxf(mx, fmaxf(S0[i], S1[i])); }
    mx = fmaxf(mx, __shfl_xor(mx, 32));
    const float mn = fmaxf(m, mx), alpha = __expf(m - mn); m = mn;
    float ls = 0.f;
#pragma unroll
    for (int i = 0; i < 16; ++i) { const float p0 = S0[i] > -1e29f ? __expf(S0[i] - mn) : 0.f, p1 = S1[i] > -1e29f ? __expf(S1[i] - mn) : 0.f; S0[i] = p0; S1[i] = p1; ls += p0 + p1; }
    l = l * alpha + ls;
#pragma unroll
    for (int i = 0; i < 16; ++i) { O[0][i] *= alpha; O[1][i] *= alpha; }
    const bf16x8 P00 = pack8<0>(S0), P01 = pack8<8>(S0), P10 = pack8<0>(S1), P11 = pack8<8>(S1);
    __builtin_amdgcn_sched_barrier(0);
#pragma unroll
    for (int d = 0; d < 2; ++d) { const LAS unsigned char* vb = VB + (32 * d + n) * 144 + 8 * h * 2;
        O[d] = MFMA32(*(const LAS bf16x8*)(vb + 0), P00, O[d]); O[d] = MFMA32(*(const LAS bf16x8*)(vb + 32), P01, O[d]);
        O[d] = MFMA32(*(const LAS bf16x8*)(vb + 64), P10, O[d]); O[d] = MFMA32(*(const LAS bf16x8*)(vb + 96), P11, O[d]); }
}
__device__ __forceinline__ void attn_stage64(LAS unsigned char* lds, const bf16_t* K, const bf16_t* VT, int tid) {
    const int row = tid >> 3, ch = tid & 7;
    const u32x4 kv = *((const u32x4*)K + tid), vv = *(const u32x4*)(VT + (size_t)row * SEQ + ch * 8);
    *(LAS u32x4*)(lds + AT_KB + row * 144 + ch * 16) = kv; *(LAS u32x4*)(lds + AT_VB + row * 144 + ch * 16) = vv;
}
__device__ __forceinline__ void phase_attn_mfma(Frame& F, int layer) {
    const int lane = F.lane, tid = F.tid, n = lane & 31, h = lane >> 5, w = F.wave;
    LAS unsigned char* lds = F.lds; const LAS unsigned char* KB = lds + AT_KB; const LAS unsigned char* VB = lds + AT_VB; volatile LAS unsigned* WUN = (volatile LAS unsigned*)(lds + AT_WUN);
    const bf16_t* QN = (const bf16_t*)(F.ws + WS_Q); const bf16_t* KVb = (const bf16_t*)(F.ws + WS_KV);
    const bf16_t* KC = (const bf16_t*)(F.ws + WS_KC); const bf16_t* VCT = (const bf16_t*)(F.ws + WS_VCT);
    const bf16_t* VST = (const bf16_t*)(F.ws + WS_VST); const bf16_t* VWT = (const bf16_t*)(F.ws + WS_VWT);
    const float* GT = (const float*)(F.ws + WS_GT); bf16_t* MIX = (bf16_t*)(F.ws + WS_MIX);
#pragma nounroll
    for (int ui = 0; ui < 2; ++ui) {
        const int bh = (F.c >> 5) + 8 * ui, tb = ui ? 31 - (F.c & 31) : (F.c & 31);
        if (F.c >= 256) break;
        const int b = bh >> 1, kvh = bh & 1, t0 = tb * 64, cur = tb;
        const int tt = t0 + 8 * w + (n >> 2), hd = n & 3; const size_t r = (size_t)b * SEQ + tt;
        bf16x8 Qf[4]; { const bf16_t* qp = QN + r * 512 + (kvh * 4 + hd) * 64 + 8 * h;
#pragma unroll
            for (int s = 0; s < 4; ++s) Qf[s] = *(const bf16x8*)(qp + 16 * s); }
        const float* gp = GT + r * 24 + (kvh * 4 + hd) * 3; const float g0 = sigmoidf_(gp[0]), g1 = sigmoidf_(gp[1]), g2 = sigmoidf_(gp[2]);
        f32x16 Ob[2]; LAS f32x4* OT = (LAS f32x4*)(lds + AT_OT + w * 8192) + lane;
        unsigned tokmask, wmask;
        __syncthreads();
#pragma unroll
        for (int q = 0; q < 2; ++q) { const int i = tid + 512 * q;
            *(LAS u32x4*)(lds + AT_KB + (i >> 3) * 144 + (i & 7) * 16) = *((const u32x4*)(KC + (size_t)bh * 128 * 64) + i);
            *(LAS u32x4*)(lds + AT_VB + (i >> 4) * 272 + (i & 15) * 16) = *((const u32x4*)(VCT + (size_t)bh * 64 * 128) + i); }
        __syncthreads();
        {
            f32x16 S[4];
#pragma unroll
            for (int ta = 0; ta < 4; ++ta) {
#pragma unroll
                for (int i = 0; i < 16; ++i) S[ta][i] = 0.f;
#pragma unroll
                for (int s = 0; s < 4; ++s) S[ta] = MFMA32(*(const LAS bf16x8*)(KB + (32 * ta + n) * 144 + (16 * s + 8 * h) * 2), Qf[s], S[ta]); }
            const int cmax = tt >= 31 ? (((tt - 31) >> 4) > 126 ? 126 : ((tt - 31) >> 4)) : -1, lim = cmax - 4 * h;
            float mx = -1e30f;
#pragma unroll
            for (int ta = 0; ta < 4; ++ta)
#pragma unroll
                for (int i = 0; i < 16; ++i) { S[ta][i] = (32 * ta + crow_(i) <= lim) ? S[ta][i] : -1e30f; mx = fmaxf(mx, S[ta][i]); }
            mx = fmaxf(mx, __shfl_xor(mx, 32));
            float ls = 0.f;
#pragma unroll
            for (int ta = 0; ta < 4; ++ta)
#pragma unroll
                for (int i = 0; i < 16; ++i) { const float p = S[ta][i] > -1e29f ? __expf(S[ta][i] - mx) : 0.f; S[ta][i] = p; ls += p; }
            ls += __shfl_xor(ls, 32);
            const float inv = rcpf_(fmaxf(ls, 1e-30f));
#pragma unroll
            for (int ta = 0; ta < 4; ++ta)
#pragma unroll
                for (int i = 0; i < 16; ++i) S[ta][i] *= inv;
            float sum4[4][4], xs[4][4]; unsigned kk[4][4];
#pragma unroll
            for (int ta = 0; ta < 4; ++ta)
#pragma unroll
                for (int u = 0; u < 4; ++u) { sum4[ta][u] = (S[ta][4 * u] + S[ta][4 * u + 1]) + (S[ta][4 * u + 2] + S[ta][4 * u + 3]); xs[ta][u] = __shfl_xor(S[ta][4 * u + 3], 32); }
            const bf16x8 P0 = pack8<0>(S[0]), P1 = pack8<8>(S[0]), P2 = pack8<0>(S[1]), P3 = pack8<8>(S[1]), P4 = pack8<0>(S[2]), P5 = pack8<8>(S[2]), P6 = pack8<0>(S[3]), P7 = pack8<8>(S[3]);
            __builtin_amdgcn_sched_barrier(0);
#pragma unroll
            for (int ta = 0; ta < 4; ++ta)
#pragma unroll
                for (int u = 0; u < 4; ++u) { const float pv0 = (u > 0) ? xs[ta][u > 0 ? u - 1 : 0] : (ta > 0 ? xs[ta > 0 ? ta - 1 : 0][3] : 0.f);
                    float v = sum4[ta][u] + (h ? xs[ta][u] : pv0); v += __shfl_xor(v, 1); v += __shfl_xor(v, 2);
                    const int G = 8 * ta + 2 * u + h; const bool causal = G <= cur, forced = (G == 0) || (G == cur) || (G == cur - 1);
                    kk[ta][u] = causal ? ((forced ? 0x7f000000u : (__float_as_uint(v) & ~31u)) | (unsigned)(31 - G)) : 0u; }
            __builtin_amdgcn_sched_barrier(0);
#pragma unroll
            for (int d = 0; d < 2; ++d) {
#pragma unroll
                for (int i = 0; i < 16; ++i) Ob[d][i] = 0.f;
                const LAS unsigned char* vb = VB + (32 * d + n) * 272 + 8 * h * 2;
                Ob[d] = MFMA32(*(const LAS bf16x8*)(vb + 0), P0, Ob[d]); Ob[d] = MFMA32(*(const LAS bf16x8*)(vb + 32), P1, Ob[d]);
                Ob[d] = MFMA32(*(const LAS bf16x8*)(vb + 64), P2, Ob[d]); Ob[d] = MFMA32(*(const LAS bf16x8*)(vb + 96), P3, Ob[d]);
                Ob[d] = MFMA32(*(const LAS bf16x8*)(vb + 128), P4, Ob[d]); Ob[d] = MFMA32(*(const LAS bf16x8*)(vb + 160), P5, Ob[d]);
                Ob[d] = MFMA32(*(const LAS bf16x8*)(vb + 192), P6, Ob[d]); Ob[d] = MFMA32(*(const LAS bf16x8*)(vb + 224), P7, Ob[d]);
#pragma unroll
                for (int q = 0; q < 4; ++q) OT[(4 * d + q) * 64] = (f32x4){Ob[d][4 * q] * g0, Ob[d][4 * q + 1] * g0, Ob[d][4 * q + 2] * g0, Ob[d][4 * q + 3] * g0}; }
            __builtin_amdgcn_sched_barrier(0);
            unsigned selbits = 0u;
#pragma unroll
            for (int rd = 0; rd < 8; ++rd) { unsigned mk = 0u;
#pragma unroll
                for (int ta = 0; ta < 4; ++ta)
#pragma unroll
                    for (int u = 0; u < 4; ++u) mk = kk[ta][u] > mk ? kk[ta][u] : mk;
                { const unsigned o = (unsigned)__shfl_xor((int)mk, 32); mk = o > mk ? o : mk; }
#pragma unroll
                for (int ta = 0; ta < 4; ++ta)
#pragma unroll
                    for (int u = 0; u < 4; ++u) { const bool hit = (kk[ta][u] == mk) && (mk != 0u); selbits |= hit ? ((1u << (8 * ta + 2 * u)) << h) : 0u; kk[ta][u] = hit ? 0u : kk[ta][u]; } }
            tokmask = selbits | (unsigned)__shfl_xor((int)selbits, 32);
            unsigned wm = tokmask; wm |= (unsigned)__shfl_xor((int)wm, 4); wm |= (unsigned)__shfl_xor((int)wm, 8); wm |= (unsigned)__shfl_xor((int)wm, 16);
            wmask = (unsigned)__builtin_amdgcn_readfirstlane((int)wm);
            if (lane == 0) WUN[w] = wmask;
        }
        __syncthreads();
        unsigned uall = 0u;
#pragma unroll
        for (int q = 0; q < 8; ++q) uall |= WUN[q];
        uall = (unsigned)__builtin_amdgcn_readfirstlane((int)uall);
        float m = -1e30f, l = 0.f;
#pragma unroll
        for (int d = 0; d < 2; ++d)
#pragma unroll
            for (int i = 0; i < 16; ++i) Ob[d][i] = 0.f;
#pragma nounroll
        for (unsigned mm = uall; mm != 0u; mm &= mm - 1u) { const int j = __builtin_ctz(mm);
            __syncthreads();
            attn_stage64(lds, KVb + 2 * KVT + ((size_t)bh * SEQ + j * 64) * 64, VST + (size_t)bh * 64 * SEQ + j * 64, tid);
            __syncthreads();
            if ((wmask >> j) & 1u) { const int tl = ((tokmask >> j) & 1u) ? (tt - 64 * j - 4 * h) : -1; attn_tile(KB, VB, Qf, Ob, m, l, tl, false, n, h); }
        }
        { const float lt = l + __shfl_xor(l, 32), sc = g1 * rcpf_(fmaxf(lt, 1e-30f));
#pragma unroll
          for (int d = 0; d < 2; ++d)
#pragma unroll
            for (int q = 0; q < 4; ++q) { f32x4 o = OT[(4 * d + q) * 64]; o.x += Ob[d][4 * q] * sc; o.y += Ob[d][4 * q + 1] * sc; o.z += Ob[d][4 * q + 2] * sc; o.w += Ob[d][4 * q + 3] * sc; OT[(4 * d + q) * 64] = o;
                Ob[d][4 * q] = 0.f; Ob[d][4 * q + 1] = 0.f; Ob[d][4 * q + 2] = 0.f; Ob[d][4 * q + 3] = 0.f; } }
        m = -1e30f; l = 0.f;
#pragma nounroll
        for (int j = (cur > 8 ? cur - 8 : 0); j <= cur; ++j) {
            __syncthreads();
            attn_stage64(lds, KVb + 4 * KVT + ((size_t)bh * SEQ + j * 64) * 64, VWT + (size_t)bh * 64 * SEQ + j * 64, tid);
            __syncthreads();
            attn_tile(KB, VB, Qf, Ob, m, l, tt - 64 * j - 4 * h, j == cur - 8, n, h);
        }
        { const float lt = l + __shfl_xor(l, 32), sc = g2 * rcpf_(fmaxf(lt, 1e-30f));
          bf16_t* op = MIX + r * D + 512 + (kvh * 4 + hd) * 64 + 4 * h;
#pragma unroll
          for (int d = 0; d < 2; ++d)
#pragma unroll
            for (int u = 0; u < 4; ++u) { const f32x4 o = OT[(4 * d + u) * 64]; u32x2 ov; ov.x = pk_bf16(o.x + Ob[d][4 * u] * sc, o.y + Ob[d][4 * u + 1] * sc); ov.y = pk_bf16(o.z + Ob[d][4 * u + 2] * sc, o.w + Ob[d][4 * u + 3] * sc);
                *(u32x2*)(op + 32 * d + 8 * u) = ov; } }
    }
}

__device__ __forceinline__ int build_ptab(Frame& F) {
    LAS int* ptab = (LAS int*)(F.lds + PTAB_OFF);
    const unsigned* cnt = (const unsigned*)(F.ws + WS_CTL) + CW_CNT;
    if (F.tid == 0) { int p = 0;
        for (int e = 0; e < NE; ++e) { const int n = (int)((__hip_atomic_load(cnt + 64 * e, __ATOMIC_RELAXED, __HIP_MEMORY_SCOPE_AGENT) + 255u) >> 8); ptab[MAXPAN + 8 + e] = p * 256; for (int i = 0; i < n && p < MAXPAN; ++i) ptab[p++] = e; }
        ptab[MAXPAN] = p; }
    __syncthreads();
    return ptab[MAXPAN];
}

template <unsigned KM> __global__ void __launch_bounds__(NTHR, 2) fwd(Args args) {
    extern __shared__ __attribute__((aligned(16))) unsigned char lds_raw[];
    Frame F; F.lds = (LAS unsigned char*)lds_raw; F.tid = threadIdx.x; F.lane = F.tid & 63; F.wave = __builtin_amdgcn_readfirstlane(F.tid >> 6);
    F.G = gridDim.x; F.c = blockIdx.x; F.in = args.in; F.out = args.out; F.ws = args.ws;
    volatile LAS unsigned* MISC = (volatile LAS unsigned*)(F.lds + MISC_OFF);
    if (F.tid < 64) MISC[F.tid] = 0u;
    __syncthreads();
    unsigned* ctl = (unsigned*)(F.ws + WS_CTL);
#if MK_PER_PHASE
#define SEAM() do {} while (0)
#else
    XcdBarrier bar = xcd_barrier_post(ctl + CW_BAR, MISC);
#define SEAM() xcd_barrier(bar)
#endif
    const int lo = args.ph_lo, hi = args.ph_hi;
#define KON(kind) (((KM) >> (kind)) & 1u)
#define IN(k) (lo <= (k) && (k) < hi)
    const int gw = F.c * NWAVES + F.wave, NGW = F.G * NWAVES;
    bf16_t* XB = (bf16_t*)(F.ws + WS_XB); float* RS = (float*)(F.ws + WS_RSTD);

    if (KON(0) && IN(0)) { FRESH_TID(F); phase_prologue(F); SEAM(); }

    for (int layer = 0; layer < 2; ++layer) {
        const int pb = 1 + 12 * layer;
        if (KON(1) && IN(pb + 0)) { FRESH_TID(F);
            pg8::Gemm g{XB, (const bf16_t*)(F.ws + WS_WIN) + (size_t)layer * INP * D, D, D, D}; pg8::SchedGrid S; S.init(M / 256, INP / 256, F.G, F.c, D, D);
            EpiIn E{RS, (bf16_t*)(F.ws + WS_U), (bf16_t*)(F.ws + WS_Q), (bf16_t*)(F.ws + WS_KV), (float*)(F.ws + WS_GT)};
            pg8::gemm_phase(F.lds, g, S, E); SEAM();
        }
        if (KON(2) && IN(pb + 1)) { FRESH_TID(F);
            { pg8::Gemm g{(const bf16_t*)(F.ws + WS_KV), (const bf16_t*)(F.ws + WS_WC1), 256, 1024, 2048}; SchedCmp S{F.G, F.c, layer};
              EpiH1 E{(float*)(F.ws + WS_H1)}; pg8::gemm_phase(F.lds, g, S, E); }
            if (F.c < 128) conv_unit(F, layer, F.c);
            else {
#pragma nounroll
                for (int q = 0; q < 3; ++q) conv_unit(F, layer, 128 + 3 * (F.c - 128) + q); }
            vtrans_items(F);
            norm_rows64((bf16_t*)(F.ws + WS_Q), M * 8, INP_(I_QG) + layer * 64, 0.125f, gw, NGW, F.lane);
            norm_rows64((bf16_t*)(F.ws + WS_KV) + 2 * KVT, NBH * SEQ, INP_(I_KG) + layer * 192 + 64, 1.0f, gw, NGW, F.lane);
            norm_rows64((bf16_t*)(F.ws + WS_KV) + 4 * KVT, NBH * SEQ, INP_(I_KG) + layer * 192 + 128, 1.0f, gw, NGW, F.lane);
            SEAM();
        }
        if (KON(3) && IN(pb + 2)) { FRESH_TID(F); phase_cmp2(F, layer); SEAM(); }
#ifndef ATTN_REF
        if (KON(4) && IN(pb + 3)) { FRESH_TID(F); phase_attn_mfma(F, layer); SEAM(); }
#else
        if (KON(4) && IN(pb + 3)) { FRESH_TID(F); phase_attn_ref(F, layer); SEAM(); }
#endif
        if (KON(5) && IN(pb + 4)) { FRESH_TID(F);
            pg8::Gemm g{(const bf16_t*)(F.ws + WS_MIX), (const bf16_t*)(F.ws + WS_WOUT) + (size_t)layer * D * D, D, D, D}; pg8::SchedGrid S; S.init(M / 256, D / 256, F.G, F.c, D, D);
            EpiRes E{layer == 0 ? INP_(I_X) : (const float*)F.out, F.out}; pg8::gemm_phase(F.lds, g, S, E); SEAM();
        }
        if (KON(6) && IN(pb + 5)) { FRESH_TID(F);
            f32x4 v[4];
            if (layer == 0) { for (int m = gw; m < M; m += NGW) xprep_row(F.out + (size_t)m * D, XB + (size_t)m * D, RS + m, F.lane, v); }
            else {
                const float* RT = (const float*)(F.ws + WS_RT); unsigned* cnt = ctl + CW_CNT; int* ROUTE = (int*)(F.ws + WS_ROUTE);
                int* stok = (int*)(F.ws + WS_SLOT); for (int i = F.c * NTHR + F.tid; i < MAXSLOT; i += F.G * NTHR) stok[i] = -1;
                for (int m = gw; m < M; m += NGW) {
                    xprep_row(F.out + (size_t)m * D, XB + (size_t)m * D, RS + m, F.lane, v);
                    float lg[8];
#pragma unroll
                    for (int e = 0; e < 8; ++e) { const f32x4* rt = (const f32x4*)(RT + e * D) + F.lane; float s = 0.f;
#pragma unroll
                        for (int j = 0; j < 4; ++j) { const f32x4 w = rt[64 * j]; s += (v[j].x * w.x + v[j].y * w.y) + (v[j].z * w.z + v[j].w * w.w); }
                        lg[e] = wave_sum(s); }
                    if (F.lane == 0) { int e0 = 0; float l0 = lg[0];
#pragma unroll
                        for (int e = 1; e < 8; ++e) if (lg[e] > l0) { l0 = lg[e]; e0 = e; }
                        int e1 = -1; float l1 = -3.0e38f;
#pragma unroll
                        for (int e = 0; e < 8; ++e) if (e != e0 && lg[e] > l1) { l1 = lg[e]; e1 = e; }
                        const float rs = RS[m]; const float p1 = __expf((l1 - l0) * rs), w0 = rcpf_(1.0f + p1), w1 = p1 * w0;
                        const int q0 = (int)atomicAdd(cnt + 64 * e0, 1u), q1 = (int)atomicAdd(cnt + 64 * e1, 1u);
                        int* rp = ROUTE + (size_t)m * 6; rp[0] = e0; rp[1] = q0; rp[2] = e1; rp[3] = q1; rp[4] = __float_as_int(w0); rp[5] = __float_as_int(w1); }
                }
            }
            SEAM();
        }
        if (layer == 0) {
            if (KON(7) && IN(pb + 6)) { FRESH_TID(F);
                pg8::Gemm g{XB, (const bf16_t*)(F.ws + WS_WF1), D, D, D}; pg8::SchedGrid S; S.init(M / 256, 2 * DFF / 256, F.G, F.c, D, D);
                EpiGlu E{RS, (bf16_t*)(F.ws + WS_ACT), DFF, 0}; pg8::gemm_phase(F.lds, g, S, E); SEAM();
            }
            if (KON(8) && IN(pb + 7)) { FRESH_TID(F);
                pg8::Gemm g{(const bf16_t*)(F.ws + WS_ACT), (const bf16_t*)(F.ws + WS_WF2), DFF, DFF, DFF}; pg8::SchedGrid S; S.init(M / 256, D / 256, F.G, F.c, DFF, DFF);
                EpiRes E{(const float*)F.out, F.out}; pg8::gemm_phase(F.lds, g, S, E); SEAM();
            }
            if (KON(9) && IN(pb + 8)) { FRESH_TID(F); f32x4 v[4]; for (int m = gw; m < M; m += NGW) xprep_row(F.out + (size_t)m * D, XB + (size_t)m * D, RS + m, F.lane, v); SEAM(); }
        } else {
            if (KON(10) && IN(pb + 6)) { FRESH_TID(F);
                build_ptab(F); const LAS int* ptab = (const LAS int*)(F.lds + PTAB_OFF);
                const int* ROUTE = (const int*)(F.ws + WS_ROUTE); int* stok = (int*)(F.ws + WS_SLOT); float* sw = (float*)(stok + MAXSLOT); float* srs = sw + MAXSLOT; bf16_t* XS = (bf16_t*)(F.ws + WS_XS);
                for (int m = gw; m < M; m += NGW) { const int* rp = ROUTE + (size_t)m * 6; const u32x4* src = (const u32x4*)(XB + (size_t)m * D) + F.lane; const u32x4 a = src[0], b2 = src[64];
#pragma unroll
                    for (int k = 0; k < 2; ++k) { const int e = rp[2 * k], pos = rp[2 * k + 1], slot = ptab[MAXPAN + 8 + e] + pos; u32x4* dst = (u32x4*)(XS + (size_t)slot * D) + F.lane; dst[0] = a; dst[64] = b2;
                        if (F.lane == 0) { stok[slot] = m * 2 + k; sw[slot] = __int_as_float(rp[4 + k]); srs[slot] = RS[m]; } } }
                SEAM();
            }
            for (int ch = 0; ch < 2; ++ch) {
                if (KON(11) && IN(pb + 7 + 2 * ch)) { FRESH_TID(F);
                    const int npan = build_ptab(F); const int p0 = ch * CHUNKP, np = (npan - p0) < 0 ? 0 : ((npan - p0) > CHUNKP ? CHUNKP : (npan - p0));
                    const int* stok = (const int*)(F.ws + WS_SLOT); const float* srs = (const float*)(stok + 2 * MAXSLOT);
                    pg8::Gemm g{(const bf16_t*)(F.ws + WS_XS), (const bf16_t*)(F.ws + WS_WM1), D, D, D}; SchedMoe1 S{F.G, F.c, p0, np, (const LAS int*)(F.lds + PTAB_OFF)};
                    EpiGlu E{srs, (bf16_t*)(F.ws + WS_ACTM), DFE, 0};
                    E.rstd = srs + (size_t)p0 * 256;
                    pg8::gemm_phase(F.lds, g, S, E); SEAM();
                }
                if (KON(12) && IN(pb + 8 + 2 * ch)) { FRESH_TID(F);
                    const int npan = build_ptab(F); const int p0 = ch * CHUNKP, np = (npan - p0) < 0 ? 0 : ((npan - p0) > CHUNKP ? CHUNKP : (npan - p0));
                    const int* stok = (const int*)(F.ws + WS_SLOT); const float* sw = (const float*)(stok + MAXSLOT);
                    pg8::Gemm g{(const bf16_t*)(F.ws + WS_ACTM), (const bf16_t*)(F.ws + WS_WM2), DFE, DFE, DFE}; SchedMoe2 S{F.G, F.c, p0, np, (const LAS int*)(F.lds + PTAB_OFF)};
                    EpiMoe2 E{stok, sw, (bf16_t*)(F.ws + WS_Y0), (bf16_t*)(F.ws + WS_Y1), p0 * 256}; pg8::gemm_phase(F.lds, g, S, E); SEAM();
                }
            }
            if (KON(13) && IN(pb + 11)) { FRESH_TID(F);
                const bf16_t* Y0 = (const bf16_t*)(F.ws + WS_Y0); const bf16_t* Y1 = (const bf16_t*)(F.ws + WS_Y1);
                for (int m = gw; m < M; m += NGW) { f32x4* xr = (f32x4*)(F.out + (size_t)m * D) + F.lane; const u32x2* y0 = (const u32x2*)(Y0 + (size_t)m * D) + F.lane; const u32x2* y1 = (const u32x2*)(Y1 + (size_t)m * D) + F.lane;
#pragma unroll
                    for (int j = 0; j < 4; ++j) { f32x4 x = xr[64 * j]; const u32x2 a = y0[64 * j], b2 = y1[64 * j];
                        x.x += bf_lo(a.x) + bf_lo(b2.x); x.y += bf_hi(a.x) + bf_hi(b2.x); x.z += bf_lo(a.y) + bf_lo(b2.y); x.w += bf_hi(a.y) + bf_hi(b2.y); xr[64 * j] = x; } }
            }
        }
    }
#undef IN
}

constexpr int NPHASE = 25;
template <unsigned KM> static bool setup_kernel(int& per_cu) {
    if (hipFuncSetAttribute((const void*)fwd<KM>, hipFuncAttributeMaxDynamicSharedMemorySize, LDS_BYTES) != hipSuccess) return false;
    if (hipOccupancyMaxActiveBlocksPerMultiprocessor(&per_cu, (const void*)fwd<KM>, NTHR, LDS_BYTES) != hipSuccess) per_cu = 0;
    (void)hipGetLastError(); return true;
}
template <unsigned KM> static void launch_kind(int grid, const Args& a, hipStream_t stream) { hipLaunchKernelGGL(fwd<KM>, dim3(grid), dim3(NTHR), LDS_BYTES, stream, a); }
extern "C" void kernel_launch(void* const* d_in, const int* in_sizes, int n_in, void* d_out, int out_size, void* d_ws, size_t ws_size, hipStream_t stream) {
    static int grid = 0;
    if (grid == 0) {
        if (n_in != 28 || in_sizes[0] != M * D || out_size != M * D || ws_size < WS_END) { fprintf(stderr, "kernel_launch: unexpected shapes / workspace (n_in %d, ws %zu, need %zu)\n", n_in, ws_size, (size_t)WS_END); grid = -1; return; }
        int dev = 0, cus = 0, per_cu = 0; bool ok = true;
        if (hipGetDevice(&dev) != hipSuccess || hipDeviceGetAttribute(&cus, hipDeviceAttributeMultiprocessorCount, dev) != hipSuccess) { grid = -1; return; }
#if MK_PER_PHASE
        ok = ok && setup_kernel<1u << 0>(per_cu) && setup_kernel<1u << 1>(per_cu) && setup_kernel<1u << 2>(per_cu) && setup_kernel<1u << 3>(per_cu) && setup_kernel<1u << 4>(per_cu) && setup_kernel<1u << 5>(per_cu) && setup_kernel<1u << 6>(per_cu)
             && setup_kernel<1u << 7>(per_cu) && setup_kernel<1u << 8>(per_cu) && setup_kernel<1u << 9>(per_cu) && setup_kernel<1u << 10>(per_cu) && setup_kernel<1u << 11>(per_cu) && setup_kernel<1u << 12>(per_cu) && setup_kernel<1u << 13>(per_cu);
#else
        ok = ok && setup_kernel<0xffffffffu>(per_cu);
#endif
        if (!ok) { fprintf(stderr, "kernel_launch: hipFuncSetAttribute failed\n"); grid = -1; return; }
        if (per_cu < 1) fprintf(stderr, "kernel_launch: occupancy query says %d\n", per_cu);
        grid = cus;
    }
    if (grid < 0) return;
    (void)hipMemsetAsync((char*)d_ws + WS_CTL, 0, CTL_BYTES, stream);
    Args a{};
    for (int i = 0; i < 28; ++i) a.in[i] = (const float*)d_in[i];
    a.out = (float*)d_out; a.ws = (unsigned char*)d_ws;
#if MK_PER_PHASE
    static const int phases[] = {0, 1, 2, 3, 4, 5, 6, 7, 8, 9, 13, 14, 15, 16, 17, 18, 19, 20, 21, 22, 23, 24};
    static const int kinds[]  = {0, 1, 2, 3, 4, 5, 6, 7, 8, 9,  1,  2,  3,  4,  5,  6, 10, 11, 12, 11, 12, 13};
    for (int i = 0; i < (int)(sizeof(phases) / sizeof(int)); ++i) { a.ph_lo = phases[i]; a.ph_hi = phases[i] + 1;
        switch (kinds[i]) {
            case 0: launch_kind<1u << 0>(grid, a, stream); break; case 1: launch_kind<1u << 1>(grid, a, stream); break; case 2: launch_kind<1u << 2>(grid, a, stream); break;
            case 3: launch_kind<1u << 3>(grid, a, stream); break; case 4: launch_kind<1u << 4>(grid, a, stream); break; case 5: launch_kind<1u << 5>(grid, a, stream); break;
            case 6: launch_kind<1u << 6>(grid, a, stream); break; case 7: launch_kind<1u << 7>(grid, a, stream); break; case 8: launch_kind<1u << 8>(grid, a, stream); break;
            case 9: launch_kind<1u << 9>(grid, a, stream); break; case 10: launch_kind<1u << 10>(grid, a, stream); break; case 11: launch_kind<1u << 11>(grid, a, stream); break;
            case 12: launch_kind<1u << 12>(grid, a, stream); break; default: launch_kind<1u << 13>(grid, a, stream); break; } }
#else
    a.ph_lo = 0; a.ph_hi = NPHASE; launch_kind<0xffffffffu>(grid, a, stream);
#endif
}
```

```cpp
#include <hip/hip_runtime.h>
#include <cstdio>
#include <cstdint>

#ifndef MK_PER_PHASE
#define MK_PER_PHASE 0
#endif

#ifndef PROBE_MASK
#define PROBE_MASK 0u
#endif
#define LAS __attribute__((address_space(3)))
typedef unsigned short bf16_t;
typedef short bf16x8 __attribute__((ext_vector_type(8)));
typedef float f32x4 __attribute__((ext_vector_type(4)));
typedef float f32x2 __attribute__((ext_vector_type(2)));
typedef unsigned u32x4 __attribute__((ext_vector_type(4)));
typedef unsigned u32x2 __attribute__((ext_vector_type(2)));

constexpr int D = 1024, NB = 8, SEQ = 2048, M = NB * SEQ;
constexpr int INW = 2328, INP = 2560;
constexpr int CW = 512, CKW = 31, DH = 64, NKV = 2, NBH = NB * NKV;
constexpr int NCMP = 127, CHID = 256;
constexpr int DFF = 2816, NE = 8, DFE = 3584;
constexpr int MAXPAN = 136, MAXSLOT = MAXPAN * 256, CHUNKP = 72;
constexpr float EPS = 1e-6f;

constexpr size_t MiB = 1u << 20;
constexpr size_t WS_CTL = 0, CTL_BYTES = 2 * MiB;
constexpr size_t WS_H1 = 342 * MiB;
constexpr size_t WS_WIN = 12 * MiB;
constexpr size_t WS_WC1 = 22 * MiB;
constexpr size_t WS_WOUT = 26 * MiB;
constexpr size_t WS_WF1 = 30 * MiB;
constexpr size_t WS_WF2 = 41 * MiB;
constexpr size_t WS_RT = 47 * MiB;
constexpr size_t WS_WM1 = 48 * MiB;
constexpr size_t WS_WM2 = 160 * MiB;
constexpr size_t WS_XB = 216 * MiB;
constexpr size_t WS_RSTD = 248 * MiB;
constexpr size_t WS_GT = WS_RSTD + 65536;
constexpr size_t WS_ROUTE = WS_GT + (size_t)M * 24 * 4;
constexpr size_t WS_PSS = 250 * MiB;
constexpr size_t WS_KC = 251 * MiB;
constexpr size_t WS_VC = WS_KC + 262144;
constexpr size_t WS_VCT = WS_KC + 524288;
constexpr size_t WS_VST = 2 * MiB, WS_VWT = 6 * MiB;
constexpr size_t WS_U = 252 * MiB;
constexpr size_t WS_Q = 268 * MiB;
constexpr size_t WS_KV = 284 * MiB;
constexpr size_t KVT = (size_t)NBH * SEQ * DH;
constexpr size_t WS_MIX = 310 * MiB;
constexpr size_t WS_ACT = 342 * MiB;
constexpr size_t WS_XS = 252 * MiB;
constexpr size_t WS_ACTM = 320 * MiB;
constexpr size_t WS_SLOT = 447 * MiB;
constexpr size_t WS_Y0 = WS_XS, WS_Y1 = 12 * MiB;
constexpr size_t WS_END = 448 * MiB;
constexpr int CW_BAR = 4096;
constexpr int CW_CNT = 8192;
constexpr int CW_B1P = 16384;

__device__ __forceinline__ unsigned cvt_pk_bf16(float lo, float hi) { unsigned r; asm volatile("v_cvt_pk_bf16_f32 %0, %1, %2" : "=v"(r) : "v"(lo), "v"(hi)); return r; }
__device__ __forceinline__ float bf_lo(unsigned v) { return __uint_as_float(v << 16); }
__device__ __forceinline__ float bf_hi(unsigned v) { return __uint_as_float(v & 0xffff0000u); }
__device__ __forceinline__ float bf2f(bf16_t v) { return __uint_as_float((unsigned)v << 16); }
__device__ __forceinline__ float rcpf_(float x) { return __builtin_amdgcn_rcpf(x); }
__device__ __forceinline__ float rsqf_(float x) { return __builtin_amdgcn_rsqf(x); }
__device__ __forceinline__ float sigmoidf_(float x) { return rcpf_(1.0f + __expf(-x)); }
__device__ __forceinline__ float siluf_(float x) { return x * sigmoidf_(x); }
__device__ __forceinline__ float wave_sum(float v) {
#pragma unroll
    for (int o = 1; o < 64; o <<= 1) v += __shfl_xor(v, o);
    return v;
}
#define DPP_ADD(v, ctrl) ((v) + __builtin_bit_cast(float, __builtin_amdgcn_update_dpp(0, __builtin_bit_cast(int, (v)), (ctrl), 0xF, 0xF, true)))
__device__ __forceinline__ float wave_sum_u(float v) {
    v = DPP_ADD(v, 0xB1); v = DPP_ADD(v, 0x4E); v = DPP_ADD(v, 0x124); v = DPP_ADD(v, 0x128);
    const int b = __builtin_bit_cast(int, v);
    return (__builtin_bit_cast(float, __builtin_amdgcn_readlane(b, 0)) + __builtin_bit_cast(float, __builtin_amdgcn_readlane(b, 16))) + (__builtin_bit_cast(float, __builtin_amdgcn_readlane(b, 32)) + __builtin_bit_cast(float, __builtin_amdgcn_readlane(b, 48)));
}
__device__ __forceinline__ float wave_max(float v) {
#pragma unroll
    for (int o = 1; o < 64; o <<= 1) v = fmaxf(v, __shfl_xor(v, o));
    return v;
}
#define LDS_WAIT() asm volatile("s_waitcnt lgkmcnt(0)" ::: "memory")
typedef float f32x16 __attribute__((ext_vector_type(16)));
typedef __bf16 bf16v2 __attribute__((ext_vector_type(2)));
#define MFMA32(a, b, c) __builtin_amdgcn_mfma_f32_32x32x16_bf16((a), (b), (c), 0, 0, 0)
__device__ __forceinline__ unsigned pk_bf16(float lo, float hi) { const f32x2 v = {lo, hi}; return __builtin_bit_cast(unsigned, __builtin_convertvector(v, bf16v2)); }
template <int S8> __device__ __forceinline__ bf16x8 pack8(const f32x16& p) { u32x4 w; w.x = pk_bf16(p[S8], p[S8 + 1]); w.y = pk_bf16(p[S8 + 2], p[S8 + 3]); w.z = pk_bf16(p[S8 + 4], p[S8 + 5]); w.w = pk_bf16(p[S8 + 6], p[S8 + 7]); return __builtin_bit_cast(bf16x8, w); }
__device__ __forceinline__ u32x2 pk8_fp8(float a0, float a1, float a2, float a3, float a4, float a5, float a6, float a7) {
    int w0 = 0, w1 = 0; w0 = __builtin_amdgcn_cvt_pk_fp8_f32(a0, a1, w0, false); w0 = __builtin_amdgcn_cvt_pk_fp8_f32(a2, a3, w0, true);
    w1 = __builtin_amdgcn_cvt_pk_fp8_f32(a4, a5, w1, false); w1 = __builtin_amdgcn_cvt_pk_fp8_f32(a6, a7, w1, true); return (u32x2){(unsigned)w0, (unsigned)w1}; }
__device__ __forceinline__ int swap23(int v) { return (v & ~12) | ((v & 4) << 1) | ((v & 8) >> 1); }

namespace pg8 {
constexpr int BM = 256, BK = 64, HALF = 128, HTB = HALF * BK * 2, STAGE_BYTES = 8 * HTB, NXCD = 8, WGM = 8;
__device__ __forceinline__ int lds_byte(int r, int c) { const int st = (r >> 4) * 2 + (c >> 5), rr = r & 15, cc = c & 31, ob = rr * 64 + cc * 2; return st * 1024 + (ob ^ (((ob >> 9) & 1) << 5)); }
__device__ __forceinline__ void stage_rc(int b, int& R, int& C) { const int st = b / 1024, sb = b % 1024, swz = sb ^ (((sb >> 9) & 1) << 5); R = (st >> 1) * 16 + swz / 64; C = (st & 1) * 32 + (swz % 64) / 2; }
__device__ __forceinline__ int perm32(int rho) { const int n = rho >> 4, i = rho & 15; return 8 * (i >> 2) + 4 * n + (i & 3); }

struct Unit { int pm, pn; size_t aoff, boff; };
struct Gemm { const bf16_t* A; const bf16_t* Bt; int K, lda, ldb; };

struct SchedGrid {
    int nM, nN, nwg, G, c; size_t astr, bstr;
    __device__ __forceinline__ void init(int nM_, int nN_, int G_, int c_, int lda, int ldb) { nM = nM_; nN = nN_; nwg = nM * nN; G = G_; c = c_; astr = (size_t)BM * lda * 2; bstr = (size_t)BM * ldb * 2; }
    __device__ __forceinline__ bool next(int i, Unit& u) const {
        const long L = (long)i * G + c; if (L >= nwg) return false;
        int wgid = (int)L; { const int q = nwg / NXCD, r = nwg % NXCD, xcd = wgid % NXCD, off = wgid / NXCD; wgid = (xcd < r ? xcd * (q + 1) : r * (q + 1) + (xcd - r) * q) + off; }
        const int nig = WGM * nN, gid = wgid / nig, fm = gid * WGM, gsz = (nM - fm) < WGM ? (nM - fm) : WGM;
        u.pm = fm + ((wgid % nig) % gsz); u.pn = (wgid % nig) / gsz; u.aoff = (size_t)u.pm * astr; u.boff = (size_t)u.pn * bstr; return true;
    }
};

template <class Epi, class Sched>
__device__ __forceinline__ void gemm_phase(LAS unsigned char* lds, const Gemm g, const Sched& S, const Epi& E) {
    int tid = threadIdx.x; asm volatile("" : "+v"(tid));
    const int wid = __builtin_amdgcn_readfirstlane(tid >> 6), lane = tid & 63, wr = wid >> 2, wc = wid & 3, fr = lane & 15, fq = lane >> 4;
    const int K = g.K, nt = K / BK;
    unsigned voffA[2], voffB[2];
#pragma unroll
    for (int i = 0; i < 2; ++i) { int R, C; stage_rc(tid * 16 + i * 8192, R, C); const int Rb = Epi::PERM ? ((R & ~31) + perm32(R & 31)) : R;
        voffA[i] = (unsigned)(R * g.lda + C) * 2u; voffB[i] = (unsigned)(Rb * g.ldb + C) * 2u; }
    const size_t kstep = (size_t)(BK * 2);
    const size_t hstepA = (size_t)HALF * g.lda * 2, hstepB = (size_t)HALF * g.ldb * 2;
    const unsigned ldsw = (unsigned)wid * 1024u;
    const int aoff = lds_byte(wr * 64 + fr, fq * 8), boff = lds_byte(wc * 32 + fr, fq * 8);
#define PG8_SA(b, h) (((b) * 2 + (h)) * HTB)
#define PG8_SB(b, h) ((4 + (b) * 2 + (h)) * HTB)
#define PG8_STAGE(bufoff, gbase, voff) do { _Pragma("unroll") for (int _i = 0; _i < 2; ++_i) \
        __builtin_amdgcn_global_load_lds((const unsigned*)((const char*)(gbase) + (voff)[_i]), (LAS unsigned*)(lds + (bufoff) + ldsw + _i * 8192), 16, 0, 0); } while (0)
#define PG8_LDA(dst, b, h) do { _Pragma("unroll") for (int m = 0; m < 4; ++m) _Pragma("unroll") for (int k = 0; k < 2; ++k) dst[m][k] = *(const LAS bf16x8*)(lds + PG8_SA(b, h) + aoff + m * 2048 + k * 1024); } while (0)
#define PG8_LDB(dst, b, h) do { _Pragma("unroll") for (int n = 0; n < 2; ++n) _Pragma("unroll") for (int k = 0; k < 2; ++k) dst[n][k] = *(const LAS bf16x8*)(lds + PG8_SB(b, h) + boff + n * 2048 + k * 1024); } while (0)
#define PG8_MMA(ai, bj, At, Bt) do { __builtin_amdgcn_s_setprio(1); _Pragma("unroll") for (int m = 0; m < 4; ++m) _Pragma("unroll") for (int n = 0; n < 2; ++n) _Pragma("unroll") for (int k = 0; k < 2; ++k) \
        acc[ai][bj][m][n] = __builtin_amdgcn_mfma_f32_16x16x32_bf16(Bt[n][k], At[m][k], acc[ai][bj][m][n], 0, 0, 0); __builtin_amdgcn_s_setprio(0); } while (0)
#define PG8_WAIT_V(n) asm volatile("s_waitcnt vmcnt(" #n ")" ::: "memory")
#define PG8_WAIT_L(n) asm volatile("s_waitcnt lgkmcnt(" #n ")" ::: "memory")
#define PG8_BAR __builtin_amdgcn_s_barrier()
#define PG8_SCHED __builtin_amdgcn_sched_barrier(0)
    Unit cur, nxt; int ui = 0;
    if (!S.next(0, cur)) return;
    f32x4 acc[2][2][4][2];
#pragma unroll
    for (int a = 0; a < 2; ++a)
#pragma unroll
        for (int b = 0; b < 2; ++b)
#pragma unroll
            for (int m = 0; m < 4; ++m)
#pragma unroll
                for (int n = 0; n < 2; ++n) acc[a][b][m][n] = (f32x4){0.f, 0.f, 0.f, 0.f};
    bf16x8 At[4][2], B0[2][2], B1[2][2];
    const char* cA = (const char*)g.A + cur.aoff; const char* cB = (const char*)g.Bt + cur.boff;
    typename Epi::Pre pre; E.prefetch(cur, wr, fr, pre);
    PG8_STAGE(PG8_SB(0, 0), cB, voffB); PG8_STAGE(PG8_SA(0, 0), cA, voffA); PG8_STAGE(PG8_SB(0, 1), cB + hstepB, voffB); PG8_STAGE(PG8_SA(0, 1), cA + hstepA, voffA);
    if (wr == 1) PG8_BAR;
    PG8_WAIT_V(4); PG8_BAR;
    PG8_STAGE(PG8_SB(1, 0), cB + kstep, voffB); PG8_STAGE(PG8_SA(1, 0), cA + kstep, voffA); PG8_STAGE(PG8_SB(1, 1), cB + hstepB + kstep, voffB);
    PG8_WAIT_V(6); PG8_BAR;
    for (;;) {
        const bool has_next = S.next(ui + 1, nxt);
        const char* nA = has_next ? (const char*)g.A + nxt.aoff : cA; const char* nB = has_next ? (const char*)g.Bt + nxt.boff : cB;
#pragma nounroll
        for (int t = 0; t < nt; t += 2) {
            const bool last = (t == nt - 2);
            const char* a1 = cA + (size_t)(t + 1) * kstep;
            const char* a2 = last ? nA : cA + (size_t)(t + 2) * kstep; const char* b2 = last ? nB : cB + (size_t)(t + 2) * kstep;
            const char* a3 = a2 + kstep; const char* b3 = b2 + kstep;
            PG8_LDB(B0, 0, 0); PG8_SCHED; PG8_LDA(At, 0, 0); PG8_STAGE(PG8_SA(1, 1), a1 + hstepA, voffA);
            PG8_WAIT_L(8); PG8_BAR; PG8_WAIT_L(0); PG8_MMA(0, 0, At, B0); PG8_BAR; PG8_SCHED;
            PG8_LDB(B1, 0, 1); PG8_STAGE(PG8_SB(0, 0), b2, voffB);
            PG8_BAR; PG8_WAIT_L(0); PG8_MMA(0, 1, At, B1); PG8_BAR;
            PG8_LDA(At, 0, 1); PG8_STAGE(PG8_SA(0, 0), a2, voffA);
            PG8_BAR; PG8_WAIT_L(0); PG8_MMA(1, 0, At, B0); PG8_BAR; PG8_SCHED;
            PG8_STAGE(PG8_SB(0, 1), b2 + hstepB, voffB);
            PG8_WAIT_V(6); PG8_BAR; PG8_MMA(1, 1, At, B1); PG8_BAR;
            PG8_LDB(B0, 1, 0); PG8_SCHED; PG8_LDA(At, 1, 0); PG8_STAGE(PG8_SA(0, 1), a2 + hstepA, voffA);
            PG8_WAIT_L(8); PG8_BAR; PG8_WAIT_L(0); PG8_MMA(0, 0, At, B0); PG8_BAR; PG8_SCHED;
            PG8_LDB(B1, 1, 1); PG8_STAGE(PG8_SB(1, 0), b3, voffB);
            PG8_BAR; PG8_WAIT_L(0); PG8_MMA(0, 1, At, B1); PG8_BAR;
            PG8_LDA(At, 1, 1); PG8_STAGE(PG8_SA(1, 0), a3, voffA);
            PG8_BAR; PG8_WAIT_L(0); PG8_MMA(1, 0, At, B0); PG8_BAR; PG8_SCHED;
            PG8_STAGE(PG8_SB(1, 1), b3 + hstepB, voffB);
            PG8_WAIT_V(6); PG8_BAR; PG8_MMA(1, 1, At, B1); PG8_BAR;
        }
        E(acc, cur, wr, wc, fr, fq, pre);
        if (!has_next) break;
        E.prefetch(nxt, wr, fr, pre);
#pragma unroll
        for (int a = 0; a < 2; ++a)
#pragma unroll
            for (int b = 0; b < 2; ++b)
#pragma unroll
                for (int m = 0; m < 4; ++m)
#pragma unroll
                    for (int n = 0; n < 2; ++n) acc[a][b][m][n] = (f32x4){0.f, 0.f, 0.f, 0.f};
        cur = nxt; cA = nA; cB = nB; ++ui;
    }
    PG8_WAIT_V(0);
    if (wr == 0) PG8_BAR;
    PG8_BAR;
#undef PG8_SA
#undef PG8_SB
#undef PG8_STAGE
#undef PG8_LDA
#undef PG8_LDB
#undef PG8_MMA
#undef PG8_WAIT_V
#undef PG8_WAIT_L
#undef PG8_BAR
#undef PG8_SCHED
}
struct Gemm8 { const unsigned char* A; const unsigned char* Bt; int K, lda, ldb; };
typedef int i32x4 __attribute__((ext_vector_type(4)));
typedef int i32x8 __attribute__((ext_vector_type(8)));
template <class Epi, class Sched>
__device__ __forceinline__ void gemm_phase8(LAS unsigned char* lds, const Gemm8 g, const Sched& S, const Epi& E) {
    int tid = threadIdx.x; asm volatile("" : "+v"(tid));
    const int wid = __builtin_amdgcn_readfirstlane(tid >> 6), lane = tid & 63, wr = wid >> 2, wc = wid & 3, fr = lane & 15, fq = lane >> 4;
    const int nt = g.K / 128;
    unsigned voffA[2], voffB[2];
#pragma unroll
    for (int i = 0; i < 2; ++i) { int R, C; stage_rc(tid * 16 + i * 8192, R, C); const int Rb = Epi::PERM ? ((R & ~31) + perm32(R & 31)) : R;
        voffA[i] = (unsigned)(R * g.lda + C * 2); voffB[i] = (unsigned)(Rb * g.ldb + C * 2); }
    const size_t kstep = (size_t)(BK * 2);
    const size_t hstepA = (size_t)HALF * g.lda, hstepB = (size_t)HALF * g.ldb;
    const unsigned ldsw = (unsigned)wid * 1024u;
    const int aoff = lds_byte(wr * 64 + fr, fq * 8), boff = lds_byte(wc * 32 + fr, fq * 8);
#define PG8_SA(b, h) (((b) * 2 + (h)) * HTB)
#define PG8_SB(b, h) ((4 + (b) * 2 + (h)) * HTB)
#define PG8_STAGE(bufoff, gbase, voff) do { _Pragma("unroll") for (int _i = 0; _i < 2; ++_i) \
        __builtin_amdgcn_global_load_lds((const unsigned*)((const char*)(gbase) + (voff)[_i]), (LAS unsigned*)(lds + (bufoff) + ldsw + _i * 8192), 16, 0, 0); } while (0)
#define PG8_LDA(dst, b, h) do { _Pragma("unroll") for (int m = 0; m < 4; ++m) { const i32x4 _l = *(const LAS i32x4*)(lds + PG8_SA(b, h) + aoff + m * 2048), _h = *(const LAS i32x4*)(lds + PG8_SA(b, h) + aoff + m * 2048 + 1024); dst[m] = __builtin_shufflevector(_l, _h, 0, 1, 2, 3, 4, 5, 6, 7); } } while (0)
#define PG8_LDB(dst, b, h) do { _Pragma("unroll") for (int n = 0; n < 2; ++n) { const i32x4 _l = *(const LAS i32x4*)(lds + PG8_SB(b, h) + boff + n * 2048), _h = *(const LAS i32x4*)(lds + PG8_SB(b, h) + boff + n * 2048 + 1024); dst[n] = __builtin_shufflevector(_l, _h, 0, 1, 2, 3, 4, 5, 6, 7); } } while (0)
#define PG8_MMA(ai, bj, At, Bt) do { __builtin_amdgcn_s_setprio(1); _Pragma("unroll") for (int m = 0; m < 4; ++m) _Pragma("unroll") for (int n = 0; n < 2; ++n) \
        asm volatile("v_mfma_f32_16x16x128_f8f6f4 %0, %1, %2, %0" : "+v"(acc[ai][bj][m][n]) : "v"(Bt[n]), "v"(At[m])); __builtin_amdgcn_s_setprio(0); } while (0)
#define PG8_WAIT_V(n) asm volatile("s_waitcnt vmcnt(" #n ")" ::: "memory")
#define PG8_WAIT_L(n) asm volatile("s_waitcnt lgkmcnt(" #n ")" ::: "memory")
#define PG8_BAR __builtin_amdgcn_s_barrier()
#define PG8_SCHED __builtin_amdgcn_sched_barrier(0)
    Unit cur, nxt; int ui = 0;
    if (!S.next(0, cur)) return;
    f32x4 acc[2][2][4][2];
#pragma unroll
    for (int a = 0; a < 2; ++a)
#pragma unroll
        for (int b = 0; b < 2; ++b)
#pragma unroll
            for (int m = 0; m < 4; ++m)
#pragma unroll
                for (int n = 0; n < 2; ++n) acc[a][b][m][n] = (f32x4){0.f, 0.f, 0.f, 0.f};
    i32x8 At[4], B0[2], B1[2];
    const char* cA = (const char*)g.A + cur.aoff; const char* cB = (const char*)g.Bt + cur.boff;
    typename Epi::Pre pre; E.prefetch(cur, wr, fr, pre);
    PG8_STAGE(PG8_SB(0, 0), cB, voffB); PG8_STAGE(PG8_SA(0, 0), cA, voffA); PG8_STAGE(PG8_SB(0, 1), cB + hstepB, voffB); PG8_STAGE(PG8_SA(0, 1), cA + hstepA, voffA);
    if (wr == 1) PG8_BAR;
    PG8_WAIT_V(4); PG8_BAR;
    PG8_STAGE(PG8_SB(1, 0), cB + kstep, voffB); PG8_STAGE(PG8_SA(1, 0), cA + kstep, voffA); PG8_STAGE(PG8_SB(1, 1), cB + hstepB + kstep, voffB);
    PG8_WAIT_V(6); PG8_BAR;
    for (;;) {
        const bool has_next = S.next(ui + 1, nxt);
        const char* nA = has_next ? (const char*)g.A + nxt.aoff : cA; const char* nB = has_next ? (const char*)g.Bt + nxt.boff : cB;
#pragma nounroll
        for (int t = 0; t < nt; t += 2) {
            const bool last = (t == nt - 2);
            const char* a1 = cA + (size_t)(t + 1) * kstep;
            const char* a2 = last ? nA : cA + (size_t)(t + 2) * kstep; const char* b2 = last ? nB : cB + (size_t)(t + 2) * kstep;
            const char* a3 = a2 + kstep; const char* b3 = b2 + kstep;
            PG8_LDB(B0, 0, 0); PG8_SCHED; PG8_LDA(At, 0, 0); PG8_STAGE(PG8_SA(1, 1), a1 + hstepA, voffA);
            PG8_WAIT_L(8); PG8_BAR; PG8_WAIT_L(0); PG8_MMA(0, 0, At, B0); PG8_BAR; PG8_SCHED;
            PG8_LDB(B1, 0, 1); PG8_STAGE(PG8_SB(0, 0), b2, voffB);
            PG8_BAR; PG8_WAIT_L(0); PG8_MMA(0, 1, At, B1); PG8_BAR;
            PG8_LDA(At, 0, 1); PG8_STAGE(PG8_SA(0, 0), a2, voffA);
            PG8_BAR; PG8_WAIT_L(0); PG8_MMA(1, 0, At, B0); PG8_BAR; PG8_SCHED;
            PG8_STAGE(PG8_SB(0, 1), b2 + hstepB, voffB);
            PG8_WAIT_V(6); PG8_BAR; PG8_MMA(1, 1, At, B1); PG8_BAR;
            PG8_LDB(B0, 1, 0); PG8_SCHED; PG8_LDA(At, 1, 0); PG8_STAGE(PG8_SA(0, 1), a2 + hstepA, voffA);
            PG8_WAIT_L(8); PG8_BAR; PG8_WAIT_L(0); PG8_MMA(0, 0, At, B0); PG8_BAR; PG8_SCHED;
            PG8_LDB(B1, 1, 1); PG8_STAGE(PG8_SB(1, 0), b3, voffB);
            PG8_BAR; PG8_WAIT_L(0); PG8_MMA(0, 1, At, B1); PG8_BAR;
            PG8_LDA(At, 1, 1); PG8_STAGE(PG8_SA(1, 0), a3, voffA);
            PG8_BAR; PG8_WAIT_L(0); PG8_MMA(1, 0, At, B0); PG8_BAR; PG8_SCHED;
            PG8_STAGE(PG8_SB(1, 1), b3 + hstepB, voffB);
            PG8_WAIT_V(6); PG8_BAR; PG8_MMA(1, 1, At, B1); PG8_BAR;
        }
        E(acc, cur, wr, wc, fr, fq, pre);
        if (!has_next) break;
        E.prefetch(nxt, wr, fr, pre);
#pragma unroll
        for (int a = 0; a < 2; ++a)
#pragma unroll
            for (int b = 0; b < 2; ++b)
#pragma unroll
                for (int m = 0; m < 4; ++m)
#pragma unroll
                    for (int n = 0; n < 2; ++n) acc[a][b][m][n] = (f32x4){0.f, 0.f, 0.f, 0.f};
        cur = nxt; cA = nA; cB = nB; ++ui;
    }
    PG8_WAIT_V(0);
    if (wr == 0) PG8_BAR;
    PG8_BAR;
#undef PG8_SA
#undef PG8_SB
#undef PG8_STAGE
#undef PG8_LDA
#undef PG8_LDB
#undef PG8_MMA
#undef PG8_WAIT_V
#undef PG8_WAIT_L
#undef PG8_BAR
#undef PG8_SCHED
}
}
using pg8::Unit;

#define XB_TMO      128
#define XB_XCNT(j)  (256  + 64 * (j))
#define XB_XSUB(j)  (1280 + 64 * (j))
#define XB_XGEN(j)  (2304 + 64 * (j))
#define XB_TOP      3328
#define XB_TOPGEN   3392
#define XCD_BAR_WORDS 3456
#define XB_SPIN_CAP (1u << 18)
__device__ __forceinline__ unsigned xb_ld(unsigned* p)              { return __hip_atomic_load(p, __ATOMIC_RELAXED, __HIP_MEMORY_SCOPE_AGENT); }
__device__ __forceinline__ unsigned xb_add(unsigned* p, unsigned v) { return __hip_atomic_fetch_add(p, v, __ATOMIC_RELAXED, __HIP_MEMORY_SCOPE_AGENT); }
__device__ __forceinline__ unsigned xb_xcc_id() { return (unsigned)__builtin_amdgcn_s_getreg((3 << 11) | 20) & 0xFu; }
#define XB_SPIN(cond, bar) do { unsigned _sp = 0; while (cond) { __builtin_amdgcn_s_sleep(1); \
    if ((++_sp & 255u) == 0u) { if (xb_ld(&(bar)[XB_TMO])) break; if (_sp > XB_SPIN_CAP) { atomicAdd(&(bar)[XB_TMO], 1u); break; } } } } while (0)
struct XcdBarrier { unsigned* bar; unsigned x; volatile LAS unsigned* st; };
__device__ __forceinline__ XcdBarrier xcd_barrier_post(unsigned* bar, volatile LAS unsigned* st) {
    XcdBarrier b; b.bar = bar; b.x = xb_xcc_id(); b.st = st;
    if (threadIdx.x == 0) (void)xb_add(&bar[XB_XCNT(b.x)], 1u);
    return b;
}
__device__ __forceinline__ void xcd_barrier_complete(unsigned* bar, unsigned x, unsigned& nloc, unsigned& nx) {
    const unsigned G = gridDim.x * gridDim.y * gridDim.z;
    unsigned sum, cnt, mine, sp = 0u;
    for (;;) {
        sum = 0u; cnt = 0u; mine = 0u;
#pragma unroll
        for (unsigned j = 0; j < 16; ++j) { const unsigned c = xb_ld(&bar[XB_XCNT(j)]); sum += c; cnt += (c > 0u) ? 1u : 0u; mine = (j == x) ? c : mine; }
        if (sum == G) break;
        __builtin_amdgcn_s_sleep(1);
        if ((++sp & 255u) == 0u) { if (xb_ld(&bar[XB_TMO])) break; if (sp > XB_SPIN_CAP) { atomicAdd(&bar[XB_TMO], 1u); break; } }
    }
    nloc = mine > 0u ? mine : 1u; nx = cnt > 0u ? cnt : 1u;
}
__device__ __forceinline__ void xcd_barrier(const XcdBarrier& b) {
    asm volatile("s_waitcnt vmcnt(0)" ::: "memory");
    __syncthreads();
    if (threadIdx.x == 0) {
        unsigned* bar = b.bar;
        __builtin_amdgcn_s_waitcnt(0);
        unsigned nloc = b.st[0], nx = b.st[1];
        if (nloc == 0u) { xcd_barrier_complete(bar, b.x, nloc, nx); b.st[0] = nloc; b.st[1] = nx; }
        const unsigned old = xb_add(&bar[XB_XSUB(b.x)], 1u);
        const unsigned gen = old / nloc;
        if (old + 1u == (gen + 1u) * nloc) {
            __builtin_amdgcn_fence(__ATOMIC_RELEASE, "agent");
            asm volatile("s_waitcnt vmcnt(0)" ::: "memory");
            const unsigned og = xb_add(&bar[XB_TOP], 1u);
            const unsigned tg = og / nx;
            if (og + 1u == (tg + 1u) * nx) xb_add(&bar[XB_TOPGEN], 1u);
            else XB_SPIN(xb_ld(&bar[XB_TOPGEN]) == tg, bar);
            __builtin_amdgcn_fence(__ATOMIC_ACQUIRE, "agent");
            xb_add(&bar[XB_XGEN(b.x)], 1u);
            asm volatile("s_waitcnt vmcnt(0)" ::: "memory");
        } else {
            XB_SPIN(xb_ld(&bar[XB_XGEN(b.x)]) == gen, bar);
            __builtin_amdgcn_fence(__ATOMIC_ACQUIRE, "agent");
            asm volatile("s_waitcnt vmcnt(0)" ::: "memory");
        }
    }
    __syncthreads();
}

constexpr int NWAVES = 8, NTHR = 512;
constexpr int LDS_BYTES = 147456;
constexpr int MISC_OFF = 131072;
constexpr int PTAB_OFF = MISC_OFF + 512;

struct Args { const float* in[28]; float* out; unsigned char* ws; int ph_lo, ph_hi; };

struct Frame {
    LAS unsigned char* lds; int tid, lane, wave, G, c;
    const float* const* in; float* out; unsigned char* ws;
};
#define INP_(i) (F.in[i])
#define FRESH_TID(F) do { int _t = threadIdx.x; asm volatile("" : "+v"(_t)); (F).tid = _t; (F).lane = _t & 63; \
    __attribute__((address_space(1))) unsigned char* _w = (__attribute__((address_space(1))) unsigned char*)args.ws; __attribute__((address_space(1))) float* _o = (__attribute__((address_space(1))) float*)args.out; \
    int _g = gridDim.x; asm volatile("" : "+s"(_w), "+s"(_o), "+s"(_g)); (F).ws = (unsigned char*)_w; (F).out = (float*)_o; (F).G = _g; } while (0)
enum { I_X = 0, I_ANG, I_WIN, I_CDW, I_CDB, I_CLG, I_CLB, I_QG, I_KG, I_PK, I_PV, I_KW1, I_KB1, I_KW2, I_KB2, I_VW1, I_VB1, I_VW2, I_VB2, I_WOUT, I_FNG, I_DW1, I_DW3, I_DW2, I_RW, I_MW1, I_MW3, I_MW2 };

#define PMARK(id) do { if (PROBE_MASK != 0u && blockIdx.x == 0 && threadIdx.x == 0) { volatile LAS unsigned long long* _a = (volatile LAS unsigned long long*)(F.lds + MISC_OFF + 160); volatile LAS unsigned* _o = (volatile LAS unsigned*)(F.lds + MISC_OFF + 168); \
    const unsigned long long _t = __builtin_amdgcn_s_memrealtime(); if (*_o) { *_a += _t; *_o = 0u; } if ((id) < 32 && ((PROBE_MASK >> (id)) & 1u)) { *_a -= _t; *_o = 1u; } } } while (0)
constexpr int RSL_OFF = MISC_OFF + 2048;
__device__ __forceinline__ void rstd_from_partials(const float* pss, int pm, LAS float* tab) {
    int t = threadIdx.x; asm volatile("" : "+v"(t));
    const int row = t >> 1, hf = t & 1;
    const f32x4 a = *(const f32x4*)(pss + (size_t)(pm * 256 + row) * 16 + hf * 8), b = *(const f32x4*)(pss + (size_t)(pm * 256 + row) * 16 + hf * 8 + 4);
    float sq = ((a.x + a.y) + (a.z + a.w)) + ((b.x + b.y) + (b.z + b.w)); sq += __shfl_xor(sq, 1);
    if (hf == 0) tab[row] = rsqf_(sq * (1.0f / D) + EPS);
}
struct EpiIn {
    static constexpr bool PERM = true;
    const float* rstd; bf16_t* U; bf16_t* Q; bf16_t* KV; float* GT; const float* pss; LAS float* rsl;
    struct Pre { int par = 1; };
    __device__ __forceinline__ void prefetch(const Unit& u, int wr, int fr, Pre& p) const {
        p.par ^= 1; LAS float* tab = rsl + p.par * 256;
        if (pss) rstd_from_partials(pss, u.pm, tab); else { int t = threadIdx.x; asm volatile("" : "+v"(t)); if (t < 256) tab[t] = rstd[u.pm * 256 + t]; } }
    __device__ __forceinline__ void operator()(const f32x4 (&acc)[2][2][4][2], const Unit& u, int wr, int wc, int fr, int fq, const Pre& pre) const {
        const int row0 = u.pm * 256 + wr * 64 + fr, cl = wc * 32 + 8 * fq;
        if (u.pn < 4) {
#pragma unroll
            for (int ai = 0; ai < 2; ++ai)
#pragma unroll
                for (int m = 0; m < 4; ++m) { const int r = row0 + ai * 128 + m * 16; const float rs = rsl[pre.par * 256 + wr * 64 + fr + ai * 128 + m * 16];
                    const f32x4 v0 = acc[ai][0][m][0] * rs, v1 = acc[ai][0][m][1] * rs, g0 = acc[ai][1][m][0] * rs, g1 = acc[ai][1][m][1] * rs;
                    u32x4 w; w.x = cvt_pk_bf16(v0[0] * sigmoidf_(g0[0]), v0[1] * sigmoidf_(g0[1])); w.y = cvt_pk_bf16(v0[2] * sigmoidf_(g0[2]), v0[3] * sigmoidf_(g0[3]));
                    w.z = cvt_pk_bf16(v1[0] * sigmoidf_(g1[0]), v1[1] * sigmoidf_(g1[1])); w.w = cvt_pk_bf16(v1[2] * sigmoidf_(g1[2]), v1[3] * sigmoidf_(g1[3]));
                    *(u32x4*)(U + (size_t)r * CW + u.pn * 128 + cl) = w; asm volatile("" ::: "memory"); }
        } else if (u.pn < 6) {
#pragma unroll
            for (int ai = 0; ai < 2; ++ai)
#pragma unroll
                for (int m = 0; m < 4; ++m) { const int r = row0 + ai * 128 + m * 16; const float rs = rsl[pre.par * 256 + wr * 64 + fr + ai * 128 + m * 16];
#pragma unroll
                    for (int bj = 0; bj < 2; ++bj) { const f32x4 v0 = acc[ai][bj][m][0] * rs, v1 = acc[ai][bj][m][1] * rs;
                        u32x4 w; w.x = cvt_pk_bf16(v0[0], v0[1]); w.y = cvt_pk_bf16(v0[2], v0[3]); w.z = cvt_pk_bf16(v1[0], v1[1]); w.w = cvt_pk_bf16(v1[2], v1[3]);
                        *(u32x4*)(Q + (size_t)r * 512 + (u.pn - 4) * 256 + bj * 128 + cl) = w; } asm volatile("" ::: "memory"); }
        } else if (u.pn < 9) {
            const int h = wc >> 1, d0 = 32 * (wc & 1) + 8 * fq;
#pragma unroll
            for (int ai = 0; ai < 2; ++ai)
#pragma unroll
                for (int m = 0; m < 4; ++m) { const int r = row0 + ai * 128 + m * 16; const float rs = rsl[pre.par * 256 + wr * 64 + fr + ai * 128 + m * 16]; const int b = r >> 11, t = r & 2047;
#pragma unroll
                    for (int bj = 0; bj < 2; ++bj) { const int tq = 2 * (u.pn - 6) + bj; const f32x4 v0 = acc[ai][bj][m][0] * rs, v1 = acc[ai][bj][m][1] * rs;
                        u32x4 w; w.x = cvt_pk_bf16(v0[0], v0[1]); w.y = cvt_pk_bf16(v0[2], v0[3]); w.z = cvt_pk_bf16(v1[0], v1[1]); w.w = cvt_pk_bf16(v1[2], v1[3]);
                        *(u32x4*)(KV + (size_t)tq * KVT + ((size_t)(b * 2 + h) * SEQ + t) * DH + d0) = w; } asm volatile("" ::: "memory"); }
        } else {
            if (wc == 0 && fq < 3) {
#pragma unroll
                for (int ai = 0; ai < 2; ++ai)
#pragma unroll
                    for (int m = 0; m < 4; ++m) { const int r = row0 + ai * 128 + m * 16; const float rs = rsl[pre.par * 256 + wr * 64 + fr + ai * 128 + m * 16];
                        *(f32x4*)(GT + (size_t)r * 24 + 8 * fq) = acc[ai][0][m][0] * rs; *(f32x4*)(GT + (size_t)r * 24 + 8 * fq + 4) = acc[ai][0][m][1] * rs; }
            }
        }
    }
};
struct EpiH1 {
    static constexpr bool PERM = false;
    float* H;
    struct Pre {}; __device__ __forceinline__ void prefetch(const Unit&, int, int, Pre&) const {}
    __device__ __forceinline__ void operator()(const f32x4 (&acc)[2][2][4][2], const Unit& u, int wr, int wc, int fr, int fq, const Pre&) const {
        const int row0 = u.pm * 256 + wr * 64 + fr, col0 = wc * 32 + 4 * fq; const int kv = u.pn >> 3, sp = u.pn & 7;
#pragma unroll
        for (int ai = 0; ai < 2; ++ai)
#pragma unroll
            for (int m = 0; m < 4; ++m) { float* rowp = H + (((size_t)sp * 2 + kv) * 2048 + row0 + ai * 128 + m * 16) * 256 + col0;
#pragma unroll
                for (int bj = 0; bj < 2; ++bj)
#pragma unroll
                    for (int n = 0; n < 2; ++n) *(f32x4*)(rowp + bj * 128 + n * 16) = acc[ai][bj][m][n]; }
    }
};
template <bool BF> struct EpiRes {
    static constexpr bool PERM = false;
    const void* base; bf16_t* xb; float* pss;
    struct Pre {}; __device__ __forceinline__ void prefetch(const Unit&, int, int, Pre&) const {}
    __device__ __forceinline__ void operator()(const f32x4 (&acc)[2][2][4][2], const Unit& u, int wr, int wc, int fr, int fq, const Pre&) const {
        const int row0 = u.pm * 256 + wr * 64 + fr, col0 = u.pn * 256 + wc * 32 + 4 * fq;
#pragma unroll
        for (int ai = 0; ai < 2; ++ai) {
            f32x4 bs[4][2][2];
#pragma unroll
            for (int m = 0; m < 4; ++m) { const size_t off = (size_t)(row0 + ai * 128 + m * 16) * D + col0;
#pragma unroll
                for (int bj = 0; bj < 2; ++bj)
#pragma unroll
                    for (int n = 0; n < 2; ++n) {
                        if (BF) { const u32x2 w = *(const u32x2*)((const bf16_t*)base + off + bj * 128 + n * 16); bs[m][bj][n] = (f32x4){bf_lo(w.x), bf_hi(w.x), bf_lo(w.y), bf_hi(w.y)}; }
                        else bs[m][bj][n] = *(const f32x4*)((const float*)base + off + bj * 128 + n * 16); } }
#pragma unroll
            for (int m = 0; m < 4; ++m) { const size_t off = (size_t)(row0 + ai * 128 + m * 16) * D + col0; float ss = 0.f;
#pragma unroll
                for (int bj = 0; bj < 2; ++bj)
#pragma unroll
                    for (int n = 0; n < 2; ++n) { const f32x4 v = bs[m][bj][n] + acc[ai][bj][m][n];
                        u32x2 w; w.x = cvt_pk_bf16(v[0], v[1]); w.y = cvt_pk_bf16(v[2], v[3]); *(u32x2*)(xb + off + bj * 128 + n * 16) = w; ss += (v[0] * v[0] + v[1] * v[1]) + (v[2] * v[2] + v[3] * v[3]); }
                if (pss) { ss += __shfl_xor(ss, 16); ss += __shfl_xor(ss, 32);
                    if (fq == 0) pss[(size_t)(row0 + ai * 128 + m * 16) * 16 + u.pn * 4 + wc] = ss; } } }
    }
};
struct EpiGlu {
    static constexpr bool PERM = true;
    const float* rstd; bf16_t* O; int ldo; int rowbase;
    const float* pss; LAS float* rsl;
    struct Pre { int par = 1; };
    __device__ __forceinline__ void prefetch(const Unit& u, int wr, int fr, Pre& p) const { p.par ^= 1; rstd_from_partials(pss, u.pm, rsl + p.par * 256); }
    __device__ __forceinline__ void operator()(const f32x4 (&acc)[2][2][4][2], const Unit& u, int wr, int wc, int fr, int fq, const Pre& pre) const {
        const int row0 = u.pm * 256 + wr * 64 + fr, cl = u.pn * 128 + wc * 32 + 8 * fq;
#pragma unroll
        for (int ai = 0; ai < 2; ++ai)
#pragma unroll
            for (int m = 0; m < 4; ++m) { const int r = row0 + ai * 128 + m * 16; const float rs = rsl[pre.par * 256 + wr * 64 + fr + ai * 128 + m * 16];
                const f32x4 g0 = acc[ai][0][m][0] * rs, g1 = acc[ai][0][m][1] * rs, u0 = acc[ai][1][m][0] * rs, u1 = acc[ai][1][m][1] * rs;
                u32x4 w; w.x = cvt_pk_bf16(siluf_(g0[0]) * u0[0], siluf_(g0[1]) * u0[1]); w.y = cvt_pk_bf16(siluf_(g0[2]) * u0[2], siluf_(g0[3]) * u0[3]);
                w.z = cvt_pk_bf16(siluf_(g1[0]) * u1[0], siluf_(g1[1]) * u1[1]); w.w = cvt_pk_bf16(siluf_(g1[2]) * u1[2], siluf_(g1[3]) * u1[3]);
                *(u32x4*)(O + (size_t)r * ldo + cl) = w; }
    }
};
struct EpiGlu8 {
    static constexpr bool PERM = true;
    const float* rstd; unsigned char* O; int ldo; float sc;
    struct Pre { float rs[8]; };
    __device__ __forceinline__ void prefetch(const Unit& u, int wr, int fr, Pre& p) const {
#pragma unroll
        for (int q = 0; q < 8; ++q) p.rs[q] = rstd[u.pm * 256 + wr * 64 + fr + (q >> 2) * 128 + (q & 3) * 16]; }
    __device__ __forceinline__ void operator()(const f32x4 (&acc)[2][2][4][2], const Unit& u, int wr, int wc, int fr, int fq, const Pre& pre) const {
        const int row0 = u.pm * 256 + wr * 64 + fr, cl = u.pn * 128 + wc * 32 + 8 * fq;
#pragma unroll
        for (int ai = 0; ai < 2; ++ai)
#pragma unroll
            for (int m = 0; m < 4; ++m) { const int r = row0 + ai * 128 + m * 16; const float rs = pre.rs[ai * 4 + m] * sc;
                const f32x4 g0 = acc[ai][0][m][0] * rs, g1 = acc[ai][0][m][1] * rs, u0 = acc[ai][1][m][0] * rs, u1 = acc[ai][1][m][1] * rs;
                *(u32x2*)(O + (size_t)r * ldo + cl) = pk8_fp8(siluf_(g0[0]) * u0[0], siluf_(g0[1]) * u0[1], siluf_(g0[2]) * u0[2], siluf_(g0[3]) * u0[3], siluf_(g1[0]) * u1[0], siluf_(g1[1]) * u1[1], siluf_(g1[2]) * u1[2], siluf_(g1[3]) * u1[3]); }
    }
};
struct EpiMoe2 {
    static constexpr bool PERM = true;
    const int* stok; const float* sw; bf16_t* Y0; bf16_t* Y1; int rowbase; float sc;
    struct Pre {}; __device__ __forceinline__ void prefetch(const Unit&, int, int, Pre&) const {}
    __device__ __forceinline__ void operator()(const f32x4 (&acc)[2][2][4][2], const Unit& u, int wr, int wc, int fr, int fq, const Pre&) const {
        const int row0 = u.pm * 256 + wr * 64 + fr, cl = u.pn * 256 + wc * 32 + 8 * fq;
        int tks[8]; float ws[8];
#pragma unroll
        for (int q = 0; q < 8; ++q) { const int r = rowbase + row0 + (q >> 2) * 128 + (q & 3) * 16; tks[q] = stok[r]; ws[q] = sw[r]; }
#pragma unroll
        for (int ai = 0; ai < 2; ++ai)
#pragma unroll
            for (int m = 0; m < 4; ++m) { const int tk = tks[ai * 4 + m]; const float w = ws[ai * 4 + m] * sc;
                if (tk >= 0) { bf16_t* dst = ((tk & 1) ? Y1 : Y0) + (size_t)(tk >> 1) * D + cl;
#pragma unroll
                    for (int bj = 0; bj < 2; ++bj) { const f32x4 v0 = acc[ai][bj][m][0] * w, v1 = acc[ai][bj][m][1] * w;
                        u32x4 o; o.x = cvt_pk_bf16(v0[0], v0[1]); o.y = cvt_pk_bf16(v0[2], v0[3]); o.z = cvt_pk_bf16(v1[0], v1[1]); o.w = cvt_pk_bf16(v1[2], v1[3]);
                        *(u32x4*)(dst + bj * 128) = o; } } }
    }
};

struct SchedCmp {
    int G, c, layer;
    __device__ __forceinline__ bool next(int i, Unit& u) const {
        const int L = i * G + c; if (L >= 128) return false;
        const int kv = L >> 6, pm = (L >> 3) & 7, s = L & 7;
        u.pm = pm; u.pn = kv * 8 + s; u.aoff = ((size_t)kv * KVT + (size_t)pm * 256 * 1024 + s * 256) * 2; u.boff = ((size_t)(layer * 2 + kv) * 256 * 2048 + s * 256) * 2; return true;
    }
};
struct SchedMoe1 {
    int G, c, p0, np; const LAS int* ptab;
    __device__ __forceinline__ bool next(int i, Unit& u) const {
        const int L = i * G + c; if (L >= np * 28) return false;
        const int j = L / np, pl = L % np, e = ptab[p0 + pl];
        u.pm = pl; u.pn = j; u.aoff = (size_t)(p0 + pl) * 256 * 1024 * 2; u.boff = ((size_t)e * 7168 + (size_t)j * 256) * 1024 * 2; return true;
    }
};
struct SchedMoe2 {
    int G, c, p0, np; const LAS int* ptab;
    __device__ __forceinline__ bool next(int i, Unit& u) const {
        const int L = i * G + c; if (L >= np * 4) return false;
        const int j = L / np, pl = L % np, e = ptab[p0 + pl];
        u.pm = pl; u.pn = j; u.aoff = (size_t)pl * 256 * DFE * 2; u.boff = ((size_t)e * 1024 + (size_t)j * 256) * DFE * 2; return true;
    }
};

struct SchedMoe1F {
    int G, c, np; const LAS int* ptab;
    __device__ __forceinline__ bool next(int i, Unit& u) const {
        const int L = i * G + c; if (L >= np * 28) return false;
        const int pl = L / 28, j = L % 28, e = ptab[pl];
        u.pm = pl; u.pn = j; u.aoff = (size_t)pl * 256 * 1024; u.boff = ((size_t)e * 7168 + (size_t)j * 256) * 1024; return true;
    }
};
struct SchedMoe2F {
    int G, c, np; const LAS int* ptab;
    __device__ __forceinline__ bool next(int i, Unit& u) const {
        const int cx = (G & 7) ? c : (c & 7) * (G >> 3) + (c >> 3);
        const int L = i * G + cx; if (L >= np * 4) return false;
        const int pl = L >> 2, j = L & 3, e = ptab[pl];
        u.pm = pl; u.pn = j; u.aoff = (size_t)pl * 256 * DFE; u.boff = ((size_t)e * 1024 + (size_t)j * 256) * DFE; return true;
    }
};

struct TwP { const float* W; const float* gv; bf16_t* WT; int ldw, n0, nvalid, k0, ldk, kind, h; float f8sc; };
__device__ __forceinline__ TwP tw_job(int r, const float* W, int ldw, int nblk, int nvalid, bf16_t* WT, int ldk, int kind, int h, const float* gv) {
    TwP P; P.W = W; P.gv = gv; P.WT = WT; P.ldw = ldw; P.n0 = 256 * (r % nblk); P.nvalid = nvalid; P.k0 = 64 * (r / nblk); P.ldk = ldk; P.kind = kind; P.h = h; P.f8sc = 0.f; return P; }
__device__ __forceinline__ void tw_load(const TwP& P, f32x4 (&tv)[8], int wave, int lane) {
    const int n = P.n0 + 4 * lane; const float* src = P.W + (size_t)(P.k0 + 8 * wave) * P.ldw + n;
#pragma unroll
    for (int i = 0; i < 8; ++i) tv[i] = (n < P.nvalid) ? *(const f32x4*)(src + (size_t)i * P.ldw) : (f32x4){0.f, 0.f, 0.f, 0.f};
}
__device__ __forceinline__ void tw_store(const TwP& P, f32x4 (&tv)[8], LAS unsigned char* tile, int wave, int lane) {
    if (P.gv) {
#pragma unroll
        for (int i = 0; i < 8; ++i) tv[i] *= P.gv[P.k0 + 8 * wave + i]; }
    const int ng = P.n0 + 32 * wave; size_t drow;
    if (P.kind == 0) drow = ng;
    else if (P.kind == 1) drow = 256 * (ng / 128) + 128 * P.h + (ng % 128);
    else { if (ng < 512) drow = 256 * (ng / 128) + (ng % 128); else if (ng < 1024) { const int cc = ng - 512; drow = 256 * (cc / 128) + 128 + (cc % 128); } else drow = ng; }
    if (P.f8sc != 0.f) {
        const float sc = P.f8sc;
#pragma unroll
        for (int c = 0; c < 4; ++c) *(LAS u32x2*)(tile + (4 * lane + c) * 80 + 8 * wave) = pk8_fp8(tv[0][c] * sc, tv[1][c] * sc, tv[2][c] * sc, tv[3][c] * sc, tv[4][c] * sc, tv[5][c] * sc, tv[6][c] * sc, tv[7][c] * sc);
        __syncthreads();
#pragma unroll
        for (int j = 0; j < 2; ++j) { const int r = (lane >> 2) + 16 * j, ch = lane & 3;
            *(u32x4*)((unsigned char*)P.WT + (drow + r) * (size_t)P.ldk + P.k0 + 16 * ch) = *(const LAS u32x4*)(tile + (32 * wave + r) * 80 + 16 * ch); }
        __syncthreads();
        return; }
#pragma unroll
    for (int c = 0; c < 4; ++c) { u32x4 o; o.x = cvt_pk_bf16(tv[0][c], tv[1][c]); o.y = cvt_pk_bf16(tv[2][c], tv[3][c]); o.z = cvt_pk_bf16(tv[4][c], tv[5][c]); o.w = cvt_pk_bf16(tv[6][c], tv[7][c]);
        *(LAS u32x4*)(tile + (4 * lane + c) * 144 + 16 * wave) = o; }
    __syncthreads();
#pragma unroll
    for (int j = 0; j < 4; ++j) { const int r = (lane >> 3) + 8 * j, c = lane & 7;
        *(u32x4*)(P.WT + (drow + r) * (size_t)P.ldk + P.k0 + 8 * c) = *(const LAS u32x4*)(tile + (32 * wave + r) * 144 + 16 * c); }
    __syncthreads();
}
#define TW_RUN(NIT, JOB) do { const int _n = (NIT); if (_n > 0) { TwP _pa, _pb; f32x4 _ta[8], _tb[8]; JOB(_pa, 0); tw_load(_pa, _ta, F.wave, F.lane); \
    _Pragma("nounroll") for (int _i = 0; _i < _n; _i += 2) { const bool _h2 = _i + 1 < _n, _h3 = _i + 2 < _n; \
        if (_h2) { JOB(_pb, _i + 1); tw_load(_pb, _tb, F.wave, F.lane); } tw_store(_pa, _ta, F.lds, F.wave, F.lane); if (!_h2) break; \
        if (_h3) { JOB(_pa, _i + 2); tw_load(_pa, _ta, F.wave, F.lane); } tw_store(_pb, _tb, F.lds, F.wave, F.lane); } } } while (0)
__device__ __forceinline__ void xprep_row(const float* xrow, bf16_t* orow, float* rstd_out, int lane, f32x4 (&v)[4]) {
    const f32x4* xr = (const f32x4*)xrow + lane; float s = 0.f;
#pragma unroll
    for (int j = 0; j < 4; ++j) { v[j] = xr[64 * j]; s += (v[j].x * v[j].x + v[j].y * v[j].y) + (v[j].z * v[j].z + v[j].w * v[j].w); }
    const float rstd = rsqf_(wave_sum_u(s) * (1.0f / D) + EPS);
    if (orow) { u32x2* o8 = (u32x2*)orow + lane;
#pragma unroll
        for (int j = 0; j < 4; ++j) { u32x2 w; w.x = cvt_pk_bf16(v[j].x, v[j].y); w.y = cvt_pk_bf16(v[j].z, v[j].w); o8[64 * j] = w; } }
    if (lane == 0) *rstd_out = rstd;
}

constexpr float MOE_S1 = 64.f, MOE_S2 = 128.f;
constexpr int MOE_SLOT_N = 7, MOE_SLOTTED = 3 * 128 * MOE_SLOT_N;
constexpr int MOE_ITEMS = 24 * 224;
__device__ __forceinline__ TwP moe_conv_job(Frame& F, int r) {
    constexpr int J_M1 = 16 * 14, J_M2 = 56 * 4;
    unsigned char* WM1 = F.ws + WS_WM1; unsigned char* WM2 = F.ws + WS_WM2;
    if (r < 16 * J_M1) { const int q = r / J_M1, e = q >> 1, h = q & 1; TwP P = tw_job(r % J_M1, (h ? INP_(I_MW3) : INP_(I_MW1)) + (size_t)e * D * DFE, DFE, 14, DFE, (bf16_t*)(WM1 + (size_t)e * 7168 * D), D, 1, h, INP_(I_FNG) + D); P.f8sc = MOE_S1; return P; }
    r -= 16 * J_M1; const int e = r / J_M2; TwP P = tw_job(r % J_M2, INP_(I_MW2) + (size_t)e * DFE * D, D, 4, D, (bf16_t*)(WM2 + (size_t)e * D * DFE), DFE, 0, 0, nullptr); P.f8sc = MOE_S2; return P;
}
__device__ __forceinline__ void moe_conv_slot(Frame& F, int slot) {
    if (F.G != 256 || F.c < 128) return;
    { int _t = threadIdx.x; asm volatile("" : "+v"(_t)); F.tid = _t; F.lane = _t & 63; }
    int base = slot * 128 * MOE_SLOT_N + ((int)blockIdx.x - 128); asm volatile("" : "+s"(base));
#define MJOB(P, i) P = moe_conv_job(F, base + (i) * 128)
    TW_RUN(MOE_SLOT_N, MJOB);
#undef MJOB
}
__device__ __forceinline__ void xprep_rows4(const float* X, bf16_t* XBo, float* RSo, int m, int ms, int lane) {
    f32x4 v[4][4];
#pragma unroll
    for (int q = 0; q < 4; ++q) { const int mm = m + q * ms; const f32x4* xr = (const f32x4*)(X + (size_t)(mm < M ? mm : 0) * D) + lane;
#pragma unroll
        for (int j = 0; j < 4; ++j) v[q][j] = xr[64 * j]; }
#pragma unroll
    for (int q = 0; q < 4; ++q) { const int mm = m + q * ms; if (mm >= M) break; float s = 0.f;
#pragma unroll
        for (int j = 0; j < 4; ++j) s += (v[q][j].x * v[q][j].x + v[q][j].y * v[q][j].y) + (v[q][j].z * v[q][j].z + v[q][j].w * v[q][j].w);
        const float rstd = rsqf_(wave_sum_u(s) * (1.0f / D) + EPS);
        u32x2* o8 = (u32x2*)(XBo + (size_t)mm * D) + lane;
#pragma unroll
        for (int j = 0; j < 4; ++j) { u32x2 w; w.x = cvt_pk_bf16(v[q][j].x, v[q][j].y); w.y = cvt_pk_bf16(v[q][j].z, v[q][j].w); o8[64 * j] = w; }
        if (lane == 0) RSo[mm] = rstd; }
}
__device__ __forceinline__ void phase_prologue(Frame& F) {
    const int gw = F.c * NWAVES + F.wave, NGW = F.G * NWAVES;
    bf16_t* WIN = (bf16_t*)(F.ws + WS_WIN); bf16_t* WC1 = (bf16_t*)(F.ws + WS_WC1); bf16_t* WOUT = (bf16_t*)(F.ws + WS_WOUT); bf16_t* WF1 = (bf16_t*)(F.ws + WS_WF1); bf16_t* WF2 = (bf16_t*)(F.ws + WS_WF2);
    constexpr int J_IN = 16 * 10, J_C1 = 32, J_OUT = 16 * 4, J_F1 = 16 * 11, J_F2 = 44 * 4;
    constexpr int NSMALL = 2 * J_IN + 4 * J_C1 + 2 * J_OUT + 2 * J_F1 + J_F2;
    const int moe0 = (F.G == 256) ? MOE_SLOTTED : 0; const int nitems = NSMALL + MOE_ITEMS - moe0;
#define P0_JOB(P, i) do { int r = F.c + (i) * F.G; \
        if (r < 2 * J_IN) { const int l = r / J_IN; P = tw_job(r % J_IN, INP_(I_WIN) + (size_t)l * D * INW, INW, 10, INW, WIN + (size_t)l * INP * D, D, 2, 0, INP_(I_ANG) + l * D); break; } r -= 2 * J_IN; \
        if (r < 4 * J_C1) { const int q = r / J_C1, l = q >> 1, kv = q & 1; P = tw_job(r % J_C1, (kv ? INP_(I_VW1) : INP_(I_KW1)) + (size_t)l * 2048 * 256, 256, 1, 256, WC1 + (size_t)(l * 2 + kv) * 256 * 2048, 2048, 0, 0, nullptr); break; } r -= 4 * J_C1; \
        if (r < 2 * J_OUT) { const int l = r / J_OUT; P = tw_job(r % J_OUT, INP_(I_WOUT) + (size_t)l * D * D, D, 4, D, WOUT + (size_t)l * D * D, D, 0, 0, nullptr); break; } r -= 2 * J_OUT; \
        if (r < 2 * J_F1) { const int h = r / J_F1; P = tw_job(r % J_F1, (h ? INP_(I_DW3) : INP_(I_DW1)), DFF, 11, DFF, WF1, D, 1, h, INP_(I_FNG)); break; } r -= 2 * J_F1; \
        if (r < J_F2) { P = tw_job(r, INP_(I_DW2), D, 4, D, WF2, DFF, 0, 0, nullptr); break; } r -= J_F2; \
        P = moe_conv_job(F, r + moe0); } while (0)
    TW_RUN((nitems - F.c + F.G - 1) / F.G, P0_JOB);
#undef P0_JOB
    { float* RT = (float*)(F.ws + WS_RT); const int gt = F.c * NTHR + F.tid; if (gt < 8192) { const int e = gt >> 10, k = gt & 1023; RT[gt] = INP_(I_RW)[k * 8 + e] * INP_(I_FNG)[D + k]; } }
    { float* B1P = (float*)(F.ws + WS_CTL) + CW_B1P; LAS float* ps = (LAS float*)F.lds;
      for (int it = F.c; it < 128; it += F.G) { const int kc = it & 7, jb = (it >> 3) & 3, kv = (it >> 5) & 1, l = it >> 6; const int j = jb * 64 + F.lane, kb = kc * 256 + 32 * F.wave;
          const float* w1 = (kv ? INP_(I_VW1) : INP_(I_KW1)) + (size_t)l * 2048 * 256; const float* pos = (kv ? INP_(I_PV) : INP_(I_PK)) + l * 2048;
          float wv[32];
#pragma unroll
          for (int k = 0; k < 32; ++k) wv[k] = w1[(size_t)(kb + k) * 256 + j];
          float sp = 0.f;
#pragma unroll
          for (int k = 0; k < 32; ++k) sp += pos[kb + k] * wv[k];
          ps[F.wave * 64 + F.lane] = sp;
          __syncthreads();
          if (F.wave == 0) { float t = (kc == 0) ? (kv ? INP_(I_VB1) : INP_(I_KB1))[l * 256 + j] : 0.f;
#pragma unroll
              for (int ww = 0; ww < 8; ++ww) t += ps[ww * 64 + F.lane];
              B1P[kc * 1024 + (l * 2 + kv) * 256 + j] = t; }
          __syncthreads(); } }
    { bf16_t* XB = (bf16_t*)(F.ws + WS_XB); float* RS = (float*)(F.ws + WS_RSTD);
      for (int m = gw; m < M; m += 4 * NGW) xprep_rows4(INP_(I_X), XB, RS, m, NGW, F.lane); }
}

__device__ __forceinline__ void norm_rows64(bf16_t* buf, int nrows, const float* g, float scale, int gw, int NGW, int lane) {
    const int sub = lane & 7; float gv[8];
#pragma unroll
    for (int j = 0; j < 8; ++j) gv[j] = g[sub * 8 + j] * scale;
    for (int it = gw; it < nrows / 8; it += NGW) { u32x4* p = (u32x4*)(buf + ((size_t)it * 8 + (lane >> 3)) * 64) + sub; const u32x4 v = *p;
        float f[8] = {bf_lo(v.x), bf_hi(v.x), bf_lo(v.y), bf_hi(v.y), bf_lo(v.z), bf_hi(v.z), bf_lo(v.w), bf_hi(v.w)}; float s = 0.f;
#pragma unroll
        for (int j = 0; j < 8; ++j) s += f[j] * f[j];
        s += __shfl_xor(s, 1); s += __shfl_xor(s, 2); s += __shfl_xor(s, 4);
        const float rs = rsqf_(s * (1.0f / 64.0f) + EPS);
        u32x4 o; o.x = cvt_pk_bf16(f[0] * rs * gv[0], f[1] * rs * gv[1]); o.y = cvt_pk_bf16(f[2] * rs * gv[2], f[3] * rs * gv[3]); o.z = cvt_pk_bf16(f[4] * rs * gv[4], f[5] * rs * gv[5]); o.w = cvt_pk_bf16(f[6] * rs * gv[6], f[7] * rs * gv[7]);
        *p = o; }
}
__device__ __forceinline__ float sum32_(float v, bool) {
    v = DPP_ADD(v, 0xB1); v = DPP_ADD(v, 0x4E); v = DPP_ADD(v, 0x124); v = DPP_ADD(v, 0x128);
    return v + __shfl_xor(v, 16);
}
__device__ __forceinline__ void conv_unit(Frame& F, int layer, int cu) {
    const int b = cu >> 6, t0 = (cu & 63) * 32; int tid = F.tid; asm volatile("" : "+v"(tid));
    const bf16_t* U = (const bf16_t*)(F.ws + WS_U); bf16_t* MIX = (bf16_t*)(F.ws + WS_MIX);
    LAS u32x4* L4 = (LAS u32x4*)F.lds;
    { u32x4 sv[8];
#pragma unroll
      for (int q = 0; q < 8; ++q) { const int i = tid + q * NTHR, row = i >> 6, ch = i & 63, t = t0 - 30 + row; sv[q] = (u32x4){0u, 0u, 0u, 0u}; if (i < 62 * 64 && t >= 0) sv[q] = *(const u32x4*)(U + (size_t)(b * SEQ + t) * CW + ch * 8); }
#pragma unroll
      for (int q = 0; q < 8; ++q) { const int i = tid + q * NTHR; if (i < 62 * 64) L4[i] = sv[q]; } }
    __syncthreads();
    const int cp = tid & 255, th = tid >> 8; const bool hi = (tid & 32) != 0; const LAS unsigned* LW = (const LAS unsigned*)F.lds;
    f32x2 w[CKW];
#pragma unroll
    for (int k = 0; k < CKW; ++k) w[k] = *(const f32x2*)(INP_(I_CDW) + (size_t)layer * CKW * CW + k * CW + 2 * cp);
    const f32x2 cb = *(const f32x2*)(INP_(I_CDB) + layer * CW + 2 * cp), lg = *(const f32x2*)(INP_(I_CLG) + layer * CW + 2 * cp), lb = *(const f32x2*)(INP_(I_CLB) + layer * CW + 2 * cp);
#pragma nounroll
    for (int hf = 0; hf < 2; ++hf) { const int tl0 = th * 16 + hf * 8;
        f32x2 in[38];
#pragma unroll
        for (int i = 0; i < 38; ++i) { const unsigned v = LW[(tl0 + i) * 256 + cp]; in[i] = (f32x2){bf_lo(v), bf_hi(v)}; }
        f32x2 acc[8];
#pragma unroll
        for (int t = 0; t < 8; ++t) { acc[t] = cb;
#pragma unroll
            for (int k = 0; k < CKW; ++k) acc[t] += w[k] * in[t + k]; }
#pragma unroll
        for (int t = 0; t < 8; ++t) {
            const float s = sum32_(acc[t].x + acc[t].y, hi), q = sum32_(acc[t].x * acc[t].x + acc[t].y * acc[t].y, hi);
            const float mu = s * (1.0f / 64.0f), var = fmaxf(q * (1.0f / 64.0f) - mu * mu, 0.f), rs = rsqf_(var + EPS);
            const float a0 = (acc[t].x - mu) * rs * lg.x + lb.x, a1 = (acc[t].y - mu) * rs * lg.y + lb.y;
            *(unsigned*)(MIX + (size_t)(b * SEQ + t0 + tl0 + t) * D + 2 * cp) = cvt_pk_bf16(siluf_(a0), siluf_(a1)); }
    }
    __syncthreads();
}
__device__ __forceinline__ void vtrans_items(Frame& F, int gw, int NGW) {
    const int lane = F.lane;
    LAS unsigned char* scr = F.lds + F.wave * 9216;
    for (int it = gw; it < 1024; it += NGW) { const int ten = it >> 9, bh = (it >> 5) & 15, kb = it & 31;
        const bf16_t* V = (const bf16_t*)(F.ws + WS_KV) + (size_t)(ten ? 5 : 3) * KVT + ((size_t)bh * SEQ + kb * 64) * 64; bf16_t* VT = (bf16_t*)(F.ws + (ten ? WS_VWT : WS_VST)) + (size_t)bh * 64 * SEQ + kb * 64;
#pragma unroll
        for (int c = 0; c < 8; ++c) *(LAS u32x4*)(scr + lane * 144 + c * 16) = *((const u32x4*)(V + (size_t)lane * 64) + c);
        LDS_WAIT(); __builtin_amdgcn_wave_barrier(); asm volatile("" ::: "memory");
#pragma unroll
        for (int c = 0; c < 8; ++c) { unsigned w[4];
#pragma unroll
            for (int q = 0; q < 4; ++q) { const int v0 = 8 * c + 2 * q, k0 = swap23(v0), k1 = swap23(v0 + 1);
                w[q] = (unsigned)*(const LAS bf16_t*)(scr + k0 * 144 + lane * 2) | ((unsigned)*(const LAS bf16_t*)(scr + k1 * 144 + lane * 2) << 16); }
            *((u32x4*)(VT + (size_t)lane * SEQ) + c) = (u32x4){w[0], w[1], w[2], w[3]}; }
        LDS_WAIT(); __builtin_amdgcn_wave_barrier(); asm volatile("" ::: "memory");
    }
}
__device__ __forceinline__ void phase_cmp2(Frame& F, int layer) {
    const int lane = F.lane, w = F.wave, k0 = 32 * w;
    const float* H1 = (const float*)(F.ws + WS_H1); const float* B1P = (const float*)(F.ws + WS_CTL) + CW_B1P + layer * 512;
    LAS float* part = (LAS float*)F.lds;
#pragma nounroll
    for (int un = F.c; un < 256; un += F.G) { const int kv = un >> 7, R0 = (un & 127) * 16;
        const float* w2 = (kv ? INP_(I_VW2) : INP_(I_KW2)) + (size_t)layer * 16384 + (size_t)k0 * 64 + lane;
        float w2r[32];
#pragma unroll
        for (int j = 0; j < 32; ++j) w2r[j] = w2[j * 64];
        float bsum = 0.f;
#pragma unroll
        for (int sp = 0; sp < 8; ++sp) bsum += B1P[sp * 1024 + kv * 256 + k0 + (lane & 31)];
        float acc[16], hx[16];
        {
            float hp[16][8];
#pragma unroll
            for (int r = 0; r < 16; ++r)
#pragma unroll
                for (int sp = 0; sp < 8; ++sp) hp[r][sp] = H1[((size_t)kv * 2048 + R0 + r) * 256 + k0 + (lane & 31) + (size_t)sp * 2 * 2048 * 256];
#pragma unroll
            for (int r = 0; r < 16; ++r) { float x = 0.f;
#pragma unroll
                for (int sp = 0; sp < 8; ++sp) x += hp[r][sp];
                hx[r] = siluf_(x + bsum); } }
#pragma unroll
        for (int r = 0; r < 16; ++r) { const int hb = __builtin_bit_cast(int, hx[r]); float a = 0.f;
#pragma unroll
            for (int j = 0; j < 32; ++j) a += __builtin_bit_cast(float, __builtin_amdgcn_readlane(hb, j)) * w2r[j];
            acc[r] = a; }
#pragma unroll
        for (int r = 0; r < 16; ++r) part[(w * 16 + r) * 64 + lane] = acc[r];
        __syncthreads();
#pragma unroll
        for (int rr = 0; rr < 2; ++rr) { const int r = 2 * w + rr, R = R0 + r;
            float a = (kv ? INP_(I_VB2) : INP_(I_KB2))[layer * 64 + lane];
#pragma unroll
            for (int ww = 0; ww < 8; ++ww) a += part[(ww * 16 + r) * 64 + lane];
            if ((R & 127) == 127) a = 0.f;
            else if (kv == 0) { const float ms = wave_sum_u(a * a) * (1.0f / 64.0f); a = a * (rsqf_(ms + EPS)) * INP_(I_KG)[layer * 192 + lane]; }
            const bf16_t ab = (bf16_t)(cvt_pk_bf16(a, 0.f) & 0xffffu);
            ((bf16_t*)(F.ws + (kv ? WS_VC : WS_KC)))[(size_t)R * 64 + lane] = ab;
            if (kv) ((bf16_t*)(F.ws + WS_VCT))[((size_t)(R >> 7) * 64 + lane) * 128 + swap23(R & 127)] = ab; }
        __syncthreads();
    }
}

__device__ __forceinline__ void dots4(const bf16_t* krow, const LAS float* qs, float (&s)[4]) {
    s[0] = s[1] = s[2] = s[3] = 0.f;
#pragma nounroll
    for (int c = 0; c < 8; ++c) { const u32x4 v = *((const u32x4*)krow + c);
        const float f[8] = {bf_lo(v.x), bf_hi(v.x), bf_lo(v.y), bf_hi(v.y), bf_lo(v.z), bf_hi(v.z), bf_lo(v.w), bf_hi(v.w)};
#pragma unroll
        for (int h = 0; h < 4; ++h) { const f32x4 q0 = *(const LAS f32x4*)(qs + h * 64 + c * 8), q1 = *(const LAS f32x4*)(qs + h * 64 + c * 8 + 4);
            s[h] += (f[0] * q0.x + f[1] * q0.y) + (f[2] * q0.z + f[3] * q0.w) + (f[4] * q1.x + f[5] * q1.y) + (f[6] * q1.z + f[7] * q1.w); } }
}
__device__ __forceinline__ void softmax_pv(LAS f32x4* sb, const LAS int* kb, int nk, const bf16_t* V, int lane, float (&o)[4]) {
    float m[4] = {-1e30f, -1e30f, -1e30f, -1e30f};
#pragma nounroll
    for (int c = 0; c < nk; ++c) { const f32x4 s = sb[c * 64 + lane]; m[0] = fmaxf(m[0], s.x); m[1] = fmaxf(m[1], s.y); m[2] = fmaxf(m[2], s.z); m[3] = fmaxf(m[3], s.w); }
#pragma unroll
    for (int h = 0; h < 4; ++h) m[h] = wave_max(m[h]);
    float sum[4] = {0.f, 0.f, 0.f, 0.f};
#pragma nounroll
    for (int c = 0; c < nk; ++c) { const f32x4 s = sb[c * 64 + lane]; f32x4 p;
        p.x = s.x > -1e29f ? __expf(s.x - m[0]) : 0.f; p.y = s.y > -1e29f ? __expf(s.y - m[1]) : 0.f; p.z = s.z > -1e29f ? __expf(s.z - m[2]) : 0.f; p.w = s.w > -1e29f ? __expf(s.w - m[3]) : 0.f;
        sum[0] += p.x; sum[1] += p.y; sum[2] += p.z; sum[3] += p.w; sb[c * 64 + lane] = p; }
    float inv[4];
#pragma unroll
    for (int h = 0; h < 4; ++h) inv[h] = rcpf_(fmaxf(wave_sum(sum[h]), 1e-30f));
    LDS_WAIT(); __builtin_amdgcn_wave_barrier(); asm volatile("" ::: "memory");
    o[0] = o[1] = o[2] = o[3] = 0.f;
#pragma nounroll
    for (int c = 0; c < nk; ++c) { const int k0 = kb[c];
#pragma unroll 4
        for (int kk = 0; kk < 64; ++kk) { int key = k0 + kk; key = key < 0 ? 0 : (key > SEQ - 1 ? SEQ - 1 : key);
            const f32x4 p = sb[c * 64 + kk]; const float v = bf2f(V[(size_t)key * 64 + lane]);
            o[0] += p.x * v; o[1] += p.y * v; o[2] += p.z * v; o[3] += p.w * v; } }
#pragma unroll
    for (int h = 0; h < 4; ++h) o[h] *= inv[h];
    __builtin_amdgcn_wave_barrier(); asm volatile("" ::: "memory");
}
__device__ __forceinline__ void phase_attn_ref(Frame& F, int layer) {
    const int lane = F.lane;
    LAS unsigned char* wl = F.lds + F.wave * 12288;
    LAS float* qs = (LAS float*)wl;
    LAS f32x4* pc = (LAS f32x4*)(wl + 1024);
    LAS float* psum = (LAS float*)(wl + 3072);
    LAS int* kbl = (LAS int*)(wl + 3584);
    LAS f32x4* sb = (LAS f32x4*)(wl + 4096);
    const bf16_t* QN = (const bf16_t*)(F.ws + WS_Q); const bf16_t* KVb = (const bf16_t*)(F.ws + WS_KV);
    const bf16_t* KC = (const bf16_t*)(F.ws + WS_KC); const bf16_t* VC = (const bf16_t*)(F.ws + WS_VC);
    const float* GT = (const float*)(F.ws + WS_GT); bf16_t* MIX = (bf16_t*)(F.ws + WS_MIX);
#pragma nounroll
    for (int un = F.c; un < NBH * 64; un += F.G) {
        const int bh = un >> 6, tile = un & 63, b = bh >> 1, kvh = bh & 1;
        const bf16_t* KS = KVb + 2 * KVT + (size_t)bh * SEQ * 64; const bf16_t* VS = KVb + 3 * KVT + (size_t)bh * SEQ * 64;
        const bf16_t* KW = KVb + 4 * KVT + (size_t)bh * SEQ * 64; const bf16_t* VW = KVb + 5 * KVT + (size_t)bh * SEQ * 64;
#pragma nounroll
        for (int ti = 0; ti < 4; ++ti) {
            const int t = tile * 32 + F.wave * 4 + ti, r = b * SEQ + t;
#pragma unroll
            for (int h = 0; h < 4; ++h) qs[h * 64 + lane] = bf2f(QN[(size_t)r * 512 + (kvh * 4 + h) * 64 + lane]);
            LDS_WAIT(); __builtin_amdgcn_wave_barrier(); asm volatile("" ::: "memory");
            float sc[2][4]; bool vc[2];
#pragma unroll
            for (int u = 0; u < 2; ++u) { const int c = lane + 64 * u; vc[u] = (c < NCMP) && (16 * c + 31 <= t);
                if (vc[u]) dots4(KC + ((size_t)bh * 128 + c) * 64, qs, sc[u]); else { sc[u][0] = sc[u][1] = sc[u][2] = sc[u][3] = -1e30f; } }
            float pr[2][4];
#pragma unroll
            for (int h = 0; h < 4; ++h) { const float mx = wave_max(fmaxf(sc[0][h], sc[1][h]));
                pr[0][h] = vc[0] ? __expf(sc[0][h] - mx) : 0.f; pr[1][h] = vc[1] ? __expf(sc[1][h] - mx) : 0.f;
                const float inv = rcpf_(fmaxf(wave_sum(pr[0][h] + pr[1][h]), 1e-30f)); pr[0][h] *= inv; pr[1][h] *= inv; }
#pragma unroll
            for (int u = 0; u < 2; ++u) { pc[lane + 64 * u] = (f32x4){pr[u][0], pr[u][1], pr[u][2], pr[u][3]}; psum[lane + 64 * u] = (pr[u][0] + pr[u][1]) + (pr[u][2] + pr[u][3]); }
            LDS_WAIT(); __builtin_amdgcn_wave_barrier(); asm volatile("" ::: "memory");
            const int j = lane & 31, cur = t >> 6; float imp = 0.f;
#pragma unroll
            for (int cc = -1; cc <= 3; ++cc) { const int c = 4 * j + cc; if (c >= 0 && c < NCMP) imp += psum[c]; }
            const bool causal = (j * 64 <= t), forced = (j == 0) || (j == cur) || (j == cur - 1);
            const float score = causal ? (forced ? imp + 1e4f : imp) : -1e30f;
            int rank = 0;
#pragma unroll
            for (int i = 0; i < 32; ++i) { const float si = __shfl(score, i); rank += (si > score || (si == score && i < j)) ? 1 : 0; }
            const unsigned selmask = (unsigned)__ballot(lane < 32 && rank < 8 && causal);
            float ocmp[4] = {0.f, 0.f, 0.f, 0.f};
            { const int nvc = t >= 31 ? (((t - 31) >> 4) + 1 > NCMP ? NCMP : ((t - 31) >> 4) + 1) : 0;
#pragma unroll 4
              for (int c = 0; c < nvc; ++c) { const f32x4 p = pc[c]; const float v = bf2f(VC[((size_t)bh * 128 + c) * 64 + lane]); ocmp[0] += p.x * v; ocmp[1] += p.y * v; ocmp[2] += p.z * v; ocmp[3] += p.w * v; } }
            __builtin_amdgcn_wave_barrier(); asm volatile("" ::: "memory");
            int nk = 0; float osel[4], owin[4];
#pragma nounroll
            for (unsigned mm = selmask; mm != 0u && nk < 8; mm &= mm - 1u) { const int jj = __builtin_ctz(mm);
                const int key = jj * 64 + lane; float s[4];
                if (key <= t) dots4(KS + (size_t)key * 64, qs, s); else { s[0] = s[1] = s[2] = s[3] = -1e30f; }
                sb[nk * 64 + lane] = (f32x4){s[0], s[1], s[2], s[3]};
                if (lane == 0) kbl[nk] = jj * 64;
                ++nk; }
            LDS_WAIT(); __builtin_amdgcn_wave_barrier(); asm volatile("" ::: "memory");
            softmax_pv(sb, kbl, nk, VS, lane, osel);
            nk = 0;
#pragma nounroll
            for (int ch = 0; ch < 8; ++ch) { const int k0 = t - 511 + 64 * ch; if (k0 + 63 < 0) continue;
                const int key = k0 + lane; float s[4];
                if (key >= 0) dots4(KW + (size_t)key * 64, qs, s); else { s[0] = s[1] = s[2] = s[3] = -1e30f; }
                sb[nk * 64 + lane] = (f32x4){s[0], s[1], s[2], s[3]};
                if (lane == 0) kbl[nk] = k0;
                ++nk; }
            LDS_WAIT(); __builtin_amdgcn_wave_barrier(); asm volatile("" ::: "memory");
            softmax_pv(sb, kbl, nk, VW, lane, owin);
#pragma unroll
            for (int h = 0; h < 4; ++h) { const float* gp = GT + (size_t)r * 24 + (kvh * 4 + h) * 3;
                const float o = sigmoidf_(gp[0]) * ocmp[h] + sigmoidf_(gp[1]) * osel[h] + sigmoidf_(gp[2]) * owin[h];
                MIX[(size_t)r * D + 512 + (kvh * 4 + h) * 64 + lane] = (bf16_t)(cvt_pk_bf16(o, 0.f) & 0xffffu); }
            __builtin_amdgcn_wave_barrier(); asm volatile("" ::: "memory");
        }
    }
}


constexpr int AT_KB = 0, AT_VB = 18432, AT_WUN = 36864, AT_OT = 40960;
__device__ __forceinline__ int crow_(int i) { return (i & 3) + 8 * (i >> 2); }
__device__ __forceinline__ float fmax_(float a, float b) { return __builtin_amdgcn_fmed3f(a, b, __builtin_inff()); }
template <int MODE>
__device__ __forceinline__ void attn_tile(const LAS unsigned char* KB, const LAS unsigned char* VB, const bf16x8 (&Qf)[4], f32x16 (&O)[2], float cref, float& l, int tl, int lo, bool rowok, int n, int h) {
    f32x16 S0, S1;
#pragma unroll
    for (int i = 0; i < 16; ++i) { S0[i] = 0.f; S1[i] = 0.f; }
#pragma unroll
    for (int s = 0; s < 4; ++s) { const bf16x8 k0 = *(const LAS bf16x8*)(KB + n * 144 + (16 * s + 8 * h) * 2), k1 = *(const LAS bf16x8*)(KB + (32 + n) * 144 + (16 * s + 8 * h) * 2);
        S0 = MFMA32(k0, Qf[s], S0); S1 = MFMA32(k1, Qf[s], S1); }
    if (MODE != 0) {
#pragma unroll
        for (int i = 0; i < 16; ++i) { const int c0 = crow_(i), c1 = 32 + crow_(i);
            if (MODE == 1) { S0[i] = rowok ? S0[i] : -1e30f; S1[i] = rowok ? S1[i] : -1e30f; }
            if (MODE == 2) { S0[i] = (c0 <= tl && c0 > lo) ? S0[i] : -1e30f; S1[i] = (c1 <= tl && c1 > lo) ? S1[i] : -1e30f; } } }
    f32x2 ls2 = {0.f, 0.f}; const f32x2 mr2 = {cref, cref};
#pragma unroll
    for (int i = 0; i < 8; ++i) { f32x2 a = (f32x2){S0[2 * i], S0[2 * i + 1]} - mr2, b = (f32x2){S1[2 * i], S1[2 * i + 1]} - mr2;
        a.x = __builtin_amdgcn_exp2f(a.x); a.y = __builtin_amdgcn_exp2f(a.y); b.x = __builtin_amdgcn_exp2f(b.x); b.y = __builtin_amdgcn_exp2f(b.y);
        S0[2 * i] = a.x; S0[2 * i + 1] = a.y; S1[2 * i] = b.x; S1[2 * i + 1] = b.y; ls2 += a + b; }
    l += ls2.x + ls2.y;
    const bf16x8 P00 = pack8<0>(S0), P01 = pack8<8>(S0), P10 = pack8<0>(S1), P11 = pack8<8>(S1);
    __builtin_amdgcn_sched_barrier(0);
#pragma unroll
    for (int d = 0; d < 2; ++d) { const LAS unsigned char* vb = VB + (32 * d + n) * 144 + 8 * h * 2;
        O[d] = MFMA32(*(const LAS bf16x8*)(vb + 0), P00, O[d]); O[d] = MFMA32(*(const LAS bf16x8*)(vb + 32), P01, O[d]);
        O[d] = MFMA32(*(const LAS bf16x8*)(vb + 64), P10, O[d]); O[d] = MFMA32(*(const LAS bf16x8*)(vb + 96), P11, O[d]); }
}
__device__ __forceinline__ void attn_stage64(LAS unsigned char* lds, const bf16_t* K, const bf16_t* VT, int tid) {
    const int row = tid >> 3, ch = tid & 7;
    const u32x4 kv = *((const u32x4*)K + tid), vv = *(const u32x4*)(VT + (size_t)row * SEQ + ch * 8);
    *(LAS u32x4*)(lds + AT_KB + row * 144 + ch * 16) = kv; *(LAS u32x4*)(lds + AT_VB + row * 144 + ch * 16) = vv;
}
__device__ __forceinline__ void phase_attn_mfma(Frame& F, int layer) {
    const int lane = F.lane, tid = F.tid, n = lane & 31, h = lane >> 5, w = F.wave;
    LAS unsigned char* lds = F.lds; const LAS unsigned char* KB = lds + AT_KB; const LAS unsigned char* VB = lds + AT_VB; volatile LAS unsigned* WUN = (volatile LAS unsigned*)(lds + AT_WUN);
    const bf16_t* QN = (const bf16_t*)(F.ws + WS_Q); const bf16_t* KVb = (const bf16_t*)(F.ws + WS_KV);
    const bf16_t* KC = (const bf16_t*)(F.ws + WS_KC); const bf16_t* VCT = (const bf16_t*)(F.ws + WS_VCT);
    const bf16_t* VST = (const bf16_t*)(F.ws + WS_VST); const bf16_t* VWT = (const bf16_t*)(F.ws + WS_VWT);
    const float* GT = (const float*)(F.ws + WS_GT); bf16_t* MIX = (bf16_t*)(F.ws + WS_MIX);
    float cref;
    { const float gq = fabsf(INP_(I_QG)[layer * 64 + lane]); const float* kg = INP_(I_KG) + layer * 192;
      const float gk = fmaxf(fabsf(kg[lane]), fmaxf(fabsf(kg[64 + lane]), fabsf(kg[128 + lane])));
      const float bound = 1.44269504089f * 8.0f * wave_max(gq) * wave_max(gk); cref = fmaxf(bound - 16.0f, 0.f); }
#pragma nounroll
    for (int ui = 0; ui < 2; ++ui) {
        const int bh = (F.c >> 5) + 8 * ui, tb = ui ? 31 - (F.c & 31) : (F.c & 31);
        if (F.c >= 256) break;
        const int b = bh >> 1, kvh = bh & 1, t0 = tb * 64, cur = tb;
        const int tt = t0 + 8 * w + (n >> 2), hd = n & 3; const size_t r = (size_t)b * SEQ + tt;
        bf16x8 Qf[4]; { const bf16_t* qp = QN + r * 512 + (kvh * 4 + hd) * 64 + 8 * h;
#pragma unroll
            for (int s = 0; s < 4; ++s) Qf[s] = *(const bf16x8*)(qp + 16 * s); }
        {
            float qv[4][8]; float ss = 0.f;
#pragma unroll
            for (int s = 0; s < 4; ++s) { const u32x4 wq = __builtin_bit_cast(u32x4, Qf[s]);
                qv[s][0] = bf_lo(wq.x); qv[s][1] = bf_hi(wq.x); qv[s][2] = bf_lo(wq.y); qv[s][3] = bf_hi(wq.y); qv[s][4] = bf_lo(wq.z); qv[s][5] = bf_hi(wq.z); qv[s][6] = bf_lo(wq.w); qv[s][7] = bf_hi(wq.w);
#pragma unroll
                for (int j = 0; j < 8; ++j) ss += qv[s][j] * qv[s][j]; }
            ss += __shfl_xor(ss, 32);
            const float rsq = rsqf_(ss * (1.0f / 64.0f) + EPS) * (0.125f * 1.44269504089f); const float* qg     = INP_(I_QG) + layer * 64 + 8 * h;
#pragma unroll
            for (int s = 0; s < 4; ++s) { const f32x4 ga = *(const f32x4*)(qg + 16 * s), gb = *(const f32x4*)(qg + 16 * s + 4);
                u32x4 wq; wq.x = pk_bf16(qv[s][0] * rsq * ga.x, qv[s][1] * rsq * ga.y); wq.y = pk_bf16(qv[s][2] * rsq * ga.z, qv[s][3] * rsq * ga.w);
                wq.z = pk_bf16(qv[s][4] * rsq * gb.x, qv[s][5] * rsq * gb.y); wq.w = pk_bf16(qv[s][6] * rsq * gb.z, qv[s][7] * rsq * gb.w); Qf[s] = __builtin_bit_cast(bf16x8, wq); } }
        const float* gp = GT + r * 24 + (kvh * 4 + hd) * 3; const float g0 = sigmoidf_(gp[0]), g1 = sigmoidf_(gp[1]), g2 = sigmoidf_(gp[2]);
        f32x16 Ob[2]; LAS f32x4* OT = (LAS f32x4*)(lds + AT_OT + w * 8192) + lane;
        unsigned tokmask, wmask;
        __syncthreads();
#pragma unroll
        for (int q = 0; q < 2; ++q) { const int i = tid + 512 * q;
            *(LAS u32x4*)(lds + AT_KB + (i >> 3) * 144 + (i & 7) * 16) = *((const u32x4*)(KC + (size_t)bh * 128 * 64) + i);
            *(LAS u32x4*)(lds + AT_VB + (i >> 4) * 272 + (i & 15) * 16) = *((const u32x4*)(VCT + (size_t)bh * 64 * 128) + i); }
        __syncthreads();
        {
            f32x16 S[4];
#pragma unroll
            for (int ta = 0; ta < 4; ++ta) {
#pragma unroll
                for (int i = 0; i < 16; ++i) S[ta][i] = 0.f;
#pragma unroll
                for (int s = 0; s < 4; ++s) S[ta] = MFMA32(*(const LAS bf16x8*)(KB + (32 * ta + n) * 144 + (16 * s + 8 * h) * 2), Qf[s], S[ta]); }
            const int cmax = tt >= 31 ? (((tt - 31) >> 4) > 126 ? 126 : ((tt - 31) >> 4)) : -1, lim = cmax - 4 * h;
            float ls = 0.f;
#pragma unroll
            for (int ta = 0; ta < 4; ++ta)
#pragma unroll
                for (int i = 0; i < 16; ++i) { const float p = (32 * ta + crow_(i) <= lim) ? __builtin_amdgcn_exp2f(S[ta][i] - cref) : 0.f; S[ta][i] = p; ls += p; }
            ls += __shfl_xor(ls, 32);
            const float inv = rcpf_(fmaxf(ls, 1e-30f));
#pragma unroll
            for (int ta = 0; ta < 4; ++ta)
#pragma unroll
                for (int i = 0; i < 16; ++i) S[ta][i] *= inv;
            float sum4[4][4], xs[4][4]; unsigned kk[4][4];
#pragma unroll
            for (int ta = 0; ta < 4; ++ta)
#pragma unroll
                for (int u = 0; u < 4; ++u) { sum4[ta][u] = (S[ta][4 * u] + S[ta][4 * u + 1]) + (S[ta][4 * u + 2] + S[ta][4 * u + 3]); xs[ta][u] = __shfl_xor(S[ta][4 * u + 3], 32); }
            const bf16x8 P0 = pack8<0>(S[0]), P1 = pack8<8>(S[0]), P2 = pack8<0>(S[1]), P3 = pack8<8>(S[1]), P4 = pack8<0>(S[2]), P5 = pack8<8>(S[2]), P6 = pack8<0>(S[3]), P7 = pack8<8>(S[3]);
            __builtin_amdgcn_sched_barrier(0);
#pragma unroll
            for (int ta = 0; ta < 4; ++ta)
#pragma unroll
                for (int u = 0; u < 4; ++u) { const float pv0 = (u > 0) ? xs[ta][u > 0 ? u - 1 : 0] : (ta > 0 ? xs[ta > 0 ? ta - 1 : 0][3] : 0.f);
                    float v = sum4[ta][u] + (h ? xs[ta][u] : pv0); v += __shfl_xor(v, 1); v += __shfl_xor(v, 2);
                    const int G = 8 * ta + 2 * u + h; const bool causal = G <= cur, forced = (G == 0) || (G == cur) || (G == cur - 1);
                    kk[ta][u] = causal ? ((forced ? 0x7f000000u : (__float_as_uint(v) & ~31u)) | (unsigned)(31 - G)) : 0u; }
            __builtin_amdgcn_sched_barrier(0);
#pragma unroll
            for (int d = 0; d < 2; ++d) {
#pragma unroll
                for (int i = 0; i < 16; ++i) Ob[d][i] = 0.f;
                const LAS unsigned char* vb = VB + (32 * d + n) * 272 + 8 * h * 2;
                Ob[d] = MFMA32(*(const LAS bf16x8*)(vb + 0), P0, Ob[d]); Ob[d] = MFMA32(*(const LAS bf16x8*)(vb + 32), P1, Ob[d]);
                Ob[d] = MFMA32(*(const LAS bf16x8*)(vb + 64), P2, Ob[d]); Ob[d] = MFMA32(*(const LAS bf16x8*)(vb + 96), P3, Ob[d]);
                Ob[d] = MFMA32(*(const LAS bf16x8*)(vb + 128), P4, Ob[d]); Ob[d] = MFMA32(*(const LAS bf16x8*)(vb + 160), P5, Ob[d]);
                Ob[d] = MFMA32(*(const LAS bf16x8*)(vb + 192), P6, Ob[d]); Ob[d] = MFMA32(*(const LAS bf16x8*)(vb + 224), P7, Ob[d]);
#pragma unroll
                for (int q = 0; q < 4; ++q) OT[(4 * d + q) * 64] = (f32x4){Ob[d][4 * q] * g0, Ob[d][4 * q + 1] * g0, Ob[d][4 * q + 2] * g0, Ob[d][4 * q + 3] * g0}; }
            __builtin_amdgcn_sched_barrier(0);
            unsigned selbits = 0u;
#pragma unroll
            for (int rd = 0; rd < 8; ++rd) { unsigned mk = 0u;
#pragma unroll
                for (int ta = 0; ta < 4; ++ta)
#pragma unroll
                    for (int u = 0; u < 4; ++u) mk = kk[ta][u] > mk ? kk[ta][u] : mk;
                { const unsigned o = (unsigned)__shfl_xor((int)mk, 32); mk = o > mk ? o : mk; }
#pragma unroll
                for (int ta = 0; ta < 4; ++ta)
#pragma unroll
                    for (int u = 0; u < 4; ++u) { const bool hit = (kk[ta][u] == mk) && (mk != 0u); selbits |= hit ? ((1u << (8 * ta + 2 * u)) << h) : 0u; kk[ta][u] = hit ? 0u : kk[ta][u]; } }
            tokmask = selbits | (unsigned)__shfl_xor((int)selbits, 32);
            unsigned wm = tokmask; wm |= (unsigned)__shfl_xor((int)wm, 4); wm |= (unsigned)__shfl_xor((int)wm, 8); wm |= (unsigned)__shfl_xor((int)wm, 16);
            wmask = (unsigned)__builtin_amdgcn_readfirstlane((int)wm);
            if (lane == 0) WUN[w] = wmask;
        }
        __syncthreads();
        unsigned uall = 0u;
#pragma unroll
        for (int q = 0; q < 8; ++q) uall |= WUN[q];
        uall = (unsigned)__builtin_amdgcn_readfirstlane((int)uall);
        if (PROBE_MASK & 0x6000000u) { if (lane == 0) ((unsigned*)(F.ws + WS_SLOT + 3 * MAXSLOT * 4))[(blockIdx.x * 2 + ui) * 8 + w] = (unsigned)__builtin_popcount(uall) | ((unsigned)__builtin_popcount(wmask) << 8); }
        float l = 0.f;
#pragma unroll
        for (int d = 0; d < 2; ++d)
#pragma unroll
            for (int i = 0; i < 16; ++i) Ob[d][i] = 0.f;
        const int j0 = cur > 8 ? cur - 8 : 0, nwin = cur - j0 + 1, ntile = nwin + __builtin_popcount(uall);
        const int srow = tid >> 3, sch = tid & 7;
        int lidx = 0, cidx = 0; unsigned lmm = uall, cmm = uall; u32x4 rk0, rv0, rk1, rv1, rk2, rv2;
#define AT_NEXT(idx, mm, wh, jj) do { if ((idx) < nwin) { (wh) = 1; (jj) = j0 + (idx); } else { (wh) = 0; (jj) = (mm) ? __builtin_ctz(mm) : 0; (mm) &= (mm) - 1u; } ++(idx); } while (0)
#define AT_LOAD(rk, rv) do { int _wh, _jj; AT_NEXT(lidx, lmm, _wh, _jj); const bf16_t* _kp = KVb + (size_t)(_wh ? 4 : 2) * KVT + ((size_t)bh * SEQ + _jj * 64) * 64; const bf16_t* _vp = (_wh ? VWT : VST) + (size_t)bh * 64 * SEQ + _jj * 64; \
        rk = *((const u32x4*)_kp + tid); rv = *(const u32x4*)(_vp + (size_t)srow * SEQ + sch * 8); } while (0)
#define AT_WRITE(b, rk, rv) do { *(LAS u32x4*)(lds + (b) * 18432 + srow * 144 + sch * 16) = rk; *(LAS u32x4*)(lds + (b) * 18432 + 9216 + srow * 144 + sch * 16) = rv; } while (0)
        AT_LOAD(rk0, rv0); AT_LOAD(rk1, rv1); AT_LOAD(rk2, rv2);
        AT_WRITE(0, rk0, rv0);
        AT_LOAD(rk0, rv0);
#define AT_STEP(i, RK, RV) do { asm volatile("s_waitcnt lgkmcnt(0)" ::: "memory"); __builtin_amdgcn_s_barrier(); asm volatile("" ::: "memory"); \
            AT_WRITE(((i) + 1) & 1, RK, RV); AT_LOAD(RK, RV); \
            int wh, j; AT_NEXT(cidx, cmm, wh, j); \
            if (i == nwin) { \
                const float lt = l + __shfl_xor(l, 32), sc = g2 * rcpf_(fmaxf(lt, 1e-30f)); \
_Pragma("unroll") \
                for (int d = 0; d < 2; ++d) \
_Pragma("unroll") \
                    for (int q = 0; q < 4; ++q) { f32x4 o = OT[(4 * d + q) * 64]; o.x += Ob[d][4 * q] * sc; o.y += Ob[d][4 * q + 1] * sc; o.z += Ob[d][4 * q + 2] * sc; o.w += Ob[d][4 * q + 3] * sc; OT[(4 * d + q) * 64] = o; \
                        Ob[d][4 * q] = 0.f; Ob[d][4 * q + 1] = 0.f; Ob[d][4 * q + 2] = 0.f; Ob[d][4 * q + 3] = 0.f; } \
                l = 0.f; } \
            const LAS unsigned char* kb = lds + (i & 1) * 18432; const LAS unsigned char* vb = kb + 9216; \
            const int tl = tt - 64 * j - 4 * h; \
            if (wh) { if (j == cur || j == cur - 8) attn_tile<2>(kb, vb, Qf, Ob, cref, l, tl, j == cur - 8 ? tl - 512 : -100000, true, n, h); else attn_tile<0>(kb, vb, Qf, Ob, cref, l, 0, 0, true, n, h); } \
            else if ((wmask >> j) & 1u) { const bool rowok = ((tokmask >> j) & 1u) != 0u; \
                if (j == cur) attn_tile<2>(kb, vb, Qf, Ob, cref, l, rowok ? tl : -1, -100000, true, n, h); else attn_tile<1>(kb, vb, Qf, Ob, cref, l, 0, 0, rowok, n, h); } \
        } while (0)
#pragma nounroll
        for (int i = 0; i < ntile; i += 3) { AT_STEP(i, rk1, rv1); if (i + 1 >= ntile) break; AT_STEP(i + 1, rk2, rv2); if (i + 2 >= ntile) break; AT_STEP(i + 2, rk0, rv0); }
#undef AT_STEP
#undef AT_NEXT
#undef AT_LOAD
#undef AT_WRITE
        { const float lt = l + __shfl_xor(l, 32), sc = g1 * rcpf_(fmaxf(lt, 1e-30f));
          bf16_t* op = MIX + r * D + 512 + (kvh * 4 + hd) * 64 + 4 * h;
#pragma unroll
          for (int d = 0; d < 2; ++d)
#pragma unroll
            for (int u = 0; u < 4; ++u) { const f32x4 o = OT[(4 * d + u) * 64]; u32x2 ov; ov.x = pk_bf16(o.x + Ob[d][4 * u] * sc, o.y + Ob[d][4 * u + 1] * sc); ov.y = pk_bf16(o.z + Ob[d][4 * u + 2] * sc, o.w + Ob[d][4 * u + 3] * sc);
                *(u32x2*)(op + 32 * d + 8 * u) = ov; } }
    }
}

__device__ __forceinline__ int build_ptab(Frame& F) {
    LAS int* ptab = (LAS int*)(F.lds + PTAB_OFF);
    const unsigned* cnt = (const unsigned*)(F.ws + WS_CTL) + CW_CNT;
    if (F.tid < 64) {
        const int e = F.tid; const unsigned c = (e < NE) ? __hip_atomic_load(cnt + 64 * e, __ATOMIC_RELAXED, __HIP_MEMORY_SCOPE_AGENT) : 0u;
        const int n = (int)((c + 255u) >> 8); int incl = n;
#pragma unroll
        for (int o = 1; o < 8; o <<= 1) { const int t = __shfl_up(incl, o); if (e >= o) incl += t; }
        const int excl = incl - n;
        if (e < NE) { ptab[MAXPAN + 8 + e] = excl * 256; for (int i = 0; i < n && excl + i < MAXPAN; ++i) ptab[excl + i] = e; }
        if (e == NE - 1) ptab[MAXPAN] = incl < MAXPAN ? incl : MAXPAN; }
    __syncthreads();
    return ptab[MAXPAN];
}

template <unsigned KM> __global__ void __launch_bounds__(NTHR, 2) fwd(Args args) {
    extern __shared__ __attribute__((aligned(16))) unsigned char lds_raw[];
    Frame F; F.lds = (LAS unsigned char*)lds_raw; F.tid = threadIdx.x; F.lane = F.tid & 63; F.wave = __builtin_amdgcn_readfirstlane(F.tid >> 6);
    F.G = gridDim.x; F.c = blockIdx.x; F.in = args.in; F.out = args.out; F.ws = args.ws;
    volatile LAS unsigned* MISC = (volatile LAS unsigned*)(F.lds + MISC_OFF);
    if (F.tid < 64) MISC[F.tid] = 0u;
    __syncthreads();
    unsigned* ctl = (unsigned*)(F.ws + WS_CTL);
#if MK_PER_PHASE
#define SEAM() do {} while (0)
#else
    XcdBarrier bar = xcd_barrier_post(ctl + CW_BAR, MISC);
#define SEAM() xcd_barrier(bar)
#endif
    const int lo = args.ph_lo, hi = args.ph_hi;
#define KON(kind) (((KM) >> (kind)) & 1u)
#define IN(k) (lo <= (k) && (k) < hi)
#define gw (F.c * NWAVES + F.wave)
#define NGW (F.G * NWAVES)
#define XB ((bf16_t*)(F.ws + WS_XB))
#define RS ((float*)(F.ws + WS_RSTD))

    if (KON(0) && IN(0)) { FRESH_TID(F); PMARK(0); phase_prologue(F); SEAM(); }

    for (int layer = 0; layer < 2; ++layer) {
        const int pb = 1 + 12 * layer;
        if (KON(1) && IN(pb + 0)) { FRESH_TID(F); PMARK(pb + 0);
            pg8::Gemm g{XB, (const bf16_t*)(F.ws + WS_WIN) + (size_t)layer * INP * D, D, D, D}; pg8::SchedGrid S; S.init(M / 256, INP / 256, F.G, F.c, D, D);
            EpiIn E{RS, (bf16_t*)(F.ws + WS_U), (bf16_t*)(F.ws + WS_Q), (bf16_t*)(F.ws + WS_KV), (float*)(F.ws + WS_GT), layer ? (const float*)(F.ws + WS_PSS) : nullptr, (LAS float*)(F.lds + RSL_OFF)};
            pg8::gemm_phase(F.lds, g, S, E); moe_conv_slot(F, layer == 0 ? 0 : 2); SEAM();
        }
        if (KON(2) && IN(pb + 1)) { FRESH_TID(F); PMARK(pb + 1);
            { pg8::Gemm g{(const bf16_t*)(F.ws + WS_KV), (const bf16_t*)(F.ws + WS_WC1), 256, 1024, 2048}; SchedCmp S{F.G, F.c, layer};
              EpiH1 E{(float*)(F.ws + WS_H1)}; pg8::gemm_phase(F.lds, g, S, E); }
            if (F.G >= 256) { if (F.c >= 128) vtrans_items(F, (F.c - 128) * NWAVES + F.wave, (F.G - 128) * NWAVES); }
            else vtrans_items(F, gw, NGW);
#ifdef ATTN_REF
            norm_rows64((bf16_t*)(F.ws + WS_Q), M * 8, INP_(I_QG) + layer * 64, 0.125f, gw, NGW, F.lane);
#endif
            norm_rows64((bf16_t*)(F.ws + WS_KV) + 2 * KVT, NBH * SEQ, INP_(I_KG) + layer * 192 + 64, 1.0f, gw, NGW, F.lane);
            norm_rows64((bf16_t*)(F.ws + WS_KV) + 4 * KVT, NBH * SEQ, INP_(I_KG) + layer * 192 + 128, 1.0f, gw, NGW, F.lane);
            SEAM();
        }
        if (KON(3) && IN(pb + 2)) { FRESH_TID(F); PMARK(pb + 2); for (int cu = F.c; cu < 512; cu += F.G) conv_unit(F, layer, cu); PMARK(30); phase_cmp2(F, layer); SEAM(); }
#ifndef ATTN_REF
        if (KON(4) && IN(pb + 3)) { FRESH_TID(F); PMARK(pb + 3); phase_attn_mfma(F, layer); SEAM(); }
#else
        if (KON(4) && IN(pb + 3)) { FRESH_TID(F); PMARK(pb + 3); phase_attn_ref(F, layer); SEAM(); }
#endif
        if (KON(5) && IN(pb + 4)) { FRESH_TID(F); PMARK(pb + 4);
            pg8::Gemm g{(const bf16_t*)(F.ws + WS_MIX), (const bf16_t*)(F.ws + WS_WOUT) + (size_t)layer * D * D, D, D, D}; pg8::SchedGrid S; S.init(M / 256, D / 256, F.G, F.c, D, D);
            { EpiRes<true> E{XB, XB, layer == 0 ? (float*)(F.ws + WS_PSS) : nullptr}; pg8::gemm_phase(F.lds, g, S, E); }
            SEAM();
        }
        if (KON(6) && IN(pb + 5) && layer == 1) { FRESH_TID(F); PMARK(pb + 5);
            f32x4 v[4];
            {
                const float* RT = (const float*)(F.ws + WS_RT); unsigned* cnt = ctl + CW_CNT; int* ROUTE = (int*)(F.ws + WS_ROUTE);
                int* stok = (int*)(F.ws + WS_SLOT);
                const int cb0 = __builtin_amdgcn_readfirstlane((int)blockIdx.x * NTHR);
#pragma nounroll
                for (int i = cb0 + F.tid; i < MAXSLOT; i += F.G * NTHR) stok[i] = -1;
                LAS f32x4* RTL = (LAS f32x4*)F.lds;
                { f32x4 sv[4];
#pragma unroll
                  for (int q = 0; q < 4; ++q) sv[q] = *((const f32x4*)RT + F.tid + q * NTHR);
#pragma unroll
                  for (int q = 0; q < 4; ++q) RTL[F.tid + q * NTHR] = sv[q]; }
                __syncthreads();
#pragma nounroll
                for (int mb = gw; mb < M; mb += 8 * NGW) {
                    int me0 = -1, me1 = -1; float mw0 = 0.f, mw1 = 0.f;
#pragma nounroll
                    for (int i4 = 0; i4 < 8; i4 += 4) {
                        f32x4 xv[4][4];
#pragma unroll
                        for (int q = 0; q < 4; ++q) { const int m = mb + (i4 + q) * NGW; const u32x2* xr = (const u32x2*)(XB + (size_t)(m < M ? m : 0) * D) + F.lane;
#pragma unroll
                            for (int j = 0; j < 4; ++j) { const u32x2 wv = xr[64 * j]; xv[q][j] = (f32x4){bf_lo(wv.x), bf_hi(wv.x), bf_lo(wv.y), bf_hi(wv.y)}; } }
#pragma unroll
                        for (int q = 0; q < 4; ++q) { const int i = i4 + q, m = mb + i * NGW; if (m >= M) break;
                            float ss = 0.f;
#pragma unroll
                            for (int j = 0; j < 4; ++j) ss += (xv[q][j].x * xv[q][j].x + xv[q][j].y * xv[q][j].y) + (xv[q][j].z * xv[q][j].z + xv[q][j].w * xv[q][j].w);
                            const float rs = rsqf_(wave_sum_u(ss) * (1.0f / D) + EPS);
                            if (F.lane == 0) RS[m] = rs;
                            float lg[8];
#pragma unroll
                            for (int e = 0; e < 8; ++e) { float sd = 0.f;
#pragma unroll
                                for (int j = 0; j < 4; ++j) { const f32x4 wv = RTL[e * 256 + 64 * j + F.lane]; sd += (xv[q][j].x * wv.x + xv[q][j].y * wv.y) + (xv[q][j].z * wv.z + xv[q][j].w * wv.w); }
                                lg[e] = wave_sum_u(sd); }
                            int e0 = 0; float l0 = lg[0];
#pragma unroll
                            for (int e = 1; e < 8; ++e) if (lg[e] > l0) { l0 = lg[e]; e0 = e; }
                            int e1 = -1; float l1 = -3.0e38f;
#pragma unroll
                            for (int e = 0; e < 8; ++e) if (e != e0 && lg[e] > l1) { l1 = lg[e]; e1 = e; }
                            const float p1 = __expf((l1 - l0) * rs), w0 = rcpf_(1.0f + p1), w1 = p1 * w0;
                            if (F.lane == i) { me0 = e0; me1 = e1; mw0 = w0; mw1 = w1; } } }
                    int r0 = 0, r1 = 0, c_mine = 0; const unsigned long long low = (1ull << F.lane) - 1ull;
#pragma unroll
                    for (int e = 0; e < 8; ++e) { const unsigned long long b0 = __ballot(me0 == e), b1 = __ballot(me1 == e);
                        if (me0 == e) r0 = __popcll(b0 & low) + __popcll(b1 & low); if (me1 == e) r1 = __popcll(b0 & low) + __popcll(b1 & low);
                        if (F.lane == e) c_mine = __popcll(b0) + __popcll(b1); }
                    int basev = 0; if (F.lane < 8 && c_mine > 0) basev = (int)atomicAdd(cnt + 64 * F.lane, (unsigned)c_mine);
                    const int b0v = __shfl(basev, me0 < 0 ? 0 : me0), b1v = __shfl(basev, me1 < 0 ? 0 : me1);
                    if (me0 >= 0) { const int m = mb + F.lane * NGW; int* rp = ROUTE + (size_t)m * 6; rp[0] = me0; rp[1] = b0v + r0; rp[2] = me1; rp[3] = b1v + r1; rp[4] = __float_as_int(mw0); rp[5] = __float_as_int(mw1); }
                }
            }
            SEAM();
        }
        if (layer == 0) {
            if (KON(7) && IN(pb + 6)) { FRESH_TID(F); PMARK(pb + 6);
                pg8::Gemm g{XB, (const bf16_t*)(F.ws + WS_WF1), D, D, D}; pg8::SchedGrid S; S.init(M / 256, 2 * DFF / 256, F.G, F.c, D, D);
                EpiGlu E{RS, (bf16_t*)(F.ws + WS_ACT), DFF, 0, (const float*)(F.ws + WS_PSS), (LAS float*)(F.lds + RSL_OFF)}; pg8::gemm_phase(F.lds, g, S, E); moe_conv_slot(F, 1); SEAM();
            }
            if (KON(8) && IN(pb + 7)) { FRESH_TID(F); PMARK(pb + 7);
                pg8::Gemm g{(const bf16_t*)(F.ws + WS_ACT), (const bf16_t*)(F.ws + WS_WF2), DFF, DFF, DFF}; pg8::SchedGrid S; S.init(M / 256, D / 256, F.G, F.c, DFF, DFF);
                EpiRes<true> E{XB, XB, (float*)(F.ws + WS_PSS)}; pg8::gemm_phase(F.lds, g, S, E); SEAM();
            }
        } else {
            if (KON(10) && IN(pb + 6)) { FRESH_TID(F); PMARK(pb + 6);
                build_ptab(F); const LAS int* ptab = (const LAS int*)(F.lds + PTAB_OFF);
                const int* ROUTE = (const int*)(F.ws + WS_ROUTE); int* stok = (int*)(F.ws + WS_SLOT); float* sw = (float*)(stok + MAXSLOT); float* srs = sw + MAXSLOT; unsigned char* XS8 = F.ws + WS_XS;
#pragma nounroll
                for (int mb = gw; mb < M; mb += 4 * NGW) {
                    int rt[4][6]; u32x4 ra[4], rb[4];
#pragma unroll
                    for (int q = 0; q < 4; ++q) { const int m = mb + q * NGW < M ? mb + q * NGW : 0; const int* rp = ROUTE + (size_t)m * 6;
#pragma unroll
                        for (int z = 0; z < 6; ++z) rt[q][z] = rp[z];
                        const u32x4* src = (const u32x4*)(XB + (size_t)m * D) + F.lane; ra[q] = src[0]; rb[q] = src[64]; }
#pragma unroll
                    for (int q = 0; q < 4; ++q) { const int m = mb + q * NGW; if (m >= M) break;
#pragma unroll
                        for (int k = 0; k < 2; ++k) { const int e = rt[q][2 * k], pos = rt[q][2 * k + 1], slot = ptab[MAXPAN + 8 + e] + pos; unsigned char* drow = XS8 + (size_t)slot * D + 8 * F.lane;
                            *(u32x2*)drow = pk8_fp8(bf_lo(ra[q].x), bf_hi(ra[q].x), bf_lo(ra[q].y), bf_hi(ra[q].y), bf_lo(ra[q].z), bf_hi(ra[q].z), bf_lo(ra[q].w), bf_hi(ra[q].w));
                            *(u32x2*)(drow + 512) = pk8_fp8(bf_lo(rb[q].x), bf_hi(rb[q].x), bf_lo(rb[q].y), bf_hi(rb[q].y), bf_lo(rb[q].z), bf_hi(rb[q].z), bf_lo(rb[q].w), bf_hi(rb[q].w));
                            if (F.lane == 0) { stok[slot] = m * 2 + k; sw[slot] = __int_as_float(rt[q][4 + k]); srs[slot] = RS[m]; } } } }
                SEAM();
            }
            if (KON(11) && IN(pb + 7)) { FRESH_TID(F); PMARK(pb + 7);
                const int npan = build_ptab(F);
                const int* stok = (const int*)(F.ws + WS_SLOT); const float* srs = (const float*)(stok + 2 * MAXSLOT);
                pg8::Gemm8 g{F.ws + WS_XS, F.ws + WS_WM1, D, D, D}; SchedMoe1F S{F.G, F.c, npan, (const LAS int*)(F.lds + PTAB_OFF)};
                EpiGlu8 E{srs, F.ws + WS_ACTM, DFE, 1.0f / MOE_S1};
                pg8::gemm_phase8(F.lds, g, S, E); SEAM();
            }
            if (KON(12) && IN(pb + 8)) { FRESH_TID(F); PMARK(pb + 8);
                const int npan = build_ptab(F);
                const int* stok = (const int*)(F.ws + WS_SLOT); const float* sw = (const float*)(stok + MAXSLOT);
                pg8::Gemm8 g{F.ws + WS_ACTM, F.ws + WS_WM2, DFE, DFE, DFE}; SchedMoe2F S{F.G, F.c, npan, (const LAS int*)(F.lds + PTAB_OFF)};
                EpiMoe2 E{stok, sw, (bf16_t*)(F.ws + WS_Y0), (bf16_t*)(F.ws + WS_Y1), 0, 1.0f / MOE_S2}; pg8::gemm_phase8(F.lds, g, S, E); SEAM();
            }
            if (KON(13) && IN(pb + 11)) { FRESH_TID(F); PMARK(pb + 11);
                const bf16_t* Y0 = (const bf16_t*)(F.ws + WS_Y0); const bf16_t* Y1 = (const bf16_t*)(F.ws + WS_Y1);
#pragma nounroll
                for (int mb = gw; mb < M; mb += 2 * NGW) { f32x4 x[2][4]; u32x2 ya[2][4], yb[2][4];
#pragma unroll
                    for (int q = 0; q < 2; ++q) { const int m = mb + q * NGW < M ? mb + q * NGW : 0; const u32x2* xr = (const u32x2*)(XB + (size_t)m * D) + F.lane; const u32x2* y0 = (const u32x2*)(Y0 + (size_t)m * D) + F.lane; const u32x2* y1 = (const u32x2*)(Y1 + (size_t)m * D) + F.lane;
#pragma unroll
                        for (int j = 0; j < 4; ++j) { const u32x2 wv = xr[64 * j]; x[q][j] = (f32x4){bf_lo(wv.x), bf_hi(wv.x), bf_lo(wv.y), bf_hi(wv.y)}; ya[q][j] = y0[64 * j]; yb[q][j] = y1[64 * j]; } }
#pragma unroll
                    for (int q = 0; q < 2; ++q) { const int m = mb + q * NGW; if (m >= M) break; f32x4* xr = (f32x4*)(F.out + (size_t)m * D) + F.lane;
#pragma unroll
                        for (int j = 0; j < 4; ++j) { f32x4 o = x[q][j]; const u32x2 a = ya[q][j], b2 = yb[q][j];
                            o.x += bf_lo(a.x) + bf_lo(b2.x); o.y += bf_hi(a.x) + bf_hi(b2.x); o.z += bf_lo(a.y) + bf_lo(b2.y); o.w += bf_hi(a.y) + bf_hi(b2.y); xr[64 * j] = o; } } }
            }
        }
    }
#undef gw
#undef NGW
#undef XB
#undef RS
    PMARK(99);
    if ((PROBE_MASK & 0x6000000u) && blockIdx.x == 0 && threadIdx.x == 0) { const unsigned* st = (const unsigned*)(F.ws + WS_SLOT + 3 * MAXSLOT * 4); unsigned long long tot = 0; for (int i = 0; i < 512 * 8; ++i) { const unsigned v = st[i]; tot += (PROBE_MASK & 0x2000000u) ? (v & 255u) : (v >> 8); }
        *(volatile LAS unsigned long long*)(F.lds + MISC_OFF + 160) += tot * 25ull / 4096ull * 10ull; }
    if (PROBE_MASK != 0u && blockIdx.x == 0 && threadIdx.x == 0) { const unsigned long long acc = *(volatile LAS unsigned long long*)(F.lds + MISC_OFF + 160), t1 = __builtin_amdgcn_s_memrealtime() + 4ull * acc; while (__builtin_amdgcn_s_memrealtime() < t1) __builtin_amdgcn_s_sleep(8); }
#undef IN
}

constexpr int NPHASE = 25;
template <unsigned KM> static bool setup_kernel(int& per_cu) {
    if (hipFuncSetAttribute((const void*)fwd<KM>, hipFuncAttributeMaxDynamicSharedMemorySize, LDS_BYTES) != hipSuccess) return false;
    if (hipOccupancyMaxActiveBlocksPerMultiprocessor(&per_cu, (const void*)fwd<KM>, NTHR, LDS_BYTES) != hipSuccess) per_cu = 0;
    (void)hipGetLastError(); return true;
}
template <unsigned KM> static void launch_kind(int grid, const Args& a, hipStream_t stream) { hipLaunchKernelGGL(fwd<KM>, dim3(grid), dim3(NTHR), LDS_BYTES, stream, a); }
extern "C" void kernel_launch(void* const* d_in, const int* in_sizes, int n_in, void* d_out, int out_size, void* d_ws, size_t ws_size, hipStream_t stream) {
    static int grid = 0;
    if (grid == 0) {
        if (n_in != 28 || in_sizes[0] != M * D || out_size != M * D || ws_size < WS_END) { fprintf(stderr, "kernel_launch: unexpected shapes / workspace (n_in %d, ws %zu, need %zu)\n", n_in, ws_size, (size_t)WS_END); grid = -1; return; }
        int dev = 0, cus = 0, per_cu = 0; bool ok = true;
        if (hipGetDevice(&dev) != hipSuccess || hipDeviceGetAttribute(&cus, hipDeviceAttributeMultiprocessorCount, dev) != hipSuccess) { grid = -1; return; }
#if MK_PER_PHASE
        ok = ok && setup_kernel<1u << 0>(per_cu) && setup_kernel<1u << 1>(per_cu) && setup_kernel<1u << 2>(per_cu) && setup_kernel<1u << 3>(per_cu) && setup_kernel<1u << 4>(per_cu) && setup_kernel<1u << 5>(per_cu) && setup_kernel<1u << 6>(per_cu)
             && setup_kernel<1u << 7>(per_cu) && setup_kernel<1u << 8>(per_cu) && setup_kernel<1u << 9>(per_cu) && setup_kernel<1u << 10>(per_cu) && setup_kernel<1u << 11>(per_cu) && setup_kernel<1u << 12>(per_cu) && setup_kernel<1u << 13>(per_cu);
#else
        ok = ok && setup_kernel<0xffffffffu>(per_cu);
#endif
        if (!ok) { fprintf(stderr, "kernel_launch: hipFuncSetAttribute failed\n"); grid = -1; return; }
        if (per_cu < 1) fprintf(stderr, "kernel_launch: occupancy query says %d\n", per_cu);
        grid = cus;
    }
    if (grid < 0) return;
    (void)hipMemsetAsync((char*)d_ws + WS_CTL, 0, CTL_BYTES, stream);
    Args a{};
    for (int i = 0; i < 28; ++i) a.in[i] = (const float*)d_in[i];
    a.out = (float*)d_out; a.ws = (unsigned char*)d_ws;
#if MK_PER_PHASE
    static const int phases[] = {0, 1, 2, 3, 4, 5, 7, 8, 13, 14, 15, 16, 17, 18, 19, 20, 21, 24};
    static const int kinds[]  = {0, 1, 2, 3, 4, 5, 7, 8,  1,  2,  3,  4,  5,  6, 10, 11, 12, 13};
    for (int i = 0; i < (int)(sizeof(phases) / sizeof(int)); ++i) { a.ph_lo = phases[i]; a.ph_hi = phases[i] + 1;
        switch (kinds[i]) {
            case 0: launch_kind<1u << 0>(grid, a, stream); break; case 1: launch_kind<1u << 1>(grid, a, stream); break; case 2: launch_kind<1u << 2>(grid, a, stream); break;
            case 3: launch_kind<1u << 3>(grid, a, stream); break; case 4: launch_kind<1u << 4>(grid, a, stream); break; case 5: launch_kind<1u << 5>(grid, a, stream); break;
            case 6: launch_kind<1u << 6>(grid, a, stream); break; case 7: launch_kind<1u << 7>(grid, a, stream); break; case 8: launch_kind<1u << 8>(grid, a, stream); break;
            case 9: launch_kind<1u << 9>(grid, a, stream); break; case 10: launch_kind<1u << 10>(grid, a, stream); break; case 11: launch_kind<1u << 11>(grid, a, stream); break;
            case 12: launch_kind<1u << 12>(grid, a, stream); break; default: launch_kind<1u << 13>(grid, a, stream); break; } }
#else
    a.ph_lo = 0; a.ph_hi = NPHASE; launch_kind<0xffffffffu>(grid, a, stream);
#endif
}
```

```cpp
#include <hip/hip_runtime.h>
#include <cstdio>
#include <cstdint>

#ifndef MK_PER_PHASE
#define MK_PER_PHASE 0
#endif

#ifndef PROBE_MASK
#define PROBE_MASK 0u
#endif
#define LAS __attribute__((address_space(3)))
typedef unsigned short bf16_t;
typedef short bf16x8 __attribute__((ext_vector_type(8)));
typedef float f32x4 __attribute__((ext_vector_type(4)));
typedef float f32x2 __attribute__((ext_vector_type(2)));
typedef unsigned u32x4 __attribute__((ext_vector_type(4)));
typedef unsigned u32x2 __attribute__((ext_vector_type(2)));

constexpr int D = 1024, NB = 8, SEQ = 2048, M = NB * SEQ;
constexpr int INW = 2328, INP = 2560;
constexpr int CW = 512, CKW = 31, DH = 64, NKV = 2, NBH = NB * NKV;
constexpr int NCMP = 127, CHID = 256;
constexpr int DFF = 2816, NE = 8, DFE = 3584;
constexpr int MAXPAN = 136, MAXSLOT = MAXPAN * 256, CHUNKP = 72;
constexpr float EPS = 1e-6f;

constexpr size_t MiB = 1u << 20;
constexpr size_t WS_CTL = 0, CTL_BYTES = 2 * MiB;
constexpr size_t WS_H1 = 342 * MiB;
constexpr size_t WS_WIN = 12 * MiB;
constexpr size_t WS_WC1 = 22 * MiB;
constexpr size_t WS_WOUT = 26 * MiB;
constexpr size_t WS_WF1 = 30 * MiB;
constexpr size_t WS_WF2 = 41 * MiB;
constexpr size_t WS_RT = 47 * MiB;
constexpr size_t WS_WM1 = 48 * MiB;
constexpr size_t WS_WM2 = 160 * MiB;
constexpr size_t WS_XB = 216 * MiB;
constexpr size_t WS_RSTD = 248 * MiB;
constexpr size_t WS_GT = WS_RSTD + 65536;
constexpr size_t WS_ROUTE = WS_GT + (size_t)M * 24 * 4;
constexpr size_t WS_PSS = 250 * MiB;
constexpr size_t WS_KC = 251 * MiB;
constexpr size_t WS_VC = WS_KC + 262144;
constexpr size_t WS_VCT = WS_KC + 524288;
constexpr size_t WS_VST = 2 * MiB, WS_VWT = 6 * MiB;
constexpr size_t WS_U = 252 * MiB;
constexpr size_t WS_Q = 268 * MiB;
constexpr size_t WS_KV = 284 * MiB;
constexpr size_t KVT = (size_t)NBH * SEQ * DH;
constexpr size_t WS_MIX = 310 * MiB;
constexpr size_t WS_ACT = 342 * MiB;
constexpr size_t WS_XS = 252 * MiB;
constexpr size_t WS_ACTM = 320 * MiB;
constexpr size_t WS_SLOT = 447 * MiB;
constexpr size_t WS_Y0 = WS_XS, WS_Y1 = 12 * MiB;
constexpr size_t WS_END = 448 * MiB;
constexpr int CW_BAR = 4096;
constexpr int CW_CNT = 8192;
constexpr int CW_B1P = 16384;

__device__ __forceinline__ unsigned cvt_pk_bf16(float lo, float hi) { unsigned r; asm volatile("v_cvt_pk_bf16_f32 %0, %1, %2" : "=v"(r) : "v"(lo), "v"(hi)); return r; }
__device__ __forceinline__ float bf_lo(unsigned v) { return __uint_as_float(v << 16); }
__device__ __forceinline__ float bf_hi(unsigned v) { return __uint_as_float(v & 0xffff0000u); }
__device__ __forceinline__ float bf2f(bf16_t v) { return __uint_as_float((unsigned)v << 16); }
__device__ __forceinline__ float rcpf_(float x) { return __builtin_amdgcn_rcpf(x); }
__device__ __forceinline__ float rsqf_(float x) { return __builtin_amdgcn_rsqf(x); }
__device__ __forceinline__ float sigmoidf_(float x) { return rcpf_(1.0f + __expf(-x)); }
__device__ __forceinline__ float siluf_(float x) { return x * sigmoidf_(x); }
__device__ __forceinline__ float wave_sum(float v) {
#pragma unroll
    for (int o = 1; o < 64; o <<= 1) v += __shfl_xor(v, o);
    return v;
}
#define DPP_ADD(v, ctrl) ((v) + __builtin_bit_cast(float, __builtin_amdgcn_update_dpp(0, __builtin_bit_cast(int, (v)), (ctrl), 0xF, 0xF, true)))
__device__ __forceinline__ float wave_sum_u(float v) {
    v = DPP_ADD(v, 0xB1); v = DPP_ADD(v, 0x4E); v = DPP_ADD(v, 0x124); v = DPP_ADD(v, 0x128);
    const int b = __builtin_bit_cast(int, v);
    return (__builtin_bit_cast(float, __builtin_amdgcn_readlane(b, 0)) + __builtin_bit_cast(float, __builtin_amdgcn_readlane(b, 16))) + (__builtin_bit_cast(float, __builtin_amdgcn_readlane(b, 32)) + __builtin_bit_cast(float, __builtin_amdgcn_readlane(b, 48)));
}
__device__ __forceinline__ float wave_max(float v) {
#pragma unroll
    for (int o = 1; o < 64; o <<= 1) v = fmaxf(v, __shfl_xor(v, o));
    return v;
}
#define LDS_WAIT() asm volatile("s_waitcnt lgkmcnt(0)" ::: "memory")
typedef float f32x16 __attribute__((ext_vector_type(16)));
typedef __bf16 bf16v2 __attribute__((ext_vector_type(2)));
#define MFMA32(a, b, c) __builtin_amdgcn_mfma_f32_32x32x16_bf16((a), (b), (c), 0, 0, 0)
__device__ __forceinline__ unsigned pk_bf16(float lo, float hi) { const f32x2 v = {lo, hi}; return __builtin_bit_cast(unsigned, __builtin_convertvector(v, bf16v2)); }
template <int S8> __device__ __forceinline__ bf16x8 pack8(const f32x16& p) { u32x4 w; w.x = pk_bf16(p[S8], p[S8 + 1]); w.y = pk_bf16(p[S8 + 2], p[S8 + 3]); w.z = pk_bf16(p[S8 + 4], p[S8 + 5]); w.w = pk_bf16(p[S8 + 6], p[S8 + 7]); return __builtin_bit_cast(bf16x8, w); }
__device__ __forceinline__ u32x2 pk8_fp8(float a0, float a1, float a2, float a3, float a4, float a5, float a6, float a7) {
    int w0 = 0, w1 = 0; w0 = __builtin_amdgcn_cvt_pk_fp8_f32(a0, a1, w0, false); w0 = __builtin_amdgcn_cvt_pk_fp8_f32(a2, a3, w0, true);
    w1 = __builtin_amdgcn_cvt_pk_fp8_f32(a4, a5, w1, false); w1 = __builtin_amdgcn_cvt_pk_fp8_f32(a6, a7, w1, true); return (u32x2){(unsigned)w0, (unsigned)w1}; }
__device__ __forceinline__ int swap23(int v) { return (v & ~12) | ((v & 4) << 1) | ((v & 8) >> 1); }

namespace pg8 {
constexpr int BM = 256, BK = 64, HALF = 128, HTB = HALF * BK * 2, STAGE_BYTES = 8 * HTB, NXCD = 8, WGM = 8;
__device__ __forceinline__ int lds_byte(int r, int c) { const int st = (r >> 4) * 2 + (c >> 5), rr = r & 15, cc = c & 31, ob = rr * 64 + cc * 2; return st * 1024 + (ob ^ (((ob >> 9) & 1) << 5)); }
__device__ __forceinline__ void stage_rc(int b, int& R, int& C) { const int st = b / 1024, sb = b % 1024, swz = sb ^ (((sb >> 9) & 1) << 5); R = (st >> 1) * 16 + swz / 64; C = (st & 1) * 32 + (swz % 64) / 2; }
__device__ __forceinline__ int perm32(int rho) { const int n = rho >> 4, i = rho & 15; return 8 * (i >> 2) + 4 * n + (i & 3); }

struct Unit { int pm, pn; size_t aoff, boff; };
struct Gemm { const bf16_t* A; const bf16_t* Bt; int K, lda, ldb; };

struct SchedGrid {
    int nM, nN, nwg, G, c; size_t astr, bstr;
    __device__ __forceinline__ void init(int nM_, int nN_, int G_, int c_, int lda, int ldb) { nM = nM_; nN = nN_; nwg = nM * nN; G = G_; c = c_; astr = (size_t)BM * lda * 2; bstr = (size_t)BM * ldb * 2; }
    __device__ __forceinline__ bool next(int i, Unit& u) const {
        const long L = (long)i * G + c; if (L >= nwg) return false;
        int wgid = (int)L; { const int q = nwg / NXCD, r = nwg % NXCD, xcd = wgid % NXCD, off = wgid / NXCD; wgid = (xcd < r ? xcd * (q + 1) : r * (q + 1) + (xcd - r) * q) + off; }
        const int nig = WGM * nN, gid = wgid / nig, fm = gid * WGM, gsz = (nM - fm) < WGM ? (nM - fm) : WGM;
        u.pm = fm + ((wgid % nig) % gsz); u.pn = (wgid % nig) / gsz; u.aoff = (size_t)u.pm * astr; u.boff = (size_t)u.pn * bstr; return true;
    }
};

template <class Epi, class Sched>
__device__ __forceinline__ void gemm_phase(LAS unsigned char* lds, const Gemm g, const Sched& S, const Epi& E) {
    int tid = threadIdx.x; asm volatile("" : "+v"(tid));
    const int wid = __builtin_amdgcn_readfirstlane(tid >> 6), lane = tid & 63, wr = wid >> 2, wc = wid & 3, fr = lane & 15, fq = lane >> 4;
    const int K = g.K, nt = K / BK;
    unsigned voffA[2], voffB[2];
#pragma unroll
    for (int i = 0; i < 2; ++i) { int R, C; stage_rc(tid * 16 + i * 8192, R, C); const int Rb = Epi::PERM ? ((R & ~31) + perm32(R & 31)) : R;
        voffA[i] = (unsigned)(R * g.lda + C) * 2u; voffB[i] = (unsigned)(Rb * g.ldb + C) * 2u; }
    const size_t kstep = (size_t)(BK * 2);
    const size_t hstepA = (size_t)HALF * g.lda * 2, hstepB = (size_t)HALF * g.ldb * 2;
    const unsigned ldsw = (unsigned)wid * 1024u;
    const int aoff = lds_byte(wr * 64 + fr, fq * 8), boff = lds_byte(wc * 32 + fr, fq * 8);
#define PG8_SA(b, h) (((b) * 2 + (h)) * HTB)
#define PG8_SB(b, h) ((4 + (b) * 2 + (h)) * HTB)
#define PG8_STAGE(bufoff, gbase, voff) do { _Pragma("unroll") for (int _i = 0; _i < 2; ++_i) \
        __builtin_amdgcn_global_load_lds((const unsigned*)((const char*)(gbase) + (voff)[_i]), (LAS unsigned*)(lds + (bufoff) + ldsw + _i * 8192), 16, 0, 0); } while (0)
#define PG8_LDA(dst, b, h) do { _Pragma("unroll") for (int m = 0; m < 4; ++m) _Pragma("unroll") for (int k = 0; k < 2; ++k) dst[m][k] = *(const LAS bf16x8*)(lds + PG8_SA(b, h) + aoff + m * 2048 + k * 1024); } while (0)
#define PG8_LDB(dst, b, h) do { _Pragma("unroll") for (int n = 0; n < 2; ++n) _Pragma("unroll") for (int k = 0; k < 2; ++k) dst[n][k] = *(const LAS bf16x8*)(lds + PG8_SB(b, h) + boff + n * 2048 + k * 1024); } while (0)
#define PG8_MMA(ai, bj, At, Bt) do { __builtin_amdgcn_s_setprio(1); _Pragma("unroll") for (int m = 0; m < 4; ++m) _Pragma("unroll") for (int n = 0; n < 2; ++n) _Pragma("unroll") for (int k = 0; k < 2; ++k) \
        acc[ai][bj][m][n] = __builtin_amdgcn_mfma_f32_16x16x32_bf16(Bt[n][k], At[m][k], acc[ai][bj][m][n], 0, 0, 0); __builtin_amdgcn_s_setprio(0); } while (0)
#define PG8_WAIT_V(n) asm volatile("s_waitcnt vmcnt(" #n ")" ::: "memory")
#define PG8_WAIT_L(n) asm volatile("s_waitcnt lgkmcnt(" #n ")" ::: "memory")
#define PG8_BAR __builtin_amdgcn_s_barrier()
#define PG8_SCHED __builtin_amdgcn_sched_barrier(0)
    Unit cur, nxt; int ui = 0;
    if (!S.next(0, cur)) return;
    f32x4 acc[2][2][4][2];
#pragma unroll
    for (int a = 0; a < 2; ++a)
#pragma unroll
        for (int b = 0; b < 2; ++b)
#pragma unroll
            for (int m = 0; m < 4; ++m)
#pragma unroll
                for (int n = 0; n < 2; ++n) acc[a][b][m][n] = (f32x4){0.f, 0.f, 0.f, 0.f};
    bf16x8 At[4][2], B0[2][2], B1[2][2];
    const char* cA = (const char*)g.A + cur.aoff; const char* cB = (const char*)g.Bt + cur.boff;
    typename Epi::Pre pre; E.prefetch(cur, wr, fr, pre);
    PG8_STAGE(PG8_SB(0, 0), cB, voffB); PG8_STAGE(PG8_SA(0, 0), cA, voffA); PG8_STAGE(PG8_SB(0, 1), cB + hstepB, voffB); PG8_STAGE(PG8_SA(0, 1), cA + hstepA, voffA);
    if (wr == 1) PG8_BAR;
    PG8_WAIT_V(4); PG8_BAR;
    PG8_STAGE(PG8_SB(1, 0), cB + kstep, voffB); PG8_STAGE(PG8_SA(1, 0), cA + kstep, voffA); PG8_STAGE(PG8_SB(1, 1), cB + hstepB + kstep, voffB);
    PG8_WAIT_V(6); PG8_BAR;
    for (;;) {
        const bool has_next = S.next(ui + 1, nxt);
        const char* nA = has_next ? (const char*)g.A + nxt.aoff : cA; const char* nB = has_next ? (const char*)g.Bt + nxt.boff : cB;
#pragma nounroll
        for (int t = 0; t < nt; t += 2) {
            const bool last = (t == nt - 2);
            const char* a1 = cA + (size_t)(t + 1) * kstep;
            const char* a2 = last ? nA : cA + (size_t)(t + 2) * kstep; const char* b2 = last ? nB : cB + (size_t)(t + 2) * kstep;
            const char* a3 = a2 + kstep; const char* b3 = b2 + kstep;
            PG8_LDB(B0, 0, 0); PG8_SCHED; PG8_LDA(At, 0, 0); PG8_STAGE(PG8_SA(1, 1), a1 + hstepA, voffA);
            PG8_WAIT_L(8); PG8_BAR; PG8_WAIT_L(0); PG8_MMA(0, 0, At, B0); PG8_BAR; PG8_SCHED;
            PG8_LDB(B1, 0, 1); PG8_STAGE(PG8_SB(0, 0), b2, voffB);
            PG8_BAR; PG8_WAIT_L(0); PG8_MMA(0, 1, At, B1); PG8_BAR;
            PG8_LDA(At, 0, 1); PG8_STAGE(PG8_SA(0, 0), a2, voffA);
            PG8_BAR; PG8_WAIT_L(0); PG8_MMA(1, 0, At, B0); PG8_BAR; PG8_SCHED;
            PG8_STAGE(PG8_SB(0, 1), b2 + hstepB, voffB);
            PG8_WAIT_V(6); PG8_BAR; PG8_MMA(1, 1, At, B1); PG8_BAR;
            PG8_LDB(B0, 1, 0); PG8_SCHED; PG8_LDA(At, 1, 0); PG8_STAGE(PG8_SA(0, 1), a2 + hstepA, voffA);
            PG8_WAIT_L(8); PG8_BAR; PG8_WAIT_L(0); PG8_MMA(0, 0, At, B0); PG8_BAR; PG8_SCHED;
            PG8_LDB(B1, 1, 1); PG8_STAGE(PG8_SB(1, 0), b3, voffB);
            PG8_BAR; PG8_WAIT_L(0); PG8_MMA(0, 1, At, B1); PG8_BAR;
            PG8_LDA(At, 1, 1); PG8_STAGE(PG8_SA(1, 0), a3, voffA);
            PG8_BAR; PG8_WAIT_L(0); PG8_MMA(1, 0, At, B0); PG8_BAR; PG8_SCHED;
            PG8_STAGE(PG8_SB(1, 1), b3 + hstepB, voffB);
            PG8_WAIT_V(6); PG8_BAR; PG8_MMA(1, 1, At, B1); PG8_BAR;
        }
        E(acc, cur, wr, wc, fr, fq, pre);
        if (!has_next) break;
        E.prefetch(nxt, wr, fr, pre);
#pragma unroll
        for (int a = 0; a < 2; ++a)
#pragma unroll
            for (int b = 0; b < 2; ++b)
#pragma unroll
                for (int m = 0; m < 4; ++m)
#pragma unroll
                    for (int n = 0; n < 2; ++n) acc[a][b][m][n] = (f32x4){0.f, 0.f, 0.f, 0.f};
        cur = nxt; cA = nA; cB = nB; ++ui;
    }
    PG8_WAIT_V(0);
    if (wr == 0) PG8_BAR;
    PG8_BAR;
#undef PG8_SA
#undef PG8_SB
#undef PG8_STAGE
#undef PG8_LDA
#undef PG8_LDB
#undef PG8_MMA
#undef PG8_WAIT_V
#undef PG8_WAIT_L
#undef PG8_BAR
#undef PG8_SCHED
}
struct Gemm8 { const unsigned char* A; const unsigned char* Bt; int K, lda, ldb; };
typedef int i32x4 __attribute__((ext_vector_type(4)));
typedef int i32x8 __attribute__((ext_vector_type(8)));
template <class Epi, class Sched>
__device__ __forceinline__ void gemm_phase8(LAS unsigned char* lds, const Gemm8 g, const Sched& S, const Epi& E) {
    int tid = threadIdx.x; asm volatile("" : "+v"(tid));
    const int wid = __builtin_amdgcn_readfirstlane(tid >> 6), lane = tid & 63, wr = wid >> 2, wc = wid & 3, fr = lane & 15, fq = lane >> 4;
    const int nt = g.K / 128;
    unsigned voffA[2], voffB[2];
#pragma unroll
    for (int i = 0; i < 2; ++i) { int R, C; stage_rc(tid * 16 + i * 8192, R, C); const int Rb = Epi::PERM ? ((R & ~31) + perm32(R & 31)) : R;
        voffA[i] = (unsigned)(R * g.lda + C * 2); voffB[i] = (unsigned)(Rb * g.ldb + C * 2); }
    const size_t kstep = (size_t)(BK * 2);
    const size_t hstepA = (size_t)HALF * g.lda, hstepB = (size_t)HALF * g.ldb;
    const unsigned ldsw = (unsigned)wid * 1024u;
    const int aoff = lds_byte(wr * 64 + fr, fq * 8), boff = lds_byte(wc * 32 + fr, fq * 8);
#define PG8_SA(b, h) (((b) * 2 + (h)) * HTB)
#define PG8_SB(b, h) ((4 + (b) * 2 + (h)) * HTB)
#define PG8_STAGE(bufoff, gbase, voff) do { _Pragma("unroll") for (int _i = 0; _i < 2; ++_i) \
        __builtin_amdgcn_global_load_lds((const unsigned*)((const char*)(gbase) + (voff)[_i]), (LAS unsigned*)(lds + (bufoff) + ldsw + _i * 8192), 16, 0, 0); } while (0)
#define PG8_LDA(dst, b, h) do { _Pragma("unroll") for (int m = 0; m < 4; ++m) { const i32x4 _l = *(const LAS i32x4*)(lds + PG8_SA(b, h) + aoff + m * 2048), _h = *(const LAS i32x4*)(lds + PG8_SA(b, h) + aoff + m * 2048 + 1024); dst[m] = __builtin_shufflevector(_l, _h, 0, 1, 2, 3, 4, 5, 6, 7); } } while (0)
#define PG8_LDB(dst, b, h) do { _Pragma("unroll") for (int n = 0; n < 2; ++n) { const i32x4 _l = *(const LAS i32x4*)(lds + PG8_SB(b, h) + boff + n * 2048), _h = *(const LAS i32x4*)(lds + PG8_SB(b, h) + boff + n * 2048 + 1024); dst[n] = __builtin_shufflevector(_l, _h, 0, 1, 2, 3, 4, 5, 6, 7); } } while (0)
#define PG8_MMA(ai, bj, At, Bt) do { __builtin_amdgcn_s_setprio(1); _Pragma("unroll") for (int m = 0; m < 4; ++m) _Pragma("unroll") for (int n = 0; n < 2; ++n) \
        asm volatile("v_mfma_f32_16x16x128_f8f6f4 %0, %1, %2, %0" : "+v"(acc[ai][bj][m][n]) : "v"(Bt[n]), "v"(At[m])); __builtin_amdgcn_s_setprio(0); } while (0)
#define PG8_WAIT_V(n) asm volatile("s_waitcnt vmcnt(" #n ")" ::: "memory")
#define PG8_WAIT_L(n) asm volatile("s_waitcnt lgkmcnt(" #n ")" ::: "memory")
#define PG8_BAR __builtin_amdgcn_s_barrier()
#define PG8_SCHED __builtin_amdgcn_sched_barrier(0)
    Unit cur, nxt; int ui = 0;
    if (!S.next(0, cur)) return;
    f32x4 acc[2][2][4][2];
#pragma unroll
    for (int a = 0; a < 2; ++a)
#pragma unroll
        for (int b = 0; b < 2; ++b)
#pragma unroll
            for (int m = 0; m < 4; ++m)
#pragma unroll
                for (int n = 0; n < 2; ++n) acc[a][b][m][n] = (f32x4){0.f, 0.f, 0.f, 0.f};
    i32x8 At[4], B0[2], B1[2];
    const char* cA = (const char*)g.A + cur.aoff; const char* cB = (const char*)g.Bt + cur.boff;
    typename Epi::Pre pre; E.prefetch(cur, wr, fr, pre);
    PG8_STAGE(PG8_SB(0, 0), cB, voffB); PG8_STAGE(PG8_SA(0, 0), cA, voffA); PG8_STAGE(PG8_SB(0, 1), cB + hstepB, voffB); PG8_STAGE(PG8_SA(0, 1), cA + hstepA, voffA);
    if (wr == 1) PG8_BAR;
    PG8_WAIT_V(4); PG8_BAR;
    PG8_STAGE(PG8_SB(1, 0), cB + kstep, voffB); PG8_STAGE(PG8_SA(1, 0), cA + kstep, voffA); PG8_STAGE(PG8_SB(1, 1), cB + hstepB + kstep, voffB);
    PG8_WAIT_V(6); PG8_BAR;
    for (;;) {
        const bool has_next = S.next(ui + 1, nxt);
        const char* nA = has_next ? (const char*)g.A + nxt.aoff : cA; const char* nB = has_next ? (const char*)g.Bt + nxt.boff : cB;
#pragma nounroll
        for (int t = 0; t < nt; t += 2) {
            const bool last = (t == nt - 2);
            const char* a1 = cA + (size_t)(t + 1) * kstep;
            const char* a2 = last ? nA : cA + (size_t)(t + 2) * kstep; const char* b2 = last ? nB : cB + (size_t)(t + 2) * kstep;
            const char* a3 = a2 + kstep; const char* b3 = b2 + kstep;
            PG8_LDB(B0, 0, 0); PG8_SCHED; PG8_LDA(At, 0, 0); PG8_STAGE(PG8_SA(1, 1), a1 + hstepA, voffA);
            PG8_WAIT_L(8); PG8_BAR; PG8_WAIT_L(0); PG8_MMA(0, 0, At, B0); PG8_BAR; PG8_SCHED;
            PG8_LDB(B1, 0, 1); PG8_STAGE(PG8_SB(0, 0), b2, voffB);
            PG8_BAR; PG8_WAIT_L(0); PG8_MMA(0, 1, At, B1); PG8_BAR;
            PG8_LDA(At, 0, 1); PG8_STAGE(PG8_SA(0, 0), a2, voffA);
            PG8_BAR; PG8_WAIT_L(0); PG8_MMA(1, 0, At, B0); PG8_BAR; PG8_SCHED;
            PG8_STAGE(PG8_SB(0, 1), b2 + hstepB, voffB);
            PG8_WAIT_V(6); PG8_BAR; PG8_MMA(1, 1, At, B1); PG8_BAR;
            PG8_LDB(B0, 1, 0); PG8_SCHED; PG8_LDA(At, 1, 0); PG8_STAGE(PG8_SA(0, 1), a2 + hstepA, voffA);
            PG8_WAIT_L(8); PG8_BAR; PG8_WAIT_L(0); PG8_MMA(0, 0, At, B0); PG8_BAR; PG8_SCHED;
            PG8_LDB(B1, 1, 1); PG8_STAGE(PG8_SB(1, 0), b3, voffB);
            PG8_BAR; PG8_WAIT_L(0); PG8_MMA(0, 1, At, B1); PG8_BAR;
            PG8_LDA(At, 1, 1); PG8_STAGE(PG8_SA(1, 0), a3, voffA);
            PG8_BAR; PG8_WAIT_L(0); PG8_MMA(1, 0, At, B0); PG8_BAR; PG8_SCHED;
            PG8_STAGE(PG8_SB(1, 1), b3 + hstepB, voffB);
            PG8_WAIT_V(6); PG8_BAR; PG8_MMA(1, 1, At, B1); PG8_BAR;
        }
        E(acc, cur, wr, wc, fr, fq, pre);
        if (!has_next) break;
        E.prefetch(nxt, wr, fr, pre);
#pragma unroll
        for (int a = 0; a < 2; ++a)
#pragma unroll
            for (int b = 0; b < 2; ++b)
#pragma unroll
                for (int m = 0; m < 4; ++m)
#pragma unroll
                    for (int n = 0; n < 2; ++n) acc[a][b][m][n] = (f32x4){0.f, 0.f, 0.f, 0.f};
        cur = nxt; cA = nA; cB = nB; ++ui;
    }
    PG8_WAIT_V(0);
    if (wr == 0) PG8_BAR;
    PG8_BAR;
#undef PG8_SA
#undef PG8_SB
#undef PG8_STAGE
#undef PG8_LDA
#undef PG8_LDB
#undef PG8_MMA
#undef PG8_WAIT_V
#undef PG8_WAIT_L
#undef PG8_BAR
#undef PG8_SCHED
}
}
using pg8::Unit;

#define XB_TMO      128
#define XB_XCNT(j)  (256  + 64 * (j))
#define XB_XSUB(j)  (1280 + 64 * (j))
#define XB_XGEN(j)  (2304 + 64 * (j))
#define XB_TOP      3328
#define XB_TOPGEN   3392
#define XCD_BAR_WORDS 3456
#define XB_SPIN_CAP (1u << 18)
__device__ __forceinline__ unsigned xb_ld(unsigned* p)              { return __hip_atomic_load(p, __ATOMIC_RELAXED, __HIP_MEMORY_SCOPE_AGENT); }
__device__ __forceinline__ unsigned xb_add(unsigned* p, unsigned v) { return __hip_atomic_fetch_add(p, v, __ATOMIC_RELAXED, __HIP_MEMORY_SCOPE_AGENT); }
__device__ __forceinline__ unsigned xb_xcc_id() { return (unsigned)__builtin_amdgcn_s_getreg((3 << 11) | 20) & 0xFu; }
#define XB_SPIN(cond, bar) do { unsigned _sp = 0; while (cond) { __builtin_amdgcn_s_sleep(1); \
    if ((++_sp & 255u) == 0u) { if (xb_ld(&(bar)[XB_TMO])) break; if (_sp > XB_SPIN_CAP) { atomicAdd(&(bar)[XB_TMO], 1u); break; } } } } while (0)
struct XcdBarrier { unsigned* bar; unsigned x; volatile LAS unsigned* st; };
__device__ __forceinline__ XcdBarrier xcd_barrier_post(unsigned* bar, volatile LAS unsigned* st) {
    XcdBarrier b; b.bar = bar; b.x = xb_xcc_id(); b.st = st;
    if (threadIdx.x == 0) (void)xb_add(&bar[XB_XCNT(b.x)], 1u);
    return b;
}
__device__ __forceinline__ void xcd_barrier_complete(unsigned* bar, unsigned x, unsigned& nloc, unsigned& nx) {
    const unsigned G = gridDim.x * gridDim.y * gridDim.z;
    unsigned sum, cnt, mine, sp = 0u;
    for (;;) {
        sum = 0u; cnt = 0u; mine = 0u;
#pragma unroll
        for (unsigned j = 0; j < 16; ++j) { const unsigned c = xb_ld(&bar[XB_XCNT(j)]); sum += c; cnt += (c > 0u) ? 1u : 0u; mine = (j == x) ? c : mine; }
        if (sum == G) break;
        __builtin_amdgcn_s_sleep(1);
        if ((++sp & 255u) == 0u) { if (xb_ld(&bar[XB_TMO])) break; if (sp > XB_SPIN_CAP) { atomicAdd(&bar[XB_TMO], 1u); break; } }
    }
    nloc = mine > 0u ? mine : 1u; nx = cnt > 0u ? cnt : 1u;
}
__device__ __forceinline__ void xcd_barrier(const XcdBarrier& b) {
    asm volatile("s_waitcnt vmcnt(0)" ::: "memory");
    __syncthreads();
    if (threadIdx.x == 0) {
        unsigned* bar = b.bar;
        __builtin_amdgcn_s_waitcnt(0);
        unsigned nloc = b.st[0], nx = b.st[1];
        if (nloc == 0u) { xcd_barrier_complete(bar, b.x, nloc, nx); b.st[0] = nloc; b.st[1] = nx; }
        const unsigned old = xb_add(&bar[XB_XSUB(b.x)], 1u);
        const unsigned gen = old / nloc;
        if (old + 1u == (gen + 1u) * nloc) {
            __builtin_amdgcn_fence(__ATOMIC_RELEASE, "agent");
            asm volatile("s_waitcnt vmcnt(0)" ::: "memory");
            const unsigned og = xb_add(&bar[XB_TOP], 1u);
            const unsigned tg = og / nx;
            if (og + 1u == (tg + 1u) * nx) xb_add(&bar[XB_TOPGEN], 1u);
            else XB_SPIN(xb_ld(&bar[XB_TOPGEN]) == tg, bar);
            __builtin_amdgcn_fence(__ATOMIC_ACQUIRE, "agent");
            xb_add(&bar[XB_XGEN(b.x)], 1u);
            asm volatile("s_waitcnt vmcnt(0)" ::: "memory");
        } else {
            XB_SPIN(xb_ld(&bar[XB_XGEN(b.x)]) == gen, bar);
            __builtin_amdgcn_fence(__ATOMIC_ACQUIRE, "agent");
            asm volatile("s_waitcnt vmcnt(0)" ::: "memory");
        }
    }
    __syncthreads();
}

constexpr int NWAVES = 8, NTHR = 512;
constexpr int LDS_BYTES = 147456;
constexpr int MISC_OFF = 131072;
constexpr int PTAB_OFF = MISC_OFF + 512;

struct Args { const float* in[28]; float* out; unsigned char* ws; int ph_lo, ph_hi; };

struct Frame {
    LAS unsigned char* lds; int tid, lane, wave, G, c;
    const float* const* in; float* out; unsigned char* ws;
};
#define INP_(i) (F.in[i])
#define FRESH_TID(F) do { int _t = threadIdx.x; asm volatile("" : "+v"(_t)); (F).tid = _t; (F).lane = _t & 63; \
    __attribute__((address_space(1))) unsigned char* _w = (__attribute__((address_space(1))) unsigned char*)args.ws; __attribute__((address_space(1))) float* _o = (__attribute__((address_space(1))) float*)args.out; \
    int _g = gridDim.x; asm volatile("" : "+s"(_w), "+s"(_o), "+s"(_g)); (F).ws = (unsigned char*)_w; (F).out = (float*)_o; (F).G = _g; } while (0)
enum { I_X = 0, I_ANG, I_WIN, I_CDW, I_CDB, I_CLG, I_CLB, I_QG, I_KG, I_PK, I_PV, I_KW1, I_KB1, I_KW2, I_KB2, I_VW1, I_VB1, I_VW2, I_VB2, I_WOUT, I_FNG, I_DW1, I_DW3, I_DW2, I_RW, I_MW1, I_MW3, I_MW2 };

#define PMARK(id) do { if (PROBE_MASK != 0u && blockIdx.x == 0 && threadIdx.x == 0) { volatile LAS unsigned long long* _a = (volatile LAS unsigned long long*)(F.lds + MISC_OFF + 160); volatile LAS unsigned* _o = (volatile LAS unsigned*)(F.lds + MISC_OFF + 168); \
    const unsigned long long _t = __builtin_amdgcn_s_memrealtime(); if (*_o) { *_a += _t; *_o = 0u; } if ((id) < 32 && ((PROBE_MASK >> (id)) & 1u)) { *_a -= _t; *_o = 1u; } } } while (0)
constexpr int RSL_OFF = MISC_OFF + 2048;
__device__ __forceinline__ void rstd_from_partials(const float* pss, int pm, LAS float* tab) {
    int t = threadIdx.x; asm volatile("" : "+v"(t));
    const int row = t >> 1, hf = t & 1;
    const f32x4 a = *(const f32x4*)(pss + (size_t)(pm * 256 + row) * 16 + hf * 8), b = *(const f32x4*)(pss + (size_t)(pm * 256 + row) * 16 + hf * 8 + 4);
    float sq = ((a.x + a.y) + (a.z + a.w)) + ((b.x + b.y) + (b.z + b.w)); sq += __shfl_xor(sq, 1);
    if (hf == 0) tab[row] = rsqf_(sq * (1.0f / D) + EPS);
}
struct EpiIn {
    static constexpr bool PERM = true;
    const float* rstd; bf16_t* U; bf16_t* Q; bf16_t* KV; float* GT; const float* pss; LAS float* rsl;
    struct Pre { int par = 1; };
    __device__ __forceinline__ void prefetch(const Unit& u, int wr, int fr, Pre& p) const {
        p.par ^= 1; LAS float* tab = rsl + p.par * 256;
        if (pss) rstd_from_partials(pss, u.pm, tab); else { int t = threadIdx.x; asm volatile("" : "+v"(t)); if (t < 256) tab[t] = rstd[u.pm * 256 + t]; } }
    __device__ __forceinline__ void operator()(const f32x4 (&acc)[2][2][4][2], const Unit& u, int wr, int wc, int fr, int fq, const Pre& pre) const {
        const int row0 = u.pm * 256 + wr * 64 + fr, cl = wc * 32 + 8 * fq;
        if (u.pn < 4) {
#pragma unroll
            for (int ai = 0; ai < 2; ++ai)
#pragma unroll
                for (int m = 0; m < 4; ++m) { const int r = row0 + ai * 128 + m * 16; const float rs = rsl[pre.par * 256 + wr * 64 + fr + ai * 128 + m * 16];
                    const f32x4 v0 = acc[ai][0][m][0] * rs, v1 = acc[ai][0][m][1] * rs, g0 = acc[ai][1][m][0] * rs, g1 = acc[ai][1][m][1] * rs;
                    u32x4 w; w.x = cvt_pk_bf16(v0[0] * sigmoidf_(g0[0]), v0[1] * sigmoidf_(g0[1])); w.y = cvt_pk_bf16(v0[2] * sigmoidf_(g0[2]), v0[3] * sigmoidf_(g0[3]));
                    w.z = cvt_pk_bf16(v1[0] * sigmoidf_(g1[0]), v1[1] * sigmoidf_(g1[1])); w.w = cvt_pk_bf16(v1[2] * sigmoidf_(g1[2]), v1[3] * sigmoidf_(g1[3]));
                    *(u32x4*)(U + (size_t)r * CW + u.pn * 128 + cl) = w; asm volatile("" ::: "memory"); }
        } else if (u.pn < 6) {
#pragma unroll
            for (int ai = 0; ai < 2; ++ai)
#pragma unroll
                for (int m = 0; m < 4; ++m) { const int r = row0 + ai * 128 + m * 16; const float rs = rsl[pre.par * 256 + wr * 64 + fr + ai * 128 + m * 16];
#pragma unroll
                    for (int bj = 0; bj < 2; ++bj) { const f32x4 v0 = acc[ai][bj][m][0] * rs, v1 = acc[ai][bj][m][1] * rs;
                        u32x4 w; w.x = cvt_pk_bf16(v0[0], v0[1]); w.y = cvt_pk_bf16(v0[2], v0[3]); w.z = cvt_pk_bf16(v1[0], v1[1]); w.w = cvt_pk_bf16(v1[2], v1[3]);
                        *(u32x4*)(Q + (size_t)r * 512 + (u.pn - 4) * 256 + bj * 128 + cl) = w; } asm volatile("" ::: "memory"); }
        } else if (u.pn < 9) {
            const int h = wc >> 1, d0 = 32 * (wc & 1) + 8 * fq;
#pragma unroll
            for (int ai = 0; ai < 2; ++ai)
#pragma unroll
                for (int m = 0; m < 4; ++m) { const int r = row0 + ai * 128 + m * 16; const float rs = rsl[pre.par * 256 + wr * 64 + fr + ai * 128 + m * 16]; const int b = r >> 11, t = r & 2047;
#pragma unroll
                    for (int bj = 0; bj < 2; ++bj) { const int tq = 2 * (u.pn - 6) + bj; const f32x4 v0 = acc[ai][bj][m][0] * rs, v1 = acc[ai][bj][m][1] * rs;
                        u32x4 w; w.x = cvt_pk_bf16(v0[0], v0[1]); w.y = cvt_pk_bf16(v0[2], v0[3]); w.z = cvt_pk_bf16(v1[0], v1[1]); w.w = cvt_pk_bf16(v1[2], v1[3]);
                        *(u32x4*)(KV + (size_t)tq * KVT + ((size_t)(b * 2 + h) * SEQ + t) * DH + d0) = w; } asm volatile("" ::: "memory"); }
        } else {
            if (wc == 0 && fq < 3) {
#pragma unroll
                for (int ai = 0; ai < 2; ++ai)
#pragma unroll
                    for (int m = 0; m < 4; ++m) { const int r = row0 + ai * 128 + m * 16; const float rs = rsl[pre.par * 256 + wr * 64 + fr + ai * 128 + m * 16];
                        *(f32x4*)(GT + (size_t)r * 24 + 8 * fq) = acc[ai][0][m][0] * rs; *(f32x4*)(GT + (size_t)r * 24 + 8 * fq + 4) = acc[ai][0][m][1] * rs; }
            }
        }
    }
};
struct EpiH1 {
    static constexpr bool PERM = false;
    float* H;
    struct Pre {}; __device__ __forceinline__ void prefetch(const Unit&, int, int, Pre&) const {}
    __device__ __forceinline__ void operator()(const f32x4 (&acc)[2][2][4][2], const Unit& u, int wr, int wc, int fr, int fq, const Pre&) const {
        const int row0 = u.pm * 256 + wr * 64 + fr, col0 = wc * 32 + 4 * fq; const int kv = u.pn >> 3, sp = u.pn & 7;
#pragma unroll
        for (int ai = 0; ai < 2; ++ai)
#pragma unroll
            for (int m = 0; m < 4; ++m) { float* rowp = H + (((size_t)sp * 2 + kv) * 2048 + row0 + ai * 128 + m * 16) * 256 + col0;
#pragma unroll
                for (int bj = 0; bj < 2; ++bj)
#pragma unroll
                    for (int n = 0; n < 2; ++n) *(f32x4*)(rowp + bj * 128 + n * 16) = acc[ai][bj][m][n]; }
    }
};
template <bool BF> struct EpiRes {
    static constexpr bool PERM = false;
    const void* base; bf16_t* xb; float* pss;
    struct Pre {}; __device__ __forceinline__ void prefetch(const Unit&, int, int, Pre&) const {}
    __device__ __forceinline__ void operator()(const f32x4 (&acc)[2][2][4][2], const Unit& u, int wr, int wc, int fr, int fq, const Pre&) const {
        const int row0 = u.pm * 256 + wr * 64 + fr, col0 = u.pn * 256 + wc * 32 + 4 * fq;
#pragma unroll
        for (int ai = 0; ai < 2; ++ai) {
            f32x4 bs[4][2][2];
#pragma unroll
            for (int m = 0; m < 4; ++m) { const size_t off = (size_t)(row0 + ai * 128 + m * 16) * D + col0;
#pragma unroll
                for (int bj = 0; bj < 2; ++bj)
#pragma unroll
                    for (int n = 0; n < 2; ++n) {
                        if (BF) { const u32x2 w = *(const u32x2*)((const bf16_t*)base + off + bj * 128 + n * 16); bs[m][bj][n] = (f32x4){bf_lo(w.x), bf_hi(w.x), bf_lo(w.y), bf_hi(w.y)}; }
                        else bs[m][bj][n] = *(const f32x4*)((const float*)base + off + bj * 128 + n * 16); } }
#pragma unroll
            for (int m = 0; m < 4; ++m) { const size_t off = (size_t)(row0 + ai * 128 + m * 16) * D + col0; float ss = 0.f;
#pragma unroll
                for (int bj = 0; bj < 2; ++bj)
#pragma unroll
                    for (int n = 0; n < 2; ++n) { const f32x4 v = bs[m][bj][n] + acc[ai][bj][m][n];
                        u32x2 w; w.x = cvt_pk_bf16(v[0], v[1]); w.y = cvt_pk_bf16(v[2], v[3]); *(u32x2*)(xb + off + bj * 128 + n * 16) = w; ss += (v[0] * v[0] + v[1] * v[1]) + (v[2] * v[2] + v[3] * v[3]); }
                if (pss) { ss += __shfl_xor(ss, 16); ss += __shfl_xor(ss, 32);
                    if (fq == 0) pss[(size_t)(row0 + ai * 128 + m * 16) * 16 + u.pn * 4 + wc] = ss; } } }
    }
};
struct EpiGlu {
    static constexpr bool PERM = true;
    const float* rstd; bf16_t* O; int ldo; int rowbase;
    const float* pss; LAS float* rsl;
    struct Pre { int par = 1; };
    __device__ __forceinline__ void prefetch(const Unit& u, int wr, int fr, Pre& p) const { p.par ^= 1; rstd_from_partials(pss, u.pm, rsl + p.par * 256); }
    __device__ __forceinline__ void operator()(const f32x4 (&acc)[2][2][4][2], const Unit& u, int wr, int wc, int fr, int fq, const Pre& pre) const {
        const int row0 = u.pm * 256 + wr * 64 + fr, cl = u.pn * 128 + wc * 32 + 8 * fq;
#pragma unroll
        for (int ai = 0; ai < 2; ++ai)
#pragma unroll
            for (int m = 0; m < 4; ++m) { const int r = row0 + ai * 128 + m * 16; const float rs = rsl[pre.par * 256 + wr * 64 + fr + ai * 128 + m * 16];
                const f32x4 g0 = acc[ai][0][m][0] * rs, g1 = acc[ai][0][m][1] * rs, u0 = acc[ai][1][m][0] * rs, u1 = acc[ai][1][m][1] * rs;
                u32x4 w; w.x = cvt_pk_bf16(siluf_(g0[0]) * u0[0], siluf_(g0[1]) * u0[1]); w.y = cvt_pk_bf16(siluf_(g0[2]) * u0[2], siluf_(g0[3]) * u0[3]);
                w.z = cvt_pk_bf16(siluf_(g1[0]) * u1[0], siluf_(g1[1]) * u1[1]); w.w = cvt_pk_bf16(siluf_(g1[2]) * u1[2], siluf_(g1[3]) * u1[3]);
                *(u32x4*)(O + (size_t)r * ldo + cl) = w; }
    }
};
struct EpiGlu8 {
    static constexpr bool PERM = true;
    const float* rstd; unsigned char* O; int ldo; float sc;
    struct Pre { float rs[8]; };
    __device__ __forceinline__ void prefetch(const Unit& u, int wr, int fr, Pre& p) const {
#pragma unroll
        for (int q = 0; q < 8; ++q) p.rs[q] = rstd[u.pm * 256 + wr * 64 + fr + (q >> 2) * 128 + (q & 3) * 16]; }
    __device__ __forceinline__ void operator()(const f32x4 (&acc)[2][2][4][2], const Unit& u, int wr, int wc, int fr, int fq, const Pre& pre) const {
        const int row0 = u.pm * 256 + wr * 64 + fr, cl = u.pn * 128 + wc * 32 + 8 * fq;
#pragma unroll
        for (int ai = 0; ai < 2; ++ai)
#pragma unroll
            for (int m = 0; m < 4; ++m) { const int r = row0 + ai * 128 + m * 16; const float rs = pre.rs[ai * 4 + m] * sc;
                const f32x4 g0 = acc[ai][0][m][0] * rs, g1 = acc[ai][0][m][1] * rs, u0 = acc[ai][1][m][0] * rs, u1 = acc[ai][1][m][1] * rs;
                *(u32x2*)(O + (size_t)r * ldo + cl) = pk8_fp8(siluf_(g0[0]) * u0[0], siluf_(g0[1]) * u0[1], siluf_(g0[2]) * u0[2], siluf_(g0[3]) * u0[3], siluf_(g1[0]) * u1[0], siluf_(g1[1]) * u1[1], siluf_(g1[2]) * u1[2], siluf_(g1[3]) * u1[3]); }
    }
};
struct EpiMoe2 {
    static constexpr bool PERM = true;
    const int* stok; const float* sw; bf16_t* Y0; bf16_t* Y1; int rowbase; float sc;
    struct Pre {}; __device__ __forceinline__ void prefetch(const Unit&, int, int, Pre&) const {}
    __device__ __forceinline__ void operator()(const f32x4 (&acc)[2][2][4][2], const Unit& u, int wr, int wc, int fr, int fq, const Pre&) const {
        const int row0 = u.pm * 256 + wr * 64 + fr, cl = u.pn * 256 + wc * 32 + 8 * fq;
        int tks[8]; float ws[8];
#pragma unroll
        for (int q = 0; q < 8; ++q) { const int r = rowbase + row0 + (q >> 2) * 128 + (q & 3) * 16; tks[q] = stok[r]; ws[q] = sw[r]; }
#pragma unroll
        for (int ai = 0; ai < 2; ++ai)
#pragma unroll
            for (int m = 0; m < 4; ++m) { const int tk = tks[ai * 4 + m]; const float w = ws[ai * 4 + m] * sc;
                if (tk >= 0) { bf16_t* dst = ((tk & 1) ? Y1 : Y0) + (size_t)(tk >> 1) * D + cl;
#pragma unroll
                    for (int bj = 0; bj < 2; ++bj) { const f32x4 v0 = acc[ai][bj][m][0] * w, v1 = acc[ai][bj][m][1] * w;
                        u32x4 o; o.x = cvt_pk_bf16(v0[0], v0[1]); o.y = cvt_pk_bf16(v0[2], v0[3]); o.z = cvt_pk_bf16(v1[0], v1[1]); o.w = cvt_pk_bf16(v1[2], v1[3]);
                        *(u32x4*)(dst + bj * 128) = o; } } }
    }
};

struct SchedCmp {
    int G, c, layer;
    __device__ __forceinline__ bool next(int i, Unit& u) const {
        const int L = i * G + c; if (L >= 128) return false;
        const int kv = L >> 6, pm = (L >> 3) & 7, s = L & 7;
        u.pm = pm; u.pn = kv * 8 + s; u.aoff = ((size_t)kv * KVT + (size_t)pm * 256 * 1024 + s * 256) * 2; u.boff = ((size_t)(layer * 2 + kv) * 256 * 2048 + s * 256) * 2; return true;
    }
};
struct SchedMoe1 {
    int G, c, p0, np; const LAS int* ptab;
    __device__ __forceinline__ bool next(int i, Unit& u) const {
        const int L = i * G + c; if (L >= np * 28) return false;
        const int j = L / np, pl = L % np, e = ptab[p0 + pl];
        u.pm = pl; u.pn = j; u.aoff = (size_t)(p0 + pl) * 256 * 1024 * 2; u.boff = ((size_t)e * 7168 + (size_t)j * 256) * 1024 * 2; return true;
    }
};
struct SchedMoe2 {
    int G, c, p0, np; const LAS int* ptab;
    __device__ __forceinline__ bool next(int i, Unit& u) const {
        const int L = i * G + c; if (L >= np * 4) return false;
        const int j = L / np, pl = L % np, e = ptab[p0 + pl];
        u.pm = pl; u.pn = j; u.aoff = (size_t)pl * 256 * DFE * 2; u.boff = ((size_t)e * 1024 + (size_t)j * 256) * DFE * 2; return true;
    }
};

struct SchedMoe1F {
    int G, c, np; const LAS int* ptab;
    __device__ __forceinline__ bool next(int i, Unit& u) const {
        const int L = i * G + c; if (L >= np * 28) return false;
        const int pl = L / 28, j = L % 28, e = ptab[pl];
        u.pm = pl; u.pn = j; u.aoff = (size_t)pl * 256 * 1024; u.boff = ((size_t)e * 7168 + (size_t)j * 256) * 1024; return true;
    }
};
struct SchedMoe2F {
    int G, c, np; const LAS int* ptab;
    __device__ __forceinline__ bool next(int i, Unit& u) const {
        const int L = i * G + c; if (L >= np * 4) return false;
        const int pl = L >> 2, j = L & 3, e = ptab[pl];
        u.pm = pl; u.pn = j; u.aoff = (size_t)pl * 256 * DFE; u.boff = ((size_t)e * 1024 + (size_t)j * 256) * DFE; return true;
    }
};

struct TwP { const float* W; const float* gv; bf16_t* WT; int ldw, n0, nvalid, k0, ldk, kind, h; float f8sc; };
__device__ __forceinline__ TwP tw_job(int r, const float* W, int ldw, int nblk, int nvalid, bf16_t* WT, int ldk, int kind, int h, const float* gv) {
    TwP P; P.W = W; P.gv = gv; P.WT = WT; P.ldw = ldw; P.n0 = 256 * (r % nblk); P.nvalid = nvalid; P.k0 = 64 * (r / nblk); P.ldk = ldk; P.kind = kind; P.h = h; P.f8sc = 0.f; return P; }
__device__ __forceinline__ void tw_load(const TwP& P, f32x4 (&tv)[8], int wave, int lane) {
    const int n = P.n0 + 4 * lane; const float* src = P.W + (size_t)(P.k0 + 8 * wave) * P.ldw + n;
#pragma unroll
    for (int i = 0; i < 8; ++i) tv[i] = (n < P.nvalid) ? *(const f32x4*)(src + (size_t)i * P.ldw) : (f32x4){0.f, 0.f, 0.f, 0.f};
}
__device__ __forceinline__ void tw_store(const TwP& P, f32x4 (&tv)[8], LAS unsigned char* tile, int wave, int lane) {
    if (P.gv) {
#pragma unroll
        for (int i = 0; i < 8; ++i) tv[i] *= P.gv[P.k0 + 8 * wave + i]; }
    const int ng = P.n0 + 32 * wave; size_t drow;
    if (P.kind == 0) drow = ng;
    else if (P.kind == 1) drow = 256 * (ng / 128) + 128 * P.h + (ng % 128);
    else { if (ng < 512) drow = 256 * (ng / 128) + (ng % 128); else if (ng < 1024) { const int cc = ng - 512; drow = 256 * (cc / 128) + 128 + (cc % 128); } else drow = ng; }
    if (P.f8sc != 0.f) {
        const float sc = P.f8sc;
#pragma unroll
        for (int c = 0; c < 4; ++c) *(LAS u32x2*)(tile + (4 * lane + c) * 80 + 8 * wave) = pk8_fp8(tv[0][c] * sc, tv[1][c] * sc, tv[2][c] * sc, tv[3][c] * sc, tv[4][c] * sc, tv[5][c] * sc, tv[6][c] * sc, tv[7][c] * sc);
        __syncthreads();
#pragma unroll
        for (int j = 0; j < 2; ++j) { const int r = (lane >> 2) + 16 * j, ch = lane & 3;
            *(u32x4*)((unsigned char*)P.WT + (drow + r) * (size_t)P.ldk + P.k0 + 16 * ch) = *(const LAS u32x4*)(tile + (32 * wave + r) * 80 + 16 * ch); }
        __syncthreads();
        return; }
#pragma unroll
    for (int c = 0; c < 4; ++c) { u32x4 o; o.x = cvt_pk_bf16(tv[0][c], tv[1][c]); o.y = cvt_pk_bf16(tv[2][c], tv[3][c]); o.z = cvt_pk_bf16(tv[4][c], tv[5][c]); o.w = cvt_pk_bf16(tv[6][c], tv[7][c]);
        *(LAS u32x4*)(tile + (4 * lane + c) * 144 + 16 * wave) = o; }
    __syncthreads();
#pragma unroll
    for (int j = 0; j < 4; ++j) { const int r = (lane >> 3) + 8 * j, c = lane & 7;
        *(u32x4*)(P.WT + (drow + r) * (size_t)P.ldk + P.k0 + 8 * c) = *(const LAS u32x4*)(tile + (32 * wave + r) * 144 + 16 * c); }
    __syncthreads();
}
#define TW_RUN(NIT, JOB) do { const int _n = (NIT); if (_n > 0) { TwP _pa, _pb; f32x4 _ta[8], _tb[8]; JOB(_pa, 0); tw_load(_pa, _ta, F.wave, F.lane); \
    _Pragma("nounroll") for (int _i = 0; _i < _n; _i += 2) { const bool _h2 = _i + 1 < _n, _h3 = _i + 2 < _n; \
        if (_h2) { JOB(_pb, _i + 1); tw_load(_pb, _tb, F.wave, F.lane); } tw_store(_pa, _ta, F.lds, F.wave, F.lane); if (!_h2) break; \
        if (_h3) { JOB(_pa, _i + 2); tw_load(_pa, _ta, F.wave, F.lane); } tw_store(_pb, _tb, F.lds, F.wave, F.lane); } } } while (0)
__device__ __forceinline__ void xprep_row(const float* xrow, bf16_t* orow, float* rstd_out, int lane, f32x4 (&v)[4]) {
    const f32x4* xr = (const f32x4*)xrow + lane; float s = 0.f;
#pragma unroll
    for (int j = 0; j < 4; ++j) { v[j] = xr[64 * j]; s += (v[j].x * v[j].x + v[j].y * v[j].y) + (v[j].z * v[j].z + v[j].w * v[j].w); }
    const float rstd = rsqf_(wave_sum_u(s) * (1.0f / D) + EPS);
    if (orow) { u32x2* o8 = (u32x2*)orow + lane;
#pragma unroll
        for (int j = 0; j < 4; ++j) { u32x2 w; w.x = cvt_pk_bf16(v[j].x, v[j].y); w.y = cvt_pk_bf16(v[j].z, v[j].w); o8[64 * j] = w; } }
    if (lane == 0) *rstd_out = rstd;
}

constexpr float MOE_S1 = 64.f, MOE_S2 = 128.f;
constexpr int MOE_SLOT_N = 7, MOE_SLOTTED = 3 * 128 * MOE_SLOT_N;
constexpr int MOE_ITEMS = 24 * 224;
__device__ __forceinline__ TwP moe_conv_job(Frame& F, int r) {
    constexpr int J_M1 = 16 * 14, J_M2 = 56 * 4;
    unsigned char* WM1 = F.ws + WS_WM1; unsigned char* WM2 = F.ws + WS_WM2;
    if (r < 16 * J_M1) { const int q = r / J_M1, e = q >> 1, h = q & 1; TwP P = tw_job(r % J_M1, (h ? INP_(I_MW3) : INP_(I_MW1)) + (size_t)e * D * DFE, DFE, 14, DFE, (bf16_t*)(WM1 + (size_t)e * 7168 * D), D, 1, h, INP_(I_FNG) + D); P.f8sc = MOE_S1; return P; }
    r -= 16 * J_M1; const int e = r / J_M2; TwP P = tw_job(r % J_M2, INP_(I_MW2) + (size_t)e * DFE * D, D, 4, D, (bf16_t*)(WM2 + (size_t)e * D * DFE), DFE, 0, 0, nullptr); P.f8sc = MOE_S2; return P;
}
__device__ __forceinline__ void moe_conv_slot(Frame& F, int slot) {
    if (F.G != 256 || F.c < 128) return;
    { int _t = threadIdx.x; asm volatile("" : "+v"(_t)); F.tid = _t; F.lane = _t & 63; }
    int base = slot * 128 * MOE_SLOT_N + ((int)blockIdx.x - 128); asm volatile("" : "+s"(base));
#define MJOB(P, i) P = moe_conv_job(F, base + (i) * 128)
    TW_RUN(MOE_SLOT_N, MJOB);
#undef MJOB
}
__device__ __forceinline__ void xprep_rows4(const float* X, bf16_t* XBo, float* RSo, int m, int ms, int lane) {
    f32x4 v[4][4];
#pragma unroll
    for (int q = 0; q < 4; ++q) { const int mm = m + q * ms; const f32x4* xr = (const f32x4*)(X + (size_t)(mm < M ? mm : 0) * D) + lane;
#pragma unroll
        for (int j = 0; j < 4; ++j) v[q][j] = xr[64 * j]; }
#pragma unroll
    for (int q = 0; q < 4; ++q) { const int mm = m + q * ms; if (mm >= M) break; float s = 0.f;
#pragma unroll
        for (int j = 0; j < 4; ++j) s += (v[q][j].x * v[q][j].x + v[q][j].y * v[q][j].y) + (v[q][j].z * v[q][j].z + v[q][j].w * v[q][j].w);
        const float rstd = rsqf_(wave_sum_u(s) * (1.0f / D) + EPS);
        u32x2* o8 = (u32x2*)(XBo + (size_t)mm * D) + lane;
#pragma unroll
        for (int j = 0; j < 4; ++j) { u32x2 w; w.x = cvt_pk_bf16(v[q][j].x, v[q][j].y); w.y = cvt_pk_bf16(v[q][j].z, v[q][j].w); o8[64 * j] = w; }
        if (lane == 0) RSo[mm] = rstd; }
}
__device__ __forceinline__ void phase_prologue(Frame& F) {
    const int gw = F.c * NWAVES + F.wave, NGW = F.G * NWAVES;
    bf16_t* WIN = (bf16_t*)(F.ws + WS_WIN); bf16_t* WC1 = (bf16_t*)(F.ws + WS_WC1); bf16_t* WOUT = (bf16_t*)(F.ws + WS_WOUT); bf16_t* WF1 = (bf16_t*)(F.ws + WS_WF1); bf16_t* WF2 = (bf16_t*)(F.ws + WS_WF2);
    constexpr int J_IN = 16 * 10, J_C1 = 32, J_OUT = 16 * 4, J_F1 = 16 * 11, J_F2 = 44 * 4;
    constexpr int NSMALL = 2 * J_IN + 4 * J_C1 + 2 * J_OUT + 2 * J_F1 + J_F2;
    const int moe0 = (F.G == 256) ? MOE_SLOTTED : 0; const int nitems = NSMALL + MOE_ITEMS - moe0;
#define P0_JOB(P, i) do { int r = F.c + (i) * F.G; \
        if (r < 2 * J_IN) { const int l = r / J_IN; P = tw_job(r % J_IN, INP_(I_WIN) + (size_t)l * D * INW, INW, 10, INW, WIN + (size_t)l * INP * D, D, 2, 0, INP_(I_ANG) + l * D); break; } r -= 2 * J_IN; \
        if (r < 4 * J_C1) { const int q = r / J_C1, l = q >> 1, kv = q & 1; P = tw_job(r % J_C1, (kv ? INP_(I_VW1) : INP_(I_KW1)) + (size_t)l * 2048 * 256, 256, 1, 256, WC1 + (size_t)(l * 2 + kv) * 256 * 2048, 2048, 0, 0, nullptr); break; } r -= 4 * J_C1; \
        if (r < 2 * J_OUT) { const int l = r / J_OUT; P = tw_job(r % J_OUT, INP_(I_WOUT) + (size_t)l * D * D, D, 4, D, WOUT + (size_t)l * D * D, D, 0, 0, nullptr); break; } r -= 2 * J_OUT; \
        if (r < 2 * J_F1) { const int h = r / J_F1; P = tw_job(r % J_F1, (h ? INP_(I_DW3) : INP_(I_DW1)), DFF, 11, DFF, WF1, D, 1, h, INP_(I_FNG)); break; } r -= 2 * J_F1; \
        if (r < J_F2) { P = tw_job(r, INP_(I_DW2), D, 4, D, WF2, DFF, 0, 0, nullptr); break; } r -= J_F2; \
        P = moe_conv_job(F, r + moe0); } while (0)
    TW_RUN((nitems - F.c + F.G - 1) / F.G, P0_JOB);
#undef P0_JOB
    { float* RT = (float*)(F.ws + WS_RT); const int gt = F.c * NTHR + F.tid; if (gt < 8192) { const int e = gt >> 10, k = gt & 1023; RT[gt] = INP_(I_RW)[k * 8 + e] * INP_(I_FNG)[D + k]; } }
    { float* B1P = (float*)(F.ws + WS_CTL) + CW_B1P; LAS float* ps = (LAS float*)F.lds;
      for (int it = F.c; it < 128; it += F.G) { const int kc = it & 7, jb = (it >> 3) & 3, kv = (it >> 5) & 1, l = it >> 6; const int j = jb * 64 + F.lane, kb = kc * 256 + 32 * F.wave;
          const float* w1 = (kv ? INP_(I_VW1) : INP_(I_KW1)) + (size_t)l * 2048 * 256; const float* pos = (kv ? INP_(I_PV) : INP_(I_PK)) + l * 2048;
          float wv[32];
#pragma unroll
          for (int k = 0; k < 32; ++k) wv[k] = w1[(size_t)(kb + k) * 256 + j];
          float sp = 0.f;
#pragma unroll
          for (int k = 0; k < 32; ++k) sp += pos[kb + k] * wv[k];
          ps[F.wave * 64 + F.lane] = sp;
          __syncthreads();
          if (F.wave == 0) { float t = (kc == 0) ? (kv ? INP_(I_VB1) : INP_(I_KB1))[l * 256 + j] : 0.f;
#pragma unroll
              for (int ww = 0; ww < 8; ++ww) t += ps[ww * 64 + F.lane];
              B1P[kc * 1024 + (l * 2 + kv) * 256 + j] = t; }
          __syncthreads(); } }
    { bf16_t* XB = (bf16_t*)(F.ws + WS_XB); float* RS = (float*)(F.ws + WS_RSTD);
      for (int m = gw; m < M; m += 4 * NGW) xprep_rows4(INP_(I_X), XB, RS, m, NGW, F.lane); }
}

__device__ __forceinline__ void norm_rows64(bf16_t* buf, int nrows, const float* g, float scale, int gw, int NGW, int lane) {
    const int sub = lane & 7; float gv[8];
#pragma unroll
    for (int j = 0; j < 8; ++j) gv[j] = g[sub * 8 + j] * scale;
    for (int it = gw; it < nrows / 8; it += NGW) { u32x4* p = (u32x4*)(buf + ((size_t)it * 8 + (lane >> 3)) * 64) + sub; const u32x4 v = *p;
        float f[8] = {bf_lo(v.x), bf_hi(v.x), bf_lo(v.y), bf_hi(v.y), bf_lo(v.z), bf_hi(v.z), bf_lo(v.w), bf_hi(v.w)}; float s = 0.f;
#pragma unroll
        for (int j = 0; j < 8; ++j) s += f[j] * f[j];
        s += __shfl_xor(s, 1); s += __shfl_xor(s, 2); s += __shfl_xor(s, 4);
        const float rs = rsqf_(s * (1.0f / 64.0f) + EPS);
        u32x4 o; o.x = cvt_pk_bf16(f[0] * rs * gv[0], f[1] * rs * gv[1]); o.y = cvt_pk_bf16(f[2] * rs * gv[2], f[3] * rs * gv[3]); o.z = cvt_pk_bf16(f[4] * rs * gv[4], f[5] * rs * gv[5]); o.w = cvt_pk_bf16(f[6] * rs * gv[6], f[7] * rs * gv[7]);
        *p = o; }
}
__device__ __forceinline__ float sum32_(float v, bool) {
    v = DPP_ADD(v, 0xB1); v = DPP_ADD(v, 0x4E); v = DPP_ADD(v, 0x124); v = DPP_ADD(v, 0x128);
    return v + __shfl_xor(v, 16);
}
__device__ __forceinline__ void conv_unit(Frame& F, int layer, int cu) {
    const int b = cu >> 6, t0 = (cu & 63) * 32; int tid = F.tid; asm volatile("" : "+v"(tid));
    const bf16_t* U = (const bf16_t*)(F.ws + WS_U); bf16_t* MIX = (bf16_t*)(F.ws + WS_MIX);
    LAS u32x4* L4 = (LAS u32x4*)F.lds;
    { u32x4 sv[8];
#pragma unroll
      for (int q = 0; q < 8; ++q) { const int i = tid + q * NTHR, row = i >> 6, ch = i & 63, t = t0 - 30 + row; sv[q] = (u32x4){0u, 0u, 0u, 0u}; if (i < 62 * 64 && t >= 0) sv[q] = *(const u32x4*)(U + (size_t)(b * SEQ + t) * CW + ch * 8); }
#pragma unroll
      for (int q = 0; q < 8; ++q) { const int i = tid + q * NTHR; if (i < 62 * 64) L4[i] = sv[q]; } }
    __syncthreads();
    const int cp = tid & 255, th = tid >> 8; const bool hi = (tid & 32) != 0; const LAS unsigned* LW = (const LAS unsigned*)F.lds;
    f32x2 w[CKW];
#pragma unroll
    for (int k = 0; k < CKW; ++k) w[k] = *(const f32x2*)(INP_(I_CDW) + (size_t)layer * CKW * CW + k * CW + 2 * cp);
    const f32x2 cb = *(const f32x2*)(INP_(I_CDB) + layer * CW + 2 * cp), lg = *(const f32x2*)(INP_(I_CLG) + layer * CW + 2 * cp), lb = *(const f32x2*)(INP_(I_CLB) + layer * CW + 2 * cp);
#pragma nounroll
    for (int hf = 0; hf < 2; ++hf) { const int tl0 = th * 16 + hf * 8;
        f32x2 in[38];
#pragma unroll
        for (int i = 0; i < 38; ++i) { const unsigned v = LW[(tl0 + i) * 256 + cp]; in[i] = (f32x2){bf_lo(v), bf_hi(v)}; }
        f32x2 acc[8];
#pragma unroll
        for (int t = 0; t < 8; ++t) { acc[t] = cb;
#pragma unroll
            for (int k = 0; k < CKW; ++k) acc[t] += w[k] * in[t + k]; }
#pragma unroll
        for (int t = 0; t < 8; ++t) {
            const float s = sum32_(acc[t].x + acc[t].y, hi), q = sum32_(acc[t].x * acc[t].x + acc[t].y * acc[t].y, hi);
            const float mu = s * (1.0f / 64.0f), var = fmaxf(q * (1.0f / 64.0f) - mu * mu, 0.f), rs = rsqf_(var + EPS);
            const float a0 = (acc[t].x - mu) * rs * lg.x + lb.x, a1 = (acc[t].y - mu) * rs * lg.y + lb.y;
            *(unsigned*)(MIX + (size_t)(b * SEQ + t0 + tl0 + t) * D + 2 * cp) = cvt_pk_bf16(siluf_(a0), siluf_(a1)); }
    }
    __syncthreads();
}
__device__ __forceinline__ void vtrans_items(Frame& F, int gw, int NGW) {
    const int lane = F.lane;
    LAS unsigned char* scr = F.lds + F.wave * 9216;
    for (int it = gw; it < 1024; it += NGW) { const int ten = it >> 9, bh = (it >> 5) & 15, kb = it & 31;
        const bf16_t* V = (const bf16_t*)(F.ws + WS_KV) + (size_t)(ten ? 5 : 3) * KVT + ((size_t)bh * SEQ + kb * 64) * 64; bf16_t* VT = (bf16_t*)(F.ws + (ten ? WS_VWT : WS_VST)) + (size_t)bh * 64 * SEQ + kb * 64;
#pragma unroll
        for (int c = 0; c < 8; ++c) *(LAS u32x4*)(scr + lane * 144 + c * 16) = *((const u32x4*)(V + (size_t)lane * 64) + c);
        LDS_WAIT(); __builtin_amdgcn_wave_barrier(); asm volatile("" ::: "memory");
#pragma unroll
        for (int c = 0; c < 8; ++c) { unsigned w[4];
#pragma unroll
            for (int q = 0; q < 4; ++q) { const int v0 = 8 * c + 2 * q, k0 = swap23(v0), k1 = swap23(v0 + 1);
                w[q] = (unsigned)*(const LAS bf16_t*)(scr + k0 * 144 + lane * 2) | ((unsigned)*(const LAS bf16_t*)(scr + k1 * 144 + lane * 2) << 16); }
            *((u32x4*)(VT + (size_t)lane * SEQ) + c) = (u32x4){w[0], w[1], w[2], w[3]}; }
        LDS_WAIT(); __builtin_amdgcn_wave_barrier(); asm volatile("" ::: "memory");
    }
}
__device__ __forceinline__ void phase_cmp2(Frame& F, int layer) {
    const int lane = F.lane, w = F.wave, k0 = 32 * w;
    const float* H1 = (const float*)(F.ws + WS_H1); const float* B1P = (const float*)(F.ws + WS_CTL) + CW_B1P + layer * 512;
    LAS float* part = (LAS float*)F.lds;
#pragma nounroll
    for (int un = F.c; un < 256; un += F.G) { const int kv = un >> 7, R0 = (un & 127) * 16;
        const float* w2 = (kv ? INP_(I_VW2) : INP_(I_KW2)) + (size_t)layer * 16384 + (size_t)k0 * 64 + lane;
        float w2r[32];
#pragma unroll
        for (int j = 0; j < 32; ++j) w2r[j] = w2[j * 64];
        float bsum = 0.f;
#pragma unroll
        for (int sp = 0; sp < 8; ++sp) bsum += B1P[sp * 1024 + kv * 256 + k0 + (lane & 31)];
        float acc[16], hx[16];
        {
            float hp[16][8];
#pragma unroll
            for (int r = 0; r < 16; ++r)
#pragma unroll
                for (int sp = 0; sp < 8; ++sp) hp[r][sp] = H1[((size_t)kv * 2048 + R0 + r) * 256 + k0 + (lane & 31) + (size_t)sp * 2 * 2048 * 256];
#pragma unroll
            for (int r = 0; r < 16; ++r) { float x = 0.f;
#pragma unroll
                for (int sp = 0; sp < 8; ++sp) x += hp[r][sp];
                hx[r] = siluf_(x + bsum); } }
#pragma unroll
        for (int r = 0; r < 16; ++r) { const int hb = __builtin_bit_cast(int, hx[r]); float a = 0.f;
#pragma unroll
            for (int j = 0; j < 32; ++j) a += __builtin_bit_cast(float, __builtin_amdgcn_readlane(hb, j)) * w2r[j];
            acc[r] = a; }
#pragma unroll
        for (int r = 0; r < 16; ++r) part[(w * 16 + r) * 64 + lane] = acc[r];
        __syncthreads();
#pragma unroll
        for (int rr = 0; rr < 2; ++rr) { const int r = 2 * w + rr, R = R0 + r;
            float a = (kv ? INP_(I_VB2) : INP_(I_KB2))[layer * 64 + lane];
#pragma unroll
            for (int ww = 0; ww < 8; ++ww) a += part[(ww * 16 + r) * 64 + lane];
            if ((R & 127) == 127) a = 0.f;
            else if (kv == 0) { const float ms = wave_sum_u(a * a) * (1.0f / 64.0f); a = a * (rsqf_(ms + EPS)) * INP_(I_KG)[layer * 192 + lane]; }
            const bf16_t ab = (bf16_t)(cvt_pk_bf16(a, 0.f) & 0xffffu);
            ((bf16_t*)(F.ws + (kv ? WS_VC : WS_KC)))[(size_t)R * 64 + lane] = ab;
            if (kv) ((bf16_t*)(F.ws + WS_VCT))[((size_t)(R >> 7) * 64 + lane) * 128 + swap23(R & 127)] = ab; }
        __syncthreads();
    }
}

__device__ __forceinline__ void dots4(const bf16_t* krow, const LAS float* qs, float (&s)[4]) {
    s[0] = s[1] = s[2] = s[3] = 0.f;
#pragma nounroll
    for (int c = 0; c < 8; ++c) { const u32x4 v = *((const u32x4*)krow + c);
        const float f[8] = {bf_lo(v.x), bf_hi(v.x), bf_lo(v.y), bf_hi(v.y), bf_lo(v.z), bf_hi(v.z), bf_lo(v.w), bf_hi(v.w)};
#pragma unroll
        for (int h = 0; h < 4; ++h) { const f32x4 q0 = *(const LAS f32x4*)(qs + h * 64 + c * 8), q1 = *(const LAS f32x4*)(qs + h * 64 + c * 8 + 4);
            s[h] += (f[0] * q0.x + f[1] * q0.y) + (f[2] * q0.z + f[3] * q0.w) + (f[4] * q1.x + f[5] * q1.y) + (f[6] * q1.z + f[7] * q1.w); } }
}
__device__ __forceinline__ void softmax_pv(LAS f32x4* sb, const LAS int* kb, int nk, const bf16_t* V, int lane, float (&o)[4]) {
    float m[4] = {-1e30f, -1e30f, -1e30f, -1e30f};
#pragma nounroll
    for (int c = 0; c < nk; ++c) { const f32x4 s = sb[c * 64 + lane]; m[0] = fmaxf(m[0], s.x); m[1] = fmaxf(m[1], s.y); m[2] = fmaxf(m[2], s.z); m[3] = fmaxf(m[3], s.w); }
#pragma unroll
    for (int h = 0; h < 4; ++h) m[h] = wave_max(m[h]);
    float sum[4] = {0.f, 0.f, 0.f, 0.f};
#pragma nounroll
    for (int c = 0; c < nk; ++c) { const f32x4 s = sb[c * 64 + lane]; f32x4 p;
        p.x = s.x > -1e29f ? __expf(s.x - m[0]) : 0.f; p.y = s.y > -1e29f ? __expf(s.y - m[1]) : 0.f; p.z = s.z > -1e29f ? __expf(s.z - m[2]) : 0.f; p.w = s.w > -1e29f ? __expf(s.w - m[3]) : 0.f;
        sum[0] += p.x; sum[1] += p.y; sum[2] += p.z; sum[3] += p.w; sb[c * 64 + lane] = p; }
    float inv[4];
#pragma unroll
    for (int h = 0; h < 4; ++h) inv[h] = rcpf_(fmaxf(wave_sum(sum[h]), 1e-30f));
    LDS_WAIT(); __builtin_amdgcn_wave_barrier(); asm volatile("" ::: "memory");
    o[0] = o[1] = o[2] = o[3] = 0.f;
#pragma nounroll
    for (int c = 0; c < nk; ++c) { const int k0 = kb[c];
#pragma unroll 4
        for (int kk = 0; kk < 64; ++kk) { int key = k0 + kk; key = key < 0 ? 0 : (key > SEQ - 1 ? SEQ - 1 : key);
            const f32x4 p = sb[c * 64 + kk]; const float v = bf2f(V[(size_t)key * 64 + lane]);
            o[0] += p.x * v; o[1] += p.y * v; o[2] += p.z * v; o[3] += p.w * v; } }
#pragma unroll
    for (int h = 0; h < 4; ++h) o[h] *= inv[h];
    __builtin_amdgcn_wave_barrier(); asm volatile("" ::: "memory");
}
__device__ __forceinline__ void phase_attn_ref(Frame& F, int layer) {
    const int lane = F.lane;
    LAS unsigned char* wl = F.lds + F.wave * 12288;
    LAS float* qs = (LAS float*)wl;
    LAS f32x4* pc = (LAS f32x4*)(wl + 1024);
    LAS float* psum = (LAS float*)(wl + 3072);
    LAS int* kbl = (LAS int*)(wl + 3584);
    LAS f32x4* sb = (LAS f32x4*)(wl + 4096);
    const bf16_t* QN = (const bf16_t*)(F.ws + WS_Q); const bf16_t* KVb = (const bf16_t*)(F.ws + WS_KV);
    const bf16_t* KC = (const bf16_t*)(F.ws + WS_KC); const bf16_t* VC = (const bf16_t*)(F.ws + WS_VC);
    const float* GT = (const float*)(F.ws + WS_GT); bf16_t* MIX = (bf16_t*)(F.ws + WS_MIX);
#pragma nounroll
    for (int un = F.c; un < NBH * 64; un += F.G) {
        const int bh = un >> 6, tile = un & 63, b = bh >> 1, kvh = bh & 1;
        const bf16_t* KS = KVb + 2 * KVT + (size_t)bh * SEQ * 64; const bf16_t* VS = KVb + 3 * KVT + (size_t)bh * SEQ * 64;
        const bf16_t* KW = KVb + 4 * KVT + (size_t)bh * SEQ * 64; const bf16_t* VW = KVb + 5 * KVT + (size_t)bh * SEQ * 64;
#pragma nounroll
        for (int ti = 0; ti < 4; ++ti) {
            const int t = tile * 32 + F.wave * 4 + ti, r = b * SEQ + t;
#pragma unroll
            for (int h = 0; h < 4; ++h) qs[h * 64 + lane] = bf2f(QN[(size_t)r * 512 + (kvh * 4 + h) * 64 + lane]);
            LDS_WAIT(); __builtin_amdgcn_wave_barrier(); asm volatile("" ::: "memory");
            float sc[2][4]; bool vc[2];
#pragma unroll
            for (int u = 0; u < 2; ++u) { const int c = lane + 64 * u; vc[u] = (c < NCMP) && (16 * c + 31 <= t);
                if (vc[u]) dots4(KC + ((size_t)bh * 128 + c) * 64, qs, sc[u]); else { sc[u][0] = sc[u][1] = sc[u][2] = sc[u][3] = -1e30f; } }
            float pr[2][4];
#pragma unroll
            for (int h = 0; h < 4; ++h) { const float mx = wave_max(fmaxf(sc[0][h], sc[1][h]));
                pr[0][h] = vc[0] ? __expf(sc[0][h] - mx) : 0.f; pr[1][h] = vc[1] ? __expf(sc[1][h] - mx) : 0.f;
                const float inv = rcpf_(fmaxf(wave_sum(pr[0][h] + pr[1][h]), 1e-30f)); pr[0][h] *= inv; pr[1][h] *= inv; }
#pragma unroll
            for (int u = 0; u < 2; ++u) { pc[lane + 64 * u] = (f32x4){pr[u][0], pr[u][1], pr[u][2], pr[u][3]}; psum[lane + 64 * u] = (pr[u][0] + pr[u][1]) + (pr[u][2] + pr[u][3]); }
            LDS_WAIT(); __builtin_amdgcn_wave_barrier(); asm volatile("" ::: "memory");
            const int j = lane & 31, cur = t >> 6; float imp = 0.f;
#pragma unroll
            for (int cc = -1; cc <= 3; ++cc) { const int c = 4 * j + cc; if (c >= 0 && c < NCMP) imp += psum[c]; }
            const bool causal = (j * 64 <= t), forced = (j == 0) || (j == cur) || (j == cur - 1);
            const float score = causal ? (forced ? imp + 1e4f : imp) : -1e30f;
            int rank = 0;
#pragma unroll
            for (int i = 0; i < 32; ++i) { const float si = __shfl(score, i); rank += (si > score || (si == score && i < j)) ? 1 : 0; }
            const unsigned selmask = (unsigned)__ballot(lane < 32 && rank < 8 && causal);
            float ocmp[4] = {0.f, 0.f, 0.f, 0.f};
            { const int nvc = t >= 31 ? (((t - 31) >> 4) + 1 > NCMP ? NCMP : ((t - 31) >> 4) + 1) : 0;
#pragma unroll 4
              for (int c = 0; c < nvc; ++c) { const f32x4 p = pc[c]; const float v = bf2f(VC[((size_t)bh * 128 + c) * 64 + lane]); ocmp[0] += p.x * v; ocmp[1] += p.y * v; ocmp[2] += p.z * v; ocmp[3] += p.w * v; } }
            __builtin_amdgcn_wave_barrier(); asm volatile("" ::: "memory");
            int nk = 0; float osel[4], owin[4];
#pragma nounroll
            for (unsigned mm = selmask; mm != 0u && nk < 8; mm &= mm - 1u) { const int jj = __builtin_ctz(mm);
                const int key = jj * 64 + lane; float s[4];
                if (key <= t) dots4(KS + (size_t)key * 64, qs, s); else { s[0] = s[1] = s[2] = s[3] = -1e30f; }
                sb[nk * 64 + lane] = (f32x4){s[0], s[1], s[2], s[3]};
                if (lane == 0) kbl[nk] = jj * 64;
                ++nk; }
            LDS_WAIT(); __builtin_amdgcn_wave_barrier(); asm volatile("" ::: "memory");
            softmax_pv(sb, kbl, nk, VS, lane, osel);
            nk = 0;
#pragma nounroll
            for (int ch = 0; ch < 8; ++ch) { const int k0 = t - 511 + 64 * ch; if (k0 + 63 < 0) continue;
                const int key = k0 + lane; float s[4];
                if (key >= 0) dots4(KW + (size_t)key * 64, qs, s); else { s[0] = s[1] = s[2] = s[3] = -1e30f; }
                sb[nk * 64 + lane] = (f32x4){s[0], s[1], s[2], s[3]};
                if (lane == 0) kbl[nk] = k0;
                ++nk; }
            LDS_WAIT(); __builtin_amdgcn_wave_barrier(); asm volatile("" ::: "memory");
            softmax_pv(sb, kbl, nk, VW, lane, owin);
#pragma unroll
            for (int h = 0; h < 4; ++h) { const float* gp = GT + (size_t)r * 24 + (kvh * 4 + h) * 3;
                const float o = sigmoidf_(gp[0]) * ocmp[h] + sigmoidf_(gp[1]) * osel[h] + sigmoidf_(gp[2]) * owin[h];
                MIX[(size_t)r * D + 512 + (kvh * 4 + h) * 64 + lane] = (bf16_t)(cvt_pk_bf16(o, 0.f) & 0xffffu); }
            __builtin_amdgcn_wave_barrier(); asm volatile("" ::: "memory");
        }
    }
}


constexpr int AT_KB = 0, AT_VB = 18432, AT_WUN = 36864, AT_OT = 40960;
__device__ __forceinline__ int crow_(int i) { return (i & 3) + 8 * (i >> 2); }
__device__ __forceinline__ float fmax_(float a, float b) { return __builtin_amdgcn_fmed3f(a, b, __builtin_inff()); }
template <int MODE>
__device__ __forceinline__ void attn_tile(const LAS unsigned char* KB, const LAS unsigned char* VB, const bf16x8 (&Qf)[4], f32x16 (&O)[2], float cref, float& l, int tl, int lo, bool rowok, int n, int h) {
    f32x16 S0, S1;
#pragma unroll
    for (int i = 0; i < 16; ++i) { S0[i] = 0.f; S1[i] = 0.f; }
#pragma unroll
    for (int s = 0; s < 4; ++s) { const bf16x8 k0 = *(const LAS bf16x8*)(KB + n * 144 + (16 * s + 8 * h) * 2), k1 = *(const LAS bf16x8*)(KB + (32 + n) * 144 + (16 * s + 8 * h) * 2);
        S0 = MFMA32(k0, Qf[s], S0); S1 = MFMA32(k1, Qf[s], S1); }
    if (MODE != 0) {
#pragma unroll
        for (int i = 0; i < 16; ++i) { const int c0 = crow_(i), c1 = 32 + crow_(i);
            if (MODE == 1) { S0[i] = rowok ? S0[i] : -1e30f; S1[i] = rowok ? S1[i] : -1e30f; }
            if (MODE == 2) { S0[i] = (c0 <= tl && c0 > lo) ? S0[i] : -1e30f; S1[i] = (c1 <= tl && c1 > lo) ? S1[i] : -1e30f; } } }
    f32x2 ls2 = {0.f, 0.f}; const f32x2 mr2 = {cref, cref};
#pragma unroll
    for (int i = 0; i < 8; ++i) { f32x2 a = (f32x2){S0[2 * i], S0[2 * i + 1]} - mr2, b = (f32x2){S1[2 * i], S1[2 * i + 1]} - mr2;
        a.x = __builtin_amdgcn_exp2f(a.x); a.y = __builtin_amdgcn_exp2f(a.y); b.x = __builtin_amdgcn_exp2f(b.x); b.y = __builtin_amdgcn_exp2f(b.y);
        S0[2 * i] = a.x; S0[2 * i + 1] = a.y; S1[2 * i] = b.x; S1[2 * i + 1] = b.y; ls2 += a + b; }
    l += ls2.x + ls2.y;
    const bf16x8 P00 = pack8<0>(S0), P01 = pack8<8>(S0), P10 = pack8<0>(S1), P11 = pack8<8>(S1);
    __builtin_amdgcn_sched_barrier(0);
#pragma unroll
    for (int d = 0; d < 2; ++d) { const LAS unsigned char* vb = VB + (32 * d + n) * 144 + 8 * h * 2;
        O[d] = MFMA32(*(const LAS bf16x8*)(vb + 0), P00, O[d]); O[d] = MFMA32(*(const LAS bf16x8*)(vb + 32), P01, O[d]);
        O[d] = MFMA32(*(const LAS bf16x8*)(vb + 64), P10, O[d]); O[d] = MFMA32(*(const LAS bf16x8*)(vb + 96), P11, O[d]); }
}
__device__ __forceinline__ void attn_stage64(LAS unsigned char* lds, const bf16_t* K, const bf16_t* VT, int tid) {
    const int row = tid >> 3, ch = tid & 7;
    const u32x4 kv = *((const u32x4*)K + tid), vv = *(const u32x4*)(VT + (size_t)row * SEQ + ch * 8);
    *(LAS u32x4*)(lds + AT_KB + row * 144 + ch * 16) = kv; *(LAS u32x4*)(lds + AT_VB + row * 144 + ch * 16) = vv;
}
__device__ __forceinline__ void phase_attn_mfma(Frame& F, int layer) {
    const int lane = F.lane, tid = F.tid, n = lane & 31, h = lane >> 5, w = F.wave;
    LAS unsigned char* lds = F.lds; const LAS unsigned char* KB = lds + AT_KB; const LAS unsigned char* VB = lds + AT_VB; volatile LAS unsigned* WUN = (volatile LAS unsigned*)(lds + AT_WUN);
    const bf16_t* QN = (const bf16_t*)(F.ws + WS_Q); const bf16_t* KVb = (const bf16_t*)(F.ws + WS_KV);
    const bf16_t* KC = (const bf16_t*)(F.ws + WS_KC); const bf16_t* VCT = (const bf16_t*)(F.ws + WS_VCT);
    const bf16_t* VST = (const bf16_t*)(F.ws + WS_VST); const bf16_t* VWT = (const bf16_t*)(F.ws + WS_VWT);
    const float* GT = (const float*)(F.ws + WS_GT); bf16_t* MIX = (bf16_t*)(F.ws + WS_MIX);
    float cref;
    { const float gq = fabsf(INP_(I_QG)[layer * 64 + lane]); const float* kg = INP_(I_KG) + layer * 192;
      const float gk = fmaxf(fabsf(kg[lane]), fmaxf(fabsf(kg[64 + lane]), fabsf(kg[128 + lane])));
      const float bound = 1.44269504089f * 8.0f * wave_max(gq) * wave_max(gk); cref = fmaxf(bound - 16.0f, 0.f); }
#pragma nounroll
    for (int ui = 0; ui < 2; ++ui) {
        const int bh = (F.c >> 5) + 8 * ui, tb = ui ? 31 - (F.c & 31) : (F.c & 31);
        if (F.c >= 256) break;
        const int b = bh >> 1, kvh = bh & 1, t0 = tb * 64, cur = tb;
        const int tt = t0 + 8 * w + (n >> 2), hd = n & 3; const size_t r = (size_t)b * SEQ + tt;
        bf16x8 Qf[4]; { const bf16_t* qp = QN + r * 512 + (kvh * 4 + hd) * 64 + 8 * h;
#pragma unroll
            for (int s = 0; s < 4; ++s) Qf[s] = *(const bf16x8*)(qp + 16 * s); }
        {
            float qv[4][8]; float ss = 0.f;
#pragma unroll
            for (int s = 0; s < 4; ++s) { const u32x4 wq = __builtin_bit_cast(u32x4, Qf[s]);
                qv[s][0] = bf_lo(wq.x); qv[s][1] = bf_hi(wq.x); qv[s][2] = bf_lo(wq.y); qv[s][3] = bf_hi(wq.y); qv[s][4] = bf_lo(wq.z); qv[s][5] = bf_hi(wq.z); qv[s][6] = bf_lo(wq.w); qv[s][7] = bf_hi(wq.w);
#pragma unroll
                for (int j = 0; j < 8; ++j) ss += qv[s][j] * qv[s][j]; }
            ss += __shfl_xor(ss, 32);
            const float rsq = rsqf_(ss * (1.0f / 64.0f) + EPS) * (0.125f * 1.44269504089f); const float* qg     = INP_(I_QG) + layer * 64 + 8 * h;
#pragma unroll
            for (int s = 0; s < 4; ++s) { const f32x4 ga = *(const f32x4*)(qg + 16 * s), gb = *(const f32x4*)(qg + 16 * s + 4);
                u32x4 wq; wq.x = pk_bf16(qv[s][0] * rsq * ga.x, qv[s][1] * rsq * ga.y); wq.y = pk_bf16(qv[s][2] * rsq * ga.z, qv[s][3] * rsq * ga.w);
                wq.z = pk_bf16(qv[s][4] * rsq * gb.x, qv[s][5] * rsq * gb.y); wq.w = pk_bf16(qv[s][6] * rsq * gb.z, qv[s][7] * rsq * gb.w); Qf[s] = __builtin_bit_cast(bf16x8, wq); } }
        const float* gp = GT + r * 24 + (kvh * 4 + hd) * 3; const float g0 = sigmoidf_(gp[0]), g1 = sigmoidf_(gp[1]), g2 = sigmoidf_(gp[2]);
        f32x16 Ob[2]; LAS f32x4* OT = (LAS f32x4*)(lds + AT_OT + w * 8192) + lane;
        unsigned tokmask, wmask;
        __syncthreads();
#pragma unroll
        for (int q = 0; q < 2; ++q) { const int i = tid + 512 * q;
            *(LAS u32x4*)(lds + AT_KB + (i >> 3) * 144 + (i & 7) * 16) = *((const u32x4*)(KC + (size_t)bh * 128 * 64) + i);
            *(LAS u32x4*)(lds + AT_VB + (i >> 4) * 272 + (i & 15) * 16) = *((const u32x4*)(VCT + (size_t)bh * 64 * 128) + i); }
        __syncthreads();
        {
            f32x16 S[4];
#pragma unroll
            for (int ta = 0; ta < 4; ++ta) {
#pragma unroll
                for (int i = 0; i < 16; ++i) S[ta][i] = 0.f;
#pragma unroll
                for (int s = 0; s < 4; ++s) S[ta] = MFMA32(*(const LAS bf16x8*)(KB + (32 * ta + n) * 144 + (16 * s + 8 * h) * 2), Qf[s], S[ta]); }
            const int cmax = tt >= 31 ? (((tt - 31) >> 4) > 126 ? 126 : ((tt - 31) >> 4)) : -1, lim = cmax - 4 * h;
            float ls = 0.f;
#pragma unroll
            for (int ta = 0; ta < 4; ++ta)
#pragma unroll
                for (int i = 0; i < 16; ++i) { const float p = (32 * ta + crow_(i) <= lim) ? __builtin_amdgcn_exp2f(S[ta][i] - cref) : 0.f; S[ta][i] = p; ls += p; }
            ls += __shfl_xor(ls, 32);
            const float inv = rcpf_(fmaxf(ls, 1e-30f));
#pragma unroll
            for (int ta = 0; ta < 4; ++ta)
#pragma unroll
                for (int i = 0; i < 16; ++i) S[ta][i] *= inv;
            float val[4][4]; unsigned kk[4];
#pragma unroll
            for (int ta = 0; ta < 4; ++ta)
#pragma unroll
                for (int u = 0; u < 4; ++u) { val[ta][u] = (S[ta][4 * u] + S[ta][4 * u + 1]) + (S[ta][4 * u + 2] + S[ta][4 * u + 3]); }
            {   float xs[4][4];
#pragma unroll
                for (int ta = 0; ta < 4; ++ta)
#pragma unroll
                    for (int u = 0; u < 4; ++u) xs[ta][u] = __shfl_xor(S[ta][4 * u + 3], 32);
#pragma unroll
                for (int ta = 0; ta < 4; ++ta)
#pragma unroll
                    for (int u = 0; u < 4; ++u) { const float pv0 = (u > 0) ? xs[ta][u > 0 ? u - 1 : 0] : (ta > 0 ? xs[ta > 0 ? ta - 1 : 0][3] : 0.f); val[ta][u] += (h ? xs[ta][u] : pv0); } }
            const bf16x8 P0 = pack8<0>(S[0]), P1 = pack8<8>(S[0]), P2 = pack8<0>(S[1]), P3 = pack8<8>(S[1]), P4 = pack8<0>(S[2]), P5 = pack8<8>(S[2]), P6 = pack8<0>(S[3]), P7 = pack8<8>(S[3]);
            __builtin_amdgcn_sched_barrier(0);
            const bool b0 = (n & 1) != 0, b1 = (n & 2) != 0; const int hd2 = 2 * (n & 3) + h;
#define DPPF(x, ctrl) __builtin_bit_cast(float, __builtin_amdgcn_update_dpp(0, __builtin_bit_cast(int, (x)), (ctrl), 0xF, 0xF, true))
#define DPPU(x, ctrl) ((unsigned)__builtin_amdgcn_update_dpp(0, (int)(x), (ctrl), 0xF, 0xF, true))
#pragma unroll
            for (int ta = 0; ta < 4; ++ta) {
                const float m0 = b0 ? val[ta][1] : val[ta][0], s0 = b0 ? val[ta][0] : val[ta][1], m1 = b0 ? val[ta][3] : val[ta][2], s1 = b0 ? val[ta][2] : val[ta][3];
                const float r0 = m0 + DPPF(s0, 0xB1), r1 = m1 + DPPF(s1, 0xB1);
                const float mm = b1 ? r1 : r0, ss = b1 ? r0 : r1; const float v = mm + DPPF(ss, 0x4E);
                const int G = 8 * ta + hd2; const bool causal = G <= cur, forced = (G == 0) || (G == cur) || (G == cur - 1);
                kk[ta] = causal ? ((forced ? 0x7f000000u : (__float_as_uint(v) & ~31u)) | (unsigned)(31 - G)) : 0u; }
            __builtin_amdgcn_sched_barrier(0);
#pragma unroll
            for (int d = 0; d < 2; ++d) {
#pragma unroll
                for (int i = 0; i < 16; ++i) Ob[d][i] = 0.f;
                const LAS unsigned char* vb = VB + (32 * d + n) * 272 + 8 * h * 2;
                Ob[d] = MFMA32(*(const LAS bf16x8*)(vb + 0), P0, Ob[d]); Ob[d] = MFMA32(*(const LAS bf16x8*)(vb + 32), P1, Ob[d]);
                Ob[d] = MFMA32(*(const LAS bf16x8*)(vb + 64), P2, Ob[d]); Ob[d] = MFMA32(*(const LAS bf16x8*)(vb + 96), P3, Ob[d]);
                Ob[d] = MFMA32(*(const LAS bf16x8*)(vb + 128), P4, Ob[d]); Ob[d] = MFMA32(*(const LAS bf16x8*)(vb + 160), P5, Ob[d]);
                Ob[d] = MFMA32(*(const LAS bf16x8*)(vb + 192), P6, Ob[d]); Ob[d] = MFMA32(*(const LAS bf16x8*)(vb + 224), P7, Ob[d]);
#pragma unroll
                for (int q = 0; q < 4; ++q) OT[(4 * d + q) * 64] = (f32x4){Ob[d][4 * q] * g0, Ob[d][4 * q + 1] * g0, Ob[d][4 * q + 2] * g0, Ob[d][4 * q + 3] * g0}; }
            __builtin_amdgcn_sched_barrier(0);
            unsigned selbits = 0u;
#pragma unroll
            for (int rd = 0; rd < 8; ++rd) { unsigned mk = kk[0] > kk[1] ? kk[0] : kk[1]; { const unsigned m2 = kk[2] > kk[3] ? kk[2] : kk[3]; mk = m2 > mk ? m2 : mk; }
                { const unsigned o = DPPU(mk, 0xB1); mk = o > mk ? o : mk; } { const unsigned o = DPPU(mk, 0x4E); mk = o > mk ? o : mk; }
                { const unsigned o = (unsigned)__shfl_xor((int)mk, 32); mk = o > mk ? o : mk; }
#pragma unroll
                for (int ta = 0; ta < 4; ++ta) { const bool hit = (kk[ta] == mk) && (mk != 0u); selbits |= hit ? ((1u << (8 * ta)) << hd2) : 0u; kk[ta] = hit ? 0u : kk[ta]; } }
            selbits |= DPPU(selbits, 0xB1); selbits |= DPPU(selbits, 0x4E);
            tokmask = selbits | (unsigned)__shfl_xor((int)selbits, 32);
#undef DPPF
#undef DPPU
            unsigned wm = tokmask; wm |= (unsigned)__shfl_xor((int)wm, 4); wm |= (unsigned)__shfl_xor((int)wm, 8); wm |= (unsigned)__shfl_xor((int)wm, 16);
            wmask = (unsigned)__builtin_amdgcn_readfirstlane((int)wm);
            if (lane == 0) WUN[w] = wmask;
        }
        __syncthreads();
        unsigned uall = 0u;
#pragma unroll
        for (int q = 0; q < 8; ++q) uall |= WUN[q];
        uall = (unsigned)__builtin_amdgcn_readfirstlane((int)uall);
        if (PROBE_MASK & 0x6000000u) { if (lane == 0) ((unsigned*)(F.ws + WS_SLOT + 3 * MAXSLOT * 4))[(blockIdx.x * 2 + ui) * 8 + w] = (unsigned)__builtin_popcount(uall) | ((unsigned)__builtin_popcount(wmask) << 8); }
        float l = 0.f;
#pragma unroll
        for (int d = 0; d < 2; ++d)
#pragma unroll
            for (int i = 0; i < 16; ++i) Ob[d][i] = 0.f;
        const int j0 = cur > 8 ? cur - 8 : 0, nwin = cur - j0 + 1, ntile = nwin + __builtin_popcount(uall);
        const int srow = tid >> 3, sch = tid & 7;
        int lidx = 0, cidx = 0; unsigned lmm = uall, cmm = uall; u32x4 rk0, rv0, rk1, rv1, rk2, rv2;
#define AT_NEXT(idx, mm, wh, jj) do { if ((idx) < nwin) { (wh) = 1; (jj) = j0 + (idx); } else { (wh) = 0; (jj) = (mm) ? __builtin_ctz(mm) : 0; (mm) &= (mm) - 1u; } ++(idx); } while (0)
#define AT_LOAD(rk, rv) do { int _wh, _jj; AT_NEXT(lidx, lmm, _wh, _jj); const bf16_t* _kp = KVb + (size_t)(_wh ? 4 : 2) * KVT + ((size_t)bh * SEQ + _jj * 64) * 64; const bf16_t* _vp = (_wh ? VWT : VST) + (size_t)bh * 64 * SEQ + _jj * 64; \
        rk = *((const u32x4*)_kp + tid); rv = *(const u32x4*)(_vp + (size_t)srow * SEQ + sch * 8); } while (0)
#define AT_WRITE(b, rk, rv) do { *(LAS u32x4*)(lds + (b) * 18432 + srow * 144 + sch * 16) = rk; *(LAS u32x4*)(lds + (b) * 18432 + 9216 + srow * 144 + sch * 16) = rv; } while (0)
        AT_LOAD(rk0, rv0); AT_LOAD(rk1, rv1); AT_LOAD(rk2, rv2);
        AT_WRITE(0, rk0, rv0);
        AT_LOAD(rk0, rv0);
#define AT_STEP(i, RK, RV) do { asm volatile("s_waitcnt lgkmcnt(0)" ::: "memory"); __builtin_amdgcn_s_barrier(); asm volatile("" ::: "memory"); \
            AT_WRITE(((i) + 1) & 1, RK, RV); AT_LOAD(RK, RV); \
            int wh, j; AT_NEXT(cidx, cmm, wh, j); \
            if (i == nwin) { \
                const float lt = l + __shfl_xor(l, 32), sc = g2 * rcpf_(fmaxf(lt, 1e-30f)); \
_Pragma("unroll") \
                for (int d = 0; d < 2; ++d) \
_Pragma("unroll") \
                    for (int q = 0; q < 4; ++q) { f32x4 o = OT[(4 * d + q) * 64]; o.x += Ob[d][4 * q] * sc; o.y += Ob[d][4 * q + 1] * sc; o.z += Ob[d][4 * q + 2] * sc; o.w += Ob[d][4 * q + 3] * sc; OT[(4 * d + q) * 64] = o; \
                        Ob[d][4 * q] = 0.f; Ob[d][4 * q + 1] = 0.f; Ob[d][4 * q + 2] = 0.f; Ob[d][4 * q + 3] = 0.f; } \
                l = 0.f; } \
            const LAS unsigned char* kb = lds + (i & 1) * 18432; const LAS unsigned char* vb = kb + 9216; \
            const int tl = tt - 64 * j - 4 * h; \
            if (wh) { if (j == cur || j == cur - 8) attn_tile<2>(kb, vb, Qf, Ob, cref, l, tl, j == cur - 8 ? tl - 512 : -100000, true, n, h); else attn_tile<0>(kb, vb, Qf, Ob, cref, l, 0, 0, true, n, h); } \
            else if ((wmask >> j) & 1u) { const bool rowok = ((tokmask >> j) & 1u) != 0u; \
                if (j == cur) attn_tile<2>(kb, vb, Qf, Ob, cref, l, rowok ? tl : -1, -100000, true, n, h); else attn_tile<1>(kb, vb, Qf, Ob, cref, l, 0, 0, rowok, n, h); } \
        } while (0)
#pragma nounroll
        for (int i = 0; i < ntile; i += 3) { AT_STEP(i, rk1, rv1); if (i + 1 >= ntile) break; AT_STEP(i + 1, rk2, rv2); if (i + 2 >= ntile) break; AT_STEP(i + 2, rk0, rv0); }
#undef AT_STEP
#undef AT_NEXT
#undef AT_LOAD
#undef AT_WRITE
        { const float lt = l + __shfl_xor(l, 32), sc = g1 * rcpf_(fmaxf(lt, 1e-30f));
          bf16_t* op = MIX + r * D + 512 + (kvh * 4 + hd) * 64 + 4 * h;
#pragma unroll
          for (int d = 0; d < 2; ++d)
#pragma unroll
            for (int u = 0; u < 4; ++u) { const f32x4 o = OT[(4 * d + u) * 64]; u32x2 ov; ov.x = pk_bf16(o.x + Ob[d][4 * u] * sc, o.y + Ob[d][4 * u + 1] * sc); ov.y = pk_bf16(o.z + Ob[d][4 * u + 2] * sc, o.w + Ob[d][4 * u + 3] * sc);
                *(u32x2*)(op + 32 * d + 8 * u) = ov; } }
    }
}

__device__ __forceinline__ int build_ptab(Frame& F) {
    LAS int* ptab = (LAS int*)(F.lds + PTAB_OFF);
    const unsigned* cnt = (const unsigned*)(F.ws + WS_CTL) + CW_CNT;
    if (F.tid < 64) {
        const int e = F.tid; const unsigned c = (e < NE) ? __hip_atomic_load(cnt + 64 * e, __ATOMIC_RELAXED, __HIP_MEMORY_SCOPE_AGENT) : 0u;
        const int n = (int)((c + 255u) >> 8); int incl = n;
#pragma unroll
        for (int o = 1; o < 8; o <<= 1) { const int t = __shfl_up(incl, o); if (e >= o) incl += t; }
        const int excl = incl - n;
        if (e < NE) { ptab[MAXPAN + 8 + e] = excl * 256; for (int i = 0; i < n && excl + i < MAXPAN; ++i) ptab[excl + i] = e; }
        if (e == NE - 1) ptab[MAXPAN] = incl < MAXPAN ? incl : MAXPAN; }
    __syncthreads();
    return ptab[MAXPAN];
}

template <unsigned KM> __global__ void __launch_bounds__(NTHR, 2) fwd(Args args) {
    extern __shared__ __attribute__((aligned(16))) unsigned char lds_raw[];
    Frame F; F.lds = (LAS unsigned char*)lds_raw; F.tid = threadIdx.x; F.lane = F.tid & 63; F.wave = __builtin_amdgcn_readfirstlane(F.tid >> 6);
    F.G = gridDim.x; F.c = blockIdx.x; F.in = args.in; F.out = args.out; F.ws = args.ws;
    volatile LAS unsigned* MISC = (volatile LAS unsigned*)(F.lds + MISC_OFF);
    if (F.tid < 64) MISC[F.tid] = 0u;
    __syncthreads();
    unsigned* ctl = (unsigned*)(F.ws + WS_CTL);
#if MK_PER_PHASE
#define SEAM() do {} while (0)
#else
    XcdBarrier bar = xcd_barrier_post(ctl + CW_BAR, MISC);
#define SEAM() xcd_barrier(bar)
#endif
    const int lo = args.ph_lo, hi = args.ph_hi;
#define KON(kind) (((KM) >> (kind)) & 1u)
#define IN(k) (lo <= (k) && (k) < hi)
#define gw (F.c * NWAVES + F.wave)
#define NGW (F.G * NWAVES)
#define XB ((bf16_t*)(F.ws + WS_XB))
#define RS ((float*)(F.ws + WS_RSTD))

    if (KON(0) && IN(0)) { FRESH_TID(F); PMARK(0); phase_prologue(F); SEAM(); }

    for (int layer = 0; layer < 2; ++layer) {
        const int pb = 1 + 12 * layer;
        if (KON(1) && IN(pb + 0)) { FRESH_TID(F); PMARK(pb + 0);
            pg8::Gemm g{XB, (const bf16_t*)(F.ws + WS_WIN) + (size_t)layer * INP * D, D, D, D}; pg8::SchedGrid S; S.init(M / 256, INP / 256, F.G, F.c, D, D);
            EpiIn E{RS, (bf16_t*)(F.ws + WS_U), (bf16_t*)(F.ws + WS_Q), (bf16_t*)(F.ws + WS_KV), (float*)(F.ws + WS_GT), layer ? (const float*)(F.ws + WS_PSS) : nullptr, (LAS float*)(F.lds + RSL_OFF)};
            pg8::gemm_phase(F.lds, g, S, E); moe_conv_slot(F, layer == 0 ? 0 : 2); SEAM();
        }
        if (KON(2) && IN(pb + 1)) { FRESH_TID(F); PMARK(pb + 1);
            { pg8::Gemm g{(const bf16_t*)(F.ws + WS_KV), (const bf16_t*)(F.ws + WS_WC1), 256, 1024, 2048}; SchedCmp S{F.G, F.c, layer};
              EpiH1 E{(float*)(F.ws + WS_H1)}; pg8::gemm_phase(F.lds, g, S, E); }
            if (F.G >= 256) { if (F.c >= 128) vtrans_items(F, (F.c - 128) * NWAVES + F.wave, (F.G - 128) * NWAVES); }
            else vtrans_items(F, gw, NGW);
#ifdef ATTN_REF
            norm_rows64((bf16_t*)(F.ws + WS_Q), M * 8, INP_(I_QG) + layer * 64, 0.125f, gw, NGW, F.lane);
#endif
            norm_rows64((bf16_t*)(F.ws + WS_KV) + 2 * KVT, NBH * SEQ, INP_(I_KG) + layer * 192 + 64, 1.0f, gw, NGW, F.lane);
            norm_rows64((bf16_t*)(F.ws + WS_KV) + 4 * KVT, NBH * SEQ, INP_(I_KG) + layer * 192 + 128, 1.0f, gw, NGW, F.lane);
            SEAM();
        }
        if (KON(3) && IN(pb + 2)) { FRESH_TID(F); PMARK(pb + 2); for (int cu = F.c; cu < 512; cu += F.G) conv_unit(F, layer, cu); PMARK(30); phase_cmp2(F, layer); SEAM(); }
#ifndef ATTN_REF
        if (KON(4) && IN(pb + 3)) { FRESH_TID(F); PMARK(pb + 3); phase_attn_mfma(F, layer); SEAM(); }
#else
        if (KON(4) && IN(pb + 3)) { FRESH_TID(F); PMARK(pb + 3); phase_attn_ref(F, layer); SEAM(); }
#endif
        if (KON(5) && IN(pb + 4)) { FRESH_TID(F); PMARK(pb + 4);
            pg8::Gemm g{(const bf16_t*)(F.ws + WS_MIX), (const bf16_t*)(F.ws + WS_WOUT) + (size_t)layer * D * D, D, D, D}; pg8::SchedGrid S; S.init(M / 256, D / 256, F.G, F.c, D, D);
            { EpiRes<true> E{XB, XB, layer == 0 ? (float*)(F.ws + WS_PSS) : nullptr}; pg8::gemm_phase(F.lds, g, S, E); }
            SEAM();
        }
        if (KON(6) && IN(pb + 5) && layer == 1) { FRESH_TID(F); PMARK(pb + 5);
            f32x4 v[4];
            {
                const float* RT = (const float*)(F.ws + WS_RT); unsigned* cnt = ctl + CW_CNT; int* ROUTE = (int*)(F.ws + WS_ROUTE);
                int* stok = (int*)(F.ws + WS_SLOT);
                const int cb0 = __builtin_amdgcn_readfirstlane((int)blockIdx.x * NTHR);
#pragma nounroll
                for (int i = cb0 + F.tid; i < MAXSLOT; i += F.G * NTHR) stok[i] = -1;
                LAS f32x4* RTL = (LAS f32x4*)F.lds;
                { f32x4 sv[4];
#pragma unroll
                  for (int q = 0; q < 4; ++q) sv[q] = *((const f32x4*)RT + F.tid + q * NTHR);
#pragma unroll
                  for (int q = 0; q < 4; ++q) RTL[F.tid + q * NTHR] = sv[q]; }
                __syncthreads();
#pragma nounroll
                for (int mb = gw; mb < M; mb += 8 * NGW) {
                    int me0 = -1, me1 = -1; float mw0 = 0.f, mw1 = 0.f;
#pragma nounroll
                    for (int i4 = 0; i4 < 8; i4 += 4) {
                        f32x4 xv[4][4];
#pragma unroll
                        for (int q = 0; q < 4; ++q) { const int m = mb + (i4 + q) * NGW; const u32x2* xr = (const u32x2*)(XB + (size_t)(m < M ? m : 0) * D) + F.lane;
#pragma unroll
                            for (int j = 0; j < 4; ++j) { const u32x2 wv = xr[64 * j]; xv[q][j] = (f32x4){bf_lo(wv.x), bf_hi(wv.x), bf_lo(wv.y), bf_hi(wv.y)}; } }
#pragma unroll
                        for (int q = 0; q < 4; ++q) { const int i = i4 + q, m = mb + i * NGW; if (m >= M) break;
                            float ss = 0.f;
#pragma unroll
                            for (int j = 0; j < 4; ++j) ss += (xv[q][j].x * xv[q][j].x + xv[q][j].y * xv[q][j].y) + (xv[q][j].z * xv[q][j].z + xv[q][j].w * xv[q][j].w);
                            const float rs = rsqf_(wave_sum_u(ss) * (1.0f / D) + EPS);
                            if (F.lane == 0) RS[m] = rs;
                            float lg[8];
#pragma unroll
                            for (int e = 0; e < 8; ++e) { float sd = 0.f;
#pragma unroll
                                for (int j = 0; j < 4; ++j) { const f32x4 wv = RTL[e * 256 + 64 * j + F.lane]; sd += (xv[q][j].x * wv.x + xv[q][j].y * wv.y) + (xv[q][j].z * wv.z + xv[q][j].w * wv.w); }
                                lg[e] = wave_sum_u(sd); }
                            int e0 = 0; float l0 = lg[0];
#pragma unroll
                            for (int e = 1; e < 8; ++e) if (lg[e] > l0) { l0 = lg[e]; e0 = e; }
                            int e1 = -1; float l1 = -3.0e38f;
#pragma unroll
                            for (int e = 0; e < 8; ++e) if (e != e0 && lg[e] > l1) { l1 = lg[e]; e1 = e; }
                            const float p1 = __expf((l1 - l0) * rs), w0 = rcpf_(1.0f + p1), w1 = p1 * w0;
                            if (F.lane == i) { me0 = e0; me1 = e1; mw0 = w0; mw1 = w1; } } }
                    int r0 = 0, r1 = 0, c_mine = 0; const unsigned long long low = (1ull << F.lane) - 1ull;
#pragma unroll
                    for (int e = 0; e < 8; ++e) { const unsigned long long b0 = __ballot(me0 == e), b1 = __ballot(me1 == e);
                        if (me0 == e) r0 = __popcll(b0 & low) + __popcll(b1 & low); if (me1 == e) r1 = __popcll(b0 & low) + __popcll(b1 & low);
                        if (F.lane == e) c_mine = __popcll(b0) + __popcll(b1); }
                    int basev = 0; if (F.lane < 8 && c_mine > 0) basev = (int)atomicAdd(cnt + 64 * F.lane, (unsigned)c_mine);
                    const int b0v = __shfl(basev, me0 < 0 ? 0 : me0), b1v = __shfl(basev, me1 < 0 ? 0 : me1);
                    if (me0 >= 0) { const int m = mb + F.lane * NGW; int* rp = ROUTE + (size_t)m * 6; rp[0] = me0; rp[1] = b0v + r0; rp[2] = me1; rp[3] = b1v + r1; rp[4] = __float_as_int(mw0); rp[5] = __float_as_int(mw1); }
                }
            }
            SEAM();
        }
        if (layer == 0) {
            if (KON(7) && IN(pb + 6)) { FRESH_TID(F); PMARK(pb + 6);
                pg8::Gemm g{XB, (const bf16_t*)(F.ws + WS_WF1), D, D, D}; pg8::SchedGrid S; S.init(M / 256, 2 * DFF / 256, F.G, F.c, D, D);
                EpiGlu E{RS, (bf16_t*)(F.ws + WS_ACT), DFF, 0, (const float*)(F.ws + WS_PSS), (LAS float*)(F.lds + RSL_OFF)}; pg8::gemm_phase(F.lds, g, S, E); moe_conv_slot(F, 1); SEAM();
            }
            if (KON(8) && IN(pb + 7)) { FRESH_TID(F); PMARK(pb + 7);
                pg8::Gemm g{(const bf16_t*)(F.ws + WS_ACT), (const bf16_t*)(F.ws + WS_WF2), DFF, DFF, DFF}; pg8::SchedGrid S; S.init(M / 256, D / 256, F.G, F.c, DFF, DFF);
                EpiRes<true> E{XB, XB, (float*)(F.ws + WS_PSS)}; pg8::gemm_phase(F.lds, g, S, E); SEAM();
            }
        } else {
            if (KON(10) && IN(pb + 6)) { FRESH_TID(F); PMARK(pb + 6);
                build_ptab(F); const LAS int* ptab = (const LAS int*)(F.lds + PTAB_OFF);
                const int* ROUTE = (const int*)(F.ws + WS_ROUTE); int* stok = (int*)(F.ws + WS_SLOT); float* sw = (float*)(stok + MAXSLOT); float* srs = sw + MAXSLOT; unsigned char* XS8 = F.ws + WS_XS;
#pragma nounroll
                for (int mb = gw; mb < M; mb += 4 * NGW) {
                    int rt[4][6]; u32x4 ra[4], rb[4];
#pragma unroll
                    for (int q = 0; q < 4; ++q) { const int m = mb + q * NGW < M ? mb + q * NGW : 0; const int* rp = ROUTE + (size_t)m * 6;
#pragma unroll
                        for (int z = 0; z < 6; ++z) rt[q][z] = rp[z];
                        const u32x4* src = (const u32x4*)(XB + (size_t)m * D) + F.lane; ra[q] = src[0]; rb[q] = src[64]; }
#pragma unroll
                    for (int q = 0; q < 4; ++q) { const int m = mb + q * NGW; if (m >= M) break;
#pragma unroll
                        for (int k = 0; k < 2; ++k) { const int e = rt[q][2 * k], pos = rt[q][2 * k + 1], slot = ptab[MAXPAN + 8 + e] + pos; unsigned char* drow = XS8 + (size_t)slot * D + 8 * F.lane;
                            *(u32x2*)drow = pk8_fp8(bf_lo(ra[q].x), bf_hi(ra[q].x), bf_lo(ra[q].y), bf_hi(ra[q].y), bf_lo(ra[q].z), bf_hi(ra[q].z), bf_lo(ra[q].w), bf_hi(ra[q].w));
                            *(u32x2*)(drow + 512) = pk8_fp8(bf_lo(rb[q].x), bf_hi(rb[q].x), bf_lo(rb[q].y), bf_hi(rb[q].y), bf_lo(rb[q].z), bf_hi(rb[q].z), bf_lo(rb[q].w), bf_hi(rb[q].w));
                            if (F.lane == 0) { stok[slot] = m * 2 + k; sw[slot] = __int_as_float(rt[q][4 + k]); srs[slot] = RS[m]; } } } }
                SEAM();
            }
            if (KON(11) && IN(pb + 7)) { FRESH_TID(F); PMARK(pb + 7);
                const int npan = build_ptab(F);
                const int* stok = (const int*)(F.ws + WS_SLOT); const float* srs = (const float*)(stok + 2 * MAXSLOT);
                pg8::Gemm8 g{F.ws + WS_XS, F.ws + WS_WM1, D, D, D}; SchedMoe1F S{F.G, F.c, npan, (const LAS int*)(F.lds + PTAB_OFF)};
                EpiGlu8 E{srs, F.ws + WS_ACTM, DFE, 1.0f / MOE_S1};
                pg8::gemm_phase8(F.lds, g, S, E); SEAM();
            }
            if (KON(12) && IN(pb + 8)) { FRESH_TID(F); PMARK(pb + 8);
                const int npan = build_ptab(F);
                const int* stok = (const int*)(F.ws + WS_SLOT); const float* sw = (const float*)(stok + MAXSLOT);
                pg8::Gemm8 g{F.ws + WS_ACTM, F.ws + WS_WM2, DFE, DFE, DFE}; SchedMoe2F S{F.G, F.c, npan, (const LAS int*)(F.lds + PTAB_OFF)};
                EpiMoe2 E{stok, sw, (bf16_t*)(F.ws + WS_Y0), (bf16_t*)(F.ws + WS_Y1), 0, 1.0f / MOE_S2}; pg8::gemm_phase8(F.lds, g, S, E); SEAM();
            }
            if (KON(13) && IN(pb + 11)) { FRESH_TID(F); PMARK(pb + 11);
                const bf16_t* Y0 = (const bf16_t*)(F.ws + WS_Y0); const bf16_t* Y1 = (const bf16_t*)(F.ws + WS_Y1);
#pragma nounroll
                for (int mb = gw; mb < M; mb += 2 * NGW) { f32x4 x[2][4]; u32x2 ya[2][4], yb[2][4];
#pragma unroll
                    for (int q = 0; q < 2; ++q) { const int m = mb + q * NGW < M ? mb + q * NGW : 0; const u32x2* xr = (const u32x2*)(XB + (size_t)m * D) + F.lane; const u32x2* y0 = (const u32x2*)(Y0 + (size_t)m * D) + F.lane; const u32x2* y1 = (const u32x2*)(Y1 + (size_t)m * D) + F.lane;
#pragma unroll
                        for (int j = 0; j < 4; ++j) { const u32x2 wv = xr[64 * j]; x[q][j] = (f32x4){bf_lo(wv.x), bf_hi(wv.x), bf_lo(wv.y), bf_hi(wv.y)}; ya[q][j] = y0[64 * j]; yb[q][j] = y1[64 * j]; } }
#pragma unroll
                    for (int q = 0; q < 2; ++q) { const int m = mb + q * NGW; if (m >= M) break; f32x4* xr = (f32x4*)(F.out + (size_t)m * D) + F.lane;
#pragma unroll
                        for (int j = 0; j < 4; ++j) { f32x4 o = x[q][j]; const u32x2 a = ya[q][j], b2 = yb[q][j];
                            o.x += bf_lo(a.x) + bf_lo(b2.x); o.y += bf_hi(a.x) + bf_hi(b2.x); o.z += bf_lo(a.y) + bf_lo(b2.y); o.w += bf_hi(a.y) + bf_hi(b2.y); xr[64 * j] = o; } } }
            }
        }
    }
#undef gw
#undef NGW
#undef XB
#undef RS
    PMARK(99);
    if ((PROBE_MASK & 0x6000000u) && blockIdx.x == 0 && threadIdx.x == 0) { const unsigned* st = (const unsigned*)(F.ws + WS_SLOT + 3 * MAXSLOT * 4); unsigned long long tot = 0; for (int i = 0; i < 512 * 8; ++i) { const unsigned v = st[i]; tot += (PROBE_MASK & 0x2000000u) ? (v & 255u) : (v >> 8); }
        *(volatile LAS unsigned long long*)(F.lds + MISC_OFF + 160) += tot * 25ull / 4096ull * 10ull; }
    if (PROBE_MASK != 0u && blockIdx.x == 0 && threadIdx.x == 0) { const unsigned long long acc = *(volatile LAS unsigned long long*)(F.lds + MISC_OFF + 160), t1 = __builtin_amdgcn_s_memrealtime() + 4ull * acc; while (__builtin_amdgcn_s_memrealtime() < t1) __builtin_amdgcn_s_sleep(8); }
#undef IN
}

constexpr int NPHASE = 25;
template <unsigned KM> static bool setup_kernel(int& per_cu) {
    if (hipFuncSetAttribute((const void*)fwd<KM>, hipFuncAttributeMaxDynamicSharedMemorySize, LDS_BYTES) != hipSuccess) return false;
    if (hipOccupancyMaxActiveBlocksPerMultiprocessor(&per_cu, (const void*)fwd<KM>, NTHR, LDS_BYTES) != hipSuccess) per_cu = 0;
    (void)hipGetLastError(); return true;
}
template <unsigned KM> static void launch_kind(int grid, const Args& a, hipStream_t stream) { hipLaunchKernelGGL(fwd<KM>, dim3(grid), dim3(NTHR), LDS_BYTES, stream, a); }
extern "C" void kernel_launch(void* const* d_in, const int* in_sizes, int n_in, void* d_out, int out_size, void* d_ws, size_t ws_size, hipStream_t stream) {
    static int grid = 0;
    if (grid == 0) {
        if (n_in != 28 || in_sizes[0] != M * D || out_size != M * D || ws_size < WS_END) { fprintf(stderr, "kernel_launch: unexpected shapes / workspace (n_in %d, ws %zu, need %zu)\n", n_in, ws_size, (size_t)WS_END); grid = -1; return; }
        int dev = 0, cus = 0, per_cu = 0; bool ok = true;
        if (hipGetDevice(&dev) != hipSuccess || hipDeviceGetAttribute(&cus, hipDeviceAttributeMultiprocessorCount, dev) != hipSuccess) { grid = -1; return; }
#if MK_PER_PHASE
        ok = ok && setup_kernel<1u << 0>(per_cu) && setup_kernel<1u << 1>(per_cu) && setup_kernel<1u << 2>(per_cu) && setup_kernel<1u << 3>(per_cu) && setup_kernel<1u << 4>(per_cu) && setup_kernel<1u << 5>(per_cu) && setup_kernel<1u << 6>(per_cu)
             && setup_kernel<1u << 7>(per_cu) && setup_kernel<1u << 8>(per_cu) && setup_kernel<1u << 9>(per_cu) && setup_kernel<1u << 10>(per_cu) && setup_kernel<1u << 11>(per_cu) && setup_kernel<1u << 12>(per_cu) && setup_kernel<1u << 13>(per_cu);
#else
        ok = ok && setup_kernel<0xffffffffu>(per_cu);
#endif
        if (!ok) { fprintf(stderr, "kernel_launch: hipFuncSetAttribute failed\n"); grid = -1; return; }
        if (per_cu < 1) fprintf(stderr, "kernel_launch: occupancy query says %d\n", per_cu);
        grid = cus;
    }
    if (grid < 0) return;
    (void)hipMemsetAsync((char*)d_ws + WS_CTL, 0, CTL_BYTES, stream);
    Args a{};
    for (int i = 0; i < 28; ++i) a.in[i] = (const float*)d_in[i];
    a.out = (float*)d_out; a.ws = (unsigned char*)d_ws;
#if MK_PER_PHASE
    static const int phases[] = {0, 1, 2, 3, 4, 5, 7, 8, 13, 14, 15, 16, 17, 18, 19, 20, 21, 24};
    static const int kinds[]  = {0, 1, 2, 3, 4, 5, 7, 8,  1,  2,  3,  4,  5,  6, 10, 11, 12, 13};
    for (int i = 0; i < (int)(sizeof(phases) / sizeof(int)); ++i) { a.ph_lo = phases[i]; a.ph_hi = phases[i] + 1;
        switch (kinds[i]) {
            case 0: launch_kind<1u << 0>(grid, a, stream); break; case 1: launch_kind<1u << 1>(grid, a, stream); break; case 2: launch_kind<1u << 2>(grid, a, stream); break;
            case 3: launch_kind<1u << 3>(grid, a, stream); break; case 4: launch_kind<1u << 4>(grid, a, stream); break; case 5: launch_kind<1u << 5>(grid, a, stream); break;
            case 6: launch_kind<1u << 6>(grid, a, stream); break; case 7: launch_kind<1u << 7>(grid, a, stream); break; case 8: launch_kind<1u << 8>(grid, a, stream); break;
            case 9: launch_kind<1u << 9>(grid, a, stream); break; case 10: launch_kind<1u << 10>(grid, a, stream); break; case 11: launch_kind<1u << 11>(grid, a, stream); break;
            case 12: launch_kind<1u << 12>(grid, a, stream); break; default: launch_kind<1u << 13>(grid, a, stream); break; } }
#else
    a.ph_lo = 0; a.ph_hi = NPHASE; launch_kind<0xffffffffu>(grid, a, stream);
#endif
}
```

```cpp
#include <hip/hip_runtime.h>
#include <cstdio>
#include <cstdint>

#ifndef MK_PER_PHASE
#define MK_PER_PHASE 0
#endif

#ifndef PROBE_MASK
#define PROBE_MASK 0u
#endif
#define LAS __attribute__((address_space(3)))
typedef unsigned short bf16_t;
typedef short bf16x8 __attribute__((ext_vector_type(8)));
typedef float f32x4 __attribute__((ext_vector_type(4)));
typedef float f32x2 __attribute__((ext_vector_type(2)));
typedef unsigned u32x4 __attribute__((ext_vector_type(4)));
typedef unsigned u32x2 __attribute__((ext_vector_type(2)));

constexpr int D = 1024, NB = 8, SEQ = 2048, M = NB * SEQ;
constexpr int INW = 2328, INP = 2560;
constexpr int CW = 512, CKW = 31, DH = 64, NKV = 2, NBH = NB * NKV;
constexpr int NCMP = 127, CHID = 256;
constexpr int DFF = 2816, NE = 8, DFE = 3584;
constexpr int MAXPAN = 136, MAXSLOT = MAXPAN * 256, CHUNKP = 72;
constexpr float EPS = 1e-6f;

constexpr size_t MiB = 1u << 20;
constexpr size_t WS_CTL = 0, CTL_BYTES = 2 * MiB;
constexpr size_t WS_H1 = 342 * MiB;
constexpr size_t WS_WIN = 12 * MiB;
constexpr size_t WS_WC1 = 22 * MiB;
constexpr size_t WS_WOUT = 26 * MiB;
constexpr size_t WS_WF1 = 30 * MiB;
constexpr size_t WS_WF2 = 41 * MiB;
constexpr size_t WS_RT = 47 * MiB;
constexpr size_t WS_WM1 = 48 * MiB;
constexpr size_t WS_WM2 = 160 * MiB;
constexpr size_t WS_XB = 216 * MiB;
constexpr size_t WS_RSTD = 248 * MiB;
constexpr size_t WS_GT = WS_RSTD + 65536;
constexpr size_t WS_ROUTE = WS_GT + (size_t)M * 24 * 4;
constexpr size_t WS_PSS = 250 * MiB;
constexpr size_t WS_KC = 251 * MiB;
constexpr size_t WS_VC = WS_KC + 262144;
constexpr size_t WS_VCT = WS_KC + 524288;
constexpr size_t WS_VST = 2 * MiB, WS_VWT = 6 * MiB;
constexpr size_t WS_U = 252 * MiB;
constexpr size_t WS_Q = 268 * MiB;
constexpr size_t WS_KV = 284 * MiB;
constexpr size_t KVT = (size_t)NBH * SEQ * DH;
constexpr size_t WS_MIX = 310 * MiB;
constexpr size_t WS_ACT = 342 * MiB;
constexpr size_t WS_XS = 252 * MiB;
constexpr size_t WS_ACTM = 320 * MiB;
constexpr size_t WS_SLOT = 447 * MiB;
constexpr size_t WS_Y0 = WS_XS, WS_Y1 = 12 * MiB;
constexpr size_t WS_END = 448 * MiB;
constexpr int CW_BAR = 4096;
constexpr int CW_CNT = 8192;
constexpr int CW_B1P = 16384;

__device__ __forceinline__ unsigned cvt_pk_bf16(float lo, float hi) { unsigned r; asm volatile("v_cvt_pk_bf16_f32 %0, %1, %2" : "=v"(r) : "v"(lo), "v"(hi)); return r; }
__device__ __forceinline__ float bf_lo(unsigned v) { return __uint_as_float(v << 16); }
__device__ __forceinline__ float bf_hi(unsigned v) { return __uint_as_float(v & 0xffff0000u); }
__device__ __forceinline__ float bf2f(bf16_t v) { return __uint_as_float((unsigned)v << 16); }
__device__ __forceinline__ float rcpf_(float x) { return __builtin_amdgcn_rcpf(x); }
__device__ __forceinline__ float rsqf_(float x) { return __builtin_amdgcn_rsqf(x); }
__device__ __forceinline__ float sigmoidf_(float x) { return rcpf_(1.0f + __expf(-x)); }
__device__ __forceinline__ float siluf_(float x) { return x * sigmoidf_(x); }
typedef float f32x2e __attribute__((ext_vector_type(2)));
__device__ __forceinline__ f32x2e glu2_(f32x2e g, f32x2e u, f32x2e nrs, f32x2e rs2) {
    f32x2e e = g * nrs; e.x = __builtin_amdgcn_exp2f(e.x); e.y = __builtin_amdgcn_exp2f(e.y);
    f32x2e d = e + (f32x2e){1.0f, 1.0f}; d.x = __builtin_amdgcn_rcpf(d.x); d.y = __builtin_amdgcn_rcpf(d.y);
    return ((g * u) * rs2) * d; }
__device__ __forceinline__ f32x2e glus2_(f32x2e v, f32x2e g, f32x2e nrs, f32x2e rs1) {
    f32x2e e = g * nrs; e.x = __builtin_amdgcn_exp2f(e.x); e.y = __builtin_amdgcn_exp2f(e.y);
    f32x2e d = e + (f32x2e){1.0f, 1.0f}; d.x = __builtin_amdgcn_rcpf(d.x); d.y = __builtin_amdgcn_rcpf(d.y);
    return (v * rs1) * d; }
#define LO2(v) ((f32x2e){(v)[0], (v)[1]})
#define HI2(v) ((f32x2e){(v)[2], (v)[3]})
__device__ __forceinline__ float wave_sum(float v) {
#pragma unroll
    for (int o = 1; o < 64; o <<= 1) v += __shfl_xor(v, o);
    return v;
}
#define DPP_ADD(v, ctrl) ((v) + __builtin_bit_cast(float, __builtin_amdgcn_update_dpp(0, __builtin_bit_cast(int, (v)), (ctrl), 0xF, 0xF, true)))
__device__ __forceinline__ float wave_sum_u(float v) {
    v = DPP_ADD(v, 0xB1); v = DPP_ADD(v, 0x4E); v = DPP_ADD(v, 0x124); v = DPP_ADD(v, 0x128);
    const int b = __builtin_bit_cast(int, v);
    return (__builtin_bit_cast(float, __builtin_amdgcn_readlane(b, 0)) + __builtin_bit_cast(float, __builtin_amdgcn_readlane(b, 16))) + (__builtin_bit_cast(float, __builtin_amdgcn_readlane(b, 32)) + __builtin_bit_cast(float, __builtin_amdgcn_readlane(b, 48)));
}
__device__ __forceinline__ float wave_max(float v) {
#pragma unroll
    for (int o = 1; o < 64; o <<= 1) v = fmaxf(v, __shfl_xor(v, o));
    return v;
}
#define LDS_WAIT() asm volatile("s_waitcnt lgkmcnt(0)" ::: "memory")
typedef float f32x16 __attribute__((ext_vector_type(16)));
typedef __bf16 bf16v2 __attribute__((ext_vector_type(2)));
#define MFMA32(a, b, c) __builtin_amdgcn_mfma_f32_32x32x16_bf16((a), (b), (c), 0, 0, 0)
__device__ __forceinline__ unsigned pk_bf16(float lo, float hi) { const f32x2 v = {lo, hi}; return __builtin_bit_cast(unsigned, __builtin_convertvector(v, bf16v2)); }
template <int S8> __device__ __forceinline__ bf16x8 pack8(const f32x16& p) { u32x4 w; w.x = pk_bf16(p[S8], p[S8 + 1]); w.y = pk_bf16(p[S8 + 2], p[S8 + 3]); w.z = pk_bf16(p[S8 + 4], p[S8 + 5]); w.w = pk_bf16(p[S8 + 6], p[S8 + 7]); return __builtin_bit_cast(bf16x8, w); }
__device__ __forceinline__ u32x2 pk8_fp8(float a0, float a1, float a2, float a3, float a4, float a5, float a6, float a7) {
    int w0 = 0, w1 = 0; w0 = __builtin_amdgcn_cvt_pk_fp8_f32(a0, a1, w0, false); w0 = __builtin_amdgcn_cvt_pk_fp8_f32(a2, a3, w0, true);
    w1 = __builtin_amdgcn_cvt_pk_fp8_f32(a4, a5, w1, false); w1 = __builtin_amdgcn_cvt_pk_fp8_f32(a6, a7, w1, true); return (u32x2){(unsigned)w0, (unsigned)w1}; }
__device__ __forceinline__ int swap23(int v) { return (v & ~12) | ((v & 4) << 1) | ((v & 8) >> 1); }

namespace pg8 {
constexpr int BM = 256, BK = 64, HALF = 128, HTB = HALF * BK * 2, STAGE_BYTES = 8 * HTB, NXCD = 8, WGM = 8;
__device__ __forceinline__ int lds_byte(int r, int c) { const int st = (r >> 4) * 2 + (c >> 5), rr = r & 15, cc = c & 31, ob = rr * 64 + cc * 2; return st * 1024 + (ob ^ (((ob >> 9) & 1) << 5)); }
__device__ __forceinline__ void stage_rc(int b, int& R, int& C) { const int st = b / 1024, sb = b % 1024, swz = sb ^ (((sb >> 9) & 1) << 5); R = (st >> 1) * 16 + swz / 64; C = (st & 1) * 32 + (swz % 64) / 2; }
__device__ __forceinline__ int perm32(int rho) { const int n = rho >> 4, i = rho & 15; return 8 * (i >> 2) + 4 * n + (i & 3); }

struct Unit { int pm, pn; size_t aoff, boff; };
struct Gemm { const bf16_t* A; const bf16_t* Bt; int K, lda, ldb; };

struct SchedGrid {
    int nM, nN, nwg, G, c; size_t astr, bstr;
    __device__ __forceinline__ void init(int nM_, int nN_, int G_, int c_, int lda, int ldb) { nM = nM_; nN = nN_; nwg = nM * nN; G = G_; c = c_; astr = (size_t)BM * lda * 2; bstr = (size_t)BM * ldb * 2; }
    __device__ __forceinline__ bool next(int i, Unit& u) const {
        const long L = (long)i * G + c; if (L >= nwg) return false;
        int wgid = (int)L; { const int q = nwg / NXCD, r = nwg % NXCD, xcd = wgid % NXCD, off = wgid / NXCD; wgid = (xcd < r ? xcd * (q + 1) : r * (q + 1) + (xcd - r) * q) + off; }
        const int nig = WGM * nN, gid = wgid / nig, fm = gid * WGM, gsz = (nM - fm) < WGM ? (nM - fm) : WGM;
        u.pm = fm + ((wgid % nig) % gsz); u.pn = (wgid % nig) / gsz; u.aoff = (size_t)u.pm * astr; u.boff = (size_t)u.pn * bstr; return true;
    }
};

template <class Epi, class Sched>
__device__ __forceinline__ void gemm_phase(LAS unsigned char* lds, const Gemm g, const Sched& S, const Epi& E) {
    int tid = threadIdx.x; asm volatile("" : "+v"(tid));
    const int wid = __builtin_amdgcn_readfirstlane(tid >> 6), lane = tid & 63, wr = wid >> 2, wc = wid & 3, fr = lane & 15, fq = lane >> 4;
    const int K = g.K, nt = K / BK;
    unsigned voffA[2], voffB[2];
#pragma unroll
    for (int i = 0; i < 2; ++i) { int R, C; stage_rc(tid * 16 + i * 8192, R, C); const int Rb = Epi::PERM ? ((R & ~31) + perm32(R & 31)) : R;
        voffA[i] = (unsigned)(R * g.lda + C) * 2u; voffB[i] = (unsigned)(Rb * g.ldb + C) * 2u; }
    const size_t kstep = (size_t)(BK * 2);
    const size_t hstepA = (size_t)HALF * g.lda * 2, hstepB = (size_t)HALF * g.ldb * 2;
    const unsigned ldsw = (unsigned)wid * 1024u;
    const int aoff = lds_byte(wr * 64 + fr, fq * 8), boff = lds_byte(wc * 32 + fr, fq * 8);
#define PG8_SA(b, h) (((b) * 2 + (h)) * HTB)
#define PG8_SB(b, h) ((4 + (b) * 2 + (h)) * HTB)
#define PG8_STAGE(bufoff, gbase, voff) do { _Pragma("unroll") for (int _i = 0; _i < 2; ++_i) \
        __builtin_amdgcn_global_load_lds((const unsigned*)((const char*)(gbase) + (voff)[_i]), (LAS unsigned*)(lds + (bufoff) + ldsw + _i * 8192), 16, 0, 0); } while (0)
#define PG8_LDA(dst, b, h) do { _Pragma("unroll") for (int m = 0; m < 4; ++m) _Pragma("unroll") for (int k = 0; k < 2; ++k) dst[m][k] = *(const LAS bf16x8*)(lds + PG8_SA(b, h) + aoff + m * 2048 + k * 1024); } while (0)
#define PG8_LDB(dst, b, h) do { _Pragma("unroll") for (int n = 0; n < 2; ++n) _Pragma("unroll") for (int k = 0; k < 2; ++k) dst[n][k] = *(const LAS bf16x8*)(lds + PG8_SB(b, h) + boff + n * 2048 + k * 1024); } while (0)
#define PG8_MMA(ai, bj, At, Bt) do { __builtin_amdgcn_s_setprio(1); _Pragma("unroll") for (int m = 0; m < 4; ++m) _Pragma("unroll") for (int n = 0; n < 2; ++n) _Pragma("unroll") for (int k = 0; k < 2; ++k) \
        acc[ai][bj][m][n] = __builtin_amdgcn_mfma_f32_16x16x32_bf16(Bt[n][k], At[m][k], acc[ai][bj][m][n], 0, 0, 0); __builtin_amdgcn_s_setprio(0); } while (0)
#define PG8_WAIT_V(n) asm volatile("s_waitcnt vmcnt(" #n ")" ::: "memory")
#define PG8_WAIT_L(n) asm volatile("s_waitcnt lgkmcnt(" #n ")" ::: "memory")
#define PG8_BAR __builtin_amdgcn_s_barrier()
#define PG8_SCHED __builtin_amdgcn_sched_barrier(0)
    Unit cur, nxt; int ui = 0;
    if (!S.next(0, cur)) return;
    f32x4 acc[2][2][4][2];
#pragma unroll
    for (int a = 0; a < 2; ++a)
#pragma unroll
        for (int b = 0; b < 2; ++b)
#pragma unroll
            for (int m = 0; m < 4; ++m)
#pragma unroll
                for (int n = 0; n < 2; ++n) acc[a][b][m][n] = (f32x4){0.f, 0.f, 0.f, 0.f};
    bf16x8 At[4][2], B0[2][2], B1[2][2];
    const char* cA = (const char*)g.A + cur.aoff; const char* cB = (const char*)g.Bt + cur.boff;
    typename Epi::Pre pre; E.prefetch(cur, wr, fr, pre);
    PG8_STAGE(PG8_SB(0, 0), cB, voffB); PG8_STAGE(PG8_SA(0, 0), cA, voffA); PG8_STAGE(PG8_SB(0, 1), cB + hstepB, voffB); PG8_STAGE(PG8_SA(0, 1), cA + hstepA, voffA);
    if (wr == 1) PG8_BAR;
    PG8_WAIT_V(4); PG8_BAR;
    PG8_STAGE(PG8_SB(1, 0), cB + kstep, voffB); PG8_STAGE(PG8_SA(1, 0), cA + kstep, voffA); PG8_STAGE(PG8_SB(1, 1), cB + hstepB + kstep, voffB);
    PG8_WAIT_V(6); PG8_BAR;
    for (;;) {
        const bool has_next = S.next(ui + 1, nxt);
        const char* nA = has_next ? (const char*)g.A + nxt.aoff : cA; const char* nB = has_next ? (const char*)g.Bt + nxt.boff : cB;
#pragma nounroll
        for (int t = 0; t < nt; t += 2) {
            const bool last = (t == nt - 2);
            const char* a1 = cA + (size_t)(t + 1) * kstep;
            const char* a2 = last ? nA : cA + (size_t)(t + 2) * kstep; const char* b2 = last ? nB : cB + (size_t)(t + 2) * kstep;
            const char* a3 = a2 + kstep; const char* b3 = b2 + kstep;
            PG8_LDB(B0, 0, 0); PG8_SCHED; PG8_LDA(At, 0, 0); PG8_STAGE(PG8_SA(1, 1), a1 + hstepA, voffA);
            PG8_WAIT_L(8); PG8_BAR; PG8_WAIT_L(0); PG8_MMA(0, 0, At, B0); PG8_BAR; PG8_SCHED;
            PG8_LDB(B1, 0, 1); PG8_STAGE(PG8_SB(0, 0), b2, voffB);
            PG8_BAR; PG8_WAIT_L(0); PG8_MMA(0, 1, At, B1); PG8_BAR;
            PG8_LDA(At, 0, 1); PG8_STAGE(PG8_SA(0, 0), a2, voffA);
            PG8_BAR; PG8_WAIT_L(0); PG8_MMA(1, 0, At, B0); PG8_BAR; PG8_SCHED;
            PG8_STAGE(PG8_SB(0, 1), b2 + hstepB, voffB);
            PG8_WAIT_V(6); PG8_BAR; PG8_MMA(1, 1, At, B1); PG8_BAR;
            PG8_LDB(B0, 1, 0); PG8_SCHED; PG8_LDA(At, 1, 0); PG8_STAGE(PG8_SA(0, 1), a2 + hstepA, voffA);
            PG8_WAIT_L(8); PG8_BAR; PG8_WAIT_L(0); PG8_MMA(0, 0, At, B0); PG8_BAR; PG8_SCHED;
            PG8_LDB(B1, 1, 1); PG8_STAGE(PG8_SB(1, 0), b3, voffB);
            PG8_BAR; PG8_WAIT_L(0); PG8_MMA(0, 1, At, B1); PG8_BAR;
            PG8_LDA(At, 1, 1); PG8_STAGE(PG8_SA(1, 0), a3, voffA);
            PG8_BAR; PG8_WAIT_L(0); PG8_MMA(1, 0, At, B0); PG8_BAR; PG8_SCHED;
            PG8_STAGE(PG8_SB(1, 1), b3 + hstepB, voffB);
            PG8_WAIT_V(6); PG8_BAR; PG8_MMA(1, 1, At, B1); PG8_BAR;
        }
        E(acc, cur, wr, wc, fr, fq, pre);
        if (!has_next) break;
        E.prefetch(nxt, wr, fr, pre);
#pragma unroll
        for (int a = 0; a < 2; ++a)
#pragma unroll
            for (int b = 0; b < 2; ++b)
#pragma unroll
                for (int m = 0; m < 4; ++m)
#pragma unroll
                    for (int n = 0; n < 2; ++n) acc[a][b][m][n] = (f32x4){0.f, 0.f, 0.f, 0.f};
        cur = nxt; cA = nA; cB = nB; ++ui;
    }
    PG8_WAIT_V(0);
    if (wr == 0) PG8_BAR;
    PG8_BAR;
#undef PG8_SA
#undef PG8_SB
#undef PG8_STAGE
#undef PG8_LDA
#undef PG8_LDB
#undef PG8_MMA
#undef PG8_WAIT_V
#undef PG8_WAIT_L
#undef PG8_BAR
#undef PG8_SCHED
}
struct Gemm8 { const unsigned char* A; const unsigned char* Bt; int K, lda, ldb; };
typedef int i32x4 __attribute__((ext_vector_type(4)));
typedef int i32x8 __attribute__((ext_vector_type(8)));
template <class Epi, class Sched>
__device__ __forceinline__ void gemm_phase8(LAS unsigned char* lds, const Gemm8 g, const Sched& S, const Epi& E) {
    int tid = threadIdx.x; asm volatile("" : "+v"(tid));
    const int wid = __builtin_amdgcn_readfirstlane(tid >> 6), lane = tid & 63, wr = wid >> 2, wc = wid & 3, fr = lane & 15, fq = lane >> 4;
    const int nt = g.K / 128;
    unsigned voffA[2], voffB[2];
#pragma unroll
    for (int i = 0; i < 2; ++i) { int R, C; stage_rc(tid * 16 + i * 8192, R, C); const int Rb = Epi::PERM ? ((R & ~31) + perm32(R & 31)) : R;
        voffA[i] = (unsigned)(R * g.lda + C * 2); voffB[i] = (unsigned)(Rb * g.ldb + C * 2); }
    const size_t kstep = (size_t)(BK * 2);
    const size_t hstepA = (size_t)HALF * g.lda, hstepB = (size_t)HALF * g.ldb;
    const unsigned ldsw = (unsigned)wid * 1024u;
    const int aoff = lds_byte(wr * 64 + fr, fq * 8), boff = lds_byte(wc * 32 + fr, fq * 8);
#define PG8_SA(b, h) (((b) * 2 + (h)) * HTB)
#define PG8_SB(b, h) ((4 + (b) * 2 + (h)) * HTB)
#define PG8_STAGE(bufoff, gbase, voff) do { _Pragma("unroll") for (int _i = 0; _i < 2; ++_i) \
        __builtin_amdgcn_global_load_lds((const unsigned*)((const char*)(gbase) + (voff)[_i]), (LAS unsigned*)(lds + (bufoff) + ldsw + _i * 8192), 16, 0, 0); } while (0)
#define PG8_LDA(dst, b, h) do { _Pragma("unroll") for (int m = 0; m < 4; ++m) { const i32x4 _l = *(const LAS i32x4*)(lds + PG8_SA(b, h) + aoff + m * 2048), _h = *(const LAS i32x4*)(lds + PG8_SA(b, h) + aoff + m * 2048 + 1024); dst[m] = __builtin_shufflevector(_l, _h, 0, 1, 2, 3, 4, 5, 6, 7); } } while (0)
#define PG8_LDB(dst, b, h) do { _Pragma("unroll") for (int n = 0; n < 2; ++n) { const i32x4 _l = *(const LAS i32x4*)(lds + PG8_SB(b, h) + boff + n * 2048), _h = *(const LAS i32x4*)(lds + PG8_SB(b, h) + boff + n * 2048 + 1024); dst[n] = __builtin_shufflevector(_l, _h, 0, 1, 2, 3, 4, 5, 6, 7); } } while (0)
#define PG8_MMA(ai, bj, At, Bt) do { __builtin_amdgcn_s_setprio(1); _Pragma("unroll") for (int m = 0; m < 4; ++m) _Pragma("unroll") for (int n = 0; n < 2; ++n) \
        asm volatile("v_mfma_f32_16x16x128_f8f6f4 %0, %1, %2, %0" : "+v"(acc[ai][bj][m][n]) : "v"(Bt[n]), "v"(At[m])); __builtin_amdgcn_s_setprio(0); } while (0)
#define PG8_WAIT_V(n) asm volatile("s_waitcnt vmcnt(" #n ")" ::: "memory")
#define PG8_WAIT_L(n) asm volatile("s_waitcnt lgkmcnt(" #n ")" ::: "memory")
#define PG8_BAR __builtin_amdgcn_s_barrier()
#define PG8_SCHED __builtin_amdgcn_sched_barrier(0)
    Unit cur, nxt; int ui = 0;
    if (!S.next(0, cur)) return;
    f32x4 acc[2][2][4][2];
#pragma unroll
    for (int a = 0; a < 2; ++a)
#pragma unroll
        for (int b = 0; b < 2; ++b)
#pragma unroll
            for (int m = 0; m < 4; ++m)
#pragma unroll
                for (int n = 0; n < 2; ++n) acc[a][b][m][n] = (f32x4){0.f, 0.f, 0.f, 0.f};
    i32x8 At[4], B0[2], B1[2];
    const char* cA = (const char*)g.A + cur.aoff; const char* cB = (const char*)g.Bt + cur.boff;
    typename Epi::Pre pre; E.prefetch(cur, wr, fr, pre);
    PG8_STAGE(PG8_SB(0, 0), cB, voffB); PG8_STAGE(PG8_SA(0, 0), cA, voffA); PG8_STAGE(PG8_SB(0, 1), cB + hstepB, voffB); PG8_STAGE(PG8_SA(0, 1), cA + hstepA, voffA);
    if (wr == 1) PG8_BAR;
    PG8_WAIT_V(4); PG8_BAR;
    PG8_STAGE(PG8_SB(1, 0), cB + kstep, voffB); PG8_STAGE(PG8_SA(1, 0), cA + kstep, voffA); PG8_STAGE(PG8_SB(1, 1), cB + hstepB + kstep, voffB);
    PG8_WAIT_V(6); PG8_BAR;
    for (;;) {
        const bool has_next = S.next(ui + 1, nxt);
        const char* nA = has_next ? (const char*)g.A + nxt.aoff : cA; const char* nB = has_next ? (const char*)g.Bt + nxt.boff : cB;
#pragma nounroll
        for (int t = 0; t < nt; t += 2) {
            const bool last = (t == nt - 2);
            const char* a1 = cA + (size_t)(t + 1) * kstep;
            const char* a2 = last ? nA : cA + (size_t)(t + 2) * kstep; const char* b2 = last ? nB : cB + (size_t)(t + 2) * kstep;
            const char* a3 = a2 + kstep; const char* b3 = b2 + kstep;
            PG8_LDB(B0, 0, 0); PG8_SCHED; PG8_LDA(At, 0, 0); PG8_STAGE(PG8_SA(1, 1), a1 + hstepA, voffA);
            PG8_WAIT_L(8); PG8_BAR; PG8_WAIT_L(0); PG8_MMA(0, 0, At, B0); PG8_BAR; PG8_SCHED;
            PG8_LDB(B1, 0, 1); PG8_STAGE(PG8_SB(0, 0), b2, voffB);
            PG8_BAR; PG8_WAIT_L(0); PG8_MMA(0, 1, At, B1); PG8_BAR;
            PG8_LDA(At, 0, 1); PG8_STAGE(PG8_SA(0, 0), a2, voffA);
            PG8_BAR; PG8_WAIT_L(0); PG8_MMA(1, 0, At, B0); PG8_BAR; PG8_SCHED;
            PG8_STAGE(PG8_SB(0, 1), b2 + hstepB, voffB);
            PG8_WAIT_V(6); PG8_BAR; PG8_MMA(1, 1, At, B1); PG8_BAR;
            PG8_LDB(B0, 1, 0); PG8_SCHED; PG8_LDA(At, 1, 0); PG8_STAGE(PG8_SA(0, 1), a2 + hstepA, voffA);
            PG8_WAIT_L(8); PG8_BAR; PG8_WAIT_L(0); PG8_MMA(0, 0, At, B0); PG8_BAR; PG8_SCHED;
            PG8_LDB(B1, 1, 1); PG8_STAGE(PG8_SB(1, 0), b3, voffB);
            PG8_BAR; PG8_WAIT_L(0); PG8_MMA(0, 1, At, B1); PG8_BAR;
            PG8_LDA(At, 1, 1); PG8_STAGE(PG8_SA(1, 0), a3, voffA);
            PG8_BAR; PG8_WAIT_L(0); PG8_MMA(1, 0, At, B0); PG8_BAR; PG8_SCHED;
            PG8_STAGE(PG8_SB(1, 1), b3 + hstepB, voffB);
            PG8_WAIT_V(6); PG8_BAR; PG8_MMA(1, 1, At, B1); PG8_BAR;
        }
        E(acc, cur, wr, wc, fr, fq, pre);
        if (!has_next) break;
        E.prefetch(nxt, wr, fr, pre);
#pragma unroll
        for (int a = 0; a < 2; ++a)
#pragma unroll
            for (int b = 0; b < 2; ++b)
#pragma unroll
                for (int m = 0; m < 4; ++m)
#pragma unroll
                    for (int n = 0; n < 2; ++n) acc[a][b][m][n] = (f32x4){0.f, 0.f, 0.f, 0.f};
        cur = nxt; cA = nA; cB = nB; ++ui;
    }
    PG8_WAIT_V(0);
    if (wr == 0) PG8_BAR;
    PG8_BAR;
#undef PG8_SA
#undef PG8_SB
#undef PG8_STAGE
#undef PG8_LDA
#undef PG8_LDB
#undef PG8_MMA
#undef PG8_WAIT_V
#undef PG8_WAIT_L
#undef PG8_BAR
#undef PG8_SCHED
}
}
using pg8::Unit;

#define XB_TMO      128
#define XB_XCNT(j)  (256  + 64 * (j))
#define XB_XSUB(j)  (1280 + 64 * (j))
#define XB_XGEN(j)  (2304 + 64 * (j))
#define XB_TOP      3328
#define XB_TOPGEN   3392
#define XCD_BAR_WORDS 3456
#define XB_SPIN_CAP (1u << 18)
__device__ __forceinline__ unsigned xb_ld(unsigned* p)              { return __hip_atomic_load(p, __ATOMIC_RELAXED, __HIP_MEMORY_SCOPE_AGENT); }
__device__ __forceinline__ unsigned xb_add(unsigned* p, unsigned v) { return __hip_atomic_fetch_add(p, v, __ATOMIC_RELAXED, __HIP_MEMORY_SCOPE_AGENT); }
__device__ __forceinline__ unsigned xb_xcc_id() { return (unsigned)__builtin_amdgcn_s_getreg((3 << 11) | 20) & 0xFu; }
#define XB_SPIN(cond, bar) do { unsigned _sp = 0; while (cond) { __builtin_amdgcn_s_sleep(1); \
    if ((++_sp & 255u) == 0u) { if (xb_ld(&(bar)[XB_TMO])) break; if (_sp > XB_SPIN_CAP) { atomicAdd(&(bar)[XB_TMO], 1u); break; } } } } while (0)
struct XcdBarrier { unsigned* bar; unsigned x; volatile LAS unsigned* st; };
__device__ __forceinline__ XcdBarrier xcd_barrier_post(unsigned* bar, volatile LAS unsigned* st) {
    XcdBarrier b; b.bar = bar; b.x = xb_xcc_id(); b.st = st;
    if (threadIdx.x == 0) (void)xb_add(&bar[XB_XCNT(b.x)], 1u);
    return b;
}
__device__ __forceinline__ void xcd_barrier_complete(unsigned* bar, unsigned x, unsigned& nloc, unsigned& nx) {
    const unsigned G = gridDim.x * gridDim.y * gridDim.z;
    unsigned sum, cnt, mine, sp = 0u;
    for (;;) {
        sum = 0u; cnt = 0u; mine = 0u;
#pragma unroll
        for (unsigned j = 0; j < 16; ++j) { const unsigned c = xb_ld(&bar[XB_XCNT(j)]); sum += c; cnt += (c > 0u) ? 1u : 0u; mine = (j == x) ? c : mine; }
        if (sum == G) break;
        __builtin_amdgcn_s_sleep(1);
        if ((++sp & 255u) == 0u) { if (xb_ld(&bar[XB_TMO])) break; if (sp > XB_SPIN_CAP) { atomicAdd(&bar[XB_TMO], 1u); break; } }
    }
    nloc = mine > 0u ? mine : 1u; nx = cnt > 0u ? cnt : 1u;
}
__device__ __forceinline__ void xcd_barrier(const XcdBarrier& b) {
    asm volatile("s_waitcnt vmcnt(0)" ::: "memory");
    __syncthreads();
    if (threadIdx.x == 0) {
        unsigned* bar = b.bar;
        __builtin_amdgcn_s_waitcnt(0);
        unsigned nloc = b.st[0], nx = b.st[1];
        if (nloc == 0u) { xcd_barrier_complete(bar, b.x, nloc, nx); b.st[0] = nloc; b.st[1] = nx; }
        const unsigned old = xb_add(&bar[XB_XSUB(b.x)], 1u);
        const unsigned gen = old / nloc;
        if (old + 1u == (gen + 1u) * nloc) {
            __builtin_amdgcn_fence(__ATOMIC_RELEASE, "agent");
            asm volatile("s_waitcnt vmcnt(0)" ::: "memory");
            const unsigned og = xb_add(&bar[XB_TOP], 1u);
            const unsigned tg = og / nx;
            if (og + 1u == (tg + 1u) * nx) xb_add(&bar[XB_TOPGEN], 1u);
            else XB_SPIN(xb_ld(&bar[XB_TOPGEN]) == tg, bar);
            __builtin_amdgcn_fence(__ATOMIC_ACQUIRE, "agent");
            xb_add(&bar[XB_XGEN(b.x)], 1u);
            asm volatile("s_waitcnt vmcnt(0)" ::: "memory");
        } else {
            XB_SPIN(xb_ld(&bar[XB_XGEN(b.x)]) == gen, bar);
            __builtin_amdgcn_fence(__ATOMIC_ACQUIRE, "agent");
            asm volatile("s_waitcnt vmcnt(0)" ::: "memory");
        }
    }
    __syncthreads();
}

constexpr int NWAVES = 8, NTHR = 512;
constexpr int LDS_BYTES = 147456;
constexpr int MISC_OFF = 131072;
constexpr int PTAB_OFF = MISC_OFF + 512;

struct Args { const float* in[28]; float* out; unsigned char* ws; int ph_lo, ph_hi; };

struct Frame {
    LAS unsigned char* lds; int tid, lane, wave, G, c;
    const float* const* in; float* out; unsigned char* ws;
};
#define INP_(i) (F.in[i])
#define FRESH_TID(F) do { int _t = threadIdx.x; asm volatile("" : "+v"(_t)); (F).tid = _t; (F).lane = _t & 63; \
    __attribute__((address_space(1))) unsigned char* _w = (__attribute__((address_space(1))) unsigned char*)args.ws; __attribute__((address_space(1))) float* _o = (__attribute__((address_space(1))) float*)args.out; \
    int _g = gridDim.x; asm volatile("" : "+s"(_w), "+s"(_o), "+s"(_g)); (F).ws = (unsigned char*)_w; (F).out = (float*)_o; (F).G = _g; } while (0)
enum { I_X = 0, I_ANG, I_WIN, I_CDW, I_CDB, I_CLG, I_CLB, I_QG, I_KG, I_PK, I_PV, I_KW1, I_KB1, I_KW2, I_KB2, I_VW1, I_VB1, I_VW2, I_VB2, I_WOUT, I_FNG, I_DW1, I_DW3, I_DW2, I_RW, I_MW1, I_MW3, I_MW2 };

#define PMARK(id) do { if (PROBE_MASK != 0u && blockIdx.x == 0 && threadIdx.x == 0) { volatile LAS unsigned long long* _a = (volatile LAS unsigned long long*)(F.lds + MISC_OFF + 160); volatile LAS unsigned* _o = (volatile LAS unsigned*)(F.lds + MISC_OFF + 168); \
    const unsigned long long _t = __builtin_amdgcn_s_memrealtime(); if (*_o) { *_a += _t; *_o = 0u; } if ((id) < 32 && ((PROBE_MASK >> (id)) & 1u)) { *_a -= _t; *_o = 1u; } } } while (0)
constexpr int RSL_OFF = MISC_OFF + 2048;
__device__ __forceinline__ void rstd_from_partials(const float* pss, int pm, LAS float* tab) {
    int t = threadIdx.x; asm volatile("" : "+v"(t));
    const int row = t >> 1, hf = t & 1;
    const f32x4 a = *(const f32x4*)(pss + (size_t)(pm * 256 + row) * 16 + hf * 8), b = *(const f32x4*)(pss + (size_t)(pm * 256 + row) * 16 + hf * 8 + 4);
    float sq = ((a.x + a.y) + (a.z + a.w)) + ((b.x + b.y) + (b.z + b.w)); sq += __shfl_xor(sq, 1);
    if (hf == 0) tab[row] = rsqf_(sq * (1.0f / D) + EPS);
}
struct EpiIn {
    static constexpr bool PERM = true;
    const float* rstd; bf16_t* U; bf16_t* Q; bf16_t* KV; float* GT; const float* pss; LAS float* rsl;
    struct Pre { int par = 1; };
    __device__ __forceinline__ void prefetch(const Unit& u, int wr, int fr, Pre& p) const {
        p.par ^= 1; LAS float* tab = rsl + p.par * 256;
        if (pss) rstd_from_partials(pss, u.pm, tab); else { int t = threadIdx.x; asm volatile("" : "+v"(t)); if (t < 256) tab[t] = rstd[u.pm * 256 + t]; } }
    __device__ __forceinline__ void operator()(const f32x4 (&acc)[2][2][4][2], const Unit& u, int wr, int wc, int fr, int fq, const Pre& pre) const {
        const int row0 = u.pm * 256 + wr * 64 + fr, cl = wc * 32 + 8 * fq;
        if (u.pn < 4) {
#pragma unroll
            for (int ai = 0; ai < 2; ++ai)
#pragma unroll
                for (int m = 0; m < 4; ++m) { const int r = row0 + ai * 128 + m * 16; const float rs = rsl[pre.par * 256 + wr * 64 + fr + ai * 128 + m * 16];
                    const f32x4 v0 = acc[ai][0][m][0], v1 = acc[ai][0][m][1], g0 = acc[ai][1][m][0], g1 = acc[ai][1][m][1];
                    const float nr = rs * -1.44269504089f; const f32x2e nrs = {nr, nr}, rs1 = {rs, rs};
                    const f32x2e o0 = glus2_(LO2(v0), LO2(g0), nrs, rs1), o1 = glus2_(HI2(v0), HI2(g0), nrs, rs1), o2 = glus2_(LO2(v1), LO2(g1), nrs, rs1), o3 = glus2_(HI2(v1), HI2(g1), nrs, rs1);
                    u32x4 w; w.x = cvt_pk_bf16(o0.x, o0.y); w.y = cvt_pk_bf16(o1.x, o1.y); w.z = cvt_pk_bf16(o2.x, o2.y); w.w = cvt_pk_bf16(o3.x, o3.y);
                    *(u32x4*)(U + (size_t)r * CW + u.pn * 128 + cl) = w; asm volatile("" ::: "memory"); }
        } else if (u.pn < 6) {
#pragma unroll
            for (int ai = 0; ai < 2; ++ai)
#pragma unroll
                for (int m = 0; m < 4; ++m) { const int r = row0 + ai * 128 + m * 16; const float rs = rsl[pre.par * 256 + wr * 64 + fr + ai * 128 + m * 16];
#pragma unroll
                    for (int bj = 0; bj < 2; ++bj) { const f32x4 v0 = acc[ai][bj][m][0] * rs, v1 = acc[ai][bj][m][1] * rs;
                        u32x4 w; w.x = cvt_pk_bf16(v0[0], v0[1]); w.y = cvt_pk_bf16(v0[2], v0[3]); w.z = cvt_pk_bf16(v1[0], v1[1]); w.w = cvt_pk_bf16(v1[2], v1[3]);
                        *(u32x4*)(Q + (size_t)r * 512 + (u.pn - 4) * 256 + bj * 128 + cl) = w; } asm volatile("" ::: "memory"); }
        } else if (u.pn < 9) {
            const int h = wc >> 1, d0 = 32 * (wc & 1) + 8 * fq;
#pragma unroll
            for (int ai = 0; ai < 2; ++ai)
#pragma unroll
                for (int m = 0; m < 4; ++m) { const int r = row0 + ai * 128 + m * 16; const float rs = rsl[pre.par * 256 + wr * 64 + fr + ai * 128 + m * 16]; const int b = r >> 11, t = r & 2047;
#pragma unroll
                    for (int bj = 0; bj < 2; ++bj) { const int tq = 2 * (u.pn - 6) + bj; const f32x4 v0 = acc[ai][bj][m][0] * rs, v1 = acc[ai][bj][m][1] * rs;
                        u32x4 w; w.x = cvt_pk_bf16(v0[0], v0[1]); w.y = cvt_pk_bf16(v0[2], v0[3]); w.z = cvt_pk_bf16(v1[0], v1[1]); w.w = cvt_pk_bf16(v1[2], v1[3]);
                        *(u32x4*)(KV + (size_t)tq * KVT + ((size_t)(b * 2 + h) * SEQ + t) * DH + d0) = w; } asm volatile("" ::: "memory"); }
        } else {
            if (wc == 0 && fq < 3) {
#pragma unroll
                for (int ai = 0; ai < 2; ++ai)
#pragma unroll
                    for (int m = 0; m < 4; ++m) { const int r = row0 + ai * 128 + m * 16; const float rs = rsl[pre.par * 256 + wr * 64 + fr + ai * 128 + m * 16];
                        *(f32x4*)(GT + (size_t)r * 24 + 8 * fq) = acc[ai][0][m][0] * rs; *(f32x4*)(GT + (size_t)r * 24 + 8 * fq + 4) = acc[ai][0][m][1] * rs; }
            }
        }
    }
};
struct EpiH1 {
    static constexpr bool PERM = false;
    float* H;
    struct Pre {}; __device__ __forceinline__ void prefetch(const Unit&, int, int, Pre&) const {}
    __device__ __forceinline__ void operator()(const f32x4 (&acc)[2][2][4][2], const Unit& u, int wr, int wc, int fr, int fq, const Pre&) const {
        const int row0 = u.pm * 256 + wr * 64 + fr, col0 = wc * 32 + 4 * fq; const int kv = u.pn >> 3, sp = u.pn & 7;
#pragma unroll
        for (int ai = 0; ai < 2; ++ai)
#pragma unroll
            for (int m = 0; m < 4; ++m) { float* rowp = H + (((size_t)sp * 2 + kv) * 2048 + row0 + ai * 128 + m * 16) * 256 + col0;
#pragma unroll
                for (int bj = 0; bj < 2; ++bj)
#pragma unroll
                    for (int n = 0; n < 2; ++n) *(f32x4*)(rowp + bj * 128 + n * 16) = acc[ai][bj][m][n]; }
    }
};
template <bool BF> struct EpiRes {
    static constexpr bool PERM = false;
    const void* base; bf16_t* xb; float* pss;
    struct Pre {}; __device__ __forceinline__ void prefetch(const Unit&, int, int, Pre&) const {}
    __device__ __forceinline__ void operator()(const f32x4 (&acc)[2][2][4][2], const Unit& u, int wr, int wc, int fr, int fq, const Pre&) const {
        const int row0 = u.pm * 256 + wr * 64 + fr, col0 = u.pn * 256 + wc * 32 + 4 * fq;
#pragma unroll
        for (int ai = 0; ai < 2; ++ai) {
            f32x4 bs[4][2][2];
#pragma unroll
            for (int m = 0; m < 4; ++m) { const size_t off = (size_t)(row0 + ai * 128 + m * 16) * D + col0;
#pragma unroll
                for (int bj = 0; bj < 2; ++bj)
#pragma unroll
                    for (int n = 0; n < 2; ++n) {
                        if (BF) { const u32x2 w = *(const u32x2*)((const bf16_t*)base + off + bj * 128 + n * 16); bs[m][bj][n] = (f32x4){bf_lo(w.x), bf_hi(w.x), bf_lo(w.y), bf_hi(w.y)}; }
                        else bs[m][bj][n] = *(const f32x4*)((const float*)base + off + bj * 128 + n * 16); } }
#pragma unroll
            for (int m = 0; m < 4; ++m) { const size_t off = (size_t)(row0 + ai * 128 + m * 16) * D + col0; float ss = 0.f;
#pragma unroll
                for (int bj = 0; bj < 2; ++bj)
#pragma unroll
                    for (int n = 0; n < 2; ++n) { const f32x4 v = bs[m][bj][n] + acc[ai][bj][m][n];
                        u32x2 w; w.x = cvt_pk_bf16(v[0], v[1]); w.y = cvt_pk_bf16(v[2], v[3]); *(u32x2*)(xb + off + bj * 128 + n * 16) = w; ss += (v[0] * v[0] + v[1] * v[1]) + (v[2] * v[2] + v[3] * v[3]); }
                if (pss) { ss += __shfl_xor(ss, 16); ss += __shfl_xor(ss, 32);
                    if (fq == 0) pss[(size_t)(row0 + ai * 128 + m * 16) * 16 + u.pn * 4 + wc] = ss; } } }
    }
};
struct EpiGlu {
    static constexpr bool PERM = true;
    const float* rstd; bf16_t* O; int ldo; int rowbase;
    const float* pss; LAS float* rsl;
    struct Pre { int par = 1; };
    __device__ __forceinline__ void prefetch(const Unit& u, int wr, int fr, Pre& p) const { p.par ^= 1; rstd_from_partials(pss, u.pm, rsl + p.par * 256); }
    __device__ __forceinline__ void operator()(const f32x4 (&acc)[2][2][4][2], const Unit& u, int wr, int wc, int fr, int fq, const Pre& pre) const {
        const int row0 = u.pm * 256 + wr * 64 + fr, cl = u.pn * 128 + wc * 32 + 8 * fq;
#pragma unroll
        for (int ai = 0; ai < 2; ++ai)
#pragma unroll
            for (int m = 0; m < 4; ++m) { const int r = row0 + ai * 128 + m * 16; const float rs = rsl[pre.par * 256 + wr * 64 + fr + ai * 128 + m * 16];
                const f32x4 g0 = acc[ai][0][m][0], g1 = acc[ai][0][m][1], u0 = acc[ai][1][m][0], u1 = acc[ai][1][m][1];
                const float nr = rs * -1.44269504089f, r2 = rs * rs; const f32x2e nrs = {nr, nr}, rs2 = {r2, r2};
                const f32x2e o0 = glu2_(LO2(g0), LO2(u0), nrs, rs2), o1 = glu2_(HI2(g0), HI2(u0), nrs, rs2), o2 = glu2_(LO2(g1), LO2(u1), nrs, rs2), o3 = glu2_(HI2(g1), HI2(u1), nrs, rs2);
                u32x4 w; w.x = cvt_pk_bf16(o0.x, o0.y); w.y = cvt_pk_bf16(o1.x, o1.y); w.z = cvt_pk_bf16(o2.x, o2.y); w.w = cvt_pk_bf16(o3.x, o3.y);
                *(u32x4*)(O + (size_t)r * ldo + cl) = w; }
    }
};
struct EpiGlu8 {
    static constexpr bool PERM = true;
    const float* rstd; unsigned char* O; int ldo; float sc;
    struct Pre { float rs[8]; };
    __device__ __forceinline__ void prefetch(const Unit& u, int wr, int fr, Pre& p) const {
#pragma unroll
        for (int q = 0; q < 8; ++q) p.rs[q] = rstd[u.pm * 256 + wr * 64 + fr + (q >> 2) * 128 + (q & 3) * 16]; }
    __device__ __forceinline__ void operator()(const f32x4 (&acc)[2][2][4][2], const Unit& u, int wr, int wc, int fr, int fq, const Pre& pre) const {
        const int row0 = u.pm * 256 + wr * 64 + fr, cl = u.pn * 128 + wc * 32 + 8 * fq;
#pragma unroll
        for (int ai = 0; ai < 2; ++ai)
#pragma unroll
            for (int m = 0; m < 4; ++m) { const int r = row0 + ai * 128 + m * 16; const float rs = pre.rs[ai * 4 + m] * sc;
                const f32x4 g0 = acc[ai][0][m][0], g1 = acc[ai][0][m][1], u0 = acc[ai][1][m][0], u1 = acc[ai][1][m][1];
                const float nr = rs * -1.44269504089f, r2 = rs * rs; const f32x2e nrs = {nr, nr}, rs2 = {r2, r2};
                const f32x2e o0 = glu2_(LO2(g0), LO2(u0), nrs, rs2), o1 = glu2_(HI2(g0), HI2(u0), nrs, rs2), o2 = glu2_(LO2(g1), LO2(u1), nrs, rs2), o3 = glu2_(HI2(g1), HI2(u1), nrs, rs2);
                *(u32x2*)(O + (size_t)r * ldo + cl) = pk8_fp8(o0.x, o0.y, o1.x, o1.y, o2.x, o2.y, o3.x, o3.y); }
    }
};
struct EpiMoe2 {
    static constexpr bool PERM = true;
    const int* stok; const float* sw; bf16_t* Y0; bf16_t* Y1; int rowbase; float sc;
    struct Pre {}; __device__ __forceinline__ void prefetch(const Unit&, int, int, Pre&) const {}
    __device__ __forceinline__ void operator()(const f32x4 (&acc)[2][2][4][2], const Unit& u, int wr, int wc, int fr, int fq, const Pre&) const {
        const int row0 = u.pm * 256 + wr * 64 + fr, cl = u.pn * 256 + wc * 32 + 8 * fq;
        int tks[8]; float ws[8];
#pragma unroll
        for (int q = 0; q < 8; ++q) { const int r = rowbase + row0 + (q >> 2) * 128 + (q & 3) * 16; tks[q] = stok[r]; ws[q] = sw[r]; }
#pragma unroll
        for (int ai = 0; ai < 2; ++ai)
#pragma unroll
            for (int m = 0; m < 4; ++m) { const int tk = tks[ai * 4 + m]; const float w = ws[ai * 4 + m] * sc;
                if (tk >= 0) { bf16_t* dst = ((tk & 1) ? Y1 : Y0) + (size_t)(tk >> 1) * D + cl;
#pragma unroll
                    for (int bj = 0; bj < 2; ++bj) { const f32x4 v0 = acc[ai][bj][m][0] * w, v1 = acc[ai][bj][m][1] * w;
                        u32x4 o; o.x = cvt_pk_bf16(v0[0], v0[1]); o.y = cvt_pk_bf16(v0[2], v0[3]); o.z = cvt_pk_bf16(v1[0], v1[1]); o.w = cvt_pk_bf16(v1[2], v1[3]);
                        *(u32x4*)(dst + bj * 128) = o; } } }
    }
};

struct SchedCmp {
    int G, c, layer;
    __device__ __forceinline__ bool next(int i, Unit& u) const {
        const int L = i * G + c; if (L >= 128) return false;
        const int kv = L >> 6, pm = (L >> 3) & 7, s = L & 7;
        u.pm = pm; u.pn = kv * 8 + s; u.aoff = ((size_t)kv * KVT + (size_t)pm * 256 * 1024 + s * 256) * 2; u.boff = ((size_t)(layer * 2 + kv) * 256 * 2048 + s * 256) * 2; return true;
    }
};
struct SchedMoe1 {
    int G, c, p0, np; const LAS int* ptab;
    __device__ __forceinline__ bool next(int i, Unit& u) const {
        const int L = i * G + c; if (L >= np * 28) return false;
        const int j = L / np, pl = L % np, e = ptab[p0 + pl];
        u.pm = pl; u.pn = j; u.aoff = (size_t)(p0 + pl) * 256 * 1024 * 2; u.boff = ((size_t)e * 7168 + (size_t)j * 256) * 1024 * 2; return true;
    }
};
struct SchedMoe2 {
    int G, c, p0, np; const LAS int* ptab;
    __device__ __forceinline__ bool next(int i, Unit& u) const {
        const int L = i * G + c; if (L >= np * 4) return false;
        const int j = L / np, pl = L % np, e = ptab[p0 + pl];
        u.pm = pl; u.pn = j; u.aoff = (size_t)pl * 256 * DFE * 2; u.boff = ((size_t)e * 1024 + (size_t)j * 256) * DFE * 2; return true;
    }
};

struct SchedMoe1F {
    int G, c, np; const LAS int* ptab;
    __device__ __forceinline__ bool next(int i, Unit& u) const {
        const int L = i * G + c; if (L >= np * 28) return false;
        const int pl = L / 28, j = L % 28, e = ptab[pl];
        u.pm = pl; u.pn = j; u.aoff = (size_t)pl * 256 * 1024; u.boff = ((size_t)e * 7168 + (size_t)j * 256) * 1024; return true;
    }
};
struct SchedMoe2F {
    int G, c, np; const LAS int* ptab;
    __device__ __forceinline__ bool next(int i, Unit& u) const {
        const int L = i * G + c; if (L >= np * 4) return false;
        const int pl = L >> 2, j = L & 3, e = ptab[pl];
        u.pm = pl; u.pn = j; u.aoff = (size_t)pl * 256 * DFE; u.boff = ((size_t)e * 1024 + (size_t)j * 256) * DFE; return true;
    }
};

struct TwP { const float* W; const float* gv; bf16_t* WT; int ldw, n0, nvalid, k0, ldk, kind, h; float f8sc; };
__device__ __forceinline__ TwP tw_job(int r, const float* W, int ldw, int nblk, int nvalid, bf16_t* WT, int ldk, int kind, int h, const float* gv) {
    TwP P; P.W = W; P.gv = gv; P.WT = WT; P.ldw = ldw; P.n0 = 256 * (r % nblk); P.nvalid = nvalid; P.k0 = 64 * (r / nblk); P.ldk = ldk; P.kind = kind; P.h = h; P.f8sc = 0.f; return P; }
__device__ __forceinline__ void tw_load(const TwP& P, f32x4 (&tv)[8], int wave, int lane) {
    const int n = P.n0 + 4 * lane; const float* src = P.W + (size_t)(P.k0 + 8 * wave) * P.ldw + n;
#pragma unroll
    for (int i = 0; i < 8; ++i) tv[i] = (n < P.nvalid) ? *(const f32x4*)(src + (size_t)i * P.ldw) : (f32x4){0.f, 0.f, 0.f, 0.f};
}
__device__ __forceinline__ void tw_store(const TwP& P, f32x4 (&tv)[8], LAS unsigned char* tile, int wave, int lane) {
    if (P.gv) {
#pragma unroll
        for (int i = 0; i < 8; ++i) tv[i] *= P.gv[P.k0 + 8 * wave + i]; }
    const int ng = P.n0 + 32 * wave; size_t drow;
    if (P.kind == 0) drow = ng;
    else if (P.kind == 1) drow = 256 * (ng / 128) + 128 * P.h + (ng % 128);
    else { if (ng < 512) drow = 256 * (ng / 128) + (ng % 128); else if (ng < 1024) { const int cc = ng - 512; drow = 256 * (cc / 128) + 128 + (cc % 128); } else drow = ng; }
    if (P.f8sc != 0.f) {
        const float sc = P.f8sc;
#pragma unroll
        for (int c = 0; c < 4; ++c) *(LAS u32x2*)(tile + (4 * lane + c) * 80 + 8 * wave) = pk8_fp8(tv[0][c] * sc, tv[1][c] * sc, tv[2][c] * sc, tv[3][c] * sc, tv[4][c] * sc, tv[5][c] * sc, tv[6][c] * sc, tv[7][c] * sc);
        __syncthreads();
#pragma unroll
        for (int j = 0; j < 2; ++j) { const int r = (lane >> 2) + 16 * j, ch = lane & 3;
            *(u32x4*)((unsigned char*)P.WT + (drow + r) * (size_t)P.ldk + P.k0 + 16 * ch) = *(const LAS u32x4*)(tile + (32 * wave + r) * 80 + 16 * ch); }
        __syncthreads();
        return; }
#pragma unroll
    for (int c = 0; c < 4; ++c) { u32x4 o; o.x = cvt_pk_bf16(tv[0][c], tv[1][c]); o.y = cvt_pk_bf16(tv[2][c], tv[3][c]); o.z = cvt_pk_bf16(tv[4][c], tv[5][c]); o.w = cvt_pk_bf16(tv[6][c], tv[7][c]);
        *(LAS u32x4*)(tile + (4 * lane + c) * 144 + 16 * wave) = o; }
    __syncthreads();
#pragma unroll
    for (int j = 0; j < 4; ++j) { const int r = (lane >> 3) + 8 * j, c = lane & 7;
        *(u32x4*)(P.WT + (drow + r) * (size_t)P.ldk + P.k0 + 8 * c) = *(const LAS u32x4*)(tile + (32 * wave + r) * 144 + 16 * c); }
    __syncthreads();
}
#define TW_RUN(NIT, JOB) do { const int _n = (NIT); if (_n > 0) { TwP _pa, _pb; f32x4 _ta[8], _tb[8]; JOB(_pa, 0); tw_load(_pa, _ta, F.wave, F.lane); \
    _Pragma("nounroll") for (int _i = 0; _i < _n; _i += 2) { const bool _h2 = _i + 1 < _n, _h3 = _i + 2 < _n; \
        if (_h2) { JOB(_pb, _i + 1); tw_load(_pb, _tb, F.wave, F.lane); } tw_store(_pa, _ta, F.lds, F.wave, F.lane); if (!_h2) break; \
        if (_h3) { JOB(_pa, _i + 2); tw_load(_pa, _ta, F.wave, F.lane); } tw_store(_pb, _tb, F.lds, F.wave, F.lane); } } } while (0)
__device__ __forceinline__ void xprep_row(const float* xrow, bf16_t* orow, float* rstd_out, int lane, f32x4 (&v)[4]) {
    const f32x4* xr = (const f32x4*)xrow + lane; float s = 0.f;
#pragma unroll
    for (int j = 0; j < 4; ++j) { v[j] = xr[64 * j]; s += (v[j].x * v[j].x + v[j].y * v[j].y) + (v[j].z * v[j].z + v[j].w * v[j].w); }
    const float rstd = rsqf_(wave_sum_u(s) * (1.0f / D) + EPS);
    if (orow) { u32x2* o8 = (u32x2*)orow + lane;
#pragma unroll
        for (int j = 0; j < 4; ++j) { u32x2 w; w.x = cvt_pk_bf16(v[j].x, v[j].y); w.y = cvt_pk_bf16(v[j].z, v[j].w); o8[64 * j] = w; } }
    if (lane == 0) *rstd_out = rstd;
}

constexpr float MOE_S1 = 64.f, MOE_S2 = 128.f;
constexpr int MOE_SLOT_N = 7, MOE_SLOTTED = 3 * 128 * MOE_SLOT_N;
constexpr int MOE_ITEMS = 24 * 224;
__device__ __forceinline__ TwP moe_conv_job(Frame& F, int r) {
    constexpr int J_M1 = 16 * 14, J_M2 = 56 * 4;
    unsigned char* WM1 = F.ws + WS_WM1; unsigned char* WM2 = F.ws + WS_WM2;
    if (r < 16 * J_M1) { const int q = r / J_M1, e = q >> 1, h = q & 1; TwP P = tw_job(r % J_M1, (h ? INP_(I_MW3) : INP_(I_MW1)) + (size_t)e * D * DFE, DFE, 14, DFE, (bf16_t*)(WM1 + (size_t)e * 7168 * D), D, 1, h, INP_(I_FNG) + D); P.f8sc = MOE_S1; return P; }
    r -= 16 * J_M1; const int e = r / J_M2; TwP P = tw_job(r % J_M2, INP_(I_MW2) + (size_t)e * DFE * D, D, 4, D, (bf16_t*)(WM2 + (size_t)e * D * DFE), DFE, 0, 0, nullptr); P.f8sc = MOE_S2; return P;
}
__device__ __forceinline__ void moe_conv_slot(Frame& F, int slot) {
    if (F.G != 256 || F.c < 128) return;
    { int _t = threadIdx.x; asm volatile("" : "+v"(_t)); F.tid = _t; F.lane = _t & 63; }
    int base = slot * 128 * MOE_SLOT_N + ((int)blockIdx.x - 128); asm volatile("" : "+s"(base));
#define MJOB(P, i) P = moe_conv_job(F, base + (i) * 128)
    TW_RUN(MOE_SLOT_N, MJOB);
#undef MJOB
}
__device__ __forceinline__ void xprep_rows4(const float* X, bf16_t* XBo, float* RSo, int m, int ms, int lane) {
    f32x4 v[4][4];
#pragma unroll
    for (int q = 0; q < 4; ++q) { const int mm = m + q * ms; const f32x4* xr = (const f32x4*)(X + (size_t)(mm < M ? mm : 0) * D) + lane;
#pragma unroll
        for (int j = 0; j < 4; ++j) v[q][j] = xr[64 * j]; }
#pragma unroll
    for (int q = 0; q < 4; ++q) { const int mm = m + q * ms; if (mm >= M) break; float s = 0.f;
#pragma unroll
        for (int j = 0; j < 4; ++j) s += (v[q][j].x * v[q][j].x + v[q][j].y * v[q][j].y) + (v[q][j].z * v[q][j].z + v[q][j].w * v[q][j].w);
        const float rstd = rsqf_(wave_sum_u(s) * (1.0f / D) + EPS);
        u32x2* o8 = (u32x2*)(XBo + (size_t)mm * D) + lane;
#pragma unroll
        for (int j = 0; j < 4; ++j) { u32x2 w; w.x = cvt_pk_bf16(v[q][j].x, v[q][j].y); w.y = cvt_pk_bf16(v[q][j].z, v[q][j].w); o8[64 * j] = w; }
        if (lane == 0) RSo[mm] = rstd; }
}
__device__ __forceinline__ void phase_prologue(Frame& F) {
    const int gw = F.c * NWAVES + F.wave, NGW = F.G * NWAVES;
    bf16_t* WIN = (bf16_t*)(F.ws + WS_WIN); bf16_t* WC1 = (bf16_t*)(F.ws + WS_WC1); bf16_t* WOUT = (bf16_t*)(F.ws + WS_WOUT); bf16_t* WF1 = (bf16_t*)(F.ws + WS_WF1); bf16_t* WF2 = (bf16_t*)(F.ws + WS_WF2);
    constexpr int J_IN = 16 * 10, J_C1 = 32, J_OUT = 16 * 4, J_F1 = 16 * 11, J_F2 = 44 * 4;
    constexpr int NSMALL = 2 * J_IN + 4 * J_C1 + 2 * J_OUT + 2 * J_F1 + J_F2;
    const int moe0 = (F.G == 256) ? MOE_SLOTTED : 0; const int nitems = NSMALL + MOE_ITEMS - moe0;
#define P0_JOB(P, i) do { int r = F.c + (i) * F.G; \
        if (r < 2 * J_IN) { const int l = r / J_IN; P = tw_job(r % J_IN, INP_(I_WIN) + (size_t)l * D * INW, INW, 10, INW, WIN + (size_t)l * INP * D, D, 2, 0, INP_(I_ANG) + l * D); break; } r -= 2 * J_IN; \
        if (r < 4 * J_C1) { const int q = r / J_C1, l = q >> 1, kv = q & 1; P = tw_job(r % J_C1, (kv ? INP_(I_VW1) : INP_(I_KW1)) + (size_t)l * 2048 * 256, 256, 1, 256, WC1 + (size_t)(l * 2 + kv) * 256 * 2048, 2048, 0, 0, nullptr); break; } r -= 4 * J_C1; \
        if (r < 2 * J_OUT) { const int l = r / J_OUT; P = tw_job(r % J_OUT, INP_(I_WOUT) + (size_t)l * D * D, D, 4, D, WOUT + (size_t)l * D * D, D, 0, 0, nullptr); break; } r -= 2 * J_OUT; \
        if (r < 2 * J_F1) { const int h = r / J_F1; P = tw_job(r % J_F1, (h ? INP_(I_DW3) : INP_(I_DW1)), DFF, 11, DFF, WF1, D, 1, h, INP_(I_FNG)); break; } r -= 2 * J_F1; \
        if (r < J_F2) { P = tw_job(r, INP_(I_DW2), D, 4, D, WF2, DFF, 0, 0, nullptr); break; } r -= J_F2; \
        P = moe_conv_job(F, r + moe0); } while (0)
    TW_RUN((nitems - F.c + F.G - 1) / F.G, P0_JOB);
#undef P0_JOB
    { float* RT = (float*)(F.ws + WS_RT); const int gt = F.c * NTHR + F.tid; if (gt < 8192) { const int e = gt >> 10, k = gt & 1023; RT[gt] = INP_(I_RW)[k * 8 + e] * INP_(I_FNG)[D + k]; } }
    { float* B1P = (float*)(F.ws + WS_CTL) + CW_B1P; LAS float* ps = (LAS float*)F.lds;
      for (int it = F.c; it < 128; it += F.G) { const int kc = it & 7, jb = (it >> 3) & 3, kv = (it >> 5) & 1, l = it >> 6; const int j = jb * 64 + F.lane, kb = kc * 256 + 32 * F.wave;
          const float* w1 = (kv ? INP_(I_VW1) : INP_(I_KW1)) + (size_t)l * 2048 * 256; const float* pos = (kv ? INP_(I_PV) : INP_(I_PK)) + l * 2048;
          float wv[32];
#pragma unroll
          for (int k = 0; k < 32; ++k) wv[k] = w1[(size_t)(kb + k) * 256 + j];
          float sp = 0.f;
#pragma unroll
          for (int k = 0; k < 32; ++k) sp += pos[kb + k] * wv[k];
          ps[F.wave * 64 + F.lane] = sp;
          __syncthreads();
          if (F.wave == 0) { float t = (kc == 0) ? (kv ? INP_(I_VB1) : INP_(I_KB1))[l * 256 + j] : 0.f;
#pragma unroll
              for (int ww = 0; ww < 8; ++ww) t += ps[ww * 64 + F.lane];
              B1P[kc * 1024 + (l * 2 + kv) * 256 + j] = t; }
          __syncthreads(); } }
    { bf16_t* XB = (bf16_t*)(F.ws + WS_XB); float* RS = (float*)(F.ws + WS_RSTD);
      for (int m = gw; m < M; m += 4 * NGW) xprep_rows4(INP_(I_X), XB, RS, m, NGW, F.lane); }
}

__device__ __forceinline__ void norm_rows64(bf16_t* buf, int nrows, const float* g, float scale, int gw, int NGW, int lane) {
    const int sub = lane & 7; float gv[8];
#pragma unroll
    for (int j = 0; j < 8; ++j) gv[j] = g[sub * 8 + j] * scale;
    for (int it = gw; it < nrows / 8; it += NGW) { u32x4* p = (u32x4*)(buf + ((size_t)it * 8 + (lane >> 3)) * 64) + sub; const u32x4 v = *p;
        float f[8] = {bf_lo(v.x), bf_hi(v.x), bf_lo(v.y), bf_hi(v.y), bf_lo(v.z), bf_hi(v.z), bf_lo(v.w), bf_hi(v.w)}; float s = 0.f;
#pragma unroll
        for (int j = 0; j < 8; ++j) s += f[j] * f[j];
        s += __shfl_xor(s, 1); s += __shfl_xor(s, 2); s += __shfl_xor(s, 4);
        const float rs = rsqf_(s * (1.0f / 64.0f) + EPS);
        u32x4 o; o.x = cvt_pk_bf16(f[0] * rs * gv[0], f[1] * rs * gv[1]); o.y = cvt_pk_bf16(f[2] * rs * gv[2], f[3] * rs * gv[3]); o.z = cvt_pk_bf16(f[4] * rs * gv[4], f[5] * rs * gv[5]); o.w = cvt_pk_bf16(f[6] * rs * gv[6], f[7] * rs * gv[7]);
        *p = o; }
}
__device__ __forceinline__ float sum32_(float v, bool) {
    v = DPP_ADD(v, 0xB1); v = DPP_ADD(v, 0x4E); v = DPP_ADD(v, 0x124); v = DPP_ADD(v, 0x128);
    return v + __shfl_xor(v, 16);
}
__device__ __forceinline__ void conv_unit(Frame& F, int layer, int cu) {
    const int b = cu >> 6, t0 = (cu & 63) * 32; int tid = F.tid; asm volatile("" : "+v"(tid));
    const bf16_t* U = (const bf16_t*)(F.ws + WS_U); bf16_t* MIX = (bf16_t*)(F.ws + WS_MIX);
    LAS u32x4* L4 = (LAS u32x4*)F.lds;
    { u32x4 sv[8];
#pragma unroll
      for (int q = 0; q < 8; ++q) { const int i = tid + q * NTHR, row = i >> 6, ch = i & 63, t = t0 - 30 + row; sv[q] = (u32x4){0u, 0u, 0u, 0u}; if (i < 62 * 64 && t >= 0) sv[q] = *(const u32x4*)(U + (size_t)(b * SEQ + t) * CW + ch * 8); }
#pragma unroll
      for (int q = 0; q < 8; ++q) { const int i = tid + q * NTHR; if (i < 62 * 64) L4[i] = sv[q]; } }
    __syncthreads();
    const int cp = tid & 255, th = tid >> 8; const bool hi = (tid & 32) != 0; const LAS unsigned* LW = (const LAS unsigned*)F.lds;
    f32x2 w[CKW];
#pragma unroll
    for (int k = 0; k < CKW; ++k) w[k] = *(const f32x2*)(INP_(I_CDW) + (size_t)layer * CKW * CW + k * CW + 2 * cp);
    const f32x2 cb = *(const f32x2*)(INP_(I_CDB) + layer * CW + 2 * cp), lg = *(const f32x2*)(INP_(I_CLG) + layer * CW + 2 * cp), lb = *(const f32x2*)(INP_(I_CLB) + layer * CW + 2 * cp);
#pragma nounroll
    for (int hf = 0; hf < 2; ++hf) { const int tl0 = th * 16 + hf * 8;
        f32x2 in[38];
#pragma unroll
        for (int i = 0; i < 38; ++i) { const unsigned v = LW[(tl0 + i) * 256 + cp]; in[i] = (f32x2){bf_lo(v), bf_hi(v)}; }
        f32x2 acc[8];
#pragma unroll
        for (int t = 0; t < 8; ++t) { acc[t] = cb;
#pragma unroll
            for (int k = 0; k < CKW; ++k) acc[t] += w[k] * in[t + k]; }
#pragma unroll
        for (int t = 0; t < 8; ++t) {
            const float s = sum32_(acc[t].x + acc[t].y, hi), q = sum32_(acc[t].x * acc[t].x + acc[t].y * acc[t].y, hi);
            const float mu = s * (1.0f / 64.0f), var = fmaxf(q * (1.0f / 64.0f) - mu * mu, 0.f), rs = rsqf_(var + EPS);
            const float a0 = (acc[t].x - mu) * rs * lg.x + lb.x, a1 = (acc[t].y - mu) * rs * lg.y + lb.y;
            *(unsigned*)(MIX + (size_t)(b * SEQ + t0 + tl0 + t) * D + 2 * cp) = cvt_pk_bf16(siluf_(a0), siluf_(a1)); }
    }
    __syncthreads();
}
__device__ __forceinline__ void vtrans_items(Frame& F, int gw, int NGW) {
    const int lane = F.lane;
    LAS unsigned char* scr = F.lds + F.wave * 9216;
    for (int it = gw; it < 1024; it += NGW) { const int ten = it >> 9, bh = (it >> 5) & 15, kb = it & 31;
        const bf16_t* V = (const bf16_t*)(F.ws + WS_KV) + (size_t)(ten ? 5 : 3) * KVT + ((size_t)bh * SEQ + kb * 64) * 64; bf16_t* VT = (bf16_t*)(F.ws + (ten ? WS_VWT : WS_VST)) + (size_t)bh * 64 * SEQ + kb * 64;
#pragma unroll
        for (int c = 0; c < 8; ++c) *(LAS u32x4*)(scr + lane * 144 + c * 16) = *((const u32x4*)(V + (size_t)lane * 64) + c);
        LDS_WAIT(); __builtin_amdgcn_wave_barrier(); asm volatile("" ::: "memory");
#pragma unroll
        for (int c = 0; c < 8; ++c) { unsigned w[4];
#pragma unroll
            for (int q = 0; q < 4; ++q) { const int v0 = 8 * c + 2 * q, k0 = swap23(v0), k1 = swap23(v0 + 1);
                w[q] = (unsigned)*(const LAS bf16_t*)(scr + k0 * 144 + lane * 2) | ((unsigned)*(const LAS bf16_t*)(scr + k1 * 144 + lane * 2) << 16); }
            *((u32x4*)(VT + (size_t)lane * SEQ) + c) = (u32x4){w[0], w[1], w[2], w[3]}; }
        LDS_WAIT(); __builtin_amdgcn_wave_barrier(); asm volatile("" ::: "memory");
    }
}
__device__ __forceinline__ void phase_cmp2(Frame& F, int layer) {
    const int lane = F.lane, w = F.wave, k0 = 32 * w;
    const float* H1 = (const float*)(F.ws + WS_H1); const float* B1P = (const float*)(F.ws + WS_CTL) + CW_B1P + layer * 512;
    LAS float* part = (LAS float*)F.lds;
#pragma nounroll
    for (int un = F.c; un < 256; un += F.G) { const int kv = un >> 7, R0 = (un & 127) * 16;
        const float* w2 = (kv ? INP_(I_VW2) : INP_(I_KW2)) + (size_t)layer * 16384 + (size_t)k0 * 64 + lane;
        float w2r[32];
#pragma unroll
        for (int j = 0; j < 32; ++j) w2r[j] = w2[j * 64];
        float bsum = 0.f;
#pragma unroll
        for (int sp = 0; sp < 8; ++sp) bsum += B1P[sp * 1024 + kv * 256 + k0 + (lane & 31)];
        float acc[16], hx[16];
        {
            float hp[16][8];
#pragma unroll
            for (int r = 0; r < 16; ++r)
#pragma unroll
                for (int sp = 0; sp < 8; ++sp) hp[r][sp] = H1[((size_t)kv * 2048 + R0 + r) * 256 + k0 + (lane & 31) + (size_t)sp * 2 * 2048 * 256];
#pragma unroll
            for (int r = 0; r < 16; ++r) { float x = 0.f;
#pragma unroll
                for (int sp = 0; sp < 8; ++sp) x += hp[r][sp];
                hx[r] = siluf_(x + bsum); } }
#pragma unroll
        for (int r = 0; r < 16; ++r) { const int hb = __builtin_bit_cast(int, hx[r]); float a = 0.f;
#pragma unroll
            for (int j = 0; j < 32; ++j) a += __builtin_bit_cast(float, __builtin_amdgcn_readlane(hb, j)) * w2r[j];
            acc[r] = a; }
#pragma unroll
        for (int r = 0; r < 16; ++r) part[(w * 16 + r) * 64 + lane] = acc[r];
        __syncthreads();
#pragma unroll
        for (int rr = 0; rr < 2; ++rr) { const int r = 2 * w + rr, R = R0 + r;
            float a = (kv ? INP_(I_VB2) : INP_(I_KB2))[layer * 64 + lane];
#pragma unroll
            for (int ww = 0; ww < 8; ++ww) a += part[(ww * 16 + r) * 64 + lane];
            if ((R & 127) == 127) a = 0.f;
            else if (kv == 0) { const float ms = wave_sum_u(a * a) * (1.0f / 64.0f); a = a * (rsqf_(ms + EPS)) * INP_(I_KG)[layer * 192 + lane]; }
            const bf16_t ab = (bf16_t)(cvt_pk_bf16(a, 0.f) & 0xffffu);
            ((bf16_t*)(F.ws + (kv ? WS_VC : WS_KC)))[(size_t)R * 64 + lane] = ab;
            if (kv) ((bf16_t*)(F.ws + WS_VCT))[((size_t)(R >> 7) * 64 + lane) * 128 + swap23(R & 127)] = ab; }
        __syncthreads();
    }
}

__device__ __forceinline__ void dots4(const bf16_t* krow, const LAS float* qs, float (&s)[4]) {
    s[0] = s[1] = s[2] = s[3] = 0.f;
#pragma nounroll
    for (int c = 0; c < 8; ++c) { const u32x4 v = *((const u32x4*)krow + c);
        const float f[8] = {bf_lo(v.x), bf_hi(v.x), bf_lo(v.y), bf_hi(v.y), bf_lo(v.z), bf_hi(v.z), bf_lo(v.w), bf_hi(v.w)};
#pragma unroll
        for (int h = 0; h < 4; ++h) { const f32x4 q0 = *(const LAS f32x4*)(qs + h * 64 + c * 8), q1 = *(const LAS f32x4*)(qs + h * 64 + c * 8 + 4);
            s[h] += (f[0] * q0.x + f[1] * q0.y) + (f[2] * q0.z + f[3] * q0.w) + (f[4] * q1.x + f[5] * q1.y) + (f[6] * q1.z + f[7] * q1.w); } }
}
__device__ __forceinline__ void softmax_pv(LAS f32x4* sb, const LAS int* kb, int nk, const bf16_t* V, int lane, float (&o)[4]) {
    float m[4] = {-1e30f, -1e30f, -1e30f, -1e30f};
#pragma nounroll
    for (int c = 0; c < nk; ++c) { const f32x4 s = sb[c * 64 + lane]; m[0] = fmaxf(m[0], s.x); m[1] = fmaxf(m[1], s.y); m[2] = fmaxf(m[2], s.z); m[3] = fmaxf(m[3], s.w); }
#pragma unroll
    for (int h = 0; h < 4; ++h) m[h] = wave_max(m[h]);
    float sum[4] = {0.f, 0.f, 0.f, 0.f};
#pragma nounroll
    for (int c = 0; c < nk; ++c) { const f32x4 s = sb[c * 64 + lane]; f32x4 p;
        p.x = s.x > -1e29f ? __expf(s.x - m[0]) : 0.f; p.y = s.y > -1e29f ? __expf(s.y - m[1]) : 0.f; p.z = s.z > -1e29f ? __expf(s.z - m[2]) : 0.f; p.w = s.w > -1e29f ? __expf(s.w - m[3]) : 0.f;
        sum[0] += p.x; sum[1] += p.y; sum[2] += p.z; sum[3] += p.w; sb[c * 64 + lane] = p; }
    float inv[4];
#pragma unroll
    for (int h = 0; h < 4; ++h) inv[h] = rcpf_(fmaxf(wave_sum(sum[h]), 1e-30f));
    LDS_WAIT(); __builtin_amdgcn_wave_barrier(); asm volatile("" ::: "memory");
    o[0] = o[1] = o[2] = o[3] = 0.f;
#pragma nounroll
    for (int c = 0; c < nk; ++c) { const int k0 = kb[c];
#pragma unroll 4
        for (int kk = 0; kk < 64; ++kk) { int key = k0 + kk; key = key < 0 ? 0 : (key > SEQ - 1 ? SEQ - 1 : key);
            const f32x4 p = sb[c * 64 + kk]; const float v = bf2f(V[(size_t)key * 64 + lane]);
            o[0] += p.x * v; o[1] += p.y * v; o[2] += p.z * v; o[3] += p.w * v; } }
#pragma unroll
    for (int h = 0; h < 4; ++h) o[h] *= inv[h];
    __builtin_amdgcn_wave_barrier(); asm volatile("" ::: "memory");
}
__device__ __forceinline__ void phase_attn_ref(Frame& F, int layer) {
    const int lane = F.lane;
    LAS unsigned char* wl = F.lds + F.wave * 12288;
    LAS float* qs = (LAS float*)wl;
    LAS f32x4* pc = (LAS f32x4*)(wl + 1024);
    LAS float* psum = (LAS float*)(wl + 3072);
    LAS int* kbl = (LAS int*)(wl + 3584);
    LAS f32x4* sb = (LAS f32x4*)(wl + 4096);
    const bf16_t* QN = (const bf16_t*)(F.ws + WS_Q); const bf16_t* KVb = (const bf16_t*)(F.ws + WS_KV);
    const bf16_t* KC = (const bf16_t*)(F.ws + WS_KC); const bf16_t* VC = (const bf16_t*)(F.ws + WS_VC);
    const float* GT = (const float*)(F.ws + WS_GT); bf16_t* MIX = (bf16_t*)(F.ws + WS_MIX);
#pragma nounroll
    for (int un = F.c; un < NBH * 64; un += F.G) {
        const int bh = un >> 6, tile = un & 63, b = bh >> 1, kvh = bh & 1;
        const bf16_t* KS = KVb + 2 * KVT + (size_t)bh * SEQ * 64; const bf16_t* VS = KVb + 3 * KVT + (size_t)bh * SEQ * 64;
        const bf16_t* KW = KVb + 4 * KVT + (size_t)bh * SEQ * 64; const bf16_t* VW = KVb + 5 * KVT + (size_t)bh * SEQ * 64;
#pragma nounroll
        for (int ti = 0; ti < 4; ++ti) {
            const int t = tile * 32 + F.wave * 4 + ti, r = b * SEQ + t;
#pragma unroll
            for (int h = 0; h < 4; ++h) qs[h * 64 + lane] = bf2f(QN[(size_t)r * 512 + (kvh * 4 + h) * 64 + lane]);
            LDS_WAIT(); __builtin_amdgcn_wave_barrier(); asm volatile("" ::: "memory");
            float sc[2][4]; bool vc[2];
#pragma unroll
            for (int u = 0; u < 2; ++u) { const int c = lane + 64 * u; vc[u] = (c < NCMP) && (16 * c + 31 <= t);
                if (vc[u]) dots4(KC + ((size_t)bh * 128 + c) * 64, qs, sc[u]); else { sc[u][0] = sc[u][1] = sc[u][2] = sc[u][3] = -1e30f; } }
            float pr[2][4];
#pragma unroll
            for (int h = 0; h < 4; ++h) { const float mx = wave_max(fmaxf(sc[0][h], sc[1][h]));
                pr[0][h] = vc[0] ? __expf(sc[0][h] - mx) : 0.f; pr[1][h] = vc[1] ? __expf(sc[1][h] - mx) : 0.f;
                const float inv = rcpf_(fmaxf(wave_sum(pr[0][h] + pr[1][h]), 1e-30f)); pr[0][h] *= inv; pr[1][h] *= inv; }
#pragma unroll
            for (int u = 0; u < 2; ++u) { pc[lane + 64 * u] = (f32x4){pr[u][0], pr[u][1], pr[u][2], pr[u][3]}; psum[lane + 64 * u] = (pr[u][0] + pr[u][1]) + (pr[u][2] + pr[u][3]); }
            LDS_WAIT(); __builtin_amdgcn_wave_barrier(); asm volatile("" ::: "memory");
            const int j = lane & 31, cur = t >> 6; float imp = 0.f;
#pragma unroll
            for (int cc = -1; cc <= 3; ++cc) { const int c = 4 * j + cc; if (c >= 0 && c < NCMP) imp += psum[c]; }
            const bool causal = (j * 64 <= t), forced = (j == 0) || (j == cur) || (j == cur - 1);
            const float score = causal ? (forced ? imp + 1e4f : imp) : -1e30f;
            int rank = 0;
#pragma unroll
            for (int i = 0; i < 32; ++i) { const float si = __shfl(score, i); rank += (si > score || (si == score && i < j)) ? 1 : 0; }
            const unsigned selmask = (unsigned)__ballot(lane < 32 && rank < 8 && causal);
            float ocmp[4] = {0.f, 0.f, 0.f, 0.f};
            { const int nvc = t >= 31 ? (((t - 31) >> 4) + 1 > NCMP ? NCMP : ((t - 31) >> 4) + 1) : 0;
#pragma unroll 4
              for (int c = 0; c < nvc; ++c) { const f32x4 p = pc[c]; const float v = bf2f(VC[((size_t)bh * 128 + c) * 64 + lane]); ocmp[0] += p.x * v; ocmp[1] += p.y * v; ocmp[2] += p.z * v; ocmp[3] += p.w * v; } }
            __builtin_amdgcn_wave_barrier(); asm volatile("" ::: "memory");
            int nk = 0; float osel[4], owin[4];
#pragma nounroll
            for (unsigned mm = selmask; mm != 0u && nk < 8; mm &= mm - 1u) { const int jj = __builtin_ctz(mm);
                const int key = jj * 64 + lane; float s[4];
                if (key <= t) dots4(KS + (size_t)key * 64, qs, s); else { s[0] = s[1] = s[2] = s[3] = -1e30f; }
                sb[nk * 64 + lane] = (f32x4){s[0], s[1], s[2], s[3]};
                if (lane == 0) kbl[nk] = jj * 64;
                ++nk; }
            LDS_WAIT(); __builtin_amdgcn_wave_barrier(); asm volatile("" ::: "memory");
            softmax_pv(sb, kbl, nk, VS, lane, osel);
            nk = 0;
#pragma nounroll
            for (int ch = 0; ch < 8; ++ch) { const int k0 = t - 511 + 64 * ch; if (k0 + 63 < 0) continue;
                const int key = k0 + lane; float s[4];
                if (key >= 0) dots4(KW + (size_t)key * 64, qs, s); else { s[0] = s[1] = s[2] = s[3] = -1e30f; }
                sb[nk * 64 + lane] = (f32x4){s[0], s[1], s[2], s[3]};
                if (lane == 0) kbl[nk] = k0;
                ++nk; }
            LDS_WAIT(); __builtin_amdgcn_wave_barrier(); asm volatile("" ::: "memory");
            softmax_pv(sb, kbl, nk, VW, lane, owin);
#pragma unroll
            for (int h = 0; h < 4; ++h) { const float* gp = GT + (size_t)r * 24 + (kvh * 4 + h) * 3;
                const float o = sigmoidf_(gp[0]) * ocmp[h] + sigmoidf_(gp[1]) * osel[h] + sigmoidf_(gp[2]) * owin[h];
                MIX[(size_t)r * D + 512 + (kvh * 4 + h) * 64 + lane] = (bf16_t)(cvt_pk_bf16(o, 0.f) & 0xffffu); }
            __builtin_amdgcn_wave_barrier(); asm volatile("" ::: "memory");
        }
    }
}


constexpr int AT_KB = 0, AT_VB = 18432, AT_WUN = 36864, AT_OT = 40960;
__device__ __forceinline__ int crow_(int i) { return (i & 3) + 8 * (i >> 2); }
__device__ __forceinline__ float fmax_(float a, float b) { return __builtin_amdgcn_fmed3f(a, b, __builtin_inff()); }
template <int MODE>
__device__ __forceinline__ void attn_tile(const LAS unsigned char* KB, const LAS unsigned char* VB, const bf16x8 (&Qf)[4], f32x16 (&O)[2], float cref, float& l, int tl, int lo, bool rowok, int n, int h) {
    f32x16 S0, S1;
#pragma unroll
    for (int i = 0; i < 16; ++i) { S0[i] = 0.f; S1[i] = 0.f; }
#pragma unroll
    for (int s = 0; s < 4; ++s) { const bf16x8 k0 = *(const LAS bf16x8*)(KB + n * 144 + (16 * s + 8 * h) * 2), k1 = *(const LAS bf16x8*)(KB + (32 + n) * 144 + (16 * s + 8 * h) * 2);
        S0 = MFMA32(k0, Qf[s], S0); S1 = MFMA32(k1, Qf[s], S1); }
    if (MODE != 0) {
#pragma unroll
        for (int i = 0; i < 16; ++i) { const int c0 = crow_(i), c1 = 32 + crow_(i);
            if (MODE == 1) { S0[i] = rowok ? S0[i] : -1e30f; S1[i] = rowok ? S1[i] : -1e30f; }
            if (MODE == 2) { S0[i] = (c0 <= tl && c0 > lo) ? S0[i] : -1e30f; S1[i] = (c1 <= tl && c1 > lo) ? S1[i] : -1e30f; } } }
    f32x2 ls2 = {0.f, 0.f}; const f32x2 mr2 = {cref, cref};
#pragma unroll
    for (int i = 0; i < 8; ++i) { f32x2 a = (f32x2){S0[2 * i], S0[2 * i + 1]} - mr2, b = (f32x2){S1[2 * i], S1[2 * i + 1]} - mr2;
        a.x = __builtin_amdgcn_exp2f(a.x); a.y = __builtin_amdgcn_exp2f(a.y); b.x = __builtin_amdgcn_exp2f(b.x); b.y = __builtin_amdgcn_exp2f(b.y);
        S0[2 * i] = a.x; S0[2 * i + 1] = a.y; S1[2 * i] = b.x; S1[2 * i + 1] = b.y; ls2 += a + b; }
    l += ls2.x + ls2.y;
    const bf16x8 P00 = pack8<0>(S0), P01 = pack8<8>(S0), P10 = pack8<0>(S1), P11 = pack8<8>(S1);
    __builtin_amdgcn_sched_barrier(0);
#pragma unroll
    for (int d = 0; d < 2; ++d) { const LAS unsigned char* vb = VB + (32 * d + n) * 144 + 8 * h * 2;
        O[d] = MFMA32(*(const LAS bf16x8*)(vb + 0), P00, O[d]); O[d] = MFMA32(*(const LAS bf16x8*)(vb + 32), P01, O[d]);
        O[d] = MFMA32(*(const LAS bf16x8*)(vb + 64), P10, O[d]); O[d] = MFMA32(*(const LAS bf16x8*)(vb + 96), P11, O[d]); }
}
__device__ __forceinline__ void attn_stage64(LAS unsigned char* lds, const bf16_t* K, const bf16_t* VT, int tid) {
    const int row = tid >> 3, ch = tid & 7;
    const u32x4 kv = *((const u32x4*)K + tid), vv = *(const u32x4*)(VT + (size_t)row * SEQ + ch * 8);
    *(LAS u32x4*)(lds + AT_KB + row * 144 + ch * 16) = kv; *(LAS u32x4*)(lds + AT_VB + row * 144 + ch * 16) = vv;
}
__device__ __forceinline__ void phase_attn_mfma(Frame& F, int layer) {
    const int lane = F.lane, tid = F.tid, n = lane & 31, h = lane >> 5, w = F.wave;
    LAS unsigned char* lds = F.lds; const LAS unsigned char* KB = lds + AT_KB; const LAS unsigned char* VB = lds + AT_VB; volatile LAS unsigned* WUN = (volatile LAS unsigned*)(lds + AT_WUN);
    const bf16_t* QN = (const bf16_t*)(F.ws + WS_Q); const bf16_t* KVb = (const bf16_t*)(F.ws + WS_KV);
    const bf16_t* KC = (const bf16_t*)(F.ws + WS_KC); const bf16_t* VCT = (const bf16_t*)(F.ws + WS_VCT);
    const bf16_t* VST = (const bf16_t*)(F.ws + WS_VST); const bf16_t* VWT = (const bf16_t*)(F.ws + WS_VWT);
    const float* GT = (const float*)(F.ws + WS_GT); bf16_t* MIX = (bf16_t*)(F.ws + WS_MIX);
    float cref;
    { const float gq = fabsf(INP_(I_QG)[layer * 64 + lane]); const float* kg = INP_(I_KG) + layer * 192;
      const float gk = fmaxf(fabsf(kg[lane]), fmaxf(fabsf(kg[64 + lane]), fabsf(kg[128 + lane])));
      const float bound = 1.44269504089f * 8.0f * wave_max(gq) * wave_max(gk); cref = fmaxf(bound - 16.0f, 0.f); }
#pragma nounroll
    for (int ui = 0; ui < 2; ++ui) {
        const int bh = (F.c >> 5) + 8 * ui, tb = ui ? 31 - (F.c & 31) : (F.c & 31);
        if (F.c >= 256) break;
        const int b = bh >> 1, kvh = bh & 1, t0 = tb * 64, cur = tb;
        const int tt = t0 + 8 * w + (n >> 2), hd = n & 3; const size_t r = (size_t)b * SEQ + tt;
        bf16x8 Qf[4]; { const bf16_t* qp = QN + r * 512 + (kvh * 4 + hd) * 64 + 8 * h;
#pragma unroll
            for (int s = 0; s < 4; ++s) Qf[s] = *(const bf16x8*)(qp + 16 * s); }
        {
            float qv[4][8]; float ss = 0.f;
#pragma unroll
            for (int s = 0; s < 4; ++s) { const u32x4 wq = __builtin_bit_cast(u32x4, Qf[s]);
                qv[s][0] = bf_lo(wq.x); qv[s][1] = bf_hi(wq.x); qv[s][2] = bf_lo(wq.y); qv[s][3] = bf_hi(wq.y); qv[s][4] = bf_lo(wq.z); qv[s][5] = bf_hi(wq.z); qv[s][6] = bf_lo(wq.w); qv[s][7] = bf_hi(wq.w);
#pragma unroll
                for (int j = 0; j < 8; ++j) ss += qv[s][j] * qv[s][j]; }
            ss += __shfl_xor(ss, 32);
            const float rsq = rsqf_(ss * (1.0f / 64.0f) + EPS) * (0.125f * 1.44269504089f); const float* qg     = INP_(I_QG) + layer * 64 + 8 * h;
#pragma unroll
            for (int s = 0; s < 4; ++s) { const f32x4 ga = *(const f32x4*)(qg + 16 * s), gb = *(const f32x4*)(qg + 16 * s + 4);
                u32x4 wq; wq.x = pk_bf16(qv[s][0] * rsq * ga.x, qv[s][1] * rsq * ga.y); wq.y = pk_bf16(qv[s][2] * rsq * ga.z, qv[s][3] * rsq * ga.w);
                wq.z = pk_bf16(qv[s][4] * rsq * gb.x, qv[s][5] * rsq * gb.y); wq.w = pk_bf16(qv[s][6] * rsq * gb.z, qv[s][7] * rsq * gb.w); Qf[s] = __builtin_bit_cast(bf16x8, wq); } }
        const float* gp = GT + r * 24 + (kvh * 4 + hd) * 3; const float g0 = sigmoidf_(gp[0]), g1 = sigmoidf_(gp[1]), g2 = sigmoidf_(gp[2]);
        f32x16 Ob[2]; LAS f32x4* OT = (LAS f32x4*)(lds + AT_OT + w * 8192) + lane;
        unsigned tokmask, wmask;
        __syncthreads();
#pragma unroll
        for (int q = 0; q < 2; ++q) { const int i = tid + 512 * q;
            *(LAS u32x4*)(lds + AT_KB + (i >> 3) * 144 + (i & 7) * 16) = *((const u32x4*)(KC + (size_t)bh * 128 * 64) + i);
            *(LAS u32x4*)(lds + AT_VB + (i >> 4) * 272 + (i & 15) * 16) = *((const u32x4*)(VCT + (size_t)bh * 64 * 128) + i); }
        __syncthreads();
        {
            f32x16 S[4];
#pragma unroll
            for (int ta = 0; ta < 4; ++ta) {
#pragma unroll
                for (int i = 0; i < 16; ++i) S[ta][i] = 0.f;
#pragma unroll
                for (int s = 0; s < 4; ++s) S[ta] = MFMA32(*(const LAS bf16x8*)(KB + (32 * ta + n) * 144 + (16 * s + 8 * h) * 2), Qf[s], S[ta]); }
            const int cmax = tt >= 31 ? (((tt - 31) >> 4) > 126 ? 126 : ((tt - 31) >> 4)) : -1, lim = cmax - 4 * h;
            float ls = 0.f;
#pragma unroll
            for (int ta = 0; ta < 4; ++ta)
#pragma unroll
                for (int i = 0; i < 16; ++i) { const float p = (32 * ta + crow_(i) <= lim) ? __builtin_amdgcn_exp2f(S[ta][i] - cref) : 0.f; S[ta][i] = p; ls += p; }
            ls += __shfl_xor(ls, 32);
            const float inv = rcpf_(fmaxf(ls, 1e-30f));
#pragma unroll
            for (int ta = 0; ta < 4; ++ta)
#pragma unroll
                for (int i = 0; i < 16; ++i) S[ta][i] *= inv;
            float val[4][4]; unsigned kk[4];
#pragma unroll
            for (int ta = 0; ta < 4; ++ta)
#pragma unroll
                for (int u = 0; u < 4; ++u) { val[ta][u] = (S[ta][4 * u] + S[ta][4 * u + 1]) + (S[ta][4 * u + 2] + S[ta][4 * u + 3]); }
            {   float xs[4][4];
#pragma unroll
                for (int ta = 0; ta < 4; ++ta)
#pragma unroll
                    for (int u = 0; u < 4; ++u) xs[ta][u] = __shfl_xor(S[ta][4 * u + 3], 32);
#pragma unroll
                for (int ta = 0; ta < 4; ++ta)
#pragma unroll
                    for (int u = 0; u < 4; ++u) { const float pv0 = (u > 0) ? xs[ta][u > 0 ? u - 1 : 0] : (ta > 0 ? xs[ta > 0 ? ta - 1 : 0][3] : 0.f); val[ta][u] += (h ? xs[ta][u] : pv0); } }
            const bf16x8 P0 = pack8<0>(S[0]), P1 = pack8<8>(S[0]), P2 = pack8<0>(S[1]), P3 = pack8<8>(S[1]), P4 = pack8<0>(S[2]), P5 = pack8<8>(S[2]), P6 = pack8<0>(S[3]), P7 = pack8<8>(S[3]);
            __builtin_amdgcn_sched_barrier(0);
            const bool b0 = (n & 1) != 0, b1 = (n & 2) != 0; const int hd2 = 2 * (n & 3) + h;
#define DPPF(x, ctrl) __builtin_bit_cast(float, __builtin_amdgcn_update_dpp(0, __builtin_bit_cast(int, (x)), (ctrl), 0xF, 0xF, true))
#define DPPU(x, ctrl) ((unsigned)__builtin_amdgcn_update_dpp(0, (int)(x), (ctrl), 0xF, 0xF, true))
#pragma unroll
            for (int ta = 0; ta < 4; ++ta) {
                const float m0 = b0 ? val[ta][1] : val[ta][0], s0 = b0 ? val[ta][0] : val[ta][1], m1 = b0 ? val[ta][3] : val[ta][2], s1 = b0 ? val[ta][2] : val[ta][3];
                const float r0 = m0 + DPPF(s0, 0xB1), r1 = m1 + DPPF(s1, 0xB1);
                const float mm = b1 ? r1 : r0, ss = b1 ? r0 : r1; const float v = mm + DPPF(ss, 0x4E);
                const int G = 8 * ta + hd2; const bool causal = G <= cur, forced = (G == 0) || (G == cur) || (G == cur - 1);
                kk[ta] = causal ? ((forced ? 0x7f000000u : (__float_as_uint(v) & ~31u)) | (unsigned)(31 - G)) : 0u; }
            __builtin_amdgcn_sched_barrier(0);
#pragma unroll
            for (int d = 0; d < 2; ++d) {
#pragma unroll
                for (int i = 0; i < 16; ++i) Ob[d][i] = 0.f;
                const LAS unsigned char* vb = VB + (32 * d + n) * 272 + 8 * h * 2;
                Ob[d] = MFMA32(*(const LAS bf16x8*)(vb + 0), P0, Ob[d]); Ob[d] = MFMA32(*(const LAS bf16x8*)(vb + 32), P1, Ob[d]);
                Ob[d] = MFMA32(*(const LAS bf16x8*)(vb + 64), P2, Ob[d]); Ob[d] = MFMA32(*(const LAS bf16x8*)(vb + 96), P3, Ob[d]);
                Ob[d] = MFMA32(*(const LAS bf16x8*)(vb + 128), P4, Ob[d]); Ob[d] = MFMA32(*(const LAS bf16x8*)(vb + 160), P5, Ob[d]);
                Ob[d] = MFMA32(*(const LAS bf16x8*)(vb + 192), P6, Ob[d]); Ob[d] = MFMA32(*(const LAS bf16x8*)(vb + 224), P7, Ob[d]);
#pragma unroll
                for (int q = 0; q < 4; ++q) OT[(4 * d + q) * 64] = (f32x4){Ob[d][4 * q] * g0, Ob[d][4 * q + 1] * g0, Ob[d][4 * q + 2] * g0, Ob[d][4 * q + 3] * g0}; }
            __builtin_amdgcn_sched_barrier(0);
            unsigned selbits = 0u;
#pragma unroll
            for (int rd = 0; rd < 8; ++rd) { unsigned mk = kk[0] > kk[1] ? kk[0] : kk[1]; { const unsigned m2 = kk[2] > kk[3] ? kk[2] : kk[3]; mk = m2 > mk ? m2 : mk; }
                { const unsigned o = DPPU(mk, 0xB1); mk = o > mk ? o : mk; } { const unsigned o = DPPU(mk, 0x4E); mk = o > mk ? o : mk; }
                { const unsigned o = (unsigned)__shfl_xor((int)mk, 32); mk = o > mk ? o : mk; }
#pragma unroll
                for (int ta = 0; ta < 4; ++ta) { const bool hit = (kk[ta] == mk) && (mk != 0u); selbits |= hit ? ((1u << (8 * ta)) << hd2) : 0u; kk[ta] = hit ? 0u : kk[ta]; } }
            selbits |= DPPU(selbits, 0xB1); selbits |= DPPU(selbits, 0x4E);
            tokmask = selbits | (unsigned)__shfl_xor((int)selbits, 32);
#undef DPPF
#undef DPPU
            unsigned wm = tokmask; wm |= (unsigned)__shfl_xor((int)wm, 4); wm |= (unsigned)__shfl_xor((int)wm, 8); wm |= (unsigned)__shfl_xor((int)wm, 16);
            wmask = (unsigned)__builtin_amdgcn_readfirstlane((int)wm);
            if (lane == 0) WUN[w] = wmask;
        }
        __syncthreads();
        unsigned uall = 0u;
#pragma unroll
        for (int q = 0; q < 8; ++q) uall |= WUN[q];
        uall = (unsigned)__builtin_amdgcn_readfirstlane((int)uall);
        if (PROBE_MASK & 0x6000000u) { if (lane == 0) ((unsigned*)(F.ws + WS_SLOT + 3 * MAXSLOT * 4))[(blockIdx.x * 2 + ui) * 8 + w] = (unsigned)__builtin_popcount(uall) | ((unsigned)__builtin_popcount(wmask) << 8); }
        float l = 0.f;
#pragma unroll
        for (int d = 0; d < 2; ++d)
#pragma unroll
            for (int i = 0; i < 16; ++i) Ob[d][i] = 0.f;
        const int j0 = cur > 8 ? cur - 8 : 0, nwin = cur - j0 + 1, ntile = nwin + __builtin_popcount(uall);
        const int srow = tid >> 3, sch = tid & 7;
        int lidx = 0, cidx = 0; unsigned lmm = uall, cmm = uall; u32x4 rk0, rv0, rk1, rv1, rk2, rv2;
#define AT_NEXT(idx, mm, wh, jj) do { if ((idx) < nwin) { (wh) = 1; (jj) = j0 + (idx); } else { (wh) = 0; (jj) = (mm) ? __builtin_ctz(mm) : 0; (mm) &= (mm) - 1u; } ++(idx); } while (0)
#define AT_LOAD(rk, rv) do { int _wh, _jj; AT_NEXT(lidx, lmm, _wh, _jj); const bf16_t* _kp = KVb + (size_t)(_wh ? 4 : 2) * KVT + ((size_t)bh * SEQ + _jj * 64) * 64; const bf16_t* _vp = (_wh ? VWT : VST) + (size_t)bh * 64 * SEQ + _jj * 64; \
        rk = *((const u32x4*)_kp + tid); rv = *(const u32x4*)(_vp + (size_t)srow * SEQ + sch * 8); } while (0)
#define AT_WRITE(b, rk, rv) do { *(LAS u32x4*)(lds + (b) * 18432 + srow * 144 + sch * 16) = rk; *(LAS u32x4*)(lds + (b) * 18432 + 9216 + srow * 144 + sch * 16) = rv; } while (0)
        AT_LOAD(rk0, rv0); AT_LOAD(rk1, rv1); AT_LOAD(rk2, rv2);
        AT_WRITE(0, rk0, rv0);
        AT_LOAD(rk0, rv0);
#define AT_STEP(i, RK, RV) do { asm volatile("s_waitcnt lgkmcnt(0)" ::: "memory"); __builtin_amdgcn_s_barrier(); asm volatile("" ::: "memory"); \
            AT_WRITE(((i) + 1) & 1, RK, RV); AT_LOAD(RK, RV); \
            int wh, j; AT_NEXT(cidx, cmm, wh, j); \
            if (i == nwin) { \
                const float lt = l + __shfl_xor(l, 32), sc = g2 * rcpf_(fmaxf(lt, 1e-30f)); \
_Pragma("unroll") \
                for (int d = 0; d < 2; ++d) \
_Pragma("unroll") \
                    for (int q = 0; q < 4; ++q) { f32x4 o = OT[(4 * d + q) * 64]; o.x += Ob[d][4 * q] * sc; o.y += Ob[d][4 * q + 1] * sc; o.z += Ob[d][4 * q + 2] * sc; o.w += Ob[d][4 * q + 3] * sc; OT[(4 * d + q) * 64] = o; \
                        Ob[d][4 * q] = 0.f; Ob[d][4 * q + 1] = 0.f; Ob[d][4 * q + 2] = 0.f; Ob[d][4 * q + 3] = 0.f; } \
                l = 0.f; } \
            const LAS unsigned char* kb = lds + (i & 1) * 18432; const LAS unsigned char* vb = kb + 9216; \
            const int tl = tt - 64 * j - 4 * h; \
            if (wh) { if (j == cur || j == cur - 8) attn_tile<2>(kb, vb, Qf, Ob, cref, l, tl, j == cur - 8 ? tl - 512 : -100000, true, n, h); else attn_tile<0>(kb, vb, Qf, Ob, cref, l, 0, 0, true, n, h); } \
            else if ((wmask >> j) & 1u) { const bool rowok = ((tokmask >> j) & 1u) != 0u; \
                if (j == cur) attn_tile<2>(kb, vb, Qf, Ob, cref, l, rowok ? tl : -1, -100000, true, n, h); else attn_tile<1>(kb, vb, Qf, Ob, cref, l, 0, 0, rowok, n, h); } \
        } while (0)
#pragma nounroll
        for (int i = 0; i < ntile; i += 3) { AT_STEP(i, rk1, rv1); if (i + 1 >= ntile) break; AT_STEP(i + 1, rk2, rv2); if (i + 2 >= ntile) break; AT_STEP(i + 2, rk0, rv0); }
#undef AT_STEP
#undef AT_NEXT
#undef AT_LOAD
#undef AT_WRITE
        { const float lt = l + __shfl_xor(l, 32), sc = g1 * rcpf_(fmaxf(lt, 1e-30f));
          bf16_t* op = MIX + r * D + 512 + (kvh * 4 + hd) * 64 + 4 * h;
#pragma unroll
          for (int d = 0; d < 2; ++d)
#pragma unroll
            for (int u = 0; u < 4; ++u) { const f32x4 o = OT[(4 * d + u) * 64]; u32x2 ov; ov.x = pk_bf16(o.x + Ob[d][4 * u] * sc, o.y + Ob[d][4 * u + 1] * sc); ov.y = pk_bf16(o.z + Ob[d][4 * u + 2] * sc, o.w + Ob[d][4 * u + 3] * sc);
                *(u32x2*)(op + 32 * d + 8 * u) = ov; } }
    }
}

__device__ __forceinline__ int build_ptab(Frame& F) {
    LAS int* ptab = (LAS int*)(F.lds + PTAB_OFF);
    const unsigned* cnt = (const unsigned*)(F.ws + WS_CTL) + CW_CNT;
    if (F.tid < 64) {
        const int e = F.tid; const unsigned c = (e < NE) ? __hip_atomic_load(cnt + 64 * e, __ATOMIC_RELAXED, __HIP_MEMORY_SCOPE_AGENT) : 0u;
        const int n = (int)((c + 255u) >> 8); int incl = n;
#pragma unroll
        for (int o = 1; o < 8; o <<= 1) { const int t = __shfl_up(incl, o); if (e >= o) incl += t; }
        const int excl = incl - n;
        if (e < NE) { ptab[MAXPAN + 8 + e] = excl * 256; for (int i = 0; i < n && excl + i < MAXPAN; ++i) ptab[excl + i] = e; }
        if (e == NE - 1) ptab[MAXPAN] = incl < MAXPAN ? incl : MAXPAN; }
    __syncthreads();
    return ptab[MAXPAN];
}

template <unsigned KM> __global__ void __launch_bounds__(NTHR, 2) fwd(Args args) {
    extern __shared__ __attribute__((aligned(16))) unsigned char lds_raw[];
    Frame F; F.lds = (LAS unsigned char*)lds_raw; F.tid = threadIdx.x; F.lane = F.tid & 63; F.wave = __builtin_amdgcn_readfirstlane(F.tid >> 6);
    F.G = gridDim.x; F.c = blockIdx.x; F.in = args.in; F.out = args.out; F.ws = args.ws;
    volatile LAS unsigned* MISC = (volatile LAS unsigned*)(F.lds + MISC_OFF);
    if (F.tid < 64) MISC[F.tid] = 0u;
    __syncthreads();
    unsigned* ctl = (unsigned*)(F.ws + WS_CTL);
#if MK_PER_PHASE
#define SEAM() do {} while (0)
#else
    XcdBarrier bar = xcd_barrier_post(ctl + CW_BAR, MISC);
#define SEAM() xcd_barrier(bar)
#endif
    const int lo = args.ph_lo, hi = args.ph_hi;
#define KON(kind) (((KM) >> (kind)) & 1u)
#define IN(k) (lo <= (k) && (k) < hi)
#define gw (F.c * NWAVES + F.wave)
#define NGW (F.G * NWAVES)
#define XB ((bf16_t*)(F.ws + WS_XB))
#define RS ((float*)(F.ws + WS_RSTD))

    if (KON(0) && IN(0)) { FRESH_TID(F); PMARK(0); phase_prologue(F); SEAM(); }

    for (int layer = 0; layer < 2; ++layer) {
        const int pb = 1 + 12 * layer;
        if (KON(1) && IN(pb + 0)) { FRESH_TID(F); PMARK(pb + 0);
            pg8::Gemm g{XB, (const bf16_t*)(F.ws + WS_WIN) + (size_t)layer * INP * D, D, D, D}; pg8::SchedGrid S; S.init(M / 256, INP / 256, F.G, F.c, D, D);
            EpiIn E{RS, (bf16_t*)(F.ws + WS_U), (bf16_t*)(F.ws + WS_Q), (bf16_t*)(F.ws + WS_KV), (float*)(F.ws + WS_GT), layer ? (const float*)(F.ws + WS_PSS) : nullptr, (LAS float*)(F.lds + RSL_OFF)};
            pg8::gemm_phase(F.lds, g, S, E); moe_conv_slot(F, layer == 0 ? 0 : 2); SEAM();
        }
        if (KON(2) && IN(pb + 1)) { FRESH_TID(F); PMARK(pb + 1);
            { pg8::Gemm g{(const bf16_t*)(F.ws + WS_KV), (const bf16_t*)(F.ws + WS_WC1), 256, 1024, 2048}; SchedCmp S{F.G, F.c, layer};
              EpiH1 E{(float*)(F.ws + WS_H1)}; pg8::gemm_phase(F.lds, g, S, E); }
            if (F.G >= 256) { if (F.c >= 128) vtrans_items(F, (F.c - 128) * NWAVES + F.wave, (F.G - 128) * NWAVES); }
            else vtrans_items(F, gw, NGW);
#ifdef ATTN_REF
            norm_rows64((bf16_t*)(F.ws + WS_Q), M * 8, INP_(I_QG) + layer * 64, 0.125f, gw, NGW, F.lane);
#endif
            norm_rows64((bf16_t*)(F.ws + WS_KV) + 2 * KVT, NBH * SEQ, INP_(I_KG) + layer * 192 + 64, 1.0f, gw, NGW, F.lane);
            norm_rows64((bf16_t*)(F.ws + WS_KV) + 4 * KVT, NBH * SEQ, INP_(I_KG) + layer * 192 + 128, 1.0f, gw, NGW, F.lane);
            SEAM();
        }
        if (KON(3) && IN(pb + 2)) { FRESH_TID(F); PMARK(pb + 2); for (int cu = F.c; cu < 512; cu += F.G) conv_unit(F, layer, cu); PMARK(30); phase_cmp2(F, layer); SEAM(); }
#ifndef ATTN_REF
        if (KON(4) && IN(pb + 3)) { FRESH_TID(F); PMARK(pb + 3); phase_attn_mfma(F, layer); SEAM(); }
#else
        if (KON(4) && IN(pb + 3)) { FRESH_TID(F); PMARK(pb + 3); phase_attn_ref(F, layer); SEAM(); }
#endif
        if (KON(5) && IN(pb + 4)) { FRESH_TID(F); PMARK(pb + 4);
            pg8::Gemm g{(const bf16_t*)(F.ws + WS_MIX), (const bf16_t*)(F.ws + WS_WOUT) + (size_t)layer * D * D, D, D, D}; pg8::SchedGrid S; S.init(M / 256, D / 256, F.G, F.c, D, D);
            { EpiRes<true> E{XB, XB, layer == 0 ? (float*)(F.ws + WS_PSS) : nullptr}; pg8::gemm_phase(F.lds, g, S, E); }
            SEAM();
        }
        if (KON(6) && IN(pb + 5) && layer == 1) { FRESH_TID(F); PMARK(pb + 5);
            f32x4 v[4];
            {
                const float* RT = (const float*)(F.ws + WS_RT); unsigned* cnt = ctl + CW_CNT; int* ROUTE = (int*)(F.ws + WS_ROUTE);
                int* stok = (int*)(F.ws + WS_SLOT);
                const int cb0 = __builtin_amdgcn_readfirstlane((int)blockIdx.x * NTHR);
#pragma nounroll
                for (int i = cb0 + F.tid; i < MAXSLOT; i += F.G * NTHR) stok[i] = -1;
                LAS f32x4* RTL = (LAS f32x4*)F.lds;
                { f32x4 sv[4];
#pragma unroll
                  for (int q = 0; q < 4; ++q) sv[q] = *((const f32x4*)RT + F.tid + q * NTHR);
#pragma unroll
                  for (int q = 0; q < 4; ++q) RTL[F.tid + q * NTHR] = sv[q]; }
                __syncthreads();
#pragma nounroll
                for (int mb = gw; mb < M; mb += 8 * NGW) {
                    int me0 = -1, me1 = -1; float mw0 = 0.f, mw1 = 0.f;
#pragma nounroll
                    for (int i4 = 0; i4 < 8; i4 += 4) {
                        f32x4 xv[4][4];
#pragma unroll
                        for (int q = 0; q < 4; ++q) { const int m = mb + (i4 + q) * NGW; const u32x2* xr = (const u32x2*)(XB + (size_t)(m < M ? m : 0) * D) + F.lane;
#pragma unroll
                            for (int j = 0; j < 4; ++j) { const u32x2 wv = xr[64 * j]; xv[q][j] = (f32x4){bf_lo(wv.x), bf_hi(wv.x), bf_lo(wv.y), bf_hi(wv.y)}; } }
#pragma unroll
                        for (int q = 0; q < 4; ++q) { const int i = i4 + q, m = mb + i * NGW; if (m >= M) break;
                            float ss = 0.f;
#pragma unroll
                            for (int j = 0; j < 4; ++j) ss += (xv[q][j].x * xv[q][j].x + xv[q][j].y * xv[q][j].y) + (xv[q][j].z * xv[q][j].z + xv[q][j].w * xv[q][j].w);
                            const float rs = rsqf_(wave_sum_u(ss) * (1.0f / D) + EPS);
                            if (F.lane == 0) RS[m] = rs;
                            float lg[8];
#pragma unroll
                            for (int e = 0; e < 8; ++e) { float sd = 0.f;
#pragma unroll
                                for (int j = 0; j < 4; ++j) { const f32x4 wv = RTL[e * 256 + 64 * j + F.lane]; sd += (xv[q][j].x * wv.x + xv[q][j].y * wv.y) + (xv[q][j].z * wv.z + xv[q][j].w * wv.w); }
                                lg[e] = wave_sum_u(sd); }
                            int e0 = 0; float l0 = lg[0];
#pragma unroll
                            for (int e = 1; e < 8; ++e) if (lg[e] > l0) { l0 = lg[e]; e0 = e; }
                            int e1 = -1; float l1 = -3.0e38f;
#pragma unroll
                            for (int e = 0; e < 8; ++e) if (e != e0 && lg[e] > l1) { l1 = lg[e]; e1 = e; }
                            const float p1 = __expf((l1 - l0) * rs), w0 = rcpf_(1.0f + p1), w1 = p1 * w0;
                            if (F.lane == i) { me0 = e0; me1 = e1; mw0 = w0; mw1 = w1; } } }
                    int r0 = 0, r1 = 0, c_mine = 0; const unsigned long long low = (1ull << F.lane) - 1ull;
#pragma unroll
                    for (int e = 0; e < 8; ++e) { const unsigned long long b0 = __ballot(me0 == e), b1 = __ballot(me1 == e);
                        if (me0 == e) r0 = __popcll(b0 & low) + __popcll(b1 & low); if (me1 == e) r1 = __popcll(b0 & low) + __popcll(b1 & low);
                        if (F.lane == e) c_mine = __popcll(b0) + __popcll(b1); }
                    int basev = 0; if (F.lane < 8 && c_mine > 0) basev = (int)atomicAdd(cnt + 64 * F.lane, (unsigned)c_mine);
                    const int b0v = __shfl(basev, me0 < 0 ? 0 : me0), b1v = __shfl(basev, me1 < 0 ? 0 : me1);
                    if (me0 >= 0) { const int m = mb + F.lane * NGW; int* rp = ROUTE + (size_t)m * 6; rp[0] = me0; rp[1] = b0v + r0; rp[2] = me1; rp[3] = b1v + r1; rp[4] = __float_as_int(mw0); rp[5] = __float_as_int(mw1); }
                }
            }
            SEAM();
        }
        if (layer == 0) {
            if (KON(7) && IN(pb + 6)) { FRESH_TID(F); PMARK(pb + 6);
                pg8::Gemm g{XB, (const bf16_t*)(F.ws + WS_WF1), D, D, D}; pg8::SchedGrid S; S.init(M / 256, 2 * DFF / 256, F.G, F.c, D, D);
                EpiGlu E{RS, (bf16_t*)(F.ws + WS_ACT), DFF, 0, (const float*)(F.ws + WS_PSS), (LAS float*)(F.lds + RSL_OFF)}; pg8::gemm_phase(F.lds, g, S, E); moe_conv_slot(F, 1); SEAM();
            }
            if (KON(8) && IN(pb + 7)) { FRESH_TID(F); PMARK(pb + 7);
                pg8::Gemm g{(const bf16_t*)(F.ws + WS_ACT), (const bf16_t*)(F.ws + WS_WF2), DFF, DFF, DFF}; pg8::SchedGrid S; S.init(M / 256, D / 256, F.G, F.c, DFF, DFF);
                EpiRes<true> E{XB, XB, (float*)(F.ws + WS_PSS)}; pg8::gemm_phase(F.lds, g, S, E); SEAM();
            }
        } else {
            if (KON(10) && IN(pb + 6)) { FRESH_TID(F); PMARK(pb + 6);
                build_ptab(F); const LAS int* ptab = (const LAS int*)(F.lds + PTAB_OFF);
                const int* ROUTE = (const int*)(F.ws + WS_ROUTE); int* stok = (int*)(F.ws + WS_SLOT); float* sw = (float*)(stok + MAXSLOT); float* srs = sw + MAXSLOT; unsigned char* XS8 = F.ws + WS_XS;
#pragma nounroll
                for (int mb = gw; mb < M; mb += 4 * NGW) {
                    int rt[4][6]; u32x4 ra[4], rb[4];
#pragma unroll
                    for (int q = 0; q < 4; ++q) { const int m = mb + q * NGW < M ? mb + q * NGW : 0; const int* rp = ROUTE + (size_t)m * 6;
#pragma unroll
                        for (int z = 0; z < 6; ++z) rt[q][z] = rp[z];
                        const u32x4* src = (const u32x4*)(XB + (size_t)m * D) + F.lane; ra[q] = src[0]; rb[q] = src[64]; }
#pragma unroll
                    for (int q = 0; q < 4; ++q) { const int m = mb + q * NGW; if (m >= M) break;
#pragma unroll
                        for (int k = 0; k < 2; ++k) { const int e = rt[q][2 * k], pos = rt[q][2 * k + 1], slot = ptab[MAXPAN + 8 + e] + pos; unsigned char* drow = XS8 + (size_t)slot * D + 8 * F.lane;
                            *(u32x2*)drow = pk8_fp8(bf_lo(ra[q].x), bf_hi(ra[q].x), bf_lo(ra[q].y), bf_hi(ra[q].y), bf_lo(ra[q].z), bf_hi(ra[q].z), bf_lo(ra[q].w), bf_hi(ra[q].w));
                            *(u32x2*)(drow + 512) = pk8_fp8(bf_lo(rb[q].x), bf_hi(rb[q].x), bf_lo(rb[q].y), bf_hi(rb[q].y), bf_lo(rb[q].z), bf_hi(rb[q].z), bf_lo(rb[q].w), bf_hi(rb[q].w));
                            if (F.lane == 0) { stok[slot] = m * 2 + k; sw[slot] = __int_as_float(rt[q][4 + k]); srs[slot] = RS[m]; } } } }
                SEAM();
            }
            if (KON(11) && IN(pb + 7)) { FRESH_TID(F); PMARK(pb + 7);
                const int npan = build_ptab(F);
                const int* stok = (const int*)(F.ws + WS_SLOT); const float* srs = (const float*)(stok + 2 * MAXSLOT);
                pg8::Gemm8 g{F.ws + WS_XS, F.ws + WS_WM1, D, D, D}; SchedMoe1F S{F.G, F.c, npan, (const LAS int*)(F.lds + PTAB_OFF)};
                EpiGlu8 E{srs, F.ws + WS_ACTM, DFE, 1.0f / MOE_S1};
                pg8::gemm_phase8(F.lds, g, S, E); SEAM();
            }
            if (KON(12) && IN(pb + 8)) { FRESH_TID(F); PMARK(pb + 8);
                const int npan = build_ptab(F);
                const int* stok = (const int*)(F.ws + WS_SLOT); const float* sw = (const float*)(stok + MAXSLOT);
                pg8::Gemm8 g{F.ws + WS_ACTM, F.ws + WS_WM2, DFE, DFE, DFE}; SchedMoe2F S{F.G, F.c, npan, (const LAS int*)(F.lds + PTAB_OFF)};
                EpiMoe2 E{stok, sw, (bf16_t*)(F.ws + WS_Y0), (bf16_t*)(F.ws + WS_Y1), 0, 1.0f / MOE_S2}; pg8::gemm_phase8(F.lds, g, S, E); SEAM();
            }
            if (KON(13) && IN(pb + 11)) { FRESH_TID(F); PMARK(pb + 11);
                const bf16_t* Y0 = (const bf16_t*)(F.ws + WS_Y0); const bf16_t* Y1 = (const bf16_t*)(F.ws + WS_Y1);
#pragma nounroll
                for (int mb = gw; mb < M; mb += 2 * NGW) { f32x4 x[2][4]; u32x2 ya[2][4], yb[2][4];
#pragma unroll
                    for (int q = 0; q < 2; ++q) { const int m = mb + q * NGW < M ? mb + q * NGW : 0; const u32x2* xr = (const u32x2*)(XB + (size_t)m * D) + F.lane; const u32x2* y0 = (const u32x2*)(Y0 + (size_t)m * D) + F.lane; const u32x2* y1 = (const u32x2*)(Y1 + (size_t)m * D) + F.lane;
#pragma unroll
                        for (int j = 0; j < 4; ++j) { const u32x2 wv = xr[64 * j]; x[q][j] = (f32x4){bf_lo(wv.x), bf_hi(wv.x), bf_lo(wv.y), bf_hi(wv.y)}; ya[q][j] = y0[64 * j]; yb[q][j] = y1[64 * j]; } }
#pragma unroll
                    for (int q = 0; q < 2; ++q) { const int m = mb + q * NGW; if (m >= M) break; f32x4* xr = (f32x4*)(F.out + (size_t)m * D) + F.lane;
#pragma unroll
                        for (int j = 0; j < 4; ++j) { f32x4 o = x[q][j]; const u32x2 a = ya[q][j], b2 = yb[q][j];
                            o.x += bf_lo(a.x) + bf_lo(b2.x); o.y += bf_hi(a.x) + bf_hi(b2.x); o.z += bf_lo(a.y) + bf_lo(b2.y); o.w += bf_hi(a.y) + bf_hi(b2.y); xr[64 * j] = o; } } }
            }
        }
    }
#undef gw
#undef NGW
#undef XB
#undef RS
    PMARK(99);
    if ((PROBE_MASK & 0x6000000u) && blockIdx.x == 0 && threadIdx.x == 0) { const unsigned* st = (const unsigned*)(F.ws + WS_SLOT + 3 * MAXSLOT * 4); unsigned long long tot = 0; for (int i = 0; i < 512 * 8; ++i) { const unsigned v = st[i]; tot += (PROBE_MASK & 0x2000000u) ? (v & 255u) : (v >> 8); }
        *(volatile LAS unsigned long long*)(F.lds + MISC_OFF + 160) += tot * 25ull / 4096ull * 10ull; }
    if (PROBE_MASK != 0u && blockIdx.x == 0 && threadIdx.x == 0) { const unsigned long long acc = *(volatile LAS unsigned long long*)(F.lds + MISC_OFF + 160), t1 = __builtin_amdgcn_s_memrealtime() + 4ull * acc; while (__builtin_amdgcn_s_memrealtime() < t1) __builtin_amdgcn_s_sleep(8); }
#undef IN
}

constexpr int NPHASE = 25;
template <unsigned KM> static bool setup_kernel(int& per_cu) {
    if (hipFuncSetAttribute((const void*)fwd<KM>, hipFuncAttributeMaxDynamicSharedMemorySize, LDS_BYTES) != hipSuccess) return false;
    if (hipOccupancyMaxActiveBlocksPerMultiprocessor(&per_cu, (const void*)fwd<KM>, NTHR, LDS_BYTES) != hipSuccess) per_cu = 0;
    (void)hipGetLastError(); return true;
}
template <unsigned KM> static void launch_kind(int grid, const Args& a, hipStream_t stream) { hipLaunchKernelGGL(fwd<KM>, dim3(grid), dim3(NTHR), LDS_BYTES, stream, a); }
extern "C" void kernel_launch(void* const* d_in, const int* in_sizes, int n_in, void* d_out, int out_size, void* d_ws, size_t ws_size, hipStream_t stream) {
    static int grid = 0;
    if (grid == 0) {
        if (n_in != 28 || in_sizes[0] != M * D || out_size != M * D || ws_size < WS_END) { fprintf(stderr, "kernel_launch: unexpected shapes / workspace (n_in %d, ws %zu, need %zu)\n", n_in, ws_size, (size_t)WS_END); grid = -1; return; }
        int dev = 0, cus = 0, per_cu = 0; bool ok = true;
        if (hipGetDevice(&dev) != hipSuccess || hipDeviceGetAttribute(&cus, hipDeviceAttributeMultiprocessorCount, dev) != hipSuccess) { grid = -1; return; }
#if MK_PER_PHASE
        ok = ok && setup_kernel<1u << 0>(per_cu) && setup_kernel<1u << 1>(per_cu) && setup_kernel<1u << 2>(per_cu) && setup_kernel<1u << 3>(per_cu) && setup_kernel<1u << 4>(per_cu) && setup_kernel<1u << 5>(per_cu) && setup_kernel<1u << 6>(per_cu)
             && setup_kernel<1u << 7>(per_cu) && setup_kernel<1u << 8>(per_cu) && setup_kernel<1u << 9>(per_cu) && setup_kernel<1u << 10>(per_cu) && setup_kernel<1u << 11>(per_cu) && setup_kernel<1u << 12>(per_cu) && setup_kernel<1u << 13>(per_cu);
#else
        ok = ok && setup_kernel<0xffffffffu>(per_cu);
#endif
        if (!ok) { fprintf(stderr, "kernel_launch: hipFuncSetAttribute failed\n"); grid = -1; return; }
        if (per_cu < 1) fprintf(stderr, "kernel_launch: occupancy query says %d\n", per_cu);
        grid = cus;
    }
    if (grid < 0) return;
    (void)hipMemsetAsync((char*)d_ws + WS_CTL, 0, CTL_BYTES, stream);
    Args a{};
    for (int i = 0; i < 28; ++i) a.in[i] = (const float*)d_in[i];
    a.out = (float*)d_out; a.ws = (unsigned char*)d_ws;
#if MK_PER_PHASE
    static const int phases[] = {0, 1, 2, 3, 4, 5, 7, 8, 13, 14, 15, 16, 17, 18, 19, 20, 21, 24};
    static const int kinds[]  = {0, 1, 2, 3, 4, 5, 7, 8,  1,  2,  3,  4,  5,  6, 10, 11, 12, 13};
    for (int i = 0; i < (int)(sizeof(phases) / sizeof(int)); ++i) { a.ph_lo = phases[i]; a.ph_hi = phases[i] + 1;
        switch (kinds[i]) {
            case 0: launch_kind<1u << 0>(grid, a, stream); break; case 1: launch_kind<1u << 1>(grid, a, stream); break; case 2: launch_kind<1u << 2>(grid, a, stream); break;
            case 3: launch_kind<1u << 3>(grid, a, stream); break; case 4: launch_kind<1u << 4>(grid, a, stream); break; case 5: launch_kind<1u << 5>(grid, a, stream); break;
            case 6: launch_kind<1u << 6>(grid, a, stream); break; case 7: launch_kind<1u << 7>(grid, a, stream); break; case 8: launch_kind<1u << 8>(grid, a, stream); break;
            case 9: launch_kind<1u << 9>(grid, a, stream); break; case 10: launch_kind<1u << 10>(grid, a, stream); break; case 11: launch_kind<1u << 11>(grid, a, stream); break;
            case 12: launch_kind<1u << 12>(grid, a, stream); break; default: launch_kind<1u << 13>(grid, a, stream); break; } }
#else
    a.ph_lo = 0; a.ph_hi = NPHASE; launch_kind<0xffffffffu>(grid, a, stream);
#endif
}
```

```cpp
#include <hip/hip_runtime.h>
#include <cstdio>
#include <cstdint>

#ifndef MK_PER_PHASE
#define MK_PER_PHASE 0
#endif

#ifndef PROBE_MASK
#define PROBE_MASK 0u
#endif
#define LAS __attribute__((address_space(3)))
typedef unsigned short bf16_t;
typedef short bf16x8 __attribute__((ext_vector_type(8)));
typedef float f32x4 __attribute__((ext_vector_type(4)));
typedef float f32x2 __attribute__((ext_vector_type(2)));
typedef unsigned u32x4 __attribute__((ext_vector_type(4)));
typedef unsigned u32x2 __attribute__((ext_vector_type(2)));

constexpr int D = 1024, NB = 8, SEQ = 2048, M = NB * SEQ;
constexpr int INW = 2328, INP = 2560;
constexpr int CW = 512, CKW = 31, DH = 64, NKV = 2, NBH = NB * NKV;
constexpr int NCMP = 127, CHID = 256;
constexpr int DFF = 2816, NE = 8, DFE = 3584;
constexpr int MAXPAN = 136, MAXSLOT = MAXPAN * 256, CHUNKP = 72;
constexpr float EPS = 1e-6f;

constexpr size_t MiB = 1u << 20;
constexpr size_t WS_CTL = 0, CTL_BYTES = 2 * MiB;
constexpr size_t WS_H1 = 342 * MiB;
constexpr size_t WS_WIN = 12 * MiB;
constexpr size_t WS_WC1 = 22 * MiB;
constexpr size_t WS_WOUT = 26 * MiB;
constexpr size_t WS_WF1 = 30 * MiB;
constexpr size_t WS_WF2 = 41 * MiB;
constexpr size_t WS_RT = 47 * MiB;
constexpr size_t WS_WM1 = 48 * MiB;
constexpr size_t WS_WM2 = 160 * MiB;
constexpr size_t WS_XB = 216 * MiB;
constexpr size_t WS_RSTD = 248 * MiB;
constexpr size_t WS_GT = WS_RSTD + 65536;
constexpr size_t WS_ROUTE = WS_GT + (size_t)M * 24 * 4;
constexpr size_t WS_PSS = 250 * MiB;
constexpr size_t WS_KC = 251 * MiB;
constexpr size_t WS_VC = WS_KC + 262144;
constexpr size_t WS_VCT = WS_KC + 524288;
constexpr size_t WS_VST = 2 * MiB, WS_VWT = 6 * MiB;
constexpr size_t WS_U = 252 * MiB;
constexpr size_t WS_Q = 268 * MiB;
constexpr size_t WS_KV = 284 * MiB;
constexpr size_t KVT = (size_t)NBH * SEQ * DH;
constexpr size_t WS_MIX = 310 * MiB;
constexpr size_t WS_ACT = 342 * MiB;
constexpr size_t WS_XS = 252 * MiB;
constexpr size_t WS_ACTM = 320 * MiB;
constexpr size_t WS_SLOT = 447 * MiB;
constexpr size_t WS_Y0 = WS_XS, WS_Y1 = 12 * MiB;
constexpr size_t WS_END = 448 * MiB;
constexpr int CW_BAR = 4096;
constexpr int CW_CNT = 8192;
constexpr int CW_B1P = 16384;

__device__ __forceinline__ unsigned cvt_pk_bf16(float lo, float hi) { unsigned r; asm volatile("v_cvt_pk_bf16_f32 %0, %1, %2" : "=v"(r) : "v"(lo), "v"(hi)); return r; }
__device__ __forceinline__ float bf_lo(unsigned v) { return __uint_as_float(v << 16); }
__device__ __forceinline__ float bf_hi(unsigned v) { return __uint_as_float(v & 0xffff0000u); }
__device__ __forceinline__ float bf2f(bf16_t v) { return __uint_as_float((unsigned)v << 16); }
__device__ __forceinline__ float rcpf_(float x) { return __builtin_amdgcn_rcpf(x); }
__device__ __forceinline__ float rsqf_(float x) { return __builtin_amdgcn_rsqf(x); }
__device__ __forceinline__ float sigmoidf_(float x) { return rcpf_(1.0f + __expf(-x)); }
__device__ __forceinline__ float siluf_(float x) { return x * sigmoidf_(x); }
typedef float f32x2e __attribute__((ext_vector_type(2)));
__device__ __forceinline__ f32x2e glu2_(f32x2e g, f32x2e u, f32x2e nrs, f32x2e rs2) {
    f32x2e e = g * nrs; e.x = __builtin_amdgcn_exp2f(e.x); e.y = __builtin_amdgcn_exp2f(e.y);
    f32x2e d = e + (f32x2e){1.0f, 1.0f}; d.x = __builtin_amdgcn_rcpf(d.x); d.y = __builtin_amdgcn_rcpf(d.y);
    return ((g * u) * rs2) * d; }
__device__ __forceinline__ f32x2e glus2_(f32x2e v, f32x2e g, f32x2e nrs, f32x2e rs1) {
    f32x2e e = g * nrs; e.x = __builtin_amdgcn_exp2f(e.x); e.y = __builtin_amdgcn_exp2f(e.y);
    f32x2e d = e + (f32x2e){1.0f, 1.0f}; d.x = __builtin_amdgcn_rcpf(d.x); d.y = __builtin_amdgcn_rcpf(d.y);
    return (v * rs1) * d; }
#define LO2(v) ((f32x2e){(v)[0], (v)[1]})
#define HI2(v) ((f32x2e){(v)[2], (v)[3]})
__device__ __forceinline__ float wave_sum(float v) {
#pragma unroll
    for (int o = 1; o < 64; o <<= 1) v += __shfl_xor(v, o);
    return v;
}
#define DPP_ADD(v, ctrl) ((v) + __builtin_bit_cast(float, __builtin_amdgcn_update_dpp(0, __builtin_bit_cast(int, (v)), (ctrl), 0xF, 0xF, true)))
__device__ __forceinline__ float wave_sum_u(float v) {
    v = DPP_ADD(v, 0xB1); v = DPP_ADD(v, 0x4E); v = DPP_ADD(v, 0x124); v = DPP_ADD(v, 0x128);
    const int b = __builtin_bit_cast(int, v);
    return (__builtin_bit_cast(float, __builtin_amdgcn_readlane(b, 0)) + __builtin_bit_cast(float, __builtin_amdgcn_readlane(b, 16))) + (__builtin_bit_cast(float, __builtin_amdgcn_readlane(b, 32)) + __builtin_bit_cast(float, __builtin_amdgcn_readlane(b, 48)));
}
__device__ __forceinline__ float wave_max(float v) {
#pragma unroll
    for (int o = 1; o < 64; o <<= 1) v = fmaxf(v, __shfl_xor(v, o));
    return v;
}
#define LDS_WAIT() asm volatile("s_waitcnt lgkmcnt(0)" ::: "memory")
typedef float f32x16 __attribute__((ext_vector_type(16)));
typedef __bf16 bf16v2 __attribute__((ext_vector_type(2)));
#define MFMA32(a, b, c) __builtin_amdgcn_mfma_f32_32x32x16_bf16((a), (b), (c), 0, 0, 0)
__device__ __forceinline__ unsigned pk_bf16(float lo, float hi) { const f32x2 v = {lo, hi}; return __builtin_bit_cast(unsigned, __builtin_convertvector(v, bf16v2)); }
template <int S8> __device__ __forceinline__ bf16x8 pack8(const f32x16& p) { u32x4 w; w.x = pk_bf16(p[S8], p[S8 + 1]); w.y = pk_bf16(p[S8 + 2], p[S8 + 3]); w.z = pk_bf16(p[S8 + 4], p[S8 + 5]); w.w = pk_bf16(p[S8 + 6], p[S8 + 7]); return __builtin_bit_cast(bf16x8, w); }
__device__ __forceinline__ u32x2 pk8_fp8(float a0, float a1, float a2, float a3, float a4, float a5, float a6, float a7) {
    int w0 = 0, w1 = 0; w0 = __builtin_amdgcn_cvt_pk_fp8_f32(a0, a1, w0, false); w0 = __builtin_amdgcn_cvt_pk_fp8_f32(a2, a3, w0, true);
    w1 = __builtin_amdgcn_cvt_pk_fp8_f32(a4, a5, w1, false); w1 = __builtin_amdgcn_cvt_pk_fp8_f32(a6, a7, w1, true); return (u32x2){(unsigned)w0, (unsigned)w1}; }
__device__ __forceinline__ int swap23(int v) { return (v & ~12) | ((v & 4) << 1) | ((v & 8) >> 1); }

namespace pg8 {
constexpr int BM = 256, BK = 64, HALF = 128, HTB = HALF * BK * 2, STAGE_BYTES = 8 * HTB, NXCD = 8, WGM = 8;
__device__ __forceinline__ int lds_byte(int r, int c) { const int st = (r >> 4) * 2 + (c >> 5), rr = r & 15, cc = c & 31, ob = rr * 64 + cc * 2; return st * 1024 + (ob ^ (((ob >> 9) & 1) << 5)); }
__device__ __forceinline__ void stage_rc(int b, int& R, int& C) { const int st = b / 1024, sb = b % 1024, swz = sb ^ (((sb >> 9) & 1) << 5); R = (st >> 1) * 16 + swz / 64; C = (st & 1) * 32 + (swz % 64) / 2; }
__device__ __forceinline__ int perm32(int rho) { const int n = rho >> 4, i = rho & 15; return 8 * (i >> 2) + 4 * n + (i & 3); }

struct Unit { int pm, pn; size_t aoff, boff; };
struct Gemm { const bf16_t* A; const bf16_t* Bt; int K, lda, ldb; };

struct SchedGrid {
    int nM, nN, nwg, G, c; size_t astr, bstr;
    __device__ __forceinline__ void init(int nM_, int nN_, int G_, int c_, int lda, int ldb) { nM = nM_; nN = nN_; nwg = nM * nN; G = G_; c = c_; astr = (size_t)BM * lda * 2; bstr = (size_t)BM * ldb * 2; }
    __device__ __forceinline__ bool next(int i, Unit& u) const {
        const long L = (long)i * G + c; if (L >= nwg) return false;
        int wgid = (int)L; { const int q = nwg / NXCD, r = nwg % NXCD, xcd = wgid % NXCD, off = wgid / NXCD; wgid = (xcd < r ? xcd * (q + 1) : r * (q + 1) + (xcd - r) * q) + off; }
        const int nig = WGM * nN, gid = wgid / nig, fm = gid * WGM, gsz = (nM - fm) < WGM ? (nM - fm) : WGM;
        u.pm = fm + ((wgid % nig) % gsz); u.pn = (wgid % nig) / gsz; u.aoff = (size_t)u.pm * astr; u.boff = (size_t)u.pn * bstr; return true;
    }
};

template <class Epi, class Sched>
__device__ __forceinline__ void gemm_phase(LAS unsigned char* lds, const Gemm g, const Sched& S, const Epi& E) {
    int tid = threadIdx.x; asm volatile("" : "+v"(tid));
    const int wid = __builtin_amdgcn_readfirstlane(tid >> 6), lane = tid & 63, wr = wid >> 2, wc = wid & 3, fr = lane & 15, fq = lane >> 4;
    const int K = g.K, nt = K / BK;
    unsigned voffA[2], voffB[2];
#pragma unroll
    for (int i = 0; i < 2; ++i) { int R, C; stage_rc(tid * 16 + i * 8192, R, C); const int Rb = Epi::PERM ? ((R & ~31) + perm32(R & 31)) : R;
        voffA[i] = (unsigned)(R * g.lda + C) * 2u; voffB[i] = (unsigned)(Rb * g.ldb + C) * 2u; }
    const size_t kstep = (size_t)(BK * 2);
    const size_t hstepA = (size_t)HALF * g.lda * 2, hstepB = (size_t)HALF * g.ldb * 2;
    const unsigned ldsw = (unsigned)wid * 1024u;
    const int aoff = lds_byte(wr * 64 + fr, fq * 8), boff = lds_byte(wc * 32 + fr, fq * 8);
#define PG8_SA(b, h) (((b) * 2 + (h)) * HTB)
#define PG8_SB(b, h) ((4 + (b) * 2 + (h)) * HTB)
#define PG8_STAGE(bufoff, gbase, voff) do { _Pragma("unroll") for (int _i = 0; _i < 2; ++_i) \
        __builtin_amdgcn_global_load_lds((const unsigned*)((const char*)(gbase) + (voff)[_i]), (LAS unsigned*)(lds + (bufoff) + ldsw + _i * 8192), 16, 0, 0); } while (0)
#define PG8_LDA(dst, b, h) do { _Pragma("unroll") for (int m = 0; m < 4; ++m) _Pragma("unroll") for (int k = 0; k < 2; ++k) dst[m][k] = *(const LAS bf16x8*)(lds + PG8_SA(b, h) + aoff + m * 2048 + k * 1024); } while (0)
#define PG8_LDB(dst, b, h) do { _Pragma("unroll") for (int n = 0; n < 2; ++n) _Pragma("unroll") for (int k = 0; k < 2; ++k) dst[n][k] = *(const LAS bf16x8*)(lds + PG8_SB(b, h) + boff + n * 2048 + k * 1024); } while (0)
#define PG8_MMA(ai, bj, At, Bt) do { __builtin_amdgcn_s_setprio(1); _Pragma("unroll") for (int m = 0; m < 4; ++m) _Pragma("unroll") for (int n = 0; n < 2; ++n) _Pragma("unroll") for (int k = 0; k < 2; ++k) \
        acc[ai][bj][m][n] = __builtin_amdgcn_mfma_f32_16x16x32_bf16(Bt[n][k], At[m][k], acc[ai][bj][m][n], 0, 0, 0); __builtin_amdgcn_s_setprio(0); } while (0)
#define PG8_WAIT_V(n) asm volatile("s_waitcnt vmcnt(" #n ")" ::: "memory")
#define PG8_WAIT_L(n) asm volatile("s_waitcnt lgkmcnt(" #n ")" ::: "memory")
#define PG8_BAR __builtin_amdgcn_s_barrier()
#define PG8_SCHED __builtin_amdgcn_sched_barrier(0)
    Unit cur, nxt; int ui = 0;
    if (!S.next(0, cur)) return;
    f32x4 acc[2][2][4][2];
#pragma unroll
    for (int a = 0; a < 2; ++a)
#pragma unroll
        for (int b = 0; b < 2; ++b)
#pragma unroll
            for (int m = 0; m < 4; ++m)
#pragma unroll
                for (int n = 0; n < 2; ++n) acc[a][b][m][n] = (f32x4){0.f, 0.f, 0.f, 0.f};
    bf16x8 At[4][2], B0[2][2], B1[2][2];
    const char* cA = (const char*)g.A + cur.aoff; const char* cB = (const char*)g.Bt + cur.boff;
    typename Epi::Pre pre; E.prefetch(cur, wr, fr, pre);
    PG8_STAGE(PG8_SB(0, 0), cB, voffB); PG8_STAGE(PG8_SA(0, 0), cA, voffA); PG8_STAGE(PG8_SB(0, 1), cB + hstepB, voffB); PG8_STAGE(PG8_SA(0, 1), cA + hstepA, voffA);
    if (wr == 1) PG8_BAR;
    PG8_WAIT_V(4); PG8_BAR;
    PG8_STAGE(PG8_SB(1, 0), cB + kstep, voffB); PG8_STAGE(PG8_SA(1, 0), cA + kstep, voffA); PG8_STAGE(PG8_SB(1, 1), cB + hstepB + kstep, voffB);
    PG8_WAIT_V(6); PG8_BAR;
    for (;;) {
        const bool has_next = S.next(ui + 1, nxt);
        const char* nA = has_next ? (const char*)g.A + nxt.aoff : cA; const char* nB = has_next ? (const char*)g.Bt + nxt.boff : cB;
#pragma nounroll
        for (int t = 0; t < nt; t += 2) {
            const bool last = (t == nt - 2);
            const char* a1 = cA + (size_t)(t + 1) * kstep;
            const char* a2 = last ? nA : cA + (size_t)(t + 2) * kstep; const char* b2 = last ? nB : cB + (size_t)(t + 2) * kstep;
            const char* a3 = a2 + kstep; const char* b3 = b2 + kstep;
            PG8_LDB(B0, 0, 0); PG8_SCHED; PG8_LDA(At, 0, 0); PG8_STAGE(PG8_SA(1, 1), a1 + hstepA, voffA);
            PG8_WAIT_L(8); PG8_BAR; PG8_WAIT_L(0); PG8_MMA(0, 0, At, B0); PG8_BAR; PG8_SCHED;
            PG8_LDB(B1, 0, 1); PG8_STAGE(PG8_SB(0, 0), b2, voffB);
            PG8_BAR; PG8_WAIT_L(0); PG8_MMA(0, 1, At, B1); PG8_BAR;
            PG8_LDA(At, 0, 1); PG8_STAGE(PG8_SA(0, 0), a2, voffA);
            PG8_BAR; PG8_WAIT_L(0); PG8_MMA(1, 0, At, B0); PG8_BAR; PG8_SCHED;
            PG8_STAGE(PG8_SB(0, 1), b2 + hstepB, voffB);
            PG8_WAIT_V(6); PG8_BAR; PG8_MMA(1, 1, At, B1); PG8_BAR;
            PG8_LDB(B0, 1, 0); PG8_SCHED; PG8_LDA(At, 1, 0); PG8_STAGE(PG8_SA(0, 1), a2 + hstepA, voffA);
            PG8_WAIT_L(8); PG8_BAR; PG8_WAIT_L(0); PG8_MMA(0, 0, At, B0); PG8_BAR; PG8_SCHED;
            PG8_LDB(B1, 1, 1); PG8_STAGE(PG8_SB(1, 0), b3, voffB);
            PG8_BAR; PG8_WAIT_L(0); PG8_MMA(0, 1, At, B1); PG8_BAR;
            PG8_LDA(At, 1, 1); PG8_STAGE(PG8_SA(1, 0), a3, voffA);
            PG8_BAR; PG8_WAIT_L(0); PG8_MMA(1, 0, At, B0); PG8_BAR; PG8_SCHED;
            PG8_STAGE(PG8_SB(1, 1), b3 + hstepB, voffB);
            PG8_WAIT_V(6); PG8_BAR; PG8_MMA(1, 1, At, B1); PG8_BAR;
        }
        E(acc, cur, wr, wc, fr, fq, pre);
        if (!has_next) break;
        E.prefetch(nxt, wr, fr, pre);
#pragma unroll
        for (int a = 0; a < 2; ++a)
#pragma unroll
            for (int b = 0; b < 2; ++b)
#pragma unroll
                for (int m = 0; m < 4; ++m)
#pragma unroll
                    for (int n = 0; n < 2; ++n) acc[a][b][m][n] = (f32x4){0.f, 0.f, 0.f, 0.f};
        cur = nxt; cA = nA; cB = nB; ++ui;
    }
    PG8_WAIT_V(0);
    if (wr == 0) PG8_BAR;
    PG8_BAR;
#undef PG8_SA
#undef PG8_SB
#undef PG8_STAGE
#undef PG8_LDA
#undef PG8_LDB
#undef PG8_MMA
#undef PG8_WAIT_V
#undef PG8_WAIT_L
#undef PG8_BAR
#undef PG8_SCHED
}
struct Gemm8 { const unsigned char* A; const unsigned char* Bt; int K, lda, ldb; };
typedef int i32x4 __attribute__((ext_vector_type(4)));
typedef int i32x8 __attribute__((ext_vector_type(8)));
template <class Epi, class Sched>
__device__ __forceinline__ void gemm_phase8(LAS unsigned char* lds, const Gemm8 g, const Sched& S, const Epi& E) {
    int tid = threadIdx.x; asm volatile("" : "+v"(tid));
    const int wid = __builtin_amdgcn_readfirstlane(tid >> 6), lane = tid & 63, wr = wid >> 2, wc = wid & 3, fr = lane & 15, fq = lane >> 4;
    const int nt = g.K / 128;
    unsigned voffA[2], voffB[2];
#pragma unroll
    for (int i = 0; i < 2; ++i) { int R, C; stage_rc(tid * 16 + i * 8192, R, C); const int Rb = Epi::PERM ? ((R & ~31) + perm32(R & 31)) : R;
        voffA[i] = (unsigned)(R * g.lda + C * 2); voffB[i] = (unsigned)(Rb * g.ldb + C * 2); }
    const size_t kstep = (size_t)(BK * 2);
    const size_t hstepA = (size_t)HALF * g.lda, hstepB = (size_t)HALF * g.ldb;
    const unsigned ldsw = (unsigned)wid * 1024u;
    const int aoff = lds_byte(wr * 64 + fr, fq * 8), boff = lds_byte(wc * 32 + fr, fq * 8);
#define PG8_SA(b, h) (((b) * 2 + (h)) * HTB)
#define PG8_SB(b, h) ((4 + (b) * 2 + (h)) * HTB)
#define PG8_STAGE(bufoff, gbase, voff) do { _Pragma("unroll") for (int _i = 0; _i < 2; ++_i) \
        __builtin_amdgcn_global_load_lds((const unsigned*)((const char*)(gbase) + (voff)[_i]), (LAS unsigned*)(lds + (bufoff) + ldsw + _i * 8192), 16, 0, 0); } while (0)
#define PG8_LDA(dst, b, h) do { _Pragma("unroll") for (int m = 0; m < 4; ++m) { const i32x4 _l = *(const LAS i32x4*)(lds + PG8_SA(b, h) + aoff + m * 2048), _h = *(const LAS i32x4*)(lds + PG8_SA(b, h) + aoff + m * 2048 + 1024); dst[m] = __builtin_shufflevector(_l, _h, 0, 1, 2, 3, 4, 5, 6, 7); } } while (0)
#define PG8_LDB(dst, b, h) do { _Pragma("unroll") for (int n = 0; n < 2; ++n) { const i32x4 _l = *(const LAS i32x4*)(lds + PG8_SB(b, h) + boff + n * 2048), _h = *(const LAS i32x4*)(lds + PG8_SB(b, h) + boff + n * 2048 + 1024); dst[n] = __builtin_shufflevector(_l, _h, 0, 1, 2, 3, 4, 5, 6, 7); } } while (0)
#define PG8_MMA(ai, bj, At, Bt) do { __builtin_amdgcn_s_setprio(1); _Pragma("unroll") for (int m = 0; m < 4; ++m) _Pragma("unroll") for (int n = 0; n < 2; ++n) \
        asm volatile("v_mfma_f32_16x16x128_f8f6f4 %0, %1, %2, %0" : "+v"(acc[ai][bj][m][n]) : "v"(Bt[n]), "v"(At[m])); __builtin_amdgcn_s_setprio(0); } while (0)
#define PG8_WAIT_V(n) asm volatile("s_waitcnt vmcnt(" #n ")" ::: "memory")
#define PG8_WAIT_L(n) asm volatile("s_waitcnt lgkmcnt(" #n ")" ::: "memory")
#define PG8_BAR __builtin_amdgcn_s_barrier()
#define PG8_SCHED __builtin_amdgcn_sched_barrier(0)
    Unit cur, nxt; int ui = 0;
    if (!S.next(0, cur)) return;
    f32x4 acc[2][2][4][2];
#pragma unroll
    for (int a = 0; a < 2; ++a)
#pragma unroll
        for (int b = 0; b < 2; ++b)
#pragma unroll
            for (int m = 0; m < 4; ++m)
#pragma unroll
                for (int n = 0; n < 2; ++n) acc[a][b][m][n] = (f32x4){0.f, 0.f, 0.f, 0.f};
    i32x8 At[4], B0[2], B1[2];
    const char* cA = (const char*)g.A + cur.aoff; const char* cB = (const char*)g.Bt + cur.boff;
    typename Epi::Pre pre; E.prefetch(cur, wr, fr, pre);
    PG8_STAGE(PG8_SB(0, 0), cB, voffB); PG8_STAGE(PG8_SA(0, 0), cA, voffA); PG8_STAGE(PG8_SB(0, 1), cB + hstepB, voffB); PG8_STAGE(PG8_SA(0, 1), cA + hstepA, voffA);
    if (wr == 1) PG8_BAR;
    PG8_WAIT_V(4); PG8_BAR;
    PG8_STAGE(PG8_SB(1, 0), cB + kstep, voffB); PG8_STAGE(PG8_SA(1, 0), cA + kstep, voffA); PG8_STAGE(PG8_SB(1, 1), cB + hstepB + kstep, voffB);
    PG8_WAIT_V(6); PG8_BAR;
    for (;;) {
        const bool has_next = S.next(ui + 1, nxt);
        const char* nA = has_next ? (const char*)g.A + nxt.aoff : cA; const char* nB = has_next ? (const char*)g.Bt + nxt.boff : cB;
#pragma nounroll
        for (int t = 0; t < nt; t += 2) {
            const bool last = (t == nt - 2);
            const char* a1 = cA + (size_t)(t + 1) * kstep;
            const char* a2 = last ? nA : cA + (size_t)(t + 2) * kstep; const char* b2 = last ? nB : cB + (size_t)(t + 2) * kstep;
            const char* a3 = a2 + kstep; const char* b3 = b2 + kstep;
            PG8_LDB(B0, 0, 0); PG8_SCHED; PG8_LDA(At, 0, 0); PG8_STAGE(PG8_SA(1, 1), a1 + hstepA, voffA);
            PG8_WAIT_L(8); PG8_BAR; PG8_WAIT_L(0); PG8_MMA(0, 0, At, B0); PG8_BAR; PG8_SCHED;
            PG8_LDB(B1, 0, 1); PG8_STAGE(PG8_SB(0, 0), b2, voffB);
            PG8_BAR; PG8_WAIT_L(0); PG8_MMA(0, 1, At, B1); PG8_BAR;
            PG8_LDA(At, 0, 1); PG8_STAGE(PG8_SA(0, 0), a2, voffA);
            PG8_BAR; PG8_WAIT_L(0); PG8_MMA(1, 0, At, B0); PG8_BAR; PG8_SCHED;
            PG8_STAGE(PG8_SB(0, 1), b2 + hstepB, voffB);
            PG8_WAIT_V(6); PG8_BAR; PG8_MMA(1, 1, At, B1); PG8_BAR;
            PG8_LDB(B0, 1, 0); PG8_SCHED; PG8_LDA(At, 1, 0); PG8_STAGE(PG8_SA(0, 1), a2 + hstepA, voffA);
            PG8_WAIT_L(8); PG8_BAR; PG8_WAIT_L(0); PG8_MMA(0, 0, At, B0); PG8_BAR; PG8_SCHED;
            PG8_LDB(B1, 1, 1); PG8_STAGE(PG8_SB(1, 0), b3, voffB);
            PG8_BAR; PG8_WAIT_L(0); PG8_MMA(0, 1, At, B1); PG8_BAR;
            PG8_LDA(At, 1, 1); PG8_STAGE(PG8_SA(1, 0), a3, voffA);
            PG8_BAR; PG8_WAIT_L(0); PG8_MMA(1, 0, At, B0); PG8_BAR; PG8_SCHED;
            PG8_STAGE(PG8_SB(1, 1), b3 + hstepB, voffB);
            PG8_WAIT_V(6); PG8_BAR; PG8_MMA(1, 1, At, B1); PG8_BAR;
        }
        E(acc, cur, wr, wc, fr, fq, pre);
        if (!has_next) break;
        E.prefetch(nxt, wr, fr, pre);
#pragma unroll
        for (int a = 0; a < 2; ++a)
#pragma unroll
            for (int b = 0; b < 2; ++b)
#pragma unroll
                for (int m = 0; m < 4; ++m)
#pragma unroll
                    for (int n = 0; n < 2; ++n) acc[a][b][m][n] = (f32x4){0.f, 0.f, 0.f, 0.f};
        cur = nxt; cA = nA; cB = nB; ++ui;
    }
    PG8_WAIT_V(0);
    if (wr == 0) PG8_BAR;
    PG8_BAR;
#undef PG8_SA
#undef PG8_SB
#undef PG8_STAGE
#undef PG8_LDA
#undef PG8_LDB
#undef PG8_MMA
#undef PG8_WAIT_V
#undef PG8_WAIT_L
#undef PG8_BAR
#undef PG8_SCHED
}
}
using pg8::Unit;

#define XB_TMO      128
#define XB_XCNT(j)  (256  + 64 * (j))
#define XB_XSUB(j)  (1280 + 64 * (j))
#define XB_XGEN(j)  (2304 + 64 * (j))
#define XB_TOP      3328
#define XB_TOPGEN   3392
#define XCD_BAR_WORDS 3456
#define XB_SPIN_CAP (1u << 18)
__device__ __forceinline__ unsigned xb_ld(unsigned* p)              { return __hip_atomic_load(p, __ATOMIC_RELAXED, __HIP_MEMORY_SCOPE_AGENT); }
__device__ __forceinline__ unsigned xb_add(unsigned* p, unsigned v) { return __hip_atomic_fetch_add(p, v, __ATOMIC_RELAXED, __HIP_MEMORY_SCOPE_AGENT); }
__device__ __forceinline__ unsigned xb_xcc_id() { return (unsigned)__builtin_amdgcn_s_getreg((3 << 11) | 20) & 0xFu; }
#define XB_SPIN(cond, bar) do { unsigned _sp = 0; while (cond) { __builtin_amdgcn_s_sleep(1); \
    if ((++_sp & 255u) == 0u) { if (xb_ld(&(bar)[XB_TMO])) break; if (_sp > XB_SPIN_CAP) { atomicAdd(&(bar)[XB_TMO], 1u); break; } } } } while (0)
struct XcdBarrier { unsigned* bar; unsigned x; volatile LAS unsigned* st; };
__device__ __forceinline__ XcdBarrier xcd_barrier_post(unsigned* bar, volatile LAS unsigned* st) {
    XcdBarrier b; b.bar = bar; b.x = xb_xcc_id(); b.st = st;
    if (threadIdx.x == 0) (void)xb_add(&bar[XB_XCNT(b.x)], 1u);
    return b;
}
__device__ __forceinline__ void xcd_barrier_complete(unsigned* bar, unsigned x, unsigned& nloc, unsigned& nx) {
    const unsigned G = gridDim.x * gridDim.y * gridDim.z;
    unsigned sum, cnt, mine, sp = 0u;
    for (;;) {
        sum = 0u; cnt = 0u; mine = 0u;
#pragma unroll
        for (unsigned j = 0; j < 16; ++j) { const unsigned c = xb_ld(&bar[XB_XCNT(j)]); sum += c; cnt += (c > 0u) ? 1u : 0u; mine = (j == x) ? c : mine; }
        if (sum == G) break;
        __builtin_amdgcn_s_sleep(1);
        if ((++sp & 255u) == 0u) { if (xb_ld(&bar[XB_TMO])) break; if (sp > XB_SPIN_CAP) { atomicAdd(&bar[XB_TMO], 1u); break; } }
    }
    nloc = mine > 0u ? mine : 1u; nx = cnt > 0u ? cnt : 1u;
}
__device__ __forceinline__ void xcd_barrier(const XcdBarrier& b) {
    asm volatile("s_waitcnt vmcnt(0)" ::: "memory");
    __syncthreads();
    if (threadIdx.x == 0) {
        unsigned* bar = b.bar;
        __builtin_amdgcn_s_waitcnt(0);
        unsigned nloc = b.st[0], nx = b.st[1];
        if (nloc == 0u) { xcd_barrier_complete(bar, b.x, nloc, nx); b.st[0] = nloc; b.st[1] = nx; }
        const unsigned old = xb_add(&bar[XB_XSUB(b.x)], 1u);
        const unsigned gen = old / nloc;
        if (old + 1u == (gen + 1u) * nloc) {
            __builtin_amdgcn_fence(__ATOMIC_RELEASE, "agent");
            asm volatile("s_waitcnt vmcnt(0)" ::: "memory");
            const unsigned og = xb_add(&bar[XB_TOP], 1u);
            const unsigned tg = og / nx;
            if (og + 1u == (tg + 1u) * nx) xb_add(&bar[XB_TOPGEN], 1u);
            else XB_SPIN(xb_ld(&bar[XB_TOPGEN]) == tg, bar);
            __builtin_amdgcn_fence(__ATOMIC_ACQUIRE, "agent");
            xb_add(&bar[XB_XGEN(b.x)], 1u);
            asm volatile("s_waitcnt vmcnt(0)" ::: "memory");
        } else {
            XB_SPIN(xb_ld(&bar[XB_XGEN(b.x)]) == gen, bar);
            __builtin_amdgcn_fence(__ATOMIC_ACQUIRE, "agent");
            asm volatile("s_waitcnt vmcnt(0)" ::: "memory");
        }
    }
    __syncthreads();
}

constexpr int NWAVES = 8, NTHR = 512;
constexpr int LDS_BYTES = 147456;
constexpr int MISC_OFF = 131072;
constexpr int PTAB_OFF = MISC_OFF + 512;

struct Args { const float* in[28]; float* out; unsigned char* ws; int ph_lo, ph_hi; };

struct Frame {
    LAS unsigned char* lds; int tid, lane, wave, G, c;
    const float* const* in; float* out; unsigned char* ws;
};
#define INP_(i) (F.in[i])
#define FRESH_TID(F) do { int _t = threadIdx.x; asm volatile("" : "+v"(_t)); (F).tid = _t; (F).lane = _t & 63; \
    __attribute__((address_space(1))) unsigned char* _w = (__attribute__((address_space(1))) unsigned char*)args.ws; __attribute__((address_space(1))) float* _o = (__attribute__((address_space(1))) float*)args.out; \
    int _g = gridDim.x; asm volatile("" : "+s"(_w), "+s"(_o), "+s"(_g)); (F).ws = (unsigned char*)_w; (F).out = (float*)_o; (F).G = _g; } while (0)
enum { I_X = 0, I_ANG, I_WIN, I_CDW, I_CDB, I_CLG, I_CLB, I_QG, I_KG, I_PK, I_PV, I_KW1, I_KB1, I_KW2, I_KB2, I_VW1, I_VB1, I_VW2, I_VB2, I_WOUT, I_FNG, I_DW1, I_DW3, I_DW2, I_RW, I_MW1, I_MW3, I_MW2 };

#define PMARK(id) do { if (PROBE_MASK != 0u && blockIdx.x == 0 && threadIdx.x == 0) { volatile LAS unsigned long long* _a = (volatile LAS unsigned long long*)(F.lds + MISC_OFF + 160); volatile LAS unsigned* _o = (volatile LAS unsigned*)(F.lds + MISC_OFF + 168); \
    const unsigned long long _t = __builtin_amdgcn_s_memrealtime(); if (*_o) { *_a += _t; *_o = 0u; } if ((id) < 32 && ((PROBE_MASK >> (id)) & 1u)) { *_a -= _t; *_o = 1u; } } } while (0)
constexpr int RSL_OFF = MISC_OFF + 2048;
__device__ __forceinline__ void rstd_from_partials(const float* pss, int pm, LAS float* tab) {
    int t = threadIdx.x; asm volatile("" : "+v"(t));
    const int row = t >> 1, hf = t & 1;
    const f32x4 a = *(const f32x4*)(pss + (size_t)(pm * 256 + row) * 16 + hf * 8), b = *(const f32x4*)(pss + (size_t)(pm * 256 + row) * 16 + hf * 8 + 4);
    float sq = ((a.x + a.y) + (a.z + a.w)) + ((b.x + b.y) + (b.z + b.w)); sq += __shfl_xor(sq, 1);
    if (hf == 0) tab[row] = rsqf_(sq * (1.0f / D) + EPS);
}
struct EpiIn {
    static constexpr bool PERM = true;
    const float* rstd; bf16_t* U; bf16_t* Q; bf16_t* KV; float* GT; const float* pss; LAS float* rsl;
    struct Pre { int par = 1; };
    __device__ __forceinline__ void prefetch(const Unit& u, int wr, int fr, Pre& p) const {
        p.par ^= 1; LAS float* tab = rsl + p.par * 256;
        if (pss) rstd_from_partials(pss, u.pm, tab); else { int t = threadIdx.x; asm volatile("" : "+v"(t)); if (t < 256) tab[t] = rstd[u.pm * 256 + t]; } }
    __device__ __forceinline__ void operator()(const f32x4 (&acc)[2][2][4][2], const Unit& u, int wr, int wc, int fr, int fq, const Pre& pre) const {
        const int row0 = u.pm * 256 + wr * 64 + fr, cl = wc * 32 + 8 * fq;
        if (u.pn < 4) {
#pragma unroll
            for (int ai = 0; ai < 2; ++ai)
#pragma unroll
                for (int m = 0; m < 4; ++m) { const int r = row0 + ai * 128 + m * 16; const float rs = rsl[pre.par * 256 + wr * 64 + fr + ai * 128 + m * 16];
                    const f32x4 v0 = acc[ai][0][m][0], v1 = acc[ai][0][m][1], g0 = acc[ai][1][m][0], g1 = acc[ai][1][m][1];
                    const float nr = rs * -1.44269504089f; const f32x2e nrs = {nr, nr}, rs1 = {rs, rs};
                    const f32x2e o0 = glus2_(LO2(v0), LO2(g0), nrs, rs1), o1 = glus2_(HI2(v0), HI2(g0), nrs, rs1), o2 = glus2_(LO2(v1), LO2(g1), nrs, rs1), o3 = glus2_(HI2(v1), HI2(g1), nrs, rs1);
                    u32x4 w; w.x = cvt_pk_bf16(o0.x, o0.y); w.y = cvt_pk_bf16(o1.x, o1.y); w.z = cvt_pk_bf16(o2.x, o2.y); w.w = cvt_pk_bf16(o3.x, o3.y);
                    *(u32x4*)(U + (size_t)r * CW + u.pn * 128 + cl) = w; asm volatile("" ::: "memory"); }
        } else if (u.pn < 6) {
#pragma unroll
            for (int ai = 0; ai < 2; ++ai)
#pragma unroll
                for (int m = 0; m < 4; ++m) { const int r = row0 + ai * 128 + m * 16; const float rs = rsl[pre.par * 256 + wr * 64 + fr + ai * 128 + m * 16];
#pragma unroll
                    for (int bj = 0; bj < 2; ++bj) { const f32x4 v0 = acc[ai][bj][m][0] * rs, v1 = acc[ai][bj][m][1] * rs;
                        u32x4 w; w.x = cvt_pk_bf16(v0[0], v0[1]); w.y = cvt_pk_bf16(v0[2], v0[3]); w.z = cvt_pk_bf16(v1[0], v1[1]); w.w = cvt_pk_bf16(v1[2], v1[3]);
                        *(u32x4*)(Q + (size_t)r * 512 + (u.pn - 4) * 256 + bj * 128 + cl) = w; } asm volatile("" ::: "memory"); }
        } else if (u.pn < 9) {
            const int h = wc >> 1, d0 = 32 * (wc & 1) + 8 * fq;
#pragma unroll
            for (int ai = 0; ai < 2; ++ai)
#pragma unroll
                for (int m = 0; m < 4; ++m) { const int r = row0 + ai * 128 + m * 16; const float rs = rsl[pre.par * 256 + wr * 64 + fr + ai * 128 + m * 16]; const int b = r >> 11, t = r & 2047;
#pragma unroll
                    for (int bj = 0; bj < 2; ++bj) { const int tq = 2 * (u.pn - 6) + bj; const f32x4 v0 = acc[ai][bj][m][0] * rs, v1 = acc[ai][bj][m][1] * rs;
                        u32x4 w; w.x = cvt_pk_bf16(v0[0], v0[1]); w.y = cvt_pk_bf16(v0[2], v0[3]); w.z = cvt_pk_bf16(v1[0], v1[1]); w.w = cvt_pk_bf16(v1[2], v1[3]);
                        *(u32x4*)(KV + (size_t)tq * KVT + ((size_t)(b * 2 + h) * SEQ + t) * DH + d0) = w; } asm volatile("" ::: "memory"); }
        } else {
            if (wc == 0 && fq < 3) {
#pragma unroll
                for (int ai = 0; ai < 2; ++ai)
#pragma unroll
                    for (int m = 0; m < 4; ++m) { const int r = row0 + ai * 128 + m * 16; const float rs = rsl[pre.par * 256 + wr * 64 + fr + ai * 128 + m * 16];
                        *(f32x4*)(GT + (size_t)r * 24 + 8 * fq) = acc[ai][0][m][0] * rs; *(f32x4*)(GT + (size_t)r * 24 + 8 * fq + 4) = acc[ai][0][m][1] * rs; }
            }
        }
    }
};
struct EpiH1 {
    static constexpr bool PERM = false;
    float* H;
    struct Pre {}; __device__ __forceinline__ void prefetch(const Unit&, int, int, Pre&) const {}
    __device__ __forceinline__ void operator()(const f32x4 (&acc)[2][2][4][2], const Unit& u, int wr, int wc, int fr, int fq, const Pre&) const {
        const int row0 = u.pm * 256 + wr * 64 + fr, col0 = wc * 32 + 4 * fq; const int kv = u.pn >> 3, sp = u.pn & 7;
#pragma unroll
        for (int ai = 0; ai < 2; ++ai)
#pragma unroll
            for (int m = 0; m < 4; ++m) { float* rowp = H + (((size_t)sp * 2 + kv) * 2048 + row0 + ai * 128 + m * 16) * 256 + col0;
#pragma unroll
                for (int bj = 0; bj < 2; ++bj)
#pragma unroll
                    for (int n = 0; n < 2; ++n) *(f32x4*)(rowp + bj * 128 + n * 16) = acc[ai][bj][m][n]; }
    }
};
template <bool BF> struct EpiRes {
    static constexpr bool PERM = false;
    const void* base; bf16_t* xb; float* pss;
    struct Pre {}; __device__ __forceinline__ void prefetch(const Unit&, int, int, Pre&) const {}
    __device__ __forceinline__ void operator()(const f32x4 (&acc)[2][2][4][2], const Unit& u, int wr, int wc, int fr, int fq, const Pre&) const {
        const int row0 = u.pm * 256 + wr * 64 + fr, col0 = u.pn * 256 + wc * 32 + 4 * fq;
#pragma unroll
        for (int ai = 0; ai < 2; ++ai) {
            f32x4 bs[4][2][2];
#pragma unroll
            for (int m = 0; m < 4; ++m) { const size_t off = (size_t)(row0 + ai * 128 + m * 16) * D + col0;
#pragma unroll
                for (int bj = 0; bj < 2; ++bj)
#pragma unroll
                    for (int n = 0; n < 2; ++n) {
                        if (BF) { const u32x2 w = *(const u32x2*)((const bf16_t*)base + off + bj * 128 + n * 16); bs[m][bj][n] = (f32x4){bf_lo(w.x), bf_hi(w.x), bf_lo(w.y), bf_hi(w.y)}; }
                        else bs[m][bj][n] = *(const f32x4*)((const float*)base + off + bj * 128 + n * 16); } }
#pragma unroll
            for (int m = 0; m < 4; ++m) { const size_t off = (size_t)(row0 + ai * 128 + m * 16) * D + col0; float ss = 0.f;
#pragma unroll
                for (int bj = 0; bj < 2; ++bj)
#pragma unroll
                    for (int n = 0; n < 2; ++n) { const f32x4 v = bs[m][bj][n] + acc[ai][bj][m][n];
                        u32x2 w; w.x = cvt_pk_bf16(v[0], v[1]); w.y = cvt_pk_bf16(v[2], v[3]); *(u32x2*)(xb + off + bj * 128 + n * 16) = w; ss += (v[0] * v[0] + v[1] * v[1]) + (v[2] * v[2] + v[3] * v[3]); }
                if (pss) { ss += __shfl_xor(ss, 16); ss += __shfl_xor(ss, 32);
                    if (fq == 0) pss[(size_t)(row0 + ai * 128 + m * 16) * 16 + u.pn * 4 + wc] = ss; } } }
    }
};
struct EpiGlu {
    static constexpr bool PERM = true;
    const float* rstd; bf16_t* O; int ldo; int rowbase;
    const float* pss; LAS float* rsl;
    struct Pre { int par = 1; };
    __device__ __forceinline__ void prefetch(const Unit& u, int wr, int fr, Pre& p) const { p.par ^= 1; rstd_from_partials(pss, u.pm, rsl + p.par * 256); }
    __device__ __forceinline__ void operator()(const f32x4 (&acc)[2][2][4][2], const Unit& u, int wr, int wc, int fr, int fq, const Pre& pre) const {
        const int row0 = u.pm * 256 + wr * 64 + fr, cl = u.pn * 128 + wc * 32 + 8 * fq;
#pragma unroll
        for (int ai = 0; ai < 2; ++ai)
#pragma unroll
            for (int m = 0; m < 4; ++m) { const int r = row0 + ai * 128 + m * 16; const float rs = rsl[pre.par * 256 + wr * 64 + fr + ai * 128 + m * 16];
                const f32x4 g0 = acc[ai][0][m][0], g1 = acc[ai][0][m][1], u0 = acc[ai][1][m][0], u1 = acc[ai][1][m][1];
                const float nr = rs * -1.44269504089f, r2 = rs * rs; const f32x2e nrs = {nr, nr}, rs2 = {r2, r2};
                const f32x2e o0 = glu2_(LO2(g0), LO2(u0), nrs, rs2), o1 = glu2_(HI2(g0), HI2(u0), nrs, rs2), o2 = glu2_(LO2(g1), LO2(u1), nrs, rs2), o3 = glu2_(HI2(g1), HI2(u1), nrs, rs2);
                u32x4 w; w.x = cvt_pk_bf16(o0.x, o0.y); w.y = cvt_pk_bf16(o1.x, o1.y); w.z = cvt_pk_bf16(o2.x, o2.y); w.w = cvt_pk_bf16(o3.x, o3.y);
                *(u32x4*)(O + (size_t)r * ldo + cl) = w; }
    }
};
struct EpiGlu8 {
    static constexpr bool PERM = true;
    const float* rstd; unsigned char* O; int ldo; float sc;
    struct Pre { float rs[8]; };
    __device__ __forceinline__ void prefetch(const Unit& u, int wr, int fr, Pre& p) const {
#pragma unroll
        for (int q = 0; q < 8; ++q) p.rs[q] = rstd[u.pm * 256 + wr * 64 + fr + (q >> 2) * 128 + (q & 3) * 16]; }
    __device__ __forceinline__ void operator()(const f32x4 (&acc)[2][2][4][2], const Unit& u, int wr, int wc, int fr, int fq, const Pre& pre) const {
        const int row0 = u.pm * 256 + wr * 64 + fr, cl = u.pn * 128 + wc * 32 + 8 * fq;
#pragma unroll
        for (int ai = 0; ai < 2; ++ai)
#pragma unroll
            for (int m = 0; m < 4; ++m) { const int r = row0 + ai * 128 + m * 16; const float rs = pre.rs[ai * 4 + m] * sc;
                const f32x4 g0 = acc[ai][0][m][0], g1 = acc[ai][0][m][1], u0 = acc[ai][1][m][0], u1 = acc[ai][1][m][1];
                const float nr = rs * -1.44269504089f, r2 = rs * rs; const f32x2e nrs = {nr, nr}, rs2 = {r2, r2};
                const f32x2e o0 = glu2_(LO2(g0), LO2(u0), nrs, rs2), o1 = glu2_(HI2(g0), HI2(u0), nrs, rs2), o2 = glu2_(LO2(g1), LO2(u1), nrs, rs2), o3 = glu2_(HI2(g1), HI2(u1), nrs, rs2);
                *(u32x2*)(O + (size_t)r * ldo + cl) = pk8_fp8(o0.x, o0.y, o1.x, o1.y, o2.x, o2.y, o3.x, o3.y); }
    }
};
struct EpiMoe2 {
    static constexpr bool PERM = true;
    const int* stok; const float* sw; bf16_t* Y0; bf16_t* Y1; int rowbase; float sc;
    struct Pre {}; __device__ __forceinline__ void prefetch(const Unit&, int, int, Pre&) const {}
    __device__ __forceinline__ void operator()(const f32x4 (&acc)[2][2][4][2], const Unit& u, int wr, int wc, int fr, int fq, const Pre&) const {
        const int row0 = u.pm * 256 + wr * 64 + fr, cl = u.pn * 256 + wc * 32 + 8 * fq;
        int tks[8]; float ws[8];
#pragma unroll
        for (int q = 0; q < 8; ++q) { const int r = rowbase + row0 + (q >> 2) * 128 + (q & 3) * 16; tks[q] = stok[r]; ws[q] = sw[r]; }
#pragma unroll
        for (int ai = 0; ai < 2; ++ai)
#pragma unroll
            for (int m = 0; m < 4; ++m) { const int tk = tks[ai * 4 + m]; const float w = ws[ai * 4 + m] * sc;
                if (tk >= 0) { bf16_t* dst = ((tk & 1) ? Y1 : Y0) + (size_t)(tk >> 1) * D + cl;
#pragma unroll
                    for (int bj = 0; bj < 2; ++bj) { const f32x4 v0 = acc[ai][bj][m][0] * w, v1 = acc[ai][bj][m][1] * w;
                        u32x4 o; o.x = cvt_pk_bf16(v0[0], v0[1]); o.y = cvt_pk_bf16(v0[2], v0[3]); o.z = cvt_pk_bf16(v1[0], v1[1]); o.w = cvt_pk_bf16(v1[2], v1[3]);
                        *(u32x4*)(dst + bj * 128) = o; } } }
    }
};

struct SchedCmp {
    int G, c, layer;
    __device__ __forceinline__ bool next(int i, Unit& u) const {
        const int L = i * G + c; if (L >= 128) return false;
        const int kv = L >> 6, pm = (L >> 3) & 7, s = L & 7;
        u.pm = pm; u.pn = kv * 8 + s; u.aoff = ((size_t)kv * KVT + (size_t)pm * 256 * 1024 + s * 256) * 2; u.boff = ((size_t)(layer * 2 + kv) * 256 * 2048 + s * 256) * 2; return true;
    }
};
struct SchedMoe1 {
    int G, c, p0, np; const LAS int* ptab;
    __device__ __forceinline__ bool next(int i, Unit& u) const {
        const int L = i * G + c; if (L >= np * 28) return false;
        const int j = L / np, pl = L % np, e = ptab[p0 + pl];
        u.pm = pl; u.pn = j; u.aoff = (size_t)(p0 + pl) * 256 * 1024 * 2; u.boff = ((size_t)e * 7168 + (size_t)j * 256) * 1024 * 2; return true;
    }
};
struct SchedMoe2 {
    int G, c, p0, np; const LAS int* ptab;
    __device__ __forceinline__ bool next(int i, Unit& u) const {
        const int L = i * G + c; if (L >= np * 4) return false;
        const int j = L / np, pl = L % np, e = ptab[p0 + pl];
        u.pm = pl; u.pn = j; u.aoff = (size_t)pl * 256 * DFE * 2; u.boff = ((size_t)e * 1024 + (size_t)j * 256) * DFE * 2; return true;
    }
};

struct SchedMoe1F {
    int G, c, np; const LAS int* ptab;
    __device__ __forceinline__ bool next(int i, Unit& u) const {
        const int L = i * G + c; if (L >= np * 28) return false;
        const int pl = L / 28, j = L % 28, e = ptab[pl];
        u.pm = pl; u.pn = j; u.aoff = (size_t)pl * 256 * 1024; u.boff = ((size_t)e * 7168 + (size_t)j * 256) * 1024; return true;
    }
};
struct SchedMoe2F {
    int G, c, np; const LAS int* ptab;
    __device__ __forceinline__ bool next(int i, Unit& u) const {
        const int L = i * G + c; if (L >= np * 4) return false;
        const int pl = L >> 2, j = L & 3, e = ptab[pl];
        u.pm = pl; u.pn = j; u.aoff = (size_t)pl * 256 * DFE; u.boff = ((size_t)e * 1024 + (size_t)j * 256) * DFE; return true;
    }
};

struct TwP { const float* W; const float* gv; bf16_t* WT; int ldw, n0, nvalid, k0, ldk, kind, h; float f8sc; };
__device__ __forceinline__ TwP tw_job(int r, const float* W, int ldw, int nblk, int nvalid, bf16_t* WT, int ldk, int kind, int h, const float* gv) {
    TwP P; P.W = W; P.gv = gv; P.WT = WT; P.ldw = ldw; P.n0 = 256 * (r % nblk); P.nvalid = nvalid; P.k0 = 64 * (r / nblk); P.ldk = ldk; P.kind = kind; P.h = h; P.f8sc = 0.f; return P; }
__device__ __forceinline__ void tw_load(const TwP& P, f32x4 (&tv)[8], int wave, int lane) {
    const int n = P.n0 + 4 * lane; const float* src = P.W + (size_t)(P.k0 + 8 * wave) * P.ldw + n;
#pragma unroll
    for (int i = 0; i < 8; ++i) tv[i] = (n < P.nvalid) ? *(const f32x4*)(src + (size_t)i * P.ldw) : (f32x4){0.f, 0.f, 0.f, 0.f};
}
__device__ __forceinline__ void tw_store(const TwP& P, f32x4 (&tv)[8], LAS unsigned char* tile, int wave, int lane) {
    if (P.gv) {
#pragma unroll
        for (int i = 0; i < 8; ++i) tv[i] *= P.gv[P.k0 + 8 * wave + i]; }
    const int ng = P.n0 + 32 * wave; size_t drow;
    if (P.kind == 0) drow = ng;
    else if (P.kind == 1) drow = 256 * (ng / 128) + 128 * P.h + (ng % 128);
    else { if (ng < 512) drow = 256 * (ng / 128) + (ng % 128); else if (ng < 1024) { const int cc = ng - 512; drow = 256 * (cc / 128) + 128 + (cc % 128); } else drow = ng; }
    if (P.f8sc != 0.f) {
        const float sc = P.f8sc;
#pragma unroll
        for (int c = 0; c < 4; ++c) *(LAS u32x2*)(tile + (4 * lane + c) * 80 + 8 * wave) = pk8_fp8(tv[0][c] * sc, tv[1][c] * sc, tv[2][c] * sc, tv[3][c] * sc, tv[4][c] * sc, tv[5][c] * sc, tv[6][c] * sc, tv[7][c] * sc);
        __syncthreads();
#pragma unroll
        for (int j = 0; j < 2; ++j) { const int r = (lane >> 2) + 16 * j, ch = lane & 3;
            *(u32x4*)((unsigned char*)P.WT + (drow + r) * (size_t)P.ldk + P.k0 + 16 * ch) = *(const LAS u32x4*)(tile + (32 * wave + r) * 80 + 16 * ch); }
        __syncthreads();
        return; }
#pragma unroll
    for (int c = 0; c < 4; ++c) { u32x4 o; o.x = cvt_pk_bf16(tv[0][c], tv[1][c]); o.y = cvt_pk_bf16(tv[2][c], tv[3][c]); o.z = cvt_pk_bf16(tv[4][c], tv[5][c]); o.w = cvt_pk_bf16(tv[6][c], tv[7][c]);
        *(LAS u32x4*)(tile + (4 * lane + c) * 144 + 16 * wave) = o; }
    __syncthreads();
#pragma unroll
    for (int j = 0; j < 4; ++j) { const int r = (lane >> 3) + 8 * j, c = lane & 7;
        *(u32x4*)(P.WT + (drow + r) * (size_t)P.ldk + P.k0 + 8 * c) = *(const LAS u32x4*)(tile + (32 * wave + r) * 144 + 16 * c); }
    __syncthreads();
}
#define TW_RUN(NIT, JOB) do { const int _n = (NIT); if (_n > 0) { TwP _pa, _pb; f32x4 _ta[8], _tb[8]; JOB(_pa, 0); tw_load(_pa, _ta, F.wave, F.lane); \
    _Pragma("nounroll") for (int _i = 0; _i < _n; _i += 2) { const bool _h2 = _i + 1 < _n, _h3 = _i + 2 < _n; \
        if (_h2) { JOB(_pb, _i + 1); tw_load(_pb, _tb, F.wave, F.lane); } tw_store(_pa, _ta, F.lds, F.wave, F.lane); if (!_h2) break; \
        if (_h3) { JOB(_pa, _i + 2); tw_load(_pa, _ta, F.wave, F.lane); } tw_store(_pb, _tb, F.lds, F.wave, F.lane); } } } while (0)
__device__ __forceinline__ void xprep_row(const float* xrow, bf16_t* orow, float* rstd_out, int lane, f32x4 (&v)[4]) {
    const f32x4* xr = (const f32x4*)xrow + lane; float s = 0.f;
#pragma unroll
    for (int j = 0; j < 4; ++j) { v[j] = xr[64 * j]; s += (v[j].x * v[j].x + v[j].y * v[j].y) + (v[j].z * v[j].z + v[j].w * v[j].w); }
    const float rstd = rsqf_(wave_sum_u(s) * (1.0f / D) + EPS);
    if (orow) { u32x2* o8 = (u32x2*)orow + lane;
#pragma unroll
        for (int j = 0; j < 4; ++j) { u32x2 w; w.x = cvt_pk_bf16(v[j].x, v[j].y); w.y = cvt_pk_bf16(v[j].z, v[j].w); o8[64 * j] = w; } }
    if (lane == 0) *rstd_out = rstd;
}

constexpr float MOE_S1 = 64.f, MOE_S2 = 128.f;
constexpr int MOE_SLOT_N = 7, MOE_SLOTTED = 3 * 128 * MOE_SLOT_N;
constexpr int MOE_ITEMS = 24 * 224;
__device__ __forceinline__ TwP moe_conv_job(Frame& F, int r) {
    constexpr int J_M1 = 16 * 14, J_M2 = 56 * 4;
    unsigned char* WM1 = F.ws + WS_WM1; unsigned char* WM2 = F.ws + WS_WM2;
    if (r < 16 * J_M1) { const int q = r / J_M1, e = q >> 1, h = q & 1; TwP P = tw_job(r % J_M1, (h ? INP_(I_MW3) : INP_(I_MW1)) + (size_t)e * D * DFE, DFE, 14, DFE, (bf16_t*)(WM1 + (size_t)e * 7168 * D), D, 1, h, INP_(I_FNG) + D); P.f8sc = MOE_S1; return P; }
    r -= 16 * J_M1; const int e = r / J_M2; TwP P = tw_job(r % J_M2, INP_(I_MW2) + (size_t)e * DFE * D, D, 4, D, (bf16_t*)(WM2 + (size_t)e * D * DFE), DFE, 0, 0, nullptr); P.f8sc = MOE_S2; return P;
}
__device__ __forceinline__ void moe_conv_slot(Frame& F, int slot) {
    if (F.G != 256 || F.c < 128) return;
    { int _t = threadIdx.x; asm volatile("" : "+v"(_t)); F.tid = _t; F.lane = _t & 63; }
    int base = slot * 128 * MOE_SLOT_N + ((int)blockIdx.x - 128); asm volatile("" : "+s"(base));
#define MJOB(P, i) P = moe_conv_job(F, base + (i) * 128)
    TW_RUN(MOE_SLOT_N, MJOB);
#undef MJOB
}
__device__ __forceinline__ void xprep_rows4(const float* X, bf16_t* XBo, float* RSo, int m, int ms, int lane) {
    f32x4 v[4][4];
#pragma unroll
    for (int q = 0; q < 4; ++q) { const int mm = m + q * ms; const f32x4* xr = (const f32x4*)(X + (size_t)(mm < M ? mm : 0) * D) + lane;
#pragma unroll
        for (int j = 0; j < 4; ++j) v[q][j] = xr[64 * j]; }
#pragma unroll
    for (int q = 0; q < 4; ++q) { const int mm = m + q * ms; if (mm >= M) break; float s = 0.f;
#pragma unroll
        for (int j = 0; j < 4; ++j) s += (v[q][j].x * v[q][j].x + v[q][j].y * v[q][j].y) + (v[q][j].z * v[q][j].z + v[q][j].w * v[q][j].w);
        const float rstd = rsqf_(wave_sum_u(s) * (1.0f / D) + EPS);
        u32x2* o8 = (u32x2*)(XBo + (size_t)mm * D) + lane;
#pragma unroll
        for (int j = 0; j < 4; ++j) { u32x2 w; w.x = cvt_pk_bf16(v[q][j].x, v[q][j].y); w.y = cvt_pk_bf16(v[q][j].z, v[q][j].w); o8[64 * j] = w; }
        if (lane == 0) RSo[mm] = rstd; }
}
__device__ __forceinline__ void phase_prologue(Frame& F) {
    const int gw = F.c * NWAVES + F.wave, NGW = F.G * NWAVES;
    bf16_t* WIN = (bf16_t*)(F.ws + WS_WIN); bf16_t* WC1 = (bf16_t*)(F.ws + WS_WC1); bf16_t* WOUT = (bf16_t*)(F.ws + WS_WOUT); bf16_t* WF1 = (bf16_t*)(F.ws + WS_WF1); bf16_t* WF2 = (bf16_t*)(F.ws + WS_WF2);
    constexpr int J_IN = 16 * 10, J_C1 = 32, J_OUT = 16 * 4, J_F1 = 16 * 11, J_F2 = 44 * 4;
    constexpr int NSMALL = 2 * J_IN + 4 * J_C1 + 2 * J_OUT + 2 * J_F1 + J_F2;
    const int moe0 = (F.G == 256) ? MOE_SLOTTED : 0; const int nitems = NSMALL + MOE_ITEMS - moe0;
#define P0_JOB(P, i) do { int r = F.c + (i) * F.G; \
        if (r < 2 * J_IN) { const int l = r / J_IN; P = tw_job(r % J_IN, INP_(I_WIN) + (size_t)l * D * INW, INW, 10, INW, WIN + (size_t)l * INP * D, D, 2, 0, INP_(I_ANG) + l * D); break; } r -= 2 * J_IN; \
        if (r < 4 * J_C1) { const int q = r / J_C1, l = q >> 1, kv = q & 1; P = tw_job(r % J_C1, (kv ? INP_(I_VW1) : INP_(I_KW1)) + (size_t)l * 2048 * 256, 256, 1, 256, WC1 + (size_t)(l * 2 + kv) * 256 * 2048, 2048, 0, 0, nullptr); break; } r -= 4 * J_C1; \
        if (r < 2 * J_OUT) { const int l = r / J_OUT; P = tw_job(r % J_OUT, INP_(I_WOUT) + (size_t)l * D * D, D, 4, D, WOUT + (size_t)l * D * D, D, 0, 0, nullptr); break; } r -= 2 * J_OUT; \
        if (r < 2 * J_F1) { const int h = r / J_F1; P = tw_job(r % J_F1, (h ? INP_(I_DW3) : INP_(I_DW1)), DFF, 11, DFF, WF1, D, 1, h, INP_(I_FNG)); break; } r -= 2 * J_F1; \
        if (r < J_F2) { P = tw_job(r, INP_(I_DW2), D, 4, D, WF2, DFF, 0, 0, nullptr); break; } r -= J_F2; \
        P = moe_conv_job(F, r + moe0); } while (0)
    TW_RUN((nitems - F.c + F.G - 1) / F.G, P0_JOB);
#undef P0_JOB
    { float* RT = (float*)(F.ws + WS_RT); const int gt = F.c * NTHR + F.tid; if (gt < 8192) { const int e = gt >> 10, k = gt & 1023; RT[gt] = INP_(I_RW)[k * 8 + e] * INP_(I_FNG)[D + k]; } }
    { float* B1P = (float*)(F.ws + WS_CTL) + CW_B1P; LAS float* ps = (LAS float*)F.lds;
      for (int it = F.c; it < 128; it += F.G) { const int kc = it & 7, jb = (it >> 3) & 3, kv = (it >> 5) & 1, l = it >> 6; const int j = jb * 64 + F.lane, kb = kc * 256 + 32 * F.wave;
          const float* w1 = (kv ? INP_(I_VW1) : INP_(I_KW1)) + (size_t)l * 2048 * 256; const float* pos = (kv ? INP_(I_PV) : INP_(I_PK)) + l * 2048;
          float wv[32];
#pragma unroll
          for (int k = 0; k < 32; ++k) wv[k] = w1[(size_t)(kb + k) * 256 + j];
          float sp = 0.f;
#pragma unroll
          for (int k = 0; k < 32; ++k) sp += pos[kb + k] * wv[k];
          ps[F.wave * 64 + F.lane] = sp;
          __syncthreads();
          if (F.wave == 0) { float t = (kc == 0) ? (kv ? INP_(I_VB1) : INP_(I_KB1))[l * 256 + j] : 0.f;
#pragma unroll
              for (int ww = 0; ww < 8; ++ww) t += ps[ww * 64 + F.lane];
              B1P[kc * 1024 + (l * 2 + kv) * 256 + j] = t; }
          __syncthreads(); } }
    { bf16_t* XB = (bf16_t*)(F.ws + WS_XB); float* RS = (float*)(F.ws + WS_RSTD);
      for (int m = gw; m < M; m += 4 * NGW) xprep_rows4(INP_(I_X), XB, RS, m, NGW, F.lane); }
}

__device__ __forceinline__ void norm_rows64(bf16_t* buf, int nrows, const float* g, float scale, int gw, int NGW, int lane) {
    const int sub = lane & 7; float gv[8];
#pragma unroll
    for (int j = 0; j < 8; ++j) gv[j] = g[sub * 8 + j] * scale;
    for (int it = gw; it < nrows / 8; it += NGW) { u32x4* p = (u32x4*)(buf + ((size_t)it * 8 + (lane >> 3)) * 64) + sub; const u32x4 v = *p;
        float f[8] = {bf_lo(v.x), bf_hi(v.x), bf_lo(v.y), bf_hi(v.y), bf_lo(v.z), bf_hi(v.z), bf_lo(v.w), bf_hi(v.w)}; float s = 0.f;
#pragma unroll
        for (int j = 0; j < 8; ++j) s += f[j] * f[j];
        s += __shfl_xor(s, 1); s += __shfl_xor(s, 2); s += __shfl_xor(s, 4);
        const float rs = rsqf_(s * (1.0f / 64.0f) + EPS);
        u32x4 o; o.x = cvt_pk_bf16(f[0] * rs * gv[0], f[1] * rs * gv[1]); o.y = cvt_pk_bf16(f[2] * rs * gv[2], f[3] * rs * gv[3]); o.z = cvt_pk_bf16(f[4] * rs * gv[4], f[5] * rs * gv[5]); o.w = cvt_pk_bf16(f[6] * rs * gv[6], f[7] * rs * gv[7]);
        *p = o; }
}
__device__ __forceinline__ float sum32_(float v, bool) {
    v = DPP_ADD(v, 0xB1); v = DPP_ADD(v, 0x4E); v = DPP_ADD(v, 0x124); v = DPP_ADD(v, 0x128);
    return v + __shfl_xor(v, 16);
}
__device__ __forceinline__ void conv_unit(Frame& F, int layer, int cu) {
    const int b = cu >> 6, t0 = (cu & 63) * 32; int tid = F.tid; asm volatile("" : "+v"(tid));
    const bf16_t* U = (const bf16_t*)(F.ws + WS_U); bf16_t* MIX = (bf16_t*)(F.ws + WS_MIX);
    LAS u32x4* L4 = (LAS u32x4*)F.lds;
    { u32x4 sv[8];
#pragma unroll
      for (int q = 0; q < 8; ++q) { const int i = tid + q * NTHR, row = i >> 6, ch = i & 63, t = t0 - 30 + row; sv[q] = (u32x4){0u, 0u, 0u, 0u}; if (i < 62 * 64 && t >= 0) sv[q] = *(const u32x4*)(U + (size_t)(b * SEQ + t) * CW + ch * 8); }
#pragma unroll
      for (int q = 0; q < 8; ++q) { const int i = tid + q * NTHR; if (i < 62 * 64) L4[i] = sv[q]; } }
    __syncthreads();
    const int cp = tid & 255, th = tid >> 8; const bool hi = (tid & 32) != 0; const LAS unsigned* LW = (const LAS unsigned*)F.lds;
    f32x2 w[CKW];
#pragma unroll
    for (int k = 0; k < CKW; ++k) w[k] = *(const f32x2*)(INP_(I_CDW) + (size_t)layer * CKW * CW + k * CW + 2 * cp);
    const f32x2 cb = *(const f32x2*)(INP_(I_CDB) + layer * CW + 2 * cp), lg = *(const f32x2*)(INP_(I_CLG) + layer * CW + 2 * cp), lb = *(const f32x2*)(INP_(I_CLB) + layer * CW + 2 * cp);
#pragma nounroll
    for (int hf = 0; hf < 2; ++hf) { const int tl0 = th * 16 + hf * 8;
        f32x2 in[38];
#pragma unroll
        for (int i = 0; i < 38; ++i) { const unsigned v = LW[(tl0 + i) * 256 + cp]; in[i] = (f32x2){bf_lo(v), bf_hi(v)}; }
        f32x2 acc[8];
#pragma unroll
        for (int t = 0; t < 8; ++t) { acc[t] = cb;
#pragma unroll
            for (int k = 0; k < CKW; ++k) acc[t] += w[k] * in[t + k]; }
#pragma unroll
        for (int t = 0; t < 8; ++t) {
            const float s = sum32_(acc[t].x + acc[t].y, hi), q = sum32_(acc[t].x * acc[t].x + acc[t].y * acc[t].y, hi);
            const float mu = s * (1.0f / 64.0f), var = fmaxf(q * (1.0f / 64.0f) - mu * mu, 0.f), rs = rsqf_(var + EPS);
            const float a0 = (acc[t].x - mu) * rs * lg.x + lb.x, a1 = (acc[t].y - mu) * rs * lg.y + lb.y;
            *(unsigned*)(MIX + (size_t)(b * SEQ + t0 + tl0 + t) * D + 2 * cp) = cvt_pk_bf16(siluf_(a0), siluf_(a1)); }
    }
    __syncthreads();
}
__device__ __forceinline__ void vtrans_items(Frame& F, int gw, int NGW) {
    const int lane = F.lane;
    LAS unsigned char* scr = F.lds + F.wave * 9216;
    for (int it = gw; it < 1024; it += NGW) { const int ten = it >> 9, bh = (it >> 5) & 15, kb = it & 31;
        const bf16_t* V = (const bf16_t*)(F.ws + WS_KV) + (size_t)(ten ? 5 : 3) * KVT + ((size_t)bh * SEQ + kb * 64) * 64; bf16_t* VT = (bf16_t*)(F.ws + (ten ? WS_VWT : WS_VST)) + (size_t)bh * 64 * SEQ + kb * 64;
#pragma unroll
        for (int c = 0; c < 8; ++c) *(LAS u32x4*)(scr + lane * 144 + c * 16) = *((const u32x4*)(V + (size_t)lane * 64) + c);
        LDS_WAIT(); __builtin_amdgcn_wave_barrier(); asm volatile("" ::: "memory");
#pragma unroll
        for (int c = 0; c < 8; ++c) { unsigned w[4];
#pragma unroll
            for (int q = 0; q < 4; ++q) { const int v0 = 8 * c + 2 * q, k0 = swap23(v0), k1 = swap23(v0 + 1);
                w[q] = (unsigned)*(const LAS bf16_t*)(scr + k0 * 144 + lane * 2) | ((unsigned)*(const LAS bf16_t*)(scr + k1 * 144 + lane * 2) << 16); }
            *((u32x4*)(VT + (size_t)lane * SEQ) + c) = (u32x4){w[0], w[1], w[2], w[3]}; }
        LDS_WAIT(); __builtin_amdgcn_wave_barrier(); asm volatile("" ::: "memory");
    }
}
__device__ __forceinline__ void phase_cmp2(Frame& F, int layer) {
    const int lane = F.lane, w = F.wave, k0 = 32 * w;
    const float* H1 = (const float*)(F.ws + WS_H1); const float* B1P = (const float*)(F.ws + WS_CTL) + CW_B1P + layer * 512;
    LAS float* part = (LAS float*)F.lds;
#pragma nounroll
    for (int un = F.c; un < 256; un += F.G) { const int kv = un >> 7, R0 = (un & 127) * 16;
        const float* w2 = (kv ? INP_(I_VW2) : INP_(I_KW2)) + (size_t)layer * 16384 + (size_t)k0 * 64 + lane;
        float w2r[32];
#pragma unroll
        for (int j = 0; j < 32; ++j) w2r[j] = w2[j * 64];
        float bsum = 0.f;
#pragma unroll
        for (int sp = 0; sp < 8; ++sp) bsum += B1P[sp * 1024 + kv * 256 + k0 + (lane & 31)];
        float acc[16], hx[16];
        {
            float hp[16][8];
#pragma unroll
            for (int r = 0; r < 16; ++r)
#pragma unroll
                for (int sp = 0; sp < 8; ++sp) hp[r][sp] = H1[((size_t)kv * 2048 + R0 + r) * 256 + k0 + (lane & 31) + (size_t)sp * 2 * 2048 * 256];
#pragma unroll
            for (int r = 0; r < 16; ++r) { float x = 0.f;
#pragma unroll
                for (int sp = 0; sp < 8; ++sp) x += hp[r][sp];
                hx[r] = siluf_(x + bsum); } }
#pragma unroll
        for (int r = 0; r < 16; ++r) { const int hb = __builtin_bit_cast(int, hx[r]); float a = 0.f;
#pragma unroll
            for (int j = 0; j < 32; ++j) a += __builtin_bit_cast(float, __builtin_amdgcn_readlane(hb, j)) * w2r[j];
            acc[r] = a; }
#pragma unroll
        for (int r = 0; r < 16; ++r) part[(w * 16 + r) * 64 + lane] = acc[r];
        __syncthreads();
#pragma unroll
        for (int rr = 0; rr < 2; ++rr) { const int r = 2 * w + rr, R = R0 + r;
            float a = (kv ? INP_(I_VB2) : INP_(I_KB2))[layer * 64 + lane];
#pragma unroll
            for (int ww = 0; ww < 8; ++ww) a += part[(ww * 16 + r) * 64 + lane];
            if ((R & 127) == 127) a = 0.f;
            else if (kv == 0) { const float ms = wave_sum_u(a * a) * (1.0f / 64.0f); a = a * (rsqf_(ms + EPS)) * INP_(I_KG)[layer * 192 + lane]; }
            const bf16_t ab = (bf16_t)(cvt_pk_bf16(a, 0.f) & 0xffffu);
            ((bf16_t*)(F.ws + (kv ? WS_VC : WS_KC)))[(size_t)R * 64 + lane] = ab;
            if (kv) ((bf16_t*)(F.ws + WS_VCT))[((size_t)(R >> 7) * 64 + lane) * 128 + swap23(R & 127)] = ab; }
        __syncthreads();
    }
}

__device__ __forceinline__ void dots4(const bf16_t* krow, const LAS float* qs, float (&s)[4]) {
    s[0] = s[1] = s[2] = s[3] = 0.f;
#pragma nounroll
    for (int c = 0; c < 8; ++c) { const u32x4 v = *((const u32x4*)krow + c);
        const float f[8] = {bf_lo(v.x), bf_hi(v.x), bf_lo(v.y), bf_hi(v.y), bf_lo(v.z), bf_hi(v.z), bf_lo(v.w), bf_hi(v.w)};
#pragma unroll
        for (int h = 0; h < 4; ++h) { const f32x4 q0 = *(const LAS f32x4*)(qs + h * 64 + c * 8), q1 = *(const LAS f32x4*)(qs + h * 64 + c * 8 + 4);
            s[h] += (f[0] * q0.x + f[1] * q0.y) + (f[2] * q0.z + f[3] * q0.w) + (f[4] * q1.x + f[5] * q1.y) + (f[6] * q1.z + f[7] * q1.w); } }
}
__device__ __forceinline__ void softmax_pv(LAS f32x4* sb, const LAS int* kb, int nk, const bf16_t* V, int lane, float (&o)[4]) {
    float m[4] = {-1e30f, -1e30f, -1e30f, -1e30f};
#pragma nounroll
    for (int c = 0; c < nk; ++c) { const f32x4 s = sb[c * 64 + lane]; m[0] = fmaxf(m[0], s.x); m[1] = fmaxf(m[1], s.y); m[2] = fmaxf(m[2], s.z); m[3] = fmaxf(m[3], s.w); }
#pragma unroll
    for (int h = 0; h < 4; ++h) m[h] = wave_max(m[h]);
    float sum[4] = {0.f, 0.f, 0.f, 0.f};
#pragma nounroll
    for (int c = 0; c < nk; ++c) { const f32x4 s = sb[c * 64 + lane]; f32x4 p;
        p.x = s.x > -1e29f ? __expf(s.x - m[0]) : 0.f; p.y = s.y > -1e29f ? __expf(s.y - m[1]) : 0.f; p.z = s.z > -1e29f ? __expf(s.z - m[2]) : 0.f; p.w = s.w > -1e29f ? __expf(s.w - m[3]) : 0.f;
        sum[0] += p.x; sum[1] += p.y; sum[2] += p.z; sum[3] += p.w; sb[c * 64 + lane] = p; }
    float inv[4];
#pragma unroll
    for (int h = 0; h < 4; ++h) inv[h] = rcpf_(fmaxf(wave_sum(sum[h]), 1e-30f));
    LDS_WAIT(); __builtin_amdgcn_wave_barrier(); asm volatile("" ::: "memory");
    o[0] = o[1] = o[2] = o[3] = 0.f;
#pragma nounroll
    for (int c = 0; c < nk; ++c) { const int k0 = kb[c];
#pragma unroll 4
        for (int kk = 0; kk < 64; ++kk) { int key = k0 + kk; key = key < 0 ? 0 : (key > SEQ - 1 ? SEQ - 1 : key);
            const f32x4 p = sb[c * 64 + kk]; const float v = bf2f(V[(size_t)key * 64 + lane]);
            o[0] += p.x * v; o[1] += p.y * v; o[2] += p.z * v; o[3] += p.w * v; } }
#pragma unroll
    for (int h = 0; h < 4; ++h) o[h] *= inv[h];
    __builtin_amdgcn_wave_barrier(); asm volatile("" ::: "memory");
}
__device__ __forceinline__ void phase_attn_ref(Frame& F, int layer) {
    const int lane = F.lane;
    LAS unsigned char* wl = F.lds + F.wave * 12288;
    LAS float* qs = (LAS float*)wl;
    LAS f32x4* pc = (LAS f32x4*)(wl + 1024);
    LAS float* psum = (LAS float*)(wl + 3072);
    LAS int* kbl = (LAS int*)(wl + 3584);
    LAS f32x4* sb = (LAS f32x4*)(wl + 4096);
    const bf16_t* QN = (const bf16_t*)(F.ws + WS_Q); const bf16_t* KVb = (const bf16_t*)(F.ws + WS_KV);
    const bf16_t* KC = (const bf16_t*)(F.ws + WS_KC); const bf16_t* VC = (const bf16_t*)(F.ws + WS_VC);
    const float* GT = (const float*)(F.ws + WS_GT); bf16_t* MIX = (bf16_t*)(F.ws + WS_MIX);
#pragma nounroll
    for (int un = F.c; un < NBH * 64; un += F.G) {
        const int bh = un >> 6, tile = un & 63, b = bh >> 1, kvh = bh & 1;
        const bf16_t* KS = KVb + 2 * KVT + (size_t)bh * SEQ * 64; const bf16_t* VS = KVb + 3 * KVT + (size_t)bh * SEQ * 64;
        const bf16_t* KW = KVb + 4 * KVT + (size_t)bh * SEQ * 64; const bf16_t* VW = KVb + 5 * KVT + (size_t)bh * SEQ * 64;
#pragma nounroll
        for (int ti = 0; ti < 4; ++ti) {
            const int t = tile * 32 + F.wave * 4 + ti, r = b * SEQ + t;
#pragma unroll
            for (int h = 0; h < 4; ++h) qs[h * 64 + lane] = bf2f(QN[(size_t)r * 512 + (kvh * 4 + h) * 64 + lane]);
            LDS_WAIT(); __builtin_amdgcn_wave_barrier(); asm volatile("" ::: "memory");
            float sc[2][4]; bool vc[2];
#pragma unroll
            for (int u = 0; u < 2; ++u) { const int c = lane + 64 * u; vc[u] = (c < NCMP) && (16 * c + 31 <= t);
                if (vc[u]) dots4(KC + ((size_t)bh * 128 + c) * 64, qs, sc[u]); else { sc[u][0] = sc[u][1] = sc[u][2] = sc[u][3] = -1e30f; } }
            float pr[2][4];
#pragma unroll
            for (int h = 0; h < 4; ++h) { const float mx = wave_max(fmaxf(sc[0][h], sc[1][h]));
                pr[0][h] = vc[0] ? __expf(sc[0][h] - mx) : 0.f; pr[1][h] = vc[1] ? __expf(sc[1][h] - mx) : 0.f;
                const float inv = rcpf_(fmaxf(wave_sum(pr[0][h] + pr[1][h]), 1e-30f)); pr[0][h] *= inv; pr[1][h] *= inv; }
#pragma unroll
            for (int u = 0; u < 2; ++u) { pc[lane + 64 * u] = (f32x4){pr[u][0], pr[u][1], pr[u][2], pr[u][3]}; psum[lane + 64 * u] = (pr[u][0] + pr[u][1]) + (pr[u][2] + pr[u][3]); }
            LDS_WAIT(); __builtin_amdgcn_wave_barrier(); asm volatile("" ::: "memory");
            const int j = lane & 31, cur = t >> 6; float imp = 0.f;
#pragma unroll
            for (int cc = -1; cc <= 3; ++cc) { const int c = 4 * j + cc; if (c >= 0 && c < NCMP) imp += psum[c]; }
            const bool causal = (j * 64 <= t), forced = (j == 0) || (j == cur) || (j == cur - 1);
            const float score = causal ? (forced ? imp + 1e4f : imp) : -1e30f;
            int rank = 0;
#pragma unroll
            for (int i = 0; i < 32; ++i) { const float si = __shfl(score, i); rank += (si > score || (si == score && i < j)) ? 1 : 0; }
            const unsigned selmask = (unsigned)__ballot(lane < 32 && rank < 8 && causal);
            float ocmp[4] = {0.f, 0.f, 0.f, 0.f};
            { const int nvc = t >= 31 ? (((t - 31) >> 4) + 1 > NCMP ? NCMP : ((t - 31) >> 4) + 1) : 0;
#pragma unroll 4
              for (int c = 0; c < nvc; ++c) { const f32x4 p = pc[c]; const float v = bf2f(VC[((size_t)bh * 128 + c) * 64 + lane]); ocmp[0] += p.x * v; ocmp[1] += p.y * v; ocmp[2] += p.z * v; ocmp[3] += p.w * v; } }
            __builtin_amdgcn_wave_barrier(); asm volatile("" ::: "memory");
            int nk = 0; float osel[4], owin[4];
#pragma nounroll
            for (unsigned mm = selmask; mm != 0u && nk < 8; mm &= mm - 1u) { const int jj = __builtin_ctz(mm);
                const int key = jj * 64 + lane; float s[4];
                if (key <= t) dots4(KS + (size_t)key * 64, qs, s); else { s[0] = s[1] = s[2] = s[3] = -1e30f; }
                sb[nk * 64 + lane] = (f32x4){s[0], s[1], s[2], s[3]};
                if (lane == 0) kbl[nk] = jj * 64;
                ++nk; }
            LDS_WAIT(); __builtin_amdgcn_wave_barrier(); asm volatile("" ::: "memory");
            softmax_pv(sb, kbl, nk, VS, lane, osel);
            nk = 0;
#pragma nounroll
            for (int ch = 0; ch < 8; ++ch) { const int k0 = t - 511 + 64 * ch; if (k0 + 63 < 0) continue;
                const int key = k0 + lane; float s[4];
                if (key >= 0) dots4(KW + (size_t)key * 64, qs, s); else { s[0] = s[1] = s[2] = s[3] = -1e30f; }
                sb[nk * 64 + lane] = (f32x4){s[0], s[1], s[2], s[3]};
                if (lane == 0) kbl[nk] = k0;
                ++nk; }
            LDS_WAIT(); __builtin_amdgcn_wave_barrier(); asm volatile("" ::: "memory");
            softmax_pv(sb, kbl, nk, VW, lane, owin);
#pragma unroll
            for (int h = 0; h < 4; ++h) { const float* gp = GT + (size_t)r * 24 + (kvh * 4 + h) * 3;
                const float o = sigmoidf_(gp[0]) * ocmp[h] + sigmoidf_(gp[1]) * osel[h] + sigmoidf_(gp[2]) * owin[h];
                MIX[(size_t)r * D + 512 + (kvh * 4 + h) * 64 + lane] = (bf16_t)(cvt_pk_bf16(o, 0.f) & 0xffffu); }
            __builtin_amdgcn_wave_barrier(); asm volatile("" ::: "memory");
        }
    }
}


constexpr int AT_KB = 0, AT_VB = 18432, AT_WUN = 36864, AT_OT = 40960;
__device__ __forceinline__ int crow_(int i) { return (i & 3) + 8 * (i >> 2); }
__device__ __forceinline__ float fmax_(float a, float b) { return __builtin_amdgcn_fmed3f(a, b, __builtin_inff()); }
template <int MODE>
__device__ __forceinline__ void attn_tile(const LAS unsigned char* KB, const LAS unsigned char* VB, const bf16x8 (&Qf)[4], f32x16 (&O)[2], float cref, float& l, int tl, int lo, bool rowok, int n, int h) {
    f32x16 S0, S1;
#pragma unroll
    for (int i = 0; i < 16; ++i) { S0[i] = 0.f; S1[i] = 0.f; }
#pragma unroll
    for (int s = 0; s < 4; ++s) { const bf16x8 k0 = *(const LAS bf16x8*)(KB + n * 144 + (16 * s + 8 * h) * 2), k1 = *(const LAS bf16x8*)(KB + (32 + n) * 144 + (16 * s + 8 * h) * 2);
        S0 = MFMA32(k0, Qf[s], S0); S1 = MFMA32(k1, Qf[s], S1); }
    if (MODE != 0) {
#pragma unroll
        for (int i = 0; i < 16; ++i) { const int c0 = crow_(i), c1 = 32 + crow_(i);
            if (MODE == 1) { S0[i] = rowok ? S0[i] : -1e30f; S1[i] = rowok ? S1[i] : -1e30f; }
            if (MODE == 2) { S0[i] = (c0 <= tl && c0 > lo) ? S0[i] : -1e30f; S1[i] = (c1 <= tl && c1 > lo) ? S1[i] : -1e30f; } } }
    f32x2 ls2 = {0.f, 0.f}; const f32x2 mr2 = {cref, cref};
#pragma unroll
    for (int i = 0; i < 8; ++i) { f32x2 a = (f32x2){S0[2 * i], S0[2 * i + 1]} - mr2, b = (f32x2){S1[2 * i], S1[2 * i + 1]} - mr2;
        a.x = __builtin_amdgcn_exp2f(a.x); a.y = __builtin_amdgcn_exp2f(a.y); b.x = __builtin_amdgcn_exp2f(b.x); b.y = __builtin_amdgcn_exp2f(b.y);
        S0[2 * i] = a.x; S0[2 * i + 1] = a.y; S1[2 * i] = b.x; S1[2 * i + 1] = b.y; ls2 += a + b; }
    l += ls2.x + ls2.y;
    const bf16x8 P00 = pack8<0>(S0), P01 = pack8<8>(S0), P10 = pack8<0>(S1), P11 = pack8<8>(S1);
    __builtin_amdgcn_sched_barrier(0);
#pragma unroll
    for (int d = 0; d < 2; ++d) { const LAS unsigned char* vb = VB + (32 * d + n) * 144 + 8 * h * 2;
        O[d] = MFMA32(*(const LAS bf16x8*)(vb + 0), P00, O[d]); O[d] = MFMA32(*(const LAS bf16x8*)(vb + 32), P01, O[d]);
        O[d] = MFMA32(*(const LAS bf16x8*)(vb + 64), P10, O[d]); O[d] = MFMA32(*(const LAS bf16x8*)(vb + 96), P11, O[d]); }
}
__device__ __forceinline__ void attn_stage64(LAS unsigned char* lds, const bf16_t* K, const bf16_t* VT, int tid) {
    const int row = tid >> 3, ch = tid & 7;
    const u32x4 kv = *((const u32x4*)K + tid), vv = *(const u32x4*)(VT + (size_t)row * SEQ + ch * 8);
    *(LAS u32x4*)(lds + AT_KB + row * 144 + ch * 16) = kv; *(LAS u32x4*)(lds + AT_VB + row * 144 + ch * 16) = vv;
}
__device__ __forceinline__ void phase_attn_mfma(Frame& F, int layer) {
    const int lane = F.lane, tid = F.tid, n = lane & 31, h = lane >> 5, w = F.wave;
    LAS unsigned char* lds = F.lds; const LAS unsigned char* KB = lds + AT_KB; const LAS unsigned char* VB = lds + AT_VB; volatile LAS unsigned* WUN = (volatile LAS unsigned*)(lds + AT_WUN);
    const bf16_t* QN = (const bf16_t*)(F.ws + WS_Q); const bf16_t* KVb = (const bf16_t*)(F.ws + WS_KV);
    const bf16_t* KC = (const bf16_t*)(F.ws + WS_KC); const bf16_t* VCT = (const bf16_t*)(F.ws + WS_VCT);
    const bf16_t* VST = (const bf16_t*)(F.ws + WS_VST); const bf16_t* VWT = (const bf16_t*)(F.ws + WS_VWT);
    const float* GT = (const float*)(F.ws + WS_GT); bf16_t* MIX = (bf16_t*)(F.ws + WS_MIX);
    float cref;
    { const float gq = fabsf(INP_(I_QG)[layer * 64 + lane]); const float* kg = INP_(I_KG) + layer * 192;
      const float gk = fmaxf(fabsf(kg[lane]), fmaxf(fabsf(kg[64 + lane]), fabsf(kg[128 + lane])));
      const float bound = 1.44269504089f * 8.0f * wave_max(gq) * wave_max(gk); cref = fmaxf(bound - 16.0f, 0.f); }
#pragma nounroll
    for (int ui = 0; ui < 2; ++ui) {
        const int bh = (F.c >> 5) + 8 * ui, tb = ui ? 31 - (F.c & 31) : (F.c & 31);
        if (F.c >= 256) break;
        const int b = bh >> 1, kvh = bh & 1, t0 = tb * 64, cur = tb;
        const int tt = t0 + 8 * w + (n >> 2), hd = n & 3; const size_t r = (size_t)b * SEQ + tt;
        bf16x8 Qf[4]; { const bf16_t* qp = QN + r * 512 + (kvh * 4 + hd) * 64 + 8 * h;
#pragma unroll
            for (int s = 0; s < 4; ++s) Qf[s] = *(const bf16x8*)(qp + 16 * s); }
        {
            float qv[4][8]; float ss = 0.f;
#pragma unroll
            for (int s = 0; s < 4; ++s) { const u32x4 wq = __builtin_bit_cast(u32x4, Qf[s]);
                qv[s][0] = bf_lo(wq.x); qv[s][1] = bf_hi(wq.x); qv[s][2] = bf_lo(wq.y); qv[s][3] = bf_hi(wq.y); qv[s][4] = bf_lo(wq.z); qv[s][5] = bf_hi(wq.z); qv[s][6] = bf_lo(wq.w); qv[s][7] = bf_hi(wq.w);
#pragma unroll
                for (int j = 0; j < 8; ++j) ss += qv[s][j] * qv[s][j]; }
            ss += __shfl_xor(ss, 32);
            const float rsq = rsqf_(ss * (1.0f / 64.0f) + EPS) * (0.125f * 1.44269504089f); const float* qg     = INP_(I_QG) + layer * 64 + 8 * h;
#pragma unroll
            for (int s = 0; s < 4; ++s) { const f32x4 ga = *(const f32x4*)(qg + 16 * s), gb = *(const f32x4*)(qg + 16 * s + 4);
                u32x4 wq; wq.x = pk_bf16(qv[s][0] * rsq * ga.x, qv[s][1] * rsq * ga.y); wq.y = pk_bf16(qv[s][2] * rsq * ga.z, qv[s][3] * rsq * ga.w);
                wq.z = pk_bf16(qv[s][4] * rsq * gb.x, qv[s][5] * rsq * gb.y); wq.w = pk_bf16(qv[s][6] * rsq * gb.z, qv[s][7] * rsq * gb.w); Qf[s] = __builtin_bit_cast(bf16x8, wq); } }
        const float* gp = GT + r * 24 + (kvh * 4 + hd) * 3; const float g0 = sigmoidf_(gp[0]), g1 = sigmoidf_(gp[1]), g2 = sigmoidf_(gp[2]);
        f32x16 Ob[2]; LAS f32x4* OT = (LAS f32x4*)(lds + AT_OT + w * 8192) + lane;
        unsigned tokmask, wmask;
        __syncthreads();
#pragma unroll
        for (int q = 0; q < 2; ++q) { const int i = tid + 512 * q;
            *(LAS u32x4*)(lds + AT_KB + (i >> 3) * 144 + (i & 7) * 16) = *((const u32x4*)(KC + (size_t)bh * 128 * 64) + i);
            *(LAS u32x4*)(lds + AT_VB + (i >> 4) * 272 + (i & 15) * 16) = *((const u32x4*)(VCT + (size_t)bh * 64 * 128) + i); }
        __syncthreads();
        {
            f32x16 S[4];
#pragma unroll
            for (int ta = 0; ta < 4; ++ta) {
#pragma unroll
                for (int i = 0; i < 16; ++i) S[ta][i] = 0.f;
#pragma unroll
                for (int s = 0; s < 4; ++s) S[ta] = MFMA32(*(const LAS bf16x8*)(KB + (32 * ta + n) * 144 + (16 * s + 8 * h) * 2), Qf[s], S[ta]); }
            const int cmax = tt >= 31 ? (((tt - 31) >> 4) > 126 ? 126 : ((tt - 31) >> 4)) : -1, lim = cmax - 4 * h;
            float ls = 0.f;
#pragma unroll
            for (int ta = 0; ta < 4; ++ta)
#pragma unroll
                for (int i = 0; i < 16; ++i) { const float p = (32 * ta + crow_(i) <= lim) ? __builtin_amdgcn_exp2f(S[ta][i] - cref) : 0.f; S[ta][i] = p; ls += p; }
            ls += __shfl_xor(ls, 32);
            const float inv = rcpf_(fmaxf(ls, 1e-30f));
#pragma unroll
            for (int ta = 0; ta < 4; ++ta)
#pragma unroll
                for (int i = 0; i < 16; ++i) S[ta][i] *= inv;
            float val[4][4]; unsigned kk[4];
#pragma unroll
            for (int ta = 0; ta < 4; ++ta)
#pragma unroll
                for (int u = 0; u < 4; ++u) { val[ta][u] = (S[ta][4 * u] + S[ta][4 * u + 1]) + (S[ta][4 * u + 2] + S[ta][4 * u + 3]); }
            {   float xs[4][4];
#pragma unroll
                for (int ta = 0; ta < 4; ++ta)
#pragma unroll
                    for (int u = 0; u < 4; ++u) xs[ta][u] = __shfl_xor(S[ta][4 * u + 3], 32);
#pragma unroll
                for (int ta = 0; ta < 4; ++ta)
#pragma unroll
                    for (int u = 0; u < 4; ++u) { const float pv0 = (u > 0) ? xs[ta][u > 0 ? u - 1 : 0] : (ta > 0 ? xs[ta > 0 ? ta - 1 : 0][3] : 0.f); val[ta][u] += (h ? xs[ta][u] : pv0); } }
            const bf16x8 P0 = pack8<0>(S[0]), P1 = pack8<8>(S[0]), P2 = pack8<0>(S[1]), P3 = pack8<8>(S[1]), P4 = pack8<0>(S[2]), P5 = pack8<8>(S[2]), P6 = pack8<0>(S[3]), P7 = pack8<8>(S[3]);
            __builtin_amdgcn_sched_barrier(0);
            const bool b0 = (n & 1) != 0, b1 = (n & 2) != 0; const int hd2 = 2 * (n & 3) + h;
#define DPPF(x, ctrl) __builtin_bit_cast(float, __builtin_amdgcn_update_dpp(0, __builtin_bit_cast(int, (x)), (ctrl), 0xF, 0xF, true))
#define DPPU(x, ctrl) ((unsigned)__builtin_amdgcn_update_dpp(0, (int)(x), (ctrl), 0xF, 0xF, true))
#pragma unroll
            for (int ta = 0; ta < 4; ++ta) {
                const float m0 = b0 ? val[ta][1] : val[ta][0], s0 = b0 ? val[ta][0] : val[ta][1], m1 = b0 ? val[ta][3] : val[ta][2], s1 = b0 ? val[ta][2] : val[ta][3];
                const float r0 = m0 + DPPF(s0, 0xB1), r1 = m1 + DPPF(s1, 0xB1);
                const float mm = b1 ? r1 : r0, ss = b1 ? r0 : r1; const float v = mm + DPPF(ss, 0x4E);
                const int G = 8 * ta + hd2; const bool causal = G <= cur, forced = (G == 0) || (G == cur) || (G == cur - 1);
                kk[ta] = causal ? ((forced ? 0x7f000000u : (__float_as_uint(v) & ~31u)) | (unsigned)(31 - G)) : 0u; }
            __builtin_amdgcn_sched_barrier(0);
#pragma unroll
            for (int d = 0; d < 2; ++d) {
#pragma unroll
                for (int i = 0; i < 16; ++i) Ob[d][i] = 0.f;
                const LAS unsigned char* vb = VB + (32 * d + n) * 272 + 8 * h * 2;
                Ob[d] = MFMA32(*(const LAS bf16x8*)(vb + 0), P0, Ob[d]); Ob[d] = MFMA32(*(const LAS bf16x8*)(vb + 32), P1, Ob[d]);
                Ob[d] = MFMA32(*(const LAS bf16x8*)(vb + 64), P2, Ob[d]); Ob[d] = MFMA32(*(const LAS bf16x8*)(vb + 96), P3, Ob[d]);
                Ob[d] = MFMA32(*(const LAS bf16x8*)(vb + 128), P4, Ob[d]); Ob[d] = MFMA32(*(const LAS bf16x8*)(vb + 160), P5, Ob[d]);
                Ob[d] = MFMA32(*(const LAS bf16x8*)(vb + 192), P6, Ob[d]); Ob[d] = MFMA32(*(const LAS bf16x8*)(vb + 224), P7, Ob[d]);
#pragma unroll
                for (int q = 0; q < 4; ++q) OT[(4 * d + q) * 64] = (f32x4){Ob[d][4 * q] * g0, Ob[d][4 * q + 1] * g0, Ob[d][4 * q + 2] * g0, Ob[d][4 * q + 3] * g0}; }
            __builtin_amdgcn_sched_barrier(0);
            unsigned selbits = 0u;
#pragma unroll
            for (int rd = 0; rd < 8; ++rd) { unsigned mk = kk[0] > kk[1] ? kk[0] : kk[1]; { const unsigned m2 = kk[2] > kk[3] ? kk[2] : kk[3]; mk = m2 > mk ? m2 : mk; }
                { const unsigned o = DPPU(mk, 0xB1); mk = o > mk ? o : mk; } { const unsigned o = DPPU(mk, 0x4E); mk = o > mk ? o : mk; }
                { const unsigned o = (unsigned)__shfl_xor((int)mk, 32); mk = o > mk ? o : mk; }
#pragma unroll
                for (int ta = 0; ta < 4; ++ta) { const bool hit = (kk[ta] == mk) && (mk != 0u); selbits |= hit ? ((1u << (8 * ta)) << hd2) : 0u; kk[ta] = hit ? 0u : kk[ta]; } }
            selbits |= DPPU(selbits, 0xB1); selbits |= DPPU(selbits, 0x4E);
            tokmask = selbits | (unsigned)__shfl_xor((int)selbits, 32);
#undef DPPF
#undef DPPU
            unsigned wm = tokmask; wm |= (unsigned)__shfl_xor((int)wm, 4); wm |= (unsigned)__shfl_xor((int)wm, 8); wm |= (unsigned)__shfl_xor((int)wm, 16);
            wmask = (unsigned)__builtin_amdgcn_readfirstlane((int)wm);
            if (lane == 0) WUN[w] = wmask;
        }
        __syncthreads();
        unsigned uall = 0u;
#pragma unroll
        for (int q = 0; q < 8; ++q) uall |= WUN[q];
        uall = (unsigned)__builtin_amdgcn_readfirstlane((int)uall);
        if (PROBE_MASK & 0x6000000u) { if (lane == 0) ((unsigned*)(F.ws + WS_SLOT + 3 * MAXSLOT * 4))[(blockIdx.x * 2 + ui) * 8 + w] = (unsigned)__builtin_popcount(uall) | ((unsigned)__builtin_popcount(wmask) << 8); }
        float l = 0.f;
#pragma unroll
        for (int d = 0; d < 2; ++d)
#pragma unroll
            for (int i = 0; i < 16; ++i) Ob[d][i] = 0.f;
        const int j0 = cur > 8 ? cur - 8 : 0, nwin = cur - j0 + 1, ntile = nwin + __builtin_popcount(uall);
        const int srow = tid >> 3, sch = tid & 7;
        int lidx = 0, cidx = 0; unsigned lmm = uall, cmm = uall; u32x4 rk0, rv0, rk1, rv1, rk2, rv2;
#define AT_NEXT(idx, mm, wh, jj) do { if ((idx) < nwin) { (wh) = 1; (jj) = j0 + (idx); } else { (wh) = 0; (jj) = (mm) ? __builtin_ctz(mm) : 0; (mm) &= (mm) - 1u; } ++(idx); } while (0)
#define AT_LOAD(rk, rv) do { int _wh, _jj; AT_NEXT(lidx, lmm, _wh, _jj); const bf16_t* _kp = KVb + (size_t)(_wh ? 4 : 2) * KVT + ((size_t)bh * SEQ + _jj * 64) * 64; const bf16_t* _vp = (_wh ? VWT : VST) + (size_t)bh * 64 * SEQ + _jj * 64; \
        rk = *((const u32x4*)_kp + tid); rv = *(const u32x4*)(_vp + (size_t)srow * SEQ + sch * 8); } while (0)
#define AT_WRITE(b, rk, rv) do { *(LAS u32x4*)(lds + (b) * 18432 + srow * 144 + sch * 16) = rk; *(LAS u32x4*)(lds + (b) * 18432 + 9216 + srow * 144 + sch * 16) = rv; } while (0)
        AT_LOAD(rk0, rv0); AT_LOAD(rk1, rv1); AT_LOAD(rk2, rv2);
        AT_WRITE(0, rk0, rv0);
        AT_LOAD(rk0, rv0);
#define AT_STEP(i, RK, RV) do { asm volatile("s_waitcnt lgkmcnt(0)" ::: "memory"); __builtin_amdgcn_s_barrier(); asm volatile("" ::: "memory"); \
            AT_WRITE(((i) + 1) & 1, RK, RV); AT_LOAD(RK, RV); \
            int wh, j; AT_NEXT(cidx, cmm, wh, j); \
            if (i == nwin) { \
                const float lt = l + __shfl_xor(l, 32), sc = g2 * rcpf_(fmaxf(lt, 1e-30f)); \
_Pragma("unroll") \
                for (int d = 0; d < 2; ++d) \
_Pragma("unroll") \
                    for (int q = 0; q < 4; ++q) { f32x4 o = OT[(4 * d + q) * 64]; o.x += Ob[d][4 * q] * sc; o.y += Ob[d][4 * q + 1] * sc; o.z += Ob[d][4 * q + 2] * sc; o.w += Ob[d][4 * q + 3] * sc; OT[(4 * d + q) * 64] = o; \
                        Ob[d][4 * q] = 0.f; Ob[d][4 * q + 1] = 0.f; Ob[d][4 * q + 2] = 0.f; Ob[d][4 * q + 3] = 0.f; } \
                l = 0.f; } \
            const LAS unsigned char* kb = lds + (i & 1) * 18432; const LAS unsigned char* vb = kb + 9216; \
            const int tl = tt - 64 * j - 4 * h; \
            if (wh) { if (j == cur || j == cur - 8) attn_tile<2>(kb, vb, Qf, Ob, cref, l, tl, j == cur - 8 ? tl - 512 : -100000, true, n, h); else attn_tile<0>(kb, vb, Qf, Ob, cref, l, 0, 0, true, n, h); } \
            else if ((wmask >> j) & 1u) { const bool rowok = ((tokmask >> j) & 1u) != 0u; \
                if (j == cur) attn_tile<2>(kb, vb, Qf, Ob, cref, l, rowok ? tl : -1, -100000, true, n, h); else attn_tile<1>(kb, vb, Qf, Ob, cref, l, 0, 0, rowok, n, h); } \
        } while (0)
#pragma nounroll
        for (int i = 0; i < ntile; i += 3) { AT_STEP(i, rk1, rv1); if (i + 1 >= ntile) break; AT_STEP(i + 1, rk2, rv2); if (i + 2 >= ntile) break; AT_STEP(i + 2, rk0, rv0); }
#undef AT_STEP
#undef AT_NEXT
#undef AT_LOAD
#undef AT_WRITE
        { const float lt = l + __shfl_xor(l, 32), sc = g1 * rcpf_(fmaxf(lt, 1e-30f));
          bf16_t* op = MIX + r * D + 512 + (kvh * 4 + hd) * 64 + 4 * h;
#pragma unroll
          for (int d = 0; d < 2; ++d)
#pragma unroll
            for (int u = 0; u < 4; ++u) { const f32x4 o = OT[(4 * d + u) * 64]; u32x2 ov; ov.x = pk_bf16(o.x + Ob[d][4 * u] * sc, o.y + Ob[d][4 * u + 1] * sc); ov.y = pk_bf16(o.z + Ob[d][4 * u + 2] * sc, o.w + Ob[d][4 * u + 3] * sc);
                *(u32x2*)(op + 32 * d + 8 * u) = ov; } }
    }
}

__device__ __forceinline__ int build_ptab(Frame& F) {
    LAS int* ptab = (LAS int*)(F.lds + PTAB_OFF);
    const unsigned* cnt = (const unsigned*)(F.ws + WS_CTL) + CW_CNT;
    if (F.tid < 64) {
        const int e = F.tid; const unsigned c = (e < NE) ? __hip_atomic_load(cnt + 64 * e, __ATOMIC_RELAXED, __HIP_MEMORY_SCOPE_AGENT) : 0u;
        const int n = (int)((c + 255u) >> 8); int incl = n;
#pragma unroll
        for (int o = 1; o < 8; o <<= 1) { const int t = __shfl_up(incl, o); if (e >= o) incl += t; }
        const int excl = incl - n;
        if (e < NE) { ptab[MAXPAN + 8 + e] = excl * 256; for (int i = 0; i < n && excl + i < MAXPAN; ++i) ptab[excl + i] = e; }
        if (e == NE - 1) ptab[MAXPAN] = incl < MAXPAN ? incl : MAXPAN; }
    __syncthreads();
    return ptab[MAXPAN];
}

template <unsigned KM> __global__ void __launch_bounds__(NTHR, 2) fwd(Args args) {
    extern __shared__ __attribute__((aligned(16))) unsigned char lds_raw[];
    Frame F; F.lds = (LAS unsigned char*)lds_raw; F.tid = threadIdx.x; F.lane = F.tid & 63; F.wave = __builtin_amdgcn_readfirstlane(F.tid >> 6);
    F.G = gridDim.x; F.c = blockIdx.x; F.in = args.in; F.out = args.out; F.ws = args.ws;
    volatile LAS unsigned* MISC = (volatile LAS unsigned*)(F.lds + MISC_OFF);
    if (F.tid < 64) MISC[F.tid] = 0u;
    __syncthreads();
    unsigned* ctl = (unsigned*)(F.ws + WS_CTL);
#if MK_PER_PHASE
#define SEAM() do {} while (0)
#else
    XcdBarrier bar = xcd_barrier_post(ctl + CW_BAR, MISC);
#define SEAM() xcd_barrier(bar)
#endif
    const int lo = args.ph_lo, hi = args.ph_hi;
#define KON(kind) (((KM) >> (kind)) & 1u)
#define IN(k) (lo <= (k) && (k) < hi)
#define gw (F.c * NWAVES + F.wave)
#define NGW (F.G * NWAVES)
#define XB ((bf16_t*)(F.ws + WS_XB))
#define RS ((float*)(F.ws + WS_RSTD))

    if (KON(0) && IN(0)) { FRESH_TID(F); PMARK(0); phase_prologue(F); SEAM(); }

    for (int layer = 0; layer < 2; ++layer) {
        const int pb = 1 + 12 * layer;
        if (KON(1) && IN(pb + 0)) { FRESH_TID(F); PMARK(pb + 0);
            pg8::Gemm g{XB, (const bf16_t*)(F.ws + WS_WIN) + (size_t)layer * INP * D, D, D, D}; pg8::SchedGrid S; S.init(M / 256, INP / 256, F.G, F.c, D, D);
            EpiIn E{RS, (bf16_t*)(F.ws + WS_U), (bf16_t*)(F.ws + WS_Q), (bf16_t*)(F.ws + WS_KV), (float*)(F.ws + WS_GT), layer ? (const float*)(F.ws + WS_PSS) : nullptr, (LAS float*)(F.lds + RSL_OFF)};
            pg8::gemm_phase(F.lds, g, S, E); moe_conv_slot(F, layer == 0 ? 0 : 2); SEAM();
        }
        if (KON(2) && IN(pb + 1)) { FRESH_TID(F); PMARK(pb + 1);
            { pg8::Gemm g{(const bf16_t*)(F.ws + WS_KV), (const bf16_t*)(F.ws + WS_WC1), 256, 1024, 2048}; SchedCmp S{F.G, F.c, layer};
              EpiH1 E{(float*)(F.ws + WS_H1)}; pg8::gemm_phase(F.lds, g, S, E); }
            if (F.G >= 256) { if (F.c >= 128) vtrans_items(F, (F.c - 128) * NWAVES + F.wave, (F.G - 128) * NWAVES); }
            else vtrans_items(F, gw, NGW);
#ifdef ATTN_REF
            norm_rows64((bf16_t*)(F.ws + WS_Q), M * 8, INP_(I_QG) + layer * 64, 0.125f, gw, NGW, F.lane);
#endif
            norm_rows64((bf16_t*)(F.ws + WS_KV) + 2 * KVT, NBH * SEQ, INP_(I_KG) + layer * 192 + 64, 1.0f, gw, NGW, F.lane);
            norm_rows64((bf16_t*)(F.ws + WS_KV) + 4 * KVT, NBH * SEQ, INP_(I_KG) + layer * 192 + 128, 1.0f, gw, NGW, F.lane);
            SEAM();
        }
        if (KON(3) && IN(pb + 2)) { FRESH_TID(F); PMARK(pb + 2); for (int cu = F.c; cu < 512; cu += F.G) conv_unit(F, layer, cu); PMARK(30); phase_cmp2(F, layer); SEAM(); }
#ifndef ATTN_REF
        if (KON(4) && IN(pb + 3)) { FRESH_TID(F); PMARK(pb + 3); phase_attn_mfma(F, layer); SEAM(); }
#else
        if (KON(4) && IN(pb + 3)) { FRESH_TID(F); PMARK(pb + 3); phase_attn_ref(F, layer); SEAM(); }
#endif
        if (KON(5) && IN(pb + 4)) { FRESH_TID(F); PMARK(pb + 4);
            pg8::Gemm g{(const bf16_t*)(F.ws + WS_MIX), (const bf16_t*)(F.ws + WS_WOUT) + (size_t)layer * D * D, D, D, D}; pg8::SchedGrid S; S.init(M / 256, D / 256, F.G, F.c, D, D);
            { EpiRes<true> E{XB, XB, layer == 0 ? (float*)(F.ws + WS_PSS) : nullptr}; pg8::gemm_phase(F.lds, g, S, E); }
            SEAM();
        }
        if (KON(6) && IN(pb + 5) && layer == 1) { FRESH_TID(F); PMARK(pb + 5);
            f32x4 v[4];
            {
                const float* RT = (const float*)(F.ws + WS_RT); unsigned* cnt = ctl + CW_CNT; int* ROUTE = (int*)(F.ws + WS_ROUTE);
                int* stok = (int*)(F.ws + WS_SLOT);
                const int cb0 = __builtin_amdgcn_readfirstlane((int)blockIdx.x * NTHR);
#pragma nounroll
                for (int i = cb0 + F.tid; i < MAXSLOT; i += F.G * NTHR) stok[i] = -1;
                LAS f32x4* RTL = (LAS f32x4*)F.lds;
                { f32x4 sv[4];
#pragma unroll
                  for (int q = 0; q < 4; ++q) sv[q] = *((const f32x4*)RT + F.tid + q * NTHR);
#pragma unroll
                  for (int q = 0; q < 4; ++q) RTL[F.tid + q * NTHR] = sv[q]; }
                __syncthreads();
#pragma nounroll
                for (int mb0 = 0; mb0 < M; mb0 += 8 * NGW) { const int mb = mb0 + gw;
                    int me0 = -1, me1 = -1; float mw0 = 0.f, mw1 = 0.f;
#pragma nounroll
                    for (int i4 = 0; i4 < 8; i4 += 4) {
                        f32x4 xv[4][4];
#pragma unroll
                        for (int q = 0; q < 4; ++q) { const int m = mb + (i4 + q) * NGW; const u32x2* xr = (const u32x2*)(XB + (size_t)(m < M ? m : 0) * D) + F.lane;
#pragma unroll
                            for (int j = 0; j < 4; ++j) { const u32x2 wv = xr[64 * j]; xv[q][j] = (f32x4){bf_lo(wv.x), bf_hi(wv.x), bf_lo(wv.y), bf_hi(wv.y)}; } }
#pragma unroll
                        for (int q = 0; q < 4; ++q) { const int i = i4 + q, m = mb + i * NGW; if (m >= M) break;
                            float ss = 0.f;
#pragma unroll
                            for (int j = 0; j < 4; ++j) ss += (xv[q][j].x * xv[q][j].x + xv[q][j].y * xv[q][j].y) + (xv[q][j].z * xv[q][j].z + xv[q][j].w * xv[q][j].w);
                            const float rs = rsqf_(wave_sum_u(ss) * (1.0f / D) + EPS);
                            if (F.lane == 0) RS[m] = rs;
                            float lg[8];
#pragma unroll
                            for (int e = 0; e < 8; ++e) { float sd = 0.f;
#pragma unroll
                                for (int j = 0; j < 4; ++j) { const f32x4 wv = RTL[e * 256 + 64 * j + F.lane]; sd += (xv[q][j].x * wv.x + xv[q][j].y * wv.y) + (xv[q][j].z * wv.z + xv[q][j].w * wv.w); }
                                lg[e] = wave_sum_u(sd); }
                            int e0 = 0; float l0 = lg[0];
#pragma unroll
                            for (int e = 1; e < 8; ++e) if (lg[e] > l0) { l0 = lg[e]; e0 = e; }
                            int e1 = -1; float l1 = -3.0e38f;
#pragma unroll
                            for (int e = 0; e < 8; ++e) if (e != e0 && lg[e] > l1) { l1 = lg[e]; e1 = e; }
                            const float p1 = __expf((l1 - l0) * rs), w0 = rcpf_(1.0f + p1), w1 = p1 * w0;
                            if (F.lane == i) { me0 = e0; me1 = e1; mw0 = w0; mw1 = w1; } } }
                    int r0 = 0, r1 = 0, c_mine = 0; const unsigned long long low = (1ull << F.lane) - 1ull;
#pragma unroll
                    for (int e = 0; e < 8; ++e) { const unsigned long long b0 = __ballot(me0 == e), b1 = __ballot(me1 == e);
                        if (me0 == e) r0 = __popcll(b0 & low) + __popcll(b1 & low); if (me1 == e) r1 = __popcll(b0 & low) + __popcll(b1 & low);
                        if (F.lane == e) c_mine = __popcll(b0) + __popcll(b1); }
                    LAS int* WC = (LAS int*)(F.lds + 32768);
                    if (F.lane < 8) WC[F.wave * 8 + F.lane] = c_mine;
                    __syncthreads();
                    if (F.wave == 0 && F.lane < 8) { int tot = 0;
#pragma unroll
                        for (int ww = 0; ww < 8; ++ww) tot += WC[ww * 8 + F.lane];
                        WC[64 + F.lane] = tot > 0 ? (int)atomicAdd(cnt + 64 * F.lane, (unsigned)tot) : 0; }
                    __syncthreads();
                    int basev = 0;
                    if (F.lane < 8) { basev = WC[64 + F.lane];
#pragma unroll
                        for (int ww = 0; ww < 8; ++ww) basev += (ww < F.wave) ? WC[ww * 8 + F.lane] : 0; }
                    __syncthreads();
                    const int b0v = __shfl(basev, me0 < 0 ? 0 : me0), b1v = __shfl(basev, me1 < 0 ? 0 : me1);
                    if (me0 >= 0) { const int m = mb + F.lane * NGW; int* rp = ROUTE + (size_t)m * 6; rp[0] = me0; rp[1] = b0v + r0; rp[2] = me1; rp[3] = b1v + r1; rp[4] = __float_as_int(mw0); rp[5] = __float_as_int(mw1); }
                }
            }
            SEAM();
        }
        if (layer == 0) {
            if (KON(7) && IN(pb + 6)) { FRESH_TID(F); PMARK(pb + 6);
                pg8::Gemm g{XB, (const bf16_t*)(F.ws + WS_WF1), D, D, D}; pg8::SchedGrid S; S.init(M / 256, 2 * DFF / 256, F.G, F.c, D, D);
                EpiGlu E{RS, (bf16_t*)(F.ws + WS_ACT), DFF, 0, (const float*)(F.ws + WS_PSS), (LAS float*)(F.lds + RSL_OFF)}; pg8::gemm_phase(F.lds, g, S, E); moe_conv_slot(F, 1); SEAM();
            }
            if (KON(8) && IN(pb + 7)) { FRESH_TID(F); PMARK(pb + 7);
                pg8::Gemm g{(const bf16_t*)(F.ws + WS_ACT), (const bf16_t*)(F.ws + WS_WF2), DFF, DFF, DFF}; pg8::SchedGrid S; S.init(M / 256, D / 256, F.G, F.c, DFF, DFF);
                EpiRes<true> E{XB, XB, (float*)(F.ws + WS_PSS)}; pg8::gemm_phase(F.lds, g, S, E); SEAM();
            }
        } else {
            if (KON(10) && IN(pb + 6)) { FRESH_TID(F); PMARK(pb + 6);
                build_ptab(F); const LAS int* ptab = (const LAS int*)(F.lds + PTAB_OFF);
                const int* ROUTE = (const int*)(F.ws + WS_ROUTE); int* stok = (int*)(F.ws + WS_SLOT); float* sw = (float*)(stok + MAXSLOT); float* srs = sw + MAXSLOT; unsigned char* XS8 = F.ws + WS_XS;
#pragma nounroll
                for (int mb = gw; mb < M; mb += 4 * NGW) {
                    int rt[4][6]; u32x4 ra[4], rb[4];
#pragma unroll
                    for (int q = 0; q < 4; ++q) { const int m = mb + q * NGW < M ? mb + q * NGW : 0; const int* rp = ROUTE + (size_t)m * 6;
#pragma unroll
                        for (int z = 0; z < 6; ++z) rt[q][z] = rp[z];
                        const u32x4* src = (const u32x4*)(XB + (size_t)m * D) + F.lane; ra[q] = src[0]; rb[q] = src[64]; }
#pragma unroll
                    for (int q = 0; q < 4; ++q) { const int m = mb + q * NGW; if (m >= M) break;
#pragma unroll
                        for (int k = 0; k < 2; ++k) { const int e = rt[q][2 * k], pos = rt[q][2 * k + 1], slot = ptab[MAXPAN + 8 + e] + pos; unsigned char* drow = XS8 + (size_t)slot * D + 8 * F.lane;
                            *(u32x2*)drow = pk8_fp8(bf_lo(ra[q].x), bf_hi(ra[q].x), bf_lo(ra[q].y), bf_hi(ra[q].y), bf_lo(ra[q].z), bf_hi(ra[q].z), bf_lo(ra[q].w), bf_hi(ra[q].w));
                            *(u32x2*)(drow + 512) = pk8_fp8(bf_lo(rb[q].x), bf_hi(rb[q].x), bf_lo(rb[q].y), bf_hi(rb[q].y), bf_lo(rb[q].z), bf_hi(rb[q].z), bf_lo(rb[q].w), bf_hi(rb[q].w));
                            if (F.lane == 0) { stok[slot] = m * 2 + k; sw[slot] = __int_as_float(rt[q][4 + k]); srs[slot] = RS[m]; } } } }
                SEAM();
            }
            if (KON(11) && IN(pb + 7)) { FRESH_TID(F); PMARK(pb + 7);
                const int npan = build_ptab(F);
                const int* stok = (const int*)(F.ws + WS_SLOT); const float* srs = (const float*)(stok + 2 * MAXSLOT);
                pg8::Gemm8 g{F.ws + WS_XS, F.ws + WS_WM1, D, D, D}; SchedMoe1F S{F.G, F.c, npan, (const LAS int*)(F.lds + PTAB_OFF)};
                EpiGlu8 E{srs, F.ws + WS_ACTM, DFE, 1.0f / MOE_S1};
                pg8::gemm_phase8(F.lds, g, S, E); SEAM();
            }
            if (KON(12) && IN(pb + 8)) { FRESH_TID(F); PMARK(pb + 8);
                const int npan = build_ptab(F);
                const int* stok = (const int*)(F.ws + WS_SLOT); const float* sw = (const float*)(stok + MAXSLOT);
                pg8::Gemm8 g{F.ws + WS_ACTM, F.ws + WS_WM2, DFE, DFE, DFE}; SchedMoe2F S{F.G, F.c, npan, (const LAS int*)(F.lds + PTAB_OFF)};
                EpiMoe2 E{stok, sw, (bf16_t*)(F.ws + WS_Y0), (bf16_t*)(F.ws + WS_Y1), 0, 1.0f / MOE_S2}; pg8::gemm_phase8(F.lds, g, S, E); SEAM();
            }
            if (KON(13) && IN(pb + 11)) { FRESH_TID(F); PMARK(pb + 11);
                const bf16_t* Y0 = (const bf16_t*)(F.ws + WS_Y0); const bf16_t* Y1 = (const bf16_t*)(F.ws + WS_Y1);
#pragma nounroll
                for (int mb = gw; mb < M; mb += 2 * NGW) { f32x4 x[2][4]; u32x2 ya[2][4], yb[2][4];
#pragma unroll
                    for (int q = 0; q < 2; ++q) { const int m = mb + q * NGW < M ? mb + q * NGW : 0; const u32x2* xr = (const u32x2*)(XB + (size_t)m * D) + F.lane; const u32x2* y0 = (const u32x2*)(Y0 + (size_t)m * D) + F.lane; const u32x2* y1 = (const u32x2*)(Y1 + (size_t)m * D) + F.lane;
#pragma unroll
                        for (int j = 0; j < 4; ++j) { const u32x2 wv = xr[64 * j]; x[q][j] = (f32x4){bf_lo(wv.x), bf_hi(wv.x), bf_lo(wv.y), bf_hi(wv.y)}; ya[q][j] = y0[64 * j]; yb[q][j] = y1[64 * j]; } }
#pragma unroll
                    for (int q = 0; q < 2; ++q) { const int m = mb + q * NGW; if (m >= M) break; f32x4* xr = (f32x4*)(F.out + (size_t)m * D) + F.lane;
#pragma unroll
                        for (int j = 0; j < 4; ++j) { f32x4 o = x[q][j]; const u32x2 a = ya[q][j], b2 = yb[q][j];
                            o.x += bf_lo(a.x) + bf_lo(b2.x); o.y += bf_hi(a.x) + bf_hi(b2.x); o.z += bf_lo(a.y) + bf_lo(b2.y); o.w += bf_hi(a.y) + bf_hi(b2.y); xr[64 * j] = o; } } }
            }
        }
    }
#undef gw
#undef NGW
#undef XB
#undef RS
    PMARK(99);
    if ((PROBE_MASK & 0x6000000u) && blockIdx.x == 0 && threadIdx.x == 0) { const unsigned* st = (const unsigned*)(F.ws + WS_SLOT + 3 * MAXSLOT * 4); unsigned long long tot = 0; for (int i = 0; i < 512 * 8; ++i) { const unsigned v = st[i]; tot += (PROBE_MASK & 0x2000000u) ? (v & 255u) : (v >> 8); }
        *(volatile LAS unsigned long long*)(F.lds + MISC_OFF + 160) += tot * 25ull / 4096ull * 10ull; }
    if (PROBE_MASK != 0u && blockIdx.x == 0 && threadIdx.x == 0) { const unsigned long long acc = *(volatile LAS unsigned long long*)(F.lds + MISC_OFF + 160), t1 = __builtin_amdgcn_s_memrealtime() + 4ull * acc; while (__builtin_amdgcn_s_memrealtime() < t1) __builtin_amdgcn_s_sleep(8); }
#undef IN
}

constexpr int NPHASE = 25;
template <unsigned KM> static bool setup_kernel(int& per_cu) {
    if (hipFuncSetAttribute((const void*)fwd<KM>, hipFuncAttributeMaxDynamicSharedMemorySize, LDS_BYTES) != hipSuccess) return false;
    if (hipOccupancyMaxActiveBlocksPerMultiprocessor(&per_cu, (const void*)fwd<KM>, NTHR, LDS_BYTES) != hipSuccess) per_cu = 0;
    (void)hipGetLastError(); return true;
}
template <unsigned KM> static void launch_kind(int grid, const Args& a, hipStream_t stream) { hipLaunchKernelGGL(fwd<KM>, dim3(grid), dim3(NTHR), LDS_BYTES, stream, a); }
extern "C" void kernel_launch(void* const* d_in, const int* in_sizes, int n_in, void* d_out, int out_size, void* d_ws, size_t ws_size, hipStream_t stream) {
    static int grid = 0;
    if (grid == 0) {
        if (n_in != 28 || in_sizes[0] != M * D || out_size != M * D || ws_size < WS_END) { fprintf(stderr, "kernel_launch: unexpected shapes / workspace (n_in %d, ws %zu, need %zu)\n", n_in, ws_size, (size_t)WS_END); grid = -1; return; }
        int dev = 0, cus = 0, per_cu = 0; bool ok = true;
        if (hipGetDevice(&dev) != hipSuccess || hipDeviceGetAttribute(&cus, hipDeviceAttributeMultiprocessorCount, dev) != hipSuccess) { grid = -1; return; }
#if MK_PER_PHASE
        ok = ok && setup_kernel<1u << 0>(per_cu) && setup_kernel<1u << 1>(per_cu) && setup_kernel<1u << 2>(per_cu) && setup_kernel<1u << 3>(per_cu) && setup_kernel<1u << 4>(per_cu) && setup_kernel<1u << 5>(per_cu) && setup_kernel<1u << 6>(per_cu)
             && setup_kernel<1u << 7>(per_cu) && setup_kernel<1u << 8>(per_cu) && setup_kernel<1u << 9>(per_cu) && setup_kernel<1u << 10>(per_cu) && setup_kernel<1u << 11>(per_cu) && setup_kernel<1u << 12>(per_cu) && setup_kernel<1u << 13>(per_cu);
#else
        ok = ok && setup_kernel<0xffffffffu>(per_cu);
#endif
        if (!ok) { fprintf(stderr, "kernel_launch: hipFuncSetAttribute failed\n"); grid = -1; return; }
        if (per_cu < 1) fprintf(stderr, "kernel_launch: occupancy query says %d\n", per_cu);
        grid = cus;
    }
    if (grid < 0) return;
    (void)hipMemsetAsync((char*)d_ws + WS_CTL, 0, CTL_BYTES, stream);
    Args a{};
    for (int i = 0; i < 28; ++i) a.in[i] = (const float*)d_in[i];
    a.out = (float*)d_out; a.ws = (unsigned char*)d_ws;
#if MK_PER_PHASE
    static const int phases[] = {0, 1, 2, 3, 4, 5, 7, 8, 13, 14, 15, 16, 17, 18, 19, 20, 21, 24};
    static const int kinds[]  = {0, 1, 2, 3, 4, 5, 7, 8,  1,  2,  3,  4,  5,  6, 10, 11, 12, 13};
    for (int i = 0; i < (int)(sizeof(phases) / sizeof(int)); ++i) { a.ph_lo = phases[i]; a.ph_hi = phases[i] + 1;
        switch (kinds[i]) {
            case 0: launch_kind<1u << 0>(grid, a, stream); break; case 1: launch_kind<1u << 1>(grid, a, stream); break; case 2: launch_kind<1u << 2>(grid, a, stream); break;
            case 3: launch_kind<1u << 3>(grid, a, stream); break; case 4: launch_kind<1u << 4>(grid, a, stream); break; case 5: launch_kind<1u << 5>(grid, a, stream); break;
            case 6: launch_kind<1u << 6>(grid, a, stream); break; case 7: launch_kind<1u << 7>(grid, a, stream); break; case 8: launch_kind<1u << 8>(grid, a, stream); break;
            case 9: launch_kind<1u << 9>(grid, a, stream); break; case 10: launch_kind<1u << 10>(grid, a, stream); break; case 11: launch_kind<1u << 11>(grid, a, stream); break;
            case 12: launch_kind<1u << 12>(grid, a, stream); break; default: launch_kind<1u << 13>(grid, a, stream); break; } }
#else
    a.ph_lo = 0; a.ph_hi = NPHASE; launch_kind<0xffffffffu>(grid, a, stream);
#endif
}
```

```cpp
#include <hip/hip_runtime.h>
#include <cstdio>
#include <cstdint>

#ifndef MK_PER_PHASE
#define MK_PER_PHASE 0
#endif

#ifndef PROBE_MASK
#define PROBE_MASK 0u
#endif
#define LAS __attribute__((address_space(3)))
typedef unsigned short bf16_t;
typedef short bf16x8 __attribute__((ext_vector_type(8)));
typedef float f32x4 __attribute__((ext_vector_type(4)));
typedef float f32x2 __attribute__((ext_vector_type(2)));
typedef unsigned u32x4 __attribute__((ext_vector_type(4)));
typedef unsigned u32x2 __attribute__((ext_vector_type(2)));

constexpr int D = 1024, NB = 8, SEQ = 2048, M = NB * SEQ;
constexpr int INW = 2328, INP = 2560;
constexpr int CW = 512, CKW = 31, DH = 64, NKV = 2, NBH = NB * NKV;
constexpr int NCMP = 127, CHID = 256;
constexpr int DFF = 2816, NE = 8, DFE = 3584;
constexpr int MAXPAN = 136, MAXSLOT = MAXPAN * 256, CHUNKP = 72;
constexpr float EPS = 1e-6f;

constexpr size_t MiB = 1u << 20;
constexpr size_t WS_CTL = 0, CTL_BYTES = 2 * MiB;
constexpr size_t WS_H1 = 342 * MiB;
constexpr size_t WS_WIN = 12 * MiB;
constexpr size_t WS_WC1 = 22 * MiB;
constexpr size_t WS_WOUT = 26 * MiB;
constexpr size_t WS_WF1 = 30 * MiB;
constexpr size_t WS_WF2 = 41 * MiB;
constexpr size_t WS_RT = 47 * MiB;
constexpr size_t WS_WM1 = 48 * MiB;
constexpr size_t WS_WM2 = 160 * MiB;
constexpr size_t WS_XB = 216 * MiB;
constexpr size_t WS_RSTD = 248 * MiB;
constexpr size_t WS_GT = WS_RSTD + 65536;
constexpr size_t WS_ROUTE = WS_GT + (size_t)M * 24 * 4;
constexpr size_t WS_PSS = 250 * MiB;
constexpr size_t WS_KC = 251 * MiB;
constexpr size_t WS_VC = WS_KC + 262144;
constexpr size_t WS_VCT = WS_KC + 524288;
constexpr size_t WS_VST = 2 * MiB, WS_VWT = 6 * MiB;
constexpr size_t WS_U = 252 * MiB;
constexpr size_t WS_Q = 268 * MiB;
constexpr size_t WS_KV = 284 * MiB;
constexpr size_t KVT = (size_t)NBH * SEQ * DH;
constexpr size_t WS_MIX = 310 * MiB;
constexpr size_t WS_ACT = 342 * MiB;
constexpr size_t WS_XS = 252 * MiB;
constexpr size_t WS_ACTM = 320 * MiB;
constexpr size_t WS_SLOT = 447 * MiB;
constexpr size_t WS_Y0 = WS_XS, WS_Y1 = 12 * MiB;
constexpr size_t WS_END = 448 * MiB;
constexpr int CW_BAR = 4096;
constexpr int CW_CNT = 8192;
constexpr int CW_B1P = 16384;

__device__ __forceinline__ unsigned cvt_pk_bf16(float lo, float hi) { unsigned r; asm volatile("v_cvt_pk_bf16_f32 %0, %1, %2" : "=v"(r) : "v"(lo), "v"(hi)); return r; }
__device__ __forceinline__ float bf_lo(unsigned v) { return __uint_as_float(v << 16); }
__device__ __forceinline__ float bf_hi(unsigned v) { return __uint_as_float(v & 0xffff0000u); }
__device__ __forceinline__ float bf2f(bf16_t v) { return __uint_as_float((unsigned)v << 16); }
__device__ __forceinline__ float rcpf_(float x) { return __builtin_amdgcn_rcpf(x); }
__device__ __forceinline__ float rsqf_(float x) { return __builtin_amdgcn_rsqf(x); }
__device__ __forceinline__ float sigmoidf_(float x) { return rcpf_(1.0f + __expf(-x)); }
__device__ __forceinline__ float siluf_(float x) { return x * sigmoidf_(x); }
typedef float f32x2e __attribute__((ext_vector_type(2)));
__device__ __forceinline__ f32x2e glu2_(f32x2e g, f32x2e u, f32x2e nrs, f32x2e rs2) {
    f32x2e e = g * nrs; e.x = __builtin_amdgcn_exp2f(e.x); e.y = __builtin_amdgcn_exp2f(e.y);
    f32x2e d = e + (f32x2e){1.0f, 1.0f}; d.x = __builtin_amdgcn_rcpf(d.x); d.y = __builtin_amdgcn_rcpf(d.y);
    return ((g * u) * rs2) * d; }
__device__ __forceinline__ f32x2e glus2_(f32x2e v, f32x2e g, f32x2e nrs, f32x2e rs1) {
    f32x2e e = g * nrs; e.x = __builtin_amdgcn_exp2f(e.x); e.y = __builtin_amdgcn_exp2f(e.y);
    f32x2e d = e + (f32x2e){1.0f, 1.0f}; d.x = __builtin_amdgcn_rcpf(d.x); d.y = __builtin_amdgcn_rcpf(d.y);
    return (v * rs1) * d; }
#define LO2(v) ((f32x2e){(v)[0], (v)[1]})
#define HI2(v) ((f32x2e){(v)[2], (v)[3]})
__device__ __forceinline__ float wave_sum(float v) {
#pragma unroll
    for (int o = 1; o < 64; o <<= 1) v += __shfl_xor(v, o);
    return v;
}
#define DPP_ADD(v, ctrl) ((v) + __builtin_bit_cast(float, __builtin_amdgcn_update_dpp(0, __builtin_bit_cast(int, (v)), (ctrl), 0xF, 0xF, true)))
__device__ __forceinline__ float wave_sum_u(float v) {
    v = DPP_ADD(v, 0xB1); v = DPP_ADD(v, 0x4E); v = DPP_ADD(v, 0x124); v = DPP_ADD(v, 0x128);
    const int b = __builtin_bit_cast(int, v);
    return (__builtin_bit_cast(float, __builtin_amdgcn_readlane(b, 0)) + __builtin_bit_cast(float, __builtin_amdgcn_readlane(b, 16))) + (__builtin_bit_cast(float, __builtin_amdgcn_readlane(b, 32)) + __builtin_bit_cast(float, __builtin_amdgcn_readlane(b, 48)));
}
__device__ __forceinline__ float wave_max(float v) {
#pragma unroll
    for (int o = 1; o < 64; o <<= 1) v = fmaxf(v, __shfl_xor(v, o));
    return v;
}
#define LDS_WAIT() asm volatile("s_waitcnt lgkmcnt(0)" ::: "memory")
typedef float f32x16 __attribute__((ext_vector_type(16)));
typedef __bf16 bf16v2 __attribute__((ext_vector_type(2)));
#define MFMA32(a, b, c) __builtin_amdgcn_mfma_f32_32x32x16_bf16((a), (b), (c), 0, 0, 0)
__device__ __forceinline__ unsigned pk_bf16(float lo, float hi) { const f32x2 v = {lo, hi}; return __builtin_bit_cast(unsigned, __builtin_convertvector(v, bf16v2)); }
template <int S8> __device__ __forceinline__ bf16x8 pack8(const f32x16& p) { u32x4 w; w.x = pk_bf16(p[S8], p[S8 + 1]); w.y = pk_bf16(p[S8 + 2], p[S8 + 3]); w.z = pk_bf16(p[S8 + 4], p[S8 + 5]); w.w = pk_bf16(p[S8 + 6], p[S8 + 7]); return __builtin_bit_cast(bf16x8, w); }
__device__ __forceinline__ u32x2 pk8_fp8(float a0, float a1, float a2, float a3, float a4, float a5, float a6, float a7) {
    int w0 = 0, w1 = 0; w0 = __builtin_amdgcn_cvt_pk_fp8_f32(a0, a1, w0, false); w0 = __builtin_amdgcn_cvt_pk_fp8_f32(a2, a3, w0, true);
    w1 = __builtin_amdgcn_cvt_pk_fp8_f32(a4, a5, w1, false); w1 = __builtin_amdgcn_cvt_pk_fp8_f32(a6, a7, w1, true); return (u32x2){(unsigned)w0, (unsigned)w1}; }
__device__ __forceinline__ int swap23(int v) { return (v & ~12) | ((v & 4) << 1) | ((v & 8) >> 1); }

namespace pg8 {
constexpr int BM = 256, BK = 64, HALF = 128, HTB = HALF * BK * 2, STAGE_BYTES = 8 * HTB, NXCD = 8, WGM = 8;
__device__ __forceinline__ int lds_byte(int r, int c) { const int st = (r >> 4) * 2 + (c >> 5), rr = r & 15, cc = c & 31, ob = rr * 64 + cc * 2; return st * 1024 + (ob ^ (((ob >> 9) & 1) << 5)); }
__device__ __forceinline__ void stage_rc(int b, int& R, int& C) { const int st = b / 1024, sb = b % 1024, swz = sb ^ (((sb >> 9) & 1) << 5); R = (st >> 1) * 16 + swz / 64; C = (st & 1) * 32 + (swz % 64) / 2; }
__device__ __forceinline__ int perm32(int rho) { const int n = rho >> 4, i = rho & 15; return 8 * (i >> 2) + 4 * n + (i & 3); }

struct Unit { int pm, pn; size_t aoff, boff; };
struct Gemm { const bf16_t* A; const bf16_t* Bt; int K, lda, ldb; };

struct SchedGrid {
    int nM, nN, nwg, G, c; size_t astr, bstr;
    __device__ __forceinline__ void init(int nM_, int nN_, int G_, int c_, int lda, int ldb) { nM = nM_; nN = nN_; nwg = nM * nN; G = G_; c = c_; astr = (size_t)BM * lda * 2; bstr = (size_t)BM * ldb * 2; }
    __device__ __forceinline__ bool next(int i, Unit& u) const {
        const long L = (long)i * G + c; if (L >= nwg) return false;
        int wgid = (int)L; { const int q = nwg / NXCD, r = nwg % NXCD, xcd = wgid % NXCD, off = wgid / NXCD; wgid = (xcd < r ? xcd * (q + 1) : r * (q + 1) + (xcd - r) * q) + off; }
        const int nig = WGM * nN, gid = wgid / nig, fm = gid * WGM, gsz = (nM - fm) < WGM ? (nM - fm) : WGM;
        u.pm = fm + ((wgid % nig) % gsz); u.pn = (wgid % nig) / gsz; u.aoff = (size_t)u.pm * astr; u.boff = (size_t)u.pn * bstr; return true;
    }
};

template <class Epi, class Sched>
__device__ __forceinline__ void gemm_phase(LAS unsigned char* lds, const Gemm g, const Sched& S, const Epi& E) {
    int tid = threadIdx.x; asm volatile("" : "+v"(tid));
    const int wid = __builtin_amdgcn_readfirstlane(tid >> 6), lane = tid & 63, wr = wid >> 2, wc = wid & 3, fr = lane & 15, fq = lane >> 4;
    const int K = g.K, nt = K / BK;
    unsigned voffA[2], voffB[2];
#pragma unroll
    for (int i = 0; i < 2; ++i) { int R, C; stage_rc(tid * 16 + i * 8192, R, C); const int Rb = Epi::PERM ? ((R & ~31) + perm32(R & 31)) : R;
        voffA[i] = (unsigned)(R * g.lda + C) * 2u; voffB[i] = (unsigned)(Rb * g.ldb + C) * 2u; }
    const size_t kstep = (size_t)(BK * 2);
    const size_t hstepA = (size_t)HALF * g.lda * 2, hstepB = (size_t)HALF * g.ldb * 2;
    const unsigned ldsw = (unsigned)wid * 1024u;
    const int aoff = lds_byte(wr * 64 + fr, fq * 8), boff = lds_byte(wc * 32 + fr, fq * 8);
#define PG8_SA(b, h) (((b) * 2 + (h)) * HTB)
#define PG8_SB(b, h) ((4 + (b) * 2 + (h)) * HTB)
#define PG8_STAGE(bufoff, gbase, voff) do { _Pragma("unroll") for (int _i = 0; _i < 2; ++_i) \
        __builtin_amdgcn_global_load_lds((const unsigned*)((const char*)(gbase) + (voff)[_i]), (LAS unsigned*)(lds + (bufoff) + ldsw + _i * 8192), 16, 0, 0); } while (0)
#define PG8_LDA(dst, b, h) do { _Pragma("unroll") for (int m = 0; m < 4; ++m) _Pragma("unroll") for (int k = 0; k < 2; ++k) dst[m][k] = *(const LAS bf16x8*)(lds + PG8_SA(b, h) + aoff + m * 2048 + k * 1024); } while (0)
#define PG8_LDB(dst, b, h) do { _Pragma("unroll") for (int n = 0; n < 2; ++n) _Pragma("unroll") for (int k = 0; k < 2; ++k) dst[n][k] = *(const LAS bf16x8*)(lds + PG8_SB(b, h) + boff + n * 2048 + k * 1024); } while (0)
#define PG8_MMA(ai, bj, At, Bt) do { __builtin_amdgcn_s_setprio(1); _Pragma("unroll") for (int m = 0; m < 4; ++m) _Pragma("unroll") for (int n = 0; n < 2; ++n) _Pragma("unroll") for (int k = 0; k < 2; ++k) \
        acc[ai][bj][m][n] = __builtin_amdgcn_mfma_f32_16x16x32_bf16(Bt[n][k], At[m][k], acc[ai][bj][m][n], 0, 0, 0); __builtin_amdgcn_s_setprio(0); } while (0)
#define PG8_WAIT_V(n) asm volatile("s_waitcnt vmcnt(" #n ")" ::: "memory")
#define PG8_WAIT_L(n) asm volatile("s_waitcnt lgkmcnt(" #n ")" ::: "memory")
#define PG8_BAR __builtin_amdgcn_s_barrier()
#define PG8_SCHED __builtin_amdgcn_sched_barrier(0)
    Unit cur, nxt; int ui = 0;
    if (!S.next(0, cur)) return;
    f32x4 acc[2][2][4][2];
#pragma unroll
    for (int a = 0; a < 2; ++a)
#pragma unroll
        for (int b = 0; b < 2; ++b)
#pragma unroll
            for (int m = 0; m < 4; ++m)
#pragma unroll
                for (int n = 0; n < 2; ++n) acc[a][b][m][n] = (f32x4){0.f, 0.f, 0.f, 0.f};
    bf16x8 At[4][2], B0[2][2], B1[2][2];
    const char* cA = (const char*)g.A + cur.aoff; const char* cB = (const char*)g.Bt + cur.boff;
    typename Epi::Pre pre; E.prefetch(cur, wr, fr, pre);
    PG8_STAGE(PG8_SB(0, 0), cB, voffB); PG8_STAGE(PG8_SA(0, 0), cA, voffA); PG8_STAGE(PG8_SB(0, 1), cB + hstepB, voffB); PG8_STAGE(PG8_SA(0, 1), cA + hstepA, voffA);
    if (wr == 1) PG8_BAR;
    PG8_WAIT_V(4); PG8_BAR;
    PG8_STAGE(PG8_SB(1, 0), cB + kstep, voffB); PG8_STAGE(PG8_SA(1, 0), cA + kstep, voffA); PG8_STAGE(PG8_SB(1, 1), cB + hstepB + kstep, voffB);
    PG8_WAIT_V(6); PG8_BAR;
    for (;;) {
        const bool has_next = S.next(ui + 1, nxt);
        const char* nA = has_next ? (const char*)g.A + nxt.aoff : cA; const char* nB = has_next ? (const char*)g.Bt + nxt.boff : cB;
#pragma nounroll
        for (int t = 0; t < nt; t += 2) {
            const bool last = (t == nt - 2);
            const char* a1 = cA + (size_t)(t + 1) * kstep;
            const char* a2 = last ? nA : cA + (size_t)(t + 2) * kstep; const char* b2 = last ? nB : cB + (size_t)(t + 2) * kstep;
            const char* a3 = a2 + kstep; const char* b3 = b2 + kstep;
            PG8_LDB(B0, 0, 0); PG8_SCHED; PG8_LDA(At, 0, 0); PG8_STAGE(PG8_SA(1, 1), a1 + hstepA, voffA);
            PG8_WAIT_L(8); PG8_BAR; PG8_WAIT_L(0); PG8_MMA(0, 0, At, B0); PG8_BAR; PG8_SCHED;
            PG8_LDB(B1, 0, 1); PG8_STAGE(PG8_SB(0, 0), b2, voffB);
            PG8_BAR; PG8_WAIT_L(0); PG8_MMA(0, 1, At, B1); PG8_BAR;
            PG8_LDA(At, 0, 1); PG8_STAGE(PG8_SA(0, 0), a2, voffA);
            PG8_BAR; PG8_WAIT_L(0); PG8_MMA(1, 0, At, B0); PG8_BAR; PG8_SCHED;
            PG8_STAGE(PG8_SB(0, 1), b2 + hstepB, voffB);
            PG8_WAIT_V(6); PG8_BAR; PG8_MMA(1, 1, At, B1); PG8_BAR;
            PG8_LDB(B0, 1, 0); PG8_SCHED; PG8_LDA(At, 1, 0); PG8_STAGE(PG8_SA(0, 1), a2 + hstepA, voffA);
            PG8_WAIT_L(8); PG8_BAR; PG8_WAIT_L(0); PG8_MMA(0, 0, At, B0); PG8_BAR; PG8_SCHED;
            PG8_LDB(B1, 1, 1); PG8_STAGE(PG8_SB(1, 0), b3, voffB);
            PG8_BAR; PG8_WAIT_L(0); PG8_MMA(0, 1, At, B1); PG8_BAR;
            PG8_LDA(At, 1, 1); PG8_STAGE(PG8_SA(1, 0), a3, voffA);
            PG8_BAR; PG8_WAIT_L(0); PG8_MMA(1, 0, At, B0); PG8_BAR; PG8_SCHED;
            PG8_STAGE(PG8_SB(1, 1), b3 + hstepB, voffB);
            PG8_WAIT_V(6); PG8_BAR; PG8_MMA(1, 1, At, B1); PG8_BAR;
        }
        E(acc, cur, wr, wc, fr, fq, pre);
        if (!has_next) break;
        E.prefetch(nxt, wr, fr, pre);
#pragma unroll
        for (int a = 0; a < 2; ++a)
#pragma unroll
            for (int b = 0; b < 2; ++b)
#pragma unroll
                for (int m = 0; m < 4; ++m)
#pragma unroll
                    for (int n = 0; n < 2; ++n) acc[a][b][m][n] = (f32x4){0.f, 0.f, 0.f, 0.f};
        cur = nxt; cA = nA; cB = nB; ++ui;
    }
    PG8_WAIT_V(0);
    if (wr == 0) PG8_BAR;
    PG8_BAR;
#undef PG8_SA
#undef PG8_SB
#undef PG8_STAGE
#undef PG8_LDA
#undef PG8_LDB
#undef PG8_MMA
#undef PG8_WAIT_V
#undef PG8_WAIT_L
#undef PG8_BAR
#undef PG8_SCHED
}
struct Gemm8 { const unsigned char* A; const unsigned char* Bt; int K, lda, ldb; };
typedef int i32x4 __attribute__((ext_vector_type(4)));
typedef int i32x8 __attribute__((ext_vector_type(8)));
template <class Epi, class Sched>
__device__ __forceinline__ void gemm_phase8(LAS unsigned char* lds, const Gemm8 g, const Sched& S, const Epi& E) {
    int tid = threadIdx.x; asm volatile("" : "+v"(tid));
    const int wid = __builtin_amdgcn_readfirstlane(tid >> 6), lane = tid & 63, wr = wid >> 2, wc = wid & 3, fr = lane & 15, fq = lane >> 4;
    const int nt = g.K / 128;
    unsigned voffA[2], voffB[2];
#pragma unroll
    for (int i = 0; i < 2; ++i) { int R, C; stage_rc(tid * 16 + i * 8192, R, C); const int Rb = Epi::PERM ? ((R & ~31) + perm32(R & 31)) : R;
        voffA[i] = (unsigned)(R * g.lda + C * 2); voffB[i] = (unsigned)(Rb * g.ldb + C * 2); }
    const size_t kstep = (size_t)(BK * 2);
    const size_t hstepA = (size_t)HALF * g.lda, hstepB = (size_t)HALF * g.ldb;
    const unsigned ldsw = (unsigned)wid * 1024u;
    const int aoff = lds_byte(wr * 64 + fr, fq * 8), boff = lds_byte(wc * 32 + fr, fq * 8);
#define PG8_SA(b, h) (((b) * 2 + (h)) * HTB)
#define PG8_SB(b, h) ((4 + (b) * 2 + (h)) * HTB)
#define PG8_STAGE(bufoff, gbase, voff) do { _Pragma("unroll") for (int _i = 0; _i < 2; ++_i) \
        __builtin_amdgcn_global_load_lds((const unsigned*)((const char*)(gbase) + (voff)[_i]), (LAS unsigned*)(lds + (bufoff) + ldsw + _i * 8192), 16, 0, 0); } while (0)
#define PG8_LDA(dst, b, h) do { _Pragma("unroll") for (int m = 0; m < 4; ++m) { const i32x4 _l = *(const LAS i32x4*)(lds + PG8_SA(b, h) + aoff + m * 2048), _h = *(const LAS i32x4*)(lds + PG8_SA(b, h) + aoff + m * 2048 + 1024); dst[m] = __builtin_shufflevector(_l, _h, 0, 1, 2, 3, 4, 5, 6, 7); } } while (0)
#define PG8_LDB(dst, b, h) do { _Pragma("unroll") for (int n = 0; n < 2; ++n) { const i32x4 _l = *(const LAS i32x4*)(lds + PG8_SB(b, h) + boff + n * 2048), _h = *(const LAS i32x4*)(lds + PG8_SB(b, h) + boff + n * 2048 + 1024); dst[n] = __builtin_shufflevector(_l, _h, 0, 1, 2, 3, 4, 5, 6, 7); } } while (0)
#define PG8_MMA(ai, bj, At, Bt) do { __builtin_amdgcn_s_setprio(1); _Pragma("unroll") for (int m = 0; m < 4; ++m) _Pragma("unroll") for (int n = 0; n < 2; ++n) \
        asm volatile("v_mfma_f32_16x16x128_f8f6f4 %0, %1, %2, %0" : "+v"(acc[ai][bj][m][n]) : "v"(Bt[n]), "v"(At[m])); __builtin_amdgcn_s_setprio(0); } while (0)
#define PG8_WAIT_V(n) asm volatile("s_waitcnt vmcnt(" #n ")" ::: "memory")
#define PG8_WAIT_L(n) asm volatile("s_waitcnt lgkmcnt(" #n ")" ::: "memory")
#define PG8_BAR __builtin_amdgcn_s_barrier()
#define PG8_SCHED __builtin_amdgcn_sched_barrier(0)
    Unit cur, nxt; int ui = 0;
    if (!S.next(0, cur)) return;
    f32x4 acc[2][2][4][2];
#pragma unroll
    for (int a = 0; a < 2; ++a)
#pragma unroll
        for (int b = 0; b < 2; ++b)
#pragma unroll
            for (int m = 0; m < 4; ++m)
#pragma unroll
                for (int n = 0; n < 2; ++n) acc[a][b][m][n] = (f32x4){0.f, 0.f, 0.f, 0.f};
    i32x8 At[4], B0[2], B1[2];
    const char* cA = (const char*)g.A + cur.aoff; const char* cB = (const char*)g.Bt + cur.boff;
    typename Epi::Pre pre; E.prefetch(cur, wr, fr, pre);
    PG8_STAGE(PG8_SB(0, 0), cB, voffB); PG8_STAGE(PG8_SA(0, 0), cA, voffA); PG8_STAGE(PG8_SB(0, 1), cB + hstepB, voffB); PG8_STAGE(PG8_SA(0, 1), cA + hstepA, voffA);
    if (wr == 1) PG8_BAR;
    PG8_WAIT_V(4); PG8_BAR;
    PG8_STAGE(PG8_SB(1, 0), cB + kstep, voffB); PG8_STAGE(PG8_SA(1, 0), cA + kstep, voffA); PG8_STAGE(PG8_SB(1, 1), cB + hstepB + kstep, voffB);
    PG8_WAIT_V(6); PG8_BAR;
    for (;;) {
        const bool has_next = S.next(ui + 1, nxt);
        const char* nA = has_next ? (const char*)g.A + nxt.aoff : cA; const char* nB = has_next ? (const char*)g.Bt + nxt.boff : cB;
#pragma nounroll
        for (int t = 0; t < nt; t += 2) {
            const bool last = (t == nt - 2);
            const char* a1 = cA + (size_t)(t + 1) * kstep;
            const char* a2 = last ? nA : cA + (size_t)(t + 2) * kstep; const char* b2 = last ? nB : cB + (size_t)(t + 2) * kstep;
            const char* a3 = a2 + kstep; const char* b3 = b2 + kstep;
            PG8_LDB(B0, 0, 0); PG8_SCHED; PG8_LDA(At, 0, 0); PG8_STAGE(PG8_SA(1, 1), a1 + hstepA, voffA);
            PG8_WAIT_L(8); PG8_BAR; PG8_WAIT_L(0); PG8_MMA(0, 0, At, B0); PG8_BAR; PG8_SCHED;
            PG8_LDB(B1, 0, 1); PG8_STAGE(PG8_SB(0, 0), b2, voffB);
            PG8_BAR; PG8_WAIT_L(0); PG8_MMA(0, 1, At, B1); PG8_BAR;
            PG8_LDA(At, 0, 1); PG8_STAGE(PG8_SA(0, 0), a2, voffA);
            PG8_BAR; PG8_WAIT_L(0); PG8_MMA(1, 0, At, B0); PG8_BAR; PG8_SCHED;
            PG8_STAGE(PG8_SB(0, 1), b2 + hstepB, voffB);
            PG8_WAIT_V(6); PG8_BAR; PG8_MMA(1, 1, At, B1); PG8_BAR;
            PG8_LDB(B0, 1, 0); PG8_SCHED; PG8_LDA(At, 1, 0); PG8_STAGE(PG8_SA(0, 1), a2 + hstepA, voffA);
            PG8_WAIT_L(8); PG8_BAR; PG8_WAIT_L(0); PG8_MMA(0, 0, At, B0); PG8_BAR; PG8_SCHED;
            PG8_LDB(B1, 1, 1); PG8_STAGE(PG8_SB(1, 0), b3, voffB);
            PG8_BAR; PG8_WAIT_L(0); PG8_MMA(0, 1, At, B1); PG8_BAR;
            PG8_LDA(At, 1, 1); PG8_STAGE(PG8_SA(1, 0), a3, voffA);
            PG8_BAR; PG8_WAIT_L(0); PG8_MMA(1, 0, At, B0); PG8_BAR; PG8_SCHED;
            PG8_STAGE(PG8_SB(1, 1), b3 + hstepB, voffB);
            PG8_WAIT_V(6); PG8_BAR; PG8_MMA(1, 1, At, B1); PG8_BAR;
        }
        E(acc, cur, wr, wc, fr, fq, pre);
        if (!has_next) break;
        E.prefetch(nxt, wr, fr, pre);
#pragma unroll
        for (int a = 0; a < 2; ++a)
#pragma unroll
            for (int b = 0; b < 2; ++b)
#pragma unroll
                for (int m = 0; m < 4; ++m)
#pragma unroll
                    for (int n = 0; n < 2; ++n) acc[a][b][m][n] = (f32x4){0.f, 0.f, 0.f, 0.f};
        cur = nxt; cA = nA; cB = nB; ++ui;
    }
    PG8_WAIT_V(0);
    if (wr == 0) PG8_BAR;
    PG8_BAR;
#undef PG8_SA
#undef PG8_SB
#undef PG8_STAGE
#undef PG8_LDA
#undef PG8_LDB
#undef PG8_MMA
#undef PG8_WAIT_V
#undef PG8_WAIT_L
#undef PG8_BAR
#undef PG8_SCHED
}
}
using pg8::Unit;

#define XB_TMO      128
#define XB_XCNT(j)  (256  + 64 * (j))
#define XB_XSUB(j)  (1280 + 64 * (j))
#define XB_XGEN(j)  (2304 + 64 * (j))
#define XB_TOP      3328
#define XB_TOPGEN   3392
#define XCD_BAR_WORDS 3456
#define XB_SPIN_CAP (1u << 18)
__device__ __forceinline__ unsigned xb_ld(unsigned* p)              { return __hip_atomic_load(p, __ATOMIC_RELAXED, __HIP_MEMORY_SCOPE_AGENT); }
__device__ __forceinline__ unsigned xb_add(unsigned* p, unsigned v) { return __hip_atomic_fetch_add(p, v, __ATOMIC_RELAXED, __HIP_MEMORY_SCOPE_AGENT); }
__device__ __forceinline__ unsigned xb_xcc_id() { return (unsigned)__builtin_amdgcn_s_getreg((3 << 11) | 20) & 0xFu; }
#define XB_SPIN(cond, bar) do { unsigned _sp = 0; while (cond) { __builtin_amdgcn_s_sleep(1); \
    if ((++_sp & 255u) == 0u) { if (xb_ld(&(bar)[XB_TMO])) break; if (_sp > XB_SPIN_CAP) { atomicAdd(&(bar)[XB_TMO], 1u); break; } } } } while (0)
struct XcdBarrier { unsigned* bar; unsigned x; volatile LAS unsigned* st; };
__device__ __forceinline__ XcdBarrier xcd_barrier_post(unsigned* bar, volatile LAS unsigned* st) {
    XcdBarrier b; b.bar = bar; b.x = xb_xcc_id(); b.st = st;
    if (threadIdx.x == 0) (void)xb_add(&bar[XB_XCNT(b.x)], 1u);
    return b;
}
__device__ __forceinline__ void xcd_barrier_complete(unsigned* bar, unsigned x, unsigned& nloc, unsigned& nx) {
    const unsigned G = gridDim.x * gridDim.y * gridDim.z;
    unsigned sum, cnt, mine, sp = 0u;
    for (;;) {
        sum = 0u; cnt = 0u; mine = 0u;
#pragma unroll
        for (unsigned j = 0; j < 16; ++j) { const unsigned c = xb_ld(&bar[XB_XCNT(j)]); sum += c; cnt += (c > 0u) ? 1u : 0u; mine = (j == x) ? c : mine; }
        if (sum == G) break;
        __builtin_amdgcn_s_sleep(1);
        if ((++sp & 255u) == 0u) { if (xb_ld(&bar[XB_TMO])) break; if (sp > XB_SPIN_CAP) { atomicAdd(&bar[XB_TMO], 1u); break; } }
    }
    nloc = mine > 0u ? mine : 1u; nx = cnt > 0u ? cnt : 1u;
}
__device__ __forceinline__ void xcd_barrier(const XcdBarrier& b) {
    asm volatile("s_waitcnt vmcnt(0)" ::: "memory");
    __syncthreads();
    if (threadIdx.x == 0) {
        unsigned* bar = b.bar;
        __builtin_amdgcn_s_waitcnt(0);
        unsigned nloc = b.st[0], nx = b.st[1];
        if (nloc == 0u) { xcd_barrier_complete(bar, b.x, nloc, nx); b.st[0] = nloc; b.st[1] = nx; }
        const unsigned old = xb_add(&bar[XB_XSUB(b.x)], 1u);
        const unsigned gen = old / nloc;
        if (old + 1u == (gen + 1u) * nloc) {
            __builtin_amdgcn_fence(__ATOMIC_RELEASE, "agent");
            asm volatile("s_waitcnt vmcnt(0)" ::: "memory");
            const unsigned og = xb_add(&bar[XB_TOP], 1u);
            const unsigned tg = og / nx;
            if (og + 1u == (tg + 1u) * nx) xb_add(&bar[XB_TOPGEN], 1u);
            else XB_SPIN(xb_ld(&bar[XB_TOPGEN]) == tg, bar);
            __builtin_amdgcn_fence(__ATOMIC_ACQUIRE, "agent");
            xb_add(&bar[XB_XGEN(b.x)], 1u);
            asm volatile("s_waitcnt vmcnt(0)" ::: "memory");
        } else {
            XB_SPIN(xb_ld(&bar[XB_XGEN(b.x)]) == gen, bar);
            __builtin_amdgcn_fence(__ATOMIC_ACQUIRE, "agent");
            asm volatile("s_waitcnt vmcnt(0)" ::: "memory");
        }
    }
    __syncthreads();
}

constexpr int NWAVES = 8, NTHR = 512;
constexpr int LDS_BYTES = 147456;
constexpr int MISC_OFF = 131072;
constexpr int PTAB_OFF = MISC_OFF + 512;

struct Args { const float* in[28]; float* out; unsigned char* ws; int ph_lo, ph_hi; };

struct Frame {
    LAS unsigned char* lds; int tid, lane, wave, G, c;
    const float* const* in; float* out; unsigned char* ws;
};
#define INP_(i) (F.in[i])
#define FRESH_TID(F) do { int _t = threadIdx.x; asm volatile("" : "+v"(_t)); (F).tid = _t; (F).lane = _t & 63; \
    __attribute__((address_space(1))) unsigned char* _w = (__attribute__((address_space(1))) unsigned char*)args.ws; __attribute__((address_space(1))) float* _o = (__attribute__((address_space(1))) float*)args.out; \
    int _g = gridDim.x; asm volatile("" : "+s"(_w), "+s"(_o), "+s"(_g)); (F).ws = (unsigned char*)_w; (F).out = (float*)_o; (F).G = _g; } while (0)
enum { I_X = 0, I_ANG, I_WIN, I_CDW, I_CDB, I_CLG, I_CLB, I_QG, I_KG, I_PK, I_PV, I_KW1, I_KB1, I_KW2, I_KB2, I_VW1, I_VB1, I_VW2, I_VB2, I_WOUT, I_FNG, I_DW1, I_DW3, I_DW2, I_RW, I_MW1, I_MW3, I_MW2 };

#define PMARK(id) do { if (PROBE_MASK != 0u && blockIdx.x == 0 && threadIdx.x == 0) { volatile LAS unsigned long long* _a = (volatile LAS unsigned long long*)(F.lds + MISC_OFF + 160); volatile LAS unsigned* _o = (volatile LAS unsigned*)(F.lds + MISC_OFF + 168); \
    const unsigned long long _t = __builtin_amdgcn_s_memrealtime(); if (*_o) { *_a += _t; *_o = 0u; } if ((id) < 32 && ((PROBE_MASK >> (id)) & 1u)) { *_a -= _t; *_o = 1u; } } } while (0)
constexpr int RSL_OFF = MISC_OFF + 2048;
__device__ __forceinline__ void rstd_from_partials(const float* pss, int pm, LAS float* tab) {
    int t = threadIdx.x; asm volatile("" : "+v"(t));
    const int row = t >> 1, hf = t & 1;
    const f32x4 a = *(const f32x4*)(pss + (size_t)(pm * 256 + row) * 16 + hf * 8), b = *(const f32x4*)(pss + (size_t)(pm * 256 + row) * 16 + hf * 8 + 4);
    float sq = ((a.x + a.y) + (a.z + a.w)) + ((b.x + b.y) + (b.z + b.w)); sq += __shfl_xor(sq, 1);
    if (hf == 0) tab[row] = rsqf_(sq * (1.0f / D) + EPS);
}
struct EpiIn {
    static constexpr bool PERM = true;
    const float* rstd; bf16_t* U; bf16_t* Q; bf16_t* KV; float* GT; const float* pss; LAS float* rsl;
    struct Pre { int par = 1; };
    __device__ __forceinline__ void prefetch(const Unit& u, int wr, int fr, Pre& p) const {
        p.par ^= 1; LAS float* tab = rsl + p.par * 256;
        if (pss) rstd_from_partials(pss, u.pm, tab); else { int t = threadIdx.x; asm volatile("" : "+v"(t)); if (t < 256) tab[t] = rstd[u.pm * 256 + t]; } }
    __device__ __forceinline__ void operator()(const f32x4 (&acc)[2][2][4][2], const Unit& u, int wr, int wc, int fr, int fq, const Pre& pre) const {
        const int row0 = u.pm * 256 + wr * 64 + fr, cl = wc * 32 + 8 * fq;
        if (u.pn < 4) {
#pragma unroll
            for (int ai = 0; ai < 2; ++ai)
#pragma unroll
                for (int m = 0; m < 4; ++m) { const int r = row0 + ai * 128 + m * 16; const float rs = rsl[pre.par * 256 + wr * 64 + fr + ai * 128 + m * 16];
                    const f32x4 v0 = acc[ai][0][m][0], v1 = acc[ai][0][m][1], g0 = acc[ai][1][m][0], g1 = acc[ai][1][m][1];
                    const float nr = rs * -1.44269504089f; const f32x2e nrs = {nr, nr}, rs1 = {rs, rs};
                    const f32x2e o0 = glus2_(LO2(v0), LO2(g0), nrs, rs1), o1 = glus2_(HI2(v0), HI2(g0), nrs, rs1), o2 = glus2_(LO2(v1), LO2(g1), nrs, rs1), o3 = glus2_(HI2(v1), HI2(g1), nrs, rs1);
                    u32x4 w; w.x = cvt_pk_bf16(o0.x, o0.y); w.y = cvt_pk_bf16(o1.x, o1.y); w.z = cvt_pk_bf16(o2.x, o2.y); w.w = cvt_pk_bf16(o3.x, o3.y);
                    *(u32x4*)(U + (size_t)r * CW + u.pn * 128 + cl) = w; asm volatile("" ::: "memory"); }
        } else if (u.pn < 6) {
#pragma unroll
            for (int ai = 0; ai < 2; ++ai)
#pragma unroll
                for (int m = 0; m < 4; ++m) { const int r = row0 + ai * 128 + m * 16; const float rs = rsl[pre.par * 256 + wr * 64 + fr + ai * 128 + m * 16];
#pragma unroll
                    for (int bj = 0; bj < 2; ++bj) { const f32x4 v0 = acc[ai][bj][m][0] * rs, v1 = acc[ai][bj][m][1] * rs;
                        u32x4 w; w.x = cvt_pk_bf16(v0[0], v0[1]); w.y = cvt_pk_bf16(v0[2], v0[3]); w.z = cvt_pk_bf16(v1[0], v1[1]); w.w = cvt_pk_bf16(v1[2], v1[3]);
                        *(u32x4*)(Q + (size_t)r * 512 + (u.pn - 4) * 256 + bj * 128 + cl) = w; } asm volatile("" ::: "memory"); }
        } else if (u.pn < 9) {
            const int h = wc >> 1, d0 = 32 * (wc & 1) + 8 * fq;
#pragma unroll
            for (int ai = 0; ai < 2; ++ai)
#pragma unroll
                for (int m = 0; m < 4; ++m) { const int r = row0 + ai * 128 + m * 16; const float rs = rsl[pre.par * 256 + wr * 64 + fr + ai * 128 + m * 16]; const int b = r >> 11, t = r & 2047;
#pragma unroll
                    for (int bj = 0; bj < 2; ++bj) { const int tq = 2 * (u.pn - 6) + bj; const f32x4 v0 = acc[ai][bj][m][0] * rs, v1 = acc[ai][bj][m][1] * rs;
                        u32x4 w; w.x = cvt_pk_bf16(v0[0], v0[1]); w.y = cvt_pk_bf16(v0[2], v0[3]); w.z = cvt_pk_bf16(v1[0], v1[1]); w.w = cvt_pk_bf16(v1[2], v1[3]);
                        *(u32x4*)(KV + (size_t)tq * KVT + ((size_t)(b * 2 + h) * SEQ + t) * DH + d0) = w; } asm volatile("" ::: "memory"); }
        } else {
            if (wc == 0 && fq < 3) {
#pragma unroll
                for (int ai = 0; ai < 2; ++ai)
#pragma unroll
                    for (int m = 0; m < 4; ++m) { const int r = row0 + ai * 128 + m * 16; const float rs = rsl[pre.par * 256 + wr * 64 + fr + ai * 128 + m * 16];
                        *(f32x4*)(GT + (size_t)r * 24 + 8 * fq) = acc[ai][0][m][0] * rs; *(f32x4*)(GT + (size_t)r * 24 + 8 * fq + 4) = acc[ai][0][m][1] * rs; }
            }
        }
    }
};
struct EpiH1 {
    static constexpr bool PERM = false;
    float* H;
    struct Pre {}; __device__ __forceinline__ void prefetch(const Unit&, int, int, Pre&) const {}
    __device__ __forceinline__ void operator()(const f32x4 (&acc)[2][2][4][2], const Unit& u, int wr, int wc, int fr, int fq, const Pre&) const {
        const int row0 = u.pm * 256 + wr * 64 + fr, col0 = wc * 32 + 4 * fq; const int kv = u.pn >> 3, sp = u.pn & 7;
#pragma unroll
        for (int ai = 0; ai < 2; ++ai)
#pragma unroll
            for (int m = 0; m < 4; ++m) { float* rowp = H + (((size_t)sp * 2 + kv) * 2048 + row0 + ai * 128 + m * 16) * 256 + col0;
#pragma unroll
                for (int bj = 0; bj < 2; ++bj)
#pragma unroll
                    for (int n = 0; n < 2; ++n) *(f32x4*)(rowp + bj * 128 + n * 16) = acc[ai][bj][m][n]; }
    }
};
template <bool BF> struct EpiRes {
    static constexpr bool PERM = false;
    const void* base; bf16_t* xb; float* pss;
    struct Pre {}; __device__ __forceinline__ void prefetch(const Unit&, int, int, Pre&) const {}
    __device__ __forceinline__ void operator()(const f32x4 (&acc)[2][2][4][2], const Unit& u, int wr, int wc, int fr, int fq, const Pre&) const {
        const int row0 = u.pm * 256 + wr * 64 + fr, col0 = u.pn * 256 + wc * 32 + 4 * fq;
#pragma unroll
        for (int ai = 0; ai < 2; ++ai) {
            f32x4 bs[4][2][2];
#pragma unroll
            for (int m = 0; m < 4; ++m) { const size_t off = (size_t)(row0 + ai * 128 + m * 16) * D + col0;
#pragma unroll
                for (int bj = 0; bj < 2; ++bj)
#pragma unroll
                    for (int n = 0; n < 2; ++n) {
                        if (BF) { const u32x2 w = *(const u32x2*)((const bf16_t*)base + off + bj * 128 + n * 16); bs[m][bj][n] = (f32x4){bf_lo(w.x), bf_hi(w.x), bf_lo(w.y), bf_hi(w.y)}; }
                        else bs[m][bj][n] = *(const f32x4*)((const float*)base + off + bj * 128 + n * 16); } }
#pragma unroll
            for (int m = 0; m < 4; ++m) { const size_t off = (size_t)(row0 + ai * 128 + m * 16) * D + col0; float ss = 0.f;
#pragma unroll
                for (int bj = 0; bj < 2; ++bj)
#pragma unroll
                    for (int n = 0; n < 2; ++n) { const f32x4 v = bs[m][bj][n] + acc[ai][bj][m][n];
                        u32x2 w; w.x = cvt_pk_bf16(v[0], v[1]); w.y = cvt_pk_bf16(v[2], v[3]); *(u32x2*)(xb + off + bj * 128 + n * 16) = w; ss += (v[0] * v[0] + v[1] * v[1]) + (v[2] * v[2] + v[3] * v[3]); }
                if (pss) { ss += __shfl_xor(ss, 16); ss += __shfl_xor(ss, 32);
                    if (fq == 0) pss[(size_t)(row0 + ai * 128 + m * 16) * 16 + u.pn * 4 + wc] = ss; } } }
    }
};
struct EpiGlu {
    static constexpr bool PERM = true;
    const float* rstd; bf16_t* O; int ldo; int rowbase;
    const float* pss; LAS float* rsl;
    struct Pre { int par = 1; };
    __device__ __forceinline__ void prefetch(const Unit& u, int wr, int fr, Pre& p) const { p.par ^= 1; rstd_from_partials(pss, u.pm, rsl + p.par * 256); }
    __device__ __forceinline__ void operator()(const f32x4 (&acc)[2][2][4][2], const Unit& u, int wr, int wc, int fr, int fq, const Pre& pre) const {
        const int row0 = u.pm * 256 + wr * 64 + fr, cl = u.pn * 128 + wc * 32 + 8 * fq;
#pragma unroll
        for (int ai = 0; ai < 2; ++ai)
#pragma unroll
            for (int m = 0; m < 4; ++m) { const int r = row0 + ai * 128 + m * 16; const float rs = rsl[pre.par * 256 + wr * 64 + fr + ai * 128 + m * 16];
                const f32x4 g0 = acc[ai][0][m][0], g1 = acc[ai][0][m][1], u0 = acc[ai][1][m][0], u1 = acc[ai][1][m][1];
                const float nr = rs * -1.44269504089f, r2 = rs * rs; const f32x2e nrs = {nr, nr}, rs2 = {r2, r2};
                const f32x2e o0 = glu2_(LO2(g0), LO2(u0), nrs, rs2), o1 = glu2_(HI2(g0), HI2(u0), nrs, rs2), o2 = glu2_(LO2(g1), LO2(u1), nrs, rs2), o3 = glu2_(HI2(g1), HI2(u1), nrs, rs2);
                u32x4 w; w.x = cvt_pk_bf16(o0.x, o0.y); w.y = cvt_pk_bf16(o1.x, o1.y); w.z = cvt_pk_bf16(o2.x, o2.y); w.w = cvt_pk_bf16(o3.x, o3.y);
                *(u32x4*)(O + (size_t)r * ldo + cl) = w; }
    }
};
struct EpiGlu8 {
    static constexpr bool PERM = true;
    const float* rstd; unsigned char* O; int ldo; float sc;
    struct Pre { float rs[8]; };
    __device__ __forceinline__ void prefetch(const Unit& u, int wr, int fr, Pre& p) const {
#pragma unroll
        for (int q = 0; q < 8; ++q) p.rs[q] = rstd[u.pm * 256 + wr * 64 + fr + (q >> 2) * 128 + (q & 3) * 16]; }
    __device__ __forceinline__ void operator()(const f32x4 (&acc)[2][2][4][2], const Unit& u, int wr, int wc, int fr, int fq, const Pre& pre) const {
        const int row0 = u.pm * 256 + wr * 64 + fr, cl = u.pn * 128 + wc * 32 + 8 * fq;
#pragma unroll
        for (int ai = 0; ai < 2; ++ai)
#pragma unroll
            for (int m = 0; m < 4; ++m) { const int r = row0 + ai * 128 + m * 16; const float rs = pre.rs[ai * 4 + m] * sc;
                const f32x4 g0 = acc[ai][0][m][0], g1 = acc[ai][0][m][1], u0 = acc[ai][1][m][0], u1 = acc[ai][1][m][1];
                const float nr = rs * -1.44269504089f, r2 = rs * rs; const f32x2e nrs = {nr, nr}, rs2 = {r2, r2};
                const f32x2e o0 = glu2_(LO2(g0), LO2(u0), nrs, rs2), o1 = glu2_(HI2(g0), HI2(u0), nrs, rs2), o2 = glu2_(LO2(g1), LO2(u1), nrs, rs2), o3 = glu2_(HI2(g1), HI2(u1), nrs, rs2);
                *(u32x2*)(O + (size_t)r * ldo + cl) = pk8_fp8(o0.x, o0.y, o1.x, o1.y, o2.x, o2.y, o3.x, o3.y); }
    }
};
struct EpiMoe2 {
    static constexpr bool PERM = true;
    const int* stok; const float* sw; bf16_t* Y0; bf16_t* Y1; int rowbase; float sc;
    struct Pre {}; __device__ __forceinline__ void prefetch(const Unit&, int, int, Pre&) const {}
    __device__ __forceinline__ void operator()(const f32x4 (&acc)[2][2][4][2], const Unit& u, int wr, int wc, int fr, int fq, const Pre&) const {
        const int row0 = u.pm * 256 + wr * 64 + fr, cl = u.pn * 256 + wc * 32 + 8 * fq;
        int tks[8]; float ws[8];
#pragma unroll
        for (int q = 0; q < 8; ++q) { const int r = rowbase + row0 + (q >> 2) * 128 + (q & 3) * 16; tks[q] = stok[r]; ws[q] = sw[r]; }
#pragma unroll
        for (int ai = 0; ai < 2; ++ai)
#pragma unroll
            for (int m = 0; m < 4; ++m) { const int tk = tks[ai * 4 + m]; const float w = ws[ai * 4 + m] * sc;
                if (tk >= 0) { bf16_t* dst = ((tk & 1) ? Y1 : Y0) + (size_t)(tk >> 1) * D + cl;
#pragma unroll
                    for (int bj = 0; bj < 2; ++bj) { const f32x4 v0 = acc[ai][bj][m][0] * w, v1 = acc[ai][bj][m][1] * w;
                        u32x4 o; o.x = cvt_pk_bf16(v0[0], v0[1]); o.y = cvt_pk_bf16(v0[2], v0[3]); o.z = cvt_pk_bf16(v1[0], v1[1]); o.w = cvt_pk_bf16(v1[2], v1[3]);
                        *(u32x4*)(dst + bj * 128) = o; } } }
    }
};

struct SchedCmp {
    int G, c, layer;
    __device__ __forceinline__ bool next(int i, Unit& u) const {
        const int L = i * G + c; if (L >= 128) return false;
        const int kv = L >> 6, pm = (L >> 3) & 7, s = L & 7;
        u.pm = pm; u.pn = kv * 8 + s; u.aoff = ((size_t)kv * KVT + (size_t)pm * 256 * 1024 + s * 256) * 2; u.boff = ((size_t)(layer * 2 + kv) * 256 * 2048 + s * 256) * 2; return true;
    }
};
struct SchedMoe1 {
    int G, c, p0, np; const LAS int* ptab;
    __device__ __forceinline__ bool next(int i, Unit& u) const {
        const int L = i * G + c; if (L >= np * 28) return false;
        const int j = L / np, pl = L % np, e = ptab[p0 + pl];
        u.pm = pl; u.pn = j; u.aoff = (size_t)(p0 + pl) * 256 * 1024 * 2; u.boff = ((size_t)e * 7168 + (size_t)j * 256) * 1024 * 2; return true;
    }
};
struct SchedMoe2 {
    int G, c, p0, np; const LAS int* ptab;
    __device__ __forceinline__ bool next(int i, Unit& u) const {
        const int L = i * G + c; if (L >= np * 4) return false;
        const int j = L / np, pl = L % np, e = ptab[p0 + pl];
        u.pm = pl; u.pn = j; u.aoff = (size_t)pl * 256 * DFE * 2; u.boff = ((size_t)e * 1024 + (size_t)j * 256) * DFE * 2; return true;
    }
};

struct SchedMoe1F {
    int G, c, np; const LAS int* ptab;
    __device__ __forceinline__ bool next(int i, Unit& u) const {
        const int L = i * G + c; if (L >= np * 28) return false;
        const int pl = L / 28, j = L % 28, e = ptab[pl];
        u.pm = pl; u.pn = j; u.aoff = (size_t)pl * 256 * 1024; u.boff = ((size_t)e * 7168 + (size_t)j * 256) * 1024; return true;
    }
};
struct SchedMoe2F {
    int G, c, np; const LAS int* ptab;
    __device__ __forceinline__ bool next(int i, Unit& u) const {
        const int L = i * G + c; if (L >= np * 4) return false;
        const int pl = L >> 2, j = L & 3, e = ptab[pl];
        u.pm = pl; u.pn = j; u.aoff = (size_t)pl * 256 * DFE; u.boff = ((size_t)e * 1024 + (size_t)j * 256) * DFE; return true;
    }
};

struct TwP { const float* W; const float* gv; bf16_t* WT; int ldw, n0, nvalid, k0, ldk, kind, h; float f8sc; };
__device__ __forceinline__ TwP tw_job(int r, const float* W, int ldw, int nblk, int nvalid, bf16_t* WT, int ldk, int kind, int h, const float* gv) {
    TwP P; P.W = W; P.gv = gv; P.WT = WT; P.ldw = ldw; P.n0 = 256 * (r % nblk); P.nvalid = nvalid; P.k0 = 64 * (r / nblk); P.ldk = ldk; P.kind = kind; P.h = h; P.f8sc = 0.f; return P; }
__device__ __forceinline__ void tw_load(const TwP& P, f32x4 (&tv)[8], int wave, int lane) {
    const int n = P.n0 + 4 * lane; const float* src = P.W + (size_t)(P.k0 + 8 * wave) * P.ldw + n;
#pragma unroll
    for (int i = 0; i < 8; ++i) tv[i] = (n < P.nvalid) ? *(const f32x4*)(src + (size_t)i * P.ldw) : (f32x4){0.f, 0.f, 0.f, 0.f};
}
__device__ __forceinline__ void tw_store(const TwP& P, f32x4 (&tv)[8], LAS unsigned char* tile, int wave, int lane) {
    if (P.gv) {
#pragma unroll
        for (int i = 0; i < 8; ++i) tv[i] *= P.gv[P.k0 + 8 * wave + i]; }
    const int ng = P.n0 + 32 * wave; size_t drow;
    if (P.kind == 0) drow = ng;
    else if (P.kind == 1) drow = 256 * (ng / 128) + 128 * P.h + (ng % 128);
    else { if (ng < 512) drow = 256 * (ng / 128) + (ng % 128); else if (ng < 1024) { const int cc = ng - 512; drow = 256 * (cc / 128) + 128 + (cc % 128); } else drow = ng; }
    if (P.f8sc != 0.f) {
        const float sc = P.f8sc;
#pragma unroll
        for (int c = 0; c < 4; ++c) *(LAS u32x2*)(tile + (4 * lane + c) * 80 + 8 * wave) = pk8_fp8(tv[0][c] * sc, tv[1][c] * sc, tv[2][c] * sc, tv[3][c] * sc, tv[4][c] * sc, tv[5][c] * sc, tv[6][c] * sc, tv[7][c] * sc);
        __syncthreads();
#pragma unroll
        for (int j = 0; j < 2; ++j) { const int r = (lane >> 2) + 16 * j, ch = lane & 3;
            *(u32x4*)((unsigned char*)P.WT + (drow + r) * (size_t)P.ldk + P.k0 + 16 * ch) = *(const LAS u32x4*)(tile + (32 * wave + r) * 80 + 16 * ch); }
        __syncthreads();
        return; }
#pragma unroll
    for (int c = 0; c < 4; ++c) { u32x4 o; o.x = cvt_pk_bf16(tv[0][c], tv[1][c]); o.y = cvt_pk_bf16(tv[2][c], tv[3][c]); o.z = cvt_pk_bf16(tv[4][c], tv[5][c]); o.w = cvt_pk_bf16(tv[6][c], tv[7][c]);
        *(LAS u32x4*)(tile + (4 * lane + c) * 144 + 16 * wave) = o; }
    __syncthreads();
#pragma unroll
    for (int j = 0; j < 4; ++j) { const int r = (lane >> 3) + 8 * j, c = lane & 7;
        *(u32x4*)(P.WT + (drow + r) * (size_t)P.ldk + P.k0 + 8 * c) = *(const LAS u32x4*)(tile + (32 * wave + r) * 144 + 16 * c); }
    __syncthreads();
}
#define TW_RUN(NIT, JOB) do { const int _n = (NIT); if (_n > 0) { TwP _pa, _pb; f32x4 _ta[8], _tb[8]; JOB(_pa, 0); tw_load(_pa, _ta, F.wave, F.lane); \
    _Pragma("nounroll") for (int _i = 0; _i < _n; _i += 2) { const bool _h2 = _i + 1 < _n, _h3 = _i + 2 < _n; \
        if (_h2) { JOB(_pb, _i + 1); tw_load(_pb, _tb, F.wave, F.lane); } tw_store(_pa, _ta, F.lds, F.wave, F.lane); if (!_h2) break; \
        if (_h3) { JOB(_pa, _i + 2); tw_load(_pa, _ta, F.wave, F.lane); } tw_store(_pb, _tb, F.lds, F.wave, F.lane); } } } while (0)
__device__ __forceinline__ void xprep_row(const float* xrow, bf16_t* orow, float* rstd_out, int lane, f32x4 (&v)[4]) {
    const f32x4* xr = (const f32x4*)xrow + lane; float s = 0.f;
#pragma unroll
    for (int j = 0; j < 4; ++j) { v[j] = xr[64 * j]; s += (v[j].x * v[j].x + v[j].y * v[j].y) + (v[j].z * v[j].z + v[j].w * v[j].w); }
    const float rstd = rsqf_(wave_sum_u(s) * (1.0f / D) + EPS);
    if (orow) { u32x2* o8 = (u32x2*)orow + lane;
#pragma unroll
        for (int j = 0; j < 4; ++j) { u32x2 w; w.x = cvt_pk_bf16(v[j].x, v[j].y); w.y = cvt_pk_bf16(v[j].z, v[j].w); o8[64 * j] = w; } }
    if (lane == 0) *rstd_out = rstd;
}

constexpr float MOE_S1 = 64.f, MOE_S2 = 128.f;
constexpr int MOE_SLOT_N = 7, MOE_SLOTTED = 3 * 128 * MOE_SLOT_N;
constexpr int MOE_ITEMS = 24 * 224;
__device__ __forceinline__ TwP moe_conv_job(Frame& F, int r) {
    constexpr int J_M1 = 16 * 14, J_M2 = 56 * 4;
    unsigned char* WM1 = F.ws + WS_WM1; unsigned char* WM2 = F.ws + WS_WM2;
    if (r < 16 * J_M1) { const int q = r / J_M1, e = q >> 1, h = q & 1; TwP P = tw_job(r % J_M1, (h ? INP_(I_MW3) : INP_(I_MW1)) + (size_t)e * D * DFE, DFE, 14, DFE, (bf16_t*)(WM1 + (size_t)e * 7168 * D), D, 1, h, INP_(I_FNG) + D); P.f8sc = MOE_S1; return P; }
    r -= 16 * J_M1; const int e = r / J_M2; TwP P = tw_job(r % J_M2, INP_(I_MW2) + (size_t)e * DFE * D, D, 4, D, (bf16_t*)(WM2 + (size_t)e * D * DFE), DFE, 0, 0, nullptr); P.f8sc = MOE_S2; return P;
}
__device__ __forceinline__ void moe_conv_slot(Frame& F, int slot) {
    if (F.G != 256 || F.c < 128) return;
    { int _t = threadIdx.x; asm volatile("" : "+v"(_t)); F.tid = _t; F.lane = _t & 63; }
    int base = slot * 128 * MOE_SLOT_N + ((int)blockIdx.x - 128); asm volatile("" : "+s"(base));
#define MJOB(P, i) P = moe_conv_job(F, base + (i) * 128)
    TW_RUN(MOE_SLOT_N, MJOB);
#undef MJOB
}
__device__ __forceinline__ void xprep_rows4(const float* X, bf16_t* XBo, float* RSo, int m, int ms, int lane) {
    f32x4 v[4][4];
#pragma unroll
    for (int q = 0; q < 4; ++q) { const int mm = m + q * ms; const f32x4* xr = (const f32x4*)(X + (size_t)(mm < M ? mm : 0) * D) + lane;
#pragma unroll
        for (int j = 0; j < 4; ++j) v[q][j] = xr[64 * j]; }
#pragma unroll
    for (int q = 0; q < 4; ++q) { const int mm = m + q * ms; if (mm >= M) break; float s = 0.f;
#pragma unroll
        for (int j = 0; j < 4; ++j) s += (v[q][j].x * v[q][j].x + v[q][j].y * v[q][j].y) + (v[q][j].z * v[q][j].z + v[q][j].w * v[q][j].w);
        const float rstd = rsqf_(wave_sum_u(s) * (1.0f / D) + EPS);
        u32x2* o8 = (u32x2*)(XBo + (size_t)mm * D) + lane;
#pragma unroll
        for (int j = 0; j < 4; ++j) { u32x2 w; w.x = cvt_pk_bf16(v[q][j].x, v[q][j].y); w.y = cvt_pk_bf16(v[q][j].z, v[q][j].w); o8[64 * j] = w; }
        if (lane == 0) RSo[mm] = rstd; }
}
__device__ __forceinline__ void phase_prologue(Frame& F) {
    const int gw = F.c * NWAVES + F.wave, NGW = F.G * NWAVES;
    bf16_t* WIN = (bf16_t*)(F.ws + WS_WIN); bf16_t* WC1 = (bf16_t*)(F.ws + WS_WC1); bf16_t* WOUT = (bf16_t*)(F.ws + WS_WOUT); bf16_t* WF1 = (bf16_t*)(F.ws + WS_WF1); bf16_t* WF2 = (bf16_t*)(F.ws + WS_WF2);
    constexpr int J_IN = 16 * 10, J_C1 = 32, J_OUT = 16 * 4, J_F1 = 16 * 11, J_F2 = 44 * 4;
    constexpr int NSMALL = 2 * J_IN + 4 * J_C1 + 2 * J_OUT + 2 * J_F1 + J_F2;
    const int moe0 = (F.G == 256) ? MOE_SLOTTED : 0; const int nitems = NSMALL + MOE_ITEMS - moe0;
#define P0_JOB(P, i) do { int r = F.c + (i) * F.G; \
        if (r < 2 * J_IN) { const int l = r / J_IN; P = tw_job(r % J_IN, INP_(I_WIN) + (size_t)l * D * INW, INW, 10, INW, WIN + (size_t)l * INP * D, D, 2, 0, INP_(I_ANG) + l * D); break; } r -= 2 * J_IN; \
        if (r < 4 * J_C1) { const int q = r / J_C1, l = q >> 1, kv = q & 1; P = tw_job(r % J_C1, (kv ? INP_(I_VW1) : INP_(I_KW1)) + (size_t)l * 2048 * 256, 256, 1, 256, WC1 + (size_t)(l * 2 + kv) * 256 * 2048, 2048, 0, 0, nullptr); break; } r -= 4 * J_C1; \
        if (r < 2 * J_OUT) { const int l = r / J_OUT; P = tw_job(r % J_OUT, INP_(I_WOUT) + (size_t)l * D * D, D, 4, D, WOUT + (size_t)l * D * D, D, 0, 0, nullptr); break; } r -= 2 * J_OUT; \
        if (r < 2 * J_F1) { const int h = r / J_F1; P = tw_job(r % J_F1, (h ? INP_(I_DW3) : INP_(I_DW1)), DFF, 11, DFF, WF1, D, 1, h, INP_(I_FNG)); break; } r -= 2 * J_F1; \
        if (r < J_F2) { P = tw_job(r, INP_(I_DW2), D, 4, D, WF2, DFF, 0, 0, nullptr); break; } r -= J_F2; \
        P = moe_conv_job(F, r + moe0); } while (0)
    TW_RUN((nitems - F.c + F.G - 1) / F.G, P0_JOB);
#undef P0_JOB
    { float* RT = (float*)(F.ws + WS_RT); const int gt = F.c * NTHR + F.tid; if (gt < 8192) { const int e = gt >> 10, k = gt & 1023; RT[gt] = INP_(I_RW)[k * 8 + e] * INP_(I_FNG)[D + k]; } }
    { float* B1P = (float*)(F.ws + WS_CTL) + CW_B1P; LAS float* ps = (LAS float*)F.lds;
      for (int it = F.c; it < 128; it += F.G) { const int kc = it & 7, jb = (it >> 3) & 3, kv = (it >> 5) & 1, l = it >> 6; const int j = jb * 64 + F.lane, kb = kc * 256 + 32 * F.wave;
          const float* w1 = (kv ? INP_(I_VW1) : INP_(I_KW1)) + (size_t)l * 2048 * 256; const float* pos = (kv ? INP_(I_PV) : INP_(I_PK)) + l * 2048;
          float wv[32];
#pragma unroll
          for (int k = 0; k < 32; ++k) wv[k] = w1[(size_t)(kb + k) * 256 + j];
          float sp = 0.f;
#pragma unroll
          for (int k = 0; k < 32; ++k) sp += pos[kb + k] * wv[k];
          ps[F.wave * 64 + F.lane] = sp;
          __syncthreads();
          if (F.wave == 0) { float t = (kc == 0) ? (kv ? INP_(I_VB1) : INP_(I_KB1))[l * 256 + j] : 0.f;
#pragma unroll
              for (int ww = 0; ww < 8; ++ww) t += ps[ww * 64 + F.lane];
              B1P[kc * 1024 + (l * 2 + kv) * 256 + j] = t; }
          __syncthreads(); } }
    { bf16_t* XB = (bf16_t*)(F.ws + WS_XB); float* RS = (float*)(F.ws + WS_RSTD);
      for (int m = gw; m < M; m += 4 * NGW) xprep_rows4(INP_(I_X), XB, RS, m, NGW, F.lane); }
}

__device__ __forceinline__ void norm_rows64(bf16_t* buf, int nrows, const float* g, float scale, int gw, int NGW, int lane) {
    const int sub = lane & 7; float gv[8];
#pragma unroll
    for (int j = 0; j < 8; ++j) gv[j] = g[sub * 8 + j] * scale;
    for (int it = gw; it < nrows / 8; it += NGW) { u32x4* p = (u32x4*)(buf + ((size_t)it * 8 + (lane >> 3)) * 64) + sub; const u32x4 v = *p;
        float f[8] = {bf_lo(v.x), bf_hi(v.x), bf_lo(v.y), bf_hi(v.y), bf_lo(v.z), bf_hi(v.z), bf_lo(v.w), bf_hi(v.w)}; float s = 0.f;
#pragma unroll
        for (int j = 0; j < 8; ++j) s += f[j] * f[j];
        s += __shfl_xor(s, 1); s += __shfl_xor(s, 2); s += __shfl_xor(s, 4);
        const float rs = rsqf_(s * (1.0f / 64.0f) + EPS);
        u32x4 o; o.x = cvt_pk_bf16(f[0] * rs * gv[0], f[1] * rs * gv[1]); o.y = cvt_pk_bf16(f[2] * rs * gv[2], f[3] * rs * gv[3]); o.z = cvt_pk_bf16(f[4] * rs * gv[4], f[5] * rs * gv[5]); o.w = cvt_pk_bf16(f[6] * rs * gv[6], f[7] * rs * gv[7]);
        *p = o; }
}
__device__ __forceinline__ float sum32_(float v, bool) {
    v = DPP_ADD(v, 0xB1); v = DPP_ADD(v, 0x4E); v = DPP_ADD(v, 0x124); v = DPP_ADD(v, 0x128);
    return v + __shfl_xor(v, 16);
}
__device__ __forceinline__ void conv_unit(Frame& F, int layer, int cu) {
    const int b = cu >> 6, t0 = (cu & 63) * 32; int tid = F.tid; asm volatile("" : "+v"(tid));
    const bf16_t* U = (const bf16_t*)(F.ws + WS_U); bf16_t* MIX = (bf16_t*)(F.ws + WS_MIX);
    LAS u32x4* L4 = (LAS u32x4*)F.lds;
    { u32x4 sv[8];
#pragma unroll
      for (int q = 0; q < 8; ++q) { const int i = tid + q * NTHR, row = i >> 6, ch = i & 63, t = t0 - 30 + row; sv[q] = (u32x4){0u, 0u, 0u, 0u}; if (i < 62 * 64 && t >= 0) sv[q] = *(const u32x4*)(U + (size_t)(b * SEQ + t) * CW + ch * 8); }
#pragma unroll
      for (int q = 0; q < 8; ++q) { const int i = tid + q * NTHR; if (i < 62 * 64) L4[i] = sv[q]; } }
    __syncthreads();
    const int cp = tid & 255, th = tid >> 8; const bool hi = (tid & 32) != 0; const LAS unsigned* LW = (const LAS unsigned*)F.lds;
    f32x2 w[CKW];
#pragma unroll
    for (int k = 0; k < CKW; ++k) w[k] = *(const f32x2*)(INP_(I_CDW) + (size_t)layer * CKW * CW + k * CW + 2 * cp);
    const f32x2 cb = *(const f32x2*)(INP_(I_CDB) + layer * CW + 2 * cp), lg = *(const f32x2*)(INP_(I_CLG) + layer * CW + 2 * cp), lb = *(const f32x2*)(INP_(I_CLB) + layer * CW + 2 * cp);
#pragma nounroll
    for (int hf = 0; hf < 2; ++hf) { const int tl0 = th * 16 + hf * 8;
        f32x2 in[38];
#pragma unroll
        for (int i = 0; i < 38; ++i) { const unsigned v = LW[(tl0 + i) * 256 + cp]; in[i] = (f32x2){bf_lo(v), bf_hi(v)}; }
        f32x2 acc[8];
#pragma unroll
        for (int t = 0; t < 8; ++t) { acc[t] = cb;
#pragma unroll
            for (int k = 0; k < CKW; ++k) acc[t] += w[k] * in[t + k]; }
#pragma unroll
        for (int t = 0; t < 8; ++t) {
            const float s = sum32_(acc[t].x + acc[t].y, hi), q = sum32_(acc[t].x * acc[t].x + acc[t].y * acc[t].y, hi);
            const float mu = s * (1.0f / 64.0f), var = fmaxf(q * (1.0f / 64.0f) - mu * mu, 0.f), rs = rsqf_(var + EPS);
            const float a0 = (acc[t].x - mu) * rs * lg.x + lb.x, a1 = (acc[t].y - mu) * rs * lg.y + lb.y;
            *(unsigned*)(MIX + (size_t)(b * SEQ + t0 + tl0 + t) * D + 2 * cp) = cvt_pk_bf16(siluf_(a0), siluf_(a1)); }
    }
    __syncthreads();
}
__device__ __forceinline__ void vtrans_items(Frame& F, int gw, int NGW) {
    const int lane = F.lane;
    LAS unsigned char* scr = F.lds + F.wave * 9216;
    for (int it = gw; it < 1024; it += NGW) { const int ten = it >> 9, bh = (it >> 5) & 15, kb = it & 31;
        const bf16_t* V = (const bf16_t*)(F.ws + WS_KV) + (size_t)(ten ? 5 : 3) * KVT + ((size_t)bh * SEQ + kb * 64) * 64; bf16_t* VT = (bf16_t*)(F.ws + (ten ? WS_VWT : WS_VST)) + (size_t)bh * 64 * SEQ + kb * 64;
#pragma unroll
        for (int c = 0; c < 8; ++c) *(LAS u32x4*)(scr + lane * 144 + c * 16) = *((const u32x4*)(V + (size_t)lane * 64) + c);
        LDS_WAIT(); __builtin_amdgcn_wave_barrier(); asm volatile("" ::: "memory");
#pragma unroll
        for (int c = 0; c < 8; ++c) { unsigned w[4];
#pragma unroll
            for (int q = 0; q < 4; ++q) { const int v0 = 8 * c + 2 * q, k0 = swap23(v0), k1 = swap23(v0 + 1);
                w[q] = (unsigned)*(const LAS bf16_t*)(scr + k0 * 144 + lane * 2) | ((unsigned)*(const LAS bf16_t*)(scr + k1 * 144 + lane * 2) << 16); }
            *((u32x4*)(VT + (size_t)lane * SEQ) + c) = (u32x4){w[0], w[1], w[2], w[3]}; }
        LDS_WAIT(); __builtin_amdgcn_wave_barrier(); asm volatile("" ::: "memory");
    }
}
__device__ __forceinline__ void phase_cmp2(Frame& F, int layer) {
    const int lane = F.lane, w = F.wave, k0 = 32 * w;
    const float* H1 = (const float*)(F.ws + WS_H1); const float* B1P = (const float*)(F.ws + WS_CTL) + CW_B1P + layer * 512;
    LAS float* part = (LAS float*)F.lds;
#pragma nounroll
    for (int un = F.c; un < 256; un += F.G) { const int kv = un >> 7, R0 = (un & 127) * 16;
        const float* w2 = (kv ? INP_(I_VW2) : INP_(I_KW2)) + (size_t)layer * 16384 + (size_t)k0 * 64 + lane;
        float w2r[32];
#pragma unroll
        for (int j = 0; j < 32; ++j) w2r[j] = w2[j * 64];
        float bsum = 0.f;
#pragma unroll
        for (int sp = 0; sp < 8; ++sp) bsum += B1P[sp * 1024 + kv * 256 + k0 + (lane & 31)];
        float acc[16], hx[16];
        {
            float hp[16][8];
#pragma unroll
            for (int r = 0; r < 16; ++r)
#pragma unroll
                for (int sp = 0; sp < 8; ++sp) hp[r][sp] = H1[((size_t)kv * 2048 + R0 + r) * 256 + k0 + (lane & 31) + (size_t)sp * 2 * 2048 * 256];
#pragma unroll
            for (int r = 0; r < 16; ++r) { float x = 0.f;
#pragma unroll
                for (int sp = 0; sp < 8; ++sp) x += hp[r][sp];
                hx[r] = siluf_(x + bsum); } }
#pragma unroll
        for (int r = 0; r < 16; ++r) { const int hb = __builtin_bit_cast(int, hx[r]); float a = 0.f;
#pragma unroll
            for (int j = 0; j < 32; ++j) a += __builtin_bit_cast(float, __builtin_amdgcn_readlane(hb, j)) * w2r[j];
            acc[r] = a; }
#pragma unroll
        for (int r = 0; r < 16; ++r) part[(w * 16 + r) * 64 + lane] = acc[r];
        __syncthreads();
#pragma unroll
        for (int rr = 0; rr < 2; ++rr) { const int r = 2 * w + rr, R = R0 + r;
            float a = (kv ? INP_(I_VB2) : INP_(I_KB2))[layer * 64 + lane];
#pragma unroll
            for (int ww = 0; ww < 8; ++ww) a += part[(ww * 16 + r) * 64 + lane];
            if ((R & 127) == 127) a = 0.f;
            else if (kv == 0) { const float ms = wave_sum_u(a * a) * (1.0f / 64.0f); a = a * (rsqf_(ms + EPS)) * INP_(I_KG)[layer * 192 + lane]; }
            const bf16_t ab = (bf16_t)(cvt_pk_bf16(a, 0.f) & 0xffffu);
            ((bf16_t*)(F.ws + (kv ? WS_VC : WS_KC)))[(size_t)R * 64 + lane] = ab;
            if (kv) ((bf16_t*)(F.ws + WS_VCT))[((size_t)(R >> 7) * 64 + lane) * 128 + swap23(R & 127)] = ab; }
        __syncthreads();
    }
}

__device__ __forceinline__ void dots4(const bf16_t* krow, const LAS float* qs, float (&s)[4]) {
    s[0] = s[1] = s[2] = s[3] = 0.f;
#pragma nounroll
    for (int c = 0; c < 8; ++c) { const u32x4 v = *((const u32x4*)krow + c);
        const float f[8] = {bf_lo(v.x), bf_hi(v.x), bf_lo(v.y), bf_hi(v.y), bf_lo(v.z), bf_hi(v.z), bf_lo(v.w), bf_hi(v.w)};
#pragma unroll
        for (int h = 0; h < 4; ++h) { const f32x4 q0 = *(const LAS f32x4*)(qs + h * 64 + c * 8), q1 = *(const LAS f32x4*)(qs + h * 64 + c * 8 + 4);
            s[h] += (f[0] * q0.x + f[1] * q0.y) + (f[2] * q0.z + f[3] * q0.w) + (f[4] * q1.x + f[5] * q1.y) + (f[6] * q1.z + f[7] * q1.w); } }
}
__device__ __forceinline__ void softmax_pv(LAS f32x4* sb, const LAS int* kb, int nk, const bf16_t* V, int lane, float (&o)[4]) {
    float m[4] = {-1e30f, -1e30f, -1e30f, -1e30f};
#pragma nounroll
    for (int c = 0; c < nk; ++c) { const f32x4 s = sb[c * 64 + lane]; m[0] = fmaxf(m[0], s.x); m[1] = fmaxf(m[1], s.y); m[2] = fmaxf(m[2], s.z); m[3] = fmaxf(m[3], s.w); }
#pragma unroll
    for (int h = 0; h < 4; ++h) m[h] = wave_max(m[h]);
    float sum[4] = {0.f, 0.f, 0.f, 0.f};
#pragma nounroll
    for (int c = 0; c < nk; ++c) { const f32x4 s = sb[c * 64 + lane]; f32x4 p;
        p.x = s.x > -1e29f ? __expf(s.x - m[0]) : 0.f; p.y = s.y > -1e29f ? __expf(s.y - m[1]) : 0.f; p.z = s.z > -1e29f ? __expf(s.z - m[2]) : 0.f; p.w = s.w > -1e29f ? __expf(s.w - m[3]) : 0.f;
        sum[0] += p.x; sum[1] += p.y; sum[2] += p.z; sum[3] += p.w; sb[c * 64 + lane] = p; }
    float inv[4];
#pragma unroll
    for (int h = 0; h < 4; ++h) inv[h] = rcpf_(fmaxf(wave_sum(sum[h]), 1e-30f));
    LDS_WAIT(); __builtin_amdgcn_wave_barrier(); asm volatile("" ::: "memory");
    o[0] = o[1] = o[2] = o[3] = 0.f;
#pragma nounroll
    for (int c = 0; c < nk; ++c) { const int k0 = kb[c];
#pragma unroll 4
        for (int kk = 0; kk < 64; ++kk) { int key = k0 + kk; key = key < 0 ? 0 : (key > SEQ - 1 ? SEQ - 1 : key);
            const f32x4 p = sb[c * 64 + kk]; const float v = bf2f(V[(size_t)key * 64 + lane]);
            o[0] += p.x * v; o[1] += p.y * v; o[2] += p.z * v; o[3] += p.w * v; } }
#pragma unroll
    for (int h = 0; h < 4; ++h) o[h] *= inv[h];
    __builtin_amdgcn_wave_barrier(); asm volatile("" ::: "memory");
}
__device__ __forceinline__ void phase_attn_ref(Frame& F, int layer) {
    const int lane = F.lane;
    LAS unsigned char* wl = F.lds + F.wave * 12288;
    LAS float* qs = (LAS float*)wl;
    LAS f32x4* pc = (LAS f32x4*)(wl + 1024);
    LAS float* psum = (LAS float*)(wl + 3072);
    LAS int* kbl = (LAS int*)(wl + 3584);
    LAS f32x4* sb = (LAS f32x4*)(wl + 4096);
    const bf16_t* QN = (const bf16_t*)(F.ws + WS_Q); const bf16_t* KVb = (const bf16_t*)(F.ws + WS_KV);
    const bf16_t* KC = (const bf16_t*)(F.ws + WS_KC); const bf16_t* VC = (const bf16_t*)(F.ws + WS_VC);
    const float* GT = (const float*)(F.ws + WS_GT); bf16_t* MIX = (bf16_t*)(F.ws + WS_MIX);
#pragma nounroll
    for (int un = F.c; un < NBH * 64; un += F.G) {
        const int bh = un >> 6, tile = un & 63, b = bh >> 1, kvh = bh & 1;
        const bf16_t* KS = KVb + 2 * KVT + (size_t)bh * SEQ * 64; const bf16_t* VS = KVb + 3 * KVT + (size_t)bh * SEQ * 64;
        const bf16_t* KW = KVb + 4 * KVT + (size_t)bh * SEQ * 64; const bf16_t* VW = KVb + 5 * KVT + (size_t)bh * SEQ * 64;
#pragma nounroll
        for (int ti = 0; ti < 4; ++ti) {
            const int t = tile * 32 + F.wave * 4 + ti, r = b * SEQ + t;
#pragma unroll
            for (int h = 0; h < 4; ++h) qs[h * 64 + lane] = bf2f(QN[(size_t)r * 512 + (kvh * 4 + h) * 64 + lane]);
            LDS_WAIT(); __builtin_amdgcn_wave_barrier(); asm volatile("" ::: "memory");
            float sc[2][4]; bool vc[2];
#pragma unroll
            for (int u = 0; u < 2; ++u) { const int c = lane + 64 * u; vc[u] = (c < NCMP) && (16 * c + 31 <= t);
                if (vc[u]) dots4(KC + ((size_t)bh * 128 + c) * 64, qs, sc[u]); else { sc[u][0] = sc[u][1] = sc[u][2] = sc[u][3] = -1e30f; } }
            float pr[2][4];
#pragma unroll
            for (int h = 0; h < 4; ++h) { const float mx = wave_max(fmaxf(sc[0][h], sc[1][h]));
                pr[0][h] = vc[0] ? __expf(sc[0][h] - mx) : 0.f; pr[1][h] = vc[1] ? __expf(sc[1][h] - mx) : 0.f;
                const float inv = rcpf_(fmaxf(wave_sum(pr[0][h] + pr[1][h]), 1e-30f)); pr[0][h] *= inv; pr[1][h] *= inv; }
#pragma unroll
            for (int u = 0; u < 2; ++u) { pc[lane + 64 * u] = (f32x4){pr[u][0], pr[u][1], pr[u][2], pr[u][3]}; psum[lane + 64 * u] = (pr[u][0] + pr[u][1]) + (pr[u][2] + pr[u][3]); }
            LDS_WAIT(); __builtin_amdgcn_wave_barrier(); asm volatile("" ::: "memory");
            const int j = lane & 31, cur = t >> 6; float imp = 0.f;
#pragma unroll
            for (int cc = -1; cc <= 3; ++cc) { const int c = 4 * j + cc; if (c >= 0 && c < NCMP) imp += psum[c]; }
            const bool causal = (j * 64 <= t), forced = (j == 0) || (j == cur) || (j == cur - 1);
            const float score = causal ? (forced ? imp + 1e4f : imp) : -1e30f;
            int rank = 0;
#pragma unroll
            for (int i = 0; i < 32; ++i) { const float si = __shfl(score, i); rank += (si > score || (si == score && i < j)) ? 1 : 0; }
            const unsigned selmask = (unsigned)__ballot(lane < 32 && rank < 8 && causal);
            float ocmp[4] = {0.f, 0.f, 0.f, 0.f};
            { const int nvc = t >= 31 ? (((t - 31) >> 4) + 1 > NCMP ? NCMP : ((t - 31) >> 4) + 1) : 0;
#pragma unroll 4
              for (int c = 0; c < nvc; ++c) { const f32x4 p = pc[c]; const float v = bf2f(VC[((size_t)bh * 128 + c) * 64 + lane]); ocmp[0] += p.x * v; ocmp[1] += p.y * v; ocmp[2] += p.z * v; ocmp[3] += p.w * v; } }
            __builtin_amdgcn_wave_barrier(); asm volatile("" ::: "memory");
            int nk = 0; float osel[4], owin[4];
#pragma nounroll
            for (unsigned mm = selmask; mm != 0u && nk < 8; mm &= mm - 1u) { const int jj = __builtin_ctz(mm);
                const int key = jj * 64 + lane; float s[4];
                if (key <= t) dots4(KS + (size_t)key * 64, qs, s); else { s[0] = s[1] = s[2] = s[3] = -1e30f; }
                sb[nk * 64 + lane] = (f32x4){s[0], s[1], s[2], s[3]};
                if (lane == 0) kbl[nk] = jj * 64;
                ++nk; }
            LDS_WAIT(); __builtin_amdgcn_wave_barrier(); asm volatile("" ::: "memory");
            softmax_pv(sb, kbl, nk, VS, lane, osel);
            nk = 0;
#pragma nounroll
            for (int ch = 0; ch < 8; ++ch) { const int k0 = t - 511 + 64 * ch; if (k0 + 63 < 0) continue;
                const int key = k0 + lane; float s[4];
                if (key >= 0) dots4(KW + (size_t)key * 64, qs, s); else { s[0] = s[1] = s[2] = s[3] = -1e30f; }
                sb[nk * 64 + lane] = (f32x4){s[0], s[1], s[2], s[3]};
                if (lane == 0) kbl[nk] = k0;
                ++nk; }
            LDS_WAIT(); __builtin_amdgcn_wave_barrier(); asm volatile("" ::: "memory");
            softmax_pv(sb, kbl, nk, VW, lane, owin);
#pragma unroll
            for (int h = 0; h < 4; ++h) { const float* gp = GT + (size_t)r * 24 + (kvh * 4 + h) * 3;
                const float o = sigmoidf_(gp[0]) * ocmp[h] + sigmoidf_(gp[1]) * osel[h] + sigmoidf_(gp[2]) * owin[h];
                MIX[(size_t)r * D + 512 + (kvh * 4 + h) * 64 + lane] = (bf16_t)(cvt_pk_bf16(o, 0.f) & 0xffffu); }
            __builtin_amdgcn_wave_barrier(); asm volatile("" ::: "memory");
        }
    }
}


constexpr int AT_KB = 0, AT_VB = 18432, AT_WUN = 36864, AT_OT = 40960;
__device__ __forceinline__ int crow_(int i) { return (i & 3) + 8 * (i >> 2); }
__device__ __forceinline__ float fmax_(float a, float b) { return __builtin_amdgcn_fmed3f(a, b, __builtin_inff()); }
template <int MODE>
__device__ __forceinline__ void attn_tile(const LAS unsigned char* KB, const LAS unsigned char* VB, const bf16x8 (&Qf)[4], f32x16 (&O)[2], float cref, float& l, int tl, int lo, bool rowok, int n, int h) {
    f32x16 S0, S1;
#pragma unroll
    for (int i = 0; i < 16; ++i) { S0[i] = 0.f; S1[i] = 0.f; }
#pragma unroll
    for (int s = 0; s < 4; ++s) { const bf16x8 k0 = *(const LAS bf16x8*)(KB + n * 144 + (16 * s + 8 * h) * 2), k1 = *(const LAS bf16x8*)(KB + (32 + n) * 144 + (16 * s + 8 * h) * 2);
        S0 = MFMA32(k0, Qf[s], S0); S1 = MFMA32(k1, Qf[s], S1); }
    if (MODE != 0) {
#pragma unroll
        for (int i = 0; i < 16; ++i) { const int c0 = crow_(i), c1 = 32 + crow_(i);
            if (MODE == 1) { S0[i] = rowok ? S0[i] : -1e30f; S1[i] = rowok ? S1[i] : -1e30f; }
            if (MODE == 2) { S0[i] = (c0 <= tl && c0 > lo) ? S0[i] : -1e30f; S1[i] = (c1 <= tl && c1 > lo) ? S1[i] : -1e30f; } } }
    f32x2 ls2 = {0.f, 0.f}; const f32x2 mr2 = {cref, cref};
#pragma unroll
    for (int i = 0; i < 8; ++i) { f32x2 a = (f32x2){S0[2 * i], S0[2 * i + 1]} - mr2, b = (f32x2){S1[2 * i], S1[2 * i + 1]} - mr2;
        a.x = __builtin_amdgcn_exp2f(a.x); a.y = __builtin_amdgcn_exp2f(a.y); b.x = __builtin_amdgcn_exp2f(b.x); b.y = __builtin_amdgcn_exp2f(b.y);
        S0[2 * i] = a.x; S0[2 * i + 1] = a.y; S1[2 * i] = b.x; S1[2 * i + 1] = b.y; ls2 += a + b; }
    l += ls2.x + ls2.y;
    const bf16x8 P00 = pack8<0>(S0), P01 = pack8<8>(S0), P10 = pack8<0>(S1), P11 = pack8<8>(S1);
    __builtin_amdgcn_sched_barrier(0);
#pragma unroll
    for (int d = 0; d < 2; ++d) { const LAS unsigned char* vb = VB + (32 * d + n) * 144 + 8 * h * 2;
        O[d] = MFMA32(*(const LAS bf16x8*)(vb + 0), P00, O[d]); O[d] = MFMA32(*(const LAS bf16x8*)(vb + 32), P01, O[d]);
        O[d] = MFMA32(*(const LAS bf16x8*)(vb + 64), P10, O[d]); O[d] = MFMA32(*(const LAS bf16x8*)(vb + 96), P11, O[d]); }
}
__device__ __forceinline__ void attn_stage64(LAS unsigned char* lds, const bf16_t* K, const bf16_t* VT, int tid) {
    const int row = tid >> 3, ch = tid & 7;
    const u32x4 kv = *((const u32x4*)K + tid), vv = *(const u32x4*)(VT + (size_t)row * SEQ + ch * 8);
    *(LAS u32x4*)(lds + AT_KB + row * 144 + ch * 16) = kv; *(LAS u32x4*)(lds + AT_VB + row * 144 + ch * 16) = vv;
}
__device__ __forceinline__ void phase_attn_mfma(Frame& F, int layer) {
    const int lane = F.lane, tid = F.tid, n = lane & 31, h = lane >> 5, w = F.wave;
    LAS unsigned char* lds = F.lds; const LAS unsigned char* KB = lds + AT_KB; const LAS unsigned char* VB = lds + AT_VB; volatile LAS unsigned* WUN = (volatile LAS unsigned*)(lds + AT_WUN);
    const bf16_t* QN = (const bf16_t*)(F.ws + WS_Q); const bf16_t* KVb = (const bf16_t*)(F.ws + WS_KV);
    const bf16_t* KC = (const bf16_t*)(F.ws + WS_KC); const bf16_t* VCT = (const bf16_t*)(F.ws + WS_VCT);
    const bf16_t* VST = (const bf16_t*)(F.ws + WS_VST); const bf16_t* VWT = (const bf16_t*)(F.ws + WS_VWT);
    const float* GT = (const float*)(F.ws + WS_GT); bf16_t* MIX = (bf16_t*)(F.ws + WS_MIX);
    float cref;
    { const float gq = fabsf(INP_(I_QG)[layer * 64 + lane]); const float* kg = INP_(I_KG) + layer * 192;
      const float gk = fmaxf(fabsf(kg[lane]), fmaxf(fabsf(kg[64 + lane]), fabsf(kg[128 + lane])));
      const float bound = 1.44269504089f * 8.0f * wave_max(gq) * wave_max(gk); cref = fmaxf(bound - 16.0f, 0.f); }
#pragma nounroll
    for (int ui = 0; ui < 2; ++ui) {
        const int bh = (F.c >> 5) + 8 * ui, tb = ui ? 31 - (F.c & 31) : (F.c & 31);
        if (F.c >= 256) break;
        const int b = bh >> 1, kvh = bh & 1, t0 = tb * 64, cur = tb;
        const int tt = t0 + 8 * w + (n >> 2), hd = n & 3; const size_t r = (size_t)b * SEQ + tt;
        bf16x8 Qf[4]; { const bf16_t* qp = QN + r * 512 + (kvh * 4 + hd) * 64 + 8 * h;
#pragma unroll
            for (int s = 0; s < 4; ++s) Qf[s] = *(const bf16x8*)(qp + 16 * s); }
        {
            float qv[4][8]; float ss = 0.f;
#pragma unroll
            for (int s = 0; s < 4; ++s) { const u32x4 wq = __builtin_bit_cast(u32x4, Qf[s]);
                qv[s][0] = bf_lo(wq.x); qv[s][1] = bf_hi(wq.x); qv[s][2] = bf_lo(wq.y); qv[s][3] = bf_hi(wq.y); qv[s][4] = bf_lo(wq.z); qv[s][5] = bf_hi(wq.z); qv[s][6] = bf_lo(wq.w); qv[s][7] = bf_hi(wq.w);
#pragma unroll
                for (int j = 0; j < 8; ++j) ss += qv[s][j] * qv[s][j]; }
            ss += __shfl_xor(ss, 32);
            const float rsq = rsqf_(ss * (1.0f / 64.0f) + EPS) * (0.125f * 1.44269504089f); const float* qg     = INP_(I_QG) + layer * 64 + 8 * h;
#pragma unroll
            for (int s = 0; s < 4; ++s) { const f32x4 ga = *(const f32x4*)(qg + 16 * s), gb = *(const f32x4*)(qg + 16 * s + 4);
                u32x4 wq; wq.x = pk_bf16(qv[s][0] * rsq * ga.x, qv[s][1] * rsq * ga.y); wq.y = pk_bf16(qv[s][2] * rsq * ga.z, qv[s][3] * rsq * ga.w);
                wq.z = pk_bf16(qv[s][4] * rsq * gb.x, qv[s][5] * rsq * gb.y); wq.w = pk_bf16(qv[s][6] * rsq * gb.z, qv[s][7] * rsq * gb.w); Qf[s] = __builtin_bit_cast(bf16x8, wq); } }
        const float* gp = GT + r * 24 + (kvh * 4 + hd) * 3; const float g0 = sigmoidf_(gp[0]), g1 = sigmoidf_(gp[1]), g2 = sigmoidf_(gp[2]);
        f32x16 Ob[2]; LAS f32x4* OT = (LAS f32x4*)(lds + AT_OT + w * 8192) + lane;
        unsigned tokmask, wmask;
        __syncthreads();
#pragma unroll
        for (int q = 0; q < 2; ++q) { const int i = tid + 512 * q;
            *(LAS u32x4*)(lds + AT_KB + (i >> 3) * 144 + (i & 7) * 16) = *((const u32x4*)(KC + (size_t)bh * 128 * 64) + i);
            *(LAS u32x4*)(lds + AT_VB + (i >> 4) * 272 + (i & 15) * 16) = *((const u32x4*)(VCT + (size_t)bh * 64 * 128) + i); }
        __syncthreads();
        {
            f32x16 S[4];
#pragma unroll
            for (int ta = 0; ta < 4; ++ta) {
#pragma unroll
                for (int i = 0; i < 16; ++i) S[ta][i] = 0.f;
#pragma unroll
                for (int s = 0; s < 4; ++s) S[ta] = MFMA32(*(const LAS bf16x8*)(KB + (32 * ta + n) * 144 + (16 * s + 8 * h) * 2), Qf[s], S[ta]); }
            const int cmax = tt >= 31 ? (((tt - 31) >> 4) > 126 ? 126 : ((tt - 31) >> 4)) : -1, lim = cmax - 4 * h;
            float ls = 0.f;
#pragma unroll
            for (int ta = 0; ta < 4; ++ta)
#pragma unroll
                for (int i = 0; i < 16; ++i) { const float p = (32 * ta + crow_(i) <= lim) ? __builtin_amdgcn_exp2f(S[ta][i] - cref) : 0.f; S[ta][i] = p; ls += p; }
            ls += __shfl_xor(ls, 32);
            const float inv = rcpf_(fmaxf(ls, 1e-30f));
#pragma unroll
            for (int ta = 0; ta < 4; ++ta)
#pragma unroll
                for (int i = 0; i < 16; ++i) S[ta][i] *= inv;
            float val[4][4]; unsigned kk[4];
#pragma unroll
            for (int ta = 0; ta < 4; ++ta)
#pragma unroll
                for (int u = 0; u < 4; ++u) { val[ta][u] = (S[ta][4 * u] + S[ta][4 * u + 1]) + (S[ta][4 * u + 2] + S[ta][4 * u + 3]); }
            {   float xs[4][4];
#pragma unroll
                for (int ta = 0; ta < 4; ++ta)
#pragma unroll
                    for (int u = 0; u < 4; ++u) xs[ta][u] = __shfl_xor(S[ta][4 * u + 3], 32);
#pragma unroll
                for (int ta = 0; ta < 4; ++ta)
#pragma unroll
                    for (int u = 0; u < 4; ++u) { const float pv0 = (u > 0) ? xs[ta][u > 0 ? u - 1 : 0] : (ta > 0 ? xs[ta > 0 ? ta - 1 : 0][3] : 0.f); val[ta][u] += (h ? xs[ta][u] : pv0); } }
            const bf16x8 P0 = pack8<0>(S[0]), P1 = pack8<8>(S[0]), P2 = pack8<0>(S[1]), P3 = pack8<8>(S[1]), P4 = pack8<0>(S[2]), P5 = pack8<8>(S[2]), P6 = pack8<0>(S[3]), P7 = pack8<8>(S[3]);
            __builtin_amdgcn_sched_barrier(0);
            const bool b0 = (n & 1) != 0, b1 = (n & 2) != 0; const int hd2 = 2 * (n & 3) + h;
#define DPPF(x, ctrl) __builtin_bit_cast(float, __builtin_amdgcn_update_dpp(0, __builtin_bit_cast(int, (x)), (ctrl), 0xF, 0xF, true))
#define DPPU(x, ctrl) ((unsigned)__builtin_amdgcn_update_dpp(0, (int)(x), (ctrl), 0xF, 0xF, true))
#pragma unroll
            for (int ta = 0; ta < 4; ++ta) {
                const float m0 = b0 ? val[ta][1] : val[ta][0], s0 = b0 ? val[ta][0] : val[ta][1], m1 = b0 ? val[ta][3] : val[ta][2], s1 = b0 ? val[ta][2] : val[ta][3];
                const float r0 = m0 + DPPF(s0, 0xB1), r1 = m1 + DPPF(s1, 0xB1);
                const float mm = b1 ? r1 : r0, ss = b1 ? r0 : r1; const float v = mm + DPPF(ss, 0x4E);
                const int G = 8 * ta + hd2; const bool causal = G <= cur, forced = (G == 0) || (G == cur) || (G == cur - 1);
                kk[ta] = causal ? ((forced ? 0x7f000000u : (__float_as_uint(v) & ~31u)) | (unsigned)(31 - G)) : 0u; }
            __builtin_amdgcn_sched_barrier(0);
#pragma unroll
            for (int d = 0; d < 2; ++d) {
#pragma unroll
                for (int i = 0; i < 16; ++i) Ob[d][i] = 0.f;
                const LAS unsigned char* vb = VB + (32 * d + n) * 272 + 8 * h * 2;
                Ob[d] = MFMA32(*(const LAS bf16x8*)(vb + 0), P0, Ob[d]); Ob[d] = MFMA32(*(const LAS bf16x8*)(vb + 32), P1, Ob[d]);
                Ob[d] = MFMA32(*(const LAS bf16x8*)(vb + 64), P2, Ob[d]); Ob[d] = MFMA32(*(const LAS bf16x8*)(vb + 96), P3, Ob[d]);
                Ob[d] = MFMA32(*(const LAS bf16x8*)(vb + 128), P4, Ob[d]); Ob[d] = MFMA32(*(const LAS bf16x8*)(vb + 160), P5, Ob[d]);
                Ob[d] = MFMA32(*(const LAS bf16x8*)(vb + 192), P6, Ob[d]); Ob[d] = MFMA32(*(const LAS bf16x8*)(vb + 224), P7, Ob[d]);
#pragma unroll
                for (int q = 0; q < 4; ++q) OT[(4 * d + q) * 64] = (f32x4){Ob[d][4 * q] * g0, Ob[d][4 * q + 1] * g0, Ob[d][4 * q + 2] * g0, Ob[d][4 * q + 3] * g0}; }
            __builtin_amdgcn_sched_barrier(0);
            unsigned selbits = 0u;
#pragma unroll
            for (int rd = 0; rd < 8; ++rd) { unsigned mk = kk[0] > kk[1] ? kk[0] : kk[1]; { const unsigned m2 = kk[2] > kk[3] ? kk[2] : kk[3]; mk = m2 > mk ? m2 : mk; }
                { const unsigned o = DPPU(mk, 0xB1); mk = o > mk ? o : mk; } { const unsigned o = DPPU(mk, 0x4E); mk = o > mk ? o : mk; }
                { const unsigned o = (unsigned)__shfl_xor((int)mk, 32); mk = o > mk ? o : mk; }
#pragma unroll
                for (int ta = 0; ta < 4; ++ta) { const bool hit = (kk[ta] == mk) && (mk != 0u); selbits |= hit ? ((1u << (8 * ta)) << hd2) : 0u; kk[ta] = hit ? 0u : kk[ta]; } }
            selbits |= DPPU(selbits, 0xB1); selbits |= DPPU(selbits, 0x4E);
            tokmask = selbits | (unsigned)__shfl_xor((int)selbits, 32);
#undef DPPF
#undef DPPU
            unsigned wm = tokmask; wm |= (unsigned)__shfl_xor((int)wm, 4); wm |= (unsigned)__shfl_xor((int)wm, 8); wm |= (unsigned)__shfl_xor((int)wm, 16);
            wmask = (unsigned)__builtin_amdgcn_readfirstlane((int)wm);
            if (lane == 0) WUN[w] = wmask;
        }
        __syncthreads();
        unsigned uall = 0u;
#pragma unroll
        for (int q = 0; q < 8; ++q) uall |= WUN[q];
        uall = (unsigned)__builtin_amdgcn_readfirstlane((int)uall);
        if (PROBE_MASK & 0x6000000u) { if (lane == 0) ((unsigned*)(F.ws + WS_SLOT + 3 * MAXSLOT * 4))[(blockIdx.x * 2 + ui) * 8 + w] = (unsigned)__builtin_popcount(uall) | ((unsigned)__builtin_popcount(wmask) << 8); }
        float l = 0.f;
#pragma unroll
        for (int d = 0; d < 2; ++d)
#pragma unroll
            for (int i = 0; i < 16; ++i) Ob[d][i] = 0.f;
        const int j0 = cur > 8 ? cur - 8 : 0, nwin = cur - j0 + 1, ntile = nwin + __builtin_popcount(uall);
        const int srow = tid >> 3, sch = tid & 7;
        int lidx = 0, cidx = 0; unsigned lmm = uall, cmm = uall; u32x4 rk0, rv0, rk1, rv1, rk2, rv2;
#define AT_NEXT(idx, mm, wh, jj) do { if ((idx) < nwin) { (wh) = 1; (jj) = j0 + (idx); } else { (wh) = 0; (jj) = (mm) ? __builtin_ctz(mm) : 0; (mm) &= (mm) - 1u; } ++(idx); } while (0)
#define AT_LOAD(rk, rv) do { int _wh, _jj; AT_NEXT(lidx, lmm, _wh, _jj); const bf16_t* _kp = KVb + (size_t)(_wh ? 4 : 2) * KVT + ((size_t)bh * SEQ + _jj * 64) * 64; const bf16_t* _vp = (_wh ? VWT : VST) + (size_t)bh * 64 * SEQ + _jj * 64; \
        rk = *((const u32x4*)_kp + tid); rv = *(const u32x4*)(_vp + (size_t)srow * SEQ + sch * 8); } while (0)
#define AT_WRITE(b, rk, rv) do { *(LAS u32x4*)(lds + (b) * 18432 + srow * 144 + sch * 16) = rk; *(LAS u32x4*)(lds + (b) * 18432 + 9216 + srow * 144 + sch * 16) = rv; } while (0)
        AT_LOAD(rk0, rv0); AT_LOAD(rk1, rv1); AT_LOAD(rk2, rv2);
        AT_WRITE(0, rk0, rv0);
        AT_LOAD(rk0, rv0);
#define AT_STEP(i, RK, RV) do { asm volatile("s_waitcnt lgkmcnt(0)" ::: "memory"); __builtin_amdgcn_s_barrier(); asm volatile("" ::: "memory"); \
            AT_WRITE(((i) + 1) & 1, RK, RV); AT_LOAD(RK, RV); \
            int wh, j; AT_NEXT(cidx, cmm, wh, j); \
            if (i == nwin) { \
                const float lt = l + __shfl_xor(l, 32), sc = g2 * rcpf_(fmaxf(lt, 1e-30f)); \
_Pragma("unroll") \
                for (int d = 0; d < 2; ++d) \
_Pragma("unroll") \
                    for (int q = 0; q < 4; ++q) { f32x4 o = OT[(4 * d + q) * 64]; o.x += Ob[d][4 * q] * sc; o.y += Ob[d][4 * q + 1] * sc; o.z += Ob[d][4 * q + 2] * sc; o.w += Ob[d][4 * q + 3] * sc; OT[(4 * d + q) * 64] = o; \
                        Ob[d][4 * q] = 0.f; Ob[d][4 * q + 1] = 0.f; Ob[d][4 * q + 2] = 0.f; Ob[d][4 * q + 3] = 0.f; } \
                l = 0.f; } \
            const LAS unsigned char* kb = lds + (i & 1) * 18432; const LAS unsigned char* vb = kb + 9216; \
            const int tl = tt - 64 * j - 4 * h; \
            if (wh) { if (j == cur || j == cur - 8) attn_tile<2>(kb, vb, Qf, Ob, cref, l, tl, j == cur - 8 ? tl - 512 : -100000, true, n, h); else attn_tile<0>(kb, vb, Qf, Ob, cref, l, 0, 0, true, n, h); } \
            else if ((wmask >> j) & 1u) { const bool rowok = ((tokmask >> j) & 1u) != 0u; \
                if (j == cur) attn_tile<2>(kb, vb, Qf, Ob, cref, l, rowok ? tl : -1, -100000, true, n, h); else attn_tile<1>(kb, vb, Qf, Ob, cref, l, 0, 0, rowok, n, h); } \
        } while (0)
#pragma nounroll
        for (int i = 0; i < ntile; i += 3) { AT_STEP(i, rk1, rv1); if (i + 1 >= ntile) break; AT_STEP(i + 1, rk2, rv2); if (i + 2 >= ntile) break; AT_STEP(i + 2, rk0, rv0); }
#undef AT_STEP
#undef AT_NEXT
#undef AT_LOAD
#undef AT_WRITE
        { const float lt = l + __shfl_xor(l, 32), sc = g1 * rcpf_(fmaxf(lt, 1e-30f));
          bf16_t* op = MIX + r * D + 512 + (kvh * 4 + hd) * 64 + 4 * h;
#pragma unroll
          for (int d = 0; d < 2; ++d)
#pragma unroll
            for (int u = 0; u < 4; ++u) { const f32x4 o = OT[(4 * d + u) * 64]; u32x2 ov; ov.x = pk_bf16(o.x + Ob[d][4 * u] * sc, o.y + Ob[d][4 * u + 1] * sc); ov.y = pk_bf16(o.z + Ob[d][4 * u + 2] * sc, o.w + Ob[d][4 * u + 3] * sc);
                *(u32x2*)(op + 32 * d + 8 * u) = ov; } }
    }
}

__device__ __forceinline__ int build_ptab(Frame& F) {
    LAS int* ptab = (LAS int*)(F.lds + PTAB_OFF);
    const unsigned* cnt = (const unsigned*)(F.ws + WS_CTL) + CW_CNT;
    if (F.tid < 64) {
        const int e = F.tid; const unsigned c = (e < NE) ? __hip_atomic_load(cnt + 64 * e, __ATOMIC_RELAXED, __HIP_MEMORY_SCOPE_AGENT) : 0u;
        const int n = (int)((c + 255u) >> 8); int incl = n;
#pragma unroll
        for (int o = 1; o < 8; o <<= 1) { const int t = __shfl_up(incl, o); if (e >= o) incl += t; }
        const int excl = incl - n;
        if (e < NE) { ptab[MAXPAN + 8 + e] = excl * 256; for (int i = 0; i < n && excl + i < MAXPAN; ++i) ptab[excl + i] = e; }
        if (e == NE - 1) ptab[MAXPAN] = incl < MAXPAN ? incl : MAXPAN; }
    __syncthreads();
    return ptab[MAXPAN];
}

template <unsigned KM> __global__ void __launch_bounds__(NTHR, 2) fwd(Args args) {
    extern __shared__ __attribute__((aligned(16))) unsigned char lds_raw[];
    Frame F; F.lds = (LAS unsigned char*)lds_raw; F.tid = threadIdx.x; F.lane = F.tid & 63; F.wave = __builtin_amdgcn_readfirstlane(F.tid >> 6);
    F.G = gridDim.x; F.c = blockIdx.x; F.in = args.in; F.out = args.out; F.ws = args.ws;
    volatile LAS unsigned* MISC = (volatile LAS unsigned*)(F.lds + MISC_OFF);
    if (F.tid < 64) MISC[F.tid] = 0u;
    __syncthreads();
    unsigned* ctl = (unsigned*)(F.ws + WS_CTL);
#if MK_PER_PHASE
#define SEAM() do {} while (0)
#else
    XcdBarrier bar = xcd_barrier_post(ctl + CW_BAR, MISC);
#define SEAM() xcd_barrier(bar)
#endif
    const int lo = args.ph_lo, hi = args.ph_hi;
#define KON(kind) (((KM) >> (kind)) & 1u)
#define IN(k) (lo <= (k) && (k) < hi)
#define gw (F.c * NWAVES + F.wave)
#define NGW (F.G * NWAVES)
#define XB ((bf16_t*)(F.ws + WS_XB))
#define RS ((float*)(F.ws + WS_RSTD))

    if (KON(0) && IN(0)) { FRESH_TID(F); PMARK(0); phase_prologue(F); SEAM(); }

    for (int layer = 0; layer < 2; ++layer) {
        const int pb = 1 + 12 * layer;
        if (KON(1) && IN(pb + 0)) { FRESH_TID(F); PMARK(pb + 0);
            pg8::Gemm g{XB, (const bf16_t*)(F.ws + WS_WIN) + (size_t)layer * INP * D, D, D, D}; pg8::SchedGrid S; S.init(M / 256, INP / 256, F.G, F.c, D, D);
            EpiIn E{RS, (bf16_t*)(F.ws + WS_U), (bf16_t*)(F.ws + WS_Q), (bf16_t*)(F.ws + WS_KV), (float*)(F.ws + WS_GT), layer ? (const float*)(F.ws + WS_PSS) : nullptr, (LAS float*)(F.lds + RSL_OFF)};
            pg8::gemm_phase(F.lds, g, S, E); moe_conv_slot(F, layer == 0 ? 0 : 2); SEAM();
        }
        if (KON(2) && IN(pb + 1)) { FRESH_TID(F); PMARK(pb + 1);
            { pg8::Gemm g{(const bf16_t*)(F.ws + WS_KV), (const bf16_t*)(F.ws + WS_WC1), 256, 1024, 2048}; SchedCmp S{F.G, F.c, layer};
              EpiH1 E{(float*)(F.ws + WS_H1)}; pg8::gemm_phase(F.lds, g, S, E); }
            if (F.G >= 256) { if (F.c >= 128) vtrans_items(F, (F.c - 128) * NWAVES + F.wave, (F.G - 128) * NWAVES); }
            else vtrans_items(F, gw, NGW);
#ifdef ATTN_REF
            norm_rows64((bf16_t*)(F.ws + WS_Q), M * 8, INP_(I_QG) + layer * 64, 0.125f, gw, NGW, F.lane);
#endif
            norm_rows64((bf16_t*)(F.ws + WS_KV) + 2 * KVT, NBH * SEQ, INP_(I_KG) + layer * 192 + 64, 1.0f, gw, NGW, F.lane);
            norm_rows64((bf16_t*)(F.ws + WS_KV) + 4 * KVT, NBH * SEQ, INP_(I_KG) + layer * 192 + 128, 1.0f, gw, NGW, F.lane);
            SEAM();
        }
        if (KON(3) && IN(pb + 2)) { FRESH_TID(F); PMARK(pb + 2); for (int cu = F.c; cu < 512; cu += F.G) conv_unit(F, layer, cu); PMARK(30); phase_cmp2(F, layer); SEAM(); }
#ifndef ATTN_REF
        if (KON(4) && IN(pb + 3)) { FRESH_TID(F); PMARK(pb + 3); phase_attn_mfma(F, layer); SEAM(); }
#else
        if (KON(4) && IN(pb + 3)) { FRESH_TID(F); PMARK(pb + 3); phase_attn_ref(F, layer); SEAM(); }
#endif
        if (KON(5) && IN(pb + 4)) { FRESH_TID(F); PMARK(pb + 4);
            pg8::Gemm g{(const bf16_t*)(F.ws + WS_MIX), (const bf16_t*)(F.ws + WS_WOUT) + (size_t)layer * D * D, D, D, D}; pg8::SchedGrid S; S.init(M / 256, D / 256, F.G, F.c, D, D);
            { EpiRes<true> E{XB, XB, layer == 0 ? (float*)(F.ws + WS_PSS) : nullptr}; pg8::gemm_phase(F.lds, g, S, E); }
            SEAM();
        }
        if (KON(6) && IN(pb + 5) && layer == 1) { FRESH_TID(F); PMARK(pb + 5);
            f32x4 v[4];
            {
                const float* RT = (const float*)(F.ws + WS_RT); unsigned* cnt = ctl + CW_CNT; int* ROUTE = (int*)(F.ws + WS_ROUTE);
                int* stok = (int*)(F.ws + WS_SLOT);
                const int cb0 = __builtin_amdgcn_readfirstlane((int)blockIdx.x * NTHR);
#pragma nounroll
                for (int i = cb0 + F.tid; i < MAXSLOT; i += F.G * NTHR) stok[i] = -1;
                LAS f32x4* RTL = (LAS f32x4*)F.lds;
                { f32x4 sv[4];
#pragma unroll
                  for (int q = 0; q < 4; ++q) sv[q] = *((const f32x4*)RT + F.tid + q * NTHR);
#pragma unroll
                  for (int q = 0; q < 4; ++q) RTL[F.tid + q * NTHR] = sv[q]; }
                __syncthreads();
#pragma nounroll
                for (int mb0 = 0; mb0 < M; mb0 += 8 * NGW) { const int mb = mb0 + gw;
                    int me0 = -1, me1 = -1; float mw0 = 0.f, mw1 = 0.f;
#pragma nounroll
                    for (int i4 = 0; i4 < 8; i4 += 4) {
                        f32x4 xv[4][4];
#pragma unroll
                        for (int q = 0; q < 4; ++q) { const int m = mb + (i4 + q) * NGW; const u32x2* xr = (const u32x2*)(XB + (size_t)(m < M ? m : 0) * D) + F.lane;
#pragma unroll
                            for (int j = 0; j < 4; ++j) { const u32x2 wv = xr[64 * j]; xv[q][j] = (f32x4){bf_lo(wv.x), bf_hi(wv.x), bf_lo(wv.y), bf_hi(wv.y)}; } }
#pragma unroll
                        for (int q = 0; q < 4; ++q) { const int i = i4 + q, m = mb + i * NGW; if (m >= M) break;
                            f32x2e ss2 = {0.f, 0.f};
#pragma unroll
                            for (int j = 0; j < 4; ++j) { const f32x2e xl = LO2(xv[q][j]), xh = HI2(xv[q][j]); ss2 = __builtin_elementwise_fma(xl, xl, ss2); ss2 = __builtin_elementwise_fma(xh, xh, ss2); }
                            const float rs = rsqf_(wave_sum_u(ss2.x + ss2.y) * (1.0f / D) + EPS);
                            if (F.lane == 0) RS[m] = rs;
                            float lg[8];
#pragma unroll
                            for (int e = 0; e < 8; ++e) { f32x2e sd2 = {0.f, 0.f};
#pragma unroll
                                for (int j = 0; j < 4; ++j) { const f32x4 wv = RTL[e * 256 + 64 * j + F.lane]; sd2 = __builtin_elementwise_fma(LO2(xv[q][j]), LO2(wv), sd2); sd2 = __builtin_elementwise_fma(HI2(xv[q][j]), HI2(wv), sd2); }
                                lg[e] = wave_sum_u(sd2.x + sd2.y); }
                            int e0 = 0; float l0 = lg[0];
#pragma unroll
                            for (int e = 1; e < 8; ++e) if (lg[e] > l0) { l0 = lg[e]; e0 = e; }
                            int e1 = -1; float l1 = -3.0e38f;
#pragma unroll
                            for (int e = 0; e < 8; ++e) if (e != e0 && lg[e] > l1) { l1 = lg[e]; e1 = e; }
                            const float p1 = __expf((l1 - l0) * rs), w0 = rcpf_(1.0f + p1), w1 = p1 * w0;
                            if (F.lane == i) { me0 = e0; me1 = e1; mw0 = w0; mw1 = w1; } } }
                    int r0 = 0, r1 = 0, c_mine = 0; const unsigned long long low = (1ull << F.lane) - 1ull;
#pragma unroll
                    for (int e = 0; e < 8; ++e) { const unsigned long long b0 = __ballot(me0 == e), b1 = __ballot(me1 == e);
                        if (me0 == e) r0 = __popcll(b0 & low) + __popcll(b1 & low); if (me1 == e) r1 = __popcll(b0 & low) + __popcll(b1 & low);
                        if (F.lane == e) c_mine = __popcll(b0) + __popcll(b1); }
                    LAS int* WC = (LAS int*)(F.lds + 32768);
                    if (F.lane < 8) WC[F.wave * 8 + F.lane] = c_mine;
                    __syncthreads();
                    if (F.wave == 0 && F.lane < 8) { int tot = 0;
#pragma unroll
                        for (int ww = 0; ww < 8; ++ww) tot += WC[ww * 8 + F.lane];
                        WC[64 + F.lane] = tot > 0 ? (int)atomicAdd(cnt + 64 * F.lane, (unsigned)tot) : 0; }
                    __syncthreads();
                    int basev = 0;
                    if (F.lane < 8) { basev = WC[64 + F.lane];
#pragma unroll
                        for (int ww = 0; ww < 8; ++ww) basev += (ww < F.wave) ? WC[ww * 8 + F.lane] : 0; }
                    __syncthreads();
                    const int b0v = __shfl(basev, me0 < 0 ? 0 : me0), b1v = __shfl(basev, me1 < 0 ? 0 : me1);
                    if (me0 >= 0) { const int m = mb + F.lane * NGW; int* rp = ROUTE + (size_t)m * 6; rp[0] = me0; rp[1] = b0v + r0; rp[2] = me1; rp[3] = b1v + r1; rp[4] = __float_as_int(mw0); rp[5] = __float_as_int(mw1); }
                }
            }
            SEAM();
        }
        if (layer == 0) {
            if (KON(7) && IN(pb + 6)) { FRESH_TID(F); PMARK(pb + 6);
                pg8::Gemm g{XB, (const bf16_t*)(F.ws + WS_WF1), D, D, D}; pg8::SchedGrid S; S.init(M / 256, 2 * DFF / 256, F.G, F.c, D, D);
                EpiGlu E{RS, (bf16_t*)(F.ws + WS_ACT), DFF, 0, (const float*)(F.ws + WS_PSS), (LAS float*)(F.lds + RSL_OFF)}; pg8::gemm_phase(F.lds, g, S, E); moe_conv_slot(F, 1); SEAM();
            }
            if (KON(8) && IN(pb + 7)) { FRESH_TID(F); PMARK(pb + 7);
                pg8::Gemm g{(const bf16_t*)(F.ws + WS_ACT), (const bf16_t*)(F.ws + WS_WF2), DFF, DFF, DFF}; pg8::SchedGrid S; S.init(M / 256, D / 256, F.G, F.c, DFF, DFF);
                EpiRes<true> E{XB, XB, (float*)(F.ws + WS_PSS)}; pg8::gemm_phase(F.lds, g, S, E); SEAM();
            }
        } else {
            if (KON(10) && IN(pb + 6)) { FRESH_TID(F); PMARK(pb + 6);
                build_ptab(F); const LAS int* ptab = (const LAS int*)(F.lds + PTAB_OFF);
                const int* ROUTE = (const int*)(F.ws + WS_ROUTE); int* stok = (int*)(F.ws + WS_SLOT); float* sw = (float*)(stok + MAXSLOT); float* srs = sw + MAXSLOT; unsigned char* XS8 = F.ws + WS_XS;
#pragma nounroll
                for (int mb = gw; mb < M; mb += 4 * NGW) {
                    int rt[4][6]; u32x4 ra[4], rb[4];
#pragma unroll
                    for (int q = 0; q < 4; ++q) { const int m = mb + q * NGW < M ? mb + q * NGW : 0; const int* rp = ROUTE + (size_t)m * 6;
#pragma unroll
                        for (int z = 0; z < 6; ++z) rt[q][z] = rp[z];
                        const u32x4* src = (const u32x4*)(XB + (size_t)m * D) + F.lane; ra[q] = src[0]; rb[q] = src[64]; }
#pragma unroll
                    for (int q = 0; q < 4; ++q) { const int m = mb + q * NGW; if (m >= M) break;
#pragma unroll
                        for (int k = 0; k < 2; ++k) { const int e = rt[q][2 * k], pos = rt[q][2 * k + 1], slot = ptab[MAXPAN + 8 + e] + pos; unsigned char* drow = XS8 + (size_t)slot * D + 8 * F.lane;
                            *(u32x2*)drow = pk8_fp8(bf_lo(ra[q].x), bf_hi(ra[q].x), bf_lo(ra[q].y), bf_hi(ra[q].y), bf_lo(ra[q].z), bf_hi(ra[q].z), bf_lo(ra[q].w), bf_hi(ra[q].w));
                            *(u32x2*)(drow + 512) = pk8_fp8(bf_lo(rb[q].x), bf_hi(rb[q].x), bf_lo(rb[q].y), bf_hi(rb[q].y), bf_lo(rb[q].z), bf_hi(rb[q].z), bf_lo(rb[q].w), bf_hi(rb[q].w));
                            if (F.lane == 0) { stok[slot] = m * 2 + k; sw[slot] = __int_as_float(rt[q][4 + k]); srs[slot] = RS[m]; } } } }
                SEAM();
            }
            if (KON(11) && IN(pb + 7)) { FRESH_TID(F); PMARK(pb + 7);
                const int npan = build_ptab(F);
                const int* stok = (const int*)(F.ws + WS_SLOT); const float* srs = (const float*)(stok + 2 * MAXSLOT);
                pg8::Gemm8 g{F.ws + WS_XS, F.ws + WS_WM1, D, D, D}; SchedMoe1F S{F.G, F.c, npan, (const LAS int*)(F.lds + PTAB_OFF)};
                EpiGlu8 E{srs, F.ws + WS_ACTM, DFE, 1.0f / MOE_S1};
                pg8::gemm_phase8(F.lds, g, S, E); SEAM();
            }
            if (KON(12) && IN(pb + 8)) { FRESH_TID(F); PMARK(pb + 8);
                const int npan = build_ptab(F);
                const int* stok = (const int*)(F.ws + WS_SLOT); const float* sw = (const float*)(stok + MAXSLOT);
                pg8::Gemm8 g{F.ws + WS_ACTM, F.ws + WS_WM2, DFE, DFE, DFE}; SchedMoe2F S{F.G, F.c, npan, (const LAS int*)(F.lds + PTAB_OFF)};
                EpiMoe2 E{stok, sw, (bf16_t*)(F.ws + WS_Y0), (bf16_t*)(F.ws + WS_Y1), 0, 1.0f / MOE_S2}; pg8::gemm_phase8(F.lds, g, S, E); SEAM();
            }
            if (KON(13) && IN(pb + 11)) { FRESH_TID(F); PMARK(pb + 11);
                const bf16_t* Y0 = (const bf16_t*)(F.ws + WS_Y0); const bf16_t* Y1 = (const bf16_t*)(F.ws + WS_Y1);
#pragma nounroll
                for (int mb = gw; mb < M; mb += 2 * NGW) { f32x4 x[2][4]; u32x2 ya[2][4], yb[2][4];
#pragma unroll
                    for (int q = 0; q < 2; ++q) { const int m = mb + q * NGW < M ? mb + q * NGW : 0; const u32x2* xr = (const u32x2*)(XB + (size_t)m * D) + F.lane; const u32x2* y0 = (const u32x2*)(Y0 + (size_t)m * D) + F.lane; const u32x2* y1 = (const u32x2*)(Y1 + (size_t)m * D) + F.lane;
#pragma unroll
                        for (int j = 0; j < 4; ++j) { const u32x2 wv = xr[64 * j]; x[q][j] = (f32x4){bf_lo(wv.x), bf_hi(wv.x), bf_lo(wv.y), bf_hi(wv.y)}; ya[q][j] = y0[64 * j]; yb[q][j] = y1[64 * j]; } }
#pragma unroll
                    for (int q = 0; q < 2; ++q) { const int m = mb + q * NGW; if (m >= M) break; f32x4* xr = (f32x4*)(F.out + (size_t)m * D) + F.lane;
#pragma unroll
                        for (int j = 0; j < 4; ++j) { f32x4 o = x[q][j]; const u32x2 a = ya[q][j], b2 = yb[q][j];
                            o.x += bf_lo(a.x) + bf_lo(b2.x); o.y += bf_hi(a.x) + bf_hi(b2.x); o.z += bf_lo(a.y) + bf_lo(b2.y); o.w += bf_hi(a.y) + bf_hi(b2.y); xr[64 * j] = o; } } }
            }
        }
    }
#undef gw
#undef NGW
#undef XB
#undef RS
    PMARK(99);
    if ((PROBE_MASK & 0x6000000u) && blockIdx.x == 0 && threadIdx.x == 0) { const unsigned* st = (const unsigned*)(F.ws + WS_SLOT + 3 * MAXSLOT * 4); unsigned long long tot = 0; for (int i = 0; i < 512 * 8; ++i) { const unsigned v = st[i]; tot += (PROBE_MASK & 0x2000000u) ? (v & 255u) : (v >> 8); }
        *(volatile LAS unsigned long long*)(F.lds + MISC_OFF + 160) += tot * 25ull / 4096ull * 10ull; }
    if (PROBE_MASK != 0u && blockIdx.x == 0 && threadIdx.x == 0) { const unsigned long long acc = *(volatile LAS unsigned long long*)(F.lds + MISC_OFF + 160), t1 = __builtin_amdgcn_s_memrealtime() + 4ull * acc; while (__builtin_amdgcn_s_memrealtime() < t1) __builtin_amdgcn_s_sleep(8); }
#undef IN
}

constexpr int NPHASE = 25;
template <unsigned KM> static bool setup_kernel(int& per_cu) {
    if (hipFuncSetAttribute((const void*)fwd<KM>, hipFuncAttributeMaxDynamicSharedMemorySize, LDS_BYTES) != hipSuccess) return false;
    if (hipOccupancyMaxActiveBlocksPerMultiprocessor(&per_cu, (const void*)fwd<KM>, NTHR, LDS_BYTES) != hipSuccess) per_cu = 0;
    (void)hipGetLastError(); return true;
}
template <unsigned KM> static void launch_kind(int grid, const Args& a, hipStream_t stream) { hipLaunchKernelGGL(fwd<KM>, dim3(grid), dim3(NTHR), LDS_BYTES, stream, a); }
extern "C" void kernel_launch(void* const* d_in, const int* in_sizes, int n_in, void* d_out, int out_size, void* d_ws, size_t ws_size, hipStream_t stream) {
    static int grid = 0;
    if (grid == 0) {
        if (n_in != 28 || in_sizes[0] != M * D || out_size != M * D || ws_size < WS_END) { fprintf(stderr, "kernel_launch: unexpected shapes / workspace (n_in %d, ws %zu, need %zu)\n", n_in, ws_size, (size_t)WS_END); grid = -1; return; }
        int dev = 0, cus = 0, per_cu = 0; bool ok = true;
        if (hipGetDevice(&dev) != hipSuccess || hipDeviceGetAttribute(&cus, hipDeviceAttributeMultiprocessorCount, dev) != hipSuccess) { grid = -1; return; }
#if MK_PER_PHASE
        ok = ok && setup_kernel<1u << 0>(per_cu) && setup_kernel<1u << 1>(per_cu) && setup_kernel<1u << 2>(per_cu) && setup_kernel<1u << 3>(per_cu) && setup_kernel<1u << 4>(per_cu) && setup_kernel<1u << 5>(per_cu) && setup_kernel<1u << 6>(per_cu)
             && setup_kernel<1u << 7>(per_cu) && setup_kernel<1u << 8>(per_cu) && setup_kernel<1u << 9>(per_cu) && setup_kernel<1u << 10>(per_cu) && setup_kernel<1u << 11>(per_cu) && setup_kernel<1u << 12>(per_cu) && setup_kernel<1u << 13>(per_cu);
#else
        ok = ok && setup_kernel<0xffffffffu>(per_cu);
#endif
        if (!ok) { fprintf(stderr, "kernel_launch: hipFuncSetAttribute failed\n"); grid = -1; return; }
        if (per_cu < 1) fprintf(stderr, "kernel_launch: occupancy query says %d\n", per_cu);
        grid = cus;
    }
    if (grid < 0) return;
    (void)hipMemsetAsync((char*)d_ws + WS_CTL, 0, CTL_BYTES, stream);
    Args a{};
    for (int i = 0; i < 28; ++i) a.in[i] = (const float*)d_in[i];
    a.out = (float*)d_out; a.ws = (unsigned char*)d_ws;
#if MK_PER_PHASE
    static const int phases[] = {0, 1, 2, 3, 4, 5, 7, 8, 13, 14, 15, 16, 17, 18, 19, 20, 21, 24};
    static const int kinds[]  = {0, 1, 2, 3, 4, 5, 7, 8,  1,  2,  3,  4,  5,  6, 10, 11, 12, 13};
    for (int i = 0; i < (int)(sizeof(phases) / sizeof(int)); ++i) { a.ph_lo = phases[i]; a.ph_hi = phases[i] + 1;
        switch (kinds[i]) {
            case 0: launch_kind<1u << 0>(grid, a, stream); break; case 1: launch_kind<1u << 1>(grid, a, stream); break; case 2: launch_kind<1u << 2>(grid, a, stream); break;
            case 3: launch_kind<1u << 3>(grid, a, stream); break; case 4: launch_kind<1u << 4>(grid, a, stream); break; case 5: launch_kind<1u << 5>(grid, a, stream); break;
            case 6: launch_kind<1u << 6>(grid, a, stream); break; case 7: launch_kind<1u << 7>(grid, a, stream); break; case 8: launch_kind<1u << 8>(grid, a, stream); break;
            case 9: launch_kind<1u << 9>(grid, a, stream); break; case 10: launch_kind<1u << 10>(grid, a, stream); break; case 11: launch_kind<1u << 11>(grid, a, stream); break;
            case 12: launch_kind<1u << 12>(grid, a, stream); break; default: launch_kind<1u << 13>(grid, a, stream); break; } }
#else
    a.ph_lo = 0; a.ph_hi = NPHASE; launch_kind<0xffffffffu>(grid, a, stream);
#endif
}
```

```cpp
#include <hip/hip_runtime.h>
#include <cstdio>
#include <cstdint>

#ifndef MK_PER_PHASE
#define MK_PER_PHASE 0
#endif

#ifndef PROBE_MASK
#define PROBE_MASK 0u
#endif
#define LAS __attribute__((address_space(3)))
typedef unsigned short bf16_t;
typedef short bf16x8 __attribute__((ext_vector_type(8)));
typedef float f32x4 __attribute__((ext_vector_type(4)));
typedef float f32x2 __attribute__((ext_vector_type(2)));
typedef unsigned u32x4 __attribute__((ext_vector_type(4)));
typedef unsigned u32x2 __attribute__((ext_vector_type(2)));

constexpr int D = 1024, NB = 8, SEQ = 2048, M = NB * SEQ;
constexpr int INW = 2328, INP = 2560;
constexpr int CW = 512, CKW = 31, DH = 64, NKV = 2, NBH = NB * NKV;
constexpr int NCMP = 127, CHID = 256;
constexpr int DFF = 2816, NE = 8, DFE = 3584;
constexpr int MAXPAN = 136, MAXSLOT = MAXPAN * 256, CHUNKP = 72;
constexpr float EPS = 1e-6f;

constexpr size_t MiB = 1u << 20;
constexpr size_t WS_CTL = 0, CTL_BYTES = 2 * MiB;
constexpr size_t WS_H1 = 342 * MiB;
constexpr size_t WS_WIN = 12 * MiB;
constexpr size_t WS_WC1 = 22 * MiB;
constexpr size_t WS_WOUT = 26 * MiB;
constexpr size_t WS_WF1 = 30 * MiB;
constexpr size_t WS_WF2 = 41 * MiB;
constexpr size_t WS_RT = 47 * MiB;
constexpr size_t WS_WM1 = 48 * MiB;
constexpr size_t WS_WM2 = 160 * MiB;
constexpr size_t WS_XB = 216 * MiB;
constexpr size_t WS_RSTD = 248 * MiB;
constexpr size_t WS_GT = WS_RSTD + 65536;
constexpr size_t WS_ROUTE = WS_GT + (size_t)M * 24 * 4;
constexpr size_t WS_PSS = 250 * MiB;
constexpr size_t WS_KC = 251 * MiB;
constexpr size_t WS_VC = WS_KC + 262144;
constexpr size_t WS_VCT = WS_KC + 524288;
constexpr size_t WS_VST = 2 * MiB, WS_VWT = 6 * MiB;
constexpr size_t WS_U = 252 * MiB;
constexpr size_t WS_Q = 268 * MiB;
constexpr size_t WS_KV = 284 * MiB;
constexpr size_t KVT = (size_t)NBH * SEQ * DH;
constexpr size_t WS_MIX = 310 * MiB;
constexpr size_t WS_ACT = 342 * MiB;
constexpr size_t WS_XS = 252 * MiB;
constexpr size_t WS_ACTM = 320 * MiB;
constexpr size_t WS_SLOT = 447 * MiB;
constexpr size_t WS_Y0 = WS_XS, WS_Y1 = 12 * MiB;
constexpr size_t WS_END = 448 * MiB;
constexpr int CW_BAR = 4096;
constexpr int CW_CNT = 8192;
constexpr int CW_B1P = 16384;

__device__ __forceinline__ unsigned cvt_pk_bf16(float lo, float hi) { unsigned r; asm volatile("v_cvt_pk_bf16_f32 %0, %1, %2" : "=v"(r) : "v"(lo), "v"(hi)); return r; }
__device__ __forceinline__ float bf_lo(unsigned v) { return __uint_as_float(v << 16); }
__device__ __forceinline__ float bf_hi(unsigned v) { return __uint_as_float(v & 0xffff0000u); }
__device__ __forceinline__ float bf2f(bf16_t v) { return __uint_as_float((unsigned)v << 16); }
__device__ __forceinline__ float rcpf_(float x) { return __builtin_amdgcn_rcpf(x); }
__device__ __forceinline__ float rsqf_(float x) { return __builtin_amdgcn_rsqf(x); }
__device__ __forceinline__ float sigmoidf_(float x) { return rcpf_(1.0f + __expf(-x)); }
__device__ __forceinline__ float siluf_(float x) { return x * sigmoidf_(x); }
typedef float f32x2e __attribute__((ext_vector_type(2)));
__device__ __forceinline__ f32x2e glu2_(f32x2e g, f32x2e u, f32x2e nrs, f32x2e rs2) {
    f32x2e e = g * nrs; e.x = __builtin_amdgcn_exp2f(e.x); e.y = __builtin_amdgcn_exp2f(e.y);
    f32x2e d = e + (f32x2e){1.0f, 1.0f}; d.x = __builtin_amdgcn_rcpf(d.x); d.y = __builtin_amdgcn_rcpf(d.y);
    return ((g * u) * rs2) * d; }
__device__ __forceinline__ f32x2e glus2_(f32x2e v, f32x2e g, f32x2e nrs, f32x2e rs1) {
    f32x2e e = g * nrs; e.x = __builtin_amdgcn_exp2f(e.x); e.y = __builtin_amdgcn_exp2f(e.y);
    f32x2e d = e + (f32x2e){1.0f, 1.0f}; d.x = __builtin_amdgcn_rcpf(d.x); d.y = __builtin_amdgcn_rcpf(d.y);
    return (v * rs1) * d; }
#define LO2(v) ((f32x2e){(v)[0], (v)[1]})
#define HI2(v) ((f32x2e){(v)[2], (v)[3]})
__device__ __forceinline__ float wave_sum(float v) {
#pragma unroll
    for (int o = 1; o < 64; o <<= 1) v += __shfl_xor(v, o);
    return v;
}
#define DPP_ADD(v, ctrl) ((v) + __builtin_bit_cast(float, __builtin_amdgcn_update_dpp(0, __builtin_bit_cast(int, (v)), (ctrl), 0xF, 0xF, true)))
__device__ __forceinline__ float wave_sum_u(float v) {
    v = DPP_ADD(v, 0xB1); v = DPP_ADD(v, 0x4E); v = DPP_ADD(v, 0x124); v = DPP_ADD(v, 0x128);
    const int b = __builtin_bit_cast(int, v);
    return (__builtin_bit_cast(float, __builtin_amdgcn_readlane(b, 0)) + __builtin_bit_cast(float, __builtin_amdgcn_readlane(b, 16))) + (__builtin_bit_cast(float, __builtin_amdgcn_readlane(b, 32)) + __builtin_bit_cast(float, __builtin_amdgcn_readlane(b, 48)));
}
__device__ __forceinline__ float wave_max(float v) {
#pragma unroll
    for (int o = 1; o < 64; o <<= 1) v = fmaxf(v, __shfl_xor(v, o));
    return v;
}
#define LDS_WAIT() asm volatile("s_waitcnt lgkmcnt(0)" ::: "memory")
typedef float f32x16 __attribute__((ext_vector_type(16)));
typedef __bf16 bf16v2 __attribute__((ext_vector_type(2)));
#define MFMA32(a, b, c) __builtin_amdgcn_mfma_f32_32x32x16_bf16((a), (b), (c), 0, 0, 0)
__device__ __forceinline__ unsigned pk_bf16(float lo, float hi) { const f32x2 v = {lo, hi}; return __builtin_bit_cast(unsigned, __builtin_convertvector(v, bf16v2)); }
template <int S8> __device__ __forceinline__ bf16x8 pack8(const f32x16& p) { u32x4 w; w.x = pk_bf16(p[S8], p[S8 + 1]); w.y = pk_bf16(p[S8 + 2], p[S8 + 3]); w.z = pk_bf16(p[S8 + 4], p[S8 + 5]); w.w = pk_bf16(p[S8 + 6], p[S8 + 7]); return __builtin_bit_cast(bf16x8, w); }
__device__ __forceinline__ u32x2 pk8_fp8(float a0, float a1, float a2, float a3, float a4, float a5, float a6, float a7) {
    int w0 = 0, w1 = 0; w0 = __builtin_amdgcn_cvt_pk_fp8_f32(a0, a1, w0, false); w0 = __builtin_amdgcn_cvt_pk_fp8_f32(a2, a3, w0, true);
    w1 = __builtin_amdgcn_cvt_pk_fp8_f32(a4, a5, w1, false); w1 = __builtin_amdgcn_cvt_pk_fp8_f32(a6, a7, w1, true); return (u32x2){(unsigned)w0, (unsigned)w1}; }
__device__ __forceinline__ int swap23(int v) { return (v & ~12) | ((v & 4) << 1) | ((v & 8) >> 1); }

namespace pg8 {
constexpr int BM = 256, BK = 64, HALF = 128, HTB = HALF * BK * 2, STAGE_BYTES = 8 * HTB, NXCD = 8, WGM = 8;
__device__ __forceinline__ int lds_byte(int r, int c) { const int st = (r >> 4) * 2 + (c >> 5), rr = r & 15, cc = c & 31, ob = rr * 64 + cc * 2; return st * 1024 + (ob ^ (((ob >> 9) & 1) << 5)); }
__device__ __forceinline__ void stage_rc(int b, int& R, int& C) { const int st = b / 1024, sb = b % 1024, swz = sb ^ (((sb >> 9) & 1) << 5); R = (st >> 1) * 16 + swz / 64; C = (st & 1) * 32 + (swz % 64) / 2; }
__device__ __forceinline__ int perm32(int rho) { const int n = rho >> 4, i = rho & 15; return 8 * (i >> 2) + 4 * n + (i & 3); }

struct Unit { int pm, pn; size_t aoff, boff; };
struct Gemm { const bf16_t* A; const bf16_t* Bt; int K, lda, ldb; };

struct SchedGrid {
    int nM, nN, nwg, G, c; size_t astr, bstr;
    __device__ __forceinline__ void init(int nM_, int nN_, int G_, int c_, int lda, int ldb) { nM = nM_; nN = nN_; nwg = nM * nN; G = G_; c = c_; astr = (size_t)BM * lda * 2; bstr = (size_t)BM * ldb * 2; }
    __device__ __forceinline__ bool next(int i, Unit& u) const {
        const long L = (long)i * G + c; if (L >= nwg) return false;
        int wgid = (int)L; { const int q = nwg / NXCD, r = nwg % NXCD, xcd = wgid % NXCD, off = wgid / NXCD; wgid = (xcd < r ? xcd * (q + 1) : r * (q + 1) + (xcd - r) * q) + off; }
        const int nig = WGM * nN, gid = wgid / nig, fm = gid * WGM, gsz = (nM - fm) < WGM ? (nM - fm) : WGM;
        u.pm = fm + ((wgid % nig) % gsz); u.pn = (wgid % nig) / gsz; u.aoff = (size_t)u.pm * astr; u.boff = (size_t)u.pn * bstr; return true;
    }
};

template <class Epi, class Sched>
__device__ __forceinline__ void gemm_phase(LAS unsigned char* lds, const Gemm g, const Sched& S, const Epi& E) {
    int tid = threadIdx.x; asm volatile("" : "+v"(tid));
    const int wid = __builtin_amdgcn_readfirstlane(tid >> 6), lane = tid & 63, wr = wid >> 2, wc = wid & 3, fr = lane & 15, fq = lane >> 4;
    const int K = g.K, nt = K / BK;
    unsigned voffA[2], voffB[2];
#pragma unroll
    for (int i = 0; i < 2; ++i) { int R, C; stage_rc(tid * 16 + i * 8192, R, C); const int Rb = Epi::PERM ? ((R & ~31) + perm32(R & 31)) : R;
        voffA[i] = (unsigned)(R * g.lda + C) * 2u; voffB[i] = (unsigned)(Rb * g.ldb + C) * 2u; }
    const size_t kstep = (size_t)(BK * 2);
    const size_t hstepA = (size_t)HALF * g.lda * 2, hstepB = (size_t)HALF * g.ldb * 2;
    const unsigned ldsw = (unsigned)wid * 1024u;
    const int aoff = lds_byte(wr * 64 + fr, fq * 8), boff = lds_byte(wc * 32 + fr, fq * 8);
#define PG8_SA(b, h) (((b) * 2 + (h)) * HTB)
#define PG8_SB(b, h) ((4 + (b) * 2 + (h)) * HTB)
#define PG8_STAGE(bufoff, gbase, voff) do { _Pragma("unroll") for (int _i = 0; _i < 2; ++_i) \
        __builtin_amdgcn_global_load_lds((const unsigned*)((const char*)(gbase) + (voff)[_i]), (LAS unsigned*)(lds + (bufoff) + ldsw + _i * 8192), 16, 0, 0); } while (0)
#define PG8_LDA(dst, b, h) do { _Pragma("unroll") for (int m = 0; m < 4; ++m) _Pragma("unroll") for (int k = 0; k < 2; ++k) dst[m][k] = *(const LAS bf16x8*)(lds + PG8_SA(b, h) + aoff + m * 2048 + k * 1024); } while (0)
#define PG8_LDB(dst, b, h) do { _Pragma("unroll") for (int n = 0; n < 2; ++n) _Pragma("unroll") for (int k = 0; k < 2; ++k) dst[n][k] = *(const LAS bf16x8*)(lds + PG8_SB(b, h) + boff + n * 2048 + k * 1024); } while (0)
#define PG8_MMA(ai, bj, At, Bt) do { __builtin_amdgcn_s_setprio(1); _Pragma("unroll") for (int m = 0; m < 4; ++m) _Pragma("unroll") for (int n = 0; n < 2; ++n) _Pragma("unroll") for (int k = 0; k < 2; ++k) \
        acc[ai][bj][m][n] = __builtin_amdgcn_mfma_f32_16x16x32_bf16(Bt[n][k], At[m][k], acc[ai][bj][m][n], 0, 0, 0); __builtin_amdgcn_s_setprio(0); } while (0)
#define PG8_WAIT_V(n) asm volatile("s_waitcnt vmcnt(" #n ")" ::: "memory")
#define PG8_WAIT_L(n) asm volatile("s_waitcnt lgkmcnt(" #n ")" ::: "memory")
#define PG8_BAR __builtin_amdgcn_s_barrier()
#define PG8_SCHED __builtin_amdgcn_sched_barrier(0)
    Unit cur, nxt; int ui = 0;
    if (!S.next(0, cur)) return;
    f32x4 acc[2][2][4][2];
#pragma unroll
    for (int a = 0; a < 2; ++a)
#pragma unroll
        for (int b = 0; b < 2; ++b)
#pragma unroll
            for (int m = 0; m < 4; ++m)
#pragma unroll
                for (int n = 0; n < 2; ++n) acc[a][b][m][n] = (f32x4){0.f, 0.f, 0.f, 0.f};
    bf16x8 At[4][2], B0[2][2], B1[2][2];
    const char* cA = (const char*)g.A + cur.aoff; const char* cB = (const char*)g.Bt + cur.boff;
    typename Epi::Pre pre; E.prefetch(cur, wr, fr, pre);
    PG8_STAGE(PG8_SB(0, 0), cB, voffB); PG8_STAGE(PG8_SA(0, 0), cA, voffA); PG8_STAGE(PG8_SB(0, 1), cB + hstepB, voffB); PG8_STAGE(PG8_SA(0, 1), cA + hstepA, voffA);
    if (wr == 1) PG8_BAR;
    PG8_WAIT_V(4); PG8_BAR;
    PG8_STAGE(PG8_SB(1, 0), cB + kstep, voffB); PG8_STAGE(PG8_SA(1, 0), cA + kstep, voffA); PG8_STAGE(PG8_SB(1, 1), cB + hstepB + kstep, voffB);
    PG8_WAIT_V(6); PG8_BAR;
    for (;;) {
        const bool has_next = S.next(ui + 1, nxt);
        const char* nA = has_next ? (const char*)g.A + nxt.aoff : cA; const char* nB = has_next ? (const char*)g.Bt + nxt.boff : cB;
#pragma nounroll
        for (int t = 0; t < nt; t += 2) {
            const bool last = (t == nt - 2);
            const char* a1 = cA + (size_t)(t + 1) * kstep;
            const char* a2 = last ? nA : cA + (size_t)(t + 2) * kstep; const char* b2 = last ? nB : cB + (size_t)(t + 2) * kstep;
            const char* a3 = a2 + kstep; const char* b3 = b2 + kstep;
            PG8_LDB(B0, 0, 0); PG8_SCHED; PG8_LDA(At, 0, 0); PG8_STAGE(PG8_SA(1, 1), a1 + hstepA, voffA);
            PG8_WAIT_L(8); PG8_BAR; PG8_WAIT_L(0); PG8_MMA(0, 0, At, B0); PG8_BAR; PG8_SCHED;
            PG8_LDB(B1, 0, 1); PG8_STAGE(PG8_SB(0, 0), b2, voffB);
            PG8_BAR; PG8_WAIT_L(0); PG8_MMA(0, 1, At, B1); PG8_BAR;
            PG8_LDA(At, 0, 1); PG8_STAGE(PG8_SA(0, 0), a2, voffA);
            PG8_BAR; PG8_WAIT_L(0); PG8_MMA(1, 0, At, B0); PG8_BAR; PG8_SCHED;
            PG8_STAGE(PG8_SB(0, 1), b2 + hstepB, voffB);
            PG8_WAIT_V(6); PG8_BAR; PG8_MMA(1, 1, At, B1); PG8_BAR;
            PG8_LDB(B0, 1, 0); PG8_SCHED; PG8_LDA(At, 1, 0); PG8_STAGE(PG8_SA(0, 1), a2 + hstepA, voffA);
            PG8_WAIT_L(8); PG8_BAR; PG8_WAIT_L(0); PG8_MMA(0, 0, At, B0); PG8_BAR; PG8_SCHED;
            PG8_LDB(B1, 1, 1); PG8_STAGE(PG8_SB(1, 0), b3, voffB);
            PG8_BAR; PG8_WAIT_L(0); PG8_MMA(0, 1, At, B1); PG8_BAR;
            PG8_LDA(At, 1, 1); PG8_STAGE(PG8_SA(1, 0), a3, voffA);
            PG8_BAR; PG8_WAIT_L(0); PG8_MMA(1, 0, At, B0); PG8_BAR; PG8_SCHED;
            PG8_STAGE(PG8_SB(1, 1), b3 + hstepB, voffB);
            PG8_WAIT_V(6); PG8_BAR; PG8_MMA(1, 1, At, B1); PG8_BAR;
        }
        E(acc, cur, wr, wc, fr, fq, pre);
        if (!has_next) break;
        E.prefetch(nxt, wr, fr, pre);
#pragma unroll
        for (int a = 0; a < 2; ++a)
#pragma unroll
            for (int b = 0; b < 2; ++b)
#pragma unroll
                for (int m = 0; m < 4; ++m)
#pragma unroll
                    for (int n = 0; n < 2; ++n) acc[a][b][m][n] = (f32x4){0.f, 0.f, 0.f, 0.f};
        cur = nxt; cA = nA; cB = nB; ++ui;
    }
    PG8_WAIT_V(0);
    if (wr == 0) PG8_BAR;
    PG8_BAR;
#undef PG8_SA
#undef PG8_SB
#undef PG8_STAGE
#undef PG8_LDA
#undef PG8_LDB
#undef PG8_MMA
#undef PG8_WAIT_V
#undef PG8_WAIT_L
#undef PG8_BAR
#undef PG8_SCHED
}
struct Gemm8 { const unsigned char* A; const unsigned char* Bt; int K, lda, ldb; };
typedef int i32x4 __attribute__((ext_vector_type(4)));
typedef int i32x8 __attribute__((ext_vector_type(8)));
template <class Epi, class Sched>
__device__ __forceinline__ void gemm_phase8(LAS unsigned char* lds, const Gemm8 g, const Sched& S, const Epi& E) {
    int tid = threadIdx.x; asm volatile("" : "+v"(tid));
    const int wid = __builtin_amdgcn_readfirstlane(tid >> 6), lane = tid & 63, wr = wid >> 2, wc = wid & 3, fr = lane & 15, fq = lane >> 4;
    const int nt = g.K / 128;
    unsigned voffA[2], voffB[2];
#pragma unroll
    for (int i = 0; i < 2; ++i) { int R, C; stage_rc(tid * 16 + i * 8192, R, C); const int Rb = Epi::PERM ? ((R & ~31) + perm32(R & 31)) : R;
        voffA[i] = (unsigned)(R * g.lda + C * 2); voffB[i] = (unsigned)(Rb * g.ldb + C * 2); }
    const size_t kstep = (size_t)(BK * 2);
    const size_t hstepA = (size_t)HALF * g.lda, hstepB = (size_t)HALF * g.ldb;
    const unsigned ldsw = (unsigned)wid * 1024u;
    const int aoff = lds_byte(wr * 64 + fr, fq * 8), boff = lds_byte(wc * 32 + fr, fq * 8);
#define PG8_SA(b, h) (((b) * 2 + (h)) * HTB)
#define PG8_SB(b, h) ((4 + (b) * 2 + (h)) * HTB)
#define PG8_STAGE(bufoff, gbase, voff) do { _Pragma("unroll") for (int _i = 0; _i < 2; ++_i) \
        __builtin_amdgcn_global_load_lds((const unsigned*)((const char*)(gbase) + (voff)[_i]), (LAS unsigned*)(lds + (bufoff) + ldsw + _i * 8192), 16, 0, 0); } while (0)
#define PG8_LDA(dst, b, h) do { _Pragma("unroll") for (int m = 0; m < 4; ++m) { const i32x4 _l = *(const LAS i32x4*)(lds + PG8_SA(b, h) + aoff + m * 2048), _h = *(const LAS i32x4*)(lds + PG8_SA(b, h) + aoff + m * 2048 + 1024); dst[m] = __builtin_shufflevector(_l, _h, 0, 1, 2, 3, 4, 5, 6, 7); } } while (0)
#define PG8_LDB(dst, b, h) do { _Pragma("unroll") for (int n = 0; n < 2; ++n) { const i32x4 _l = *(const LAS i32x4*)(lds + PG8_SB(b, h) + boff + n * 2048), _h = *(const LAS i32x4*)(lds + PG8_SB(b, h) + boff + n * 2048 + 1024); dst[n] = __builtin_shufflevector(_l, _h, 0, 1, 2, 3, 4, 5, 6, 7); } } while (0)
#define PG8_MMA(ai, bj, At, Bt) do { __builtin_amdgcn_s_setprio(1); _Pragma("unroll") for (int m = 0; m < 4; ++m) _Pragma("unroll") for (int n = 0; n < 2; ++n) \
        asm volatile("v_mfma_f32_16x16x128_f8f6f4 %0, %1, %2, %0" : "+v"(acc[ai][bj][m][n]) : "v"(Bt[n]), "v"(At[m])); __builtin_amdgcn_s_setprio(0); } while (0)
#define PG8_WAIT_V(n) asm volatile("s_waitcnt vmcnt(" #n ")" ::: "memory")
#define PG8_WAIT_L(n) asm volatile("s_waitcnt lgkmcnt(" #n ")" ::: "memory")
#define PG8_BAR __builtin_amdgcn_s_barrier()
#define PG8_SCHED __builtin_amdgcn_sched_barrier(0)
    Unit cur, nxt; int ui = 0;
    if (!S.next(0, cur)) return;
    f32x4 acc[2][2][4][2];
#pragma unroll
    for (int a = 0; a < 2; ++a)
#pragma unroll
        for (int b = 0; b < 2; ++b)
#pragma unroll
            for (int m = 0; m < 4; ++m)
#pragma unroll
                for (int n = 0; n < 2; ++n) acc[a][b][m][n] = (f32x4){0.f, 0.f, 0.f, 0.f};
    i32x8 At[4], B0[2], B1[2];
    const char* cA = (const char*)g.A + cur.aoff; const char* cB = (const char*)g.Bt + cur.boff;
    typename Epi::Pre pre; E.prefetch(cur, wr, fr, pre);
    PG8_STAGE(PG8_SB(0, 0), cB, voffB); PG8_STAGE(PG8_SA(0, 0), cA, voffA); PG8_STAGE(PG8_SB(0, 1), cB + hstepB, voffB); PG8_STAGE(PG8_SA(0, 1), cA + hstepA, voffA);
    if (wr == 1) PG8_BAR;
    PG8_WAIT_V(4); PG8_BAR;
    PG8_STAGE(PG8_SB(1, 0), cB + kstep, voffB); PG8_STAGE(PG8_SA(1, 0), cA + kstep, voffA); PG8_STAGE(PG8_SB(1, 1), cB + hstepB + kstep, voffB);
    PG8_WAIT_V(6); PG8_BAR;
    for (;;) {
        const bool has_next = S.next(ui + 1, nxt);
        const char* nA = has_next ? (const char*)g.A + nxt.aoff : cA; const char* nB = has_next ? (const char*)g.Bt + nxt.boff : cB;
#pragma nounroll
        for (int t = 0; t < nt; t += 2) {
            const bool last = (t == nt - 2);
            const char* a1 = cA + (size_t)(t + 1) * kstep;
            const char* a2 = last ? nA : cA + (size_t)(t + 2) * kstep; const char* b2 = last ? nB : cB + (size_t)(t + 2) * kstep;
            const char* a3 = a2 + kstep; const char* b3 = b2 + kstep;
            PG8_LDB(B0, 0, 0); PG8_SCHED; PG8_LDA(At, 0, 0); PG8_STAGE(PG8_SA(1, 1), a1 + hstepA, voffA);
            PG8_WAIT_L(8); PG8_BAR; PG8_WAIT_L(0); PG8_MMA(0, 0, At, B0); PG8_BAR; PG8_SCHED;
            PG8_LDB(B1, 0, 1); PG8_STAGE(PG8_SB(0, 0), b2, voffB);
            PG8_BAR; PG8_WAIT_L(0); PG8_MMA(0, 1, At, B1); PG8_BAR;
            PG8_LDA(At, 0, 1); PG8_STAGE(PG8_SA(0, 0), a2, voffA);
            PG8_BAR; PG8_WAIT_L(0); PG8_MMA(1, 0, At, B0); PG8_BAR; PG8_SCHED;
            PG8_STAGE(PG8_SB(0, 1), b2 + hstepB, voffB);
            PG8_WAIT_V(6); PG8_BAR; PG8_MMA(1, 1, At, B1); PG8_BAR;
            PG8_LDB(B0, 1, 0); PG8_SCHED; PG8_LDA(At, 1, 0); PG8_STAGE(PG8_SA(0, 1), a2 + hstepA, voffA);
            PG8_WAIT_L(8); PG8_BAR; PG8_WAIT_L(0); PG8_MMA(0, 0, At, B0); PG8_BAR; PG8_SCHED;
            PG8_LDB(B1, 1, 1); PG8_STAGE(PG8_SB(1, 0), b3, voffB);
            PG8_BAR; PG8_WAIT_L(0); PG8_MMA(0, 1, At, B1); PG8_BAR;
            PG8_LDA(At, 1, 1); PG8_STAGE(PG8_SA(1, 0), a3, voffA);
            PG8_BAR; PG8_WAIT_L(0); PG8_MMA(1, 0, At, B0); PG8_BAR; PG8_SCHED;
            PG8_STAGE(PG8_SB(1, 1), b3 + hstepB, voffB);
            PG8_WAIT_V(6); PG8_BAR; PG8_MMA(1, 1, At, B1); PG8_BAR;
        }
        E(acc, cur, wr, wc, fr, fq, pre);
        if (!has_next) break;
        E.prefetch(nxt, wr, fr, pre);
#pragma unroll
        for (int a = 0; a < 2; ++a)
#pragma unroll
            for (int b = 0; b < 2; ++b)
#pragma unroll
                for (int m = 0; m < 4; ++m)
#pragma unroll
                    for (int n = 0; n < 2; ++n) acc[a][b][m][n] = (f32x4){0.f, 0.f, 0.f, 0.f};
        cur = nxt; cA = nA; cB = nB; ++ui;
    }
    PG8_WAIT_V(0);
    if (wr == 0) PG8_BAR;
    PG8_BAR;
#undef PG8_SA
#undef PG8_SB
#undef PG8_STAGE
#undef PG8_LDA
#undef PG8_LDB
#undef PG8_MMA
#undef PG8_WAIT_V
#undef PG8_WAIT_L
#undef PG8_BAR
#undef PG8_SCHED
}
}
using pg8::Unit;

#define XB_TMO      128
#define XB_XCNT(j)  (256  + 64 * (j))
#define XB_XSUB(j)  (1280 + 64 * (j))
#define XB_XGEN(j)  (2304 + 64 * (j))
#define XB_TOP      3328
#define XB_TOPGEN   3392
#define XCD_BAR_WORDS 3456
#define XB_SPIN_CAP (1u << 18)
__device__ __forceinline__ unsigned xb_ld(unsigned* p)              { return __hip_atomic_load(p, __ATOMIC_RELAXED, __HIP_MEMORY_SCOPE_AGENT); }
__device__ __forceinline__ unsigned xb_add(unsigned* p, unsigned v) { return __hip_atomic_fetch_add(p, v, __ATOMIC_RELAXED, __HIP_MEMORY_SCOPE_AGENT); }
__device__ __forceinline__ unsigned xb_xcc_id() { return (unsigned)__builtin_amdgcn_s_getreg((3 << 11) | 20) & 0xFu; }
#define XB_SPIN(cond, bar) do { unsigned _sp = 0; while (cond) { __builtin_amdgcn_s_sleep(1); \
    if ((++_sp & 255u) == 0u) { if (xb_ld(&(bar)[XB_TMO])) break; if (_sp > XB_SPIN_CAP) { atomicAdd(&(bar)[XB_TMO], 1u); break; } } } } while (0)
struct XcdBarrier { unsigned* bar; unsigned x; volatile LAS unsigned* st; };
__device__ __forceinline__ XcdBarrier xcd_barrier_post(unsigned* bar, volatile LAS unsigned* st) {
    XcdBarrier b; b.bar = bar; b.x = xb_xcc_id(); b.st = st;
    if (threadIdx.x == 0) (void)xb_add(&bar[XB_XCNT(b.x)], 1u);
    return b;
}
__device__ __forceinline__ void xcd_barrier_complete(unsigned* bar, unsigned x, unsigned& nloc, unsigned& nx) {
    const unsigned G = gridDim.x * gridDim.y * gridDim.z;
    unsigned sum, cnt, mine, sp = 0u;
    for (;;) {
        sum = 0u; cnt = 0u; mine = 0u;
#pragma unroll
        for (unsigned j = 0; j < 16; ++j) { const unsigned c = xb_ld(&bar[XB_XCNT(j)]); sum += c; cnt += (c > 0u) ? 1u : 0u; mine = (j == x) ? c : mine; }
        if (sum == G) break;
        __builtin_amdgcn_s_sleep(1);
        if ((++sp & 255u) == 0u) { if (xb_ld(&bar[XB_TMO])) break; if (sp > XB_SPIN_CAP) { atomicAdd(&bar[XB_TMO], 1u); break; } }
    }
    nloc = mine > 0u ? mine : 1u; nx = cnt > 0u ? cnt : 1u;
}
__device__ __forceinline__ void xcd_barrier(const XcdBarrier& b) {
    asm volatile("s_waitcnt vmcnt(0)" ::: "memory");
    __syncthreads();
    if (threadIdx.x == 0) {
        unsigned* bar = b.bar;
        __builtin_amdgcn_s_waitcnt(0);
        unsigned nloc = b.st[0], nx = b.st[1];
        if (nloc == 0u) { xcd_barrier_complete(bar, b.x, nloc, nx); b.st[0] = nloc; b.st[1] = nx; }
        const unsigned old = xb_add(&bar[XB_XSUB(b.x)], 1u);
        const unsigned gen = old / nloc;
        if (old + 1u == (gen + 1u) * nloc) {
            __builtin_amdgcn_fence(__ATOMIC_RELEASE, "agent");
            asm volatile("s_waitcnt vmcnt(0)" ::: "memory");
            const unsigned og = xb_add(&bar[XB_TOP], 1u);
            const unsigned tg = og / nx;
            if (og + 1u == (tg + 1u) * nx) xb_add(&bar[XB_TOPGEN], 1u);
            else XB_SPIN(xb_ld(&bar[XB_TOPGEN]) == tg, bar);
            __builtin_amdgcn_fence(__ATOMIC_ACQUIRE, "agent");
            xb_add(&bar[XB_XGEN(b.x)], 1u);
            asm volatile("s_waitcnt vmcnt(0)" ::: "memory");
        } else {
            XB_SPIN(xb_ld(&bar[XB_XGEN(b.x)]) == gen, bar);
            __builtin_amdgcn_fence(__ATOMIC_ACQUIRE, "agent");
            asm volatile("s_waitcnt vmcnt(0)" ::: "memory");
        }
    }
    __syncthreads();
}

constexpr int NWAVES = 8, NTHR = 512;
constexpr int LDS_BYTES = 147456;
constexpr int MISC_OFF = 131072;
constexpr int PTAB_OFF = MISC_OFF + 512;

struct Args { const float* in[28]; float* out; unsigned char* ws; int ph_lo, ph_hi; };

struct Frame {
    LAS unsigned char* lds; int tid, lane, wave, G, c;
    const float* const* in; float* out; unsigned char* ws;
};
#define INP_(i) (F.in[i])
#define FRESH_TID(F) do { int _t = threadIdx.x; asm volatile("" : "+v"(_t)); (F).tid = _t; (F).lane = _t & 63; \
    __attribute__((address_space(1))) unsigned char* _w = (__attribute__((address_space(1))) unsigned char*)args.ws; __attribute__((address_space(1))) float* _o = (__attribute__((address_space(1))) float*)args.out; \
    int _g = gridDim.x; asm volatile("" : "+s"(_w), "+s"(_o), "+s"(_g)); (F).ws = (unsigned char*)_w; (F).out = (float*)_o; (F).G = _g; } while (0)
enum { I_X = 0, I_ANG, I_WIN, I_CDW, I_CDB, I_CLG, I_CLB, I_QG, I_KG, I_PK, I_PV, I_KW1, I_KB1, I_KW2, I_KB2, I_VW1, I_VB1, I_VW2, I_VB2, I_WOUT, I_FNG, I_DW1, I_DW3, I_DW2, I_RW, I_MW1, I_MW3, I_MW2 };

#define PMARK(id) do { if (PROBE_MASK != 0u && blockIdx.x == 0 && threadIdx.x == 0) { volatile LAS unsigned long long* _a = (volatile LAS unsigned long long*)(F.lds + MISC_OFF + 160); volatile LAS unsigned* _o = (volatile LAS unsigned*)(F.lds + MISC_OFF + 168); \
    const unsigned long long _t = __builtin_amdgcn_s_memrealtime(); if (*_o) { *_a += _t; *_o = 0u; } if ((id) < 32 && ((PROBE_MASK >> (id)) & 1u)) { *_a -= _t; *_o = 1u; } } } while (0)
constexpr int RSL_OFF = MISC_OFF + 2048;
__device__ __forceinline__ void rstd_from_partials(const float* pss, int pm, LAS float* tab) {
    int t = threadIdx.x; asm volatile("" : "+v"(t));
    const int row = t >> 1, hf = t & 1;
    const f32x4 a = *(const f32x4*)(pss + (size_t)(pm * 256 + row) * 16 + hf * 8), b = *(const f32x4*)(pss + (size_t)(pm * 256 + row) * 16 + hf * 8 + 4);
    float sq = ((a.x + a.y) + (a.z + a.w)) + ((b.x + b.y) + (b.z + b.w)); sq += __shfl_xor(sq, 1);
    if (hf == 0) tab[row] = rsqf_(sq * (1.0f / D) + EPS);
}
struct EpiIn {
    static constexpr bool PERM = true;
    const float* rstd; bf16_t* U; bf16_t* Q; bf16_t* KV; float* GT; const float* pss; LAS float* rsl;
    struct Pre { int par = 1; };
    __device__ __forceinline__ void prefetch(const Unit& u, int wr, int fr, Pre& p) const {
        p.par ^= 1; LAS float* tab = rsl + p.par * 256;
        if (pss) rstd_from_partials(pss, u.pm, tab); else { int t = threadIdx.x; asm volatile("" : "+v"(t)); if (t < 256) tab[t] = rstd[u.pm * 256 + t]; } }
    __device__ __forceinline__ void operator()(const f32x4 (&acc)[2][2][4][2], const Unit& u, int wr, int wc, int fr, int fq, const Pre& pre) const {
        const int row0 = u.pm * 256 + wr * 64 + fr, cl = wc * 32 + 8 * fq;
        if (u.pn < 4) {
#pragma unroll
            for (int ai = 0; ai < 2; ++ai)
#pragma unroll
                for (int m = 0; m < 4; ++m) { const int r = row0 + ai * 128 + m * 16; const float rs = rsl[pre.par * 256 + wr * 64 + fr + ai * 128 + m * 16];
                    const f32x4 v0 = acc[ai][0][m][0], v1 = acc[ai][0][m][1], g0 = acc[ai][1][m][0], g1 = acc[ai][1][m][1];
                    const float nr = rs * -1.44269504089f; const f32x2e nrs = {nr, nr}, rs1 = {rs, rs};
                    const f32x2e o0 = glus2_(LO2(v0), LO2(g0), nrs, rs1), o1 = glus2_(HI2(v0), HI2(g0), nrs, rs1), o2 = glus2_(LO2(v1), LO2(g1), nrs, rs1), o3 = glus2_(HI2(v1), HI2(g1), nrs, rs1);
                    u32x4 w; w.x = cvt_pk_bf16(o0.x, o0.y); w.y = cvt_pk_bf16(o1.x, o1.y); w.z = cvt_pk_bf16(o2.x, o2.y); w.w = cvt_pk_bf16(o3.x, o3.y);
                    *(u32x4*)(U + (size_t)r * CW + u.pn * 128 + cl) = w; asm volatile("" ::: "memory"); }
        } else if (u.pn < 6) {
#pragma unroll
            for (int ai = 0; ai < 2; ++ai)
#pragma unroll
                for (int m = 0; m < 4; ++m) { const int r = row0 + ai * 128 + m * 16; const float rs = rsl[pre.par * 256 + wr * 64 + fr + ai * 128 + m * 16];
#pragma unroll
                    for (int bj = 0; bj < 2; ++bj) { const f32x4 v0 = acc[ai][bj][m][0] * rs, v1 = acc[ai][bj][m][1] * rs;
                        u32x4 w; w.x = cvt_pk_bf16(v0[0], v0[1]); w.y = cvt_pk_bf16(v0[2], v0[3]); w.z = cvt_pk_bf16(v1[0], v1[1]); w.w = cvt_pk_bf16(v1[2], v1[3]);
                        *(u32x4*)(Q + (size_t)r * 512 + (u.pn - 4) * 256 + bj * 128 + cl) = w; } asm volatile("" ::: "memory"); }
        } else if (u.pn < 9) {
            const int h = wc >> 1, d0 = 32 * (wc & 1) + 8 * fq;
#pragma unroll
            for (int ai = 0; ai < 2; ++ai)
#pragma unroll
                for (int m = 0; m < 4; ++m) { const int r = row0 + ai * 128 + m * 16; const float rs = rsl[pre.par * 256 + wr * 64 + fr + ai * 128 + m * 16]; const int b = r >> 11, t = r & 2047;
#pragma unroll
                    for (int bj = 0; bj < 2; ++bj) { const int tq = 2 * (u.pn - 6) + bj; const f32x4 v0 = acc[ai][bj][m][0] * rs, v1 = acc[ai][bj][m][1] * rs;
                        u32x4 w; w.x = cvt_pk_bf16(v0[0], v0[1]); w.y = cvt_pk_bf16(v0[2], v0[3]); w.z = cvt_pk_bf16(v1[0], v1[1]); w.w = cvt_pk_bf16(v1[2], v1[3]);
                        *(u32x4*)(KV + (size_t)tq * KVT + ((size_t)(b * 2 + h) * SEQ + t) * DH + d0) = w; } asm volatile("" ::: "memory"); }
        } else {
            if (wc == 0 && fq < 3) {
#pragma unroll
                for (int ai = 0; ai < 2; ++ai)
#pragma unroll
                    for (int m = 0; m < 4; ++m) { const int r = row0 + ai * 128 + m * 16; const float rs = rsl[pre.par * 256 + wr * 64 + fr + ai * 128 + m * 16];
                        *(f32x4*)(GT + (size_t)r * 24 + 8 * fq) = acc[ai][0][m][0] * rs; *(f32x4*)(GT + (size_t)r * 24 + 8 * fq + 4) = acc[ai][0][m][1] * rs; }
            }
        }
    }
};
struct EpiH1 {
    static constexpr bool PERM = false;
    float* H;
    struct Pre {}; __device__ __forceinline__ void prefetch(const Unit&, int, int, Pre&) const {}
    __device__ __forceinline__ void operator()(const f32x4 (&acc)[2][2][4][2], const Unit& u, int wr, int wc, int fr, int fq, const Pre&) const {
        const int row0 = u.pm * 256 + wr * 64 + fr, col0 = wc * 32 + 4 * fq; const int kv = u.pn >> 3, sp = u.pn & 7;
#pragma unroll
        for (int ai = 0; ai < 2; ++ai)
#pragma unroll
            for (int m = 0; m < 4; ++m) { float* rowp = H + (((size_t)sp * 2 + kv) * 2048 + row0 + ai * 128 + m * 16) * 256 + col0;
#pragma unroll
                for (int bj = 0; bj < 2; ++bj)
#pragma unroll
                    for (int n = 0; n < 2; ++n) *(f32x4*)(rowp + bj * 128 + n * 16) = acc[ai][bj][m][n]; }
    }
};
template <bool BF> struct EpiRes {
    static constexpr bool PERM = false;
    const void* base; bf16_t* xb; float* pss;
    struct Pre {}; __device__ __forceinline__ void prefetch(const Unit&, int, int, Pre&) const {}
    __device__ __forceinline__ void operator()(const f32x4 (&acc)[2][2][4][2], const Unit& u, int wr, int wc, int fr, int fq, const Pre&) const {
        const int row0 = u.pm * 256 + wr * 64 + fr, col0 = u.pn * 256 + wc * 32 + 4 * fq;
#pragma unroll
        for (int ai = 0; ai < 2; ++ai) {
            f32x4 bs[4][2][2];
#pragma unroll
            for (int m = 0; m < 4; ++m) { const size_t off = (size_t)(row0 + ai * 128 + m * 16) * D + col0;
#pragma unroll
                for (int bj = 0; bj < 2; ++bj)
#pragma unroll
                    for (int n = 0; n < 2; ++n) {
                        if (BF) { const u32x2 w = *(const u32x2*)((const bf16_t*)base + off + bj * 128 + n * 16); bs[m][bj][n] = (f32x4){bf_lo(w.x), bf_hi(w.x), bf_lo(w.y), bf_hi(w.y)}; }
                        else bs[m][bj][n] = *(const f32x4*)((const float*)base + off + bj * 128 + n * 16); } }
#pragma unroll
            for (int m = 0; m < 4; ++m) { const size_t off = (size_t)(row0 + ai * 128 + m * 16) * D + col0; float ss = 0.f;
#pragma unroll
                for (int bj = 0; bj < 2; ++bj)
#pragma unroll
                    for (int n = 0; n < 2; ++n) { const f32x4 v = bs[m][bj][n] + acc[ai][bj][m][n];
                        u32x2 w; w.x = cvt_pk_bf16(v[0], v[1]); w.y = cvt_pk_bf16(v[2], v[3]); *(u32x2*)(xb + off + bj * 128 + n * 16) = w; ss += (v[0] * v[0] + v[1] * v[1]) + (v[2] * v[2] + v[3] * v[3]); }
                if (pss) { ss += __shfl_xor(ss, 16); ss += __shfl_xor(ss, 32);
                    if (fq == 0) pss[(size_t)(row0 + ai * 128 + m * 16) * 16 + u.pn * 4 + wc] = ss; } } }
    }
};
struct EpiGlu {
    static constexpr bool PERM = true;
    const float* rstd; bf16_t* O; int ldo; int rowbase;
    const float* pss; LAS float* rsl;
    struct Pre { int par = 1; };
    __device__ __forceinline__ void prefetch(const Unit& u, int wr, int fr, Pre& p) const { p.par ^= 1; rstd_from_partials(pss, u.pm, rsl + p.par * 256); }
    __device__ __forceinline__ void operator()(const f32x4 (&acc)[2][2][4][2], const Unit& u, int wr, int wc, int fr, int fq, const Pre& pre) const {
        const int row0 = u.pm * 256 + wr * 64 + fr, cl = u.pn * 128 + wc * 32 + 8 * fq;
#pragma unroll
        for (int ai = 0; ai < 2; ++ai)
#pragma unroll
            for (int m = 0; m < 4; ++m) { const int r = row0 + ai * 128 + m * 16; const float rs = rsl[pre.par * 256 + wr * 64 + fr + ai * 128 + m * 16];
                const f32x4 g0 = acc[ai][0][m][0], g1 = acc[ai][0][m][1], u0 = acc[ai][1][m][0], u1 = acc[ai][1][m][1];
                const float nr = rs * -1.44269504089f, r2 = rs * rs; const f32x2e nrs = {nr, nr}, rs2 = {r2, r2};
                const f32x2e o0 = glu2_(LO2(g0), LO2(u0), nrs, rs2), o1 = glu2_(HI2(g0), HI2(u0), nrs, rs2), o2 = glu2_(LO2(g1), LO2(u1), nrs, rs2), o3 = glu2_(HI2(g1), HI2(u1), nrs, rs2);
                u32x4 w; w.x = cvt_pk_bf16(o0.x, o0.y); w.y = cvt_pk_bf16(o1.x, o1.y); w.z = cvt_pk_bf16(o2.x, o2.y); w.w = cvt_pk_bf16(o3.x, o3.y);
                *(u32x4*)(O + (size_t)r * ldo + cl) = w; }
    }
};
struct EpiGlu8 {
    static constexpr bool PERM = true;
    const float* rstd; unsigned char* O; int ldo; float sc;
    struct Pre { float rs[8]; };
    __device__ __forceinline__ void prefetch(const Unit& u, int wr, int fr, Pre& p) const {
#pragma unroll
        for (int q = 0; q < 8; ++q) p.rs[q] = rstd[u.pm * 256 + wr * 64 + fr + (q >> 2) * 128 + (q & 3) * 16]; }
    __device__ __forceinline__ void operator()(const f32x4 (&acc)[2][2][4][2], const Unit& u, int wr, int wc, int fr, int fq, const Pre& pre) const {
        const int row0 = u.pm * 256 + wr * 64 + fr, cl = u.pn * 128 + wc * 32 + 8 * fq;
#pragma unroll
        for (int ai = 0; ai < 2; ++ai)
#pragma unroll
            for (int m = 0; m < 4; ++m) { const int r = row0 + ai * 128 + m * 16; const float rs = pre.rs[ai * 4 + m] * sc;
                const f32x4 g0 = acc[ai][0][m][0], g1 = acc[ai][0][m][1], u0 = acc[ai][1][m][0], u1 = acc[ai][1][m][1];
                const float nr = rs * -1.44269504089f, r2 = rs * rs; const f32x2e nrs = {nr, nr}, rs2 = {r2, r2};
                const f32x2e o0 = glu2_(LO2(g0), LO2(u0), nrs, rs2), o1 = glu2_(HI2(g0), HI2(u0), nrs, rs2), o2 = glu2_(LO2(g1), LO2(u1), nrs, rs2), o3 = glu2_(HI2(g1), HI2(u1), nrs, rs2);
                *(u32x2*)(O + (size_t)r * ldo + cl) = pk8_fp8(o0.x, o0.y, o1.x, o1.y, o2.x, o2.y, o3.x, o3.y); }
    }
};
struct EpiMoe2 {
    static constexpr bool PERM = true;
    const int* stok; const float* sw; bf16_t* Y0; bf16_t* Y1; int rowbase; float sc;
    struct Pre {}; __device__ __forceinline__ void prefetch(const Unit&, int, int, Pre&) const {}
    __device__ __forceinline__ void operator()(const f32x4 (&acc)[2][2][4][2], const Unit& u, int wr, int wc, int fr, int fq, const Pre&) const {
        const int row0 = u.pm * 256 + wr * 64 + fr, cl = u.pn * 256 + wc * 32 + 8 * fq;
        int tks[8]; float ws[8];
#pragma unroll
        for (int q = 0; q < 8; ++q) { const int r = rowbase + row0 + (q >> 2) * 128 + (q & 3) * 16; tks[q] = stok[r]; ws[q] = sw[r]; }
#pragma unroll
        for (int ai = 0; ai < 2; ++ai)
#pragma unroll
            for (int m = 0; m < 4; ++m) { const int tk = tks[ai * 4 + m]; const float w = ws[ai * 4 + m] * sc;
                if (tk >= 0) { bf16_t* dst = ((tk & 1) ? Y1 : Y0) + (size_t)(tk >> 1) * D + cl;
#pragma unroll
                    for (int bj = 0; bj < 2; ++bj) { const f32x4 v0 = acc[ai][bj][m][0] * w, v1 = acc[ai][bj][m][1] * w;
                        u32x4 o; o.x = cvt_pk_bf16(v0[0], v0[1]); o.y = cvt_pk_bf16(v0[2], v0[3]); o.z = cvt_pk_bf16(v1[0], v1[1]); o.w = cvt_pk_bf16(v1[2], v1[3]);
                        *(u32x4*)(dst + bj * 128) = o; } } }
    }
};

struct SchedCmp {
    int G, c, layer;
    __device__ __forceinline__ bool next(int i, Unit& u) const {
        const int L = i * G + c; if (L >= 128) return false;
        const int kv = L >> 6, pm = (L >> 3) & 7, s = L & 7;
        u.pm = pm; u.pn = kv * 8 + s; u.aoff = ((size_t)kv * KVT + (size_t)pm * 256 * 1024 + s * 256) * 2; u.boff = ((size_t)(layer * 2 + kv) * 256 * 2048 + s * 256) * 2; return true;
    }
};
struct SchedMoe1 {
    int G, c, p0, np; const LAS int* ptab;
    __device__ __forceinline__ bool next(int i, Unit& u) const {
        const int L = i * G + c; if (L >= np * 28) return false;
        const int j = L / np, pl = L % np, e = ptab[p0 + pl];
        u.pm = pl; u.pn = j; u.aoff = (size_t)(p0 + pl) * 256 * 1024 * 2; u.boff = ((size_t)e * 7168 + (size_t)j * 256) * 1024 * 2; return true;
    }
};
struct SchedMoe2 {
    int G, c, p0, np; const LAS int* ptab;
    __device__ __forceinline__ bool next(int i, Unit& u) const {
        const int L = i * G + c; if (L >= np * 4) return false;
        const int j = L / np, pl = L % np, e = ptab[p0 + pl];
        u.pm = pl; u.pn = j; u.aoff = (size_t)pl * 256 * DFE * 2; u.boff = ((size_t)e * 1024 + (size_t)j * 256) * DFE * 2; return true;
    }
};

struct SchedMoe1F {
    int G, c, np; const LAS int* ptab;
    __device__ __forceinline__ bool next(int i, Unit& u) const {
        const int L = i * G + c; if (L >= np * 28) return false;
        const int pl = L / 28, j = L % 28, e = ptab[pl];
        u.pm = pl; u.pn = j; u.aoff = (size_t)pl * 256 * 1024; u.boff = ((size_t)e * 7168 + (size_t)j * 256) * 1024; return true;
    }
};
struct SchedMoe2F {
    int G, c, np; const LAS int* ptab;
    __device__ __forceinline__ bool next(int i, Unit& u) const {
        const int L = i * G + c; if (L >= np * 4) return false;
        const int pl = L >> 2, j = L & 3, e = ptab[pl];
        u.pm = pl; u.pn = j; u.aoff = (size_t)pl * 256 * DFE; u.boff = ((size_t)e * 1024 + (size_t)j * 256) * DFE; return true;
    }
};

struct TwP { const float* W; const float* gv; bf16_t* WT; int ldw, n0, nvalid, k0, ldk, kind, h; float f8sc; };
__device__ __forceinline__ TwP tw_job(int r, const float* W, int ldw, int nblk, int nvalid, bf16_t* WT, int ldk, int kind, int h, const float* gv) {
    TwP P; P.W = W; P.gv = gv; P.WT = WT; P.ldw = ldw; P.n0 = 256 * (r % nblk); P.nvalid = nvalid; P.k0 = 64 * (r / nblk); P.ldk = ldk; P.kind = kind; P.h = h; P.f8sc = 0.f; return P; }
__device__ __forceinline__ void tw_load(const TwP& P, f32x4 (&tv)[8], int wave, int lane) {
    const int n = P.n0 + 4 * lane; const float* src = P.W + (size_t)(P.k0 + 8 * wave) * P.ldw + n;
#pragma unroll
    for (int i = 0; i < 8; ++i) tv[i] = (n < P.nvalid) ? *(const f32x4*)(src + (size_t)i * P.ldw) : (f32x4){0.f, 0.f, 0.f, 0.f};
}
__device__ __forceinline__ void tw_store(const TwP& P, f32x4 (&tv)[8], LAS unsigned char* tile, int wave, int lane) {
    if (P.gv) {
#pragma unroll
        for (int i = 0; i < 8; ++i) tv[i] *= P.gv[P.k0 + 8 * wave + i]; }
    const int ng = P.n0 + 32 * wave; size_t drow;
    if (P.kind == 0) drow = ng;
    else if (P.kind == 1) drow = 256 * (ng / 128) + 128 * P.h + (ng % 128);
    else { if (ng < 512) drow = 256 * (ng / 128) + (ng % 128); else if (ng < 1024) { const int cc = ng - 512; drow = 256 * (cc / 128) + 128 + (cc % 128); } else drow = ng; }
    if (P.f8sc != 0.f) {
        const float sc = P.f8sc;
#pragma unroll
        for (int c = 0; c < 4; ++c) *(LAS u32x2*)(tile + (4 * lane + c) * 80 + 8 * wave) = pk8_fp8(tv[0][c] * sc, tv[1][c] * sc, tv[2][c] * sc, tv[3][c] * sc, tv[4][c] * sc, tv[5][c] * sc, tv[6][c] * sc, tv[7][c] * sc);
        __syncthreads();
#pragma unroll
        for (int j = 0; j < 2; ++j) { const int r = (lane >> 2) + 16 * j, ch = lane & 3;
            *(u32x4*)((unsigned char*)P.WT + (drow + r) * (size_t)P.ldk + P.k0 + 16 * ch) = *(const LAS u32x4*)(tile + (32 * wave + r) * 80 + 16 * ch); }
        __syncthreads();
        return; }
#pragma unroll
    for (int c = 0; c < 4; ++c) { u32x4 o; o.x = cvt_pk_bf16(tv[0][c], tv[1][c]); o.y = cvt_pk_bf16(tv[2][c], tv[3][c]); o.z = cvt_pk_bf16(tv[4][c], tv[5][c]); o.w = cvt_pk_bf16(tv[6][c], tv[7][c]);
        *(LAS u32x4*)(tile + (4 * lane + c) * 144 + 16 * wave) = o; }
    __syncthreads();
#pragma unroll
    for (int j = 0; j < 4; ++j) { const int r = (lane >> 3) + 8 * j, c = lane & 7;
        *(u32x4*)(P.WT + (drow + r) * (size_t)P.ldk + P.k0 + 8 * c) = *(const LAS u32x4*)(tile + (32 * wave + r) * 144 + 16 * c); }
    __syncthreads();
}
#define TW_RUN(NIT, JOB) do { const int _n = (NIT); if (_n > 0) { TwP _pa, _pb; f32x4 _ta[8], _tb[8]; JOB(_pa, 0); tw_load(_pa, _ta, F.wave, F.lane); \
    _Pragma("nounroll") for (int _i = 0; _i < _n; _i += 2) { const bool _h2 = _i + 1 < _n, _h3 = _i + 2 < _n; \
        if (_h2) { JOB(_pb, _i + 1); tw_load(_pb, _tb, F.wave, F.lane); } tw_store(_pa, _ta, F.lds, F.wave, F.lane); if (!_h2) break; \
        if (_h3) { JOB(_pa, _i + 2); tw_load(_pa, _ta, F.wave, F.lane); } tw_store(_pb, _tb, F.lds, F.wave, F.lane); } } } while (0)
__device__ __forceinline__ void xprep_row(const float* xrow, bf16_t* orow, float* rstd_out, int lane, f32x4 (&v)[4]) {
    const f32x4* xr = (const f32x4*)xrow + lane; float s = 0.f;
#pragma unroll
    for (int j = 0; j < 4; ++j) { v[j] = xr[64 * j]; s += (v[j].x * v[j].x + v[j].y * v[j].y) + (v[j].z * v[j].z + v[j].w * v[j].w); }
    const float rstd = rsqf_(wave_sum_u(s) * (1.0f / D) + EPS);
    if (orow) { u32x2* o8 = (u32x2*)orow + lane;
#pragma unroll
        for (int j = 0; j < 4; ++j) { u32x2 w; w.x = cvt_pk_bf16(v[j].x, v[j].y); w.y = cvt_pk_bf16(v[j].z, v[j].w); o8[64 * j] = w; } }
    if (lane == 0) *rstd_out = rstd;
}

constexpr float MOE_S1 = 64.f, MOE_S2 = 128.f;
constexpr int MOE_SLOT_N = 7, MOE_SLOTTED = 3 * 128 * MOE_SLOT_N;
constexpr int MOE_ITEMS = 24 * 224;
__device__ __forceinline__ TwP moe_conv_job(Frame& F, int r) {
    constexpr int J_M1 = 16 * 14, J_M2 = 56 * 4;
    unsigned char* WM1 = F.ws + WS_WM1; unsigned char* WM2 = F.ws + WS_WM2;
    if (r < 16 * J_M1) { const int q = r / J_M1, e = q >> 1, h = q & 1; TwP P = tw_job(r % J_M1, (h ? INP_(I_MW3) : INP_(I_MW1)) + (size_t)e * D * DFE, DFE, 14, DFE, (bf16_t*)(WM1 + (size_t)e * 7168 * D), D, 1, h, INP_(I_FNG) + D); P.f8sc = MOE_S1; return P; }
    r -= 16 * J_M1; const int e = r / J_M2; TwP P = tw_job(r % J_M2, INP_(I_MW2) + (size_t)e * DFE * D, D, 4, D, (bf16_t*)(WM2 + (size_t)e * D * DFE), DFE, 0, 0, nullptr); P.f8sc = MOE_S2; return P;
}
__device__ __forceinline__ void moe_conv_slot(Frame& F, int slot) {
    if (F.G != 256 || F.c < 128) return;
    { int _t = threadIdx.x; asm volatile("" : "+v"(_t)); F.tid = _t; F.lane = _t & 63; }
    int base = slot * 128 * MOE_SLOT_N + ((int)blockIdx.x - 128); asm volatile("" : "+s"(base));
#define MJOB(P, i) P = moe_conv_job(F, base + (i) * 128)
    TW_RUN(MOE_SLOT_N, MJOB);
#undef MJOB
}
__device__ __forceinline__ void xprep_rows4(const float* X, bf16_t* XBo, float* RSo, int m, int ms, int lane) {
    f32x4 v[4][4];
#pragma unroll
    for (int q = 0; q < 4; ++q) { const int mm = m + q * ms; const f32x4* xr = (const f32x4*)(X + (size_t)(mm < M ? mm : 0) * D) + lane;
#pragma unroll
        for (int j = 0; j < 4; ++j) v[q][j] = xr[64 * j]; }
#pragma unroll
    for (int q = 0; q < 4; ++q) { const int mm = m + q * ms; if (mm >= M) break; float s = 0.f;
#pragma unroll
        for (int j = 0; j < 4; ++j) s += (v[q][j].x * v[q][j].x + v[q][j].y * v[q][j].y) + (v[q][j].z * v[q][j].z + v[q][j].w * v[q][j].w);
        const float rstd = rsqf_(wave_sum_u(s) * (1.0f / D) + EPS);
        u32x2* o8 = (u32x2*)(XBo + (size_t)mm * D) + lane;
#pragma unroll
        for (int j = 0; j < 4; ++j) { u32x2 w; w.x = cvt_pk_bf16(v[q][j].x, v[q][j].y); w.y = cvt_pk_bf16(v[q][j].z, v[q][j].w); o8[64 * j] = w; }
        if (lane == 0) RSo[mm] = rstd; }
}
__device__ __forceinline__ void phase_prologue(Frame& F) {
    const int gw = F.c * NWAVES + F.wave, NGW = F.G * NWAVES;
    bf16_t* WIN = (bf16_t*)(F.ws + WS_WIN); bf16_t* WC1 = (bf16_t*)(F.ws + WS_WC1); bf16_t* WOUT = (bf16_t*)(F.ws + WS_WOUT); bf16_t* WF1 = (bf16_t*)(F.ws + WS_WF1); bf16_t* WF2 = (bf16_t*)(F.ws + WS_WF2);
    constexpr int J_IN = 16 * 10, J_C1 = 32, J_OUT = 16 * 4, J_F1 = 16 * 11, J_F2 = 44 * 4;
    constexpr int NSMALL = 2 * J_IN + 4 * J_C1 + 2 * J_OUT + 2 * J_F1 + J_F2;
    const int moe0 = (F.G == 256) ? MOE_SLOTTED : 0; const int nitems = NSMALL + MOE_ITEMS - moe0;
#define P0_JOB(P, i) do { int r = F.c + (i) * F.G; \
        if (r < 2 * J_IN) { const int l = r / J_IN; P = tw_job(r % J_IN, INP_(I_WIN) + (size_t)l * D * INW, INW, 10, INW, WIN + (size_t)l * INP * D, D, 2, 0, INP_(I_ANG) + l * D); break; } r -= 2 * J_IN; \
        if (r < 4 * J_C1) { const int q = r / J_C1, l = q >> 1, kv = q & 1; P = tw_job(r % J_C1, (kv ? INP_(I_VW1) : INP_(I_KW1)) + (size_t)l * 2048 * 256, 256, 1, 256, WC1 + (size_t)(l * 2 + kv) * 256 * 2048, 2048, 0, 0, nullptr); break; } r -= 4 * J_C1; \
        if (r < 2 * J_OUT) { const int l = r / J_OUT; P = tw_job(r % J_OUT, INP_(I_WOUT) + (size_t)l * D * D, D, 4, D, WOUT + (size_t)l * D * D, D, 0, 0, nullptr); break; } r -= 2 * J_OUT; \
        if (r < 2 * J_F1) { const int h = r / J_F1; P = tw_job(r % J_F1, (h ? INP_(I_DW3) : INP_(I_DW1)), DFF, 11, DFF, WF1, D, 1, h, INP_(I_FNG)); break; } r -= 2 * J_F1; \
        if (r < J_F2) { P = tw_job(r, INP_(I_DW2), D, 4, D, WF2, DFF, 0, 0, nullptr); break; } r -= J_F2; \
        P = moe_conv_job(F, r + moe0); } while (0)
    TW_RUN((nitems - F.c + F.G - 1) / F.G, P0_JOB);
#undef P0_JOB
    { float* RT = (float*)(F.ws + WS_RT); const int gt = F.c * NTHR + F.tid; if (gt < 8192) { const int e = gt >> 10, k = gt & 1023; RT[gt] = INP_(I_RW)[k * 8 + e] * INP_(I_FNG)[D + k]; } }
    { float* B1P = (float*)(F.ws + WS_CTL) + CW_B1P; LAS float* ps = (LAS float*)F.lds;
      for (int it = F.c; it < 128; it += F.G) { const int kc = it & 7, jb = (it >> 3) & 3, kv = (it >> 5) & 1, l = it >> 6; const int j = jb * 64 + F.lane, kb = kc * 256 + 32 * F.wave;
          const float* w1 = (kv ? INP_(I_VW1) : INP_(I_KW1)) + (size_t)l * 2048 * 256; const float* pos = (kv ? INP_(I_PV) : INP_(I_PK)) + l * 2048;
          float wv[32];
#pragma unroll
          for (int k = 0; k < 32; ++k) wv[k] = w1[(size_t)(kb + k) * 256 + j];
          float sp = 0.f;
#pragma unroll
          for (int k = 0; k < 32; ++k) sp += pos[kb + k] * wv[k];
          ps[F.wave * 64 + F.lane] = sp;
          __syncthreads();
          if (F.wave == 0) { float t = (kc == 0) ? (kv ? INP_(I_VB1) : INP_(I_KB1))[l * 256 + j] : 0.f;
#pragma unroll
              for (int ww = 0; ww < 8; ++ww) t += ps[ww * 64 + F.lane];
              B1P[kc * 1024 + (l * 2 + kv) * 256 + j] = t; }
          __syncthreads(); } }
    { bf16_t* XB = (bf16_t*)(F.ws + WS_XB); float* RS = (float*)(F.ws + WS_RSTD);
      for (int m = gw; m < M; m += 4 * NGW) xprep_rows4(INP_(I_X), XB, RS, m, NGW, F.lane); }
}

__device__ __forceinline__ void norm_rows64(bf16_t* buf, int nrows, const float* g, float scale, int gw, int NGW, int lane) {
    const int sub = lane & 7; float gv[8];
#pragma unroll
    for (int j = 0; j < 8; ++j) gv[j] = g[sub * 8 + j] * scale;
    for (int it = gw; it < nrows / 8; it += NGW) { u32x4* p = (u32x4*)(buf + ((size_t)it * 8 + (lane >> 3)) * 64) + sub; const u32x4 v = *p;
        float f[8] = {bf_lo(v.x), bf_hi(v.x), bf_lo(v.y), bf_hi(v.y), bf_lo(v.z), bf_hi(v.z), bf_lo(v.w), bf_hi(v.w)}; float s = 0.f;
#pragma unroll
        for (int j = 0; j < 8; ++j) s += f[j] * f[j];
        s += __shfl_xor(s, 1); s += __shfl_xor(s, 2); s += __shfl_xor(s, 4);
        const float rs = rsqf_(s * (1.0f / 64.0f) + EPS);
        u32x4 o; o.x = cvt_pk_bf16(f[0] * rs * gv[0], f[1] * rs * gv[1]); o.y = cvt_pk_bf16(f[2] * rs * gv[2], f[3] * rs * gv[3]); o.z = cvt_pk_bf16(f[4] * rs * gv[4], f[5] * rs * gv[5]); o.w = cvt_pk_bf16(f[6] * rs * gv[6], f[7] * rs * gv[7]);
        *p = o; }
}
__device__ __forceinline__ float sum32_(float v, bool) {
    v = DPP_ADD(v, 0xB1); v = DPP_ADD(v, 0x4E); v = DPP_ADD(v, 0x124); v = DPP_ADD(v, 0x128);
    return v + __shfl_xor(v, 16);
}
__device__ __forceinline__ void conv_unit(Frame& F, int layer, int cu) {
    const int b = cu >> 6, t0 = (cu & 63) * 32; int tid = F.tid; asm volatile("" : "+v"(tid));
    const bf16_t* U = (const bf16_t*)(F.ws + WS_U); bf16_t* MIX = (bf16_t*)(F.ws + WS_MIX);
    LAS u32x4* L4 = (LAS u32x4*)F.lds;
    { u32x4 sv[8];
#pragma unroll
      for (int q = 0; q < 8; ++q) { const int i = tid + q * NTHR, row = i >> 6, ch = i & 63, t = t0 - 30 + row; sv[q] = (u32x4){0u, 0u, 0u, 0u}; if (i < 62 * 64 && t >= 0) sv[q] = *(const u32x4*)(U + (size_t)(b * SEQ + t) * CW + ch * 8); }
#pragma unroll
      for (int q = 0; q < 8; ++q) { const int i = tid + q * NTHR; if (i < 62 * 64) L4[i] = sv[q]; } }
    __syncthreads();
    const int cp = tid & 255, th = tid >> 8; const bool hi = (tid & 32) != 0; const LAS unsigned* LW = (const LAS unsigned*)F.lds;
    f32x2 w[CKW];
#pragma unroll
    for (int k = 0; k < CKW; ++k) w[k] = *(const f32x2*)(INP_(I_CDW) + (size_t)layer * CKW * CW + k * CW + 2 * cp);
    const f32x2 cb = *(const f32x2*)(INP_(I_CDB) + layer * CW + 2 * cp), lg = *(const f32x2*)(INP_(I_CLG) + layer * CW + 2 * cp), lb = *(const f32x2*)(INP_(I_CLB) + layer * CW + 2 * cp);
#pragma nounroll
    for (int hf = 0; hf < 2; ++hf) { const int tl0 = th * 16 + hf * 8;
        f32x2 in[38];
#pragma unroll
        for (int i = 0; i < 38; ++i) { const unsigned v = LW[(tl0 + i) * 256 + cp]; in[i] = (f32x2){bf_lo(v), bf_hi(v)}; }
        f32x2 acc[8];
#pragma unroll
        for (int t = 0; t < 8; ++t) { acc[t] = cb;
#pragma unroll
            for (int k = 0; k < CKW; ++k) acc[t] += w[k] * in[t + k]; }
#pragma unroll
        for (int t = 0; t < 8; ++t) {
            const float s = sum32_(acc[t].x + acc[t].y, hi), q = sum32_(acc[t].x * acc[t].x + acc[t].y * acc[t].y, hi);
            const float mu = s * (1.0f / 64.0f), var = fmaxf(q * (1.0f / 64.0f) - mu * mu, 0.f), rs = rsqf_(var + EPS);
            const float a0 = (acc[t].x - mu) * rs * lg.x + lb.x, a1 = (acc[t].y - mu) * rs * lg.y + lb.y;
            *(unsigned*)(MIX + (size_t)(b * SEQ + t0 + tl0 + t) * D + 2 * cp) = cvt_pk_bf16(siluf_(a0), siluf_(a1)); }
    }
    __syncthreads();
}
__device__ __forceinline__ void vtrans_items(Frame& F, int gw, int NGW) {
    const int lane = F.lane;
    LAS unsigned char* scr = F.lds + F.wave * 9216;
    for (int it = gw; it < 1024; it += NGW) { const int ten = it >> 9, bh = (it >> 5) & 15, kb = it & 31;
        const bf16_t* V = (const bf16_t*)(F.ws + WS_KV) + (size_t)(ten ? 5 : 3) * KVT + ((size_t)bh * SEQ + kb * 64) * 64; bf16_t* VT = (bf16_t*)(F.ws + (ten ? WS_VWT : WS_VST)) + (size_t)bh * 64 * SEQ + kb * 64;
#pragma unroll
        for (int c = 0; c < 8; ++c) *(LAS u32x4*)(scr + lane * 144 + c * 16) = *((const u32x4*)(V + (size_t)lane * 64) + c);
        LDS_WAIT(); __builtin_amdgcn_wave_barrier(); asm volatile("" ::: "memory");
#pragma unroll
        for (int c = 0; c < 8; ++c) { unsigned w[4];
#pragma unroll
            for (int q = 0; q < 4; ++q) { const int v0 = 8 * c + 2 * q, k0 = swap23(v0), k1 = swap23(v0 + 1);
                w[q] = (unsigned)*(const LAS bf16_t*)(scr + k0 * 144 + lane * 2) | ((unsigned)*(const LAS bf16_t*)(scr + k1 * 144 + lane * 2) << 16); }
            *((u32x4*)(VT + (size_t)lane * SEQ) + c) = (u32x4){w[0], w[1], w[2], w[3]}; }
        LDS_WAIT(); __builtin_amdgcn_wave_barrier(); asm volatile("" ::: "memory");
    }
}
__device__ __forceinline__ void phase_cmp2(Frame& F, int layer) {
    const int lane = F.lane, w = F.wave, k0 = 32 * w;
    const float* H1 = (const float*)(F.ws + WS_H1); const float* B1P = (const float*)(F.ws + WS_CTL) + CW_B1P + layer * 512;
    LAS float* part = (LAS float*)F.lds;
#pragma nounroll
    for (int un = F.c; un < 256; un += F.G) { const int kv = un >> 7, R0 = (un & 127) * 16;
        const float* w2 = (kv ? INP_(I_VW2) : INP_(I_KW2)) + (size_t)layer * 16384 + (size_t)k0 * 64 + lane;
        float w2r[32];
#pragma unroll
        for (int j = 0; j < 32; ++j) w2r[j] = w2[j * 64];
        float bsum = 0.f;
#pragma unroll
        for (int sp = 0; sp < 8; ++sp) bsum += B1P[sp * 1024 + kv * 256 + k0 + (lane & 31)];
        float acc[16], hx[16];
        {
            float hp[16][8];
#pragma unroll
            for (int r = 0; r < 16; ++r)
#pragma unroll
                for (int sp = 0; sp < 8; ++sp) hp[r][sp] = H1[((size_t)kv * 2048 + R0 + r) * 256 + k0 + (lane & 31) + (size_t)sp * 2 * 2048 * 256];
#pragma unroll
            for (int r = 0; r < 16; ++r) { float x = 0.f;
#pragma unroll
                for (int sp = 0; sp < 8; ++sp) x += hp[r][sp];
                hx[r] = siluf_(x + bsum); } }
#pragma unroll
        for (int r = 0; r < 16; ++r) { const int hb = __builtin_bit_cast(int, hx[r]); float a = 0.f;
#pragma unroll
            for (int j = 0; j < 32; ++j) a += __builtin_bit_cast(float, __builtin_amdgcn_readlane(hb, j)) * w2r[j];
            acc[r] = a; }
#pragma unroll
        for (int r = 0; r < 16; ++r) part[(w * 16 + r) * 64 + lane] = acc[r];
        __syncthreads();
#pragma unroll
        for (int rr = 0; rr < 2; ++rr) { const int r = 2 * w + rr, R = R0 + r;
            float a = (kv ? INP_(I_VB2) : INP_(I_KB2))[layer * 64 + lane];
#pragma unroll
            for (int ww = 0; ww < 8; ++ww) a += part[(ww * 16 + r) * 64 + lane];
            if ((R & 127) == 127) a = 0.f;
            else if (kv == 0) { const float ms = wave_sum_u(a * a) * (1.0f / 64.0f); a = a * (rsqf_(ms + EPS)) * INP_(I_KG)[layer * 192 + lane]; }
            const bf16_t ab = (bf16_t)(cvt_pk_bf16(a, 0.f) & 0xffffu);
            ((bf16_t*)(F.ws + (kv ? WS_VC : WS_KC)))[(size_t)R * 64 + lane] = ab;
            if (kv) ((bf16_t*)(F.ws + WS_VCT))[((size_t)(R >> 7) * 64 + lane) * 128 + swap23(R & 127)] = ab; }
        __syncthreads();
    }
}

__device__ __forceinline__ void dots4(const bf16_t* krow, const LAS float* qs, float (&s)[4]) {
    s[0] = s[1] = s[2] = s[3] = 0.f;
#pragma nounroll
    for (int c = 0; c < 8; ++c) { const u32x4 v = *((const u32x4*)krow + c);
        const float f[8] = {bf_lo(v.x), bf_hi(v.x), bf_lo(v.y), bf_hi(v.y), bf_lo(v.z), bf_hi(v.z), bf_lo(v.w), bf_hi(v.w)};
#pragma unroll
        for (int h = 0; h < 4; ++h) { const f32x4 q0 = *(const LAS f32x4*)(qs + h * 64 + c * 8), q1 = *(const LAS f32x4*)(qs + h * 64 + c * 8 + 4);
            s[h] += (f[0] * q0.x + f[1] * q0.y) + (f[2] * q0.z + f[3] * q0.w) + (f[4] * q1.x + f[5] * q1.y) + (f[6] * q1.z + f[7] * q1.w); } }
}
__device__ __forceinline__ void softmax_pv(LAS f32x4* sb, const LAS int* kb, int nk, const bf16_t* V, int lane, float (&o)[4]) {
    float m[4] = {-1e30f, -1e30f, -1e30f, -1e30f};
#pragma nounroll
    for (int c = 0; c < nk; ++c) { const f32x4 s = sb[c * 64 + lane]; m[0] = fmaxf(m[0], s.x); m[1] = fmaxf(m[1], s.y); m[2] = fmaxf(m[2], s.z); m[3] = fmaxf(m[3], s.w); }
#pragma unroll
    for (int h = 0; h < 4; ++h) m[h] = wave_max(m[h]);
    float sum[4] = {0.f, 0.f, 0.f, 0.f};
#pragma nounroll
    for (int c = 0; c < nk; ++c) { const f32x4 s = sb[c * 64 + lane]; f32x4 p;
        p.x = s.x > -1e29f ? __expf(s.x - m[0]) : 0.f; p.y = s.y > -1e29f ? __expf(s.y - m[1]) : 0.f; p.z = s.z > -1e29f ? __expf(s.z - m[2]) : 0.f; p.w = s.w > -1e29f ? __expf(s.w - m[3]) : 0.f;
        sum[0] += p.x; sum[1] += p.y; sum[2] += p.z; sum[3] += p.w; sb[c * 64 + lane] = p; }
    float inv[4];
#pragma unroll
    for (int h = 0; h < 4; ++h) inv[h] = rcpf_(fmaxf(wave_sum(sum[h]), 1e-30f));
    LDS_WAIT(); __builtin_amdgcn_wave_barrier(); asm volatile("" ::: "memory");
    o[0] = o[1] = o[2] = o[3] = 0.f;
#pragma nounroll
    for (int c = 0; c < nk; ++c) { const int k0 = kb[c];
#pragma unroll 4
        for (int kk = 0; kk < 64; ++kk) { int key = k0 + kk; key = key < 0 ? 0 : (key > SEQ - 1 ? SEQ - 1 : key);
            const f32x4 p = sb[c * 64 + kk]; const float v = bf2f(V[(size_t)key * 64 + lane]);
            o[0] += p.x * v; o[1] += p.y * v; o[2] += p.z * v; o[3] += p.w * v; } }
#pragma unroll
    for (int h = 0; h < 4; ++h) o[h] *= inv[h];
    __builtin_amdgcn_wave_barrier(); asm volatile("" ::: "memory");
}
__device__ __forceinline__ void phase_attn_ref(Frame& F, int layer) {
    const int lane = F.lane;
    LAS unsigned char* wl = F.lds + F.wave * 12288;
    LAS float* qs = (LAS float*)wl;
    LAS f32x4* pc = (LAS f32x4*)(wl + 1024);
    LAS float* psum = (LAS float*)(wl + 3072);
    LAS int* kbl = (LAS int*)(wl + 3584);
    LAS f32x4* sb = (LAS f32x4*)(wl + 4096);
    const bf16_t* QN = (const bf16_t*)(F.ws + WS_Q); const bf16_t* KVb = (const bf16_t*)(F.ws + WS_KV);
    const bf16_t* KC = (const bf16_t*)(F.ws + WS_KC); const bf16_t* VC = (const bf16_t*)(F.ws + WS_VC);
    const float* GT = (const float*)(F.ws + WS_GT); bf16_t* MIX = (bf16_t*)(F.ws + WS_MIX);
#pragma nounroll
    for (int un = F.c; un < NBH * 64; un += F.G) {
        const int bh = un >> 6, tile = un & 63, b = bh >> 1, kvh = bh & 1;
        const bf16_t* KS = KVb + 2 * KVT + (size_t)bh * SEQ * 64; const bf16_t* VS = KVb + 3 * KVT + (size_t)bh * SEQ * 64;
        const bf16_t* KW = KVb + 4 * KVT + (size_t)bh * SEQ * 64; const bf16_t* VW = KVb + 5 * KVT + (size_t)bh * SEQ * 64;
#pragma nounroll
        for (int ti = 0; ti < 4; ++ti) {
            const int t = tile * 32 + F.wave * 4 + ti, r = b * SEQ + t;
#pragma unroll
            for (int h = 0; h < 4; ++h) qs[h * 64 + lane] = bf2f(QN[(size_t)r * 512 + (kvh * 4 + h) * 64 + lane]);
            LDS_WAIT(); __builtin_amdgcn_wave_barrier(); asm volatile("" ::: "memory");
            float sc[2][4]; bool vc[2];
#pragma unroll
            for (int u = 0; u < 2; ++u) { const int c = lane + 64 * u; vc[u] = (c < NCMP) && (16 * c + 31 <= t);
                if (vc[u]) dots4(KC + ((size_t)bh * 128 + c) * 64, qs, sc[u]); else { sc[u][0] = sc[u][1] = sc[u][2] = sc[u][3] = -1e30f; } }
            float pr[2][4];
#pragma unroll
            for (int h = 0; h < 4; ++h) { const float mx = wave_max(fmaxf(sc[0][h], sc[1][h]));
                pr[0][h] = vc[0] ? __expf(sc[0][h] - mx) : 0.f; pr[1][h] = vc[1] ? __expf(sc[1][h] - mx) : 0.f;
                const float inv = rcpf_(fmaxf(wave_sum(pr[0][h] + pr[1][h]), 1e-30f)); pr[0][h] *= inv; pr[1][h] *= inv; }
#pragma unroll
            for (int u = 0; u < 2; ++u) { pc[lane + 64 * u] = (f32x4){pr[u][0], pr[u][1], pr[u][2], pr[u][3]}; psum[lane + 64 * u] = (pr[u][0] + pr[u][1]) + (pr[u][2] + pr[u][3]); }
            LDS_WAIT(); __builtin_amdgcn_wave_barrier(); asm volatile("" ::: "memory");
            const int j = lane & 31, cur = t >> 6; float imp = 0.f;
#pragma unroll
            for (int cc = -1; cc <= 3; ++cc) { const int c = 4 * j + cc; if (c >= 0 && c < NCMP) imp += psum[c]; }
            const bool causal = (j * 64 <= t), forced = (j == 0) || (j == cur) || (j == cur - 1);
            const float score = causal ? (forced ? imp + 1e4f : imp) : -1e30f;
            int rank = 0;
#pragma unroll
            for (int i = 0; i < 32; ++i) { const float si = __shfl(score, i); rank += (si > score || (si == score && i < j)) ? 1 : 0; }
            const unsigned selmask = (unsigned)__ballot(lane < 32 && rank < 8 && causal);
            float ocmp[4] = {0.f, 0.f, 0.f, 0.f};
            { const int nvc = t >= 31 ? (((t - 31) >> 4) + 1 > NCMP ? NCMP : ((t - 31) >> 4) + 1) : 0;
#pragma unroll 4
              for (int c = 0; c < nvc; ++c) { const f32x4 p = pc[c]; const float v = bf2f(VC[((size_t)bh * 128 + c) * 64 + lane]); ocmp[0] += p.x * v; ocmp[1] += p.y * v; ocmp[2] += p.z * v; ocmp[3] += p.w * v; } }
            __builtin_amdgcn_wave_barrier(); asm volatile("" ::: "memory");
            int nk = 0; float osel[4], owin[4];
#pragma nounroll
            for (unsigned mm = selmask; mm != 0u && nk < 8; mm &= mm - 1u) { const int jj = __builtin_ctz(mm);
                const int key = jj * 64 + lane; float s[4];
                if (key <= t) dots4(KS + (size_t)key * 64, qs, s); else { s[0] = s[1] = s[2] = s[3] = -1e30f; }
                sb[nk * 64 + lane] = (f32x4){s[0], s[1], s[2], s[3]};
                if (lane == 0) kbl[nk] = jj * 64;
                ++nk; }
            LDS_WAIT(); __builtin_amdgcn_wave_barrier(); asm volatile("" ::: "memory");
            softmax_pv(sb, kbl, nk, VS, lane, osel);
            nk = 0;
#pragma nounroll
            for (int ch = 0; ch < 8; ++ch) { const int k0 = t - 511 + 64 * ch; if (k0 + 63 < 0) continue;
                const int key = k0 + lane; float s[4];
                if (key >= 0) dots4(KW + (size_t)key * 64, qs, s); else { s[0] = s[1] = s[2] = s[3] = -1e30f; }
                sb[nk * 64 + lane] = (f32x4){s[0], s[1], s[2], s[3]};
                if (lane == 0) kbl[nk] = k0;
                ++nk; }
            LDS_WAIT(); __builtin_amdgcn_wave_barrier(); asm volatile("" ::: "memory");
            softmax_pv(sb, kbl, nk, VW, lane, owin);
#pragma unroll
            for (int h = 0; h < 4; ++h) { const float* gp = GT + (size_t)r * 24 + (kvh * 4 + h) * 3;
                const float o = sigmoidf_(gp[0]) * ocmp[h] + sigmoidf_(gp[1]) * osel[h] + sigmoidf_(gp[2]) * owin[h];
                MIX[(size_t)r * D + 512 + (kvh * 4 + h) * 64 + lane] = (bf16_t)(cvt_pk_bf16(o, 0.f) & 0xffffu); }
            __builtin_amdgcn_wave_barrier(); asm volatile("" ::: "memory");
        }
    }
}


constexpr int AT_KB = 0, AT_VB = 18432, AT_WUN = 36864, AT_OT = 40960;
__device__ __forceinline__ int crow_(int i) { return (i & 3) + 8 * (i >> 2); }
__device__ __forceinline__ float fmax_(float a, float b) { return __builtin_amdgcn_fmed3f(a, b, __builtin_inff()); }
template <int MODE>
__device__ __forceinline__ void attn_tile(const LAS unsigned char* KB, const LAS unsigned char* VB, const bf16x8 (&Qf)[4], f32x16 (&O)[2], float cref, float& l, int tl, int lo, bool rowok, int n, int h) {
    f32x16 S0, S1;
#pragma unroll
    for (int i = 0; i < 16; ++i) { S0[i] = 0.f; S1[i] = 0.f; }
#pragma unroll
    for (int s = 0; s < 4; ++s) { const bf16x8 k0 = *(const LAS bf16x8*)(KB + n * 144 + (16 * s + 8 * h) * 2), k1 = *(const LAS bf16x8*)(KB + (32 + n) * 144 + (16 * s + 8 * h) * 2);
        S0 = MFMA32(k0, Qf[s], S0); S1 = MFMA32(k1, Qf[s], S1); }
    if (MODE != 0) {
#pragma unroll
        for (int i = 0; i < 16; ++i) { const int c0 = crow_(i), c1 = 32 + crow_(i);
            if (MODE == 2) { S0[i] = (c0 <= tl && c0 > lo) ? S0[i] : -1e30f; S1[i] = (c1 <= tl && c1 > lo) ? S1[i] : -1e30f; } } }
    f32x2 ls2 = {0.f, 0.f}; const float crow = (MODE == 1) ? (rowok ? cref : 1e30f) : cref; const f32x2 mr2 = {crow, crow};
#pragma unroll
    for (int i = 0; i < 8; ++i) { f32x2 a = (f32x2){S0[2 * i], S0[2 * i + 1]} - mr2, b = (f32x2){S1[2 * i], S1[2 * i + 1]} - mr2;
        a.x = __builtin_amdgcn_exp2f(a.x); a.y = __builtin_amdgcn_exp2f(a.y); b.x = __builtin_amdgcn_exp2f(b.x); b.y = __builtin_amdgcn_exp2f(b.y);
        S0[2 * i] = a.x; S0[2 * i + 1] = a.y; S1[2 * i] = b.x; S1[2 * i + 1] = b.y; ls2 += a + b; }
    l += ls2.x + ls2.y;
    const bf16x8 P00 = pack8<0>(S0), P01 = pack8<8>(S0), P10 = pack8<0>(S1), P11 = pack8<8>(S1);
    __builtin_amdgcn_sched_barrier(0);
#pragma unroll
    for (int d = 0; d < 2; ++d) { const LAS unsigned char* vb = VB + (32 * d + n) * 144 + 8 * h * 2;
        O[d] = MFMA32(*(const LAS bf16x8*)(vb + 0), P00, O[d]); O[d] = MFMA32(*(const LAS bf16x8*)(vb + 32), P01, O[d]);
        O[d] = MFMA32(*(const LAS bf16x8*)(vb + 64), P10, O[d]); O[d] = MFMA32(*(const LAS bf16x8*)(vb + 96), P11, O[d]); }
}
__device__ __forceinline__ void attn_stage64(LAS unsigned char* lds, const bf16_t* K, const bf16_t* VT, int tid) {
    const int row = tid >> 3, ch = tid & 7;
    const u32x4 kv = *((const u32x4*)K + tid), vv = *(const u32x4*)(VT + (size_t)row * SEQ + ch * 8);
    *(LAS u32x4*)(lds + AT_KB + row * 144 + ch * 16) = kv; *(LAS u32x4*)(lds + AT_VB + row * 144 + ch * 16) = vv;
}
__device__ __forceinline__ void phase_attn_mfma(Frame& F, int layer) {
    const int lane = F.lane, tid = F.tid, n = lane & 31, h = lane >> 5, w = F.wave;
    LAS unsigned char* lds = F.lds; const LAS unsigned char* KB = lds + AT_KB; const LAS unsigned char* VB = lds + AT_VB; volatile LAS unsigned* WUN = (volatile LAS unsigned*)(lds + AT_WUN);
    const bf16_t* QN = (const bf16_t*)(F.ws + WS_Q); const bf16_t* KVb = (const bf16_t*)(F.ws + WS_KV);
    const bf16_t* KC = (const bf16_t*)(F.ws + WS_KC); const bf16_t* VCT = (const bf16_t*)(F.ws + WS_VCT);
    const bf16_t* VST = (const bf16_t*)(F.ws + WS_VST); const bf16_t* VWT = (const bf16_t*)(F.ws + WS_VWT);
    const float* GT = (const float*)(F.ws + WS_GT); bf16_t* MIX = (bf16_t*)(F.ws + WS_MIX);
    float cref;
    { const float gq = fabsf(INP_(I_QG)[layer * 64 + lane]); const float* kg = INP_(I_KG) + layer * 192;
      const float gk = fmaxf(fabsf(kg[lane]), fmaxf(fabsf(kg[64 + lane]), fabsf(kg[128 + lane])));
      const float bound = 1.44269504089f * 8.0f * wave_max(gq) * wave_max(gk); cref = fmaxf(bound - 16.0f, 0.f); }
#pragma nounroll
    for (int ui = 0; ui < 2; ++ui) {
        const int bh = (F.c >> 5) + 8 * ui, tb = ui ? 31 - (F.c & 31) : (F.c & 31);
        if (F.c >= 256) break;
        const int b = bh >> 1, kvh = bh & 1, t0 = tb * 64, cur = tb;
        const int tt = t0 + 8 * w + (n >> 2), hd = n & 3; const size_t r = (size_t)b * SEQ + tt;
        bf16x8 Qf[4]; { const bf16_t* qp = QN + r * 512 + (kvh * 4 + hd) * 64 + 8 * h;
#pragma unroll
            for (int s = 0; s < 4; ++s) Qf[s] = *(const bf16x8*)(qp + 16 * s); }
        {
            float qv[4][8]; float ss = 0.f;
#pragma unroll
            for (int s = 0; s < 4; ++s) { const u32x4 wq = __builtin_bit_cast(u32x4, Qf[s]);
                qv[s][0] = bf_lo(wq.x); qv[s][1] = bf_hi(wq.x); qv[s][2] = bf_lo(wq.y); qv[s][3] = bf_hi(wq.y); qv[s][4] = bf_lo(wq.z); qv[s][5] = bf_hi(wq.z); qv[s][6] = bf_lo(wq.w); qv[s][7] = bf_hi(wq.w);
#pragma unroll
                for (int j = 0; j < 8; ++j) ss += qv[s][j] * qv[s][j]; }
            ss += __shfl_xor(ss, 32);
            const float rsq = rsqf_(ss * (1.0f / 64.0f) + EPS) * (0.125f * 1.44269504089f); const float* qg     = INP_(I_QG) + layer * 64 + 8 * h;
#pragma unroll
            for (int s = 0; s < 4; ++s) { const f32x4 ga = *(const f32x4*)(qg + 16 * s), gb = *(const f32x4*)(qg + 16 * s + 4);
                u32x4 wq; wq.x = pk_bf16(qv[s][0] * rsq * ga.x, qv[s][1] * rsq * ga.y); wq.y = pk_bf16(qv[s][2] * rsq * ga.z, qv[s][3] * rsq * ga.w);
                wq.z = pk_bf16(qv[s][4] * rsq * gb.x, qv[s][5] * rsq * gb.y); wq.w = pk_bf16(qv[s][6] * rsq * gb.z, qv[s][7] * rsq * gb.w); Qf[s] = __builtin_bit_cast(bf16x8, wq); } }
        const float* gp = GT + r * 24 + (kvh * 4 + hd) * 3; const float g0 = sigmoidf_(gp[0]), g1 = sigmoidf_(gp[1]), g2 = sigmoidf_(gp[2]);
        f32x16 Ob[2]; LAS f32x4* OT = (LAS f32x4*)(lds + AT_OT + w * 8192) + lane;
        unsigned tokmask, wmask;
        __syncthreads();
#pragma unroll
        for (int q = 0; q < 2; ++q) { const int i = tid + 512 * q;
            *(LAS u32x4*)(lds + AT_KB + (i >> 3) * 144 + (i & 7) * 16) = *((const u32x4*)(KC + (size_t)bh * 128 * 64) + i);
            *(LAS u32x4*)(lds + AT_VB + (i >> 4) * 272 + (i & 15) * 16) = *((const u32x4*)(VCT + (size_t)bh * 64 * 128) + i); }
        __syncthreads();
        {
            f32x16 S[4];
#pragma unroll
            for (int ta = 0; ta < 4; ++ta) {
#pragma unroll
                for (int i = 0; i < 16; ++i) S[ta][i] = 0.f;
#pragma unroll
                for (int s = 0; s < 4; ++s) S[ta] = MFMA32(*(const LAS bf16x8*)(KB + (32 * ta + n) * 144 + (16 * s + 8 * h) * 2), Qf[s], S[ta]); }
            const int cmax = tt >= 31 ? (((tt - 31) >> 4) > 126 ? 126 : ((tt - 31) >> 4)) : -1, lim = cmax - 4 * h;
            float ls = 0.f;
#pragma unroll
            for (int ta = 0; ta < 4; ++ta)
#pragma unroll
                for (int i = 0; i < 16; ++i) { const float p = (32 * ta + crow_(i) <= lim) ? __builtin_amdgcn_exp2f(S[ta][i] - cref) : 0.f; S[ta][i] = p; ls += p; }
            ls += __shfl_xor(ls, 32);
            const float inv = rcpf_(fmaxf(ls, 1e-30f));
#pragma unroll
            for (int ta = 0; ta < 4; ++ta)
#pragma unroll
                for (int i = 0; i < 16; ++i) S[ta][i] *= inv;
            float val[4][4]; unsigned kk[4];
#pragma unroll
            for (int ta = 0; ta < 4; ++ta)
#pragma unroll
                for (int u = 0; u < 4; ++u) { val[ta][u] = (S[ta][4 * u] + S[ta][4 * u + 1]) + (S[ta][4 * u + 2] + S[ta][4 * u + 3]); }
            {   float xs[4][4];
#pragma unroll
                for (int ta = 0; ta < 4; ++ta)
#pragma unroll
                    for (int u = 0; u < 4; ++u) xs[ta][u] = __shfl_xor(S[ta][4 * u + 3], 32);
#pragma unroll
                for (int ta = 0; ta < 4; ++ta)
#pragma unroll
                    for (int u = 0; u < 4; ++u) { const float pv0 = (u > 0) ? xs[ta][u > 0 ? u - 1 : 0] : (ta > 0 ? xs[ta > 0 ? ta - 1 : 0][3] : 0.f); val[ta][u] += (h ? xs[ta][u] : pv0); } }
            const bf16x8 P0 = pack8<0>(S[0]), P1 = pack8<8>(S[0]), P2 = pack8<0>(S[1]), P3 = pack8<8>(S[1]), P4 = pack8<0>(S[2]), P5 = pack8<8>(S[2]), P6 = pack8<0>(S[3]), P7 = pack8<8>(S[3]);
            __builtin_amdgcn_sched_barrier(0);
            const bool b0 = (n & 1) != 0, b1 = (n & 2) != 0; const int hd2 = 2 * (n & 3) + h;
#define DPPF(x, ctrl) __builtin_bit_cast(float, __builtin_amdgcn_update_dpp(0, __builtin_bit_cast(int, (x)), (ctrl), 0xF, 0xF, true))
#define DPPU(x, ctrl) ((unsigned)__builtin_amdgcn_update_dpp(0, (int)(x), (ctrl), 0xF, 0xF, true))
#pragma unroll
            for (int ta = 0; ta < 4; ++ta) {
                const float m0 = b0 ? val[ta][1] : val[ta][0], s0 = b0 ? val[ta][0] : val[ta][1], m1 = b0 ? val[ta][3] : val[ta][2], s1 = b0 ? val[ta][2] : val[ta][3];
                const float r0 = m0 + DPPF(s0, 0xB1), r1 = m1 + DPPF(s1, 0xB1);
                const float mm = b1 ? r1 : r0, ss = b1 ? r0 : r1; const float v = mm + DPPF(ss, 0x4E);
                const int G = 8 * ta + hd2; const bool causal = G <= cur, forced = (G == 0) || (G == cur) || (G == cur - 1);
                kk[ta] = causal ? ((forced ? 0x7f000000u : (__float_as_uint(v) & ~31u)) | (unsigned)(31 - G)) : 0u; }
            __builtin_amdgcn_sched_barrier(0);
#pragma unroll
            for (int d = 0; d < 2; ++d) {
#pragma unroll
                for (int i = 0; i < 16; ++i) Ob[d][i] = 0.f;
                const LAS unsigned char* vb = VB + (32 * d + n) * 272 + 8 * h * 2;
                Ob[d] = MFMA32(*(const LAS bf16x8*)(vb + 0), P0, Ob[d]); Ob[d] = MFMA32(*(const LAS bf16x8*)(vb + 32), P1, Ob[d]);
                Ob[d] = MFMA32(*(const LAS bf16x8*)(vb + 64), P2, Ob[d]); Ob[d] = MFMA32(*(const LAS bf16x8*)(vb + 96), P3, Ob[d]);
                Ob[d] = MFMA32(*(const LAS bf16x8*)(vb + 128), P4, Ob[d]); Ob[d] = MFMA32(*(const LAS bf16x8*)(vb + 160), P5, Ob[d]);
                Ob[d] = MFMA32(*(const LAS bf16x8*)(vb + 192), P6, Ob[d]); Ob[d] = MFMA32(*(const LAS bf16x8*)(vb + 224), P7, Ob[d]);
#pragma unroll
                for (int q = 0; q < 4; ++q) OT[(4 * d + q) * 64] = (f32x4){Ob[d][4 * q] * g0, Ob[d][4 * q + 1] * g0, Ob[d][4 * q + 2] * g0, Ob[d][4 * q + 3] * g0}; }
            __builtin_amdgcn_sched_barrier(0);
            unsigned selbits = 0u;
#pragma unroll
            for (int rd = 0; rd < 8; ++rd) { unsigned mk = kk[0] > kk[1] ? kk[0] : kk[1]; { const unsigned m2 = kk[2] > kk[3] ? kk[2] : kk[3]; mk = m2 > mk ? m2 : mk; }
                { const unsigned o = DPPU(mk, 0xB1); mk = o > mk ? o : mk; } { const unsigned o = DPPU(mk, 0x4E); mk = o > mk ? o : mk; }
                { const unsigned o = (unsigned)__shfl_xor((int)mk, 32); mk = o > mk ? o : mk; }
#pragma unroll
                for (int ta = 0; ta < 4; ++ta) { const bool hit = (kk[ta] == mk) && (mk != 0u); selbits |= hit ? ((1u << (8 * ta)) << hd2) : 0u; kk[ta] = hit ? 0u : kk[ta]; } }
            selbits |= DPPU(selbits, 0xB1); selbits |= DPPU(selbits, 0x4E);
            tokmask = selbits | (unsigned)__shfl_xor((int)selbits, 32);
#undef DPPF
#undef DPPU
            unsigned wm = tokmask; wm |= (unsigned)__shfl_xor((int)wm, 4); wm |= (unsigned)__shfl_xor((int)wm, 8); wm |= (unsigned)__shfl_xor((int)wm, 16);
            wmask = (unsigned)__builtin_amdgcn_readfirstlane((int)wm);
            if (lane == 0) WUN[w] = wmask;
        }
        __syncthreads();
        unsigned uall = 0u;
#pragma unroll
        for (int q = 0; q < 8; ++q) uall |= WUN[q];
        uall = (unsigned)__builtin_amdgcn_readfirstlane((int)uall);
        if (PROBE_MASK & 0x6000000u) { if (lane == 0) ((unsigned*)(F.ws + WS_SLOT + 3 * MAXSLOT * 4))[(blockIdx.x * 2 + ui) * 8 + w] = (unsigned)__builtin_popcount(uall) | ((unsigned)__builtin_popcount(wmask) << 8); }
        float l = 0.f;
#pragma unroll
        for (int d = 0; d < 2; ++d)
#pragma unroll
            for (int i = 0; i < 16; ++i) Ob[d][i] = 0.f;
        const int j0 = cur > 8 ? cur - 8 : 0, nwin = cur - j0 + 1, ntile = nwin + __builtin_popcount(uall);
        const int srow = tid >> 3, sch = tid & 7;
        int lidx = 0, cidx = 0; unsigned lmm = uall, cmm = uall; u32x4 rk0, rv0, rk1, rv1, rk2, rv2;
#define AT_NEXT(idx, mm, wh, jj) do { if ((idx) < nwin) { (wh) = 1; (jj) = j0 + (idx); } else { (wh) = 0; (jj) = (mm) ? __builtin_ctz(mm) : 0; (mm) &= (mm) - 1u; } ++(idx); } while (0)
#define AT_LOAD(rk, rv) do { int _wh, _jj; AT_NEXT(lidx, lmm, _wh, _jj); const bf16_t* _kp = KVb + (size_t)(_wh ? 4 : 2) * KVT + ((size_t)bh * SEQ + _jj * 64) * 64; const bf16_t* _vp = (_wh ? VWT : VST) + (size_t)bh * 64 * SEQ + _jj * 64; \
        rk = *((const u32x4*)_kp + tid); rv = *(const u32x4*)(_vp + (size_t)srow * SEQ + sch * 8); } while (0)
#define AT_WRITE(b, rk, rv) do { *(LAS u32x4*)(lds + (b) * 18432 + srow * 144 + sch * 16) = rk; *(LAS u32x4*)(lds + (b) * 18432 + 9216 + srow * 144 + sch * 16) = rv; } while (0)
        AT_LOAD(rk0, rv0); AT_LOAD(rk1, rv1); AT_LOAD(rk2, rv2);
        AT_WRITE(0, rk0, rv0);
        AT_LOAD(rk0, rv0);
#define AT_STEP(i, RK, RV) do { asm volatile("s_waitcnt lgkmcnt(0)" ::: "memory"); __builtin_amdgcn_s_barrier(); asm volatile("" ::: "memory"); \
            AT_WRITE(((i) + 1) & 1, RK, RV); AT_LOAD(RK, RV); \
            int wh, j; AT_NEXT(cidx, cmm, wh, j); \
            if (i == nwin) { \
                const float lt = l + __shfl_xor(l, 32), sc = g2 * rcpf_(fmaxf(lt, 1e-30f)); \
_Pragma("unroll") \
                for (int d = 0; d < 2; ++d) \
_Pragma("unroll") \
                    for (int q = 0; q < 4; ++q) { f32x4 o = OT[(4 * d + q) * 64]; o.x += Ob[d][4 * q] * sc; o.y += Ob[d][4 * q + 1] * sc; o.z += Ob[d][4 * q + 2] * sc; o.w += Ob[d][4 * q + 3] * sc; OT[(4 * d + q) * 64] = o; \
                        Ob[d][4 * q] = 0.f; Ob[d][4 * q + 1] = 0.f; Ob[d][4 * q + 2] = 0.f; Ob[d][4 * q + 3] = 0.f; } \
                l = 0.f; } \
            const LAS unsigned char* kb = lds + (i & 1) * 18432; const LAS unsigned char* vb = kb + 9216; \
            const int tl = tt - 64 * j - 4 * h; \
            if (wh) { if (j == cur || j == cur - 8) attn_tile<2>(kb, vb, Qf, Ob, cref, l, tl, j == cur - 8 ? tl - 512 : -100000, true, n, h); else attn_tile<0>(kb, vb, Qf, Ob, cref, l, 0, 0, true, n, h); } \
            else if ((wmask >> j) & 1u) { const bool rowok = ((tokmask >> j) & 1u) != 0u; \
                if (j == cur) attn_tile<2>(kb, vb, Qf, Ob, cref, l, rowok ? tl : -1, -100000, true, n, h); else attn_tile<1>(kb, vb, Qf, Ob, cref, l, 0, 0, rowok, n, h); } \
        } while (0)
#pragma nounroll
        for (int i = 0; i < ntile; i += 3) { AT_STEP(i, rk1, rv1); if (i + 1 >= ntile) break; AT_STEP(i + 1, rk2, rv2); if (i + 2 >= ntile) break; AT_STEP(i + 2, rk0, rv0); }
#undef AT_STEP
#undef AT_NEXT
#undef AT_LOAD
#undef AT_WRITE
        { const float lt = l + __shfl_xor(l, 32), sc = g1 * rcpf_(fmaxf(lt, 1e-30f));
          bf16_t* op = MIX + r * D + 512 + (kvh * 4 + hd) * 64 + 4 * h;
#pragma unroll
          for (int d = 0; d < 2; ++d)
#pragma unroll
            for (int u = 0; u < 4; ++u) { const f32x4 o = OT[(4 * d + u) * 64]; u32x2 ov; ov.x = pk_bf16(o.x + Ob[d][4 * u] * sc, o.y + Ob[d][4 * u + 1] * sc); ov.y = pk_bf16(o.z + Ob[d][4 * u + 2] * sc, o.w + Ob[d][4 * u + 3] * sc);
                *(u32x2*)(op + 32 * d + 8 * u) = ov; } }
    }
}

__device__ __forceinline__ int build_ptab(Frame& F) {
    LAS int* ptab = (LAS int*)(F.lds + PTAB_OFF);
    const unsigned* cnt = (const unsigned*)(F.ws + WS_CTL) + CW_CNT;
    if (F.tid < 64) {
        const int e = F.tid; const unsigned c = (e < NE) ? __hip_atomic_load(cnt + 64 * e, __ATOMIC_RELAXED, __HIP_MEMORY_SCOPE_AGENT) : 0u;
        const int n = (int)((c + 255u) >> 8); int incl = n;
#pragma unroll
        for (int o = 1; o < 8; o <<= 1) { const int t = __shfl_up(incl, o); if (e >= o) incl += t; }
        const int excl = incl - n;
        if (e < NE) { ptab[MAXPAN + 8 + e] = excl * 256; for (int i = 0; i < n && excl + i < MAXPAN; ++i) ptab[excl + i] = e; }
        if (e == NE - 1) ptab[MAXPAN] = incl < MAXPAN ? incl : MAXPAN; }
    __syncthreads();
    return ptab[MAXPAN];
}

template <unsigned KM> __global__ void __launch_bounds__(NTHR, 2) fwd(Args args) {
    extern __shared__ __attribute__((aligned(16))) unsigned char lds_raw[];
    Frame F; F.lds = (LAS unsigned char*)lds_raw; F.tid = threadIdx.x; F.lane = F.tid & 63; F.wave = __builtin_amdgcn_readfirstlane(F.tid >> 6);
    F.G = gridDim.x; F.c = blockIdx.x; F.in = args.in; F.out = args.out; F.ws = args.ws;
    volatile LAS unsigned* MISC = (volatile LAS unsigned*)(F.lds + MISC_OFF);
    if (F.tid < 64) MISC[F.tid] = 0u;
    __syncthreads();
    unsigned* ctl = (unsigned*)(F.ws + WS_CTL);
#if MK_PER_PHASE
#define SEAM() do {} while (0)
#else
    XcdBarrier bar = xcd_barrier_post(ctl + CW_BAR, MISC);
#define SEAM() xcd_barrier(bar)
#endif
    const int lo = args.ph_lo, hi = args.ph_hi;
#define KON(kind) (((KM) >> (kind)) & 1u)
#define IN(k) (lo <= (k) && (k) < hi)
#define gw (F.c * NWAVES + F.wave)
#define NGW (F.G * NWAVES)
#define XB ((bf16_t*)(F.ws + WS_XB))
#define RS ((float*)(F.ws + WS_RSTD))

    if (KON(0) && IN(0)) { FRESH_TID(F); PMARK(0); phase_prologue(F); SEAM(); }

    for (int layer = 0; layer < 2; ++layer) {
        const int pb = 1 + 12 * layer;
        if (KON(1) && IN(pb + 0)) { FRESH_TID(F); PMARK(pb + 0);
            pg8::Gemm g{XB, (const bf16_t*)(F.ws + WS_WIN) + (size_t)layer * INP * D, D, D, D}; pg8::SchedGrid S; S.init(M / 256, INP / 256, F.G, F.c, D, D);
            EpiIn E{RS, (bf16_t*)(F.ws + WS_U), (bf16_t*)(F.ws + WS_Q), (bf16_t*)(F.ws + WS_KV), (float*)(F.ws + WS_GT), layer ? (const float*)(F.ws + WS_PSS) : nullptr, (LAS float*)(F.lds + RSL_OFF)};
            pg8::gemm_phase(F.lds, g, S, E); moe_conv_slot(F, layer == 0 ? 0 : 2); SEAM();
        }
        if (KON(2) && IN(pb + 1)) { FRESH_TID(F); PMARK(pb + 1);
            { pg8::Gemm g{(const bf16_t*)(F.ws + WS_KV), (const bf16_t*)(F.ws + WS_WC1), 256, 1024, 2048}; SchedCmp S{F.G, F.c, layer};
              EpiH1 E{(float*)(F.ws + WS_H1)}; pg8::gemm_phase(F.lds, g, S, E); }
            if (F.G >= 256) { if (F.c >= 128) vtrans_items(F, (F.c - 128) * NWAVES + F.wave, (F.G - 128) * NWAVES); }
            else vtrans_items(F, gw, NGW);
#ifdef ATTN_REF
            norm_rows64((bf16_t*)(F.ws + WS_Q), M * 8, INP_(I_QG) + layer * 64, 0.125f, gw, NGW, F.lane);
#endif
            norm_rows64((bf16_t*)(F.ws + WS_KV) + 2 * KVT, NBH * SEQ, INP_(I_KG) + layer * 192 + 64, 1.0f, gw, NGW, F.lane);
            norm_rows64((bf16_t*)(F.ws + WS_KV) + 4 * KVT, NBH * SEQ, INP_(I_KG) + layer * 192 + 128, 1.0f, gw, NGW, F.lane);
            SEAM();
        }
        if (KON(3) && IN(pb + 2)) { FRESH_TID(F); PMARK(pb + 2); for (int cu = F.c; cu < 512; cu += F.G) conv_unit(F, layer, cu); PMARK(30); phase_cmp2(F, layer); SEAM(); }
#ifndef ATTN_REF
        if (KON(4) && IN(pb + 3)) { FRESH_TID(F); PMARK(pb + 3); phase_attn_mfma(F, layer); SEAM(); }
#else
        if (KON(4) && IN(pb + 3)) { FRESH_TID(F); PMARK(pb + 3); phase_attn_ref(F, layer); SEAM(); }
#endif
        if (KON(5) && IN(pb + 4)) { FRESH_TID(F); PMARK(pb + 4);
            pg8::Gemm g{(const bf16_t*)(F.ws + WS_MIX), (const bf16_t*)(F.ws + WS_WOUT) + (size_t)layer * D * D, D, D, D}; pg8::SchedGrid S; S.init(M / 256, D / 256, F.G, F.c, D, D);
            { EpiRes<true> E{XB, XB, layer == 0 ? (float*)(F.ws + WS_PSS) : nullptr}; pg8::gemm_phase(F.lds, g, S, E); }
            SEAM();
        }
        if (KON(6) && IN(pb + 5) && layer == 1) { FRESH_TID(F); PMARK(pb + 5);
            f32x4 v[4];
            {
                const float* RT = (const float*)(F.ws + WS_RT); unsigned* cnt = ctl + CW_CNT; int* ROUTE = (int*)(F.ws + WS_ROUTE);
                int* stok = (int*)(F.ws + WS_SLOT);
                const int cb0 = __builtin_amdgcn_readfirstlane((int)blockIdx.x * NTHR);
#pragma nounroll
                for (int i = cb0 + F.tid; i < MAXSLOT; i += F.G * NTHR) stok[i] = -1;
                LAS f32x4* RTL = (LAS f32x4*)F.lds;
                { f32x4 sv[4];
#pragma unroll
                  for (int q = 0; q < 4; ++q) sv[q] = *((const f32x4*)RT + F.tid + q * NTHR);
#pragma unroll
                  for (int q = 0; q < 4; ++q) RTL[F.tid + q * NTHR] = sv[q]; }
                __syncthreads();
#pragma nounroll
                for (int mb0 = 0; mb0 < M; mb0 += 8 * NGW) { const int mb = mb0 + gw;
                    int me0 = -1, me1 = -1; float mw0 = 0.f, mw1 = 0.f;
#pragma nounroll
                    for (int i4 = 0; i4 < 8; i4 += 4) {
                        f32x4 xv[4][4];
#pragma unroll
                        for (int q = 0; q < 4; ++q) { const int m = mb + (i4 + q) * NGW; const u32x2* xr = (const u32x2*)(XB + (size_t)(m < M ? m : 0) * D) + F.lane;
#pragma unroll
                            for (int j = 0; j < 4; ++j) { const u32x2 wv = xr[64 * j]; xv[q][j] = (f32x4){bf_lo(wv.x), bf_hi(wv.x), bf_lo(wv.y), bf_hi(wv.y)}; } }
#pragma unroll
                        for (int q = 0; q < 4; ++q) { const int i = i4 + q, m = mb + i * NGW; if (m >= M) break;
                            f32x2e ss2 = {0.f, 0.f};
#pragma unroll
                            for (int j = 0; j < 4; ++j) { const f32x2e xl = LO2(xv[q][j]), xh = HI2(xv[q][j]); ss2 = __builtin_elementwise_fma(xl, xl, ss2); ss2 = __builtin_elementwise_fma(xh, xh, ss2); }
                            const float rs = rsqf_(wave_sum_u(ss2.x + ss2.y) * (1.0f / D) + EPS);
                            if (F.lane == 0) RS[m] = rs;
                            float lg[8];
#pragma unroll
                            for (int e = 0; e < 8; ++e) { f32x2e sd2 = {0.f, 0.f};
#pragma unroll
                                for (int j = 0; j < 4; ++j) { const f32x4 wv = RTL[e * 256 + 64 * j + F.lane]; sd2 = __builtin_elementwise_fma(LO2(xv[q][j]), LO2(wv), sd2); sd2 = __builtin_elementwise_fma(HI2(xv[q][j]), HI2(wv), sd2); }
                                lg[e] = wave_sum_u(sd2.x + sd2.y); }
                            int e0 = 0; float l0 = lg[0];
#pragma unroll
                            for (int e = 1; e < 8; ++e) if (lg[e] > l0) { l0 = lg[e]; e0 = e; }
                            int e1 = -1; float l1 = -3.0e38f;
#pragma unroll
                            for (int e = 0; e < 8; ++e) if (e != e0 && lg[e] > l1) { l1 = lg[e]; e1 = e; }
                            const float p1 = __expf((l1 - l0) * rs), w0 = rcpf_(1.0f + p1), w1 = p1 * w0;
                            if (F.lane == i) { me0 = e0; me1 = e1; mw0 = w0; mw1 = w1; } } }
                    int r0 = 0, r1 = 0, c_mine = 0; const unsigned long long low = (1ull << F.lane) - 1ull;
#pragma unroll
                    for (int e = 0; e < 8; ++e) { const unsigned long long b0 = __ballot(me0 == e), b1 = __ballot(me1 == e);
                        if (me0 == e) r0 = __popcll(b0 & low) + __popcll(b1 & low); if (me1 == e) r1 = __popcll(b0 & low) + __popcll(b1 & low);
                        if (F.lane == e) c_mine = __popcll(b0) + __popcll(b1); }
                    LAS int* WC = (LAS int*)(F.lds + 32768);
                    if (F.lane < 8) WC[F.wave * 8 + F.lane] = c_mine;
                    __syncthreads();
                    if (F.wave == 0 && F.lane < 8) { int tot = 0;
#pragma unroll
                        for (int ww = 0; ww < 8; ++ww) tot += WC[ww * 8 + F.lane];
                        WC[64 + F.lane] = tot > 0 ? (int)atomicAdd(cnt + 64 * F.lane, (unsigned)tot) : 0; }
                    __syncthreads();
                    int basev = 0;
                    if (F.lane < 8) { basev = WC[64 + F.lane];
#pragma unroll
                        for (int ww = 0; ww < 8; ++ww) basev += (ww < F.wave) ? WC[ww * 8 + F.lane] : 0; }
                    __syncthreads();
                    const int b0v = __shfl(basev, me0 < 0 ? 0 : me0), b1v = __shfl(basev, me1 < 0 ? 0 : me1);
                    if (me0 >= 0) { const int m = mb + F.lane * NGW; int* rp = ROUTE + (size_t)m * 6; rp[0] = me0; rp[1] = b0v + r0; rp[2] = me1; rp[3] = b1v + r1; rp[4] = __float_as_int(mw0); rp[5] = __float_as_int(mw1); }
                }
            }
            SEAM();
        }
        if (layer == 0) {
            if (KON(7) && IN(pb + 6)) { FRESH_TID(F); PMARK(pb + 6);
                pg8::Gemm g{XB, (const bf16_t*)(F.ws + WS_WF1), D, D, D}; pg8::SchedGrid S; S.init(M / 256, 2 * DFF / 256, F.G, F.c, D, D);
                EpiGlu E{RS, (bf16_t*)(F.ws + WS_ACT), DFF, 0, (const float*)(F.ws + WS_PSS), (LAS float*)(F.lds + RSL_OFF)}; pg8::gemm_phase(F.lds, g, S, E); moe_conv_slot(F, 1); SEAM();
            }
            if (KON(8) && IN(pb + 7)) { FRESH_TID(F); PMARK(pb + 7);
                pg8::Gemm g{(const bf16_t*)(F.ws + WS_ACT), (const bf16_t*)(F.ws + WS_WF2), DFF, DFF, DFF}; pg8::SchedGrid S; S.init(M / 256, D / 256, F.G, F.c, DFF, DFF);
                EpiRes<true> E{XB, XB, (float*)(F.ws + WS_PSS)}; pg8::gemm_phase(F.lds, g, S, E); SEAM();
            }
        } else {
            if (KON(10) && IN(pb + 6)) { FRESH_TID(F); PMARK(pb + 6);
                build_ptab(F); const LAS int* ptab = (const LAS int*)(F.lds + PTAB_OFF);
                const int* ROUTE = (const int*)(F.ws + WS_ROUTE); int* stok = (int*)(F.ws + WS_SLOT); float* sw = (float*)(stok + MAXSLOT); float* srs = sw + MAXSLOT; unsigned char* XS8 = F.ws + WS_XS;
#pragma nounroll
                for (int mb = gw; mb < M; mb += 4 * NGW) {
                    int rt[4][6]; u32x4 ra[4], rb[4];
#pragma unroll
                    for (int q = 0; q < 4; ++q) { const int m = mb + q * NGW < M ? mb + q * NGW : 0; const int* rp = ROUTE + (size_t)m * 6;
#pragma unroll
                        for (int z = 0; z < 6; ++z) rt[q][z] = rp[z];
                        const u32x4* src = (const u32x4*)(XB + (size_t)m * D) + F.lane; ra[q] = src[0]; rb[q] = src[64]; }
#pragma unroll
                    for (int q = 0; q < 4; ++q) { const int m = mb + q * NGW; if (m >= M) break;
#pragma unroll
                        for (int k = 0; k < 2; ++k) { const int e = rt[q][2 * k], pos = rt[q][2 * k + 1], slot = ptab[MAXPAN + 8 + e] + pos; unsigned char* drow = XS8 + (size_t)slot * D + 8 * F.lane;
                            *(u32x2*)drow = pk8_fp8(bf_lo(ra[q].x), bf_hi(ra[q].x), bf_lo(ra[q].y), bf_hi(ra[q].y), bf_lo(ra[q].z), bf_hi(ra[q].z), bf_lo(ra[q].w), bf_hi(ra[q].w));
                            *(u32x2*)(drow + 512) = pk8_fp8(bf_lo(rb[q].x), bf_hi(rb[q].x), bf_lo(rb[q].y), bf_hi(rb[q].y), bf_lo(rb[q].z), bf_hi(rb[q].z), bf_lo(rb[q].w), bf_hi(rb[q].w));
                            if (F.lane == 0) { stok[slot] = m * 2 + k; sw[slot] = __int_as_float(rt[q][4 + k]); srs[slot] = RS[m]; } } } }
                SEAM();
            }
            if (KON(11) && IN(pb + 7)) { FRESH_TID(F); PMARK(pb + 7);
                const int npan = build_ptab(F);
                const int* stok = (const int*)(F.ws + WS_SLOT); const float* srs = (const float*)(stok + 2 * MAXSLOT);
                pg8::Gemm8 g{F.ws + WS_XS, F.ws + WS_WM1, D, D, D}; SchedMoe1F S{F.G, F.c, npan, (const LAS int*)(F.lds + PTAB_OFF)};
                EpiGlu8 E{srs, F.ws + WS_ACTM, DFE, 1.0f / MOE_S1};
                pg8::gemm_phase8(F.lds, g, S, E); SEAM();
            }
            if (KON(12) && IN(pb + 8)) { FRESH_TID(F); PMARK(pb + 8);
                const int npan = build_ptab(F);
                const int* stok = (const int*)(F.ws + WS_SLOT); const float* sw = (const float*)(stok + MAXSLOT);
                pg8::Gemm8 g{F.ws + WS_ACTM, F.ws + WS_WM2, DFE, DFE, DFE}; SchedMoe2F S{F.G, F.c, npan, (const LAS int*)(F.lds + PTAB_OFF)};
                EpiMoe2 E{stok, sw, (bf16_t*)(F.ws + WS_Y0), (bf16_t*)(F.ws + WS_Y1), 0, 1.0f / MOE_S2}; pg8::gemm_phase8(F.lds, g, S, E); SEAM();
            }
            if (KON(13) && IN(pb + 11)) { FRESH_TID(F); PMARK(pb + 11);
                const bf16_t* Y0 = (const bf16_t*)(F.ws + WS_Y0); const bf16_t* Y1 = (const bf16_t*)(F.ws + WS_Y1);
#pragma nounroll
                for (int mb = gw; mb < M; mb += 2 * NGW) { f32x4 x[2][4]; u32x2 ya[2][4], yb[2][4];
#pragma unroll
                    for (int q = 0; q < 2; ++q) { const int m = mb + q * NGW < M ? mb + q * NGW : 0; const u32x2* xr = (const u32x2*)(XB + (size_t)m * D) + F.lane; const u32x2* y0 = (const u32x2*)(Y0 + (size_t)m * D) + F.lane; const u32x2* y1 = (const u32x2*)(Y1 + (size_t)m * D) + F.lane;
#pragma unroll
                        for (int j = 0; j < 4; ++j) { const u32x2 wv = xr[64 * j]; x[q][j] = (f32x4){bf_lo(wv.x), bf_hi(wv.x), bf_lo(wv.y), bf_hi(wv.y)}; ya[q][j] = y0[64 * j]; yb[q][j] = y1[64 * j]; } }
#pragma unroll
                    for (int q = 0; q < 2; ++q) { const int m = mb + q * NGW; if (m >= M) break; f32x4* xr = (f32x4*)(F.out + (size_t)m * D) + F.lane;
#pragma unroll
                        for (int j = 0; j < 4; ++j) { f32x4 o = x[q][j]; const u32x2 a = ya[q][j], b2 = yb[q][j];
                            o.x += bf_lo(a.x) + bf_lo(b2.x); o.y += bf_hi(a.x) + bf_hi(b2.x); o.z += bf_lo(a.y) + bf_lo(b2.y); o.w += bf_hi(a.y) + bf_hi(b2.y); xr[64 * j] = o; } } }
            }
        }
    }
#undef gw
#undef NGW
#undef XB
#undef RS
    PMARK(99);
    if ((PROBE_MASK & 0x6000000u) && blockIdx.x == 0 && threadIdx.x == 0) { const unsigned* st = (const unsigned*)(F.ws + WS_SLOT + 3 * MAXSLOT * 4); unsigned long long tot = 0; for (int i = 0; i < 512 * 8; ++i) { const unsigned v = st[i]; tot += (PROBE_MASK & 0x2000000u) ? (v & 255u) : (v >> 8); }
        *(volatile LAS unsigned long long*)(F.lds + MISC_OFF + 160) += tot * 25ull / 4096ull * 10ull; }
    if (PROBE_MASK != 0u && blockIdx.x == 0 && threadIdx.x == 0) { const unsigned long long acc = *(volatile LAS unsigned long long*)(F.lds + MISC_OFF + 160), t1 = __builtin_amdgcn_s_memrealtime() + 4ull * acc; while (__builtin_amdgcn_s_memrealtime() < t1) __builtin_amdgcn_s_sleep(8); }
#undef IN
}

constexpr int NPHASE = 25;
template <unsigned KM> static bool setup_kernel(int& per_cu) {
    if (hipFuncSetAttribute((const void*)fwd<KM>, hipFuncAttributeMaxDynamicSharedMemorySize, LDS_BYTES) != hipSuccess) return false;
    if (hipOccupancyMaxActiveBlocksPerMultiprocessor(&per_cu, (const void*)fwd<KM>, NTHR, LDS_BYTES) != hipSuccess) per_cu = 0;
    (void)hipGetLastError(); return true;
}
template <unsigned KM> static void launch_kind(int grid, const Args& a, hipStream_t stream) { hipLaunchKernelGGL(fwd<KM>, dim3(grid), dim3(NTHR), LDS_BYTES, stream, a); }
extern "C" void kernel_launch(void* const* d_in, const int* in_sizes, int n_in, void* d_out, int out_size, void* d_ws, size_t ws_size, hipStream_t stream) {
    static int grid = 0;
    if (grid == 0) {
        if (n_in != 28 || in_sizes[0] != M * D || out_size != M * D || ws_size < WS_END) { fprintf(stderr, "kernel_launch: unexpected shapes / workspace (n_in %d, ws %zu, need %zu)\n", n_in, ws_size, (size_t)WS_END); grid = -1; return; }
        int dev = 0, cus = 0, per_cu = 0; bool ok = true;
        if (hipGetDevice(&dev) != hipSuccess || hipDeviceGetAttribute(&cus, hipDeviceAttributeMultiprocessorCount, dev) != hipSuccess) { grid = -1; return; }
#if MK_PER_PHASE
        ok = ok && setup_kernel<1u << 0>(per_cu) && setup_kernel<1u << 1>(per_cu) && setup_kernel<1u << 2>(per_cu) && setup_kernel<1u << 3>(per_cu) && setup_kernel<1u << 4>(per_cu) && setup_kernel<1u << 5>(per_cu) && setup_kernel<1u << 6>(per_cu)
             && setup_kernel<1u << 7>(per_cu) && setup_kernel<1u << 8>(per_cu) && setup_kernel<1u << 9>(per_cu) && setup_kernel<1u << 10>(per_cu) && setup_kernel<1u << 11>(per_cu) && setup_kernel<1u << 12>(per_cu) && setup_kernel<1u << 13>(per_cu);
#else
        ok = ok && setup_kernel<0xffffffffu>(per_cu);
#endif
        if (!ok) { fprintf(stderr, "kernel_launch: hipFuncSetAttribute failed\n"); grid = -1; return; }
        if (per_cu < 1) fprintf(stderr, "kernel_launch: occupancy query says %d\n", per_cu);
        grid = cus;
    }
    if (grid < 0) return;
    (void)hipMemsetAsync((char*)d_ws + WS_CTL, 0, CTL_BYTES, stream);
    Args a{};
    for (int i = 0; i < 28; ++i) a.in[i] = (const float*)d_in[i];
    a.out = (float*)d_out; a.ws = (unsigned char*)d_ws;
#if MK_PER_PHASE
    static const int phases[] = {0, 1, 2, 3, 4, 5, 7, 8, 13, 14, 15, 16, 17, 18, 19, 20, 21, 24};
    static const int kinds[]  = {0, 1, 2, 3, 4, 5, 7, 8,  1,  2,  3,  4,  5,  6, 10, 11, 12, 13};
    for (int i = 0; i < (int)(sizeof(phases) / sizeof(int)); ++i) { a.ph_lo = phases[i]; a.ph_hi = phases[i] + 1;
        switch (kinds[i]) {
            case 0: launch_kind<1u << 0>(grid, a, stream); break; case 1: launch_kind<1u << 1>(grid, a, stream); break; case 2: launch_kind<1u << 2>(grid, a, stream); break;
            case 3: launch_kind<1u << 3>(grid, a, stream); break; case 4: launch_kind<1u << 4>(grid, a, stream); break; case 5: launch_kind<1u << 5>(grid, a, stream); break;
            case 6: launch_kind<1u << 6>(grid, a, stream); break; case 7: launch_kind<1u << 7>(grid, a, stream); break; case 8: launch_kind<1u << 8>(grid, a, stream); break;
            case 9: launch_kind<1u << 9>(grid, a, stream); break; case 10: launch_kind<1u << 10>(grid, a, stream); break; case 11: launch_kind<1u << 11>(grid, a, stream); break;
            case 12: launch_kind<1u << 12>(grid, a, stream); break; default: launch_kind<1u << 13>(grid, a, stream); break; } }
#else
    a.ph_lo = 0; a.ph_hi = NPHASE; launch_kind<0xffffffffu>(grid, a, stream);
#endif
}
```

```cpp
#include <hip/hip_runtime.h>
#include <cstdio>
#include <cstdint>

#ifndef MK_PER_PHASE
#define MK_PER_PHASE 0
#endif

#ifndef PROBE_MASK
#define PROBE_MASK 0u
#endif
#define LAS __attribute__((address_space(3)))
typedef unsigned short bf16_t;
typedef short bf16x8 __attribute__((ext_vector_type(8)));
typedef float f32x4 __attribute__((ext_vector_type(4)));
typedef float f32x2 __attribute__((ext_vector_type(2)));
typedef unsigned u32x4 __attribute__((ext_vector_type(4)));
typedef unsigned u32x2 __attribute__((ext_vector_type(2)));

constexpr int D = 1024, NB = 8, SEQ = 2048, M = NB * SEQ;
constexpr int INW = 2328, INP = 2560;
constexpr int CW = 512, CKW = 31, DH = 64, NKV = 2, NBH = NB * NKV;
constexpr int NCMP = 127, CHID = 256;
constexpr int DFF = 2816, NE = 8, DFE = 3584;
constexpr int MAXPAN = 136, MAXSLOT = MAXPAN * 256, CHUNKP = 72;
constexpr float EPS = 1e-6f;

constexpr size_t MiB = 1u << 20;
constexpr size_t WS_CTL = 0, CTL_BYTES = 2 * MiB;
constexpr size_t WS_H1 = 342 * MiB;
constexpr size_t WS_WIN = 12 * MiB;
constexpr size_t WS_WC1 = 22 * MiB;
constexpr size_t WS_WOUT = 26 * MiB;
constexpr size_t WS_WF1 = 30 * MiB;
constexpr size_t WS_WF2 = 41 * MiB;
constexpr size_t WS_RT = 47 * MiB;
constexpr size_t WS_WM1 = 48 * MiB;
constexpr size_t WS_WM2 = 160 * MiB;
constexpr size_t WS_XB = 216 * MiB;
constexpr size_t WS_RSTD = 248 * MiB;
constexpr size_t WS_GT = WS_RSTD + 65536;
constexpr size_t WS_ROUTE = WS_GT + (size_t)M * 24 * 4;
constexpr size_t WS_PSS = 250 * MiB;
constexpr size_t WS_KC = 251 * MiB;
constexpr size_t WS_VC = WS_KC + 262144;
constexpr size_t WS_VCT = WS_KC + 524288;
constexpr size_t WS_VST = 2 * MiB, WS_VWT = 6 * MiB;
constexpr size_t WS_U = 252 * MiB;
constexpr size_t WS_Q = 268 * MiB;
constexpr size_t WS_KV = 284 * MiB;
constexpr size_t KVT = (size_t)NBH * SEQ * DH;
constexpr size_t WS_MIX = 310 * MiB;
constexpr size_t WS_ACT = 342 * MiB;
constexpr size_t WS_XS = 252 * MiB;
constexpr size_t WS_ACTM = 320 * MiB;
constexpr size_t WS_SLOT = 447 * MiB;
constexpr size_t WS_Y0 = 288 * MiB, WS_Y1 = 12 * MiB;
constexpr size_t WS_END = 448 * MiB;
constexpr int CW_BAR = 4096;
constexpr int CW_CNT = 8192;
constexpr int CW_B1P = 16384;

__device__ __forceinline__ unsigned cvt_pk_bf16(float lo, float hi) { unsigned r; asm volatile("v_cvt_pk_bf16_f32 %0, %1, %2" : "=v"(r) : "v"(lo), "v"(hi)); return r; }
__device__ __forceinline__ float bf_lo(unsigned v) { return __uint_as_float(v << 16); }
__device__ __forceinline__ float bf_hi(unsigned v) { return __uint_as_float(v & 0xffff0000u); }
__device__ __forceinline__ float bf2f(bf16_t v) { return __uint_as_float((unsigned)v << 16); }
__device__ __forceinline__ float rcpf_(float x) { return __builtin_amdgcn_rcpf(x); }
__device__ __forceinline__ float rsqf_(float x) { return __builtin_amdgcn_rsqf(x); }
__device__ __forceinline__ float sigmoidf_(float x) { return rcpf_(1.0f + __expf(-x)); }
__device__ __forceinline__ float siluf_(float x) { return x * sigmoidf_(x); }
typedef float f32x2e __attribute__((ext_vector_type(2)));
__device__ __forceinline__ f32x2e glu2_(f32x2e g, f32x2e u, f32x2e nrs, f32x2e rs2) {
    f32x2e e = g * nrs; e.x = __builtin_amdgcn_exp2f(e.x); e.y = __builtin_amdgcn_exp2f(e.y);
    f32x2e d = e + (f32x2e){1.0f, 1.0f}; d.x = __builtin_amdgcn_rcpf(d.x); d.y = __builtin_amdgcn_rcpf(d.y);
    return ((g * u) * rs2) * d; }
__device__ __forceinline__ f32x2e glus2_(f32x2e v, f32x2e g, f32x2e nrs, f32x2e rs1) {
    f32x2e e = g * nrs; e.x = __builtin_amdgcn_exp2f(e.x); e.y = __builtin_amdgcn_exp2f(e.y);
    f32x2e d = e + (f32x2e){1.0f, 1.0f}; d.x = __builtin_amdgcn_rcpf(d.x); d.y = __builtin_amdgcn_rcpf(d.y);
    return (v * rs1) * d; }
#define LO2(v) ((f32x2e){(v)[0], (v)[1]})
#define HI2(v) ((f32x2e){(v)[2], (v)[3]})
__device__ __forceinline__ float wave_sum(float v) {
#pragma unroll
    for (int o = 1; o < 64; o <<= 1) v += __shfl_xor(v, o);
    return v;
}
#define DPP_ADD(v, ctrl) ((v) + __builtin_bit_cast(float, __builtin_amdgcn_update_dpp(0, __builtin_bit_cast(int, (v)), (ctrl), 0xF, 0xF, true)))
__device__ __forceinline__ float wave_sum_u(float v) {
    v = DPP_ADD(v, 0xB1); v = DPP_ADD(v, 0x4E); v = DPP_ADD(v, 0x124); v = DPP_ADD(v, 0x128);
    const int b = __builtin_bit_cast(int, v);
    return (__builtin_bit_cast(float, __builtin_amdgcn_readlane(b, 0)) + __builtin_bit_cast(float, __builtin_amdgcn_readlane(b, 16))) + (__builtin_bit_cast(float, __builtin_amdgcn_readlane(b, 32)) + __builtin_bit_cast(float, __builtin_amdgcn_readlane(b, 48)));
}
__device__ __forceinline__ float wave_max(float v) {
#pragma unroll
    for (int o = 1; o < 64; o <<= 1) v = fmaxf(v, __shfl_xor(v, o));
    return v;
}
#define LDS_WAIT() asm volatile("s_waitcnt lgkmcnt(0)" ::: "memory")
typedef float f32x16 __attribute__((ext_vector_type(16)));
typedef __bf16 bf16v2 __attribute__((ext_vector_type(2)));
#define MFMA32(a, b, c) __builtin_amdgcn_mfma_f32_32x32x16_bf16((a), (b), (c), 0, 0, 0)
__device__ __forceinline__ unsigned pk_bf16(float lo, float hi) { const f32x2 v = {lo, hi}; return __builtin_bit_cast(unsigned, __builtin_convertvector(v, bf16v2)); }
template <int S8> __device__ __forceinline__ bf16x8 pack8(const f32x16& p) { u32x4 w; w.x = pk_bf16(p[S8], p[S8 + 1]); w.y = pk_bf16(p[S8 + 2], p[S8 + 3]); w.z = pk_bf16(p[S8 + 4], p[S8 + 5]); w.w = pk_bf16(p[S8 + 6], p[S8 + 7]); return __builtin_bit_cast(bf16x8, w); }
__device__ __forceinline__ u32x2 pk8_fp8(float a0, float a1, float a2, float a3, float a4, float a5, float a6, float a7) {
    int w0 = 0, w1 = 0; w0 = __builtin_amdgcn_cvt_pk_fp8_f32(a0, a1, w0, false); w0 = __builtin_amdgcn_cvt_pk_fp8_f32(a2, a3, w0, true);
    w1 = __builtin_amdgcn_cvt_pk_fp8_f32(a4, a5, w1, false); w1 = __builtin_amdgcn_cvt_pk_fp8_f32(a6, a7, w1, true); return (u32x2){(unsigned)w0, (unsigned)w1}; }
__device__ __forceinline__ int swap23(int v) { return (v & ~12) | ((v & 4) << 1) | ((v & 8) >> 1); }

namespace pg8 {
constexpr int BM = 256, BK = 64, HALF = 128, HTB = HALF * BK * 2, STAGE_BYTES = 8 * HTB, NXCD = 8, WGM = 8;
__device__ __forceinline__ int lds_byte(int r, int c) { const int st = (r >> 4) * 2 + (c >> 5), rr = r & 15, cc = c & 31, ob = rr * 64 + cc * 2; return st * 1024 + (ob ^ (((ob >> 9) & 1) << 5)); }
__device__ __forceinline__ void stage_rc(int b, int& R, int& C) { const int st = b / 1024, sb = b % 1024, swz = sb ^ (((sb >> 9) & 1) << 5); R = (st >> 1) * 16 + swz / 64; C = (st & 1) * 32 + (swz % 64) / 2; }
__device__ __forceinline__ int perm32(int rho) { const int n = rho >> 4, i = rho & 15; return 8 * (i >> 2) + 4 * n + (i & 3); }

struct Unit { int pm, pn; size_t aoff, boff; };
struct Gemm { const bf16_t* A; const bf16_t* Bt; int K, lda, ldb; };

struct SchedGrid {
    int nM, nN, nwg, G, c; size_t astr, bstr;
    __device__ __forceinline__ void init(int nM_, int nN_, int G_, int c_, int lda, int ldb) { nM = nM_; nN = nN_; nwg = nM * nN; G = G_; c = c_; astr = (size_t)BM * lda * 2; bstr = (size_t)BM * ldb * 2; }
    __device__ __forceinline__ bool next(int i, Unit& u) const {
        const long L = (long)i * G + c; if (L >= nwg) return false;
        int wgid = (int)L; { const int q = nwg / NXCD, r = nwg % NXCD, xcd = wgid % NXCD, off = wgid / NXCD; wgid = (xcd < r ? xcd * (q + 1) : r * (q + 1) + (xcd - r) * q) + off; }
        const int nig = WGM * nN, gid = wgid / nig, fm = gid * WGM, gsz = (nM - fm) < WGM ? (nM - fm) : WGM;
        u.pm = fm + ((wgid % nig) % gsz); u.pn = (wgid % nig) / gsz; u.aoff = (size_t)u.pm * astr; u.boff = (size_t)u.pn * bstr; return true;
    }
};

template <class Epi, class Sched>
__device__ __forceinline__ void gemm_phase(LAS unsigned char* lds, const Gemm g, const Sched& S, const Epi& E) {
    int tid = threadIdx.x; asm volatile("" : "+v"(tid));
    const int wid = __builtin_amdgcn_readfirstlane(tid >> 6), lane = tid & 63, wr = wid >> 2, wc = wid & 3, fr = lane & 15, fq = lane >> 4;
    const int K = g.K, nt = K / BK;
    unsigned voffA[2], voffB[2];
#pragma unroll
    for (int i = 0; i < 2; ++i) { int R, C; stage_rc(tid * 16 + i * 8192, R, C); const int Rb = Epi::PERM ? ((R & ~31) + perm32(R & 31)) : R;
        voffA[i] = (unsigned)(R * g.lda + C) * 2u; voffB[i] = (unsigned)(Rb * g.ldb + C) * 2u; }
    const size_t kstep = (size_t)(BK * 2);
    const size_t hstepA = (size_t)HALF * g.lda * 2, hstepB = (size_t)HALF * g.ldb * 2;
    const unsigned ldsw = (unsigned)wid * 1024u;
    const int aoff = lds_byte(wr * 64 + fr, fq * 8), boff = lds_byte(wc * 32 + fr, fq * 8);
#define PG8_SA(b, h) (((b) * 2 + (h)) * HTB)
#define PG8_SB(b, h) ((4 + (b) * 2 + (h)) * HTB)
#define PG8_STAGE(bufoff, gbase, voff) do { _Pragma("unroll") for (int _i = 0; _i < 2; ++_i) \
        __builtin_amdgcn_global_load_lds((const unsigned*)((const char*)(gbase) + (voff)[_i]), (LAS unsigned*)(lds + (bufoff) + ldsw + _i * 8192), 16, 0, 0); } while (0)
#define PG8_LDA(dst, b, h) do { _Pragma("unroll") for (int m = 0; m < 4; ++m) _Pragma("unroll") for (int k = 0; k < 2; ++k) dst[m][k] = *(const LAS bf16x8*)(lds + PG8_SA(b, h) + aoff + m * 2048 + k * 1024); } while (0)
#define PG8_LDB(dst, b, h) do { _Pragma("unroll") for (int n = 0; n < 2; ++n) _Pragma("unroll") for (int k = 0; k < 2; ++k) dst[n][k] = *(const LAS bf16x8*)(lds + PG8_SB(b, h) + boff + n * 2048 + k * 1024); } while (0)
#define PG8_MMA(ai, bj, At, Bt) do { __builtin_amdgcn_s_setprio(1); _Pragma("unroll") for (int m = 0; m < 4; ++m) _Pragma("unroll") for (int n = 0; n < 2; ++n) _Pragma("unroll") for (int k = 0; k < 2; ++k) \
        acc[ai][bj][m][n] = __builtin_amdgcn_mfma_f32_16x16x32_bf16(Bt[n][k], At[m][k], acc[ai][bj][m][n], 0, 0, 0); __builtin_amdgcn_s_setprio(0); } while (0)
#define PG8_WAIT_V(n) asm volatile("s_waitcnt vmcnt(" #n ")" ::: "memory")
#define PG8_WAIT_L(n) asm volatile("s_waitcnt lgkmcnt(" #n ")" ::: "memory")
#define PG8_BAR __builtin_amdgcn_s_barrier()
#define PG8_SCHED __builtin_amdgcn_sched_barrier(0)
    Unit cur, nxt; int ui = 0;
    if (!S.next(0, cur)) return;
    f32x4 acc[2][2][4][2];
#pragma unroll
    for (int a = 0; a < 2; ++a)
#pragma unroll
        for (int b = 0; b < 2; ++b)
#pragma unroll
            for (int m = 0; m < 4; ++m)
#pragma unroll
                for (int n = 0; n < 2; ++n) acc[a][b][m][n] = (f32x4){0.f, 0.f, 0.f, 0.f};
    bf16x8 At[4][2], B0[2][2], B1[2][2];
    const char* cA = (const char*)g.A + cur.aoff; const char* cB = (const char*)g.Bt + cur.boff;
    typename Epi::Pre pre; E.prefetch(cur, wr, fr, pre);
    PG8_STAGE(PG8_SB(0, 0), cB, voffB); PG8_STAGE(PG8_SA(0, 0), cA, voffA); PG8_STAGE(PG8_SB(0, 1), cB + hstepB, voffB); PG8_STAGE(PG8_SA(0, 1), cA + hstepA, voffA);
    if (wr == 1) PG8_BAR;
    PG8_WAIT_V(4); PG8_BAR;
    PG8_STAGE(PG8_SB(1, 0), cB + kstep, voffB); PG8_STAGE(PG8_SA(1, 0), cA + kstep, voffA); PG8_STAGE(PG8_SB(1, 1), cB + hstepB + kstep, voffB);
    PG8_WAIT_V(6); PG8_BAR;
    for (;;) {
        const bool has_next = S.next(ui + 1, nxt);
        const char* nA = has_next ? (const char*)g.A + nxt.aoff : cA; const char* nB = has_next ? (const char*)g.Bt + nxt.boff : cB;
#pragma nounroll
        for (int t = 0; t < nt; t += 2) {
            const bool last = (t == nt - 2);
            const char* a1 = cA + (size_t)(t + 1) * kstep;
            const char* a2 = last ? nA : cA + (size_t)(t + 2) * kstep; const char* b2 = last ? nB : cB + (size_t)(t + 2) * kstep;
            const char* a3 = a2 + kstep; const char* b3 = b2 + kstep;
            PG8_LDB(B0, 0, 0); PG8_SCHED; PG8_LDA(At, 0, 0); PG8_STAGE(PG8_SA(1, 1), a1 + hstepA, voffA);
            PG8_WAIT_L(8); PG8_BAR; PG8_WAIT_L(0); PG8_MMA(0, 0, At, B0); PG8_BAR; PG8_SCHED;
            PG8_LDB(B1, 0, 1); PG8_STAGE(PG8_SB(0, 0), b2, voffB);
            PG8_BAR; PG8_WAIT_L(0); PG8_MMA(0, 1, At, B1); PG8_BAR;
            PG8_LDA(At, 0, 1); PG8_STAGE(PG8_SA(0, 0), a2, voffA);
            PG8_BAR; PG8_WAIT_L(0); PG8_MMA(1, 0, At, B0); PG8_BAR; PG8_SCHED;
            PG8_STAGE(PG8_SB(0, 1), b2 + hstepB, voffB);
            PG8_WAIT_V(6); PG8_BAR; PG8_MMA(1, 1, At, B1); PG8_BAR;
            PG8_LDB(B0, 1, 0); PG8_SCHED; PG8_LDA(At, 1, 0); PG8_STAGE(PG8_SA(0, 1), a2 + hstepA, voffA);
            PG8_WAIT_L(8); PG8_BAR; PG8_WAIT_L(0); PG8_MMA(0, 0, At, B0); PG8_BAR; PG8_SCHED;
            PG8_LDB(B1, 1, 1); PG8_STAGE(PG8_SB(1, 0), b3, voffB);
            PG8_BAR; PG8_WAIT_L(0); PG8_MMA(0, 1, At, B1); PG8_BAR;
            PG8_LDA(At, 1, 1); PG8_STAGE(PG8_SA(1, 0), a3, voffA);
            PG8_BAR; PG8_WAIT_L(0); PG8_MMA(1, 0, At, B0); PG8_BAR; PG8_SCHED;
            PG8_STAGE(PG8_SB(1, 1), b3 + hstepB, voffB);
            PG8_WAIT_V(6); PG8_BAR; PG8_MMA(1, 1, At, B1); PG8_BAR;
        }
        E(acc, cur, wr, wc, fr, fq, pre);
        if (!has_next) break;
        E.prefetch(nxt, wr, fr, pre);
#pragma unroll
        for (int a = 0; a < 2; ++a)
#pragma unroll
            for (int b = 0; b < 2; ++b)
#pragma unroll
                for (int m = 0; m < 4; ++m)
#pragma unroll
                    for (int n = 0; n < 2; ++n) acc[a][b][m][n] = (f32x4){0.f, 0.f, 0.f, 0.f};
        cur = nxt; cA = nA; cB = nB; ++ui;
    }
    PG8_WAIT_V(0);
    if (wr == 0) PG8_BAR;
    PG8_BAR;
#undef PG8_SA
#undef PG8_SB
#undef PG8_STAGE
#undef PG8_LDA
#undef PG8_LDB
#undef PG8_MMA
#undef PG8_WAIT_V
#undef PG8_WAIT_L
#undef PG8_BAR
#undef PG8_SCHED
}
struct Gemm8 { const unsigned char* A; const unsigned char* Bt; int K, lda, ldb; };
typedef int i32x4 __attribute__((ext_vector_type(4)));
typedef int i32x8 __attribute__((ext_vector_type(8)));
template <class Epi, class Sched>
__device__ __forceinline__ void gemm_phase8(LAS unsigned char* lds, const Gemm8 g, const Sched& S, const Epi& E) {
    int tid = threadIdx.x; asm volatile("" : "+v"(tid));
    const int wid = __builtin_amdgcn_readfirstlane(tid >> 6), lane = tid & 63, wr = wid >> 2, wc = wid & 3, fr = lane & 15, fq = lane >> 4;
    const int nt = g.K / 128;
    unsigned voffA[2], voffB[2];
#pragma unroll
    for (int i = 0; i < 2; ++i) { int R, C; stage_rc(tid * 16 + i * 8192, R, C); const int Rb = Epi::PERM ? ((R & ~31) + perm32(R & 31)) : R;
        voffA[i] = (unsigned)(R * g.lda + C * 2); voffB[i] = (unsigned)(Rb * g.ldb + C * 2); }
    const size_t kstep = (size_t)(BK * 2);
    const size_t hstepA = (size_t)HALF * g.lda, hstepB = (size_t)HALF * g.ldb;
    const unsigned ldsw = (unsigned)wid * 1024u;
    const int aoff = lds_byte(wr * 64 + fr, fq * 8), boff = lds_byte(wc * 32 + fr, fq * 8);
#define PG8_SA(b, h) (((b) * 2 + (h)) * HTB)
#define PG8_SB(b, h) ((4 + (b) * 2 + (h)) * HTB)
#define PG8_STAGE(bufoff, gbase, voff) do { _Pragma("unroll") for (int _i = 0; _i < 2; ++_i) \
        __builtin_amdgcn_global_load_lds((const unsigned*)((const char*)(gbase) + (voff)[_i]), (LAS unsigned*)(lds + (bufoff) + ldsw + _i * 8192), 16, 0, 0); } while (0)
#define PG8_LDA(dst, b, h) do { _Pragma("unroll") for (int m = 0; m < 4; ++m) { const i32x4 _l = *(const LAS i32x4*)(lds + PG8_SA(b, h) + aoff + m * 2048), _h = *(const LAS i32x4*)(lds + PG8_SA(b, h) + aoff + m * 2048 + 1024); dst[m] = __builtin_shufflevector(_l, _h, 0, 1, 2, 3, 4, 5, 6, 7); } } while (0)
#define PG8_LDB(dst, b, h) do { _Pragma("unroll") for (int n = 0; n < 2; ++n) { const i32x4 _l = *(const LAS i32x4*)(lds + PG8_SB(b, h) + boff + n * 2048), _h = *(const LAS i32x4*)(lds + PG8_SB(b, h) + boff + n * 2048 + 1024); dst[n] = __builtin_shufflevector(_l, _h, 0, 1, 2, 3, 4, 5, 6, 7); } } while (0)
#define PG8_MMA(ai, bj, At, Bt) do { __builtin_amdgcn_s_setprio(1); _Pragma("unroll") for (int m = 0; m < 4; ++m) _Pragma("unroll") for (int n = 0; n < 2; ++n) \
        asm volatile("v_mfma_f32_16x16x128_f8f6f4 %0, %1, %2, %0" : "+v"(acc[ai][bj][m][n]) : "v"(Bt[n]), "v"(At[m])); __builtin_amdgcn_s_setprio(0); } while (0)
#define PG8_WAIT_V(n) asm volatile("s_waitcnt vmcnt(" #n ")" ::: "memory")
#define PG8_WAIT_L(n) asm volatile("s_waitcnt lgkmcnt(" #n ")" ::: "memory")
#define PG8_BAR __builtin_amdgcn_s_barrier()
#define PG8_SCHED __builtin_amdgcn_sched_barrier(0)
    Unit cur, nxt; int ui = 0;
    if (!S.next(0, cur)) return;
    f32x4 acc[2][2][4][2];
#pragma unroll
    for (int a = 0; a < 2; ++a)
#pragma unroll
        for (int b = 0; b < 2; ++b)
#pragma unroll
            for (int m = 0; m < 4; ++m)
#pragma unroll
                for (int n = 0; n < 2; ++n) acc[a][b][m][n] = (f32x4){0.f, 0.f, 0.f, 0.f};
    i32x8 At[4], B0[2], B1[2];
    const char* cA = (const char*)g.A + cur.aoff; const char* cB = (const char*)g.Bt + cur.boff;
    typename Epi::Pre pre; E.prefetch(cur, wr, fr, pre);
    PG8_STAGE(PG8_SB(0, 0), cB, voffB); PG8_STAGE(PG8_SA(0, 0), cA, voffA); PG8_STAGE(PG8_SB(0, 1), cB + hstepB, voffB); PG8_STAGE(PG8_SA(0, 1), cA + hstepA, voffA);
    if (wr == 1) PG8_BAR;
    PG8_WAIT_V(4); PG8_BAR;
    PG8_STAGE(PG8_SB(1, 0), cB + kstep, voffB); PG8_STAGE(PG8_SA(1, 0), cA + kstep, voffA); PG8_STAGE(PG8_SB(1, 1), cB + hstepB + kstep, voffB);
    PG8_WAIT_V(6); PG8_BAR;
    for (;;) {
        const bool has_next = S.next(ui + 1, nxt);
        const char* nA = has_next ? (const char*)g.A + nxt.aoff : cA; const char* nB = has_next ? (const char*)g.Bt + nxt.boff : cB;
#pragma nounroll
        for (int t = 0; t < nt; t += 2) {
            const bool last = (t == nt - 2);
            const char* a1 = cA + (size_t)(t + 1) * kstep;
            const char* a2 = last ? nA : cA + (size_t)(t + 2) * kstep; const char* b2 = last ? nB : cB + (size_t)(t + 2) * kstep;
            const char* a3 = a2 + kstep; const char* b3 = b2 + kstep;
            PG8_LDB(B0, 0, 0); PG8_SCHED; PG8_LDA(At, 0, 0); PG8_STAGE(PG8_SA(1, 1), a1 + hstepA, voffA);
            PG8_WAIT_L(8); PG8_BAR; PG8_WAIT_L(0); PG8_MMA(0, 0, At, B0); PG8_BAR; PG8_SCHED;
            PG8_LDB(B1, 0, 1); PG8_STAGE(PG8_SB(0, 0), b2, voffB);
            PG8_BAR; PG8_WAIT_L(0); PG8_MMA(0, 1, At, B1); PG8_BAR;
            PG8_LDA(At, 0, 1); PG8_STAGE(PG8_SA(0, 0), a2, voffA);
            PG8_BAR; PG8_WAIT_L(0); PG8_MMA(1, 0, At, B0); PG8_BAR; PG8_SCHED;
            PG8_STAGE(PG8_SB(0, 1), b2 + hstepB, voffB);
            PG8_WAIT_V(6); PG8_BAR; PG8_MMA(1, 1, At, B1); PG8_BAR;
            PG8_LDB(B0, 1, 0); PG8_SCHED; PG8_LDA(At, 1, 0); PG8_STAGE(PG8_SA(0, 1), a2 + hstepA, voffA);
            PG8_WAIT_L(8); PG8_BAR; PG8_WAIT_L(0); PG8_MMA(0, 0, At, B0); PG8_BAR; PG8_SCHED;
            PG8_LDB(B1, 1, 1); PG8_STAGE(PG8_SB(1, 0), b3, voffB);
            PG8_BAR; PG8_WAIT_L(0); PG8_MMA(0, 1, At, B1); PG8_BAR;
            PG8_LDA(At, 1, 1); PG8_STAGE(PG8_SA(1, 0), a3, voffA);
            PG8_BAR; PG8_WAIT_L(0); PG8_MMA(1, 0, At, B0); PG8_BAR; PG8_SCHED;
            PG8_STAGE(PG8_SB(1, 1), b3 + hstepB, voffB);
            PG8_WAIT_V(6); PG8_BAR; PG8_MMA(1, 1, At, B1); PG8_BAR;
        }
        E(acc, cur, wr, wc, fr, fq, pre);
        if (!has_next) break;
        E.prefetch(nxt, wr, fr, pre);
#pragma unroll
        for (int a = 0; a < 2; ++a)
#pragma unroll
            for (int b = 0; b < 2; ++b)
#pragma unroll
                for (int m = 0; m < 4; ++m)
#pragma unroll
                    for (int n = 0; n < 2; ++n) acc[a][b][m][n] = (f32x4){0.f, 0.f, 0.f, 0.f};
        cur = nxt; cA = nA; cB = nB; ++ui;
    }
    PG8_WAIT_V(0);
    if (wr == 0) PG8_BAR;
    PG8_BAR;
#undef PG8_SA
#undef PG8_SB
#undef PG8_STAGE
#undef PG8_LDA
#undef PG8_LDB
#undef PG8_MMA
#undef PG8_WAIT_V
#undef PG8_WAIT_L
#undef PG8_BAR
#undef PG8_SCHED
}
}
using pg8::Unit;

#define XB_TMO      128
#define XB_XCNT(j)  (256  + 64 * (j))
#define XB_XSUB(j)  (1280 + 64 * (j))
#define XB_XGEN(j)  (2304 + 64 * (j))
#define XB_TOP      3328
#define XB_TOPGEN   3392
#define XCD_BAR_WORDS 3456
#define XB_SPIN_CAP (1u << 18)
__device__ __forceinline__ unsigned xb_ld(unsigned* p)              { return __hip_atomic_load(p, __ATOMIC_RELAXED, __HIP_MEMORY_SCOPE_AGENT); }
__device__ __forceinline__ unsigned xb_add(unsigned* p, unsigned v) { return __hip_atomic_fetch_add(p, v, __ATOMIC_RELAXED, __HIP_MEMORY_SCOPE_AGENT); }
__device__ __forceinline__ unsigned xb_xcc_id() { return (unsigned)__builtin_amdgcn_s_getreg((3 << 11) | 20) & 0xFu; }
#define XB_SPIN(cond, bar) do { unsigned _sp = 0; while (cond) { __builtin_amdgcn_s_sleep(1); \
    if ((++_sp & 255u) == 0u) { if (xb_ld(&(bar)[XB_TMO])) break; if (_sp > XB_SPIN_CAP) { atomicAdd(&(bar)[XB_TMO], 1u); break; } } } } while (0)
struct XcdBarrier { unsigned* bar; unsigned x; volatile LAS unsigned* st; };
__device__ __forceinline__ XcdBarrier xcd_barrier_post(unsigned* bar, volatile LAS unsigned* st) {
    XcdBarrier b; b.bar = bar; b.x = xb_xcc_id(); b.st = st;
    if (threadIdx.x == 0) (void)xb_add(&bar[XB_XCNT(b.x)], 1u);
    return b;
}
__device__ __forceinline__ void xcd_barrier_complete(unsigned* bar, unsigned x, unsigned& nloc, unsigned& nx) {
    const unsigned G = gridDim.x * gridDim.y * gridDim.z;
    unsigned sum, cnt, mine, sp = 0u;
    for (;;) {
        sum = 0u; cnt = 0u; mine = 0u;
#pragma unroll
        for (unsigned j = 0; j < 16; ++j) { const unsigned c = xb_ld(&bar[XB_XCNT(j)]); sum += c; cnt += (c > 0u) ? 1u : 0u; mine = (j == x) ? c : mine; }
        if (sum == G) break;
        __builtin_amdgcn_s_sleep(1);
        if ((++sp & 255u) == 0u) { if (xb_ld(&bar[XB_TMO])) break; if (sp > XB_SPIN_CAP) { atomicAdd(&bar[XB_TMO], 1u); break; } }
    }
    nloc = mine > 0u ? mine : 1u; nx = cnt > 0u ? cnt : 1u;
}
__device__ __forceinline__ void xcd_barrier(const XcdBarrier& b) {
    asm volatile("s_waitcnt vmcnt(0)" ::: "memory");
    __syncthreads();
    if (threadIdx.x == 0) {
        unsigned* bar = b.bar;
        __builtin_amdgcn_s_waitcnt(0);
        unsigned nloc = b.st[0], nx = b.st[1];
        if (nloc == 0u) { xcd_barrier_complete(bar, b.x, nloc, nx); b.st[0] = nloc; b.st[1] = nx; }
        const unsigned old = xb_add(&bar[XB_XSUB(b.x)], 1u);
        const unsigned gen = old / nloc;
        if (old + 1u == (gen + 1u) * nloc) {
            __builtin_amdgcn_fence(__ATOMIC_RELEASE, "agent");
            asm volatile("s_waitcnt vmcnt(0)" ::: "memory");
            const unsigned og = xb_add(&bar[XB_TOP], 1u);
            const unsigned tg = og / nx;
            if (og + 1u == (tg + 1u) * nx) xb_add(&bar[XB_TOPGEN], 1u);
            else XB_SPIN(xb_ld(&bar[XB_TOPGEN]) == tg, bar);
            __builtin_amdgcn_fence(__ATOMIC_ACQUIRE, "agent");
            xb_add(&bar[XB_XGEN(b.x)], 1u);
            asm volatile("s_waitcnt vmcnt(0)" ::: "memory");
        } else {
            XB_SPIN(xb_ld(&bar[XB_XGEN(b.x)]) == gen, bar);
            __builtin_amdgcn_fence(__ATOMIC_ACQUIRE, "agent");
            asm volatile("s_waitcnt vmcnt(0)" ::: "memory");
        }
    }
    __syncthreads();
}

constexpr int NWAVES = 8, NTHR = 512;
constexpr int LDS_BYTES = 147456;
constexpr int MISC_OFF = 131072;
constexpr int PTAB_OFF = MISC_OFF + 512;

struct Args { const float* in[28]; float* out; unsigned char* ws; int ph_lo, ph_hi; };

struct Frame {
    LAS unsigned char* lds; int tid, lane, wave, G, c;
    const float* const* in; float* out; unsigned char* ws;
};
#define INP_(i) (F.in[i])
#define FRESH_TID(F) do { int _t = threadIdx.x; asm volatile("" : "+v"(_t)); (F).tid = _t; (F).lane = _t & 63; \
    __attribute__((address_space(1))) unsigned char* _w = (__attribute__((address_space(1))) unsigned char*)args.ws; __attribute__((address_space(1))) float* _o = (__attribute__((address_space(1))) float*)args.out; \
    int _g = gridDim.x; asm volatile("" : "+s"(_w), "+s"(_o), "+s"(_g)); (F).ws = (unsigned char*)_w; (F).out = (float*)_o; (F).G = _g; } while (0)
enum { I_X = 0, I_ANG, I_WIN, I_CDW, I_CDB, I_CLG, I_CLB, I_QG, I_KG, I_PK, I_PV, I_KW1, I_KB1, I_KW2, I_KB2, I_VW1, I_VB1, I_VW2, I_VB2, I_WOUT, I_FNG, I_DW1, I_DW3, I_DW2, I_RW, I_MW1, I_MW3, I_MW2 };

#define PMARK(id) do { if (PROBE_MASK != 0u && blockIdx.x == 0 && threadIdx.x == 0) { volatile LAS unsigned long long* _a = (volatile LAS unsigned long long*)(F.lds + MISC_OFF + 160); volatile LAS unsigned* _o = (volatile LAS unsigned*)(F.lds + MISC_OFF + 168); \
    const unsigned long long _t = __builtin_amdgcn_s_memrealtime(); if (*_o) { *_a += _t; *_o = 0u; } if ((id) < 32 && ((PROBE_MASK >> (id)) & 1u)) { *_a -= _t; *_o = 1u; } } } while (0)
constexpr int RSL_OFF = MISC_OFF + 2048;
__device__ __forceinline__ void rstd_from_partials(const float* pss, int pm, LAS float* tab) {
    int t = threadIdx.x; asm volatile("" : "+v"(t));
    const int row = t >> 1, hf = t & 1;
    const f32x4 a = *(const f32x4*)(pss + (size_t)(pm * 256 + row) * 16 + hf * 8), b = *(const f32x4*)(pss + (size_t)(pm * 256 + row) * 16 + hf * 8 + 4);
    float sq = ((a.x + a.y) + (a.z + a.w)) + ((b.x + b.y) + (b.z + b.w)); sq += __shfl_xor(sq, 1);
    if (hf == 0) tab[row] = rsqf_(sq * (1.0f / D) + EPS);
}
struct EpiIn {
    static constexpr bool PERM = true;
    const float* rstd; bf16_t* U; bf16_t* Q; bf16_t* KV; float* GT; const float* pss; LAS float* rsl;
    struct Pre { int par = 1; };
    __device__ __forceinline__ void prefetch(const Unit& u, int wr, int fr, Pre& p) const {
        p.par ^= 1; LAS float* tab = rsl + p.par * 256;
        if (pss) rstd_from_partials(pss, u.pm, tab); else { int t = threadIdx.x; asm volatile("" : "+v"(t)); if (t < 256) tab[t] = rstd[u.pm * 256 + t]; } }
    __device__ __forceinline__ void operator()(const f32x4 (&acc)[2][2][4][2], const Unit& u, int wr, int wc, int fr, int fq, const Pre& pre) const {
        const int row0 = u.pm * 256 + wr * 64 + fr, cl = wc * 32 + 8 * fq;
        if (u.pn < 4) {
#pragma unroll
            for (int ai = 0; ai < 2; ++ai)
#pragma unroll
                for (int m = 0; m < 4; ++m) { const int r = row0 + ai * 128 + m * 16; const float rs = rsl[pre.par * 256 + wr * 64 + fr + ai * 128 + m * 16];
                    const f32x4 v0 = acc[ai][0][m][0], v1 = acc[ai][0][m][1], g0 = acc[ai][1][m][0], g1 = acc[ai][1][m][1];
                    const float nr = rs * -1.44269504089f; const f32x2e nrs = {nr, nr}, rs1 = {rs, rs};
                    const f32x2e o0 = glus2_(LO2(v0), LO2(g0), nrs, rs1), o1 = glus2_(HI2(v0), HI2(g0), nrs, rs1), o2 = glus2_(LO2(v1), LO2(g1), nrs, rs1), o3 = glus2_(HI2(v1), HI2(g1), nrs, rs1);
                    u32x4 w; w.x = cvt_pk_bf16(o0.x, o0.y); w.y = cvt_pk_bf16(o1.x, o1.y); w.z = cvt_pk_bf16(o2.x, o2.y); w.w = cvt_pk_bf16(o3.x, o3.y);
                    *(u32x4*)(U + (size_t)r * CW + u.pn * 128 + cl) = w; asm volatile("" ::: "memory"); }
        } else if (u.pn < 6) {
#pragma unroll
            for (int ai = 0; ai < 2; ++ai)
#pragma unroll
                for (int m = 0; m < 4; ++m) { const int r = row0 + ai * 128 + m * 16; const float rs = rsl[pre.par * 256 + wr * 64 + fr + ai * 128 + m * 16];
#pragma unroll
                    for (int bj = 0; bj < 2; ++bj) { const f32x4 v0 = acc[ai][bj][m][0] * rs, v1 = acc[ai][bj][m][1] * rs;
                        u32x4 w; w.x = cvt_pk_bf16(v0[0], v0[1]); w.y = cvt_pk_bf16(v0[2], v0[3]); w.z = cvt_pk_bf16(v1[0], v1[1]); w.w = cvt_pk_bf16(v1[2], v1[3]);
                        *(u32x4*)(Q + (size_t)r * 512 + (u.pn - 4) * 256 + bj * 128 + cl) = w; } asm volatile("" ::: "memory"); }
        } else if (u.pn < 9) {
            const int h = wc >> 1, d0 = 32 * (wc & 1) + 8 * fq;
#pragma unroll
            for (int ai = 0; ai < 2; ++ai)
#pragma unroll
                for (int m = 0; m < 4; ++m) { const int r = row0 + ai * 128 + m * 16; const float rs = rsl[pre.par * 256 + wr * 64 + fr + ai * 128 + m * 16]; const int b = r >> 11, t = r & 2047;
#pragma unroll
                    for (int bj = 0; bj < 2; ++bj) { const int tq = 2 * (u.pn - 6) + bj; const f32x4 v0 = acc[ai][bj][m][0] * rs, v1 = acc[ai][bj][m][1] * rs;
                        u32x4 w; w.x = cvt_pk_bf16(v0[0], v0[1]); w.y = cvt_pk_bf16(v0[2], v0[3]); w.z = cvt_pk_bf16(v1[0], v1[1]); w.w = cvt_pk_bf16(v1[2], v1[3]);
                        *(u32x4*)(KV + (size_t)tq * KVT + ((size_t)(b * 2 + h) * SEQ + t) * DH + d0) = w; } asm volatile("" ::: "memory"); }
        } else {
            if (wc == 0 && fq < 3) {
#pragma unroll
                for (int ai = 0; ai < 2; ++ai)
#pragma unroll
                    for (int m = 0; m < 4; ++m) { const int r = row0 + ai * 128 + m * 16; const float rs = rsl[pre.par * 256 + wr * 64 + fr + ai * 128 + m * 16];
                        *(f32x4*)(GT + (size_t)r * 24 + 8 * fq) = acc[ai][0][m][0] * rs; *(f32x4*)(GT + (size_t)r * 24 + 8 * fq + 4) = acc[ai][0][m][1] * rs; }
            }
        }
    }
};
struct EpiH1 {
    static constexpr bool PERM = false;
    float* H;
    struct Pre {}; __device__ __forceinline__ void prefetch(const Unit&, int, int, Pre&) const {}
    __device__ __forceinline__ void operator()(const f32x4 (&acc)[2][2][4][2], const Unit& u, int wr, int wc, int fr, int fq, const Pre&) const {
        const int row0 = u.pm * 256 + wr * 64 + fr, col0 = wc * 32 + 4 * fq; const int kv = u.pn >> 3, sp = u.pn & 7;
#pragma unroll
        for (int ai = 0; ai < 2; ++ai)
#pragma unroll
            for (int m = 0; m < 4; ++m) { float* rowp = H + (((size_t)sp * 2 + kv) * 2048 + row0 + ai * 128 + m * 16) * 256 + col0;
#pragma unroll
                for (int bj = 0; bj < 2; ++bj)
#pragma unroll
                    for (int n = 0; n < 2; ++n) *(f32x4*)(rowp + bj * 128 + n * 16) = acc[ai][bj][m][n]; }
    }
};
template <bool BF> struct EpiRes {
    static constexpr bool PERM = false;
    const void* base; bf16_t* xb; float* pss;
    struct Pre {}; __device__ __forceinline__ void prefetch(const Unit&, int, int, Pre&) const {}
    __device__ __forceinline__ void operator()(const f32x4 (&acc)[2][2][4][2], const Unit& u, int wr, int wc, int fr, int fq, const Pre&) const {
        const int row0 = u.pm * 256 + wr * 64 + fr, col0 = u.pn * 256 + wc * 32 + 4 * fq;
#pragma unroll
        for (int ai = 0; ai < 2; ++ai) {
            f32x4 bs[4][2][2];
#pragma unroll
            for (int m = 0; m < 4; ++m) { const size_t off = (size_t)(row0 + ai * 128 + m * 16) * D + col0;
#pragma unroll
                for (int bj = 0; bj < 2; ++bj)
#pragma unroll
                    for (int n = 0; n < 2; ++n) {
                        if (BF) { const u32x2 w = *(const u32x2*)((const bf16_t*)base + off + bj * 128 + n * 16); bs[m][bj][n] = (f32x4){bf_lo(w.x), bf_hi(w.x), bf_lo(w.y), bf_hi(w.y)}; }
                        else bs[m][bj][n] = *(const f32x4*)((const float*)base + off + bj * 128 + n * 16); } }
#pragma unroll
            for (int m = 0; m < 4; ++m) { const size_t off = (size_t)(row0 + ai * 128 + m * 16) * D + col0; float ss = 0.f;
#pragma unroll
                for (int bj = 0; bj < 2; ++bj)
#pragma unroll
                    for (int n = 0; n < 2; ++n) { const f32x4 v = bs[m][bj][n] + acc[ai][bj][m][n];
                        u32x2 w; w.x = cvt_pk_bf16(v[0], v[1]); w.y = cvt_pk_bf16(v[2], v[3]); *(u32x2*)(xb + off + bj * 128 + n * 16) = w; ss += (v[0] * v[0] + v[1] * v[1]) + (v[2] * v[2] + v[3] * v[3]); }
                if (pss) { ss += __shfl_xor(ss, 16); ss += __shfl_xor(ss, 32);
                    if (fq == 0) pss[(size_t)(row0 + ai * 128 + m * 16) * 16 + u.pn * 4 + wc] = ss; } } }
    }
};
struct EpiGlu {
    static constexpr bool PERM = true;
    const float* rstd; bf16_t* O; int ldo; int rowbase;
    const float* pss; LAS float* rsl;
    struct Pre { int par = 1; };
    __device__ __forceinline__ void prefetch(const Unit& u, int wr, int fr, Pre& p) const { p.par ^= 1; rstd_from_partials(pss, u.pm, rsl + p.par * 256); }
    __device__ __forceinline__ void operator()(const f32x4 (&acc)[2][2][4][2], const Unit& u, int wr, int wc, int fr, int fq, const Pre& pre) const {
        const int row0 = u.pm * 256 + wr * 64 + fr, cl = u.pn * 128 + wc * 32 + 8 * fq;
#pragma unroll
        for (int ai = 0; ai < 2; ++ai)
#pragma unroll
            for (int m = 0; m < 4; ++m) { const int r = row0 + ai * 128 + m * 16; const float rs = rsl[pre.par * 256 + wr * 64 + fr + ai * 128 + m * 16];
                const f32x4 g0 = acc[ai][0][m][0], g1 = acc[ai][0][m][1], u0 = acc[ai][1][m][0], u1 = acc[ai][1][m][1];
                const float nr = rs * -1.44269504089f, r2 = rs * rs; const f32x2e nrs = {nr, nr}, rs2 = {r2, r2};
                const f32x2e o0 = glu2_(LO2(g0), LO2(u0), nrs, rs2), o1 = glu2_(HI2(g0), HI2(u0), nrs, rs2), o2 = glu2_(LO2(g1), LO2(u1), nrs, rs2), o3 = glu2_(HI2(g1), HI2(u1), nrs, rs2);
                u32x4 w; w.x = cvt_pk_bf16(o0.x, o0.y); w.y = cvt_pk_bf16(o1.x, o1.y); w.z = cvt_pk_bf16(o2.x, o2.y); w.w = cvt_pk_bf16(o3.x, o3.y);
                *(u32x4*)(O + (size_t)r * ldo + cl) = w; }
    }
};
struct EpiGlu8 {
    static constexpr bool PERM = true;
    const float* rstd; unsigned char* O; int ldo; float sc;
    struct Pre { float rs[8]; };
    __device__ __forceinline__ void prefetch(const Unit& u, int wr, int fr, Pre& p) const {
#pragma unroll
        for (int q = 0; q < 8; ++q) p.rs[q] = rstd[u.pm * 256 + wr * 64 + fr + (q >> 2) * 128 + (q & 3) * 16]; }
    __device__ __forceinline__ void operator()(const f32x4 (&acc)[2][2][4][2], const Unit& u, int wr, int wc, int fr, int fq, const Pre& pre) const {
        const int row0 = u.pm * 256 + wr * 64 + fr, cl = u.pn * 128 + wc * 32 + 8 * fq;
#pragma unroll
        for (int ai = 0; ai < 2; ++ai)
#pragma unroll
            for (int m = 0; m < 4; ++m) { const int r = row0 + ai * 128 + m * 16; const float rs = pre.rs[ai * 4 + m] * sc;
                const f32x4 g0 = acc[ai][0][m][0], g1 = acc[ai][0][m][1], u0 = acc[ai][1][m][0], u1 = acc[ai][1][m][1];
                const float nr = rs * -1.44269504089f, r2 = rs * rs; const f32x2e nrs = {nr, nr}, rs2 = {r2, r2};
                const f32x2e o0 = glu2_(LO2(g0), LO2(u0), nrs, rs2), o1 = glu2_(HI2(g0), HI2(u0), nrs, rs2), o2 = glu2_(LO2(g1), LO2(u1), nrs, rs2), o3 = glu2_(HI2(g1), HI2(u1), nrs, rs2);
                *(u32x2*)(O + (size_t)r * ldo + cl) = pk8_fp8(o0.x, o0.y, o1.x, o1.y, o2.x, o2.y, o3.x, o3.y); }
    }
};
struct EpiMoe2 {
    static constexpr bool PERM = true;
    const int* stok; const float* sw; bf16_t* Y0; bf16_t* Y1; int rowbase; float sc;
    struct Pre {}; __device__ __forceinline__ void prefetch(const Unit&, int, int, Pre&) const {}
    __device__ __forceinline__ void operator()(const f32x4 (&acc)[2][2][4][2], const Unit& u, int wr, int wc, int fr, int fq, const Pre&) const {
        const int row0 = u.pm * 256 + wr * 64 + fr, cl = u.pn * 256 + wc * 32 + 8 * fq;
        int tks[8]; float ws[8];
#pragma unroll
        for (int q = 0; q < 8; ++q) { const int r = rowbase + row0 + (q >> 2) * 128 + (q & 3) * 16; tks[q] = stok[r]; ws[q] = sw[r]; }
#pragma unroll
        for (int ai = 0; ai < 2; ++ai)
#pragma unroll
            for (int m = 0; m < 4; ++m) { const int tk = tks[ai * 4 + m]; const float w = ws[ai * 4 + m] * sc;
                if (tk >= 0) { bf16_t* dst = ((tk & 1) ? Y1 : Y0) + (size_t)(tk >> 1) * D + cl;
#pragma unroll
                    for (int bj = 0; bj < 2; ++bj) { const f32x4 v0 = acc[ai][bj][m][0] * w, v1 = acc[ai][bj][m][1] * w;
                        u32x4 o; o.x = cvt_pk_bf16(v0[0], v0[1]); o.y = cvt_pk_bf16(v0[2], v0[3]); o.z = cvt_pk_bf16(v1[0], v1[1]); o.w = cvt_pk_bf16(v1[2], v1[3]);
                        *(u32x4*)(dst + bj * 128) = o; } } }
    }
};

struct SchedCmp {
    int G, c, layer;
    __device__ __forceinline__ bool next(int i, Unit& u) const {
        const int L = i * G + c; if (L >= 128) return false;
        const int kv = L >> 6, pm = (L >> 3) & 7, s = L & 7;
        u.pm = pm; u.pn = kv * 8 + s; u.aoff = ((size_t)kv * KVT + (size_t)pm * 256 * 1024 + s * 256) * 2; u.boff = ((size_t)(layer * 2 + kv) * 256 * 2048 + s * 256) * 2; return true;
    }
};
struct SchedMoe1 {
    int G, c, p0, np; const LAS int* ptab;
    __device__ __forceinline__ bool next(int i, Unit& u) const {
        const int L = i * G + c; if (L >= np * 28) return false;
        const int j = L / np, pl = L % np, e = ptab[p0 + pl];
        u.pm = pl; u.pn = j; u.aoff = (size_t)(p0 + pl) * 256 * 1024 * 2; u.boff = ((size_t)e * 7168 + (size_t)j * 256) * 1024 * 2; return true;
    }
};
struct SchedMoe2 {
    int G, c, p0, np; const LAS int* ptab;
    __device__ __forceinline__ bool next(int i, Unit& u) const {
        const int L = i * G + c; if (L >= np * 4) return false;
        const int j = L / np, pl = L % np, e = ptab[p0 + pl];
        u.pm = pl; u.pn = j; u.aoff = (size_t)pl * 256 * DFE * 2; u.boff = ((size_t)e * 1024 + (size_t)j * 256) * DFE * 2; return true;
    }
};

struct SchedMoe1F {
    int G, c, np; const LAS int* ptab;
    __device__ __forceinline__ bool next(int i, Unit& u) const {
        const int L = i * G + c; if (L >= np * 28) return false;
        const int pl = L / 28, j = L % 28, e = ptab[pl];
        u.pm = pl; u.pn = j; u.aoff = (size_t)pl * 256 * 1024; u.boff = ((size_t)e * 7168 + (size_t)j * 256) * 1024; return true;
    }
};
struct SchedMoe2F {
    int G, c, np; const LAS int* ptab;
    __device__ __forceinline__ bool next(int i, Unit& u) const {
        const int L = i * G + c; if (L >= np * 4) return false;
        const int pl = L >> 2, j = L & 3, e = ptab[pl];
        u.pm = pl; u.pn = j; u.aoff = (size_t)pl * 256 * DFE; u.boff = ((size_t)e * 1024 + (size_t)j * 256) * DFE; return true;
    }
};

struct MoePlan { int N1, PA, nup, qa, n2; };
__device__ __forceinline__ MoePlan moe_plan(int np, int G) {
    MoePlan P; const bool split = (G == 256) && np >= 128 && np <= 136;
    P.nup = 28 * np; P.N1 = split ? 2048 : P.nup; P.PA = split ? np - 64 : np;
    const int r1 = P.nup - P.N1, nA = 4 * P.PA; P.n2 = (split && nA > G) ? nA - G : 0;
    const int R = (r1 + 3 * P.n2 + G - 1) / G; P.qa = R > 3 ? R - 3 : 0; return P; }
struct SchedMoe1R {
    int G, c, L0, ntot, qa, n2; const LAS int* ptab;
    __device__ __forceinline__ bool next(int i, Unit& u) const {
        int L; if (i < qa) L = L0 + i * G + c; else { if (c < n2) return false; L = L0 + qa * G + (i - qa) * (G - n2) + (c - n2); }
        if (L >= ntot) return false;
        const int pl = L / 28, j = L % 28, e = ptab[pl];
        u.pm = pl; u.pn = j; u.aoff = (size_t)pl * 256 * 1024; u.boff = ((size_t)e * 7168 + (size_t)j * 256) * 1024; return true;
    }
};
struct SchedMoe2R {
    int G, c, p0, np; const LAS int* ptab;
    __device__ __forceinline__ bool next(int i, Unit& u) const {
        const int L = i * G + c; if (L >= np * 4) return false;
        const int pl = p0 + (L >> 2), j = L & 3, e = ptab[pl];
        u.pm = pl; u.pn = j; u.aoff = (size_t)pl * 256 * DFE; u.boff = ((size_t)e * 1024 + (size_t)j * 256) * DFE; return true;
    }
};

struct TwP { const float* W; const float* gv; bf16_t* WT; int ldw, n0, nvalid, k0, ldk, kind, h; float f8sc; };
__device__ __forceinline__ TwP tw_job(int r, const float* W, int ldw, int nblk, int nvalid, bf16_t* WT, int ldk, int kind, int h, const float* gv) {
    TwP P; P.W = W; P.gv = gv; P.WT = WT; P.ldw = ldw; P.n0 = 256 * (r % nblk); P.nvalid = nvalid; P.k0 = 64 * (r / nblk); P.ldk = ldk; P.kind = kind; P.h = h; P.f8sc = 0.f; return P; }
__device__ __forceinline__ void tw_load(const TwP& P, f32x4 (&tv)[8], int wave, int lane) {
    const int n = P.n0 + 4 * lane; const float* src = P.W + (size_t)(P.k0 + 8 * wave) * P.ldw + n;
#pragma unroll
    for (int i = 0; i < 8; ++i) tv[i] = (n < P.nvalid) ? *(const f32x4*)(src + (size_t)i * P.ldw) : (f32x4){0.f, 0.f, 0.f, 0.f};
}
__device__ __forceinline__ void tw_store(const TwP& P, f32x4 (&tv)[8], LAS unsigned char* tile, int wave, int lane) {
    if (P.gv) {
#pragma unroll
        for (int i = 0; i < 8; ++i) tv[i] *= P.gv[P.k0 + 8 * wave + i]; }
    const int ng = P.n0 + 32 * wave; size_t drow;
    if (P.kind == 0) drow = ng;
    else if (P.kind == 1) drow = 256 * (ng / 128) + 128 * P.h + (ng % 128);
    else { if (ng < 512) drow = 256 * (ng / 128) + (ng % 128); else if (ng < 1024) { const int cc = ng - 512; drow = 256 * (cc / 128) + 128 + (cc % 128); } else drow = ng; }
    if (P.f8sc != 0.f) {
        const float sc = P.f8sc;
#pragma unroll
        for (int c = 0; c < 4; ++c) *(LAS u32x2*)(tile + (4 * lane + c) * 80 + 8 * wave) = pk8_fp8(tv[0][c] * sc, tv[1][c] * sc, tv[2][c] * sc, tv[3][c] * sc, tv[4][c] * sc, tv[5][c] * sc, tv[6][c] * sc, tv[7][c] * sc);
        __syncthreads();
#pragma unroll
        for (int j = 0; j < 2; ++j) { const int r = (lane >> 2) + 16 * j, ch = lane & 3;
            *(u32x4*)((unsigned char*)P.WT + (drow + r) * (size_t)P.ldk + P.k0 + 16 * ch) = *(const LAS u32x4*)(tile + (32 * wave + r) * 80 + 16 * ch); }
        __syncthreads();
        return; }
#pragma unroll
    for (int c = 0; c < 4; ++c) { u32x4 o; o.x = cvt_pk_bf16(tv[0][c], tv[1][c]); o.y = cvt_pk_bf16(tv[2][c], tv[3][c]); o.z = cvt_pk_bf16(tv[4][c], tv[5][c]); o.w = cvt_pk_bf16(tv[6][c], tv[7][c]);
        *(LAS u32x4*)(tile + (4 * lane + c) * 144 + 16 * wave) = o; }
    __syncthreads();
#pragma unroll
    for (int j = 0; j < 4; ++j) { const int r = (lane >> 3) + 8 * j, c = lane & 7;
        *(u32x4*)(P.WT + (drow + r) * (size_t)P.ldk + P.k0 + 8 * c) = *(const LAS u32x4*)(tile + (32 * wave + r) * 144 + 16 * c); }
    __syncthreads();
}
#define TW_RUN(NIT, JOB) do { const int _n = (NIT); if (_n > 0) { TwP _pa, _pb; f32x4 _ta[8], _tb[8]; JOB(_pa, 0); tw_load(_pa, _ta, F.wave, F.lane); \
    _Pragma("nounroll") for (int _i = 0; _i < _n; _i += 2) { const bool _h2 = _i + 1 < _n, _h3 = _i + 2 < _n; \
        if (_h2) { JOB(_pb, _i + 1); tw_load(_pb, _tb, F.wave, F.lane); } tw_store(_pa, _ta, F.lds, F.wave, F.lane); if (!_h2) break; \
        if (_h3) { JOB(_pa, _i + 2); tw_load(_pa, _ta, F.wave, F.lane); } tw_store(_pb, _tb, F.lds, F.wave, F.lane); } } } while (0)
__device__ __forceinline__ void xprep_row(const float* xrow, bf16_t* orow, float* rstd_out, int lane, f32x4 (&v)[4]) {
    const f32x4* xr = (const f32x4*)xrow + lane; float s = 0.f;
#pragma unroll
    for (int j = 0; j < 4; ++j) { v[j] = xr[64 * j]; s += (v[j].x * v[j].x + v[j].y * v[j].y) + (v[j].z * v[j].z + v[j].w * v[j].w); }
    const float rstd = rsqf_(wave_sum_u(s) * (1.0f / D) + EPS);
    if (orow) { u32x2* o8 = (u32x2*)orow + lane;
#pragma unroll
        for (int j = 0; j < 4; ++j) { u32x2 w; w.x = cvt_pk_bf16(v[j].x, v[j].y); w.y = cvt_pk_bf16(v[j].z, v[j].w); o8[64 * j] = w; } }
    if (lane == 0) *rstd_out = rstd;
}

constexpr float MOE_S1 = 64.f, MOE_S2 = 128.f;
constexpr int MOE_SLOT_N = 7, MOE_SLOTTED = 3 * 128 * MOE_SLOT_N;
constexpr int MOE_ITEMS = 24 * 224;
__device__ __forceinline__ TwP moe_conv_job(Frame& F, int r) {
    constexpr int J_M1 = 16 * 14, J_M2 = 56 * 4;
    unsigned char* WM1 = F.ws + WS_WM1; unsigned char* WM2 = F.ws + WS_WM2;
    if (r < 16 * J_M1) { const int q = r / J_M1, e = q >> 1, h = q & 1; TwP P = tw_job(r % J_M1, (h ? INP_(I_MW3) : INP_(I_MW1)) + (size_t)e * D * DFE, DFE, 14, DFE, (bf16_t*)(WM1 + (size_t)e * 7168 * D), D, 1, h, INP_(I_FNG) + D); P.f8sc = MOE_S1; return P; }
    r -= 16 * J_M1; const int e = r / J_M2; TwP P = tw_job(r % J_M2, INP_(I_MW2) + (size_t)e * DFE * D, D, 4, D, (bf16_t*)(WM2 + (size_t)e * D * DFE), DFE, 0, 0, nullptr); P.f8sc = MOE_S2; return P;
}
__device__ __forceinline__ void moe_conv_slot(Frame& F, int slot) {
    if (F.G != 256 || F.c < 128) return;
    { int _t = threadIdx.x; asm volatile("" : "+v"(_t)); F.tid = _t; F.lane = _t & 63; }
    int base = slot * 128 * MOE_SLOT_N + ((int)blockIdx.x - 128); asm volatile("" : "+s"(base));
#define MJOB(P, i) P = moe_conv_job(F, base + (i) * 128)
    TW_RUN(MOE_SLOT_N, MJOB);
#undef MJOB
}
__device__ __forceinline__ void xprep_rows4(const float* X, bf16_t* XBo, float* RSo, int m, int ms, int lane) {
    f32x4 v[4][4];
#pragma unroll
    for (int q = 0; q < 4; ++q) { const int mm = m + q * ms; const f32x4* xr = (const f32x4*)(X + (size_t)(mm < M ? mm : 0) * D) + lane;
#pragma unroll
        for (int j = 0; j < 4; ++j) v[q][j] = xr[64 * j]; }
#pragma unroll
    for (int q = 0; q < 4; ++q) { const int mm = m + q * ms; if (mm >= M) break; float s = 0.f;
#pragma unroll
        for (int j = 0; j < 4; ++j) s += (v[q][j].x * v[q][j].x + v[q][j].y * v[q][j].y) + (v[q][j].z * v[q][j].z + v[q][j].w * v[q][j].w);
        const float rstd = rsqf_(wave_sum_u(s) * (1.0f / D) + EPS);
        u32x2* o8 = (u32x2*)(XBo + (size_t)mm * D) + lane;
#pragma unroll
        for (int j = 0; j < 4; ++j) { u32x2 w; w.x = cvt_pk_bf16(v[q][j].x, v[q][j].y); w.y = cvt_pk_bf16(v[q][j].z, v[q][j].w); o8[64 * j] = w; }
        if (lane == 0) RSo[mm] = rstd; }
}
__device__ __forceinline__ void phase_prologue(Frame& F) {
    const int gw = F.c * NWAVES + F.wave, NGW = F.G * NWAVES;
    bf16_t* WIN = (bf16_t*)(F.ws + WS_WIN); bf16_t* WC1 = (bf16_t*)(F.ws + WS_WC1); bf16_t* WOUT = (bf16_t*)(F.ws + WS_WOUT); bf16_t* WF1 = (bf16_t*)(F.ws + WS_WF1); bf16_t* WF2 = (bf16_t*)(F.ws + WS_WF2);
    constexpr int J_IN = 16 * 10, J_C1 = 32, J_OUT = 16 * 4, J_F1 = 16 * 11, J_F2 = 44 * 4;
    constexpr int NSMALL = 2 * J_IN + 4 * J_C1 + 2 * J_OUT + 2 * J_F1 + J_F2;
    const int moe0 = (F.G == 256) ? MOE_SLOTTED : 0; const int nitems = NSMALL + MOE_ITEMS - moe0;
#define P0_JOB(P, i) do { int r = F.c + (i) * F.G; \
        if (r < 2 * J_IN) { const int l = r / J_IN; P = tw_job(r % J_IN, INP_(I_WIN) + (size_t)l * D * INW, INW, 10, INW, WIN + (size_t)l * INP * D, D, 2, 0, INP_(I_ANG) + l * D); break; } r -= 2 * J_IN; \
        if (r < 4 * J_C1) { const int q = r / J_C1, l = q >> 1, kv = q & 1; P = tw_job(r % J_C1, (kv ? INP_(I_VW1) : INP_(I_KW1)) + (size_t)l * 2048 * 256, 256, 1, 256, WC1 + (size_t)(l * 2 + kv) * 256 * 2048, 2048, 0, 0, nullptr); break; } r -= 4 * J_C1; \
        if (r < 2 * J_OUT) { const int l = r / J_OUT; P = tw_job(r % J_OUT, INP_(I_WOUT) + (size_t)l * D * D, D, 4, D, WOUT + (size_t)l * D * D, D, 0, 0, nullptr); break; } r -= 2 * J_OUT; \
        if (r < 2 * J_F1) { const int h = r / J_F1; P = tw_job(r % J_F1, (h ? INP_(I_DW3) : INP_(I_DW1)), DFF, 11, DFF, WF1, D, 1, h, INP_(I_FNG)); break; } r -= 2 * J_F1; \
        if (r < J_F2) { P = tw_job(r, INP_(I_DW2), D, 4, D, WF2, DFF, 0, 0, nullptr); break; } r -= J_F2; \
        P = moe_conv_job(F, r + moe0); } while (0)
    TW_RUN((nitems - F.c + F.G - 1) / F.G, P0_JOB);
#undef P0_JOB
    { float* RT = (float*)(F.ws + WS_RT); const int gt = F.c * NTHR + F.tid; if (gt < 8192) { const int e = gt >> 10, k = gt & 1023; RT[gt] = INP_(I_RW)[k * 8 + e] * INP_(I_FNG)[D + k]; } }
    { float* B1P = (float*)(F.ws + WS_CTL) + CW_B1P; LAS float* ps = (LAS float*)F.lds;
      for (int it = F.c; it < 128; it += F.G) { const int kc = it & 7, jb = (it >> 3) & 3, kv = (it >> 5) & 1, l = it >> 6; const int j = jb * 64 + F.lane, kb = kc * 256 + 32 * F.wave;
          const float* w1 = (kv ? INP_(I_VW1) : INP_(I_KW1)) + (size_t)l * 2048 * 256; const float* pos = (kv ? INP_(I_PV) : INP_(I_PK)) + l * 2048;
          float wv[32];
#pragma unroll
          for (int k = 0; k < 32; ++k) wv[k] = w1[(size_t)(kb + k) * 256 + j];
          float sp = 0.f;
#pragma unroll
          for (int k = 0; k < 32; ++k) sp += pos[kb + k] * wv[k];
          ps[F.wave * 64 + F.lane] = sp;
          __syncthreads();
          if (F.wave == 0) { float t = (kc == 0) ? (kv ? INP_(I_VB1) : INP_(I_KB1))[l * 256 + j] : 0.f;
#pragma unroll
              for (int ww = 0; ww < 8; ++ww) t += ps[ww * 64 + F.lane];
              B1P[kc * 1024 + (l * 2 + kv) * 256 + j] = t; }
          __syncthreads(); } }
    { bf16_t* XB = (bf16_t*)(F.ws + WS_XB); float* RS = (float*)(F.ws + WS_RSTD);
      for (int m = gw; m < M; m += 4 * NGW) xprep_rows4(INP_(I_X), XB, RS, m, NGW, F.lane); }
}

__device__ __forceinline__ void norm_rows64(bf16_t* buf, int nrows, const float* g, float scale, int gw, int NGW, int lane) {
    const int sub = lane & 7; float gv[8];
#pragma unroll
    for (int j = 0; j < 8; ++j) gv[j] = g[sub * 8 + j] * scale;
    for (int it = gw; it < nrows / 8; it += NGW) { u32x4* p = (u32x4*)(buf + ((size_t)it * 8 + (lane >> 3)) * 64) + sub; const u32x4 v = *p;
        float f[8] = {bf_lo(v.x), bf_hi(v.x), bf_lo(v.y), bf_hi(v.y), bf_lo(v.z), bf_hi(v.z), bf_lo(v.w), bf_hi(v.w)}; float s = 0.f;
#pragma unroll
        for (int j = 0; j < 8; ++j) s += f[j] * f[j];
        s += __shfl_xor(s, 1); s += __shfl_xor(s, 2); s += __shfl_xor(s, 4);
        const float rs = rsqf_(s * (1.0f / 64.0f) + EPS);
        u32x4 o; o.x = cvt_pk_bf16(f[0] * rs * gv[0], f[1] * rs * gv[1]); o.y = cvt_pk_bf16(f[2] * rs * gv[2], f[3] * rs * gv[3]); o.z = cvt_pk_bf16(f[4] * rs * gv[4], f[5] * rs * gv[5]); o.w = cvt_pk_bf16(f[6] * rs * gv[6], f[7] * rs * gv[7]);
        *p = o; }
}
__device__ __forceinline__ float sum32_(float v, bool) {
    v = DPP_ADD(v, 0xB1); v = DPP_ADD(v, 0x4E); v = DPP_ADD(v, 0x124); v = DPP_ADD(v, 0x128);
    return v + __shfl_xor(v, 16);
}
__device__ __forceinline__ void conv_unit(Frame& F, int layer, int cu) {
    const int b = cu >> 6, t0 = (cu & 63) * 32; int tid = F.tid; asm volatile("" : "+v"(tid));
    const bf16_t* U = (const bf16_t*)(F.ws + WS_U); bf16_t* MIX = (bf16_t*)(F.ws + WS_MIX);
    LAS u32x4* L4 = (LAS u32x4*)F.lds;
    { u32x4 sv[8];
#pragma unroll
      for (int q = 0; q < 8; ++q) { const int i = tid + q * NTHR, row = i >> 6, ch = i & 63, t = t0 - 30 + row; sv[q] = (u32x4){0u, 0u, 0u, 0u}; if (i < 62 * 64 && t >= 0) sv[q] = *(const u32x4*)(U + (size_t)(b * SEQ + t) * CW + ch * 8); }
#pragma unroll
      for (int q = 0; q < 8; ++q) { const int i = tid + q * NTHR; if (i < 62 * 64) L4[i] = sv[q]; } }
    __syncthreads();
    const int cp = tid & 255, th = tid >> 8; const bool hi = (tid & 32) != 0; const LAS unsigned* LW = (const LAS unsigned*)F.lds;
    f32x2 w[CKW];
#pragma unroll
    for (int k = 0; k < CKW; ++k) w[k] = *(const f32x2*)(INP_(I_CDW) + (size_t)layer * CKW * CW + k * CW + 2 * cp);
    const f32x2 cb = *(const f32x2*)(INP_(I_CDB) + layer * CW + 2 * cp), lg = *(const f32x2*)(INP_(I_CLG) + layer * CW + 2 * cp), lb = *(const f32x2*)(INP_(I_CLB) + layer * CW + 2 * cp);
#pragma nounroll
    for (int hf = 0; hf < 2; ++hf) { const int tl0 = th * 16 + hf * 8;
        f32x2 in[38];
#pragma unroll
        for (int i = 0; i < 38; ++i) { const unsigned v = LW[(tl0 + i) * 256 + cp]; in[i] = (f32x2){bf_lo(v), bf_hi(v)}; }
        f32x2 acc[8];
#pragma unroll
        for (int t = 0; t < 8; ++t) { acc[t] = cb;
#pragma unroll
            for (int k = 0; k < CKW; ++k) acc[t] += w[k] * in[t + k]; }
#pragma unroll
        for (int t = 0; t < 8; ++t) {
            const float s = sum32_(acc[t].x + acc[t].y, hi), q = sum32_(acc[t].x * acc[t].x + acc[t].y * acc[t].y, hi);
            const float mu = s * (1.0f / 64.0f), var = fmaxf(q * (1.0f / 64.0f) - mu * mu, 0.f), rs = rsqf_(var + EPS);
            const float a0 = (acc[t].x - mu) * rs * lg.x + lb.x, a1 = (acc[t].y - mu) * rs * lg.y + lb.y;
            *(unsigned*)(MIX + (size_t)(b * SEQ + t0 + tl0 + t) * D + 2 * cp) = cvt_pk_bf16(siluf_(a0), siluf_(a1)); }
    }
    __syncthreads();
}
__device__ __forceinline__ void vtrans_items(Frame& F, int gw, int NGW) {
    const int lane = F.lane;
    LAS unsigned char* scr = F.lds + F.wave * 9216;
    for (int it = gw; it < 1024; it += NGW) { const int ten = it >> 9, bh = (it >> 5) & 15, kb = it & 31;
        const bf16_t* V = (const bf16_t*)(F.ws + WS_KV) + (size_t)(ten ? 5 : 3) * KVT + ((size_t)bh * SEQ + kb * 64) * 64; bf16_t* VT = (bf16_t*)(F.ws + (ten ? WS_VWT : WS_VST)) + (size_t)bh * 64 * SEQ + kb * 64;
#pragma unroll
        for (int c = 0; c < 8; ++c) *(LAS u32x4*)(scr + lane * 144 + c * 16) = *((const u32x4*)(V + (size_t)lane * 64) + c);
        LDS_WAIT(); __builtin_amdgcn_wave_barrier(); asm volatile("" ::: "memory");
#pragma unroll
        for (int c = 0; c < 8; ++c) { unsigned w[4];
#pragma unroll
            for (int q = 0; q < 4; ++q) { const int v0 = 8 * c + 2 * q, k0 = swap23(v0), k1 = swap23(v0 + 1);
                w[q] = (unsigned)*(const LAS bf16_t*)(scr + k0 * 144 + lane * 2) | ((unsigned)*(const LAS bf16_t*)(scr + k1 * 144 + lane * 2) << 16); }
            *((u32x4*)(VT + (size_t)lane * SEQ) + c) = (u32x4){w[0], w[1], w[2], w[3]}; }
        LDS_WAIT(); __builtin_amdgcn_wave_barrier(); asm volatile("" ::: "memory");
    }
}
__device__ __forceinline__ void phase_cmp2(Frame& F, int layer) {
    const int lane = F.lane, w = F.wave, k0 = 32 * w;
    const float* H1 = (const float*)(F.ws + WS_H1); const float* B1P = (const float*)(F.ws + WS_CTL) + CW_B1P + layer * 512;
    LAS float* part = (LAS float*)F.lds;
#pragma nounroll
    for (int un = F.c; un < 256; un += F.G) { const int kv = un >> 7, R0 = (un & 127) * 16;
        const float* w2 = (kv ? INP_(I_VW2) : INP_(I_KW2)) + (size_t)layer * 16384 + (size_t)k0 * 64 + lane;
        float w2r[32];
#pragma unroll
        for (int j = 0; j < 32; ++j) w2r[j] = w2[j * 64];
        float bsum = 0.f;
#pragma unroll
        for (int sp = 0; sp < 8; ++sp) bsum += B1P[sp * 1024 + kv * 256 + k0 + (lane & 31)];
        float acc[16], hx[16];
        {
            float hp[16][8];
#pragma unroll
            for (int r = 0; r < 16; ++r)
#pragma unroll
                for (int sp = 0; sp < 8; ++sp) hp[r][sp] = H1[((size_t)kv * 2048 + R0 + r) * 256 + k0 + (lane & 31) + (size_t)sp * 2 * 2048 * 256];
#pragma unroll
            for (int r = 0; r < 16; ++r) { float x = 0.f;
#pragma unroll
                for (int sp = 0; sp < 8; ++sp) x += hp[r][sp];
                hx[r] = siluf_(x + bsum); } }
#pragma unroll
        for (int r = 0; r < 16; ++r) { const int hb = __builtin_bit_cast(int, hx[r]); float a = 0.f;
#pragma unroll
            for (int j = 0; j < 32; ++j) a += __builtin_bit_cast(float, __builtin_amdgcn_readlane(hb, j)) * w2r[j];
            acc[r] = a; }
#pragma unroll
        for (int r = 0; r < 16; ++r) part[(w * 16 + r) * 64 + lane] = acc[r];
        __syncthreads();
#pragma unroll
        for (int rr = 0; rr < 2; ++rr) { const int r = 2 * w + rr, R = R0 + r;
            float a = (kv ? INP_(I_VB2) : INP_(I_KB2))[layer * 64 + lane];
#pragma unroll
            for (int ww = 0; ww < 8; ++ww) a += part[(ww * 16 + r) * 64 + lane];
            if ((R & 127) == 127) a = 0.f;
            else if (kv == 0) { const float ms = wave_sum_u(a * a) * (1.0f / 64.0f); a = a * (rsqf_(ms + EPS)) * INP_(I_KG)[layer * 192 + lane]; }
            const bf16_t ab = (bf16_t)(cvt_pk_bf16(a, 0.f) & 0xffffu);
            ((bf16_t*)(F.ws + (kv ? WS_VC : WS_KC)))[(size_t)R * 64 + lane] = ab;
            if (kv) ((bf16_t*)(F.ws + WS_VCT))[((size_t)(R >> 7) * 64 + lane) * 128 + swap23(R & 127)] = ab; }
        __syncthreads();
    }
}

__device__ __forceinline__ void dots4(const bf16_t* krow, const LAS float* qs, float (&s)[4]) {
    s[0] = s[1] = s[2] = s[3] = 0.f;
#pragma nounroll
    for (int c = 0; c < 8; ++c) { const u32x4 v = *((const u32x4*)krow + c);
        const float f[8] = {bf_lo(v.x), bf_hi(v.x), bf_lo(v.y), bf_hi(v.y), bf_lo(v.z), bf_hi(v.z), bf_lo(v.w), bf_hi(v.w)};
#pragma unroll
        for (int h = 0; h < 4; ++h) { const f32x4 q0 = *(const LAS f32x4*)(qs + h * 64 + c * 8), q1 = *(const LAS f32x4*)(qs + h * 64 + c * 8 + 4);
            s[h] += (f[0] * q0.x + f[1] * q0.y) + (f[2] * q0.z + f[3] * q0.w) + (f[4] * q1.x + f[5] * q1.y) + (f[6] * q1.z + f[7] * q1.w); } }
}
__device__ __forceinline__ void softmax_pv(LAS f32x4* sb, const LAS int* kb, int nk, const bf16_t* V, int lane, float (&o)[4]) {
    float m[4] = {-1e30f, -1e30f, -1e30f, -1e30f};
#pragma nounroll
    for (int c = 0; c < nk; ++c) { const f32x4 s = sb[c * 64 + lane]; m[0] = fmaxf(m[0], s.x); m[1] = fmaxf(m[1], s.y); m[2] = fmaxf(m[2], s.z); m[3] = fmaxf(m[3], s.w); }
#pragma unroll
    for (int h = 0; h < 4; ++h) m[h] = wave_max(m[h]);
    float sum[4] = {0.f, 0.f, 0.f, 0.f};
#pragma nounroll
    for (int c = 0; c < nk; ++c) { const f32x4 s = sb[c * 64 + lane]; f32x4 p;
        p.x = s.x > -1e29f ? __expf(s.x - m[0]) : 0.f; p.y = s.y > -1e29f ? __expf(s.y - m[1]) : 0.f; p.z = s.z > -1e29f ? __expf(s.z - m[2]) : 0.f; p.w = s.w > -1e29f ? __expf(s.w - m[3]) : 0.f;
        sum[0] += p.x; sum[1] += p.y; sum[2] += p.z; sum[3] += p.w; sb[c * 64 + lane] = p; }
    float inv[4];
#pragma unroll
    for (int h = 0; h < 4; ++h) inv[h] = rcpf_(fmaxf(wave_sum(sum[h]), 1e-30f));
    LDS_WAIT(); __builtin_amdgcn_wave_barrier(); asm volatile("" ::: "memory");
    o[0] = o[1] = o[2] = o[3] = 0.f;
#pragma nounroll
    for (int c = 0; c < nk; ++c) { const int k0 = kb[c];
#pragma unroll 4
        for (int kk = 0; kk < 64; ++kk) { int key = k0 + kk; key = key < 0 ? 0 : (key > SEQ - 1 ? SEQ - 1 : key);
            const f32x4 p = sb[c * 64 + kk]; const float v = bf2f(V[(size_t)key * 64 + lane]);
            o[0] += p.x * v; o[1] += p.y * v; o[2] += p.z * v; o[3] += p.w * v; } }
#pragma unroll
    for (int h = 0; h < 4; ++h) o[h] *= inv[h];
    __builtin_amdgcn_wave_barrier(); asm volatile("" ::: "memory");
}
__device__ __forceinline__ void phase_attn_ref(Frame& F, int layer) {
    const int lane = F.lane;
    LAS unsigned char* wl = F.lds + F.wave * 12288;
    LAS float* qs = (LAS float*)wl;
    LAS f32x4* pc = (LAS f32x4*)(wl + 1024);
    LAS float* psum = (LAS float*)(wl + 3072);
    LAS int* kbl = (LAS int*)(wl + 3584);
    LAS f32x4* sb = (LAS f32x4*)(wl + 4096);
    const bf16_t* QN = (const bf16_t*)(F.ws + WS_Q); const bf16_t* KVb = (const bf16_t*)(F.ws + WS_KV);
    const bf16_t* KC = (const bf16_t*)(F.ws + WS_KC); const bf16_t* VC = (const bf16_t*)(F.ws + WS_VC);
    const float* GT = (const float*)(F.ws + WS_GT); bf16_t* MIX = (bf16_t*)(F.ws + WS_MIX);
#pragma nounroll
    for (int un = F.c; un < NBH * 64; un += F.G) {
        const int bh = un >> 6, tile = un & 63, b = bh >> 1, kvh = bh & 1;
        const bf16_t* KS = KVb + 2 * KVT + (size_t)bh * SEQ * 64; const bf16_t* VS = KVb + 3 * KVT + (size_t)bh * SEQ * 64;
        const bf16_t* KW = KVb + 4 * KVT + (size_t)bh * SEQ * 64; const bf16_t* VW = KVb + 5 * KVT + (size_t)bh * SEQ * 64;
#pragma nounroll
        for (int ti = 0; ti < 4; ++ti) {
            const int t = tile * 32 + F.wave * 4 + ti, r = b * SEQ + t;
#pragma unroll
            for (int h = 0; h < 4; ++h) qs[h * 64 + lane] = bf2f(QN[(size_t)r * 512 + (kvh * 4 + h) * 64 + lane]);
            LDS_WAIT(); __builtin_amdgcn_wave_barrier(); asm volatile("" ::: "memory");
            float sc[2][4]; bool vc[2];
#pragma unroll
            for (int u = 0; u < 2; ++u) { const int c = lane + 64 * u; vc[u] = (c < NCMP) && (16 * c + 31 <= t);
                if (vc[u]) dots4(KC + ((size_t)bh * 128 + c) * 64, qs, sc[u]); else { sc[u][0] = sc[u][1] = sc[u][2] = sc[u][3] = -1e30f; } }
            float pr[2][4];
#pragma unroll
            for (int h = 0; h < 4; ++h) { const float mx = wave_max(fmaxf(sc[0][h], sc[1][h]));
                pr[0][h] = vc[0] ? __expf(sc[0][h] - mx) : 0.f; pr[1][h] = vc[1] ? __expf(sc[1][h] - mx) : 0.f;
                const float inv = rcpf_(fmaxf(wave_sum(pr[0][h] + pr[1][h]), 1e-30f)); pr[0][h] *= inv; pr[1][h] *= inv; }
#pragma unroll
            for (int u = 0; u < 2; ++u) { pc[lane + 64 * u] = (f32x4){pr[u][0], pr[u][1], pr[u][2], pr[u][3]}; psum[lane + 64 * u] = (pr[u][0] + pr[u][1]) + (pr[u][2] + pr[u][3]); }
            LDS_WAIT(); __builtin_amdgcn_wave_barrier(); asm volatile("" ::: "memory");
            const int j = lane & 31, cur = t >> 6; float imp = 0.f;
#pragma unroll
            for (int cc = -1; cc <= 3; ++cc) { const int c = 4 * j + cc; if (c >= 0 && c < NCMP) imp += psum[c]; }
            const bool causal = (j * 64 <= t), forced = (j == 0) || (j == cur) || (j == cur - 1);
            const float score = causal ? (forced ? imp + 1e4f : imp) : -1e30f;
            int rank = 0;
#pragma unroll
            for (int i = 0; i < 32; ++i) { const float si = __shfl(score, i); rank += (si > score || (si == score && i < j)) ? 1 : 0; }
            const unsigned selmask = (unsigned)__ballot(lane < 32 && rank < 8 && causal);
            float ocmp[4] = {0.f, 0.f, 0.f, 0.f};
            { const int nvc = t >= 31 ? (((t - 31) >> 4) + 1 > NCMP ? NCMP : ((t - 31) >> 4) + 1) : 0;
#pragma unroll 4
              for (int c = 0; c < nvc; ++c) { const f32x4 p = pc[c]; const float v = bf2f(VC[((size_t)bh * 128 + c) * 64 + lane]); ocmp[0] += p.x * v; ocmp[1] += p.y * v; ocmp[2] += p.z * v; ocmp[3] += p.w * v; } }
            __builtin_amdgcn_wave_barrier(); asm volatile("" ::: "memory");
            int nk = 0; float osel[4], owin[4];
#pragma nounroll
            for (unsigned mm = selmask; mm != 0u && nk < 8; mm &= mm - 1u) { const int jj = __builtin_ctz(mm);
                const int key = jj * 64 + lane; float s[4];
                if (key <= t) dots4(KS + (size_t)key * 64, qs, s); else { s[0] = s[1] = s[2] = s[3] = -1e30f; }
                sb[nk * 64 + lane] = (f32x4){s[0], s[1], s[2], s[3]};
                if (lane == 0) kbl[nk] = jj * 64;
                ++nk; }
            LDS_WAIT(); __builtin_amdgcn_wave_barrier(); asm volatile("" ::: "memory");
            softmax_pv(sb, kbl, nk, VS, lane, osel);
            nk = 0;
#pragma nounroll
            for (int ch = 0; ch < 8; ++ch) { const int k0 = t - 511 + 64 * ch; if (k0 + 63 < 0) continue;
                const int key = k0 + lane; float s[4];
                if (key >= 0) dots4(KW + (size_t)key * 64, qs, s); else { s[0] = s[1] = s[2] = s[3] = -1e30f; }
                sb[nk * 64 + lane] = (f32x4){s[0], s[1], s[2], s[3]};
                if (lane == 0) kbl[nk] = k0;
                ++nk; }
            LDS_WAIT(); __builtin_amdgcn_wave_barrier(); asm volatile("" ::: "memory");
            softmax_pv(sb, kbl, nk, VW, lane, owin);
#pragma unroll
            for (int h = 0; h < 4; ++h) { const float* gp = GT + (size_t)r * 24 + (kvh * 4 + h) * 3;
                const float o = sigmoidf_(gp[0]) * ocmp[h] + sigmoidf_(gp[1]) * osel[h] + sigmoidf_(gp[2]) * owin[h];
                MIX[(size_t)r * D + 512 + (kvh * 4 + h) * 64 + lane] = (bf16_t)(cvt_pk_bf16(o, 0.f) & 0xffffu); }
            __builtin_amdgcn_wave_barrier(); asm volatile("" ::: "memory");
        }
    }
}


constexpr int AT_KB = 0, AT_VB = 18432, AT_WUN = 36864, AT_OT = 40960;
__device__ __forceinline__ int crow_(int i) { return (i & 3) + 8 * (i >> 2); }
__device__ __forceinline__ float fmax_(float a, float b) { return __builtin_amdgcn_fmed3f(a, b, __builtin_inff()); }
template <int MODE>
__device__ __forceinline__ void attn_tile(const LAS unsigned char* KB, const LAS unsigned char* VB, const bf16x8 (&Qf)[4], f32x16 (&O)[2], float cref, float& l, int tl, int lo, bool rowok, int n, int h) {
    f32x16 S0, S1;
#pragma unroll
    for (int i = 0; i < 16; ++i) { S0[i] = 0.f; S1[i] = 0.f; }
#pragma unroll
    for (int s = 0; s < 4; ++s) { const bf16x8 k0 = *(const LAS bf16x8*)(KB + n * 144 + (16 * s + 8 * h) * 2), k1 = *(const LAS bf16x8*)(KB + (32 + n) * 144 + (16 * s + 8 * h) * 2);
        S0 = MFMA32(k0, Qf[s], S0); S1 = MFMA32(k1, Qf[s], S1); }
    if (MODE != 0) {
#pragma unroll
        for (int i = 0; i < 16; ++i) { const int c0 = crow_(i), c1 = 32 + crow_(i);
            if (MODE == 2) { S0[i] = (c0 <= tl && c0 > lo) ? S0[i] : -1e30f; S1[i] = (c1 <= tl && c1 > lo) ? S1[i] : -1e30f; } } }
    f32x2 ls2 = {0.f, 0.f}; const float crow = (MODE == 1) ? (rowok ? cref : 1e30f) : cref; const f32x2 mr2 = {crow, crow};
#pragma unroll
    for (int i = 0; i < 8; ++i) { f32x2 a = (f32x2){S0[2 * i], S0[2 * i + 1]} - mr2, b = (f32x2){S1[2 * i], S1[2 * i + 1]} - mr2;
        a.x = __builtin_amdgcn_exp2f(a.x); a.y = __builtin_amdgcn_exp2f(a.y); b.x = __builtin_amdgcn_exp2f(b.x); b.y = __builtin_amdgcn_exp2f(b.y);
        S0[2 * i] = a.x; S0[2 * i + 1] = a.y; S1[2 * i] = b.x; S1[2 * i + 1] = b.y; ls2 += a + b; }
    l += ls2.x + ls2.y;
    const bf16x8 P00 = pack8<0>(S0), P01 = pack8<8>(S0), P10 = pack8<0>(S1), P11 = pack8<8>(S1);
    __builtin_amdgcn_sched_barrier(0);
#pragma unroll
    for (int d = 0; d < 2; ++d) { const LAS unsigned char* vb = VB + (32 * d + n) * 144 + 8 * h * 2;
        O[d] = MFMA32(*(const LAS bf16x8*)(vb + 0), P00, O[d]); O[d] = MFMA32(*(const LAS bf16x8*)(vb + 32), P01, O[d]);
        O[d] = MFMA32(*(const LAS bf16x8*)(vb + 64), P10, O[d]); O[d] = MFMA32(*(const LAS bf16x8*)(vb + 96), P11, O[d]); }
}
__device__ __forceinline__ void attn_stage64(LAS unsigned char* lds, const bf16_t* K, const bf16_t* VT, int tid) {
    const int row = tid >> 3, ch = tid & 7;
    const u32x4 kv = *((const u32x4*)K + tid), vv = *(const u32x4*)(VT + (size_t)row * SEQ + ch * 8);
    *(LAS u32x4*)(lds + AT_KB + row * 144 + ch * 16) = kv; *(LAS u32x4*)(lds + AT_VB + row * 144 + ch * 16) = vv;
}
__device__ __forceinline__ void phase_attn_mfma(Frame& F, int layer) {
    const int lane = F.lane, tid = F.tid, n = lane & 31, h = lane >> 5, w = F.wave;
    LAS unsigned char* lds = F.lds; const LAS unsigned char* KB = lds + AT_KB; const LAS unsigned char* VB = lds + AT_VB; volatile LAS unsigned* WUN = (volatile LAS unsigned*)(lds + AT_WUN);
    const bf16_t* QN = (const bf16_t*)(F.ws + WS_Q); const bf16_t* KVb = (const bf16_t*)(F.ws + WS_KV);
    const bf16_t* KC = (const bf16_t*)(F.ws + WS_KC); const bf16_t* VCT = (const bf16_t*)(F.ws + WS_VCT);
    const bf16_t* VST = (const bf16_t*)(F.ws + WS_VST); const bf16_t* VWT = (const bf16_t*)(F.ws + WS_VWT);
    const float* GT = (const float*)(F.ws + WS_GT); bf16_t* MIX = (bf16_t*)(F.ws + WS_MIX);
    float cref;
    { const float gq = fabsf(INP_(I_QG)[layer * 64 + lane]); const float* kg = INP_(I_KG) + layer * 192;
      const float gk = fmaxf(fabsf(kg[lane]), fmaxf(fabsf(kg[64 + lane]), fabsf(kg[128 + lane])));
      const float bound = 1.44269504089f * 8.0f * wave_max(gq) * wave_max(gk); cref = fmaxf(bound - 16.0f, 0.f); }
#pragma nounroll
    for (int ui = 0; ui < 2; ++ui) {
        const int bh = (F.c >> 5) + 8 * ui, tb = ui ? 31 - (F.c & 31) : (F.c & 31);
        if (F.c >= 256) break;
        const int b = bh >> 1, kvh = bh & 1, t0 = tb * 64, cur = tb;
        const int tt = t0 + 8 * w + (n >> 2), hd = n & 3; const size_t r = (size_t)b * SEQ + tt;
        bf16x8 Qf[4]; { const bf16_t* qp = QN + r * 512 + (kvh * 4 + hd) * 64 + 8 * h;
#pragma unroll
            for (int s = 0; s < 4; ++s) Qf[s] = *(const bf16x8*)(qp + 16 * s); }
        {
            float qv[4][8]; float ss = 0.f;
#pragma unroll
            for (int s = 0; s < 4; ++s) { const u32x4 wq = __builtin_bit_cast(u32x4, Qf[s]);
                qv[s][0] = bf_lo(wq.x); qv[s][1] = bf_hi(wq.x); qv[s][2] = bf_lo(wq.y); qv[s][3] = bf_hi(wq.y); qv[s][4] = bf_lo(wq.z); qv[s][5] = bf_hi(wq.z); qv[s][6] = bf_lo(wq.w); qv[s][7] = bf_hi(wq.w);
#pragma unroll
                for (int j = 0; j < 8; ++j) ss += qv[s][j] * qv[s][j]; }
            ss += __shfl_xor(ss, 32);
            const float rsq = rsqf_(ss * (1.0f / 64.0f) + EPS) * (0.125f * 1.44269504089f); const float* qg     = INP_(I_QG) + layer * 64 + 8 * h;
#pragma unroll
            for (int s = 0; s < 4; ++s) { const f32x4 ga = *(const f32x4*)(qg + 16 * s), gb = *(const f32x4*)(qg + 16 * s + 4);
                u32x4 wq; wq.x = pk_bf16(qv[s][0] * rsq * ga.x, qv[s][1] * rsq * ga.y); wq.y = pk_bf16(qv[s][2] * rsq * ga.z, qv[s][3] * rsq * ga.w);
                wq.z = pk_bf16(qv[s][4] * rsq * gb.x, qv[s][5] * rsq * gb.y); wq.w = pk_bf16(qv[s][6] * rsq * gb.z, qv[s][7] * rsq * gb.w); Qf[s] = __builtin_bit_cast(bf16x8, wq); } }
        const float* gp = GT + r * 24 + (kvh * 4 + hd) * 3; const float g0 = sigmoidf_(gp[0]), g1 = sigmoidf_(gp[1]), g2 = sigmoidf_(gp[2]);
        f32x16 Ob[2]; LAS f32x4* OT = (LAS f32x4*)(lds + AT_OT + w * 8192) + lane;
        unsigned tokmask, wmask;
        __syncthreads();
#pragma unroll
        for (int q = 0; q < 2; ++q) { const int i = tid + 512 * q;
            *(LAS u32x4*)(lds + AT_KB + (i >> 3) * 144 + (i & 7) * 16) = *((const u32x4*)(KC + (size_t)bh * 128 * 64) + i);
            *(LAS u32x4*)(lds + AT_VB + (i >> 4) * 272 + (i & 15) * 16) = *((const u32x4*)(VCT + (size_t)bh * 64 * 128) + i); }
        __syncthreads();
        {
            f32x16 S[4];
#pragma unroll
            for (int ta = 0; ta < 4; ++ta) {
#pragma unroll
                for (int i = 0; i < 16; ++i) S[ta][i] = 0.f;
#pragma unroll
                for (int s = 0; s < 4; ++s) S[ta] = MFMA32(*(const LAS bf16x8*)(KB + (32 * ta + n) * 144 + (16 * s + 8 * h) * 2), Qf[s], S[ta]); }
            const int cmax = tt >= 31 ? (((tt - 31) >> 4) > 126 ? 126 : ((tt - 31) >> 4)) : -1, lim = cmax - 4 * h;
            float ls = 0.f;
#pragma unroll
            for (int ta = 0; ta < 4; ++ta)
#pragma unroll
                for (int i = 0; i < 16; ++i) { const float p = (32 * ta + crow_(i) <= lim) ? __builtin_amdgcn_exp2f(S[ta][i] - cref) : 0.f; S[ta][i] = p; ls += p; }
            ls += __shfl_xor(ls, 32);
            const float inv = rcpf_(fmaxf(ls, 1e-30f));
#pragma unroll
            for (int ta = 0; ta < 4; ++ta)
#pragma unroll
                for (int i = 0; i < 16; ++i) S[ta][i] *= inv;
            float val[4][4]; unsigned kk[4];
#pragma unroll
            for (int ta = 0; ta < 4; ++ta)
#pragma unroll
                for (int u = 0; u < 4; ++u) { val[ta][u] = (S[ta][4 * u] + S[ta][4 * u + 1]) + (S[ta][4 * u + 2] + S[ta][4 * u + 3]); }
            {   float xs[4][4];
#pragma unroll
                for (int ta = 0; ta < 4; ++ta)
#pragma unroll
                    for (int u = 0; u < 4; ++u) xs[ta][u] = __shfl_xor(S[ta][4 * u + 3], 32);
#pragma unroll
                for (int ta = 0; ta < 4; ++ta)
#pragma unroll
                    for (int u = 0; u < 4; ++u) { const float pv0 = (u > 0) ? xs[ta][u > 0 ? u - 1 : 0] : (ta > 0 ? xs[ta > 0 ? ta - 1 : 0][3] : 0.f); val[ta][u] += (h ? xs[ta][u] : pv0); } }
            const bf16x8 P0 = pack8<0>(S[0]), P1 = pack8<8>(S[0]), P2 = pack8<0>(S[1]), P3 = pack8<8>(S[1]), P4 = pack8<0>(S[2]), P5 = pack8<8>(S[2]), P6 = pack8<0>(S[3]), P7 = pack8<8>(S[3]);
            __builtin_amdgcn_sched_barrier(0);
            const bool b0 = (n & 1) != 0, b1 = (n & 2) != 0; const int hd2 = 2 * (n & 3) + h;
#define DPPF(x, ctrl) __builtin_bit_cast(float, __builtin_amdgcn_update_dpp(0, __builtin_bit_cast(int, (x)), (ctrl), 0xF, 0xF, true))
#define DPPU(x, ctrl) ((unsigned)__builtin_amdgcn_update_dpp(0, (int)(x), (ctrl), 0xF, 0xF, true))
#pragma unroll
            for (int ta = 0; ta < 4; ++ta) {
                const float m0 = b0 ? val[ta][1] : val[ta][0], s0 = b0 ? val[ta][0] : val[ta][1], m1 = b0 ? val[ta][3] : val[ta][2], s1 = b0 ? val[ta][2] : val[ta][3];
                const float r0 = m0 + DPPF(s0, 0xB1), r1 = m1 + DPPF(s1, 0xB1);
                const float mm = b1 ? r1 : r0, ss = b1 ? r0 : r1; const float v = mm + DPPF(ss, 0x4E);
                const int G = 8 * ta + hd2; const bool causal = G <= cur, forced = (G == 0) || (G == cur) || (G == cur - 1);
                kk[ta] = causal ? ((forced ? 0x7f000000u : (__float_as_uint(v) & ~31u)) | (unsigned)(31 - G)) : 0u; }
            __builtin_amdgcn_sched_barrier(0);
#pragma unroll
            for (int d = 0; d < 2; ++d) {
#pragma unroll
                for (int i = 0; i < 16; ++i) Ob[d][i] = 0.f;
                const LAS unsigned char* vb = VB + (32 * d + n) * 272 + 8 * h * 2;
                Ob[d] = MFMA32(*(const LAS bf16x8*)(vb + 0), P0, Ob[d]); Ob[d] = MFMA32(*(const LAS bf16x8*)(vb + 32), P1, Ob[d]);
                Ob[d] = MFMA32(*(const LAS bf16x8*)(vb + 64), P2, Ob[d]); Ob[d] = MFMA32(*(const LAS bf16x8*)(vb + 96), P3, Ob[d]);
                Ob[d] = MFMA32(*(const LAS bf16x8*)(vb + 128), P4, Ob[d]); Ob[d] = MFMA32(*(const LAS bf16x8*)(vb + 160), P5, Ob[d]);
                Ob[d] = MFMA32(*(const LAS bf16x8*)(vb + 192), P6, Ob[d]); Ob[d] = MFMA32(*(const LAS bf16x8*)(vb + 224), P7, Ob[d]);
#pragma unroll
                for (int q = 0; q < 4; ++q) OT[(4 * d + q) * 64] = (f32x4){Ob[d][4 * q] * g0, Ob[d][4 * q + 1] * g0, Ob[d][4 * q + 2] * g0, Ob[d][4 * q + 3] * g0}; }
            __builtin_amdgcn_sched_barrier(0);
            unsigned selbits = 0u;
#pragma unroll
            for (int rd = 0; rd < 8; ++rd) { unsigned mk = kk[0] > kk[1] ? kk[0] : kk[1]; { const unsigned m2 = kk[2] > kk[3] ? kk[2] : kk[3]; mk = m2 > mk ? m2 : mk; }
                { const unsigned o = DPPU(mk, 0xB1); mk = o > mk ? o : mk; } { const unsigned o = DPPU(mk, 0x4E); mk = o > mk ? o : mk; }
                { const unsigned o = (unsigned)__shfl_xor((int)mk, 32); mk = o > mk ? o : mk; }
#pragma unroll
                for (int ta = 0; ta < 4; ++ta) { const bool hit = (kk[ta] == mk) && (mk != 0u); selbits |= hit ? ((1u << (8 * ta)) << hd2) : 0u; kk[ta] = hit ? 0u : kk[ta]; } }
            selbits |= DPPU(selbits, 0xB1); selbits |= DPPU(selbits, 0x4E);
            tokmask = selbits | (unsigned)__shfl_xor((int)selbits, 32);
#undef DPPF
#undef DPPU
            unsigned wm = tokmask; wm |= (unsigned)__shfl_xor((int)wm, 4); wm |= (unsigned)__shfl_xor((int)wm, 8); wm |= (unsigned)__shfl_xor((int)wm, 16);
            wmask = (unsigned)__builtin_amdgcn_readfirstlane((int)wm);
            if (lane == 0) WUN[w] = wmask;
        }
        __syncthreads();
        unsigned uall = 0u;
#pragma unroll
        for (int q = 0; q < 8; ++q) uall |= WUN[q];
        uall = (unsigned)__builtin_amdgcn_readfirstlane((int)uall);
        if (PROBE_MASK & 0x6000000u) { if (lane == 0) ((unsigned*)(F.ws + WS_SLOT + 3 * MAXSLOT * 4))[(blockIdx.x * 2 + ui) * 8 + w] = (unsigned)__builtin_popcount(uall) | ((unsigned)__builtin_popcount(wmask) << 8); }
        float l = 0.f;
#pragma unroll
        for (int d = 0; d < 2; ++d)
#pragma unroll
            for (int i = 0; i < 16; ++i) Ob[d][i] = 0.f;
        const int j0 = cur > 8 ? cur - 8 : 0, nwin = cur - j0 + 1, ntile = nwin + __builtin_popcount(uall);
        const int srow = tid >> 3, sch = tid & 7;
        int lidx = 0, cidx = 0; unsigned lmm = uall, cmm = uall; u32x4 rk0, rv0, rk1, rv1, rk2, rv2;
#define AT_NEXT(idx, mm, wh, jj) do { if ((idx) < nwin) { (wh) = 1; (jj) = j0 + (idx); } else { (wh) = 0; (jj) = (mm) ? __builtin_ctz(mm) : 0; (mm) &= (mm) - 1u; } ++(idx); } while (0)
#define AT_LOAD(rk, rv) do { int _wh, _jj; AT_NEXT(lidx, lmm, _wh, _jj); const bf16_t* _kp = KVb + (size_t)(_wh ? 4 : 2) * KVT + ((size_t)bh * SEQ + _jj * 64) * 64; const bf16_t* _vp = (_wh ? VWT : VST) + (size_t)bh * 64 * SEQ + _jj * 64; \
        rk = *((const u32x4*)_kp + tid); rv = *(const u32x4*)(_vp + (size_t)srow * SEQ + sch * 8); } while (0)
#define AT_WRITE(b, rk, rv) do { *(LAS u32x4*)(lds + (b) * 18432 + srow * 144 + sch * 16) = rk; *(LAS u32x4*)(lds + (b) * 18432 + 9216 + srow * 144 + sch * 16) = rv; } while (0)
        AT_LOAD(rk0, rv0); AT_LOAD(rk1, rv1); AT_LOAD(rk2, rv2);
        AT_WRITE(0, rk0, rv0);
        AT_LOAD(rk0, rv0);
#define AT_STEP(i, RK, RV) do { asm volatile("s_waitcnt lgkmcnt(0)" ::: "memory"); __builtin_amdgcn_s_barrier(); asm volatile("" ::: "memory"); \
            AT_WRITE(((i) + 1) & 1, RK, RV); AT_LOAD(RK, RV); \
            int wh, j; AT_NEXT(cidx, cmm, wh, j); \
            if (i == nwin) { \
                const float lt = l + __shfl_xor(l, 32), sc = g2 * rcpf_(fmaxf(lt, 1e-30f)); \
_Pragma("unroll") \
                for (int d = 0; d < 2; ++d) \
_Pragma("unroll") \
                    for (int q = 0; q < 4; ++q) { f32x4 o = OT[(4 * d + q) * 64]; o.x += Ob[d][4 * q] * sc; o.y += Ob[d][4 * q + 1] * sc; o.z += Ob[d][4 * q + 2] * sc; o.w += Ob[d][4 * q + 3] * sc; OT[(4 * d + q) * 64] = o; \
                        Ob[d][4 * q] = 0.f; Ob[d][4 * q + 1] = 0.f; Ob[d][4 * q + 2] = 0.f; Ob[d][4 * q + 3] = 0.f; } \
                l = 0.f; } \
            const LAS unsigned char* kb = lds + (i & 1) * 18432; const LAS unsigned char* vb = kb + 9216; \
            const int tl = tt - 64 * j - 4 * h; \
            if (wh) { if (j == cur || j == cur - 8) attn_tile<2>(kb, vb, Qf, Ob, cref, l, tl, j == cur - 8 ? tl - 512 : -100000, true, n, h); else attn_tile<0>(kb, vb, Qf, Ob, cref, l, 0, 0, true, n, h); } \
            else if ((wmask >> j) & 1u) { const bool rowok = ((tokmask >> j) & 1u) != 0u; \
                if (j == cur) attn_tile<2>(kb, vb, Qf, Ob, cref, l, rowok ? tl : -1, -100000, true, n, h); else attn_tile<1>(kb, vb, Qf, Ob, cref, l, 0, 0, rowok, n, h); } \
        } while (0)
#pragma nounroll
        for (int i = 0; i < ntile; i += 3) { AT_STEP(i, rk1, rv1); if (i + 1 >= ntile) break; AT_STEP(i + 1, rk2, rv2); if (i + 2 >= ntile) break; AT_STEP(i + 2, rk0, rv0); }
#undef AT_STEP
#undef AT_NEXT
#undef AT_LOAD
#undef AT_WRITE
        { const float lt = l + __shfl_xor(l, 32), sc = g1 * rcpf_(fmaxf(lt, 1e-30f));
          bf16_t* op = MIX + r * D + 512 + (kvh * 4 + hd) * 64 + 4 * h;
#pragma unroll
          for (int d = 0; d < 2; ++d)
#pragma unroll
            for (int u = 0; u < 4; ++u) { const f32x4 o = OT[(4 * d + u) * 64]; u32x2 ov; ov.x = pk_bf16(o.x + Ob[d][4 * u] * sc, o.y + Ob[d][4 * u + 1] * sc); ov.y = pk_bf16(o.z + Ob[d][4 * u + 2] * sc, o.w + Ob[d][4 * u + 3] * sc);
                *(u32x2*)(op + 32 * d + 8 * u) = ov; } }
    }
}

__device__ __forceinline__ int build_ptab(Frame& F) {
    LAS int* ptab = (LAS int*)(F.lds + PTAB_OFF);
    const unsigned* cnt = (const unsigned*)(F.ws + WS_CTL) + CW_CNT;
    if (F.tid < 64) {
        const int e = F.tid; const unsigned c = (e < NE) ? __hip_atomic_load(cnt + 64 * e, __ATOMIC_RELAXED, __HIP_MEMORY_SCOPE_AGENT) : 0u;
        const int n = (int)((c + 255u) >> 8); int incl = n;
#pragma unroll
        for (int o = 1; o < 8; o <<= 1) { const int t = __shfl_up(incl, o); if (e >= o) incl += t; }
        const int excl = incl - n;
        if (e < NE) { ptab[MAXPAN + 8 + e] = excl * 256; for (int i = 0; i < n && excl + i < MAXPAN; ++i) ptab[excl + i] = e; }
        if (e == NE - 1) ptab[MAXPAN] = incl < MAXPAN ? incl : MAXPAN; }
    __syncthreads();
    return ptab[MAXPAN];
}

template <unsigned KM> __global__ void __launch_bounds__(NTHR, 2) fwd(Args args) {
    extern __shared__ __attribute__((aligned(16))) unsigned char lds_raw[];
    Frame F; F.lds = (LAS unsigned char*)lds_raw; F.tid = threadIdx.x; F.lane = F.tid & 63; F.wave = __builtin_amdgcn_readfirstlane(F.tid >> 6);
    F.G = gridDim.x; F.c = blockIdx.x; F.in = args.in; F.out = args.out; F.ws = args.ws;
    volatile LAS unsigned* MISC = (volatile LAS unsigned*)(F.lds + MISC_OFF);
    if (F.tid < 64) MISC[F.tid] = 0u;
    __syncthreads();
    unsigned* ctl = (unsigned*)(F.ws + WS_CTL);
#if MK_PER_PHASE
#define SEAM() do {} while (0)
#else
    XcdBarrier bar = xcd_barrier_post(ctl + CW_BAR, MISC);
#define SEAM() xcd_barrier(bar)
#endif
    const int lo = args.ph_lo, hi = args.ph_hi;
#define KON(kind) (((KM) >> (kind)) & 1u)
#define IN(k) (lo <= (k) && (k) < hi)
#define gw (F.c * NWAVES + F.wave)
#define NGW (F.G * NWAVES)
#define XB ((bf16_t*)(F.ws + WS_XB))
#define RS ((float*)(F.ws + WS_RSTD))

    if (KON(0) && IN(0)) { FRESH_TID(F); PMARK(0); phase_prologue(F); SEAM(); }

    for (int layer = 0; layer < 2; ++layer) {
        const int pb = 1 + 12 * layer;
        if (KON(1) && IN(pb + 0)) { FRESH_TID(F); PMARK(pb + 0);
            pg8::Gemm g{XB, (const bf16_t*)(F.ws + WS_WIN) + (size_t)layer * INP * D, D, D, D}; pg8::SchedGrid S; S.init(M / 256, INP / 256, F.G, F.c, D, D);
            EpiIn E{RS, (bf16_t*)(F.ws + WS_U), (bf16_t*)(F.ws + WS_Q), (bf16_t*)(F.ws + WS_KV), (float*)(F.ws + WS_GT), layer ? (const float*)(F.ws + WS_PSS) : nullptr, (LAS float*)(F.lds + RSL_OFF)};
            pg8::gemm_phase(F.lds, g, S, E); moe_conv_slot(F, layer == 0 ? 0 : 2); SEAM();
        }
        if (KON(2) && IN(pb + 1)) { FRESH_TID(F); PMARK(pb + 1);
            { pg8::Gemm g{(const bf16_t*)(F.ws + WS_KV), (const bf16_t*)(F.ws + WS_WC1), 256, 1024, 2048}; SchedCmp S{F.G, F.c, layer};
              EpiH1 E{(float*)(F.ws + WS_H1)}; pg8::gemm_phase(F.lds, g, S, E); }
            if (F.G >= 256) { if (F.c >= 128) vtrans_items(F, (F.c - 128) * NWAVES + F.wave, (F.G - 128) * NWAVES); }
            else vtrans_items(F, gw, NGW);
#ifdef ATTN_REF
            norm_rows64((bf16_t*)(F.ws + WS_Q), M * 8, INP_(I_QG) + layer * 64, 0.125f, gw, NGW, F.lane);
#endif
            norm_rows64((bf16_t*)(F.ws + WS_KV) + 2 * KVT, NBH * SEQ, INP_(I_KG) + layer * 192 + 64, 1.0f, gw, NGW, F.lane);
            norm_rows64((bf16_t*)(F.ws + WS_KV) + 4 * KVT, NBH * SEQ, INP_(I_KG) + layer * 192 + 128, 1.0f, gw, NGW, F.lane);
            SEAM();
        }
        if (KON(3) && IN(pb + 2)) { FRESH_TID(F); PMARK(pb + 2); for (int cu = F.c; cu < 512; cu += F.G) conv_unit(F, layer, cu); PMARK(30); phase_cmp2(F, layer); SEAM(); }
#ifndef ATTN_REF
        if (KON(4) && IN(pb + 3)) { FRESH_TID(F); PMARK(pb + 3); phase_attn_mfma(F, layer); SEAM(); }
#else
        if (KON(4) && IN(pb + 3)) { FRESH_TID(F); PMARK(pb + 3); phase_attn_ref(F, layer); SEAM(); }
#endif
        if (KON(5) && IN(pb + 4)) { FRESH_TID(F); PMARK(pb + 4);
            pg8::Gemm g{(const bf16_t*)(F.ws + WS_MIX), (const bf16_t*)(F.ws + WS_WOUT) + (size_t)layer * D * D, D, D, D}; pg8::SchedGrid S; S.init(M / 256, D / 256, F.G, F.c, D, D);
            { EpiRes<true> E{XB, XB, layer == 0 ? (float*)(F.ws + WS_PSS) : nullptr}; pg8::gemm_phase(F.lds, g, S, E); }
            SEAM();
        }
        if (KON(6) && IN(pb + 5) && layer == 1) { FRESH_TID(F); PMARK(pb + 5);
            f32x4 v[4];
            {
                const float* RT = (const float*)(F.ws + WS_RT); unsigned* cnt = ctl + CW_CNT; int* ROUTE = (int*)(F.ws + WS_ROUTE);
                int* stok = (int*)(F.ws + WS_SLOT);
                const int cb0 = __builtin_amdgcn_readfirstlane((int)blockIdx.x * NTHR);
#pragma nounroll
                for (int i = cb0 + F.tid; i < MAXSLOT; i += F.G * NTHR) stok[i] = -1;
                LAS f32x4* RTL = (LAS f32x4*)F.lds;
                { f32x4 sv[4];
#pragma unroll
                  for (int q = 0; q < 4; ++q) sv[q] = *((const f32x4*)RT + F.tid + q * NTHR);
#pragma unroll
                  for (int q = 0; q < 4; ++q) RTL[F.tid + q * NTHR] = sv[q]; }
                __syncthreads();
#pragma nounroll
                for (int mb0 = 0; mb0 < M; mb0 += 8 * NGW) { const int mb = mb0 + gw;
                    int me0 = -1, me1 = -1; float mw0 = 0.f, mw1 = 0.f;
#pragma nounroll
                    for (int i4 = 0; i4 < 8; i4 += 4) {
                        f32x4 xv[4][4];
#pragma unroll
                        for (int q = 0; q < 4; ++q) { const int m = mb + (i4 + q) * NGW; const u32x2* xr = (const u32x2*)(XB + (size_t)(m < M ? m : 0) * D) + F.lane;
#pragma unroll
                            for (int j = 0; j < 4; ++j) { const u32x2 wv = xr[64 * j]; xv[q][j] = (f32x4){bf_lo(wv.x), bf_hi(wv.x), bf_lo(wv.y), bf_hi(wv.y)}; } }
#pragma unroll
                        for (int q = 0; q < 4; ++q) { const int i = i4 + q, m = mb + i * NGW; if (m >= M) break;
                            f32x2e ss2 = {0.f, 0.f};
#pragma unroll
                            for (int j = 0; j < 4; ++j) { const f32x2e xl = LO2(xv[q][j]), xh = HI2(xv[q][j]); ss2 = __builtin_elementwise_fma(xl, xl, ss2); ss2 = __builtin_elementwise_fma(xh, xh, ss2); }
                            const float rs = rsqf_(wave_sum_u(ss2.x + ss2.y) * (1.0f / D) + EPS);
                            if (F.lane == 0) RS[m] = rs;
                            float lg[8];
#pragma unroll
                            for (int e = 0; e < 8; ++e) { f32x2e sd2 = {0.f, 0.f};
#pragma unroll
                                for (int j = 0; j < 4; ++j) { const f32x4 wv = RTL[e * 256 + 64 * j + F.lane]; sd2 = __builtin_elementwise_fma(LO2(xv[q][j]), LO2(wv), sd2); sd2 = __builtin_elementwise_fma(HI2(xv[q][j]), HI2(wv), sd2); }
                                lg[e] = wave_sum_u(sd2.x + sd2.y); }
                            int e0 = 0; float l0 = lg[0];
#pragma unroll
                            for (int e = 1; e < 8; ++e) if (lg[e] > l0) { l0 = lg[e]; e0 = e; }
                            int e1 = -1; float l1 = -3.0e38f;
#pragma unroll
                            for (int e = 0; e < 8; ++e) if (e != e0 && lg[e] > l1) { l1 = lg[e]; e1 = e; }
                            const float p1 = __expf((l1 - l0) * rs), w0 = rcpf_(1.0f + p1), w1 = p1 * w0;
                            if (F.lane == i) { me0 = e0; me1 = e1; mw0 = w0; mw1 = w1; } } }
                    int r0 = 0, r1 = 0, c_mine = 0; const unsigned long long low = (1ull << F.lane) - 1ull;
#pragma unroll
                    for (int e = 0; e < 8; ++e) { const unsigned long long b0 = __ballot(me0 == e), b1 = __ballot(me1 == e);
                        if (me0 == e) r0 = __popcll(b0 & low) + __popcll(b1 & low); if (me1 == e) r1 = __popcll(b0 & low) + __popcll(b1 & low);
                        if (F.lane == e) c_mine = __popcll(b0) + __popcll(b1); }
                    LAS int* WC = (LAS int*)(F.lds + 32768);
                    if (F.lane < 8) WC[F.wave * 8 + F.lane] = c_mine;
                    __syncthreads();
                    if (F.wave == 0 && F.lane < 8) { int tot = 0;
#pragma unroll
                        for (int ww = 0; ww < 8; ++ww) tot += WC[ww * 8 + F.lane];
                        WC[64 + F.lane] = tot > 0 ? (int)atomicAdd(cnt + 64 * F.lane, (unsigned)tot) : 0; }
                    __syncthreads();
                    int basev = 0;
                    if (F.lane < 8) { basev = WC[64 + F.lane];
#pragma unroll
                        for (int ww = 0; ww < 8; ++ww) basev += (ww < F.wave) ? WC[ww * 8 + F.lane] : 0; }
                    __syncthreads();
                    const int b0v = __shfl(basev, me0 < 0 ? 0 : me0), b1v = __shfl(basev, me1 < 0 ? 0 : me1);
                    if (me0 >= 0) { const int m = mb + F.lane * NGW; int* rp = ROUTE + (size_t)m * 6; rp[0] = me0; rp[1] = b0v + r0; rp[2] = me1; rp[3] = b1v + r1; rp[4] = __float_as_int(mw0); rp[5] = __float_as_int(mw1); }
                }
            }
            SEAM();
        }
        if (layer == 0) {
            if (KON(7) && IN(pb + 6)) { FRESH_TID(F); PMARK(pb + 6);
                pg8::Gemm g{XB, (const bf16_t*)(F.ws + WS_WF1), D, D, D}; pg8::SchedGrid S; S.init(M / 256, 2 * DFF / 256, F.G, F.c, D, D);
                EpiGlu E{RS, (bf16_t*)(F.ws + WS_ACT), DFF, 0, (const float*)(F.ws + WS_PSS), (LAS float*)(F.lds + RSL_OFF)}; pg8::gemm_phase(F.lds, g, S, E); moe_conv_slot(F, 1); SEAM();
            }
            if (KON(8) && IN(pb + 7)) { FRESH_TID(F); PMARK(pb + 7);
                pg8::Gemm g{(const bf16_t*)(F.ws + WS_ACT), (const bf16_t*)(F.ws + WS_WF2), DFF, DFF, DFF}; pg8::SchedGrid S; S.init(M / 256, D / 256, F.G, F.c, DFF, DFF);
                EpiRes<true> E{XB, XB, (float*)(F.ws + WS_PSS)}; pg8::gemm_phase(F.lds, g, S, E); SEAM();
            }
        } else {
            if (KON(10) && IN(pb + 6)) { FRESH_TID(F); PMARK(pb + 6);
                build_ptab(F); const LAS int* ptab = (const LAS int*)(F.lds + PTAB_OFF);
                const int* ROUTE = (const int*)(F.ws + WS_ROUTE); int* stok = (int*)(F.ws + WS_SLOT); float* sw = (float*)(stok + MAXSLOT); float* srs = sw + MAXSLOT; unsigned char* XS8 = F.ws + WS_XS;
#pragma nounroll
                for (int mb = gw; mb < M; mb += 4 * NGW) {
                    int rt[4][6]; u32x4 ra[4], rb[4];
#pragma unroll
                    for (int q = 0; q < 4; ++q) { const int m = mb + q * NGW < M ? mb + q * NGW : 0; const int* rp = ROUTE + (size_t)m * 6;
#pragma unroll
                        for (int z = 0; z < 6; ++z) rt[q][z] = rp[z];
                        const u32x4* src = (const u32x4*)(XB + (size_t)m * D) + F.lane; ra[q] = src[0]; rb[q] = src[64]; }
#pragma unroll
                    for (int q = 0; q < 4; ++q) { const int m = mb + q * NGW; if (m >= M) break;
#pragma unroll
                        for (int k = 0; k < 2; ++k) { const int e = rt[q][2 * k], pos = rt[q][2 * k + 1], slot = ptab[MAXPAN + 8 + e] + pos; unsigned char* drow = XS8 + (size_t)slot * D + 8 * F.lane;
                            *(u32x2*)drow = pk8_fp8(bf_lo(ra[q].x), bf_hi(ra[q].x), bf_lo(ra[q].y), bf_hi(ra[q].y), bf_lo(ra[q].z), bf_hi(ra[q].z), bf_lo(ra[q].w), bf_hi(ra[q].w));
                            *(u32x2*)(drow + 512) = pk8_fp8(bf_lo(rb[q].x), bf_hi(rb[q].x), bf_lo(rb[q].y), bf_hi(rb[q].y), bf_lo(rb[q].z), bf_hi(rb[q].z), bf_lo(rb[q].w), bf_hi(rb[q].w));
                            if (F.lane == 0) { stok[slot] = m * 2 + k; sw[slot] = __int_as_float(rt[q][4 + k]); srs[slot] = RS[m]; } } } }
                SEAM();
            }
            if (KON(11) && IN(pb + 7)) { FRESH_TID(F); PMARK(pb + 7);
                const int npan = build_ptab(F); const MoePlan P = moe_plan(npan, F.G);
                const int* stok = (const int*)(F.ws + WS_SLOT); const float* srs = (const float*)(stok + 2 * MAXSLOT);
                pg8::Gemm8 g{F.ws + WS_XS, F.ws + WS_WM1, D, D, D}; SchedMoe1R S{F.G, F.c, 0, P.N1, 1 << 20, 0, (const LAS int*)(F.lds + PTAB_OFF)};
                EpiGlu8 E{srs, F.ws + WS_ACTM, DFE, 1.0f / MOE_S1};
                pg8::gemm_phase8(F.lds, g, S, E); SEAM();
            }
            if (KON(12) && IN(pb + 8)) { FRESH_TID(F); PMARK(pb + 8);
                const int npan = build_ptab(F); const MoePlan P = moe_plan(npan, F.G);
                const int* stok = (const int*)(F.ws + WS_SLOT); const float* sw = (const float*)(stok + MAXSLOT); const float* srs = (const float*)(stok + 2 * MAXSLOT);
                { pg8::Gemm8 g{F.ws + WS_ACTM, F.ws + WS_WM2, DFE, DFE, DFE}; SchedMoe2R S{F.G, F.c, 0, P.PA, (const LAS int*)(F.lds + PTAB_OFF)};
                  EpiMoe2 E{stok, sw, (bf16_t*)(F.ws + WS_Y0), (bf16_t*)(F.ws + WS_Y1), 0, 1.0f / MOE_S2}; pg8::gemm_phase8(F.lds, g, S, E); }
                if (P.N1 < P.nup) { pg8::Gemm8 g{F.ws + WS_XS, F.ws + WS_WM1, D, D, D}; SchedMoe1R S{F.G, F.c, P.N1, P.nup, P.qa, P.n2, (const LAS int*)(F.lds + PTAB_OFF)};
                  EpiGlu8 E{srs, F.ws + WS_ACTM, DFE, 1.0f / MOE_S1}; pg8::gemm_phase8(F.lds, g, S, E); }
                SEAM();
            }
            if (KON(12) && IN(pb + 9)) { FRESH_TID(F); PMARK(pb + 9);
                const int npan = build_ptab(F); const MoePlan P = moe_plan(npan, F.G);
                const int* stok = (const int*)(F.ws + WS_SLOT); const float* sw = (const float*)(stok + MAXSLOT);
                if (P.PA < npan) { pg8::Gemm8 g{F.ws + WS_ACTM, F.ws + WS_WM2, DFE, DFE, DFE}; SchedMoe2R S{F.G, F.c, P.PA, npan - P.PA, (const LAS int*)(F.lds + PTAB_OFF)};
                  EpiMoe2 E{stok, sw, (bf16_t*)(F.ws + WS_Y0), (bf16_t*)(F.ws + WS_Y1), 0, 1.0f / MOE_S2}; pg8::gemm_phase8(F.lds, g, S, E); }
                SEAM();
            }
            if (KON(13) && IN(pb + 11)) { FRESH_TID(F); PMARK(pb + 11);
                const bf16_t* Y0 = (const bf16_t*)(F.ws + WS_Y0); const bf16_t* Y1 = (const bf16_t*)(F.ws + WS_Y1);
#pragma nounroll
                for (int mb = gw; mb < M; mb += 2 * NGW) { f32x4 x[2][4]; u32x2 ya[2][4], yb[2][4];
#pragma unroll
                    for (int q = 0; q < 2; ++q) { const int m = mb + q * NGW < M ? mb + q * NGW : 0; const u32x2* xr = (const u32x2*)(XB + (size_t)m * D) + F.lane; const u32x2* y0 = (const u32x2*)(Y0 + (size_t)m * D) + F.lane; const u32x2* y1 = (const u32x2*)(Y1 + (size_t)m * D) + F.lane;
#pragma unroll
                        for (int j = 0; j < 4; ++j) { const u32x2 wv = xr[64 * j]; x[q][j] = (f32x4){bf_lo(wv.x), bf_hi(wv.x), bf_lo(wv.y), bf_hi(wv.y)}; ya[q][j] = y0[64 * j]; yb[q][j] = y1[64 * j]; } }
#pragma unroll
                    for (int q = 0; q < 2; ++q) { const int m = mb + q * NGW; if (m >= M) break; f32x4* xr = (f32x4*)(F.out + (size_t)m * D) + F.lane;
#pragma unroll
                        for (int j = 0; j < 4; ++j) { f32x4 o = x[q][j]; const u32x2 a = ya[q][j], b2 = yb[q][j];
                            o.x += bf_lo(a.x) + bf_lo(b2.x); o.y += bf_hi(a.x) + bf_hi(b2.x); o.z += bf_lo(a.y) + bf_lo(b2.y); o.w += bf_hi(a.y) + bf_hi(b2.y); xr[64 * j] = o; } } }
            }
        }
    }
#undef gw
#undef NGW
#undef XB
#undef RS
    PMARK(99);
    if ((PROBE_MASK & 0x6000000u) && blockIdx.x == 0 && threadIdx.x == 0) { const unsigned* st = (const unsigned*)(F.ws + WS_SLOT + 3 * MAXSLOT * 4); unsigned long long tot = 0; for (int i = 0; i < 512 * 8; ++i) { const unsigned v = st[i]; tot += (PROBE_MASK & 0x2000000u) ? (v & 255u) : (v >> 8); }
        *(volatile LAS unsigned long long*)(F.lds + MISC_OFF + 160) += tot * 25ull / 4096ull * 10ull; }
    if (PROBE_MASK != 0u && blockIdx.x == 0 && threadIdx.x == 0) { const unsigned long long acc = *(volatile LAS unsigned long long*)(F.lds + MISC_OFF + 160), t1 = __builtin_amdgcn_s_memrealtime() + 4ull * acc; while (__builtin_amdgcn_s_memrealtime() < t1) __builtin_amdgcn_s_sleep(8); }
#undef IN
}

constexpr int NPHASE = 25;
template <unsigned KM> static bool setup_kernel(int& per_cu) {
    if (hipFuncSetAttribute((const void*)fwd<KM>, hipFuncAttributeMaxDynamicSharedMemorySize, LDS_BYTES) != hipSuccess) return false;
    if (hipOccupancyMaxActiveBlocksPerMultiprocessor(&per_cu, (const void*)fwd<KM>, NTHR, LDS_BYTES) != hipSuccess) per_cu = 0;
    (void)hipGetLastError(); return true;
}
template <unsigned KM> static void launch_kind(int grid, const Args& a, hipStream_t stream) { hipLaunchKernelGGL(fwd<KM>, dim3(grid), dim3(NTHR), LDS_BYTES, stream, a); }
extern "C" void kernel_launch(void* const* d_in, const int* in_sizes, int n_in, void* d_out, int out_size, void* d_ws, size_t ws_size, hipStream_t stream) {
    static int grid = 0;
    if (grid == 0) {
        if (n_in != 28 || in_sizes[0] != M * D || out_size != M * D || ws_size < WS_END) { fprintf(stderr, "kernel_launch: unexpected shapes / workspace (n_in %d, ws %zu, need %zu)\n", n_in, ws_size, (size_t)WS_END); grid = -1; return; }
        int dev = 0, cus = 0, per_cu = 0; bool ok = true;
        if (hipGetDevice(&dev) != hipSuccess || hipDeviceGetAttribute(&cus, hipDeviceAttributeMultiprocessorCount, dev) != hipSuccess) { grid = -1; return; }
#if MK_PER_PHASE
        ok = ok && setup_kernel<1u << 0>(per_cu) && setup_kernel<1u << 1>(per_cu) && setup_kernel<1u << 2>(per_cu) && setup_kernel<1u << 3>(per_cu) && setup_kernel<1u << 4>(per_cu) && setup_kernel<1u << 5>(per_cu) && setup_kernel<1u << 6>(per_cu)
             && setup_kernel<1u << 7>(per_cu) && setup_kernel<1u << 8>(per_cu) && setup_kernel<1u << 9>(per_cu) && setup_kernel<1u << 10>(per_cu) && setup_kernel<1u << 11>(per_cu) && setup_kernel<1u << 12>(per_cu) && setup_kernel<1u << 13>(per_cu);
#else
        ok = ok && setup_kernel<0xffffffffu>(per_cu);
#endif
        if (!ok) { fprintf(stderr, "kernel_launch: hipFuncSetAttribute failed\n"); grid = -1; return; }
        if (per_cu < 1) fprintf(stderr, "kernel_launch: occupancy query says %d\n", per_cu);
        grid = cus;
    }
    if (grid < 0) return;
    (void)hipMemsetAsync((char*)d_ws + WS_CTL, 0, CTL_BYTES, stream);
    Args a{};
    for (int i = 0; i < 28; ++i) a.in[i] = (const float*)d_in[i];
    a.out = (float*)d_out; a.ws = (unsigned char*)d_ws;
#if MK_PER_PHASE
    static const int phases[] = {0, 1, 2, 3, 4, 5, 7, 8, 13, 14, 15, 16, 17, 18, 19, 20, 21, 24};
    static const int kinds[]  = {0, 1, 2, 3, 4, 5, 7, 8,  1,  2,  3,  4,  5,  6, 10, 11, 12, 13};
    for (int i = 0; i < (int)(sizeof(phases) / sizeof(int)); ++i) { a.ph_lo = phases[i]; a.ph_hi = phases[i] + 1;
        switch (kinds[i]) {
            case 0: launch_kind<1u << 0>(grid, a, stream); break; case 1: launch_kind<1u << 1>(grid, a, stream); break; case 2: launch_kind<1u << 2>(grid, a, stream); break;
            case 3: launch_kind<1u << 3>(grid, a, stream); break; case 4: launch_kind<1u << 4>(grid, a, stream); break; case 5: launch_kind<1u << 5>(grid, a, stream); break;
            case 6: launch_kind<1u << 6>(grid, a, stream); break; case 7: launch_kind<1u << 7>(grid, a, stream); break; case 8: launch_kind<1u << 8>(grid, a, stream); break;
            case 9: launch_kind<1u << 9>(grid, a, stream); break; case 10: launch_kind<1u << 10>(grid, a, stream); break; case 11: launch_kind<1u << 11>(grid, a, stream); break;
            case 12: launch_kind<1u << 12>(grid, a, stream); break; default: launch_kind<1u << 13>(grid, a, stream); break; } }
#else
    a.ph_lo = 0; a.ph_hi = NPHASE; launch_kind<0xffffffffu>(grid, a, stream);
#endif
}
```

```cpp
#include <hip/hip_runtime.h>
#include <cstdio>
#include <cstdint>

#ifndef MK_PER_PHASE
#define MK_PER_PHASE 0
#endif

#ifndef PROBE_MASK
#define PROBE_MASK 0u
#endif
#define LAS __attribute__((address_space(3)))
typedef unsigned short bf16_t;
typedef short bf16x8 __attribute__((ext_vector_type(8)));
typedef float f32x4 __attribute__((ext_vector_type(4)));
typedef float f32x2 __attribute__((ext_vector_type(2)));
typedef unsigned u32x4 __attribute__((ext_vector_type(4)));
typedef unsigned u32x2 __attribute__((ext_vector_type(2)));

constexpr int D = 1024, NB = 8, SEQ = 2048, M = NB * SEQ;
constexpr int INW = 2328, INP = 2560;
constexpr int CW = 512, CKW = 31, DH = 64, NKV = 2, NBH = NB * NKV;
constexpr int NCMP = 127, CHID = 256;
constexpr int DFF = 2816, NE = 8, DFE = 3584;
constexpr int MAXPAN = 136, MAXSLOT = MAXPAN * 256, CHUNKP = 72;
constexpr float EPS = 1e-6f;

constexpr size_t MiB = 1u << 20;
constexpr size_t WS_CTL = 0, CTL_BYTES = 2 * MiB;
constexpr size_t WS_H1 = 342 * MiB;
constexpr size_t WS_WIN = 12 * MiB;
constexpr size_t WS_WC1 = 22 * MiB;
constexpr size_t WS_WOUT = 26 * MiB;
constexpr size_t WS_WF1 = 30 * MiB;
constexpr size_t WS_WF2 = 41 * MiB;
constexpr size_t WS_RT = 47 * MiB;
constexpr size_t WS_WM1 = 48 * MiB;
constexpr size_t WS_WM2 = 160 * MiB;
constexpr size_t WS_XB = 216 * MiB;
constexpr size_t WS_RSTD = 248 * MiB;
constexpr size_t WS_GT = WS_RSTD + 65536;
constexpr size_t WS_ROUTE = WS_GT + (size_t)M * 24 * 4;
constexpr size_t WS_PSS = 250 * MiB;
constexpr size_t WS_KC = 251 * MiB;
constexpr size_t WS_VC = WS_KC + 262144;
constexpr size_t WS_VCT = WS_KC + 524288;
constexpr size_t WS_VST = 2 * MiB, WS_VWT = 6 * MiB;
constexpr size_t WS_U = 252 * MiB;
constexpr size_t WS_Q = 268 * MiB;
constexpr size_t WS_KV = 284 * MiB;
constexpr size_t KVT = (size_t)NBH * SEQ * DH;
constexpr size_t WS_MIX = 310 * MiB;
constexpr size_t WS_ACT = 342 * MiB;
constexpr size_t WS_XS = 252 * MiB;
constexpr size_t WS_ACTM = 320 * MiB;
constexpr size_t WS_SLOT = 447 * MiB;
constexpr size_t WS_Y0 = 288 * MiB, WS_Y1 = 12 * MiB;
constexpr size_t WS_END = 448 * MiB;
constexpr int CW_BAR = 4096;
constexpr int CW_CNT = 8192;
constexpr int CW_B1P = 16384;

__device__ __forceinline__ unsigned cvt_pk_bf16(float lo, float hi) { unsigned r; asm volatile("v_cvt_pk_bf16_f32 %0, %1, %2" : "=v"(r) : "v"(lo), "v"(hi)); return r; }
__device__ __forceinline__ float bf_lo(unsigned v) { return __uint_as_float(v << 16); }
__device__ __forceinline__ float bf_hi(unsigned v) { return __uint_as_float(v & 0xffff0000u); }
__device__ __forceinline__ float bf2f(bf16_t v) { return __uint_as_float((unsigned)v << 16); }
__device__ __forceinline__ float rcpf_(float x) { return __builtin_amdgcn_rcpf(x); }
__device__ __forceinline__ float rsqf_(float x) { return __builtin_amdgcn_rsqf(x); }
__device__ __forceinline__ float sigmoidf_(float x) { return rcpf_(1.0f + __expf(-x)); }
__device__ __forceinline__ float siluf_(float x) { return x * sigmoidf_(x); }
typedef float f32x2e __attribute__((ext_vector_type(2)));
__device__ __forceinline__ f32x2e glu2_(f32x2e g, f32x2e u, f32x2e nrs, f32x2e rs2) {
    f32x2e e = g * nrs; e.x = __builtin_amdgcn_exp2f(e.x); e.y = __builtin_amdgcn_exp2f(e.y);
    f32x2e d = e + (f32x2e){1.0f, 1.0f}; d.x = __builtin_amdgcn_rcpf(d.x); d.y = __builtin_amdgcn_rcpf(d.y);
    return ((g * u) * rs2) * d; }
__device__ __forceinline__ f32x2e glus2_(f32x2e v, f32x2e g, f32x2e nrs, f32x2e rs1) {
    f32x2e e = g * nrs; e.x = __builtin_amdgcn_exp2f(e.x); e.y = __builtin_amdgcn_exp2f(e.y);
    f32x2e d = e + (f32x2e){1.0f, 1.0f}; d.x = __builtin_amdgcn_rcpf(d.x); d.y = __builtin_amdgcn_rcpf(d.y);
    return (v * rs1) * d; }
#define LO2(v) ((f32x2e){(v)[0], (v)[1]})
#define HI2(v) ((f32x2e){(v)[2], (v)[3]})
__device__ __forceinline__ float wave_sum(float v) {
#pragma unroll
    for (int o = 1; o < 64; o <<= 1) v += __shfl_xor(v, o);
    return v;
}
#define DPP_ADD(v, ctrl) ((v) + __builtin_bit_cast(float, __builtin_amdgcn_update_dpp(0, __builtin_bit_cast(int, (v)), (ctrl), 0xF, 0xF, true)))
__device__ __forceinline__ float wave_sum_u(float v) {
    v = DPP_ADD(v, 0xB1); v = DPP_ADD(v, 0x4E); v = DPP_ADD(v, 0x124); v = DPP_ADD(v, 0x128);
    const int b = __builtin_bit_cast(int, v);
    return (__builtin_bit_cast(float, __builtin_amdgcn_readlane(b, 0)) + __builtin_bit_cast(float, __builtin_amdgcn_readlane(b, 16))) + (__builtin_bit_cast(float, __builtin_amdgcn_readlane(b, 32)) + __builtin_bit_cast(float, __builtin_amdgcn_readlane(b, 48)));
}
typedef unsigned u32x2s __attribute__((ext_vector_type(2)));
__device__ __forceinline__ float xsum32(float v) { const unsigned b = __float_as_uint(v); const auto r = __builtin_amdgcn_permlane32_swap(b, b, false, false); return __uint_as_float(r[0]) + __uint_as_float(r[1]); }
__device__ __forceinline__ unsigned xmax32u(unsigned v) { const auto r = __builtin_amdgcn_permlane32_swap(v, v, false, false); return r[0] > r[1] ? r[0] : r[1]; }
__device__ __forceinline__ unsigned xor32u(unsigned v) { const auto r = __builtin_amdgcn_permlane32_swap(v, v, false, false); return r[0] | r[1]; }
__device__ __forceinline__ float xget32(float v, int h) { const unsigned b = __float_as_uint(v); const auto r = __builtin_amdgcn_permlane32_swap(b, b, false, false); return __uint_as_float(h ? r[0] : r[1]); }
__device__ __forceinline__ float wave_max(float v) {
#pragma unroll
    for (int o = 1; o < 64; o <<= 1) v = fmaxf(v, __shfl_xor(v, o));
    return v;
}
#define LDS_WAIT() asm volatile("s_waitcnt lgkmcnt(0)" ::: "memory")
typedef float f32x16 __attribute__((ext_vector_type(16)));
typedef __bf16 bf16v2 __attribute__((ext_vector_type(2)));
#define MFMA32(a, b, c) __builtin_amdgcn_mfma_f32_32x32x16_bf16((a), (b), (c), 0, 0, 0)
__device__ __forceinline__ unsigned pk_bf16(float lo, float hi) { const f32x2 v = {lo, hi}; return __builtin_bit_cast(unsigned, __builtin_convertvector(v, bf16v2)); }
template <int S8> __device__ __forceinline__ bf16x8 pack8(const f32x16& p) { u32x4 w; w.x = pk_bf16(p[S8], p[S8 + 1]); w.y = pk_bf16(p[S8 + 2], p[S8 + 3]); w.z = pk_bf16(p[S8 + 4], p[S8 + 5]); w.w = pk_bf16(p[S8 + 6], p[S8 + 7]); return __builtin_bit_cast(bf16x8, w); }
__device__ __forceinline__ u32x2 pk8_fp8(float a0, float a1, float a2, float a3, float a4, float a5, float a6, float a7) {
    int w0 = 0, w1 = 0; w0 = __builtin_amdgcn_cvt_pk_fp8_f32(a0, a1, w0, false); w0 = __builtin_amdgcn_cvt_pk_fp8_f32(a2, a3, w0, true);
    w1 = __builtin_amdgcn_cvt_pk_fp8_f32(a4, a5, w1, false); w1 = __builtin_amdgcn_cvt_pk_fp8_f32(a6, a7, w1, true); return (u32x2){(unsigned)w0, (unsigned)w1}; }
__device__ __forceinline__ int swap23(int v) { return (v & ~12) | ((v & 4) << 1) | ((v & 8) >> 1); }

namespace pg8 {
constexpr int BM = 256, BK = 64, HALF = 128, HTB = HALF * BK * 2, STAGE_BYTES = 8 * HTB, NXCD = 8, WGM = 8;
__device__ __forceinline__ int lds_byte(int r, int c) { const int st = (r >> 4) * 2 + (c >> 5), rr = r & 15, cc = c & 31, ob = rr * 64 + cc * 2; return st * 1024 + (ob ^ (((ob >> 9) & 1) << 5)); }
__device__ __forceinline__ void stage_rc(int b, int& R, int& C) { const int st = b / 1024, sb = b % 1024, swz = sb ^ (((sb >> 9) & 1) << 5); R = (st >> 1) * 16 + swz / 64; C = (st & 1) * 32 + (swz % 64) / 2; }
__device__ __forceinline__ int perm32(int rho) { const int n = rho >> 4, i = rho & 15; return 8 * (i >> 2) + 4 * n + (i & 3); }

struct Unit { int pm, pn; size_t aoff, boff; };
struct Gemm { const bf16_t* A; const bf16_t* Bt; int K, lda, ldb; };

struct SchedGrid {
    int nM, nN, nwg, G, c; size_t astr, bstr;
    __device__ __forceinline__ void init(int nM_, int nN_, int G_, int c_, int lda, int ldb) { nM = nM_; nN = nN_; nwg = nM * nN; G = G_; c = c_; astr = (size_t)BM * lda * 2; bstr = (size_t)BM * ldb * 2; }
    __device__ __forceinline__ bool next(int i, Unit& u) const {
        const long L = (long)i * G + c; if (L >= nwg) return false;
        int wgid = (int)L; { const int q = nwg / NXCD, r = nwg % NXCD, xcd = wgid % NXCD, off = wgid / NXCD; wgid = (xcd < r ? xcd * (q + 1) : r * (q + 1) + (xcd - r) * q) + off; }
        const int nig = WGM * nN, gid = wgid / nig, fm = gid * WGM, gsz = (nM - fm) < WGM ? (nM - fm) : WGM;
        u.pm = fm + ((wgid % nig) % gsz); u.pn = (wgid % nig) / gsz; u.aoff = (size_t)u.pm * astr; u.boff = (size_t)u.pn * bstr; return true;
    }
};

template <class Epi, class Sched>
__device__ __forceinline__ void gemm_phase(LAS unsigned char* lds, const Gemm g, const Sched& S, const Epi& E) {
    int tid = threadIdx.x; asm volatile("" : "+v"(tid));
    const int wid = __builtin_amdgcn_readfirstlane(tid >> 6), lane = tid & 63, wr = wid >> 2, wc = wid & 3, fr = lane & 15, fq = lane >> 4;
    const int K = g.K, nt = K / BK;
    unsigned voffA[2], voffB[2];
#pragma unroll
    for (int i = 0; i < 2; ++i) { int R, C; stage_rc(tid * 16 + i * 8192, R, C); const int Rb = Epi::PERM ? ((R & ~31) + perm32(R & 31)) : R;
        voffA[i] = (unsigned)(R * g.lda + C) * 2u; voffB[i] = (unsigned)(Rb * g.ldb + C) * 2u; }
    const size_t kstep = (size_t)(BK * 2);
    const size_t hstepA = (size_t)HALF * g.lda * 2, hstepB = (size_t)HALF * g.ldb * 2;
    const unsigned ldsw = (unsigned)wid * 1024u;
    const int aoff = lds_byte(wr * 64 + fr, fq * 8), boff = lds_byte(wc * 32 + fr, fq * 8);
#define PG8_SA(b, h) (((b) * 2 + (h)) * HTB)
#define PG8_SB(b, h) ((4 + (b) * 2 + (h)) * HTB)
#define PG8_STAGE(bufoff, gbase, voff) do { _Pragma("unroll") for (int _i = 0; _i < 2; ++_i) \
        __builtin_amdgcn_global_load_lds((const unsigned*)((const char*)(gbase) + (voff)[_i]), (LAS unsigned*)(lds + (bufoff) + ldsw + _i * 8192), 16, 0, 0); } while (0)
#define PG8_LDA(dst, b, h) do { _Pragma("unroll") for (int m = 0; m < 4; ++m) _Pragma("unroll") for (int k = 0; k < 2; ++k) dst[m][k] = *(const LAS bf16x8*)(lds + PG8_SA(b, h) + aoff + m * 2048 + k * 1024); } while (0)
#define PG8_LDB(dst, b, h) do { _Pragma("unroll") for (int n = 0; n < 2; ++n) _Pragma("unroll") for (int k = 0; k < 2; ++k) dst[n][k] = *(const LAS bf16x8*)(lds + PG8_SB(b, h) + boff + n * 2048 + k * 1024); } while (0)
#define PG8_MMA(ai, bj, At, Bt) do { __builtin_amdgcn_s_setprio(1); _Pragma("unroll") for (int m = 0; m < 4; ++m) _Pragma("unroll") for (int n = 0; n < 2; ++n) _Pragma("unroll") for (int k = 0; k < 2; ++k) \
        acc[ai][bj][m][n] = __builtin_amdgcn_mfma_f32_16x16x32_bf16(Bt[n][k], At[m][k], acc[ai][bj][m][n], 0, 0, 0); __builtin_amdgcn_s_setprio(0); } while (0)
#define PG8_WAIT_V(n) asm volatile("s_waitcnt vmcnt(" #n ")" ::: "memory")
#define PG8_WAIT_L(n) asm volatile("s_waitcnt lgkmcnt(" #n ")" ::: "memory")
#define PG8_BAR __builtin_amdgcn_s_barrier()
#define PG8_SCHED __builtin_amdgcn_sched_barrier(0)
    Unit cur, nxt; int ui = 0;
    if (!S.next(0, cur)) return;
    f32x4 acc[2][2][4][2];
#pragma unroll
    for (int a = 0; a < 2; ++a)
#pragma unroll
        for (int b = 0; b < 2; ++b)
#pragma unroll
            for (int m = 0; m < 4; ++m)
#pragma unroll
                for (int n = 0; n < 2; ++n) acc[a][b][m][n] = (f32x4){0.f, 0.f, 0.f, 0.f};
    bf16x8 At[4][2], B0[2][2], B1[2][2];
    const char* cA = (const char*)g.A + cur.aoff; const char* cB = (const char*)g.Bt + cur.boff;
    typename Epi::Pre pre; E.prefetch(cur, wr, fr, pre);
    PG8_STAGE(PG8_SB(0, 0), cB, voffB); PG8_STAGE(PG8_SA(0, 0), cA, voffA); PG8_STAGE(PG8_SB(0, 1), cB + hstepB, voffB); PG8_STAGE(PG8_SA(0, 1), cA + hstepA, voffA);
    if (wr == 1) PG8_BAR;
    PG8_WAIT_V(4); PG8_BAR;
    PG8_STAGE(PG8_SB(1, 0), cB + kstep, voffB); PG8_STAGE(PG8_SA(1, 0), cA + kstep, voffA); PG8_STAGE(PG8_SB(1, 1), cB + hstepB + kstep, voffB);
    PG8_WAIT_V(6); PG8_BAR;
    for (;;) {
        const bool has_next = S.next(ui + 1, nxt);
        const char* nA = has_next ? (const char*)g.A + nxt.aoff : cA; const char* nB = has_next ? (const char*)g.Bt + nxt.boff : cB;
#pragma nounroll
        for (int t = 0; t < nt; t += 2) {
            const bool last = (t == nt - 2);
            const char* a1 = cA + (size_t)(t + 1) * kstep;
            const char* a2 = last ? nA : cA + (size_t)(t + 2) * kstep; const char* b2 = last ? nB : cB + (size_t)(t + 2) * kstep;
            const char* a3 = a2 + kstep; const char* b3 = b2 + kstep;
            PG8_LDB(B0, 0, 0); PG8_SCHED; PG8_LDA(At, 0, 0); PG8_STAGE(PG8_SA(1, 1), a1 + hstepA, voffA);
            PG8_WAIT_L(8); PG8_BAR; PG8_WAIT_L(0); PG8_MMA(0, 0, At, B0); PG8_BAR; PG8_SCHED;
            PG8_LDB(B1, 0, 1); PG8_STAGE(PG8_SB(0, 0), b2, voffB);
            PG8_BAR; PG8_WAIT_L(0); PG8_MMA(0, 1, At, B1); PG8_BAR;
            PG8_LDA(At, 0, 1); PG8_STAGE(PG8_SA(0, 0), a2, voffA);
            PG8_BAR; PG8_WAIT_L(0); PG8_MMA(1, 0, At, B0); PG8_BAR; PG8_SCHED;
            PG8_STAGE(PG8_SB(0, 1), b2 + hstepB, voffB);
            PG8_WAIT_V(6); PG8_BAR; PG8_MMA(1, 1, At, B1); PG8_BAR;
            PG8_LDB(B0, 1, 0); PG8_SCHED; PG8_LDA(At, 1, 0); PG8_STAGE(PG8_SA(0, 1), a2 + hstepA, voffA);
            PG8_WAIT_L(8); PG8_BAR; PG8_WAIT_L(0); PG8_MMA(0, 0, At, B0); PG8_BAR; PG8_SCHED;
            PG8_LDB(B1, 1, 1); PG8_STAGE(PG8_SB(1, 0), b3, voffB);
            PG8_BAR; PG8_WAIT_L(0); PG8_MMA(0, 1, At, B1); PG8_BAR;
            PG8_LDA(At, 1, 1); PG8_STAGE(PG8_SA(1, 0), a3, voffA);
            PG8_BAR; PG8_WAIT_L(0); PG8_MMA(1, 0, At, B0); PG8_BAR; PG8_SCHED;
            PG8_STAGE(PG8_SB(1, 1), b3 + hstepB, voffB);
            PG8_WAIT_V(6); PG8_BAR; PG8_MMA(1, 1, At, B1); PG8_BAR;
        }
        E(acc, cur, wr, wc, fr, fq, pre);
        if (!has_next) break;
        E.prefetch(nxt, wr, fr, pre);
#pragma unroll
        for (int a = 0; a < 2; ++a)
#pragma unroll
            for (int b = 0; b < 2; ++b)
#pragma unroll
                for (int m = 0; m < 4; ++m)
#pragma unroll
                    for (int n = 0; n < 2; ++n) acc[a][b][m][n] = (f32x4){0.f, 0.f, 0.f, 0.f};
        cur = nxt; cA = nA; cB = nB; ++ui;
    }
    PG8_WAIT_V(0);
    if (wr == 0) PG8_BAR;
    PG8_BAR;
#undef PG8_SA
#undef PG8_SB
#undef PG8_STAGE
#undef PG8_LDA
#undef PG8_LDB
#undef PG8_MMA
#undef PG8_WAIT_V
#undef PG8_WAIT_L
#undef PG8_BAR
#undef PG8_SCHED
}
struct Gemm8 { const unsigned char* A; const unsigned char* Bt; int K, lda, ldb; };
typedef int i32x4 __attribute__((ext_vector_type(4)));
typedef int i32x8 __attribute__((ext_vector_type(8)));
template <class Epi, class Sched>
__device__ __forceinline__ void gemm_phase8(LAS unsigned char* lds, const Gemm8 g, const Sched& S, const Epi& E) {
    int tid = threadIdx.x; asm volatile("" : "+v"(tid));
    const int wid = __builtin_amdgcn_readfirstlane(tid >> 6), lane = tid & 63, wr = wid >> 2, wc = wid & 3, fr = lane & 15, fq = lane >> 4;
    const int nt = g.K / 128;
    unsigned voffA[2], voffB[2];
#pragma unroll
    for (int i = 0; i < 2; ++i) { int R, C; stage_rc(tid * 16 + i * 8192, R, C); const int Rb = Epi::PERM ? ((R & ~31) + perm32(R & 31)) : R;
        voffA[i] = (unsigned)(R * g.lda + C * 2); voffB[i] = (unsigned)(Rb * g.ldb + C * 2); }
    const size_t kstep = (size_t)(BK * 2);
    const size_t hstepA = (size_t)HALF * g.lda, hstepB = (size_t)HALF * g.ldb;
    const unsigned ldsw = (unsigned)wid * 1024u;
    const int aoff = lds_byte(wr * 64 + fr, fq * 8), boff = lds_byte(wc * 32 + fr, fq * 8);
#define PG8_SA(b, h) (((b) * 2 + (h)) * HTB)
#define PG8_SB(b, h) ((4 + (b) * 2 + (h)) * HTB)
#define PG8_STAGE(bufoff, gbase, voff) do { _Pragma("unroll") for (int _i = 0; _i < 2; ++_i) \
        __builtin_amdgcn_global_load_lds((const unsigned*)((const char*)(gbase) + (voff)[_i]), (LAS unsigned*)(lds + (bufoff) + ldsw + _i * 8192), 16, 0, 0); } while (0)
#define PG8_LDA(dst, b, h) do { _Pragma("unroll") for (int m = 0; m < 4; ++m) { const i32x4 _l = *(const LAS i32x4*)(lds + PG8_SA(b, h) + aoff + m * 2048), _h = *(const LAS i32x4*)(lds + PG8_SA(b, h) + aoff + m * 2048 + 1024); dst[m] = __builtin_shufflevector(_l, _h, 0, 1, 2, 3, 4, 5, 6, 7); } } while (0)
#define PG8_LDB(dst, b, h) do { _Pragma("unroll") for (int n = 0; n < 2; ++n) { const i32x4 _l = *(const LAS i32x4*)(lds + PG8_SB(b, h) + boff + n * 2048), _h = *(const LAS i32x4*)(lds + PG8_SB(b, h) + boff + n * 2048 + 1024); dst[n] = __builtin_shufflevector(_l, _h, 0, 1, 2, 3, 4, 5, 6, 7); } } while (0)
#define PG8_MMA(ai, bj, At, Bt) do { __builtin_amdgcn_s_setprio(1); _Pragma("unroll") for (int m = 0; m < 4; ++m) _Pragma("unroll") for (int n = 0; n < 2; ++n) \
        asm volatile("v_mfma_f32_16x16x128_f8f6f4 %0, %1, %2, %0" : "+v"(acc[ai][bj][m][n]) : "v"(Bt[n]), "v"(At[m])); __builtin_amdgcn_s_setprio(0); } while (0)
#define PG8_WAIT_V(n) asm volatile("s_waitcnt vmcnt(" #n ")" ::: "memory")
#define PG8_WAIT_L(n) asm volatile("s_waitcnt lgkmcnt(" #n ")" ::: "memory")
#define PG8_BAR __builtin_amdgcn_s_barrier()
#define PG8_SCHED __builtin_amdgcn_sched_barrier(0)
    Unit cur, nxt; int ui = 0;
    if (!S.next(0, cur)) return;
    f32x4 acc[2][2][4][2];
#pragma unroll
    for (int a = 0; a < 2; ++a)
#pragma unroll
        for (int b = 0; b < 2; ++b)
#pragma unroll
            for (int m = 0; m < 4; ++m)
#pragma unroll
                for (int n = 0; n < 2; ++n) acc[a][b][m][n] = (f32x4){0.f, 0.f, 0.f, 0.f};
    i32x8 At[4], B0[2], B1[2];
    const char* cA = (const char*)g.A + cur.aoff; const char* cB = (const char*)g.Bt + cur.boff;
    typename Epi::Pre pre; E.prefetch(cur, wr, fr, pre);
    PG8_STAGE(PG8_SB(0, 0), cB, voffB); PG8_STAGE(PG8_SA(0, 0), cA, voffA); PG8_STAGE(PG8_SB(0, 1), cB + hstepB, voffB); PG8_STAGE(PG8_SA(0, 1), cA + hstepA, voffA);
    if (wr == 1) PG8_BAR;
    PG8_WAIT_V(4); PG8_BAR;
    PG8_STAGE(PG8_SB(1, 0), cB + kstep, voffB); PG8_STAGE(PG8_SA(1, 0), cA + kstep, voffA); PG8_STAGE(PG8_SB(1, 1), cB + hstepB + kstep, voffB);
    PG8_WAIT_V(6); PG8_BAR;
    for (;;) {
        const bool has_next = S.next(ui + 1, nxt);
        const char* nA = has_next ? (const char*)g.A + nxt.aoff : cA; const char* nB = has_next ? (const char*)g.Bt + nxt.boff : cB;
#pragma nounroll
        for (int t = 0; t < nt; t += 2) {
            const bool last = (t == nt - 2);
            const char* a1 = cA + (size_t)(t + 1) * kstep;
            const char* a2 = last ? nA : cA + (size_t)(t + 2) * kstep; const char* b2 = last ? nB : cB + (size_t)(t + 2) * kstep;
            const char* a3 = a2 + kstep; const char* b3 = b2 + kstep;
            PG8_LDB(B0, 0, 0); PG8_SCHED; PG8_LDA(At, 0, 0); PG8_STAGE(PG8_SA(1, 1), a1 + hstepA, voffA);
            PG8_WAIT_L(8); PG8_BAR; PG8_WAIT_L(0); PG8_MMA(0, 0, At, B0); PG8_BAR; PG8_SCHED;
            PG8_LDB(B1, 0, 1); PG8_STAGE(PG8_SB(0, 0), b2, voffB);
            PG8_BAR; PG8_WAIT_L(0); PG8_MMA(0, 1, At, B1); PG8_BAR;
            PG8_LDA(At, 0, 1); PG8_STAGE(PG8_SA(0, 0), a2, voffA);
            PG8_BAR; PG8_WAIT_L(0); PG8_MMA(1, 0, At, B0); PG8_BAR; PG8_SCHED;
            PG8_STAGE(PG8_SB(0, 1), b2 + hstepB, voffB);
            PG8_WAIT_V(6); PG8_BAR; PG8_MMA(1, 1, At, B1); PG8_BAR;
            PG8_LDB(B0, 1, 0); PG8_SCHED; PG8_LDA(At, 1, 0); PG8_STAGE(PG8_SA(0, 1), a2 + hstepA, voffA);
            PG8_WAIT_L(8); PG8_BAR; PG8_WAIT_L(0); PG8_MMA(0, 0, At, B0); PG8_BAR; PG8_SCHED;
            PG8_LDB(B1, 1, 1); PG8_STAGE(PG8_SB(1, 0), b3, voffB);
            PG8_BAR; PG8_WAIT_L(0); PG8_MMA(0, 1, At, B1); PG8_BAR;
            PG8_LDA(At, 1, 1); PG8_STAGE(PG8_SA(1, 0), a3, voffA);
            PG8_BAR; PG8_WAIT_L(0); PG8_MMA(1, 0, At, B0); PG8_BAR; PG8_SCHED;
            PG8_STAGE(PG8_SB(1, 1), b3 + hstepB, voffB);
            PG8_WAIT_V(6); PG8_BAR; PG8_MMA(1, 1, At, B1); PG8_BAR;
        }
        E(acc, cur, wr, wc, fr, fq, pre);
        if (!has_next) break;
        E.prefetch(nxt, wr, fr, pre);
#pragma unroll
        for (int a = 0; a < 2; ++a)
#pragma unroll
            for (int b = 0; b < 2; ++b)
#pragma unroll
                for (int m = 0; m < 4; ++m)
#pragma unroll
                    for (int n = 0; n < 2; ++n) acc[a][b][m][n] = (f32x4){0.f, 0.f, 0.f, 0.f};
        cur = nxt; cA = nA; cB = nB; ++ui;
    }
    PG8_WAIT_V(0);
    if (wr == 0) PG8_BAR;
    PG8_BAR;
#undef PG8_SA
#undef PG8_SB
#undef PG8_STAGE
#undef PG8_LDA
#undef PG8_LDB
#undef PG8_MMA
#undef PG8_WAIT_V
#undef PG8_WAIT_L
#undef PG8_BAR
#undef PG8_SCHED
}
}
using pg8::Unit;

#define XB_TMO      128
#define XB_XCNT(j)  (256  + 64 * (j))
#define XB_XSUB(j)  (1280 + 64 * (j))
#define XB_XGEN(j)  (2304 + 64 * (j))
#define XB_TOP      3328
#define XB_TOPGEN   3392
#define XCD_BAR_WORDS 3456
#define XB_SPIN_CAP (1u << 18)
__device__ __forceinline__ unsigned xb_ld(unsigned* p)              { return __hip_atomic_load(p, __ATOMIC_RELAXED, __HIP_MEMORY_SCOPE_AGENT); }
__device__ __forceinline__ unsigned xb_add(unsigned* p, unsigned v) { return __hip_atomic_fetch_add(p, v, __ATOMIC_RELAXED, __HIP_MEMORY_SCOPE_AGENT); }
__device__ __forceinline__ unsigned xb_xcc_id() { return (unsigned)__builtin_amdgcn_s_getreg((3 << 11) | 20) & 0xFu; }
#define XB_SPIN(cond, bar) do { unsigned _sp = 0; while (cond) { __builtin_amdgcn_s_sleep(1); \
    if ((++_sp & 255u) == 0u) { if (xb_ld(&(bar)[XB_TMO])) break; if (_sp > XB_SPIN_CAP) { atomicAdd(&(bar)[XB_TMO], 1u); break; } } } } while (0)
struct XcdBarrier { unsigned* bar; unsigned x; volatile LAS unsigned* st; };
__device__ __forceinline__ XcdBarrier xcd_barrier_post(unsigned* bar, volatile LAS unsigned* st) {
    XcdBarrier b; b.bar = bar; b.x = xb_xcc_id(); b.st = st;
    if (threadIdx.x == 0) (void)xb_add(&bar[XB_XCNT(b.x)], 1u);
    return b;
}
__device__ __forceinline__ void xcd_barrier_complete(unsigned* bar, unsigned x, unsigned& nloc, unsigned& nx) {
    const unsigned G = gridDim.x * gridDim.y * gridDim.z;
    unsigned sum, cnt, mine, sp = 0u;
    for (;;) {
        sum = 0u; cnt = 0u; mine = 0u;
#pragma unroll
        for (unsigned j = 0; j < 16; ++j) { const unsigned c = xb_ld(&bar[XB_XCNT(j)]); sum += c; cnt += (c > 0u) ? 1u : 0u; mine = (j == x) ? c : mine; }
        if (sum == G) break;
        __builtin_amdgcn_s_sleep(1);
        if ((++sp & 255u) == 0u) { if (xb_ld(&bar[XB_TMO])) break; if (sp > XB_SPIN_CAP) { atomicAdd(&bar[XB_TMO], 1u); break; } }
    }
    nloc = mine > 0u ? mine : 1u; nx = cnt > 0u ? cnt : 1u;
}
__device__ __forceinline__ void xcd_barrier(const XcdBarrier& b) {
    asm volatile("s_waitcnt vmcnt(0)" ::: "memory");
    __syncthreads();
    if (threadIdx.x == 0) {
        unsigned* bar = b.bar;
        __builtin_amdgcn_s_waitcnt(0);
        unsigned nloc = b.st[0], nx = b.st[1];
        if (nloc == 0u) { xcd_barrier_complete(bar, b.x, nloc, nx); b.st[0] = nloc; b.st[1] = nx; }
        const unsigned old = xb_add(&bar[XB_XSUB(b.x)], 1u);
        const unsigned gen = old / nloc;
        if (old + 1u == (gen + 1u) * nloc) {
            __builtin_amdgcn_fence(__ATOMIC_RELEASE, "agent");
            asm volatile("s_waitcnt vmcnt(0)" ::: "memory");
            const unsigned og = xb_add(&bar[XB_TOP], 1u);
            const unsigned tg = og / nx;
            if (og + 1u == (tg + 1u) * nx) xb_add(&bar[XB_TOPGEN], 1u);
            else XB_SPIN(xb_ld(&bar[XB_TOPGEN]) == tg, bar);
            __builtin_amdgcn_fence(__ATOMIC_ACQUIRE, "agent");
            xb_add(&bar[XB_XGEN(b.x)], 1u);
            asm volatile("s_waitcnt vmcnt(0)" ::: "memory");
        } else {
            XB_SPIN(xb_ld(&bar[XB_XGEN(b.x)]) == gen, bar);
            __builtin_amdgcn_fence(__ATOMIC_ACQUIRE, "agent");
            asm volatile("s_waitcnt vmcnt(0)" ::: "memory");
        }
    }
    __syncthreads();
}

constexpr int NWAVES = 8, NTHR = 512;
constexpr int LDS_BYTES = 147456;
constexpr int MISC_OFF = 131072;
constexpr int PTAB_OFF = MISC_OFF + 512;

struct Args { const float* in[28]; float* out; unsigned char* ws; int ph_lo, ph_hi; };

struct Frame {
    LAS unsigned char* lds; int tid, lane, wave, G, c;
    const float* const* in; float* out; unsigned char* ws;
};
#define INP_(i) (F.in[i])
#define FRESH_TID(F) do { int _t = threadIdx.x; asm volatile("" : "+v"(_t)); (F).tid = _t; (F).lane = _t & 63; \
    __attribute__((address_space(1))) unsigned char* _w = (__attribute__((address_space(1))) unsigned char*)args.ws; __attribute__((address_space(1))) float* _o = (__attribute__((address_space(1))) float*)args.out; \
    int _g = gridDim.x; asm volatile("" : "+s"(_w), "+s"(_o), "+s"(_g)); (F).ws = (unsigned char*)_w; (F).out = (float*)_o; (F).G = _g; } while (0)
enum { I_X = 0, I_ANG, I_WIN, I_CDW, I_CDB, I_CLG, I_CLB, I_QG, I_KG, I_PK, I_PV, I_KW1, I_KB1, I_KW2, I_KB2, I_VW1, I_VB1, I_VW2, I_VB2, I_WOUT, I_FNG, I_DW1, I_DW3, I_DW2, I_RW, I_MW1, I_MW3, I_MW2 };

#define PMARK(id) do { if (PROBE_MASK != 0u && blockIdx.x == 0 && threadIdx.x == 0) { volatile LAS unsigned long long* _a = (volatile LAS unsigned long long*)(F.lds + MISC_OFF + 160); volatile LAS unsigned* _o = (volatile LAS unsigned*)(F.lds + MISC_OFF + 168); \
    const unsigned long long _t = __builtin_amdgcn_s_memrealtime(); if (*_o) { *_a += _t; *_o = 0u; } if ((id) < 32 && ((PROBE_MASK >> (id)) & 1u)) { *_a -= _t; *_o = 1u; } } } while (0)
constexpr int RSL_OFF = MISC_OFF + 2048;
__device__ __forceinline__ void rstd_from_partials(const float* pss, int pm, LAS float* tab) {
    int t = threadIdx.x; asm volatile("" : "+v"(t));
    const int row = t >> 1, hf = t & 1;
    const f32x4 a = *(const f32x4*)(pss + (size_t)(pm * 256 + row) * 16 + hf * 8), b = *(const f32x4*)(pss + (size_t)(pm * 256 + row) * 16 + hf * 8 + 4);
    float sq = ((a.x + a.y) + (a.z + a.w)) + ((b.x + b.y) + (b.z + b.w)); sq += __shfl_xor(sq, 1);
    if (hf == 0) tab[row] = rsqf_(sq * (1.0f / D) + EPS);
}
struct EpiIn {
    static constexpr bool PERM = true;
    const float* rstd; bf16_t* U; bf16_t* Q; bf16_t* KV; float* GT; const float* pss; LAS float* rsl;
    struct Pre { int par = 1; };
    __device__ __forceinline__ void prefetch(const Unit& u, int wr, int fr, Pre& p) const {
        p.par ^= 1; LAS float* tab = rsl + p.par * 256;
        if (pss) rstd_from_partials(pss, u.pm, tab); else { int t = threadIdx.x; asm volatile("" : "+v"(t)); if (t < 256) tab[t] = rstd[u.pm * 256 + t]; } }
    __device__ __forceinline__ void operator()(const f32x4 (&acc)[2][2][4][2], const Unit& u, int wr, int wc, int fr, int fq, const Pre& pre) const {
        const int row0 = u.pm * 256 + wr * 64 + fr, cl = wc * 32 + 8 * fq;
        if (u.pn < 4) {
#pragma unroll
            for (int ai = 0; ai < 2; ++ai)
#pragma unroll
                for (int m = 0; m < 4; ++m) { const int r = row0 + ai * 128 + m * 16; const float rs = rsl[pre.par * 256 + wr * 64 + fr + ai * 128 + m * 16];
                    const f32x4 v0 = acc[ai][0][m][0], v1 = acc[ai][0][m][1], g0 = acc[ai][1][m][0], g1 = acc[ai][1][m][1];
                    const float nr = rs * -1.44269504089f; const f32x2e nrs = {nr, nr}, rs1 = {rs, rs};
                    const f32x2e o0 = glus2_(LO2(v0), LO2(g0), nrs, rs1), o1 = glus2_(HI2(v0), HI2(g0), nrs, rs1), o2 = glus2_(LO2(v1), LO2(g1), nrs, rs1), o3 = glus2_(HI2(v1), HI2(g1), nrs, rs1);
                    u32x4 w; w.x = cvt_pk_bf16(o0.x, o0.y); w.y = cvt_pk_bf16(o1.x, o1.y); w.z = cvt_pk_bf16(o2.x, o2.y); w.w = cvt_pk_bf16(o3.x, o3.y);
                    *(u32x4*)(U + (size_t)r * CW + u.pn * 128 + cl) = w; asm volatile("" ::: "memory"); }
        } else if (u.pn < 6) {
#pragma unroll
            for (int ai = 0; ai < 2; ++ai)
#pragma unroll
                for (int m = 0; m < 4; ++m) { const int r = row0 + ai * 128 + m * 16; const float rs = rsl[pre.par * 256 + wr * 64 + fr + ai * 128 + m * 16];
#pragma unroll
                    for (int bj = 0; bj < 2; ++bj) { const f32x4 v0 = acc[ai][bj][m][0] * rs, v1 = acc[ai][bj][m][1] * rs;
                        u32x4 w; w.x = cvt_pk_bf16(v0[0], v0[1]); w.y = cvt_pk_bf16(v0[2], v0[3]); w.z = cvt_pk_bf16(v1[0], v1[1]); w.w = cvt_pk_bf16(v1[2], v1[3]);
                        *(u32x4*)(Q + (size_t)r * 512 + (u.pn - 4) * 256 + bj * 128 + cl) = w; } asm volatile("" ::: "memory"); }
        } else if (u.pn < 9) {
            const int h = wc >> 1, d0 = 32 * (wc & 1) + 8 * fq;
#pragma unroll
            for (int ai = 0; ai < 2; ++ai)
#pragma unroll
                for (int m = 0; m < 4; ++m) { const int r = row0 + ai * 128 + m * 16; const float rs = rsl[pre.par * 256 + wr * 64 + fr + ai * 128 + m * 16]; const int b = r >> 11, t = r & 2047;
#pragma unroll
                    for (int bj = 0; bj < 2; ++bj) { const int tq = 2 * (u.pn - 6) + bj; const f32x4 v0 = acc[ai][bj][m][0] * rs, v1 = acc[ai][bj][m][1] * rs;
                        u32x4 w; w.x = cvt_pk_bf16(v0[0], v0[1]); w.y = cvt_pk_bf16(v0[2], v0[3]); w.z = cvt_pk_bf16(v1[0], v1[1]); w.w = cvt_pk_bf16(v1[2], v1[3]);
                        *(u32x4*)(KV + (size_t)tq * KVT + ((size_t)(b * 2 + h) * SEQ + t) * DH + d0) = w; } asm volatile("" ::: "memory"); }
        } else {
            if (wc == 0 && fq < 3) {
#pragma unroll
                for (int ai = 0; ai < 2; ++ai)
#pragma unroll
                    for (int m = 0; m < 4; ++m) { const int r = row0 + ai * 128 + m * 16; const float rs = rsl[pre.par * 256 + wr * 64 + fr + ai * 128 + m * 16];
                        *(f32x4*)(GT + (size_t)r * 24 + 8 * fq) = acc[ai][0][m][0] * rs; *(f32x4*)(GT + (size_t)r * 24 + 8 * fq + 4) = acc[ai][0][m][1] * rs; }
            }
        }
    }
};
struct EpiH1 {
    static constexpr bool PERM = false;
    float* H;
    struct Pre {}; __device__ __forceinline__ void prefetch(const Unit&, int, int, Pre&) const {}
    __device__ __forceinline__ void operator()(const f32x4 (&acc)[2][2][4][2], const Unit& u, int wr, int wc, int fr, int fq, const Pre&) const {
        const int row0 = u.pm * 256 + wr * 64 + fr, col0 = wc * 32 + 4 * fq; const int kv = u.pn >> 3, sp = u.pn & 7;
#pragma unroll
        for (int ai = 0; ai < 2; ++ai)
#pragma unroll
            for (int m = 0; m < 4; ++m) { float* rowp = H + (((size_t)sp * 2 + kv) * 2048 + row0 + ai * 128 + m * 16) * 256 + col0;
#pragma unroll
                for (int bj = 0; bj < 2; ++bj)
#pragma unroll
                    for (int n = 0; n < 2; ++n) *(f32x4*)(rowp + bj * 128 + n * 16) = acc[ai][bj][m][n]; }
    }
};
template <bool BF> struct EpiRes {
    static constexpr bool PERM = false;
    const void* base; bf16_t* xb; float* pss;
    struct Pre {}; __device__ __forceinline__ void prefetch(const Unit&, int, int, Pre&) const {}
    __device__ __forceinline__ void operator()(const f32x4 (&acc)[2][2][4][2], const Unit& u, int wr, int wc, int fr, int fq, const Pre&) const {
        const int row0 = u.pm * 256 + wr * 64 + fr, col0 = u.pn * 256 + wc * 32 + 4 * fq;
#pragma unroll
        for (int ai = 0; ai < 2; ++ai) {
            f32x4 bs[4][2][2];
#pragma unroll
            for (int m = 0; m < 4; ++m) { const size_t off = (size_t)(row0 + ai * 128 + m * 16) * D + col0;
#pragma unroll
                for (int bj = 0; bj < 2; ++bj)
#pragma unroll
                    for (int n = 0; n < 2; ++n) {
                        if (BF) { const u32x2 w = *(const u32x2*)((const bf16_t*)base + off + bj * 128 + n * 16); bs[m][bj][n] = (f32x4){bf_lo(w.x), bf_hi(w.x), bf_lo(w.y), bf_hi(w.y)}; }
                        else bs[m][bj][n] = *(const f32x4*)((const float*)base + off + bj * 128 + n * 16); } }
#pragma unroll
            for (int m = 0; m < 4; ++m) { const size_t off = (size_t)(row0 + ai * 128 + m * 16) * D + col0; float ss = 0.f;
#pragma unroll
                for (int bj = 0; bj < 2; ++bj)
#pragma unroll
                    for (int n = 0; n < 2; ++n) { const f32x4 v = bs[m][bj][n] + acc[ai][bj][m][n];
                        u32x2 w; w.x = cvt_pk_bf16(v[0], v[1]); w.y = cvt_pk_bf16(v[2], v[3]); *(u32x2*)(xb + off + bj * 128 + n * 16) = w; ss += (v[0] * v[0] + v[1] * v[1]) + (v[2] * v[2] + v[3] * v[3]); }
                if (pss) { ss += __shfl_xor(ss, 16); ss += __shfl_xor(ss, 32);
                    if (fq == 0) pss[(size_t)(row0 + ai * 128 + m * 16) * 16 + u.pn * 4 + wc] = ss; } } }
    }
};
struct EpiGlu {
    static constexpr bool PERM = true;
    const float* rstd; bf16_t* O; int ldo; int rowbase;
    const float* pss; LAS float* rsl;
    struct Pre { int par = 1; };
    __device__ __forceinline__ void prefetch(const Unit& u, int wr, int fr, Pre& p) const { p.par ^= 1; rstd_from_partials(pss, u.pm, rsl + p.par * 256); }
    __device__ __forceinline__ void operator()(const f32x4 (&acc)[2][2][4][2], const Unit& u, int wr, int wc, int fr, int fq, const Pre& pre) const {
        const int row0 = u.pm * 256 + wr * 64 + fr, cl = u.pn * 128 + wc * 32 + 8 * fq;
#pragma unroll
        for (int ai = 0; ai < 2; ++ai)
#pragma unroll
            for (int m = 0; m < 4; ++m) { const int r = row0 + ai * 128 + m * 16; const float rs = rsl[pre.par * 256 + wr * 64 + fr + ai * 128 + m * 16];
                const f32x4 g0 = acc[ai][0][m][0], g1 = acc[ai][0][m][1], u0 = acc[ai][1][m][0], u1 = acc[ai][1][m][1];
                const float nr = rs * -1.44269504089f, r2 = rs * rs; const f32x2e nrs = {nr, nr}, rs2 = {r2, r2};
                const f32x2e o0 = glu2_(LO2(g0), LO2(u0), nrs, rs2), o1 = glu2_(HI2(g0), HI2(u0), nrs, rs2), o2 = glu2_(LO2(g1), LO2(u1), nrs, rs2), o3 = glu2_(HI2(g1), HI2(u1), nrs, rs2);
                u32x4 w; w.x = cvt_pk_bf16(o0.x, o0.y); w.y = cvt_pk_bf16(o1.x, o1.y); w.z = cvt_pk_bf16(o2.x, o2.y); w.w = cvt_pk_bf16(o3.x, o3.y);
                *(u32x4*)(O + (size_t)r * ldo + cl) = w; }
    }
};
struct EpiGlu8 {
    static constexpr bool PERM = true;
    const float* rstd; unsigned char* O; int ldo; float sc;
    struct Pre { float rs[8]; };
    __device__ __forceinline__ void prefetch(const Unit& u, int wr, int fr, Pre& p) const {
#pragma unroll
        for (int q = 0; q < 8; ++q) p.rs[q] = rstd[u.pm * 256 + wr * 64 + fr + (q >> 2) * 128 + (q & 3) * 16]; }
    __device__ __forceinline__ void operator()(const f32x4 (&acc)[2][2][4][2], const Unit& u, int wr, int wc, int fr, int fq, const Pre& pre) const {
        const int row0 = u.pm * 256 + wr * 64 + fr, cl = u.pn * 128 + wc * 32 + 8 * fq;
#pragma unroll
        for (int ai = 0; ai < 2; ++ai)
#pragma unroll
            for (int m = 0; m < 4; ++m) { const int r = row0 + ai * 128 + m * 16; const float rs = pre.rs[ai * 4 + m] * sc;
                const f32x4 g0 = acc[ai][0][m][0], g1 = acc[ai][0][m][1], u0 = acc[ai][1][m][0], u1 = acc[ai][1][m][1];
                const float nr = rs * -1.44269504089f, r2 = rs * rs; const f32x2e nrs = {nr, nr}, rs2 = {r2, r2};
                const f32x2e o0 = glu2_(LO2(g0), LO2(u0), nrs, rs2), o1 = glu2_(HI2(g0), HI2(u0), nrs, rs2), o2 = glu2_(LO2(g1), LO2(u1), nrs, rs2), o3 = glu2_(HI2(g1), HI2(u1), nrs, rs2);
                *(u32x2*)(O + (size_t)r * ldo + cl) = pk8_fp8(o0.x, o0.y, o1.x, o1.y, o2.x, o2.y, o3.x, o3.y); }
    }
};
struct EpiMoe2 {
    static constexpr bool PERM = true;
    const int* stok; const float* sw; bf16_t* Y0; bf16_t* Y1; int rowbase; float sc;
    struct Pre {}; __device__ __forceinline__ void prefetch(const Unit&, int, int, Pre&) const {}
    __device__ __forceinline__ void operator()(const f32x4 (&acc)[2][2][4][2], const Unit& u, int wr, int wc, int fr, int fq, const Pre&) const {
        const int row0 = u.pm * 256 + wr * 64 + fr, cl = u.pn * 256 + wc * 32 + 8 * fq;
        int tks[8]; float ws[8];
#pragma unroll
        for (int q = 0; q < 8; ++q) { const int r = rowbase + row0 + (q >> 2) * 128 + (q & 3) * 16; tks[q] = stok[r]; ws[q] = sw[r]; }
#pragma unroll
        for (int ai = 0; ai < 2; ++ai)
#pragma unroll
            for (int m = 0; m < 4; ++m) { const int tk = tks[ai * 4 + m]; const float w = ws[ai * 4 + m] * sc;
                if (tk >= 0) { bf16_t* dst = ((tk & 1) ? Y1 : Y0) + (size_t)(tk >> 1) * D + cl;
#pragma unroll
                    for (int bj = 0; bj < 2; ++bj) { const f32x4 v0 = acc[ai][bj][m][0] * w, v1 = acc[ai][bj][m][1] * w;
                        u32x4 o; o.x = cvt_pk_bf16(v0[0], v0[1]); o.y = cvt_pk_bf16(v0[2], v0[3]); o.z = cvt_pk_bf16(v1[0], v1[1]); o.w = cvt_pk_bf16(v1[2], v1[3]);
                        *(u32x4*)(dst + bj * 128) = o; } } }
    }
};

struct SchedCmp {
    int G, c, layer;
    __device__ __forceinline__ bool next(int i, Unit& u) const {
        const int L = i * G + c; if (L >= 128) return false;
        const int kv = L >> 6, pm = (L >> 3) & 7, s = L & 7;
        u.pm = pm; u.pn = kv * 8 + s; u.aoff = ((size_t)kv * KVT + (size_t)pm * 256 * 1024 + s * 256) * 2; u.boff = ((size_t)(layer * 2 + kv) * 256 * 2048 + s * 256) * 2; return true;
    }
};
struct SchedMoe1 {
    int G, c, p0, np; const LAS int* ptab;
    __device__ __forceinline__ bool next(int i, Unit& u) const {
        const int L = i * G + c; if (L >= np * 28) return false;
        const int j = L / np, pl = L % np, e = ptab[p0 + pl];
        u.pm = pl; u.pn = j; u.aoff = (size_t)(p0 + pl) * 256 * 1024 * 2; u.boff = ((size_t)e * 7168 + (size_t)j * 256) * 1024 * 2; return true;
    }
};
struct SchedMoe2 {
    int G, c, p0, np; const LAS int* ptab;
    __device__ __forceinline__ bool next(int i, Unit& u) const {
        const int L = i * G + c; if (L >= np * 4) return false;
        const int j = L / np, pl = L % np, e = ptab[p0 + pl];
        u.pm = pl; u.pn = j; u.aoff = (size_t)pl * 256 * DFE * 2; u.boff = ((size_t)e * 1024 + (size_t)j * 256) * DFE * 2; return true;
    }
};

struct SchedMoe1F {
    int G, c, np; const LAS int* ptab;
    __device__ __forceinline__ bool next(int i, Unit& u) const {
        const int L = i * G + c; if (L >= np * 28) return false;
        const int pl = L / 28, j = L % 28, e = ptab[pl];
        u.pm = pl; u.pn = j; u.aoff = (size_t)pl * 256 * 1024; u.boff = ((size_t)e * 7168 + (size_t)j * 256) * 1024; return true;
    }
};
struct SchedMoe2F {
    int G, c, np; const LAS int* ptab;
    __device__ __forceinline__ bool next(int i, Unit& u) const {
        const int L = i * G + c; if (L >= np * 4) return false;
        const int pl = L >> 2, j = L & 3, e = ptab[pl];
        u.pm = pl; u.pn = j; u.aoff = (size_t)pl * 256 * DFE; u.boff = ((size_t)e * 1024 + (size_t)j * 256) * DFE; return true;
    }
};

struct MoePlan { int N1, PA, nup, qa, n2; };
__device__ __forceinline__ MoePlan moe_plan(int np, int G) {
    MoePlan P; const bool split = (G == 256) && np >= 128 && np <= 136;
    P.nup = 28 * np; P.N1 = split ? 2048 : P.nup; P.PA = split ? np - 64 : np;
    const int r1 = P.nup - P.N1, nA = 4 * P.PA; P.n2 = (split && nA > G) ? nA - G : 0;
    const int R = (r1 + 3 * P.n2 + G - 1) / G; P.qa = R > 3 ? R - 3 : 0; return P; }
struct SchedMoe1R {
    int G, c, L0, ntot, qa, n2; const LAS int* ptab;
    __device__ __forceinline__ bool next(int i, Unit& u) const {
        int L; if (i < qa) L = L0 + i * G + c; else { if (c < n2) return false; L = L0 + qa * G + (i - qa) * (G - n2) + (c - n2); }
        if (L >= ntot) return false;
        const int pl = L / 28, j = L % 28, e = ptab[pl];
        u.pm = pl; u.pn = j; u.aoff = (size_t)pl * 256 * 1024; u.boff = ((size_t)e * 7168 + (size_t)j * 256) * 1024; return true;
    }
};
struct SchedMoe2R {
    int G, c, p0, np; const LAS int* ptab;
    __device__ __forceinline__ bool next(int i, Unit& u) const {
        const int L = i * G + c; if (L >= np * 4) return false;
        const int pl = p0 + (L >> 2), j = L & 3, e = ptab[pl];
        u.pm = pl; u.pn = j; u.aoff = (size_t)pl * 256 * DFE; u.boff = ((size_t)e * 1024 + (size_t)j * 256) * DFE; return true;
    }
};

struct TwP { const float* W; const float* gv; bf16_t* WT; int ldw, n0, nvalid, k0, ldk, kind, h; float f8sc; };
__device__ __forceinline__ TwP tw_job(int r, const float* W, int ldw, int nblk, int nvalid, bf16_t* WT, int ldk, int kind, int h, const float* gv) {
    TwP P; P.W = W; P.gv = gv; P.WT = WT; P.ldw = ldw; P.n0 = 256 * (r % nblk); P.nvalid = nvalid; P.k0 = 64 * (r / nblk); P.ldk = ldk; P.kind = kind; P.h = h; P.f8sc = 0.f; return P; }
__device__ __forceinline__ void tw_load(const TwP& P, f32x4 (&tv)[8], int wave, int lane) {
    const int n = P.n0 + 4 * lane; const float* src = P.W + (size_t)(P.k0 + 8 * wave) * P.ldw + n;
#pragma unroll
    for (int i = 0; i < 8; ++i) tv[i] = (n < P.nvalid) ? *(const f32x4*)(src + (size_t)i * P.ldw) : (f32x4){0.f, 0.f, 0.f, 0.f};
}
__device__ __forceinline__ void tw_store(const TwP& P, f32x4 (&tv)[8], LAS unsigned char* tile, int wave, int lane) {
    if (P.gv) {
#pragma unroll
        for (int i = 0; i < 8; ++i) tv[i] *= P.gv[P.k0 + 8 * wave + i]; }
    const int ng = P.n0 + 32 * wave; size_t drow;
    if (P.kind == 0) drow = ng;
    else if (P.kind == 1) drow = 256 * (ng / 128) + 128 * P.h + (ng % 128);
    else { if (ng < 512) drow = 256 * (ng / 128) + (ng % 128); else if (ng < 1024) { const int cc = ng - 512; drow = 256 * (cc / 128) + 128 + (cc % 128); } else drow = ng; }
    if (P.f8sc != 0.f) {
        const float sc = P.f8sc;
#pragma unroll
        for (int c = 0; c < 4; ++c) *(LAS u32x2*)(tile + (4 * lane + c) * 80 + 8 * wave) = pk8_fp8(tv[0][c] * sc, tv[1][c] * sc, tv[2][c] * sc, tv[3][c] * sc, tv[4][c] * sc, tv[5][c] * sc, tv[6][c] * sc, tv[7][c] * sc);
        __syncthreads();
#pragma unroll
        for (int j = 0; j < 2; ++j) { const int r = (lane >> 2) + 16 * j, ch = lane & 3;
            *(u32x4*)((unsigned char*)P.WT + (drow + r) * (size_t)P.ldk + P.k0 + 16 * ch) = *(const LAS u32x4*)(tile + (32 * wave + r) * 80 + 16 * ch); }
        __syncthreads();
        return; }
#pragma unroll
    for (int c = 0; c < 4; ++c) { u32x4 o; o.x = cvt_pk_bf16(tv[0][c], tv[1][c]); o.y = cvt_pk_bf16(tv[2][c], tv[3][c]); o.z = cvt_pk_bf16(tv[4][c], tv[5][c]); o.w = cvt_pk_bf16(tv[6][c], tv[7][c]);
        *(LAS u32x4*)(tile + (4 * lane + c) * 144 + 16 * wave) = o; }
    __syncthreads();
#pragma unroll
    for (int j = 0; j < 4; ++j) { const int r = (lane >> 3) + 8 * j, c = lane & 7;
        *(u32x4*)(P.WT + (drow + r) * (size_t)P.ldk + P.k0 + 8 * c) = *(const LAS u32x4*)(tile + (32 * wave + r) * 144 + 16 * c); }
    __syncthreads();
}
#define TW_RUN(NIT, JOB) do { const int _n = (NIT); if (_n > 0) { TwP _pa, _pb; f32x4 _ta[8], _tb[8]; JOB(_pa, 0); tw_load(_pa, _ta, F.wave, F.lane); \
    _Pragma("nounroll") for (int _i = 0; _i < _n; _i += 2) { const bool _h2 = _i + 1 < _n, _h3 = _i + 2 < _n; \
        if (_h2) { JOB(_pb, _i + 1); tw_load(_pb, _tb, F.wave, F.lane); } tw_store(_pa, _ta, F.lds, F.wave, F.lane); if (!_h2) break; \
        if (_h3) { JOB(_pa, _i + 2); tw_load(_pa, _ta, F.wave, F.lane); } tw_store(_pb, _tb, F.lds, F.wave, F.lane); } } } while (0)
__device__ __forceinline__ void xprep_row(const float* xrow, bf16_t* orow, float* rstd_out, int lane, f32x4 (&v)[4]) {
    const f32x4* xr = (const f32x4*)xrow + lane; float s = 0.f;
#pragma unroll
    for (int j = 0; j < 4; ++j) { v[j] = xr[64 * j]; s += (v[j].x * v[j].x + v[j].y * v[j].y) + (v[j].z * v[j].z + v[j].w * v[j].w); }
    const float rstd = rsqf_(wave_sum_u(s) * (1.0f / D) + EPS);
    if (orow) { u32x2* o8 = (u32x2*)orow + lane;
#pragma unroll
        for (int j = 0; j < 4; ++j) { u32x2 w; w.x = cvt_pk_bf16(v[j].x, v[j].y); w.y = cvt_pk_bf16(v[j].z, v[j].w); o8[64 * j] = w; } }
    if (lane == 0) *rstd_out = rstd;
}

constexpr float MOE_S1 = 64.f, MOE_S2 = 128.f;
constexpr int MOE_SLOT_N = 7, MOE_SLOTTED = 3 * 128 * MOE_SLOT_N;
constexpr int MOE_ITEMS = 24 * 224;
__device__ __forceinline__ TwP moe_conv_job(Frame& F, int r) {
    constexpr int J_M1 = 16 * 14, J_M2 = 56 * 4;
    unsigned char* WM1 = F.ws + WS_WM1; unsigned char* WM2 = F.ws + WS_WM2;
    if (r < 16 * J_M1) { const int q = r / J_M1, e = q >> 1, h = q & 1; TwP P = tw_job(r % J_M1, (h ? INP_(I_MW3) : INP_(I_MW1)) + (size_t)e * D * DFE, DFE, 14, DFE, (bf16_t*)(WM1 + (size_t)e * 7168 * D), D, 1, h, INP_(I_FNG) + D); P.f8sc = MOE_S1; return P; }
    r -= 16 * J_M1; const int e = r / J_M2; TwP P = tw_job(r % J_M2, INP_(I_MW2) + (size_t)e * DFE * D, D, 4, D, (bf16_t*)(WM2 + (size_t)e * D * DFE), DFE, 0, 0, nullptr); P.f8sc = MOE_S2; return P;
}
__device__ __forceinline__ void moe_conv_slot(Frame& F, int slot) {
    if (F.G != 256 || F.c < 128) return;
    { int _t = threadIdx.x; asm volatile("" : "+v"(_t)); F.tid = _t; F.lane = _t & 63; }
    int base = slot * 128 * MOE_SLOT_N + ((int)blockIdx.x - 128); asm volatile("" : "+s"(base));
#define MJOB(P, i) P = moe_conv_job(F, base + (i) * 128)
    TW_RUN(MOE_SLOT_N, MJOB);
#undef MJOB
}
__device__ __forceinline__ void xprep_rows4(const float* X, bf16_t* XBo, float* RSo, int m, int ms, int lane) {
    f32x4 v[4][4];
#pragma unroll
    for (int q = 0; q < 4; ++q) { const int mm = m + q * ms; const f32x4* xr = (const f32x4*)(X + (size_t)(mm < M ? mm : 0) * D) + lane;
#pragma unroll
        for (int j = 0; j < 4; ++j) v[q][j] = xr[64 * j]; }
#pragma unroll
    for (int q = 0; q < 4; ++q) { const int mm = m + q * ms; if (mm >= M) break; float s = 0.f;
#pragma unroll
        for (int j = 0; j < 4; ++j) s += (v[q][j].x * v[q][j].x + v[q][j].y * v[q][j].y) + (v[q][j].z * v[q][j].z + v[q][j].w * v[q][j].w);
        const float rstd = rsqf_(wave_sum_u(s) * (1.0f / D) + EPS);
        u32x2* o8 = (u32x2*)(XBo + (size_t)mm * D) + lane;
#pragma unroll
        for (int j = 0; j < 4; ++j) { u32x2 w; w.x = cvt_pk_bf16(v[q][j].x, v[q][j].y); w.y = cvt_pk_bf16(v[q][j].z, v[q][j].w); o8[64 * j] = w; }
        if (lane == 0) RSo[mm] = rstd; }
}
__device__ __forceinline__ void phase_prologue(Frame& F) {
    const int gw = F.c * NWAVES + F.wave, NGW = F.G * NWAVES;
    bf16_t* WIN = (bf16_t*)(F.ws + WS_WIN); bf16_t* WC1 = (bf16_t*)(F.ws + WS_WC1); bf16_t* WOUT = (bf16_t*)(F.ws + WS_WOUT); bf16_t* WF1 = (bf16_t*)(F.ws + WS_WF1); bf16_t* WF2 = (bf16_t*)(F.ws + WS_WF2);
    constexpr int J_IN = 16 * 10, J_C1 = 32, J_OUT = 16 * 4, J_F1 = 16 * 11, J_F2 = 44 * 4;
    constexpr int NSMALL = 2 * J_IN + 4 * J_C1 + 2 * J_OUT + 2 * J_F1 + J_F2;
    const int moe0 = (F.G == 256) ? MOE_SLOTTED : 0; const int nitems = NSMALL + MOE_ITEMS - moe0;
#define P0_JOB(P, i) do { int r = F.c + (i) * F.G; \
        if (r < 2 * J_IN) { const int l = r / J_IN; P = tw_job(r % J_IN, INP_(I_WIN) + (size_t)l * D * INW, INW, 10, INW, WIN + (size_t)l * INP * D, D, 2, 0, INP_(I_ANG) + l * D); break; } r -= 2 * J_IN; \
        if (r < 4 * J_C1) { const int q = r / J_C1, l = q >> 1, kv = q & 1; P = tw_job(r % J_C1, (kv ? INP_(I_VW1) : INP_(I_KW1)) + (size_t)l * 2048 * 256, 256, 1, 256, WC1 + (size_t)(l * 2 + kv) * 256 * 2048, 2048, 0, 0, nullptr); break; } r -= 4 * J_C1; \
        if (r < 2 * J_OUT) { const int l = r / J_OUT; P = tw_job(r % J_OUT, INP_(I_WOUT) + (size_t)l * D * D, D, 4, D, WOUT + (size_t)l * D * D, D, 0, 0, nullptr); break; } r -= 2 * J_OUT; \
        if (r < 2 * J_F1) { const int h = r / J_F1; P = tw_job(r % J_F1, (h ? INP_(I_DW3) : INP_(I_DW1)), DFF, 11, DFF, WF1, D, 1, h, INP_(I_FNG)); break; } r -= 2 * J_F1; \
        if (r < J_F2) { P = tw_job(r, INP_(I_DW2), D, 4, D, WF2, DFF, 0, 0, nullptr); break; } r -= J_F2; \
        P = moe_conv_job(F, r + moe0); } while (0)
    TW_RUN((nitems - F.c + F.G - 1) / F.G, P0_JOB);
#undef P0_JOB
    { float* RT = (float*)(F.ws + WS_RT); const int gt = F.c * NTHR + F.tid; if (gt < 8192) { const int e = gt >> 10, k = gt & 1023; RT[gt] = INP_(I_RW)[k * 8 + e] * INP_(I_FNG)[D + k]; } }
    { float* B1P = (float*)(F.ws + WS_CTL) + CW_B1P; LAS float* ps = (LAS float*)F.lds;
      for (int it = F.c; it < 128; it += F.G) { const int kc = it & 7, jb = (it >> 3) & 3, kv = (it >> 5) & 1, l = it >> 6; const int j = jb * 64 + F.lane, kb = kc * 256 + 32 * F.wave;
          const float* w1 = (kv ? INP_(I_VW1) : INP_(I_KW1)) + (size_t)l * 2048 * 256; const float* pos = (kv ? INP_(I_PV) : INP_(I_PK)) + l * 2048;
          float wv[32];
#pragma unroll
          for (int k = 0; k < 32; ++k) wv[k] = w1[(size_t)(kb + k) * 256 + j];
          float sp = 0.f;
#pragma unroll
          for (int k = 0; k < 32; ++k) sp += pos[kb + k] * wv[k];
          ps[F.wave * 64 + F.lane] = sp;
          __syncthreads();
          if (F.wave == 0) { float t = (kc == 0) ? (kv ? INP_(I_VB1) : INP_(I_KB1))[l * 256 + j] : 0.f;
#pragma unroll
              for (int ww = 0; ww < 8; ++ww) t += ps[ww * 64 + F.lane];
              B1P[kc * 1024 + (l * 2 + kv) * 256 + j] = t; }
          __syncthreads(); } }
    { bf16_t* XB = (bf16_t*)(F.ws + WS_XB); float* RS = (float*)(F.ws + WS_RSTD);
      for (int m = gw; m < M; m += 4 * NGW) xprep_rows4(INP_(I_X), XB, RS, m, NGW, F.lane); }
}

__device__ __forceinline__ void norm_rows64(bf16_t* buf, int nrows, const float* g, float scale, int gw, int NGW, int lane) {
    const int sub = lane & 7; float gv[8];
#pragma unroll
    for (int j = 0; j < 8; ++j) gv[j] = g[sub * 8 + j] * scale;
    for (int it = gw; it < nrows / 8; it += NGW) { u32x4* p = (u32x4*)(buf + ((size_t)it * 8 + (lane >> 3)) * 64) + sub; const u32x4 v = *p;
        float f[8] = {bf_lo(v.x), bf_hi(v.x), bf_lo(v.y), bf_hi(v.y), bf_lo(v.z), bf_hi(v.z), bf_lo(v.w), bf_hi(v.w)}; float s = 0.f;
#pragma unroll
        for (int j = 0; j < 8; ++j) s += f[j] * f[j];
        s += __shfl_xor(s, 1); s += __shfl_xor(s, 2); s += __shfl_xor(s, 4);
        const float rs = rsqf_(s * (1.0f / 64.0f) + EPS);
        u32x4 o; o.x = cvt_pk_bf16(f[0] * rs * gv[0], f[1] * rs * gv[1]); o.y = cvt_pk_bf16(f[2] * rs * gv[2], f[3] * rs * gv[3]); o.z = cvt_pk_bf16(f[4] * rs * gv[4], f[5] * rs * gv[5]); o.w = cvt_pk_bf16(f[6] * rs * gv[6], f[7] * rs * gv[7]);
        *p = o; }
}
__device__ __forceinline__ float sum32_(float v, bool) {
    v = DPP_ADD(v, 0xB1); v = DPP_ADD(v, 0x4E); v = DPP_ADD(v, 0x124); v = DPP_ADD(v, 0x128);
    return v + __shfl_xor(v, 16);
}
__device__ __forceinline__ void conv_unit(Frame& F, int layer, int cu) {
    const int b = cu >> 6, t0 = (cu & 63) * 32; int tid = F.tid; asm volatile("" : "+v"(tid));
    const bf16_t* U = (const bf16_t*)(F.ws + WS_U); bf16_t* MIX = (bf16_t*)(F.ws + WS_MIX);
    LAS u32x4* L4 = (LAS u32x4*)F.lds;
    { u32x4 sv[8];
#pragma unroll
      for (int q = 0; q < 8; ++q) { const int i = tid + q * NTHR, row = i >> 6, ch = i & 63, t = t0 - 30 + row; sv[q] = (u32x4){0u, 0u, 0u, 0u}; if (i < 62 * 64 && t >= 0) sv[q] = *(const u32x4*)(U + (size_t)(b * SEQ + t) * CW + ch * 8); }
#pragma unroll
      for (int q = 0; q < 8; ++q) { const int i = tid + q * NTHR; if (i < 62 * 64) L4[i] = sv[q]; } }
    __syncthreads();
    const int cp = tid & 255, th = tid >> 8; const bool hi = (tid & 32) != 0; const LAS unsigned* LW = (const LAS unsigned*)F.lds;
    f32x2 w[CKW];
#pragma unroll
    for (int k = 0; k < CKW; ++k) w[k] = *(const f32x2*)(INP_(I_CDW) + (size_t)layer * CKW * CW + k * CW + 2 * cp);
    const f32x2 cb = *(const f32x2*)(INP_(I_CDB) + layer * CW + 2 * cp), lg = *(const f32x2*)(INP_(I_CLG) + layer * CW + 2 * cp), lb = *(const f32x2*)(INP_(I_CLB) + layer * CW + 2 * cp);
#pragma nounroll
    for (int hf = 0; hf < 2; ++hf) { const int tl0 = th * 16 + hf * 8;
        f32x2 in[38];
#pragma unroll
        for (int i = 0; i < 38; ++i) { const unsigned v = LW[(tl0 + i) * 256 + cp]; in[i] = (f32x2){bf_lo(v), bf_hi(v)}; }
        f32x2 acc[8];
#pragma unroll
        for (int t = 0; t < 8; ++t) { acc[t] = cb;
#pragma unroll
            for (int k = 0; k < CKW; ++k) acc[t] += w[k] * in[t + k]; }
#pragma unroll
        for (int t = 0; t < 8; ++t) {
            const float s = sum32_(acc[t].x + acc[t].y, hi), q = sum32_(acc[t].x * acc[t].x + acc[t].y * acc[t].y, hi);
            const float mu = s * (1.0f / 64.0f), var = fmaxf(q * (1.0f / 64.0f) - mu * mu, 0.f), rs = rsqf_(var + EPS);
            const float a0 = (acc[t].x - mu) * rs * lg.x + lb.x, a1 = (acc[t].y - mu) * rs * lg.y + lb.y;
            *(unsigned*)(MIX + (size_t)(b * SEQ + t0 + tl0 + t) * D + 2 * cp) = cvt_pk_bf16(siluf_(a0), siluf_(a1)); }
    }
    __syncthreads();
}
__device__ __forceinline__ void vtrans_items(Frame& F, int gw, int NGW) {
    const int lane = F.lane;
    LAS unsigned char* scr = F.lds + F.wave * 9216;
    for (int it = gw; it < 1024; it += NGW) { const int ten = it >> 9, bh = (it >> 5) & 15, kb = it & 31;
        const bf16_t* V = (const bf16_t*)(F.ws + WS_KV) + (size_t)(ten ? 5 : 3) * KVT + ((size_t)bh * SEQ + kb * 64) * 64; bf16_t* VT = (bf16_t*)(F.ws + (ten ? WS_VWT : WS_VST)) + (size_t)bh * 64 * SEQ + kb * 64;
#pragma unroll
        for (int c = 0; c < 8; ++c) *(LAS u32x4*)(scr + lane * 144 + c * 16) = *((const u32x4*)(V + (size_t)lane * 64) + c);
        LDS_WAIT(); __builtin_amdgcn_wave_barrier(); asm volatile("" ::: "memory");
#pragma unroll
        for (int c = 0; c < 8; ++c) { unsigned w[4];
#pragma unroll
            for (int q = 0; q < 4; ++q) { const int v0 = 8 * c + 2 * q, k0 = swap23(v0), k1 = swap23(v0 + 1);
                w[q] = (unsigned)*(const LAS bf16_t*)(scr + k0 * 144 + lane * 2) | ((unsigned)*(const LAS bf16_t*)(scr + k1 * 144 + lane * 2) << 16); }
            *((u32x4*)(VT + (size_t)lane * SEQ) + c) = (u32x4){w[0], w[1], w[2], w[3]}; }
        LDS_WAIT(); __builtin_amdgcn_wave_barrier(); asm volatile("" ::: "memory");
    }
}
__device__ __forceinline__ void phase_cmp2(Frame& F, int layer) {
    const int lane = F.lane, w = F.wave, k0 = 32 * w;
    const float* H1 = (const float*)(F.ws + WS_H1); const float* B1P = (const float*)(F.ws + WS_CTL) + CW_B1P + layer * 512;
    LAS float* part = (LAS float*)F.lds;
#pragma nounroll
    for (int un = F.c; un < 256; un += F.G) { const int kv = un >> 7, R0 = (un & 127) * 16;
        const float* w2 = (kv ? INP_(I_VW2) : INP_(I_KW2)) + (size_t)layer * 16384 + (size_t)k0 * 64 + lane;
        float w2r[32];
#pragma unroll
        for (int j = 0; j < 32; ++j) w2r[j] = w2[j * 64];
        float bsum = 0.f;
#pragma unroll
        for (int sp = 0; sp < 8; ++sp) bsum += B1P[sp * 1024 + kv * 256 + k0 + (lane & 31)];
        float acc[16], hx[16];
        {
            float hp[16][8];
#pragma unroll
            for (int r = 0; r < 16; ++r)
#pragma unroll
                for (int sp = 0; sp < 8; ++sp) hp[r][sp] = H1[((size_t)kv * 2048 + R0 + r) * 256 + k0 + (lane & 31) + (size_t)sp * 2 * 2048 * 256];
#pragma unroll
            for (int r = 0; r < 16; ++r) { float x = 0.f;
#pragma unroll
                for (int sp = 0; sp < 8; ++sp) x += hp[r][sp];
                hx[r] = siluf_(x + bsum); } }
#pragma unroll
        for (int r = 0; r < 16; ++r) { const int hb = __builtin_bit_cast(int, hx[r]); float a = 0.f;
#pragma unroll
            for (int j = 0; j < 32; ++j) a += __builtin_bit_cast(float, __builtin_amdgcn_readlane(hb, j)) * w2r[j];
            acc[r] = a; }
#pragma unroll
        for (int r = 0; r < 16; ++r) part[(w * 16 + r) * 64 + lane] = acc[r];
        __syncthreads();
#pragma unroll
        for (int rr = 0; rr < 2; ++rr) { const int r = 2 * w + rr, R = R0 + r;
            float a = (kv ? INP_(I_VB2) : INP_(I_KB2))[layer * 64 + lane];
#pragma unroll
            for (int ww = 0; ww < 8; ++ww) a += part[(ww * 16 + r) * 64 + lane];
            if ((R & 127) == 127) a = 0.f;
            else if (kv == 0) { const float ms = wave_sum_u(a * a) * (1.0f / 64.0f); a = a * (rsqf_(ms + EPS)) * INP_(I_KG)[layer * 192 + lane]; }
            const bf16_t ab = (bf16_t)(cvt_pk_bf16(a, 0.f) & 0xffffu);
            ((bf16_t*)(F.ws + (kv ? WS_VC : WS_KC)))[(size_t)R * 64 + lane] = ab;
            if (kv) ((bf16_t*)(F.ws + WS_VCT))[((size_t)(R >> 7) * 64 + lane) * 128 + swap23(R & 127)] = ab; }
        __syncthreads();
    }
}

__device__ __forceinline__ void dots4(const bf16_t* krow, const LAS float* qs, float (&s)[4]) {
    s[0] = s[1] = s[2] = s[3] = 0.f;
#pragma nounroll
    for (int c = 0; c < 8; ++c) { const u32x4 v = *((const u32x4*)krow + c);
        const float f[8] = {bf_lo(v.x), bf_hi(v.x), bf_lo(v.y), bf_hi(v.y), bf_lo(v.z), bf_hi(v.z), bf_lo(v.w), bf_hi(v.w)};
#pragma unroll
        for (int h = 0; h < 4; ++h) { const f32x4 q0 = *(const LAS f32x4*)(qs + h * 64 + c * 8), q1 = *(const LAS f32x4*)(qs + h * 64 + c * 8 + 4);
            s[h] += (f[0] * q0.x + f[1] * q0.y) + (f[2] * q0.z + f[3] * q0.w) + (f[4] * q1.x + f[5] * q1.y) + (f[6] * q1.z + f[7] * q1.w); } }
}
__device__ __forceinline__ void softmax_pv(LAS f32x4* sb, const LAS int* kb, int nk, const bf16_t* V, int lane, float (&o)[4]) {
    float m[4] = {-1e30f, -1e30f, -1e30f, -1e30f};
#pragma nounroll
    for (int c = 0; c < nk; ++c) { const f32x4 s = sb[c * 64 + lane]; m[0] = fmaxf(m[0], s.x); m[1] = fmaxf(m[1], s.y); m[2] = fmaxf(m[2], s.z); m[3] = fmaxf(m[3], s.w); }
#pragma unroll
    for (int h = 0; h < 4; ++h) m[h] = wave_max(m[h]);
    float sum[4] = {0.f, 0.f, 0.f, 0.f};
#pragma nounroll
    for (int c = 0; c < nk; ++c) { const f32x4 s = sb[c * 64 + lane]; f32x4 p;
        p.x = s.x > -1e29f ? __expf(s.x - m[0]) : 0.f; p.y = s.y > -1e29f ? __expf(s.y - m[1]) : 0.f; p.z = s.z > -1e29f ? __expf(s.z - m[2]) : 0.f; p.w = s.w > -1e29f ? __expf(s.w - m[3]) : 0.f;
        sum[0] += p.x; sum[1] += p.y; sum[2] += p.z; sum[3] += p.w; sb[c * 64 + lane] = p; }
    float inv[4];
#pragma unroll
    for (int h = 0; h < 4; ++h) inv[h] = rcpf_(fmaxf(wave_sum(sum[h]), 1e-30f));
    LDS_WAIT(); __builtin_amdgcn_wave_barrier(); asm volatile("" ::: "memory");
    o[0] = o[1] = o[2] = o[3] = 0.f;
#pragma nounroll
    for (int c = 0; c < nk; ++c) { const int k0 = kb[c];
#pragma unroll 4
        for (int kk = 0; kk < 64; ++kk) { int key = k0 + kk; key = key < 0 ? 0 : (key > SEQ - 1 ? SEQ - 1 : key);
            const f32x4 p = sb[c * 64 + kk]; const float v = bf2f(V[(size_t)key * 64 + lane]);
            o[0] += p.x * v; o[1] += p.y * v; o[2] += p.z * v; o[3] += p.w * v; } }
#pragma unroll
    for (int h = 0; h < 4; ++h) o[h] *= inv[h];
    __builtin_amdgcn_wave_barrier(); asm volatile("" ::: "memory");
}
__device__ __forceinline__ void phase_attn_ref(Frame& F, int layer) {
    const int lane = F.lane;
    LAS unsigned char* wl = F.lds + F.wave * 12288;
    LAS float* qs = (LAS float*)wl;
    LAS f32x4* pc = (LAS f32x4*)(wl + 1024);
    LAS float* psum = (LAS float*)(wl + 3072);
    LAS int* kbl = (LAS int*)(wl + 3584);
    LAS f32x4* sb = (LAS f32x4*)(wl + 4096);
    const bf16_t* QN = (const bf16_t*)(F.ws + WS_Q); const bf16_t* KVb = (const bf16_t*)(F.ws + WS_KV);
    const bf16_t* KC = (const bf16_t*)(F.ws + WS_KC); const bf16_t* VC = (const bf16_t*)(F.ws + WS_VC);
    const float* GT = (const float*)(F.ws + WS_GT); bf16_t* MIX = (bf16_t*)(F.ws + WS_MIX);
#pragma nounroll
    for (int un = F.c; un < NBH * 64; un += F.G) {
        const int bh = un >> 6, tile = un & 63, b = bh >> 1, kvh = bh & 1;
        const bf16_t* KS = KVb + 2 * KVT + (size_t)bh * SEQ * 64; const bf16_t* VS = KVb + 3 * KVT + (size_t)bh * SEQ * 64;
        const bf16_t* KW = KVb + 4 * KVT + (size_t)bh * SEQ * 64; const bf16_t* VW = KVb + 5 * KVT + (size_t)bh * SEQ * 64;
#pragma nounroll
        for (int ti = 0; ti < 4; ++ti) {
            const int t = tile * 32 + F.wave * 4 + ti, r = b * SEQ + t;
#pragma unroll
            for (int h = 0; h < 4; ++h) qs[h * 64 + lane] = bf2f(QN[(size_t)r * 512 + (kvh * 4 + h) * 64 + lane]);
            LDS_WAIT(); __builtin_amdgcn_wave_barrier(); asm volatile("" ::: "memory");
            float sc[2][4]; bool vc[2];
#pragma unroll
            for (int u = 0; u < 2; ++u) { const int c = lane + 64 * u; vc[u] = (c < NCMP) && (16 * c + 31 <= t);
                if (vc[u]) dots4(KC + ((size_t)bh * 128 + c) * 64, qs, sc[u]); else { sc[u][0] = sc[u][1] = sc[u][2] = sc[u][3] = -1e30f; } }
            float pr[2][4];
#pragma unroll
            for (int h = 0; h < 4; ++h) { const float mx = wave_max(fmaxf(sc[0][h], sc[1][h]));
                pr[0][h] = vc[0] ? __expf(sc[0][h] - mx) : 0.f; pr[1][h] = vc[1] ? __expf(sc[1][h] - mx) : 0.f;
                const float inv = rcpf_(fmaxf(wave_sum(pr[0][h] + pr[1][h]), 1e-30f)); pr[0][h] *= inv; pr[1][h] *= inv; }
#pragma unroll
            for (int u = 0; u < 2; ++u) { pc[lane + 64 * u] = (f32x4){pr[u][0], pr[u][1], pr[u][2], pr[u][3]}; psum[lane + 64 * u] = (pr[u][0] + pr[u][1]) + (pr[u][2] + pr[u][3]); }
            LDS_WAIT(); __builtin_amdgcn_wave_barrier(); asm volatile("" ::: "memory");
            const int j = lane & 31, cur = t >> 6; float imp = 0.f;
#pragma unroll
            for (int cc = -1; cc <= 3; ++cc) { const int c = 4 * j + cc; if (c >= 0 && c < NCMP) imp += psum[c]; }
            const bool causal = (j * 64 <= t), forced = (j == 0) || (j == cur) || (j == cur - 1);
            const float score = causal ? (forced ? imp + 1e4f : imp) : -1e30f;
            int rank = 0;
#pragma unroll
            for (int i = 0; i < 32; ++i) { const float si = __shfl(score, i); rank += (si > score || (si == score && i < j)) ? 1 : 0; }
            const unsigned selmask = (unsigned)__ballot(lane < 32 && rank < 8 && causal);
            float ocmp[4] = {0.f, 0.f, 0.f, 0.f};
            { const int nvc = t >= 31 ? (((t - 31) >> 4) + 1 > NCMP ? NCMP : ((t - 31) >> 4) + 1) : 0;
#pragma unroll 4
              for (int c = 0; c < nvc; ++c) { const f32x4 p = pc[c]; const float v = bf2f(VC[((size_t)bh * 128 + c) * 64 + lane]); ocmp[0] += p.x * v; ocmp[1] += p.y * v; ocmp[2] += p.z * v; ocmp[3] += p.w * v; } }
            __builtin_amdgcn_wave_barrier(); asm volatile("" ::: "memory");
            int nk = 0; float osel[4], owin[4];
#pragma nounroll
            for (unsigned mm = selmask; mm != 0u && nk < 8; mm &= mm - 1u) { const int jj = __builtin_ctz(mm);
                const int key = jj * 64 + lane; float s[4];
                if (key <= t) dots4(KS + (size_t)key * 64, qs, s); else { s[0] = s[1] = s[2] = s[3] = -1e30f; }
                sb[nk * 64 + lane] = (f32x4){s[0], s[1], s[2], s[3]};
                if (lane == 0) kbl[nk] = jj * 64;
                ++nk; }
            LDS_WAIT(); __builtin_amdgcn_wave_barrier(); asm volatile("" ::: "memory");
            softmax_pv(sb, kbl, nk, VS, lane, osel);
            nk = 0;
#pragma nounroll
            for (int ch = 0; ch < 8; ++ch) { const int k0 = t - 511 + 64 * ch; if (k0 + 63 < 0) continue;
                const int key = k0 + lane; float s[4];
                if (key >= 0) dots4(KW + (size_t)key * 64, qs, s); else { s[0] = s[1] = s[2] = s[3] = -1e30f; }
                sb[nk * 64 + lane] = (f32x4){s[0], s[1], s[2], s[3]};
                if (lane == 0) kbl[nk] = k0;
                ++nk; }
            LDS_WAIT(); __builtin_amdgcn_wave_barrier(); asm volatile("" ::: "memory");
            softmax_pv(sb, kbl, nk, VW, lane, owin);
#pragma unroll
            for (int h = 0; h < 4; ++h) { const float* gp = GT + (size_t)r * 24 + (kvh * 4 + h) * 3;
                const float o = sigmoidf_(gp[0]) * ocmp[h] + sigmoidf_(gp[1]) * osel[h] + sigmoidf_(gp[2]) * owin[h];
                MIX[(size_t)r * D + 512 + (kvh * 4 + h) * 64 + lane] = (bf16_t)(cvt_pk_bf16(o, 0.f) & 0xffffu); }
            __builtin_amdgcn_wave_barrier(); asm volatile("" ::: "memory");
        }
    }
}


constexpr int AT_KB = 0, AT_VB = 18432, AT_WUN = 36864, AT_OT = 40960;
__device__ __forceinline__ int crow_(int i) { return (i & 3) + 8 * (i >> 2); }
__device__ __forceinline__ float fmax_(float a, float b) { return __builtin_amdgcn_fmed3f(a, b, __builtin_inff()); }
template <int MODE>
__device__ __forceinline__ void attn_tile(const LAS unsigned char* KB, const LAS unsigned char* VB, const bf16x8 (&Qf)[4], f32x16 (&O)[2], float cref, float& l, int tl, int lo, bool rowok, int n, int h) {
    f32x16 S0, S1;
#pragma unroll
    for (int i = 0; i < 16; ++i) { S0[i] = 0.f; S1[i] = 0.f; }
#pragma unroll
    for (int s = 0; s < 4; ++s) { const bf16x8 k0 = *(const LAS bf16x8*)(KB + n * 144 + (16 * s + 8 * h) * 2), k1 = *(const LAS bf16x8*)(KB + (32 + n) * 144 + (16 * s + 8 * h) * 2);
        S0 = MFMA32(k0, Qf[s], S0); S1 = MFMA32(k1, Qf[s], S1); }
    if (MODE != 0) {
#pragma unroll
        for (int i = 0; i < 16; ++i) { const int c0 = crow_(i), c1 = 32 + crow_(i);
            if (MODE == 2) { S0[i] = (c0 <= tl && c0 > lo) ? S0[i] : -1e30f; S1[i] = (c1 <= tl && c1 > lo) ? S1[i] : -1e30f; } } }
    f32x2 ls2 = {0.f, 0.f}; const float crow = (MODE == 1) ? (rowok ? cref : 1e30f) : cref; const f32x2 mr2 = {crow, crow};
#pragma unroll
    for (int i = 0; i < 8; ++i) { f32x2 a = (f32x2){S0[2 * i], S0[2 * i + 1]} - mr2, b = (f32x2){S1[2 * i], S1[2 * i + 1]} - mr2;
        a.x = __builtin_amdgcn_exp2f(a.x); a.y = __builtin_amdgcn_exp2f(a.y); b.x = __builtin_amdgcn_exp2f(b.x); b.y = __builtin_amdgcn_exp2f(b.y);
        S0[2 * i] = a.x; S0[2 * i + 1] = a.y; S1[2 * i] = b.x; S1[2 * i + 1] = b.y; ls2 += a + b; }
    l += ls2.x + ls2.y;
    const bf16x8 P00 = pack8<0>(S0), P01 = pack8<8>(S0), P10 = pack8<0>(S1), P11 = pack8<8>(S1);
    __builtin_amdgcn_sched_barrier(0);
#pragma unroll
    for (int d = 0; d < 2; ++d) { const LAS unsigned char* vb = VB + (32 * d + n) * 144 + 8 * h * 2;
        O[d] = MFMA32(*(const LAS bf16x8*)(vb + 0), P00, O[d]); O[d] = MFMA32(*(const LAS bf16x8*)(vb + 32), P01, O[d]);
        O[d] = MFMA32(*(const LAS bf16x8*)(vb + 64), P10, O[d]); O[d] = MFMA32(*(const LAS bf16x8*)(vb + 96), P11, O[d]); }
}
__device__ __forceinline__ void attn_stage64(LAS unsigned char* lds, const bf16_t* K, const bf16_t* VT, int tid) {
    const int row = tid >> 3, ch = tid & 7;
    const u32x4 kv = *((const u32x4*)K + tid), vv = *(const u32x4*)(VT + (size_t)row * SEQ + ch * 8);
    *(LAS u32x4*)(lds + AT_KB + row * 144 + ch * 16) = kv; *(LAS u32x4*)(lds + AT_VB + row * 144 + ch * 16) = vv;
}
__device__ __forceinline__ void phase_attn_mfma(Frame& F, int layer) {
    const int lane = F.lane, tid = F.tid, n = lane & 31, h = lane >> 5, w = F.wave;
    LAS unsigned char* lds = F.lds; const LAS unsigned char* KB = lds + AT_KB; const LAS unsigned char* VB = lds + AT_VB; volatile LAS unsigned* WUN = (volatile LAS unsigned*)(lds + AT_WUN);
    const bf16_t* QN = (const bf16_t*)(F.ws + WS_Q); const bf16_t* KVb = (const bf16_t*)(F.ws + WS_KV);
    const bf16_t* KC = (const bf16_t*)(F.ws + WS_KC); const bf16_t* VCT = (const bf16_t*)(F.ws + WS_VCT);
    const bf16_t* VST = (const bf16_t*)(F.ws + WS_VST); const bf16_t* VWT = (const bf16_t*)(F.ws + WS_VWT);
    const float* GT = (const float*)(F.ws + WS_GT); bf16_t* MIX = (bf16_t*)(F.ws + WS_MIX);
    float cref;
    { const float gq = fabsf(INP_(I_QG)[layer * 64 + lane]); const float* kg = INP_(I_KG) + layer * 192;
      const float gk = fmaxf(fabsf(kg[lane]), fmaxf(fabsf(kg[64 + lane]), fabsf(kg[128 + lane])));
      const float bound = 1.44269504089f * 8.0f * wave_max(gq) * wave_max(gk); cref = fmaxf(bound - 16.0f, 0.f); }
#pragma nounroll
    for (int ui = 0; ui < 2; ++ui) {
        const int bh = (F.c >> 5) + 8 * ui, tb = ui ? 31 - (F.c & 31) : (F.c & 31);
        if (F.c >= 256) break;
        const int b = bh >> 1, kvh = bh & 1, t0 = tb * 64, cur = tb;
        const int tt = t0 + 8 * w + (n >> 2), hd = n & 3; const size_t r = (size_t)b * SEQ + tt;
        bf16x8 Qf[4]; { const bf16_t* qp = QN + r * 512 + (kvh * 4 + hd) * 64 + 8 * h;
#pragma unroll
            for (int s = 0; s < 4; ++s) Qf[s] = *(const bf16x8*)(qp + 16 * s); }
        {
            float qv[4][8]; float ss = 0.f;
#pragma unroll
            for (int s = 0; s < 4; ++s) { const u32x4 wq = __builtin_bit_cast(u32x4, Qf[s]);
                qv[s][0] = bf_lo(wq.x); qv[s][1] = bf_hi(wq.x); qv[s][2] = bf_lo(wq.y); qv[s][3] = bf_hi(wq.y); qv[s][4] = bf_lo(wq.z); qv[s][5] = bf_hi(wq.z); qv[s][6] = bf_lo(wq.w); qv[s][7] = bf_hi(wq.w);
#pragma unroll
                for (int j = 0; j < 8; ++j) ss += qv[s][j] * qv[s][j]; }
            ss = xsum32(ss);
            const float rsq = rsqf_(ss * (1.0f / 64.0f) + EPS) * (0.125f * 1.44269504089f); const float* qg     = INP_(I_QG) + layer * 64 + 8 * h;
#pragma unroll
            for (int s = 0; s < 4; ++s) { const f32x4 ga = *(const f32x4*)(qg + 16 * s), gb = *(const f32x4*)(qg + 16 * s + 4);
                u32x4 wq; wq.x = pk_bf16(qv[s][0] * rsq * ga.x, qv[s][1] * rsq * ga.y); wq.y = pk_bf16(qv[s][2] * rsq * ga.z, qv[s][3] * rsq * ga.w);
                wq.z = pk_bf16(qv[s][4] * rsq * gb.x, qv[s][5] * rsq * gb.y); wq.w = pk_bf16(qv[s][6] * rsq * gb.z, qv[s][7] * rsq * gb.w); Qf[s] = __builtin_bit_cast(bf16x8, wq); } }
        const float* gp = GT + r * 24 + (kvh * 4 + hd) * 3; const float g0 = sigmoidf_(gp[0]), g1 = sigmoidf_(gp[1]), g2 = sigmoidf_(gp[2]);
        f32x16 Ob[2]; LAS f32x4* OT = (LAS f32x4*)(lds + AT_OT + w * 8192) + lane;
        unsigned tokmask, wmask;
        __syncthreads();
#pragma unroll
        for (int q = 0; q < 2; ++q) { const int i = tid + 512 * q;
            *(LAS u32x4*)(lds + AT_KB + (i >> 3) * 144 + (i & 7) * 16) = *((const u32x4*)(KC + (size_t)bh * 128 * 64) + i);
            *(LAS u32x4*)(lds + AT_VB + (i >> 4) * 272 + (i & 15) * 16) = *((const u32x4*)(VCT + (size_t)bh * 64 * 128) + i); }
        __syncthreads();
        {
            f32x16 S[4];
#pragma unroll
            for (int ta = 0; ta < 4; ++ta) {
#pragma unroll
                for (int i = 0; i < 16; ++i) S[ta][i] = 0.f;
#pragma unroll
                for (int s = 0; s < 4; ++s) S[ta] = MFMA32(*(const LAS bf16x8*)(KB + (32 * ta + n) * 144 + (16 * s + 8 * h) * 2), Qf[s], S[ta]); }
            const int cmax = tt >= 31 ? (((tt - 31) >> 4) > 126 ? 126 : ((tt - 31) >> 4)) : -1, lim = cmax - 4 * h;
            float ls = 0.f;
#pragma unroll
            for (int ta = 0; ta < 4; ++ta)
#pragma unroll
                for (int i = 0; i < 16; ++i) { const float p = (32 * ta + crow_(i) <= lim) ? __builtin_amdgcn_exp2f(S[ta][i] - cref) : 0.f; S[ta][i] = p; ls += p; }
            ls = xsum32(ls);
            const float inv = rcpf_(fmaxf(ls, 1e-30f));
#pragma unroll
            for (int ta = 0; ta < 4; ++ta)
#pragma unroll
                for (int i = 0; i < 16; ++i) S[ta][i] *= inv;
            float val[4][4]; unsigned kk[4];
#pragma unroll
            for (int ta = 0; ta < 4; ++ta)
#pragma unroll
                for (int u = 0; u < 4; ++u) { val[ta][u] = (S[ta][4 * u] + S[ta][4 * u + 1]) + (S[ta][4 * u + 2] + S[ta][4 * u + 3]); }
            {   float xs[4][4];
#pragma unroll
                for (int ta = 0; ta < 4; ++ta)
#pragma unroll
                    for (int u = 0; u < 4; ++u) xs[ta][u] = xget32(S[ta][4 * u + 3], h);
#pragma unroll
                for (int ta = 0; ta < 4; ++ta)
#pragma unroll
                    for (int u = 0; u < 4; ++u) { const float pv0 = (u > 0) ? xs[ta][u > 0 ? u - 1 : 0] : (ta > 0 ? xs[ta > 0 ? ta - 1 : 0][3] : 0.f); val[ta][u] += (h ? xs[ta][u] : pv0); } }
            const bf16x8 P0 = pack8<0>(S[0]), P1 = pack8<8>(S[0]), P2 = pack8<0>(S[1]), P3 = pack8<8>(S[1]), P4 = pack8<0>(S[2]), P5 = pack8<8>(S[2]), P6 = pack8<0>(S[3]), P7 = pack8<8>(S[3]);
            __builtin_amdgcn_sched_barrier(0);
            const bool b0 = (n & 1) != 0, b1 = (n & 2) != 0; const int hd2 = 2 * (n & 3) + h;
#define DPPF(x, ctrl) __builtin_bit_cast(float, __builtin_amdgcn_update_dpp(0, __builtin_bit_cast(int, (x)), (ctrl), 0xF, 0xF, true))
#define DPPU(x, ctrl) ((unsigned)__builtin_amdgcn_update_dpp(0, (int)(x), (ctrl), 0xF, 0xF, true))
#pragma unroll
            for (int ta = 0; ta < 4; ++ta) {
                const float m0 = b0 ? val[ta][1] : val[ta][0], s0 = b0 ? val[ta][0] : val[ta][1], m1 = b0 ? val[ta][3] : val[ta][2], s1 = b0 ? val[ta][2] : val[ta][3];
                const float r0 = m0 + DPPF(s0, 0xB1), r1 = m1 + DPPF(s1, 0xB1);
                const float mm = b1 ? r1 : r0, ss = b1 ? r0 : r1; const float v = mm + DPPF(ss, 0x4E);
                const int G = 8 * ta + hd2; const bool causal = G <= cur, forced = (G == 0) || (G == cur) || (G == cur - 1);
                kk[ta] = causal ? ((forced ? 0x7f000000u : (__float_as_uint(v) & ~31u)) | (unsigned)(31 - G)) : 0u; }
            __builtin_amdgcn_sched_barrier(0);
#pragma unroll
            for (int d = 0; d < 2; ++d) {
#pragma unroll
                for (int i = 0; i < 16; ++i) Ob[d][i] = 0.f;
                const LAS unsigned char* vb = VB + (32 * d + n) * 272 + 8 * h * 2;
                Ob[d] = MFMA32(*(const LAS bf16x8*)(vb + 0), P0, Ob[d]); Ob[d] = MFMA32(*(const LAS bf16x8*)(vb + 32), P1, Ob[d]);
                Ob[d] = MFMA32(*(const LAS bf16x8*)(vb + 64), P2, Ob[d]); Ob[d] = MFMA32(*(const LAS bf16x8*)(vb + 96), P3, Ob[d]);
                Ob[d] = MFMA32(*(const LAS bf16x8*)(vb + 128), P4, Ob[d]); Ob[d] = MFMA32(*(const LAS bf16x8*)(vb + 160), P5, Ob[d]);
                Ob[d] = MFMA32(*(const LAS bf16x8*)(vb + 192), P6, Ob[d]); Ob[d] = MFMA32(*(const LAS bf16x8*)(vb + 224), P7, Ob[d]);
#pragma unroll
                for (int q = 0; q < 4; ++q) OT[(4 * d + q) * 64] = (f32x4){Ob[d][4 * q] * g0, Ob[d][4 * q + 1] * g0, Ob[d][4 * q + 2] * g0, Ob[d][4 * q + 3] * g0}; }
            __builtin_amdgcn_sched_barrier(0);
            unsigned selbits = 0u;
#pragma unroll
            for (int rd = 0; rd < 8; ++rd) { unsigned mk = kk[0] > kk[1] ? kk[0] : kk[1]; { const unsigned m2 = kk[2] > kk[3] ? kk[2] : kk[3]; mk = m2 > mk ? m2 : mk; }
                { const unsigned o = DPPU(mk, 0xB1); mk = o > mk ? o : mk; } { const unsigned o = DPPU(mk, 0x4E); mk = o > mk ? o : mk; }
                mk = xmax32u(mk);
#pragma unroll
                for (int ta = 0; ta < 4; ++ta) { const bool hit = (kk[ta] == mk) && (mk != 0u); selbits |= hit ? ((1u << (8 * ta)) << hd2) : 0u; kk[ta] = hit ? 0u : kk[ta]; } }
            selbits |= DPPU(selbits, 0xB1); selbits |= DPPU(selbits, 0x4E);
            tokmask = xor32u(selbits);
#undef DPPF
#undef DPPU
            unsigned wm = tokmask; wm |= (unsigned)__shfl_xor((int)wm, 4); wm |= (unsigned)__shfl_xor((int)wm, 8); wm |= (unsigned)__shfl_xor((int)wm, 16);
            wmask = (unsigned)__builtin_amdgcn_readfirstlane((int)wm);
            if (lane == 0) WUN[w] = wmask;
        }
        __syncthreads();
        unsigned uall = 0u;
#pragma unroll
        for (int q = 0; q < 8; ++q) uall |= WUN[q];
        uall = (unsigned)__builtin_amdgcn_readfirstlane((int)uall);
        if (PROBE_MASK & 0x6000000u) { if (lane == 0) ((unsigned*)(F.ws + WS_SLOT + 3 * MAXSLOT * 4))[(blockIdx.x * 2 + ui) * 8 + w] = (unsigned)__builtin_popcount(uall) | ((unsigned)__builtin_popcount(wmask) << 8); }
        float l = 0.f;
#pragma unroll
        for (int d = 0; d < 2; ++d)
#pragma unroll
            for (int i = 0; i < 16; ++i) Ob[d][i] = 0.f;
        const int j0 = cur > 8 ? cur - 8 : 0, nwin = cur - j0 + 1, ntile = nwin + __builtin_popcount(uall);
        const int srow = tid >> 3, sch = tid & 7;
        int lidx = 0, cidx = 0; unsigned lmm = uall, cmm = uall; u32x4 rk0, rv0, rk1, rv1, rk2, rv2;
#define AT_NEXT(idx, mm, wh, jj) do { if ((idx) < nwin) { (wh) = 1; (jj) = j0 + (idx); } else { (wh) = 0; (jj) = (mm) ? __builtin_ctz(mm) : 0; (mm) &= (mm) - 1u; } ++(idx); } while (0)
#define AT_LOAD(rk, rv) do { int _wh, _jj; AT_NEXT(lidx, lmm, _wh, _jj); const bf16_t* _kp = KVb + (size_t)(_wh ? 4 : 2) * KVT + ((size_t)bh * SEQ + _jj * 64) * 64; const bf16_t* _vp = (_wh ? VWT : VST) + (size_t)bh * 64 * SEQ + _jj * 64; \
        rk = *((const u32x4*)_kp + tid); rv = *(const u32x4*)(_vp + (size_t)srow * SEQ + sch * 8); } while (0)
#define AT_WRITE(b, rk, rv) do { *(LAS u32x4*)(lds + (b) * 18432 + srow * 144 + sch * 16) = rk; *(LAS u32x4*)(lds + (b) * 18432 + 9216 + srow * 144 + sch * 16) = rv; } while (0)
        AT_LOAD(rk0, rv0); AT_LOAD(rk1, rv1); AT_LOAD(rk2, rv2);
        AT_WRITE(0, rk0, rv0);
        AT_LOAD(rk0, rv0);
#define AT_STEP(i, RK, RV) do { asm volatile("s_waitcnt lgkmcnt(0)" ::: "memory"); __builtin_amdgcn_s_barrier(); asm volatile("" ::: "memory"); \
            AT_WRITE(((i) + 1) & 1, RK, RV); AT_LOAD(RK, RV); \
            int wh, j; AT_NEXT(cidx, cmm, wh, j); \
            if (i == nwin) { \
                const float lt = xsum32(l), sc = g2 * rcpf_(fmaxf(lt, 1e-30f)); \
_Pragma("unroll") \
                for (int d = 0; d < 2; ++d) \
_Pragma("unroll") \
                    for (int q = 0; q < 4; ++q) { f32x4 o = OT[(4 * d + q) * 64]; o.x += Ob[d][4 * q] * sc; o.y += Ob[d][4 * q + 1] * sc; o.z += Ob[d][4 * q + 2] * sc; o.w += Ob[d][4 * q + 3] * sc; OT[(4 * d + q) * 64] = o; \
                        Ob[d][4 * q] = 0.f; Ob[d][4 * q + 1] = 0.f; Ob[d][4 * q + 2] = 0.f; Ob[d][4 * q + 3] = 0.f; } \
                l = 0.f; } \
            const LAS unsigned char* kb = lds + (i & 1) * 18432; const LAS unsigned char* vb = kb + 9216; \
            const int tl = tt - 64 * j - 4 * h; \
            if (wh) { if (j == cur || j == cur - 8) attn_tile<2>(kb, vb, Qf, Ob, cref, l, tl, j == cur - 8 ? tl - 512 : -100000, true, n, h); else attn_tile<0>(kb, vb, Qf, Ob, cref, l, 0, 0, true, n, h); } \
            else if ((wmask >> j) & 1u) { const bool rowok = ((tokmask >> j) & 1u) != 0u; \
                if (j == cur) attn_tile<2>(kb, vb, Qf, Ob, cref, l, rowok ? tl : -1, -100000, true, n, h); else attn_tile<1>(kb, vb, Qf, Ob, cref, l, 0, 0, rowok, n, h); } \
        } while (0)
#pragma nounroll
        for (int i = 0; i < ntile; i += 3) { AT_STEP(i, rk1, rv1); if (i + 1 >= ntile) break; AT_STEP(i + 1, rk2, rv2); if (i + 2 >= ntile) break; AT_STEP(i + 2, rk0, rv0); }
#undef AT_STEP
#undef AT_NEXT
#undef AT_LOAD
#undef AT_WRITE
        { const float lt = xsum32(l), sc = g1 * rcpf_(fmaxf(lt, 1e-30f));
          bf16_t* op = MIX + r * D + 512 + (kvh * 4 + hd) * 64 + 4 * h;
#pragma unroll
          for (int d = 0; d < 2; ++d)
#pragma unroll
            for (int u = 0; u < 4; ++u) { const f32x4 o = OT[(4 * d + u) * 64]; u32x2 ov; ov.x = pk_bf16(o.x + Ob[d][4 * u] * sc, o.y + Ob[d][4 * u + 1] * sc); ov.y = pk_bf16(o.z + Ob[d][4 * u + 2] * sc, o.w + Ob[d][4 * u + 3] * sc);
                *(u32x2*)(op + 32 * d + 8 * u) = ov; } }
    }
}

__device__ __forceinline__ int build_ptab(Frame& F) {
    LAS int* ptab = (LAS int*)(F.lds + PTAB_OFF);
    const unsigned* cnt = (const unsigned*)(F.ws + WS_CTL) + CW_CNT;
    if (F.tid < 64) {
        const int e = F.tid; const unsigned c = (e < NE) ? __hip_atomic_load(cnt + 64 * e, __ATOMIC_RELAXED, __HIP_MEMORY_SCOPE_AGENT) : 0u;
        const int n = (int)((c + 255u) >> 8); int incl = n;
#pragma unroll
        for (int o = 1; o < 8; o <<= 1) { const int t = __shfl_up(incl, o); if (e >= o) incl += t; }
        const int excl = incl - n;
        if (e < NE) { ptab[MAXPAN + 8 + e] = excl * 256; for (int i = 0; i < n && excl + i < MAXPAN; ++i) ptab[excl + i] = e; }
        if (e == NE - 1) ptab[MAXPAN] = incl < MAXPAN ? incl : MAXPAN; }
    __syncthreads();
    return ptab[MAXPAN];
}

template <unsigned KM> __global__ void __launch_bounds__(NTHR, 2) fwd(Args args) {
    extern __shared__ __attribute__((aligned(16))) unsigned char lds_raw[];
    Frame F; F.lds = (LAS unsigned char*)lds_raw; F.tid = threadIdx.x; F.lane = F.tid & 63; F.wave = __builtin_amdgcn_readfirstlane(F.tid >> 6);
    F.G = gridDim.x; F.c = blockIdx.x; F.in = args.in; F.out = args.out; F.ws = args.ws;
    volatile LAS unsigned* MISC = (volatile LAS unsigned*)(F.lds + MISC_OFF);
    if (F.tid < 64) MISC[F.tid] = 0u;
    __syncthreads();
    unsigned* ctl = (unsigned*)(F.ws + WS_CTL);
#if MK_PER_PHASE
#define SEAM() do {} while (0)
#else
    XcdBarrier bar = xcd_barrier_post(ctl + CW_BAR, MISC);
#define SEAM() xcd_barrier(bar)
#endif
    const int lo = args.ph_lo, hi = args.ph_hi;
#define KON(kind) (((KM) >> (kind)) & 1u)
#define IN(k) (lo <= (k) && (k) < hi)
#define gw (F.c * NWAVES + F.wave)
#define NGW (F.G * NWAVES)
#define XB ((bf16_t*)(F.ws + WS_XB))
#define RS ((float*)(F.ws + WS_RSTD))

    if (KON(0) && IN(0)) { FRESH_TID(F); PMARK(0); phase_prologue(F); SEAM(); }

    for (int layer = 0; layer < 2; ++layer) {
        const int pb = 1 + 12 * layer;
        if (KON(1) && IN(pb + 0)) { FRESH_TID(F); PMARK(pb + 0);
            pg8::Gemm g{XB, (const bf16_t*)(F.ws + WS_WIN) + (size_t)layer * INP * D, D, D, D}; pg8::SchedGrid S; S.init(M / 256, INP / 256, F.G, F.c, D, D);
            EpiIn E{RS, (bf16_t*)(F.ws + WS_U), (bf16_t*)(F.ws + WS_Q), (bf16_t*)(F.ws + WS_KV), (float*)(F.ws + WS_GT), layer ? (const float*)(F.ws + WS_PSS) : nullptr, (LAS float*)(F.lds + RSL_OFF)};
            pg8::gemm_phase(F.lds, g, S, E); moe_conv_slot(F, layer == 0 ? 0 : 2); SEAM();
        }
        if (KON(2) && IN(pb + 1)) { FRESH_TID(F); PMARK(pb + 1);
            { pg8::Gemm g{(const bf16_t*)(F.ws + WS_KV), (const bf16_t*)(F.ws + WS_WC1), 256, 1024, 2048}; SchedCmp S{F.G, F.c, layer};
              EpiH1 E{(float*)(F.ws + WS_H1)}; pg8::gemm_phase(F.lds, g, S, E); }
            if (F.G >= 256) { if (F.c >= 128) vtrans_items(F, (F.c - 128) * NWAVES + F.wave, (F.G - 128) * NWAVES); }
            else vtrans_items(F, gw, NGW);
#ifdef ATTN_REF
            norm_rows64((bf16_t*)(F.ws + WS_Q), M * 8, INP_(I_QG) + layer * 64, 0.125f, gw, NGW, F.lane);
#endif
            norm_rows64((bf16_t*)(F.ws + WS_KV) + 2 * KVT, NBH * SEQ, INP_(I_KG) + layer * 192 + 64, 1.0f, gw, NGW, F.lane);
            norm_rows64((bf16_t*)(F.ws + WS_KV) + 4 * KVT, NBH * SEQ, INP_(I_KG) + layer * 192 + 128, 1.0f, gw, NGW, F.lane);
            SEAM();
        }
        if (KON(3) && IN(pb + 2)) { FRESH_TID(F); PMARK(pb + 2); for (int cu = F.c; cu < 512; cu += F.G) conv_unit(F, layer, cu); PMARK(30); phase_cmp2(F, layer); SEAM(); }
#ifndef ATTN_REF
        if (KON(4) && IN(pb + 3)) { FRESH_TID(F); PMARK(pb + 3); phase_attn_mfma(F, layer); SEAM(); }
#else
        if (KON(4) && IN(pb + 3)) { FRESH_TID(F); PMARK(pb + 3); phase_attn_ref(F, layer); SEAM(); }
#endif
        if (KON(5) && IN(pb + 4)) { FRESH_TID(F); PMARK(pb + 4);
            pg8::Gemm g{(const bf16_t*)(F.ws + WS_MIX), (const bf16_t*)(F.ws + WS_WOUT) + (size_t)layer * D * D, D, D, D}; pg8::SchedGrid S; S.init(M / 256, D / 256, F.G, F.c, D, D);
            { EpiRes<true> E{XB, XB, layer == 0 ? (float*)(F.ws + WS_PSS) : nullptr}; pg8::gemm_phase(F.lds, g, S, E); }
            SEAM();
        }
        if (KON(6) && IN(pb + 5) && layer == 1) { FRESH_TID(F); PMARK(pb + 5);
            f32x4 v[4];
            {
                const float* RT = (const float*)(F.ws + WS_RT); unsigned* cnt = ctl + CW_CNT; int* ROUTE = (int*)(F.ws + WS_ROUTE);
                int* stok = (int*)(F.ws + WS_SLOT);
                const int cb0 = __builtin_amdgcn_readfirstlane((int)blockIdx.x * NTHR);
#pragma nounroll
                for (int i = cb0 + F.tid; i < MAXSLOT; i += F.G * NTHR) stok[i] = -1;
                LAS f32x4* RTL = (LAS f32x4*)F.lds;
                { f32x4 sv[4];
#pragma unroll
                  for (int q = 0; q < 4; ++q) sv[q] = *((const f32x4*)RT + F.tid + q * NTHR);
#pragma unroll
                  for (int q = 0; q < 4; ++q) RTL[F.tid + q * NTHR] = sv[q]; }
                __syncthreads();
#pragma nounroll
                for (int mb0 = 0; mb0 < M; mb0 += 8 * NGW) { const int mb = mb0 + gw;
                    int me0 = -1, me1 = -1; float mw0 = 0.f, mw1 = 0.f;
#pragma nounroll
                    for (int i4 = 0; i4 < 8; i4 += 4) {
                        f32x4 xv[4][4];
#pragma unroll
                        for (int q = 0; q < 4; ++q) { const int m = mb + (i4 + q) * NGW; const u32x2* xr = (const u32x2*)(XB + (size_t)(m < M ? m : 0) * D) + F.lane;
#pragma unroll
                            for (int j = 0; j < 4; ++j) { const u32x2 wv = xr[64 * j]; xv[q][j] = (f32x4){bf_lo(wv.x), bf_hi(wv.x), bf_lo(wv.y), bf_hi(wv.y)}; } }
#pragma unroll
                        for (int q = 0; q < 4; ++q) { const int i = i4 + q, m = mb + i * NGW; if (m >= M) break;
                            f32x2e ss2 = {0.f, 0.f};
#pragma unroll
                            for (int j = 0; j < 4; ++j) { const f32x2e xl = LO2(xv[q][j]), xh = HI2(xv[q][j]); ss2 = __builtin_elementwise_fma(xl, xl, ss2); ss2 = __builtin_elementwise_fma(xh, xh, ss2); }
                            const float rs = rsqf_(wave_sum_u(ss2.x + ss2.y) * (1.0f / D) + EPS);
                            if (F.lane == 0) RS[m] = rs;
                            float lg[8];
#pragma unroll
                            for (int e = 0; e < 8; ++e) { f32x2e sd2 = {0.f, 0.f};
#pragma unroll
                                for (int j = 0; j < 4; ++j) { const f32x4 wv = RTL[e * 256 + 64 * j + F.lane]; sd2 = __builtin_elementwise_fma(LO2(xv[q][j]), LO2(wv), sd2); sd2 = __builtin_elementwise_fma(HI2(xv[q][j]), HI2(wv), sd2); }
                                lg[e] = wave_sum_u(sd2.x + sd2.y); }
                            int e0 = 0; float l0 = lg[0];
#pragma unroll
                            for (int e = 1; e < 8; ++e) if (lg[e] > l0) { l0 = lg[e]; e0 = e; }
                            int e1 = -1; float l1 = -3.0e38f;
#pragma unroll
                            for (int e = 0; e < 8; ++e) if (e != e0 && lg[e] > l1) { l1 = lg[e]; e1 = e; }
                            const float p1 = __expf((l1 - l0) * rs), w0 = rcpf_(1.0f + p1), w1 = p1 * w0;
                            if (F.lane == i) { me0 = e0; me1 = e1; mw0 = w0; mw1 = w1; } } }
                    int r0 = 0, r1 = 0, c_mine = 0; const unsigned long long low = (1ull << F.lane) - 1ull;
#pragma unroll
                    for (int e = 0; e < 8; ++e) { const unsigned long long b0 = __ballot(me0 == e), b1 = __ballot(me1 == e);
                        if (me0 == e) r0 = __popcll(b0 & low) + __popcll(b1 & low); if (me1 == e) r1 = __popcll(b0 & low) + __popcll(b1 & low);
                        if (F.lane == e) c_mine = __popcll(b0) + __popcll(b1); }
                    LAS int* WC = (LAS int*)(F.lds + 32768);
                    if (F.lane < 8) WC[F.wave * 8 + F.lane] = c_mine;
                    __syncthreads();
                    if (F.wave == 0 && F.lane < 8) { int tot = 0;
#pragma unroll
                        for (int ww = 0; ww < 8; ++ww) tot += WC[ww * 8 + F.lane];
                        WC[64 + F.lane] = tot > 0 ? (int)atomicAdd(cnt + 64 * F.lane, (unsigned)tot) : 0; }
                    __syncthreads();
                    int basev = 0;
                    if (F.lane < 8) { basev = WC[64 + F.lane];
#pragma unroll
                        for (int ww = 0; ww < 8; ++ww) basev += (ww < F.wave) ? WC[ww * 8 + F.lane] : 0; }
                    __syncthreads();
                    const int b0v = __shfl(basev, me0 < 0 ? 0 : me0), b1v = __shfl(basev, me1 < 0 ? 0 : me1);
                    if (me0 >= 0) { const int m = mb + F.lane * NGW; int* rp = ROUTE + (size_t)m * 6; rp[0] = me0; rp[1] = b0v + r0; rp[2] = me1; rp[3] = b1v + r1; rp[4] = __float_as_int(mw0); rp[5] = __float_as_int(mw1); }
                }
            }
            SEAM();
        }
        if (layer == 0) {
            if (KON(7) && IN(pb + 6)) { FRESH_TID(F); PMARK(pb + 6);
                pg8::Gemm g{XB, (const bf16_t*)(F.ws + WS_WF1), D, D, D}; pg8::SchedGrid S; S.init(M / 256, 2 * DFF / 256, F.G, F.c, D, D);
                EpiGlu E{RS, (bf16_t*)(F.ws + WS_ACT), DFF, 0, (const float*)(F.ws + WS_PSS), (LAS float*)(F.lds + RSL_OFF)}; pg8::gemm_phase(F.lds, g, S, E); moe_conv_slot(F, 1); SEAM();
            }
            if (KON(8) && IN(pb + 7)) { FRESH_TID(F); PMARK(pb + 7);
                pg8::Gemm g{(const bf16_t*)(F.ws + WS_ACT), (const bf16_t*)(F.ws + WS_WF2), DFF, DFF, DFF}; pg8::SchedGrid S; S.init(M / 256, D / 256, F.G, F.c, DFF, DFF);
                EpiRes<true> E{XB, XB, (float*)(F.ws + WS_PSS)}; pg8::gemm_phase(F.lds, g, S, E); SEAM();
            }
        } else {
            if (KON(10) && IN(pb + 6)) { FRESH_TID(F); PMARK(pb + 6);
                build_ptab(F); const LAS int* ptab = (const LAS int*)(F.lds + PTAB_OFF);
                const int* ROUTE = (const int*)(F.ws + WS_ROUTE); int* stok = (int*)(F.ws + WS_SLOT); float* sw = (float*)(stok + MAXSLOT); float* srs = sw + MAXSLOT; unsigned char* XS8 = F.ws + WS_XS;
#pragma nounroll
                for (int mb = gw; mb < M; mb += 4 * NGW) {
                    int rt[4][6]; u32x4 ra[4], rb[4];
#pragma unroll
                    for (int q = 0; q < 4; ++q) { const int m = mb + q * NGW < M ? mb + q * NGW : 0; const int* rp = ROUTE + (size_t)m * 6;
#pragma unroll
                        for (int z = 0; z < 6; ++z) rt[q][z] = rp[z];
                        const u32x4* src = (const u32x4*)(XB + (size_t)m * D) + F.lane; ra[q] = src[0]; rb[q] = src[64]; }
#pragma unroll
                    for (int q = 0; q < 4; ++q) { const int m = mb + q * NGW; if (m >= M) break;
#pragma unroll
                        for (int k = 0; k < 2; ++k) { const int e = rt[q][2 * k], pos = rt[q][2 * k + 1], slot = ptab[MAXPAN + 8 + e] + pos; unsigned char* drow = XS8 + (size_t)slot * D + 8 * F.lane;
                            *(u32x2*)drow = pk8_fp8(bf_lo(ra[q].x), bf_hi(ra[q].x), bf_lo(ra[q].y), bf_hi(ra[q].y), bf_lo(ra[q].z), bf_hi(ra[q].z), bf_lo(ra[q].w), bf_hi(ra[q].w));
                            *(u32x2*)(drow + 512) = pk8_fp8(bf_lo(rb[q].x), bf_hi(rb[q].x), bf_lo(rb[q].y), bf_hi(rb[q].y), bf_lo(rb[q].z), bf_hi(rb[q].z), bf_lo(rb[q].w), bf_hi(rb[q].w));
                            if (F.lane == 0) { stok[slot] = m * 2 + k; sw[slot] = __int_as_float(rt[q][4 + k]); srs[slot] = RS[m]; } } } }
                SEAM();
            }
            if (KON(11) && IN(pb + 7)) { FRESH_TID(F); PMARK(pb + 7);
                const int npan = build_ptab(F); const MoePlan P = moe_plan(npan, F.G);
                const int* stok = (const int*)(F.ws + WS_SLOT); const float* srs = (const float*)(stok + 2 * MAXSLOT);
                pg8::Gemm8 g{F.ws + WS_XS, F.ws + WS_WM1, D, D, D}; SchedMoe1R S{F.G, F.c, 0, P.N1, 1 << 20, 0, (const LAS int*)(F.lds + PTAB_OFF)};
                EpiGlu8 E{srs, F.ws + WS_ACTM, DFE, 1.0f / MOE_S1};
                pg8::gemm_phase8(F.lds, g, S, E); SEAM();
            }
            if (KON(12) && IN(pb + 8)) { FRESH_TID(F); PMARK(pb + 8);
                const int npan = build_ptab(F); const MoePlan P = moe_plan(npan, F.G);
                const int* stok = (const int*)(F.ws + WS_SLOT); const float* sw = (const float*)(stok + MAXSLOT); const float* srs = (const float*)(stok + 2 * MAXSLOT);
                { pg8::Gemm8 g{F.ws + WS_ACTM, F.ws + WS_WM2, DFE, DFE, DFE}; SchedMoe2R S{F.G, F.c, 0, P.PA, (const LAS int*)(F.lds + PTAB_OFF)};
                  EpiMoe2 E{stok, sw, (bf16_t*)(F.ws + WS_Y0), (bf16_t*)(F.ws + WS_Y1), 0, 1.0f / MOE_S2}; pg8::gemm_phase8(F.lds, g, S, E); }
                if (P.N1 < P.nup) { pg8::Gemm8 g{F.ws + WS_XS, F.ws + WS_WM1, D, D, D}; SchedMoe1R S{F.G, F.c, P.N1, P.nup, P.qa, P.n2, (const LAS int*)(F.lds + PTAB_OFF)};
                  EpiGlu8 E{srs, F.ws + WS_ACTM, DFE, 1.0f / MOE_S1}; pg8::gemm_phase8(F.lds, g, S, E); }
                SEAM();
            }
            if (KON(12) && IN(pb + 9)) { FRESH_TID(F); PMARK(pb + 9);
                const int npan = build_ptab(F); const MoePlan P = moe_plan(npan, F.G);
                const int* stok = (const int*)(F.ws + WS_SLOT); const float* sw = (const float*)(stok + MAXSLOT);
                if (P.PA < npan) { pg8::Gemm8 g{F.ws + WS_ACTM, F.ws + WS_WM2, DFE, DFE, DFE}; SchedMoe2R S{F.G, F.c, P.PA, npan - P.PA, (const LAS int*)(F.lds + PTAB_OFF)};
                  EpiMoe2 E{stok, sw, (bf16_t*)(F.ws + WS_Y0), (bf16_t*)(F.ws + WS_Y1), 0, 1.0f / MOE_S2}; pg8::gemm_phase8(F.lds, g, S, E); }
                SEAM();
            }
            if (KON(13) && IN(pb + 11)) { FRESH_TID(F); PMARK(pb + 11);
                const bf16_t* Y0 = (const bf16_t*)(F.ws + WS_Y0); const bf16_t* Y1 = (const bf16_t*)(F.ws + WS_Y1);
#pragma nounroll
                for (int mb = gw; mb < M; mb += 2 * NGW) { f32x4 x[2][4]; u32x2 ya[2][4], yb[2][4];
#pragma unroll
                    for (int q = 0; q < 2; ++q) { const int m = mb + q * NGW < M ? mb + q * NGW : 0; const u32x2* xr = (const u32x2*)(XB + (size_t)m * D) + F.lane; const u32x2* y0 = (const u32x2*)(Y0 + (size_t)m * D) + F.lane; const u32x2* y1 = (const u32x2*)(Y1 + (size_t)m * D) + F.lane;
#pragma unroll
                        for (int j = 0; j < 4; ++j) { const u32x2 wv = xr[64 * j]; x[q][j] = (f32x4){bf_lo(wv.x), bf_hi(wv.x), bf_lo(wv.y), bf_hi(wv.y)}; ya[q][j] = y0[64 * j]; yb[q][j] = y1[64 * j]; } }
#pragma unroll
                    for (int q = 0; q < 2; ++q) { const int m = mb + q * NGW; if (m >= M) break; f32x4* xr = (f32x4*)(F.out + (size_t)m * D) + F.lane;
#pragma unroll
                        for (int j = 0; j < 4; ++j) { f32x4 o = x[q][j]; const u32x2 a = ya[q][j], b2 = yb[q][j];
                            o.x += bf_lo(a.x) + bf_lo(b2.x); o.y += bf_hi(a.x) + bf_hi(b2.x); o.z += bf_lo(a.y) + bf_lo(b2.y); o.w += bf_hi(a.y) + bf_hi(b2.y); xr[64 * j] = o; } } }
            }
        }
    }
#undef gw
#undef NGW
#undef XB
#undef RS
    PMARK(99);
    if ((PROBE_MASK & 0x6000000u) && blockIdx.x == 0 && threadIdx.x == 0) { const unsigned* st = (const unsigned*)(F.ws + WS_SLOT + 3 * MAXSLOT * 4); unsigned long long tot = 0; for (int i = 0; i < 512 * 8; ++i) { const unsigned v = st[i]; tot += (PROBE_MASK & 0x2000000u) ? (v & 255u) : (v >> 8); }
        *(volatile LAS unsigned long long*)(F.lds + MISC_OFF + 160) += tot * 25ull / 4096ull * 10ull; }
    if (PROBE_MASK != 0u && blockIdx.x == 0 && threadIdx.x == 0) { const unsigned long long acc = *(volatile LAS unsigned long long*)(F.lds + MISC_OFF + 160), t1 = __builtin_amdgcn_s_memrealtime() + 4ull * acc; while (__builtin_amdgcn_s_memrealtime() < t1) __builtin_amdgcn_s_sleep(8); }
#undef IN
}

constexpr int NPHASE = 25;
template <unsigned KM> static bool setup_kernel(int& per_cu) {
    if (hipFuncSetAttribute((const void*)fwd<KM>, hipFuncAttributeMaxDynamicSharedMemorySize, LDS_BYTES) != hipSuccess) return false;
    if (hipOccupancyMaxActiveBlocksPerMultiprocessor(&per_cu, (const void*)fwd<KM>, NTHR, LDS_BYTES) != hipSuccess) per_cu = 0;
    (void)hipGetLastError(); return true;
}
template <unsigned KM> static void launch_kind(int grid, const Args& a, hipStream_t stream) { hipLaunchKernelGGL(fwd<KM>, dim3(grid), dim3(NTHR), LDS_BYTES, stream, a); }
extern "C" void kernel_launch(void* const* d_in, const int* in_sizes, int n_in, void* d_out, int out_size, void* d_ws, size_t ws_size, hipStream_t stream) {
    static int grid = 0;
    if (grid == 0) {
        if (n_in != 28 || in_sizes[0] != M * D || out_size != M * D || ws_size < WS_END) { fprintf(stderr, "kernel_launch: unexpected shapes / workspace (n_in %d, ws %zu, need %zu)\n", n_in, ws_size, (size_t)WS_END); grid = -1; return; }
        int dev = 0, cus = 0, per_cu = 0; bool ok = true;
        if (hipGetDevice(&dev) != hipSuccess || hipDeviceGetAttribute(&cus, hipDeviceAttributeMultiprocessorCount, dev) != hipSuccess) { grid = -1; return; }
#if MK_PER_PHASE
        ok = ok && setup_kernel<1u << 0>(per_cu) && setup_kernel<1u << 1>(per_cu) && setup_kernel<1u << 2>(per_cu) && setup_kernel<1u << 3>(per_cu) && setup_kernel<1u << 4>(per_cu) && setup_kernel<1u << 5>(per_cu) && setup_kernel<1u << 6>(per_cu)
             && setup_kernel<1u << 7>(per_cu) && setup_kernel<1u << 8>(per_cu) && setup_kernel<1u << 9>(per_cu) && setup_kernel<1u << 10>(per_cu) && setup_kernel<1u << 11>(per_cu) && setup_kernel<1u << 12>(per_cu) && setup_kernel<1u << 13>(per_cu);
#else
        ok = ok && setup_kernel<0xffffffffu>(per_cu);
#endif
        if (!ok) { fprintf(stderr, "kernel_launch: hipFuncSetAttribute failed\n"); grid = -1; return; }
        if (per_cu < 1) fprintf(stderr, "kernel_launch: occupancy query says %d\n", per_cu);
        grid = cus;
    }
    if (grid < 0) return;
    (void)hipMemsetAsync((char*)d_ws + WS_CTL, 0, CTL_BYTES, stream);
    Args a{};
    for (int i = 0; i < 28; ++i) a.in[i] = (const float*)d_in[i];
    a.out = (float*)d_out; a.ws = (unsigned char*)d_ws;
#if MK_PER_PHASE
    static const int phases[] = {0, 1, 2, 3, 4, 5, 7, 8, 13, 14, 15, 16, 17, 18, 19, 20, 21, 24};
    static const int kinds[]  = {0, 1, 2, 3, 4, 5, 7, 8,  1,  2,  3,  4,  5,  6, 10, 11, 12, 13};
    for (int i = 0; i < (int)(sizeof(phases) / sizeof(int)); ++i) { a.ph_lo = phases[i]; a.ph_hi = phases[i] + 1;
        switch (kinds[i]) {
            case 0: launch_kind<1u << 0>(grid, a, stream); break; case 1: launch_kind<1u << 1>(grid, a, stream); break; case 2: launch_kind<1u << 2>(grid, a, stream); break;
            case 3: launch_kind<1u << 3>(grid, a, stream); break; case 4: launch_kind<1u << 4>(grid, a, stream); break; case 5: launch_kind<1u << 5>(grid, a, stream); break;
            case 6: launch_kind<1u << 6>(grid, a, stream); break; case 7: launch_kind<1u << 7>(grid, a, stream); break; case 8: launch_kind<1u << 8>(grid, a, stream); break;
            case 9: launch_kind<1u << 9>(grid, a, stream); break; case 10: launch_kind<1u << 10>(grid, a, stream); break; case 11: launch_kind<1u << 11>(grid, a, stream); break;
            case 12: launch_kind<1u << 12>(grid, a, stream); break; default: launch_kind<1u << 13>(grid, a, stream); break; } }
#else
    a.ph_lo = 0; a.ph_hi = NPHASE; launch_kind<0xffffffffu>(grid, a, stream);
#endif
}
```

```cpp
#include <hip/hip_runtime.h>
#include <cstdio>
#include <cstdint>

#ifndef MK_PER_PHASE
#define MK_PER_PHASE 0
#endif

#ifndef PROBE_MASK
#define PROBE_MASK 0u
#endif
#define LAS __attribute__((address_space(3)))
typedef unsigned short bf16_t;
typedef short bf16x8 __attribute__((ext_vector_type(8)));
typedef float f32x4 __attribute__((ext_vector_type(4)));
typedef float f32x2 __attribute__((ext_vector_type(2)));
typedef unsigned u32x4 __attribute__((ext_vector_type(4)));
typedef unsigned u32x2 __attribute__((ext_vector_type(2)));

constexpr int D = 1024, NB = 8, SEQ = 2048, M = NB * SEQ;
constexpr int INW = 2328, INP = 2560;
constexpr int CW = 512, CKW = 31, DH = 64, NKV = 2, NBH = NB * NKV;
constexpr int NCMP = 127, CHID = 256;
constexpr int DFF = 2816, NE = 8, DFE = 3584;
constexpr int MAXPAN = 136, MAXSLOT = MAXPAN * 256, CHUNKP = 72;
constexpr float EPS = 1e-6f;

constexpr size_t MiB = 1u << 20;
constexpr size_t WS_CTL = 0, CTL_BYTES = 2 * MiB;
constexpr size_t WS_H1 = 342 * MiB;
constexpr size_t WS_WIN = 12 * MiB;
constexpr size_t WS_WC1 = 22 * MiB;
constexpr size_t WS_WOUT = 26 * MiB;
constexpr size_t WS_WF1 = 30 * MiB;
constexpr size_t WS_WF2 = 41 * MiB;
constexpr size_t WS_RT = 47 * MiB;
constexpr size_t WS_WM1 = 48 * MiB;
constexpr size_t WS_WM2 = 160 * MiB;
constexpr size_t WS_XB = 216 * MiB;
constexpr size_t WS_RSTD = 248 * MiB;
constexpr size_t WS_GT = WS_RSTD + 65536;
constexpr size_t WS_ROUTE = WS_GT + (size_t)M * 24 * 4;
constexpr size_t WS_PSS = 250 * MiB;
constexpr size_t WS_KC = 251 * MiB;
constexpr size_t WS_VC = WS_KC + 262144;
constexpr size_t WS_VCT = WS_KC + 524288;
constexpr size_t WS_VST = 2 * MiB, WS_VWT = 6 * MiB;
constexpr size_t WS_U = 252 * MiB;
constexpr size_t WS_Q = 268 * MiB;
constexpr size_t WS_KV = 284 * MiB;
constexpr size_t KVT = (size_t)NBH * SEQ * DH;
constexpr size_t WS_MIX = 310 * MiB;
constexpr size_t WS_ACT = 342 * MiB;
constexpr size_t WS_XS = 252 * MiB;
constexpr size_t WS_ACTM = 320 * MiB;
constexpr size_t WS_SLOT = 447 * MiB;
constexpr size_t WS_Y0 = 288 * MiB, WS_Y1 = 12 * MiB;
constexpr size_t WS_END = 448 * MiB;
constexpr int CW_BAR = 4096;
constexpr int CW_CNT = 8192;
constexpr int CW_B1P = 16384;

__device__ __forceinline__ unsigned cvt_pk_bf16(float lo, float hi) { unsigned r; asm volatile("v_cvt_pk_bf16_f32 %0, %1, %2" : "=v"(r) : "v"(lo), "v"(hi)); return r; }
__device__ __forceinline__ float bf_lo(unsigned v) { return __uint_as_float(v << 16); }
__device__ __forceinline__ float bf_hi(unsigned v) { return __uint_as_float(v & 0xffff0000u); }
__device__ __forceinline__ float bf2f(bf16_t v) { return __uint_as_float((unsigned)v << 16); }
__device__ __forceinline__ float rcpf_(float x) { return __builtin_amdgcn_rcpf(x); }
__device__ __forceinline__ float rsqf_(float x) { return __builtin_amdgcn_rsqf(x); }
__device__ __forceinline__ float sigmoidf_(float x) { return rcpf_(1.0f + __expf(-x)); }
__device__ __forceinline__ float siluf_(float x) { return x * sigmoidf_(x); }
typedef float f32x2e __attribute__((ext_vector_type(2)));
__device__ __forceinline__ f32x2e glu2_(f32x2e g, f32x2e u, f32x2e nrs, f32x2e rs2) {
    f32x2e e = g * nrs; e.x = __builtin_amdgcn_exp2f(e.x); e.y = __builtin_amdgcn_exp2f(e.y);
    f32x2e d = e + (f32x2e){1.0f, 1.0f}; d.x = __builtin_amdgcn_rcpf(d.x); d.y = __builtin_amdgcn_rcpf(d.y);
    return ((g * u) * rs2) * d; }
__device__ __forceinline__ f32x2e glus2_(f32x2e v, f32x2e g, f32x2e nrs, f32x2e rs1) {
    f32x2e e = g * nrs; e.x = __builtin_amdgcn_exp2f(e.x); e.y = __builtin_amdgcn_exp2f(e.y);
    f32x2e d = e + (f32x2e){1.0f, 1.0f}; d.x = __builtin_amdgcn_rcpf(d.x); d.y = __builtin_amdgcn_rcpf(d.y);
    return (v * rs1) * d; }
#define LO2(v) ((f32x2e){(v)[0], (v)[1]})
#define HI2(v) ((f32x2e){(v)[2], (v)[3]})
__device__ __forceinline__ float wave_sum(float v) {
#pragma unroll
    for (int o = 1; o < 64; o <<= 1) v += __shfl_xor(v, o);
    return v;
}
#define DPP_ADD(v, ctrl) ((v) + __builtin_bit_cast(float, __builtin_amdgcn_update_dpp(0, __builtin_bit_cast(int, (v)), (ctrl), 0xF, 0xF, true)))
__device__ __forceinline__ float wave_sum_u(float v) {
    v = DPP_ADD(v, 0xB1); v = DPP_ADD(v, 0x4E); v = DPP_ADD(v, 0x124); v = DPP_ADD(v, 0x128);
    const int b = __builtin_bit_cast(int, v);
    return (__builtin_bit_cast(float, __builtin_amdgcn_readlane(b, 0)) + __builtin_bit_cast(float, __builtin_amdgcn_readlane(b, 16))) + (__builtin_bit_cast(float, __builtin_amdgcn_readlane(b, 32)) + __builtin_bit_cast(float, __builtin_amdgcn_readlane(b, 48)));
}
typedef unsigned u32x2s __attribute__((ext_vector_type(2)));
__device__ __forceinline__ float xsum32(float v) { const unsigned b = __float_as_uint(v); const auto r = __builtin_amdgcn_permlane32_swap(b, b, false, false); return __uint_as_float(r[0]) + __uint_as_float(r[1]); }
__device__ __forceinline__ unsigned xmax32u(unsigned v) { const auto r = __builtin_amdgcn_permlane32_swap(v, v, false, false); return r[0] > r[1] ? r[0] : r[1]; }
__device__ __forceinline__ unsigned xor32u(unsigned v) { const auto r = __builtin_amdgcn_permlane32_swap(v, v, false, false); return r[0] | r[1]; }
__device__ __forceinline__ float xget32(float v, int h) { const unsigned b = __float_as_uint(v); const auto r = __builtin_amdgcn_permlane32_swap(b, b, false, false); return __uint_as_float(h ? r[0] : r[1]); }
__device__ __forceinline__ float wave_max(float v) {
#pragma unroll
    for (int o = 1; o < 64; o <<= 1) v = fmaxf(v, __shfl_xor(v, o));
    return v;
}
#define LDS_WAIT() asm volatile("s_waitcnt lgkmcnt(0)" ::: "memory")
typedef float f32x16 __attribute__((ext_vector_type(16)));
typedef __bf16 bf16v2 __attribute__((ext_vector_type(2)));
#define MFMA32(a, b, c) __builtin_amdgcn_mfma_f32_32x32x16_bf16((a), (b), (c), 0, 0, 0)
__device__ __forceinline__ unsigned pk_bf16(float lo, float hi) { const f32x2 v = {lo, hi}; return __builtin_bit_cast(unsigned, __builtin_convertvector(v, bf16v2)); }
template <int S8> __device__ __forceinline__ bf16x8 pack8(const f32x16& p) { u32x4 w; w.x = pk_bf16(p[S8], p[S8 + 1]); w.y = pk_bf16(p[S8 + 2], p[S8 + 3]); w.z = pk_bf16(p[S8 + 4], p[S8 + 5]); w.w = pk_bf16(p[S8 + 6], p[S8 + 7]); return __builtin_bit_cast(bf16x8, w); }
__device__ __forceinline__ u32x2 pk8_fp8(float a0, float a1, float a2, float a3, float a4, float a5, float a6, float a7) {
    int w0 = 0, w1 = 0; w0 = __builtin_amdgcn_cvt_pk_fp8_f32(a0, a1, w0, false); w0 = __builtin_amdgcn_cvt_pk_fp8_f32(a2, a3, w0, true);
    w1 = __builtin_amdgcn_cvt_pk_fp8_f32(a4, a5, w1, false); w1 = __builtin_amdgcn_cvt_pk_fp8_f32(a6, a7, w1, true); return (u32x2){(unsigned)w0, (unsigned)w1}; }
__device__ __forceinline__ int swap23(int v) { return (v & ~12) | ((v & 4) << 1) | ((v & 8) >> 1); }

namespace pg8 {
constexpr int BM = 256, BK = 64, HALF = 128, HTB = HALF * BK * 2, STAGE_BYTES = 8 * HTB, NXCD = 8, WGM = 8;
__device__ __forceinline__ int lds_byte(int r, int c) { const int st = (r >> 4) * 2 + (c >> 5), rr = r & 15, cc = c & 31, ob = rr * 64 + cc * 2; return st * 1024 + (ob ^ (((ob >> 9) & 1) << 5)); }
__device__ __forceinline__ void stage_rc(int b, int& R, int& C) { const int st = b / 1024, sb = b % 1024, swz = sb ^ (((sb >> 9) & 1) << 5); R = (st >> 1) * 16 + swz / 64; C = (st & 1) * 32 + (swz % 64) / 2; }
__device__ __forceinline__ int perm32(int rho) { const int n = rho >> 4, i = rho & 15; return 8 * (i >> 2) + 4 * n + (i & 3); }

struct Unit { int pm, pn; size_t aoff, boff; };
struct Gemm { const bf16_t* A; const bf16_t* Bt; int K, lda, ldb; };

struct SchedGrid {
    int nM, nN, nwg, G, c; size_t astr, bstr;
    __device__ __forceinline__ void init(int nM_, int nN_, int G_, int c_, int lda, int ldb) { nM = nM_; nN = nN_; nwg = nM * nN; G = G_; c = c_; astr = (size_t)BM * lda * 2; bstr = (size_t)BM * ldb * 2; }
    __device__ __forceinline__ bool next(int i, Unit& u) const {
        const long L = (long)i * G + c; if (L >= nwg) return false;
        int wgid = (int)L; { const int q = nwg / NXCD, r = nwg % NXCD, xcd = wgid % NXCD, off = wgid / NXCD; wgid = (xcd < r ? xcd * (q + 1) : r * (q + 1) + (xcd - r) * q) + off; }
        const int nig = WGM * nN, gid = wgid / nig, fm = gid * WGM, gsz = (nM - fm) < WGM ? (nM - fm) : WGM;
        u.pm = fm + ((wgid % nig) % gsz); u.pn = (wgid % nig) / gsz; u.aoff = (size_t)u.pm * astr; u.boff = (size_t)u.pn * bstr; return true;
    }
};

template <class Epi, class Sched>
__device__ __forceinline__ void gemm_phase(LAS unsigned char* lds, const Gemm g, const Sched& S, const Epi& E) {
    int tid = threadIdx.x; asm volatile("" : "+v"(tid));
    const int wid = __builtin_amdgcn_readfirstlane(tid >> 6), lane = tid & 63, wr = wid >> 2, wc = wid & 3, fr = lane & 15, fq = lane >> 4;
    const int K = g.K, nt = K / BK;
    unsigned voffA[2], voffB[2];
#pragma unroll
    for (int i = 0; i < 2; ++i) { int R, C; stage_rc(tid * 16 + i * 8192, R, C); const int Rb = Epi::PERM ? ((R & ~31) + perm32(R & 31)) : R;
        voffA[i] = (unsigned)(R * g.lda + C) * 2u; voffB[i] = (unsigned)(Rb * g.ldb + C) * 2u; }
    const size_t kstep = (size_t)(BK * 2);
    const size_t hstepA = (size_t)HALF * g.lda * 2, hstepB = (size_t)HALF * g.ldb * 2;
    const unsigned ldsw = (unsigned)wid * 1024u;
    const int aoff = lds_byte(wr * 64 + fr, fq * 8), boff = lds_byte(wc * 32 + fr, fq * 8);
#define PG8_SA(b, h) (((b) * 2 + (h)) * HTB)
#define PG8_SB(b, h) ((4 + (b) * 2 + (h)) * HTB)
#define PG8_STAGE(bufoff, gbase, voff) do { _Pragma("unroll") for (int _i = 0; _i < 2; ++_i) \
        __builtin_amdgcn_global_load_lds((const unsigned*)((const char*)(gbase) + (voff)[_i]), (LAS unsigned*)(lds + (bufoff) + ldsw + _i * 8192), 16, 0, 0); } while (0)
#define PG8_LDA(dst, b, h) do { _Pragma("unroll") for (int m = 0; m < 4; ++m) _Pragma("unroll") for (int k = 0; k < 2; ++k) dst[m][k] = *(const LAS bf16x8*)(lds + PG8_SA(b, h) + aoff + m * 2048 + k * 1024); } while (0)
#define PG8_LDB(dst, b, h) do { _Pragma("unroll") for (int n = 0; n < 2; ++n) _Pragma("unroll") for (int k = 0; k < 2; ++k) dst[n][k] = *(const LAS bf16x8*)(lds + PG8_SB(b, h) + boff + n * 2048 + k * 1024); } while (0)
#define PG8_MMA(ai, bj, At, Bt) do { __builtin_amdgcn_s_setprio(1); _Pragma("unroll") for (int m = 0; m < 4; ++m) _Pragma("unroll") for (int n = 0; n < 2; ++n) _Pragma("unroll") for (int k = 0; k < 2; ++k) \
        acc[ai][bj][m][n] = __builtin_amdgcn_mfma_f32_16x16x32_bf16(Bt[n][k], At[m][k], acc[ai][bj][m][n], 0, 0, 0); __builtin_amdgcn_s_setprio(0); } while (0)
#define PG8_WAIT_V(n) asm volatile("s_waitcnt vmcnt(" #n ")" ::: "memory")
#define PG8_WAIT_L(n) asm volatile("s_waitcnt lgkmcnt(" #n ")" ::: "memory")
#define PG8_BAR __builtin_amdgcn_s_barrier()
#define PG8_SCHED __builtin_amdgcn_sched_barrier(0)
    Unit cur, nxt; int ui = 0;
    if (!S.next(0, cur)) return;
    f32x4 acc[2][2][4][2];
#pragma unroll
    for (int a = 0; a < 2; ++a)
#pragma unroll
        for (int b = 0; b < 2; ++b)
#pragma unroll
            for (int m = 0; m < 4; ++m)
#pragma unroll
                for (int n = 0; n < 2; ++n) acc[a][b][m][n] = (f32x4){0.f, 0.f, 0.f, 0.f};
    bf16x8 At[4][2], B0[2][2], B1[2][2];
    const char* cA = (const char*)g.A + cur.aoff; const char* cB = (const char*)g.Bt + cur.boff;
    typename Epi::Pre pre; E.prefetch(cur, wr, fr, pre);
    PG8_STAGE(PG8_SB(0, 0), cB, voffB); PG8_STAGE(PG8_SA(0, 0), cA, voffA); PG8_STAGE(PG8_SB(0, 1), cB + hstepB, voffB); PG8_STAGE(PG8_SA(0, 1), cA + hstepA, voffA);
    if (wr == 1) PG8_BAR;
    PG8_WAIT_V(4); PG8_BAR;
    PG8_STAGE(PG8_SB(1, 0), cB + kstep, voffB); PG8_STAGE(PG8_SA(1, 0), cA + kstep, voffA); PG8_STAGE(PG8_SB(1, 1), cB + hstepB + kstep, voffB);
    PG8_WAIT_V(6); PG8_BAR;
    for (;;) {
        const bool has_next = S.next(ui + 1, nxt);
        const char* nA = has_next ? (const char*)g.A + nxt.aoff : cA; const char* nB = has_next ? (const char*)g.Bt + nxt.boff : cB;
#pragma nounroll
        for (int t = 0; t < nt; t += 2) {
            const bool last = (t == nt - 2);
            const char* a1 = cA + (size_t)(t + 1) * kstep;
            const char* a2 = last ? nA : cA + (size_t)(t + 2) * kstep; const char* b2 = last ? nB : cB + (size_t)(t + 2) * kstep;
            const char* a3 = a2 + kstep; const char* b3 = b2 + kstep;
            PG8_LDB(B0, 0, 0); PG8_SCHED; PG8_LDA(At, 0, 0); PG8_STAGE(PG8_SA(1, 1), a1 + hstepA, voffA);
            PG8_WAIT_L(8); PG8_BAR; PG8_WAIT_L(0); PG8_MMA(0, 0, At, B0); PG8_BAR; PG8_SCHED;
            PG8_LDB(B1, 0, 1); PG8_STAGE(PG8_SB(0, 0), b2, voffB);
            PG8_BAR; PG8_WAIT_L(0); PG8_MMA(0, 1, At, B1); PG8_BAR;
            PG8_LDA(At, 0, 1); PG8_STAGE(PG8_SA(0, 0), a2, voffA);
            PG8_BAR; PG8_WAIT_L(0); PG8_MMA(1, 0, At, B0); PG8_BAR; PG8_SCHED;
            PG8_STAGE(PG8_SB(0, 1), b2 + hstepB, voffB);
            PG8_WAIT_V(6); PG8_BAR; PG8_MMA(1, 1, At, B1); PG8_BAR;
            PG8_LDB(B0, 1, 0); PG8_SCHED; PG8_LDA(At, 1, 0); PG8_STAGE(PG8_SA(0, 1), a2 + hstepA, voffA);
            PG8_WAIT_L(8); PG8_BAR; PG8_WAIT_L(0); PG8_MMA(0, 0, At, B0); PG8_BAR; PG8_SCHED;
            PG8_LDB(B1, 1, 1); PG8_STAGE(PG8_SB(1, 0), b3, voffB);
            PG8_BAR; PG8_WAIT_L(0); PG8_MMA(0, 1, At, B1); PG8_BAR;
            PG8_LDA(At, 1, 1); PG8_STAGE(PG8_SA(1, 0), a3, voffA);
            PG8_BAR; PG8_WAIT_L(0); PG8_MMA(1, 0, At, B0); PG8_BAR; PG8_SCHED;
            PG8_STAGE(PG8_SB(1, 1), b3 + hstepB, voffB);
            PG8_WAIT_V(6); PG8_BAR; PG8_MMA(1, 1, At, B1); PG8_BAR;
        }
        E(acc, cur, wr, wc, fr, fq, pre);
        if (!has_next) break;
        E.prefetch(nxt, wr, fr, pre);
#pragma unroll
        for (int a = 0; a < 2; ++a)
#pragma unroll
            for (int b = 0; b < 2; ++b)
#pragma unroll
                for (int m = 0; m < 4; ++m)
#pragma unroll
                    for (int n = 0; n < 2; ++n) acc[a][b][m][n] = (f32x4){0.f, 0.f, 0.f, 0.f};
        cur = nxt; cA = nA; cB = nB; ++ui;
    }
    PG8_WAIT_V(0);
    if (wr == 0) PG8_BAR;
    PG8_BAR;
#undef PG8_SA
#undef PG8_SB
#undef PG8_STAGE
#undef PG8_LDA
#undef PG8_LDB
#undef PG8_MMA
#undef PG8_WAIT_V
#undef PG8_WAIT_L
#undef PG8_BAR
#undef PG8_SCHED
}
struct Gemm8 { const unsigned char* A; const unsigned char* Bt; int K, lda, ldb; };
typedef int i32x4 __attribute__((ext_vector_type(4)));
typedef int i32x8 __attribute__((ext_vector_type(8)));
template <class Epi, class Sched>
__device__ __forceinline__ void gemm_phase8(LAS unsigned char* lds, const Gemm8 g, const Sched& S, const Epi& E) {
    int tid = threadIdx.x; asm volatile("" : "+v"(tid));
    const int wid = __builtin_amdgcn_readfirstlane(tid >> 6), lane = tid & 63, wr = wid >> 2, wc = wid & 3, fr = lane & 15, fq = lane >> 4;
    const int nt = g.K / 128;
    unsigned voffA[2], voffB[2];
#pragma unroll
    for (int i = 0; i < 2; ++i) { int R, C; stage_rc(tid * 16 + i * 8192, R, C); const int Rb = Epi::PERM ? ((R & ~31) + perm32(R & 31)) : R;
        voffA[i] = (unsigned)(R * g.lda + C * 2); voffB[i] = (unsigned)(Rb * g.ldb + C * 2); }
    const size_t kstep = (size_t)(BK * 2);
    const size_t hstepA = (size_t)HALF * g.lda, hstepB = (size_t)HALF * g.ldb;
    const unsigned ldsw = (unsigned)wid * 1024u;
    const int aoff = lds_byte(wr * 64 + fr, fq * 8), boff = lds_byte(wc * 32 + fr, fq * 8);
#define PG8_SA(b, h) (((b) * 2 + (h)) * HTB)
#define PG8_SB(b, h) ((4 + (b) * 2 + (h)) * HTB)
#define PG8_STAGE(bufoff, gbase, voff) do { _Pragma("unroll") for (int _i = 0; _i < 2; ++_i) \
        __builtin_amdgcn_global_load_lds((const unsigned*)((const char*)(gbase) + (voff)[_i]), (LAS unsigned*)(lds + (bufoff) + ldsw + _i * 8192), 16, 0, 0); } while (0)
#define PG8_LDA(dst, b, h) do { _Pragma("unroll") for (int m = 0; m < 4; ++m) { const i32x4 _l = *(const LAS i32x4*)(lds + PG8_SA(b, h) + aoff + m * 2048), _h = *(const LAS i32x4*)(lds + PG8_SA(b, h) + aoff + m * 2048 + 1024); dst[m] = __builtin_shufflevector(_l, _h, 0, 1, 2, 3, 4, 5, 6, 7); } } while (0)
#define PG8_LDB(dst, b, h) do { _Pragma("unroll") for (int n = 0; n < 2; ++n) { const i32x4 _l = *(const LAS i32x4*)(lds + PG8_SB(b, h) + boff + n * 2048), _h = *(const LAS i32x4*)(lds + PG8_SB(b, h) + boff + n * 2048 + 1024); dst[n] = __builtin_shufflevector(_l, _h, 0, 1, 2, 3, 4, 5, 6, 7); } } while (0)
#define PG8_MMA(ai, bj, At, Bt) do { __builtin_amdgcn_s_setprio(1); _Pragma("unroll") for (int m = 0; m < 4; ++m) _Pragma("unroll") for (int n = 0; n < 2; ++n) \
        asm volatile("v_mfma_f32_16x16x128_f8f6f4 %0, %1, %2, %0" : "+v"(acc[ai][bj][m][n]) : "v"(Bt[n]), "v"(At[m])); __builtin_amdgcn_s_setprio(0); } while (0)
#define PG8_WAIT_V(n) asm volatile("s_waitcnt vmcnt(" #n ")" ::: "memory")
#define PG8_WAIT_L(n) asm volatile("s_waitcnt lgkmcnt(" #n ")" ::: "memory")
#define PG8_BAR __builtin_amdgcn_s_barrier()
#define PG8_SCHED __builtin_amdgcn_sched_barrier(0)
    Unit cur, nxt; int ui = 0;
    if (!S.next(0, cur)) return;
    f32x4 acc[2][2][4][2];
#pragma unroll
    for (int a = 0; a < 2; ++a)
#pragma unroll
        for (int b = 0; b < 2; ++b)
#pragma unroll
            for (int m = 0; m < 4; ++m)
#pragma unroll
                for (int n = 0; n < 2; ++n) acc[a][b][m][n] = (f32x4){0.f, 0.f, 0.f, 0.f};
    i32x8 At[4], B0[2], B1[2];
    const char* cA = (const char*)g.A + cur.aoff; const char* cB = (const char*)g.Bt + cur.boff;
    typename Epi::Pre pre; E.prefetch(cur, wr, fr, pre);
    PG8_STAGE(PG8_SB(0, 0), cB, voffB); PG8_STAGE(PG8_SA(0, 0), cA, voffA); PG8_STAGE(PG8_SB(0, 1), cB + hstepB, voffB); PG8_STAGE(PG8_SA(0, 1), cA + hstepA, voffA);
    if (wr == 1) PG8_BAR;
    PG8_WAIT_V(4); PG8_BAR;
    PG8_STAGE(PG8_SB(1, 0), cB + kstep, voffB); PG8_STAGE(PG8_SA(1, 0), cA + kstep, voffA); PG8_STAGE(PG8_SB(1, 1), cB + hstepB + kstep, voffB);
    PG8_WAIT_V(6); PG8_BAR;
    for (;;) {
        const bool has_next = S.next(ui + 1, nxt);
        const char* nA = has_next ? (const char*)g.A + nxt.aoff : cA; const char* nB = has_next ? (const char*)g.Bt + nxt.boff : cB;
#pragma nounroll
        for (int t = 0; t < nt; t += 2) {
            const bool last = (t == nt - 2);
            const char* a1 = cA + (size_t)(t + 1) * kstep;
            const char* a2 = last ? nA : cA + (size_t)(t + 2) * kstep; const char* b2 = last ? nB : cB + (size_t)(t + 2) * kstep;
            const char* a3 = a2 + kstep; const char* b3 = b2 + kstep;
            PG8_LDB(B0, 0, 0); PG8_SCHED; PG8_LDA(At, 0, 0); PG8_STAGE(PG8_SA(1, 1), a1 + hstepA, voffA);
            PG8_WAIT_L(8); PG8_BAR; PG8_WAIT_L(0); PG8_MMA(0, 0, At, B0); PG8_BAR; PG8_SCHED;
            PG8_LDB(B1, 0, 1); PG8_STAGE(PG8_SB(0, 0), b2, voffB);
            PG8_BAR; PG8_WAIT_L(0); PG8_MMA(0, 1, At, B1); PG8_BAR;
            PG8_LDA(At, 0, 1); PG8_STAGE(PG8_SA(0, 0), a2, voffA);
            PG8_BAR; PG8_WAIT_L(0); PG8_MMA(1, 0, At, B0); PG8_BAR; PG8_SCHED;
            PG8_STAGE(PG8_SB(0, 1), b2 + hstepB, voffB);
            PG8_WAIT_V(6); PG8_BAR; PG8_MMA(1, 1, At, B1); PG8_BAR;
            PG8_LDB(B0, 1, 0); PG8_SCHED; PG8_LDA(At, 1, 0); PG8_STAGE(PG8_SA(0, 1), a2 + hstepA, voffA);
            PG8_WAIT_L(8); PG8_BAR; PG8_WAIT_L(0); PG8_MMA(0, 0, At, B0); PG8_BAR; PG8_SCHED;
            PG8_LDB(B1, 1, 1); PG8_STAGE(PG8_SB(1, 0), b3, voffB);
            PG8_BAR; PG8_WAIT_L(0); PG8_MMA(0, 1, At, B1); PG8_BAR;
            PG8_LDA(At, 1, 1); PG8_STAGE(PG8_SA(1, 0), a3, voffA);
            PG8_BAR; PG8_WAIT_L(0); PG8_MMA(1, 0, At, B0); PG8_BAR; PG8_SCHED;
            PG8_STAGE(PG8_SB(1, 1), b3 + hstepB, voffB);
            PG8_WAIT_V(6); PG8_BAR; PG8_MMA(1, 1, At, B1); PG8_BAR;
        }
        E(acc, cur, wr, wc, fr, fq, pre);
        if (!has_next) break;
        E.prefetch(nxt, wr, fr, pre);
#pragma unroll
        for (int a = 0; a < 2; ++a)
#pragma unroll
            for (int b = 0; b < 2; ++b)
#pragma unroll
                for (int m = 0; m < 4; ++m)
#pragma unroll
                    for (int n = 0; n < 2; ++n) acc[a][b][m][n] = (f32x4){0.f, 0.f, 0.f, 0.f};
        cur = nxt; cA = nA; cB = nB; ++ui;
    }
    PG8_WAIT_V(0);
    if (wr == 0) PG8_BAR;
    PG8_BAR;
#undef PG8_SA
#undef PG8_SB
#undef PG8_STAGE
#undef PG8_LDA
#undef PG8_LDB
#undef PG8_MMA
#undef PG8_WAIT_V
#undef PG8_WAIT_L
#undef PG8_BAR
#undef PG8_SCHED
}
}
using pg8::Unit;

#define XB_TMO      128
#define XB_XCNT(j)  (256  + 64 * (j))
#define XB_XSUB(j)  (1280 + 64 * (j))
#define XB_XGEN(j)  (2304 + 64 * (j))
#define XB_TOP      3328
#define XB_TOPGEN   3392
#define XCD_BAR_WORDS 3456
#define XB_SPIN_CAP (1u << 18)
__device__ __forceinline__ unsigned xb_ld(unsigned* p)              { return __hip_atomic_load(p, __ATOMIC_RELAXED, __HIP_MEMORY_SCOPE_AGENT); }
__device__ __forceinline__ unsigned xb_add(unsigned* p, unsigned v) { return __hip_atomic_fetch_add(p, v, __ATOMIC_RELAXED, __HIP_MEMORY_SCOPE_AGENT); }
__device__ __forceinline__ unsigned xb_xcc_id() { return (unsigned)__builtin_amdgcn_s_getreg((3 << 11) | 20) & 0xFu; }
#define XB_SPIN(cond, bar) do { unsigned _sp = 0; while (cond) { __builtin_amdgcn_s_sleep(1); \
    if ((++_sp & 255u) == 0u) { if (xb_ld(&(bar)[XB_TMO])) break; if (_sp > XB_SPIN_CAP) { atomicAdd(&(bar)[XB_TMO], 1u); break; } } } } while (0)
struct XcdBarrier { unsigned* bar; unsigned x; volatile LAS unsigned* st; };
__device__ __forceinline__ XcdBarrier xcd_barrier_post(unsigned* bar, volatile LAS unsigned* st) {
    XcdBarrier b; b.bar = bar; b.x = xb_xcc_id(); b.st = st;
    if (threadIdx.x == 0) (void)xb_add(&bar[XB_XCNT(b.x)], 1u);
    return b;
}
__device__ __forceinline__ void xcd_barrier_complete(unsigned* bar, unsigned x, unsigned& nloc, unsigned& nx) {
    const unsigned G = gridDim.x * gridDim.y * gridDim.z;
    unsigned sum, cnt, mine, sp = 0u;
    for (;;) {
        sum = 0u; cnt = 0u; mine = 0u;
#pragma unroll
        for (unsigned j = 0; j < 16; ++j) { const unsigned c = xb_ld(&bar[XB_XCNT(j)]); sum += c; cnt += (c > 0u) ? 1u : 0u; mine = (j == x) ? c : mine; }
        if (sum == G) break;
        __builtin_amdgcn_s_sleep(1);
        if ((++sp & 255u) == 0u) { if (xb_ld(&bar[XB_TMO])) break; if (sp > XB_SPIN_CAP) { atomicAdd(&bar[XB_TMO], 1u); break; } }
    }
    nloc = mine > 0u ? mine : 1u; nx = cnt > 0u ? cnt : 1u;
}
__device__ __forceinline__ void xcd_barrier(const XcdBarrier& b) {
    asm volatile("s_waitcnt vmcnt(0)" ::: "memory");
    __syncthreads();
    if (threadIdx.x == 0) {
        unsigned* bar = b.bar;
        __builtin_amdgcn_s_waitcnt(0);
        unsigned nloc = b.st[0], nx = b.st[1];
        if (nloc == 0u) { xcd_barrier_complete(bar, b.x, nloc, nx); b.st[0] = nloc; b.st[1] = nx; }
        const unsigned old = xb_add(&bar[XB_XSUB(b.x)], 1u);
        const unsigned gen = old / nloc;
        if (old + 1u == (gen + 1u) * nloc) {
            __builtin_amdgcn_fence(__ATOMIC_RELEASE, "agent");
            asm volatile("s_waitcnt vmcnt(0)" ::: "memory");
            const unsigned og = xb_add(&bar[XB_TOP], 1u);
            const unsigned tg = og / nx;
            if (og + 1u == (tg + 1u) * nx) xb_add(&bar[XB_TOPGEN], 1u);
            else XB_SPIN(xb_ld(&bar[XB_TOPGEN]) == tg, bar);
            __builtin_amdgcn_fence(__ATOMIC_ACQUIRE, "agent");
            xb_add(&bar[XB_XGEN(b.x)], 1u);
            asm volatile("s_waitcnt vmcnt(0)" ::: "memory");
        } else {
            XB_SPIN(xb_ld(&bar[XB_XGEN(b.x)]) == gen, bar);
            __builtin_amdgcn_fence(__ATOMIC_ACQUIRE, "agent");
            asm volatile("s_waitcnt vmcnt(0)" ::: "memory");
        }
    }
    __syncthreads();
}

constexpr int NWAVES = 8, NTHR = 512;
constexpr int LDS_BYTES = 147456;
constexpr int MISC_OFF = 131072;
constexpr int PTAB_OFF = MISC_OFF + 512;

struct Args { const float* in[28]; float* out; unsigned char* ws; int ph_lo, ph_hi; };

struct Frame {
    LAS unsigned char* lds; int tid, lane, wave, G, c;
    const float* const* in; float* out; unsigned char* ws;
};
#define INP_(i) (F.in[i])
#define FRESH_TID(F) do { int _t = threadIdx.x; asm volatile("" : "+v"(_t)); (F).tid = _t; (F).lane = _t & 63; \
    __attribute__((address_space(1))) unsigned char* _w = (__attribute__((address_space(1))) unsigned char*)args.ws; __attribute__((address_space(1))) float* _o = (__attribute__((address_space(1))) float*)args.out; \
    int _g = gridDim.x; asm volatile("" : "+s"(_w), "+s"(_o), "+s"(_g)); (F).ws = (unsigned char*)_w; (F).out = (float*)_o; (F).G = _g; } while (0)
enum { I_X = 0, I_ANG, I_WIN, I_CDW, I_CDB, I_CLG, I_CLB, I_QG, I_KG, I_PK, I_PV, I_KW1, I_KB1, I_KW2, I_KB2, I_VW1, I_VB1, I_VW2, I_VB2, I_WOUT, I_FNG, I_DW1, I_DW3, I_DW2, I_RW, I_MW1, I_MW3, I_MW2 };

#define PMARK(id) do { if (PROBE_MASK != 0u && blockIdx.x == 0 && threadIdx.x == 0) { volatile LAS unsigned long long* _a = (volatile LAS unsigned long long*)(F.lds + MISC_OFF + 160); volatile LAS unsigned* _o = (volatile LAS unsigned*)(F.lds + MISC_OFF + 168); \
    const unsigned long long _t = __builtin_amdgcn_s_memrealtime(); if (*_o) { *_a += _t; *_o = 0u; } if ((id) < 32 && ((PROBE_MASK >> (id)) & 1u)) { *_a -= _t; *_o = 1u; } } } while (0)
constexpr int RSL_OFF = MISC_OFF + 2048;
__device__ __forceinline__ void rstd_from_partials(const float* pss, int pm, LAS float* tab) {
    int t = threadIdx.x; asm volatile("" : "+v"(t));
    const int row = t >> 1, hf = t & 1;
    const f32x4 a = *(const f32x4*)(pss + (size_t)(pm * 256 + row) * 16 + hf * 8), b = *(const f32x4*)(pss + (size_t)(pm * 256 + row) * 16 + hf * 8 + 4);
    float sq = ((a.x + a.y) + (a.z + a.w)) + ((b.x + b.y) + (b.z + b.w)); sq += __shfl_xor(sq, 1);
    if (hf == 0) tab[row] = rsqf_(sq * (1.0f / D) + EPS);
}
struct EpiIn {
    static constexpr bool PERM = true;
    const float* rstd; bf16_t* U; bf16_t* Q; bf16_t* KV; float* GT; const float* pss; LAS float* rsl;
    struct Pre { int par = 1; };
    __device__ __forceinline__ void prefetch(const Unit& u, int wr, int fr, Pre& p) const {
        p.par ^= 1; LAS float* tab = rsl + p.par * 256;
        if (pss) rstd_from_partials(pss, u.pm, tab); else { int t = threadIdx.x; asm volatile("" : "+v"(t)); if (t < 256) tab[t] = rstd[u.pm * 256 + t]; } }
    __device__ __forceinline__ void operator()(const f32x4 (&acc)[2][2][4][2], const Unit& u, int wr, int wc, int fr, int fq, const Pre& pre) const {
        const int row0 = u.pm * 256 + wr * 64 + fr, cl = wc * 32 + 8 * fq;
        if (u.pn < 4) {
#pragma unroll
            for (int ai = 0; ai < 2; ++ai)
#pragma unroll
                for (int m = 0; m < 4; ++m) { const int r = row0 + ai * 128 + m * 16; const float rs = rsl[pre.par * 256 + wr * 64 + fr + ai * 128 + m * 16];
                    const f32x4 v0 = acc[ai][0][m][0], v1 = acc[ai][0][m][1], g0 = acc[ai][1][m][0], g1 = acc[ai][1][m][1];
                    const float nr = rs * -1.44269504089f; const f32x2e nrs = {nr, nr}, rs1 = {rs, rs};
                    const f32x2e o0 = glus2_(LO2(v0), LO2(g0), nrs, rs1), o1 = glus2_(HI2(v0), HI2(g0), nrs, rs1), o2 = glus2_(LO2(v1), LO2(g1), nrs, rs1), o3 = glus2_(HI2(v1), HI2(g1), nrs, rs1);
                    u32x4 w; w.x = cvt_pk_bf16(o0.x, o0.y); w.y = cvt_pk_bf16(o1.x, o1.y); w.z = cvt_pk_bf16(o2.x, o2.y); w.w = cvt_pk_bf16(o3.x, o3.y);
                    *(u32x4*)(U + (size_t)r * CW + u.pn * 128 + cl) = w; asm volatile("" ::: "memory"); }
        } else if (u.pn < 6) {
#pragma unroll
            for (int ai = 0; ai < 2; ++ai)
#pragma unroll
                for (int m = 0; m < 4; ++m) { const int r = row0 + ai * 128 + m * 16; const float rs = rsl[pre.par * 256 + wr * 64 + fr + ai * 128 + m * 16];
#pragma unroll
                    for (int bj = 0; bj < 2; ++bj) { const f32x4 v0 = acc[ai][bj][m][0] * rs, v1 = acc[ai][bj][m][1] * rs;
                        u32x4 w; w.x = cvt_pk_bf16(v0[0], v0[1]); w.y = cvt_pk_bf16(v0[2], v0[3]); w.z = cvt_pk_bf16(v1[0], v1[1]); w.w = cvt_pk_bf16(v1[2], v1[3]);
                        *(u32x4*)(Q + (size_t)r * 512 + (u.pn - 4) * 256 + bj * 128 + cl) = w; } asm volatile("" ::: "memory"); }
        } else if (u.pn < 9) {
            const int h = wc >> 1, d0 = 32 * (wc & 1) + 8 * fq;
#pragma unroll
            for (int ai = 0; ai < 2; ++ai)
#pragma unroll
                for (int m = 0; m < 4; ++m) { const int r = row0 + ai * 128 + m * 16; const float rs = rsl[pre.par * 256 + wr * 64 + fr + ai * 128 + m * 16]; const int b = r >> 11, t = r & 2047;
#pragma unroll
                    for (int bj = 0; bj < 2; ++bj) { const int tq = 2 * (u.pn - 6) + bj; const f32x4 v0 = acc[ai][bj][m][0] * rs, v1 = acc[ai][bj][m][1] * rs;
                        u32x4 w; w.x = cvt_pk_bf16(v0[0], v0[1]); w.y = cvt_pk_bf16(v0[2], v0[3]); w.z = cvt_pk_bf16(v1[0], v1[1]); w.w = cvt_pk_bf16(v1[2], v1[3]);
                        *(u32x4*)(KV + (size_t)tq * KVT + ((size_t)(b * 2 + h) * SEQ + t) * DH + d0) = w; } asm volatile("" ::: "memory"); }
        } else {
            if (wc == 0 && fq < 3) {
#pragma unroll
                for (int ai = 0; ai < 2; ++ai)
#pragma unroll
                    for (int m = 0; m < 4; ++m) { const int r = row0 + ai * 128 + m * 16; const float rs = rsl[pre.par * 256 + wr * 64 + fr + ai * 128 + m * 16];
                        *(f32x4*)(GT + (size_t)r * 24 + 8 * fq) = acc[ai][0][m][0] * rs; *(f32x4*)(GT + (size_t)r * 24 + 8 * fq + 4) = acc[ai][0][m][1] * rs; }
            }
        }
    }
};
struct EpiH1 {
    static constexpr bool PERM = false;
    float* H;
    struct Pre {}; __device__ __forceinline__ void prefetch(const Unit&, int, int, Pre&) const {}
    __device__ __forceinline__ void operator()(const f32x4 (&acc)[2][2][4][2], const Unit& u, int wr, int wc, int fr, int fq, const Pre&) const {
        const int row0 = u.pm * 256 + wr * 64 + fr, col0 = wc * 32 + 4 * fq; const int kv = u.pn >> 3, sp = u.pn & 7;
#pragma unroll
        for (int ai = 0; ai < 2; ++ai)
#pragma unroll
            for (int m = 0; m < 4; ++m) { float* rowp = H + (((size_t)sp * 2 + kv) * 2048 + row0 + ai * 128 + m * 16) * 256 + col0;
#pragma unroll
                for (int bj = 0; bj < 2; ++bj)
#pragma unroll
                    for (int n = 0; n < 2; ++n) *(f32x4*)(rowp + bj * 128 + n * 16) = acc[ai][bj][m][n]; }
    }
};
template <bool BF> struct EpiRes {
    static constexpr bool PERM = false;
    const void* base; bf16_t* xb; float* pss;
    struct Pre {}; __device__ __forceinline__ void prefetch(const Unit&, int, int, Pre&) const {}
    __device__ __forceinline__ void operator()(const f32x4 (&acc)[2][2][4][2], const Unit& u, int wr, int wc, int fr, int fq, const Pre&) const {
        const int row0 = u.pm * 256 + wr * 64 + fr, col0 = u.pn * 256 + wc * 32 + 4 * fq;
#pragma unroll
        for (int ai = 0; ai < 2; ++ai) {
            f32x4 bs[4][2][2];
#pragma unroll
            for (int m = 0; m < 4; ++m) { const size_t off = (size_t)(row0 + ai * 128 + m * 16) * D + col0;
#pragma unroll
                for (int bj = 0; bj < 2; ++bj)
#pragma unroll
                    for (int n = 0; n < 2; ++n) {
                        if (BF) { const u32x2 w = *(const u32x2*)((const bf16_t*)base + off + bj * 128 + n * 16); bs[m][bj][n] = (f32x4){bf_lo(w.x), bf_hi(w.x), bf_lo(w.y), bf_hi(w.y)}; }
                        else bs[m][bj][n] = *(const f32x4*)((const float*)base + off + bj * 128 + n * 16); } }
#pragma unroll
            for (int m = 0; m < 4; ++m) { const size_t off = (size_t)(row0 + ai * 128 + m * 16) * D + col0; float ss = 0.f;
#pragma unroll
                for (int bj = 0; bj < 2; ++bj)
#pragma unroll
                    for (int n = 0; n < 2; ++n) { const f32x4 v = bs[m][bj][n] + acc[ai][bj][m][n];
                        u32x2 w; w.x = cvt_pk_bf16(v[0], v[1]); w.y = cvt_pk_bf16(v[2], v[3]); *(u32x2*)(xb + off + bj * 128 + n * 16) = w; ss += (v[0] * v[0] + v[1] * v[1]) + (v[2] * v[2] + v[3] * v[3]); }
                if (pss) { ss += __shfl_xor(ss, 16); ss += __shfl_xor(ss, 32);
                    if (fq == 0) pss[(size_t)(row0 + ai * 128 + m * 16) * 16 + u.pn * 4 + wc] = ss; } } }
    }
};
struct EpiGlu {
    static constexpr bool PERM = true;
    const float* rstd; bf16_t* O; int ldo; int rowbase;
    const float* pss; LAS float* rsl;
    struct Pre { int par = 1; };
    __device__ __forceinline__ void prefetch(const Unit& u, int wr, int fr, Pre& p) const { p.par ^= 1; rstd_from_partials(pss, u.pm, rsl + p.par * 256); }
    __device__ __forceinline__ void operator()(const f32x4 (&acc)[2][2][4][2], const Unit& u, int wr, int wc, int fr, int fq, const Pre& pre) const {
        const int row0 = u.pm * 256 + wr * 64 + fr, cl = u.pn * 128 + wc * 32 + 8 * fq;
#pragma unroll
        for (int ai = 0; ai < 2; ++ai)
#pragma unroll
            for (int m = 0; m < 4; ++m) { const int r = row0 + ai * 128 + m * 16; const float rs = rsl[pre.par * 256 + wr * 64 + fr + ai * 128 + m * 16];
                const f32x4 g0 = acc[ai][0][m][0], g1 = acc[ai][0][m][1], u0 = acc[ai][1][m][0], u1 = acc[ai][1][m][1];
                const float nr = rs * -1.44269504089f, r2 = rs * rs; const f32x2e nrs = {nr, nr}, rs2 = {r2, r2};
                const f32x2e o0 = glu2_(LO2(g0), LO2(u0), nrs, rs2), o1 = glu2_(HI2(g0), HI2(u0), nrs, rs2), o2 = glu2_(LO2(g1), LO2(u1), nrs, rs2), o3 = glu2_(HI2(g1), HI2(u1), nrs, rs2);
                u32x4 w; w.x = cvt_pk_bf16(o0.x, o0.y); w.y = cvt_pk_bf16(o1.x, o1.y); w.z = cvt_pk_bf16(o2.x, o2.y); w.w = cvt_pk_bf16(o3.x, o3.y);
                *(u32x4*)(O + (size_t)r * ldo + cl) = w; }
    }
};
struct EpiGlu8 {
    static constexpr bool PERM = true;
    const float* rstd; unsigned char* O; int ldo; float sc;
    struct Pre { float rs[8]; };
    __device__ __forceinline__ void prefetch(const Unit& u, int wr, int fr, Pre& p) const {
#pragma unroll
        for (int q = 0; q < 8; ++q) p.rs[q] = rstd[u.pm * 256 + wr * 64 + fr + (q >> 2) * 128 + (q & 3) * 16]; }
    __device__ __forceinline__ void operator()(const f32x4 (&acc)[2][2][4][2], const Unit& u, int wr, int wc, int fr, int fq, const Pre& pre) const {
        const int row0 = u.pm * 256 + wr * 64 + fr, cl = u.pn * 128 + wc * 32 + 8 * fq;
#pragma unroll
        for (int ai = 0; ai < 2; ++ai)
#pragma unroll
            for (int m = 0; m < 4; ++m) { const int r = row0 + ai * 128 + m * 16; const float rs = pre.rs[ai * 4 + m] * sc;
                const f32x4 g0 = acc[ai][0][m][0], g1 = acc[ai][0][m][1], u0 = acc[ai][1][m][0], u1 = acc[ai][1][m][1];
                const float nr = rs * -1.44269504089f, r2 = rs * rs; const f32x2e nrs = {nr, nr}, rs2 = {r2, r2};
                const f32x2e o0 = glu2_(LO2(g0), LO2(u0), nrs, rs2), o1 = glu2_(HI2(g0), HI2(u0), nrs, rs2), o2 = glu2_(LO2(g1), LO2(u1), nrs, rs2), o3 = glu2_(HI2(g1), HI2(u1), nrs, rs2);
                *(u32x2*)(O + (size_t)r * ldo + cl) = pk8_fp8(o0.x, o0.y, o1.x, o1.y, o2.x, o2.y, o3.x, o3.y); }
    }
};
struct EpiMoe2 {
    static constexpr bool PERM = true;
    const int* stok; const float* sw; bf16_t* Y0; bf16_t* Y1; int rowbase; float sc;
    struct Pre {}; __device__ __forceinline__ void prefetch(const Unit&, int, int, Pre&) const {}
    __device__ __forceinline__ void operator()(const f32x4 (&acc)[2][2][4][2], const Unit& u, int wr, int wc, int fr, int fq, const Pre&) const {
        const int row0 = u.pm * 256 + wr * 64 + fr, cl = u.pn * 256 + wc * 32 + 8 * fq;
        int tks[8]; float ws[8];
#pragma unroll
        for (int q = 0; q < 8; ++q) { const int r = rowbase + row0 + (q >> 2) * 128 + (q & 3) * 16; tks[q] = stok[r]; ws[q] = sw[r]; }
#pragma unroll
        for (int ai = 0; ai < 2; ++ai)
#pragma unroll
            for (int m = 0; m < 4; ++m) { const int tk = tks[ai * 4 + m]; const float w = ws[ai * 4 + m] * sc;
                if (tk >= 0) { bf16_t* dst = ((tk & 1) ? Y1 : Y0) + (size_t)(tk >> 1) * D + cl;
#pragma unroll
                    for (int bj = 0; bj < 2; ++bj) { const f32x4 v0 = acc[ai][bj][m][0] * w, v1 = acc[ai][bj][m][1] * w;
                        u32x4 o; o.x = cvt_pk_bf16(v0[0], v0[1]); o.y = cvt_pk_bf16(v0[2], v0[3]); o.z = cvt_pk_bf16(v1[0], v1[1]); o.w = cvt_pk_bf16(v1[2], v1[3]);
                        *(u32x4*)(dst + bj * 128) = o; } } }
    }
};

struct SchedCmp {
    int G, c, layer;
    __device__ __forceinline__ bool next(int i, Unit& u) const {
        const int L = i * G + c; if (L >= 128) return false;
        const int kv = L >> 6, pm = (L >> 3) & 7, s = L & 7;
        u.pm = pm; u.pn = kv * 8 + s; u.aoff = ((size_t)kv * KVT + (size_t)pm * 256 * 1024 + s * 256) * 2; u.boff = ((size_t)(layer * 2 + kv) * 256 * 2048 + s * 256) * 2; return true;
    }
};
struct SchedMoe1 {
    int G, c, p0, np; const LAS int* ptab;
    __device__ __forceinline__ bool next(int i, Unit& u) const {
        const int L = i * G + c; if (L >= np * 28) return false;
        const int j = L / np, pl = L % np, e = ptab[p0 + pl];
        u.pm = pl; u.pn = j; u.aoff = (size_t)(p0 + pl) * 256 * 1024 * 2; u.boff = ((size_t)e * 7168 + (size_t)j * 256) * 1024 * 2; return true;
    }
};
struct SchedMoe2 {
    int G, c, p0, np; const LAS int* ptab;
    __device__ __forceinline__ bool next(int i, Unit& u) const {
        const int L = i * G + c; if (L >= np * 4) return false;
        const int j = L / np, pl = L % np, e = ptab[p0 + pl];
        u.pm = pl; u.pn = j; u.aoff = (size_t)pl * 256 * DFE * 2; u.boff = ((size_t)e * 1024 + (size_t)j * 256) * DFE * 2; return true;
    }
};

struct SchedMoe1F {
    int G, c, np; const LAS int* ptab;
    __device__ __forceinline__ bool next(int i, Unit& u) const {
        const int L = i * G + c; if (L >= np * 28) return false;
        const int pl = L / 28, j = L % 28, e = ptab[pl];
        u.pm = pl; u.pn = j; u.aoff = (size_t)pl * 256 * 1024; u.boff = ((size_t)e * 7168 + (size_t)j * 256) * 1024; return true;
    }
};
struct SchedMoe2F {
    int G, c, np; const LAS int* ptab;
    __device__ __forceinline__ bool next(int i, Unit& u) const {
        const int L = i * G + c; if (L >= np * 4) return false;
        const int pl = L >> 2, j = L & 3, e = ptab[pl];
        u.pm = pl; u.pn = j; u.aoff = (size_t)pl * 256 * DFE; u.boff = ((size_t)e * 1024 + (size_t)j * 256) * DFE; return true;
    }
};

struct MoePlan { int N1, PA, nup, qa, n2; };
__device__ __forceinline__ MoePlan moe_plan(int np, int G) {
    MoePlan P; const bool split = (G == 256) && np >= 128 && np <= 136;
    P.nup = 28 * np; P.N1 = split ? 2048 : P.nup; P.PA = split ? np - 64 : np;
    const int r1 = P.nup - P.N1, nA = 4 * P.PA; P.n2 = (split && nA > G) ? nA - G : 0;
    const int R = (r1 + 3 * P.n2 + G - 1) / G; P.qa = R > 3 ? R - 3 : 0; return P; }
struct SchedMoe1R {
    int G, c, L0, ntot, qa, n2; const LAS int* ptab;
    __device__ __forceinline__ bool next(int i, Unit& u) const {
        int L; if (i < qa) L = L0 + i * G + c; else { if (c < n2) return false; L = L0 + qa * G + (i - qa) * (G - n2) + (c - n2); }
        if (L >= ntot) return false;
        const int pl = L / 28, j = L % 28, e = ptab[pl];
        u.pm = pl; u.pn = j; u.aoff = (size_t)pl * 256 * 1024; u.boff = ((size_t)e * 7168 + (size_t)j * 256) * 1024; return true;
    }
};
struct SchedMoe2R {
    int G, c, p0, np; const LAS int* ptab;
    __device__ __forceinline__ bool next(int i, Unit& u) const {
        const int L = i * G + c; if (L >= np * 4) return false;
        const int pl = p0 + (L >> 2), j = L & 3, e = ptab[pl];
        u.pm = pl; u.pn = j; u.aoff = (size_t)pl * 256 * DFE; u.boff = ((size_t)e * 1024 + (size_t)j * 256) * DFE; return true;
    }
};

struct TwP { const float* W; const float* gv; bf16_t* WT; int ldw, n0, nvalid, k0, ldk, kind, h; float f8sc; };
__device__ __forceinline__ TwP tw_job(int r, const float* W, int ldw, int nblk, int nvalid, bf16_t* WT, int ldk, int kind, int h, const float* gv) {
    TwP P; P.W = W; P.gv = gv; P.WT = WT; P.ldw = ldw; P.n0 = 256 * (r % nblk); P.nvalid = nvalid; P.k0 = 64 * (r / nblk); P.ldk = ldk; P.kind = kind; P.h = h; P.f8sc = 0.f; return P; }
__device__ __forceinline__ void tw_load(const TwP& P, f32x4 (&tv)[8], int wave, int lane) {
    const int n = P.n0 + 4 * lane; const float* src = P.W + (size_t)(P.k0 + 8 * wave) * P.ldw + n;
#pragma unroll
    for (int i = 0; i < 8; ++i) tv[i] = (n < P.nvalid) ? *(const f32x4*)(src + (size_t)i * P.ldw) : (f32x4){0.f, 0.f, 0.f, 0.f};
}
__device__ __forceinline__ void tw_store(const TwP& P, f32x4 (&tv)[8], LAS unsigned char* tile, int wave, int lane) {
    if (P.gv) {
#pragma unroll
        for (int i = 0; i < 8; ++i) tv[i] *= P.gv[P.k0 + 8 * wave + i]; }
    const int ng = P.n0 + 32 * wave; size_t drow;
    if (P.kind == 0) drow = ng;
    else if (P.kind == 1) drow = 256 * (ng / 128) + 128 * P.h + (ng % 128);
    else { if (ng < 512) drow = 256 * (ng / 128) + (ng % 128); else if (ng < 1024) { const int cc = ng - 512; drow = 256 * (cc / 128) + 128 + (cc % 128); } else drow = ng; }
    if (P.f8sc != 0.f) {
        const float sc = P.f8sc;
#pragma unroll
        for (int c = 0; c < 4; ++c) *(LAS u32x2*)(tile + (4 * lane + c) * 80 + 8 * wave) = pk8_fp8(tv[0][c] * sc, tv[1][c] * sc, tv[2][c] * sc, tv[3][c] * sc, tv[4][c] * sc, tv[5][c] * sc, tv[6][c] * sc, tv[7][c] * sc);
        __syncthreads();
#pragma unroll
        for (int j = 0; j < 2; ++j) { const int r = (lane >> 2) + 16 * j, ch = lane & 3;
            *(u32x4*)((unsigned char*)P.WT + (drow + r) * (size_t)P.ldk + P.k0 + 16 * ch) = *(const LAS u32x4*)(tile + (32 * wave + r) * 80 + 16 * ch); }
        __syncthreads();
        return; }
#pragma unroll
    for (int c = 0; c < 4; ++c) { u32x4 o; o.x = cvt_pk_bf16(tv[0][c], tv[1][c]); o.y = cvt_pk_bf16(tv[2][c], tv[3][c]); o.z = cvt_pk_bf16(tv[4][c], tv[5][c]); o.w = cvt_pk_bf16(tv[6][c], tv[7][c]);
        *(LAS u32x4*)(tile + (4 * lane + c) * 144 + 16 * wave) = o; }
    __syncthreads();
#pragma unroll
    for (int j = 0; j < 4; ++j) { const int r = (lane >> 3) + 8 * j, c = lane & 7;
        *(u32x4*)(P.WT + (drow + r) * (size_t)P.ldk + P.k0 + 8 * c) = *(const LAS u32x4*)(tile + (32 * wave + r) * 144 + 16 * c); }
    __syncthreads();
}
#define TW_RUN(NIT, JOB) do { const int _n = (NIT); if (_n > 0) { TwP _pa, _pb; f32x4 _ta[8], _tb[8]; JOB(_pa, 0); tw_load(_pa, _ta, F.wave, F.lane); \
    _Pragma("nounroll") for (int _i = 0; _i < _n; _i += 2) { const bool _h2 = _i + 1 < _n, _h3 = _i + 2 < _n; \
        if (_h2) { JOB(_pb, _i + 1); tw_load(_pb, _tb, F.wave, F.lane); } tw_store(_pa, _ta, F.lds, F.wave, F.lane); if (!_h2) break; \
        if (_h3) { JOB(_pa, _i + 2); tw_load(_pa, _ta, F.wave, F.lane); } tw_store(_pb, _tb, F.lds, F.wave, F.lane); } } } while (0)
__device__ __forceinline__ void xprep_row(const float* xrow, bf16_t* orow, float* rstd_out, int lane, f32x4 (&v)[4]) {
    const f32x4* xr = (const f32x4*)xrow + lane; float s = 0.f;
#pragma unroll
    for (int j = 0; j < 4; ++j) { v[j] = xr[64 * j]; s += (v[j].x * v[j].x + v[j].y * v[j].y) + (v[j].z * v[j].z + v[j].w * v[j].w); }
    const float rstd = rsqf_(wave_sum_u(s) * (1.0f / D) + EPS);
    if (orow) { u32x2* o8 = (u32x2*)orow + lane;
#pragma unroll
        for (int j = 0; j < 4; ++j) { u32x2 w; w.x = cvt_pk_bf16(v[j].x, v[j].y); w.y = cvt_pk_bf16(v[j].z, v[j].w); o8[64 * j] = w; } }
    if (lane == 0) *rstd_out = rstd;
}

constexpr float MOE_S1 = 64.f, MOE_S2 = 128.f;
constexpr int MOE_SLOT_N = 7, MOE_SLOTTED = 3 * 128 * MOE_SLOT_N;
constexpr int MOE_ITEMS = 24 * 224;
__device__ __forceinline__ TwP moe_conv_job(Frame& F, int r) {
    constexpr int J_M1 = 16 * 14, J_M2 = 56 * 4;
    unsigned char* WM1 = F.ws + WS_WM1; unsigned char* WM2 = F.ws + WS_WM2;
    if (r < 16 * J_M1) { const int q = r / J_M1, e = q >> 1, h = q & 1; TwP P = tw_job(r % J_M1, (h ? INP_(I_MW3) : INP_(I_MW1)) + (size_t)e * D * DFE, DFE, 14, DFE, (bf16_t*)(WM1 + (size_t)e * 7168 * D), D, 1, h, INP_(I_FNG) + D); P.f8sc = MOE_S1; return P; }
    r -= 16 * J_M1; const int e = r / J_M2; TwP P = tw_job(r % J_M2, INP_(I_MW2) + (size_t)e * DFE * D, D, 4, D, (bf16_t*)(WM2 + (size_t)e * D * DFE), DFE, 0, 0, nullptr); P.f8sc = MOE_S2; return P;
}
__device__ __forceinline__ void moe_conv_slot(Frame& F, int slot) {
    if (F.G != 256 || F.c < 128) return;
    { int _t = threadIdx.x; asm volatile("" : "+v"(_t)); F.tid = _t; F.lane = _t & 63; }
    int base = slot * 128 * MOE_SLOT_N + ((int)blockIdx.x - 128); asm volatile("" : "+s"(base));
#define MJOB(P, i) P = moe_conv_job(F, base + (i) * 128)
    TW_RUN(MOE_SLOT_N, MJOB);
#undef MJOB
}
__device__ __forceinline__ void xprep_rows4(const float* X, bf16_t* XBo, float* RSo, int m, int ms, int lane) {
    f32x4 v[4][4];
#pragma unroll
    for (int q = 0; q < 4; ++q) { const int mm = m + q * ms; const f32x4* xr = (const f32x4*)(X + (size_t)(mm < M ? mm : 0) * D) + lane;
#pragma unroll
        for (int j = 0; j < 4; ++j) v[q][j] = xr[64 * j]; }
#pragma unroll
    for (int q = 0; q < 4; ++q) { const int mm = m + q * ms; if (mm >= M) break; float s = 0.f;
#pragma unroll
        for (int j = 0; j < 4; ++j) s += (v[q][j].x * v[q][j].x + v[q][j].y * v[q][j].y) + (v[q][j].z * v[q][j].z + v[q][j].w * v[q][j].w);
        const float rstd = rsqf_(wave_sum_u(s) * (1.0f / D) + EPS);
        u32x2* o8 = (u32x2*)(XBo + (size_t)mm * D) + lane;
#pragma unroll
        for (int j = 0; j < 4; ++j) { u32x2 w; w.x = cvt_pk_bf16(v[q][j].x, v[q][j].y); w.y = cvt_pk_bf16(v[q][j].z, v[q][j].w); o8[64 * j] = w; }
        if (lane == 0) RSo[mm] = rstd; }
}
__device__ __forceinline__ void phase_prologue(Frame& F) {
    const int gw = F.c * NWAVES + F.wave, NGW = F.G * NWAVES;
    bf16_t* WIN = (bf16_t*)(F.ws + WS_WIN); bf16_t* WC1 = (bf16_t*)(F.ws + WS_WC1); bf16_t* WOUT = (bf16_t*)(F.ws + WS_WOUT); bf16_t* WF1 = (bf16_t*)(F.ws + WS_WF1); bf16_t* WF2 = (bf16_t*)(F.ws + WS_WF2);
    constexpr int J_IN = 16 * 10, J_C1 = 32, J_OUT = 16 * 4, J_F1 = 16 * 11, J_F2 = 44 * 4;
    constexpr int NSMALL = 2 * J_IN + 4 * J_C1 + 2 * J_OUT + 2 * J_F1 + J_F2;
    const int moe0 = (F.G == 256) ? MOE_SLOTTED : 0; const int nitems = NSMALL + MOE_ITEMS - moe0;
#define P0_JOB(P, i) do { int r = F.c + (i) * F.G; \
        if (r < 2 * J_IN) { const int l = r / J_IN; P = tw_job(r % J_IN, INP_(I_WIN) + (size_t)l * D * INW, INW, 10, INW, WIN + (size_t)l * INP * D, D, 2, 0, INP_(I_ANG) + l * D); break; } r -= 2 * J_IN; \
        if (r < 4 * J_C1) { const int q = r / J_C1, l = q >> 1, kv = q & 1; P = tw_job(r % J_C1, (kv ? INP_(I_VW1) : INP_(I_KW1)) + (size_t)l * 2048 * 256, 256, 1, 256, WC1 + (size_t)(l * 2 + kv) * 256 * 2048, 2048, 0, 0, nullptr); break; } r -= 4 * J_C1; \
        if (r < 2 * J_OUT) { const int l = r / J_OUT; P = tw_job(r % J_OUT, INP_(I_WOUT) + (size_t)l * D * D, D, 4, D, WOUT + (size_t)l * D * D, D, 0, 0, nullptr); break; } r -= 2 * J_OUT; \
        if (r < 2 * J_F1) { const int h = r / J_F1; P = tw_job(r % J_F1, (h ? INP_(I_DW3) : INP_(I_DW1)), DFF, 11, DFF, WF1, D, 1, h, INP_(I_FNG)); break; } r -= 2 * J_F1; \
        if (r < J_F2) { P = tw_job(r, INP_(I_DW2), D, 4, D, WF2, DFF, 0, 0, nullptr); break; } r -= J_F2; \
        P = moe_conv_job(F, r + moe0); } while (0)
    TW_RUN((nitems - F.c + F.G - 1) / F.G, P0_JOB);
#undef P0_JOB
    { float* RT = (float*)(F.ws + WS_RT); const int gt = F.c * NTHR + F.tid; if (gt < 8192) { const int e = gt >> 10, k = gt & 1023; RT[gt] = INP_(I_RW)[k * 8 + e] * INP_(I_FNG)[D + k]; } }
    { float* B1P = (float*)(F.ws + WS_CTL) + CW_B1P; LAS float* ps = (LAS float*)F.lds;
      for (int it = F.c; it < 128; it += F.G) { const int kc = it & 7, jb = (it >> 3) & 3, kv = (it >> 5) & 1, l = it >> 6; const int j = jb * 64 + F.lane, kb = kc * 256 + 32 * F.wave;
          const float* w1 = (kv ? INP_(I_VW1) : INP_(I_KW1)) + (size_t)l * 2048 * 256; const float* pos = (kv ? INP_(I_PV) : INP_(I_PK)) + l * 2048;
          float wv[32];
#pragma unroll
          for (int k = 0; k < 32; ++k) wv[k] = w1[(size_t)(kb + k) * 256 + j];
          float sp = 0.f;
#pragma unroll
          for (int k = 0; k < 32; ++k) sp += pos[kb + k] * wv[k];
          ps[F.wave * 64 + F.lane] = sp;
          __syncthreads();
          if (F.wave == 0) { float t = (kc == 0) ? (kv ? INP_(I_VB1) : INP_(I_KB1))[l * 256 + j] : 0.f;
#pragma unroll
              for (int ww = 0; ww < 8; ++ww) t += ps[ww * 64 + F.lane];
              B1P[kc * 1024 + (l * 2 + kv) * 256 + j] = t; }
          __syncthreads(); } }
    { bf16_t* XB = (bf16_t*)(F.ws + WS_XB); float* RS = (float*)(F.ws + WS_RSTD);
      for (int m = gw; m < M; m += 4 * NGW) xprep_rows4(INP_(I_X), XB, RS, m, NGW, F.lane); }
}

__device__ __forceinline__ void norm_rows64(bf16_t* buf, int nrows, const float* g, float scale, int gw, int NGW, int lane) {
    const int sub = lane & 7; float gv[8];
#pragma unroll
    for (int j = 0; j < 8; ++j) gv[j] = g[sub * 8 + j] * scale;
    for (int it = gw; it < nrows / 8; it += NGW) { u32x4* p = (u32x4*)(buf + ((size_t)it * 8 + (lane >> 3)) * 64) + sub; const u32x4 v = *p;
        float f[8] = {bf_lo(v.x), bf_hi(v.x), bf_lo(v.y), bf_hi(v.y), bf_lo(v.z), bf_hi(v.z), bf_lo(v.w), bf_hi(v.w)}; float s = 0.f;
#pragma unroll
        for (int j = 0; j < 8; ++j) s += f[j] * f[j];
        s += __shfl_xor(s, 1); s += __shfl_xor(s, 2); s += __shfl_xor(s, 4);
        const float rs = rsqf_(s * (1.0f / 64.0f) + EPS);
        u32x4 o; o.x = cvt_pk_bf16(f[0] * rs * gv[0], f[1] * rs * gv[1]); o.y = cvt_pk_bf16(f[2] * rs * gv[2], f[3] * rs * gv[3]); o.z = cvt_pk_bf16(f[4] * rs * gv[4], f[5] * rs * gv[5]); o.w = cvt_pk_bf16(f[6] * rs * gv[6], f[7] * rs * gv[7]);
        *p = o; }
}
__device__ __forceinline__ float sum32_(float v, bool) {
    v = DPP_ADD(v, 0xB1); v = DPP_ADD(v, 0x4E); v = DPP_ADD(v, 0x124); v = DPP_ADD(v, 0x128);
    return v + __shfl_xor(v, 16);
}
__device__ __forceinline__ void conv_unit(Frame& F, int layer, int cu) {
    const int b = cu >> 6, t0 = (cu & 63) * 32; int tid = F.tid; asm volatile("" : "+v"(tid));
    const bf16_t* U = (const bf16_t*)(F.ws + WS_U); bf16_t* MIX = (bf16_t*)(F.ws + WS_MIX);
    LAS u32x4* L4 = (LAS u32x4*)F.lds;
    const int cp = tid & 255, th = tid >> 8; const bool hi = (tid & 32) != 0; const LAS unsigned* LW = (const LAS unsigned*)F.lds;
    f32x2 w[CKW];
#pragma unroll
    for (int k = 0; k < CKW; ++k) w[k] = *(const f32x2*)(INP_(I_CDW) + (size_t)layer * CKW * CW + k * CW + 2 * cp);
    const f32x2 cb = *(const f32x2*)(INP_(I_CDB) + layer * CW + 2 * cp), lg = *(const f32x2*)(INP_(I_CLG) + layer * CW + 2 * cp), lb = *(const f32x2*)(INP_(I_CLB) + layer * CW + 2 * cp);
    { u32x4 sv[8];
#pragma unroll
      for (int q = 0; q < 8; ++q) { const int i = tid + q * NTHR, row = i >> 6, ch = i & 63, t = t0 - 30 + row; sv[q] = (u32x4){0u, 0u, 0u, 0u}; if (i < 62 * 64 && t >= 0) sv[q] = *(const u32x4*)(U + (size_t)(b * SEQ + t) * CW + ch * 8); }
#pragma unroll
      for (int q = 0; q < 8; ++q) { const int i = tid + q * NTHR; if (i < 62 * 64) L4[i] = sv[q]; } }
    __syncthreads();
#pragma nounroll
    for (int hf = 0; hf < 2; ++hf) { const int tl0 = th * 16 + hf * 8;
        f32x2 in[38];
#pragma unroll
        for (int i = 0; i < 38; ++i) { const unsigned v = LW[(tl0 + i) * 256 + cp]; in[i] = (f32x2){bf_lo(v), bf_hi(v)}; }
        f32x2 acc[8];
#pragma unroll
        for (int t = 0; t < 8; ++t) { acc[t] = cb;
#pragma unroll
            for (int k = 0; k < CKW; ++k) acc[t] += w[k] * in[t + k]; }
#pragma unroll
        for (int t = 0; t < 8; ++t) {
            const float s = sum32_(acc[t].x + acc[t].y, hi), q = sum32_(acc[t].x * acc[t].x + acc[t].y * acc[t].y, hi);
            const float mu = s * (1.0f / 64.0f), var = fmaxf(q * (1.0f / 64.0f) - mu * mu, 0.f), rs = rsqf_(var + EPS);
            const float a0 = (acc[t].x - mu) * rs * lg.x + lb.x, a1 = (acc[t].y - mu) * rs * lg.y + lb.y;
            *(unsigned*)(MIX + (size_t)(b * SEQ + t0 + tl0 + t) * D + 2 * cp) = cvt_pk_bf16(siluf_(a0), siluf_(a1)); }
    }
    __syncthreads();
}
__device__ __forceinline__ void vtrans_items(Frame& F, int gw, int NGW) {
    const int lane = F.lane;
    LAS unsigned char* scr = F.lds + F.wave * 9216;
    for (int it = gw; it < 1024; it += NGW) { const int ten = it >> 9, bh = (it >> 5) & 15, kb = it & 31;
        const bf16_t* V = (const bf16_t*)(F.ws + WS_KV) + (size_t)(ten ? 5 : 3) * KVT + ((size_t)bh * SEQ + kb * 64) * 64; bf16_t* VT = (bf16_t*)(F.ws + (ten ? WS_VWT : WS_VST)) + (size_t)bh * 64 * SEQ + kb * 64;
#pragma unroll
        for (int c = 0; c < 8; ++c) *(LAS u32x4*)(scr + lane * 144 + c * 16) = *((const u32x4*)(V + (size_t)lane * 64) + c);
        LDS_WAIT(); __builtin_amdgcn_wave_barrier(); asm volatile("" ::: "memory");
#pragma unroll
        for (int c = 0; c < 8; ++c) { unsigned w[4];
#pragma unroll
            for (int q = 0; q < 4; ++q) { const int v0 = 8 * c + 2 * q, k0 = swap23(v0), k1 = swap23(v0 + 1);
                w[q] = (unsigned)*(const LAS bf16_t*)(scr + k0 * 144 + lane * 2) | ((unsigned)*(const LAS bf16_t*)(scr + k1 * 144 + lane * 2) << 16); }
            *((u32x4*)(VT + (size_t)lane * SEQ) + c) = (u32x4){w[0], w[1], w[2], w[3]}; }
        LDS_WAIT(); __builtin_amdgcn_wave_barrier(); asm volatile("" ::: "memory");
    }
}
__device__ __forceinline__ void phase_cmp2(Frame& F, int layer) {
    const int lane = F.lane, w = F.wave, k0 = 32 * w;
    const float* H1 = (const float*)(F.ws + WS_H1); const float* B1P = (const float*)(F.ws + WS_CTL) + CW_B1P + layer * 512;
    LAS float* part = (LAS float*)F.lds;
#pragma nounroll
    for (int un = F.c; un < 256; un += F.G) { const int kv = un >> 7, R0 = (un & 127) * 16;
        const float* w2 = (kv ? INP_(I_VW2) : INP_(I_KW2)) + (size_t)layer * 16384 + (size_t)k0 * 64 + lane;
        float w2r[32];
#pragma unroll
        for (int j = 0; j < 32; ++j) w2r[j] = w2[j * 64];
        float bsum = 0.f;
#pragma unroll
        for (int sp = 0; sp < 8; ++sp) bsum += B1P[sp * 1024 + kv * 256 + k0 + (lane & 31)];
        float acc[16], hx[16];
        {
            float hp[16][8];
#pragma unroll
            for (int r = 0; r < 16; ++r)
#pragma unroll
                for (int sp = 0; sp < 8; ++sp) hp[r][sp] = H1[((size_t)kv * 2048 + R0 + r) * 256 + k0 + (lane & 31) + (size_t)sp * 2 * 2048 * 256];
#pragma unroll
            for (int r = 0; r < 16; ++r) { float x = 0.f;
#pragma unroll
                for (int sp = 0; sp < 8; ++sp) x += hp[r][sp];
                hx[r] = siluf_(x + bsum); } }
#pragma unroll
        for (int r = 0; r < 16; ++r) { const int hb = __builtin_bit_cast(int, hx[r]); float a = 0.f;
#pragma unroll
            for (int j = 0; j < 32; ++j) a += __builtin_bit_cast(float, __builtin_amdgcn_readlane(hb, j)) * w2r[j];
            acc[r] = a; }
#pragma unroll
        for (int r = 0; r < 16; ++r) part[(w * 16 + r) * 64 + lane] = acc[r];
        __syncthreads();
#pragma unroll
        for (int rr = 0; rr < 2; ++rr) { const int r = 2 * w + rr, R = R0 + r;
            float a = (kv ? INP_(I_VB2) : INP_(I_KB2))[layer * 64 + lane];
#pragma unroll
            for (int ww = 0; ww < 8; ++ww) a += part[(ww * 16 + r) * 64 + lane];
            if ((R & 127) == 127) a = 0.f;
            else if (kv == 0) { const float ms = wave_sum_u(a * a) * (1.0f / 64.0f); a = a * (rsqf_(ms + EPS)) * INP_(I_KG)[layer * 192 + lane]; }
            const bf16_t ab = (bf16_t)(cvt_pk_bf16(a, 0.f) & 0xffffu);
            ((bf16_t*)(F.ws + (kv ? WS_VC : WS_KC)))[(size_t)R * 64 + lane] = ab;
            if (kv) ((bf16_t*)(F.ws + WS_VCT))[((size_t)(R >> 7) * 64 + lane) * 128 + swap23(R & 127)] = ab; }
        __syncthreads();
    }
}

__device__ __forceinline__ void dots4(const bf16_t* krow, const LAS float* qs, float (&s)[4]) {
    s[0] = s[1] = s[2] = s[3] = 0.f;
#pragma nounroll
    for (int c = 0; c < 8; ++c) { const u32x4 v = *((const u32x4*)krow + c);
        const float f[8] = {bf_lo(v.x), bf_hi(v.x), bf_lo(v.y), bf_hi(v.y), bf_lo(v.z), bf_hi(v.z), bf_lo(v.w), bf_hi(v.w)};
#pragma unroll
        for (int h = 0; h < 4; ++h) { const f32x4 q0 = *(const LAS f32x4*)(qs + h * 64 + c * 8), q1 = *(const LAS f32x4*)(qs + h * 64 + c * 8 + 4);
            s[h] += (f[0] * q0.x + f[1] * q0.y) + (f[2] * q0.z + f[3] * q0.w) + (f[4] * q1.x + f[5] * q1.y) + (f[6] * q1.z + f[7] * q1.w); } }
}
__device__ __forceinline__ void softmax_pv(LAS f32x4* sb, const LAS int* kb, int nk, const bf16_t* V, int lane, float (&o)[4]) {
    float m[4] = {-1e30f, -1e30f, -1e30f, -1e30f};
#pragma nounroll
    for (int c = 0; c < nk; ++c) { const f32x4 s = sb[c * 64 + lane]; m[0] = fmaxf(m[0], s.x); m[1] = fmaxf(m[1], s.y); m[2] = fmaxf(m[2], s.z); m[3] = fmaxf(m[3], s.w); }
#pragma unroll
    for (int h = 0; h < 4; ++h) m[h] = wave_max(m[h]);
    float sum[4] = {0.f, 0.f, 0.f, 0.f};
#pragma nounroll
    for (int c = 0; c < nk; ++c) { const f32x4 s = sb[c * 64 + lane]; f32x4 p;
        p.x = s.x > -1e29f ? __expf(s.x - m[0]) : 0.f; p.y = s.y > -1e29f ? __expf(s.y - m[1]) : 0.f; p.z = s.z > -1e29f ? __expf(s.z - m[2]) : 0.f; p.w = s.w > -1e29f ? __expf(s.w - m[3]) : 0.f;
        sum[0] += p.x; sum[1] += p.y; sum[2] += p.z; sum[3] += p.w; sb[c * 64 + lane] = p; }
    float inv[4];
#pragma unroll
    for (int h = 0; h < 4; ++h) inv[h] = rcpf_(fmaxf(wave_sum(sum[h]), 1e-30f));
    LDS_WAIT(); __builtin_amdgcn_wave_barrier(); asm volatile("" ::: "memory");
    o[0] = o[1] = o[2] = o[3] = 0.f;
#pragma nounroll
    for (int c = 0; c < nk; ++c) { const int k0 = kb[c];
#pragma unroll 4
        for (int kk = 0; kk < 64; ++kk) { int key = k0 + kk; key = key < 0 ? 0 : (key > SEQ - 1 ? SEQ - 1 : key);
            const f32x4 p = sb[c * 64 + kk]; const float v = bf2f(V[(size_t)key * 64 + lane]);
            o[0] += p.x * v; o[1] += p.y * v; o[2] += p.z * v; o[3] += p.w * v; } }
#pragma unroll
    for (int h = 0; h < 4; ++h) o[h] *= inv[h];
    __builtin_amdgcn_wave_barrier(); asm volatile("" ::: "memory");
}
__device__ __forceinline__ void phase_attn_ref(Frame& F, int layer) {
    const int lane = F.lane;
    LAS unsigned char* wl = F.lds + F.wave * 12288;
    LAS float* qs = (LAS float*)wl;
    LAS f32x4* pc = (LAS f32x4*)(wl + 1024);
    LAS float* psum = (LAS float*)(wl + 3072);
    LAS int* kbl = (LAS int*)(wl + 3584);
    LAS f32x4* sb = (LAS f32x4*)(wl + 4096);
    const bf16_t* QN = (const bf16_t*)(F.ws + WS_Q); const bf16_t* KVb = (const bf16_t*)(F.ws + WS_KV);
    const bf16_t* KC = (const bf16_t*)(F.ws + WS_KC); const bf16_t* VC = (const bf16_t*)(F.ws + WS_VC);
    const float* GT = (const float*)(F.ws + WS_GT); bf16_t* MIX = (bf16_t*)(F.ws + WS_MIX);
#pragma nounroll
    for (int un = F.c; un < NBH * 64; un += F.G) {
        const int bh = un >> 6, tile = un & 63, b = bh >> 1, kvh = bh & 1;
        const bf16_t* KS = KVb + 2 * KVT + (size_t)bh * SEQ * 64; const bf16_t* VS = KVb + 3 * KVT + (size_t)bh * SEQ * 64;
        const bf16_t* KW = KVb + 4 * KVT + (size_t)bh * SEQ * 64; const bf16_t* VW = KVb + 5 * KVT + (size_t)bh * SEQ * 64;
#pragma nounroll
        for (int ti = 0; ti < 4; ++ti) {
            const int t = tile * 32 + F.wave * 4 + ti, r = b * SEQ + t;
#pragma unroll
            for (int h = 0; h < 4; ++h) qs[h * 64 + lane] = bf2f(QN[(size_t)r * 512 + (kvh * 4 + h) * 64 + lane]);
            LDS_WAIT(); __builtin_amdgcn_wave_barrier(); asm volatile("" ::: "memory");
            float sc[2][4]; bool vc[2];
#pragma unroll
            for (int u = 0; u < 2; ++u) { const int c = lane + 64 * u; vc[u] = (c < NCMP) && (16 * c + 31 <= t);
                if (vc[u]) dots4(KC + ((size_t)bh * 128 + c) * 64, qs, sc[u]); else { sc[u][0] = sc[u][1] = sc[u][2] = sc[u][3] = -1e30f; } }
            float pr[2][4];
#pragma unroll
            for (int h = 0; h < 4; ++h) { const float mx = wave_max(fmaxf(sc[0][h], sc[1][h]));
                pr[0][h] = vc[0] ? __expf(sc[0][h] - mx) : 0.f; pr[1][h] = vc[1] ? __expf(sc[1][h] - mx) : 0.f;
                const float inv = rcpf_(fmaxf(wave_sum(pr[0][h] + pr[1][h]), 1e-30f)); pr[0][h] *= inv; pr[1][h] *= inv; }
#pragma unroll
            for (int u = 0; u < 2; ++u) { pc[lane + 64 * u] = (f32x4){pr[u][0], pr[u][1], pr[u][2], pr[u][3]}; psum[lane + 64 * u] = (pr[u][0] + pr[u][1]) + (pr[u][2] + pr[u][3]); }
            LDS_WAIT(); __builtin_amdgcn_wave_barrier(); asm volatile("" ::: "memory");
            const int j = lane & 31, cur = t >> 6; float imp = 0.f;
#pragma unroll
            for (int cc = -1; cc <= 3; ++cc) { const int c = 4 * j + cc; if (c >= 0 && c < NCMP) imp += psum[c]; }
            const bool causal = (j * 64 <= t), forced = (j == 0) || (j == cur) || (j == cur - 1);
            const float score = causal ? (forced ? imp + 1e4f : imp) : -1e30f;
            int rank = 0;
#pragma unroll
            for (int i = 0; i < 32; ++i) { const float si = __shfl(score, i); rank += (si > score || (si == score && i < j)) ? 1 : 0; }
            const unsigned selmask = (unsigned)__ballot(lane < 32 && rank < 8 && causal);
            float ocmp[4] = {0.f, 0.f, 0.f, 0.f};
            { const int nvc = t >= 31 ? (((t - 31) >> 4) + 1 > NCMP ? NCMP : ((t - 31) >> 4) + 1) : 0;
#pragma unroll 4
              for (int c = 0; c < nvc; ++c) { const f32x4 p = pc[c]; const float v = bf2f(VC[((size_t)bh * 128 + c) * 64 + lane]); ocmp[0] += p.x * v; ocmp[1] += p.y * v; ocmp[2] += p.z * v; ocmp[3] += p.w * v; } }
            __builtin_amdgcn_wave_barrier(); asm volatile("" ::: "memory");
            int nk = 0; float osel[4], owin[4];
#pragma nounroll
            for (unsigned mm = selmask; mm != 0u && nk < 8; mm &= mm - 1u) { const int jj = __builtin_ctz(mm);
                const int key = jj * 64 + lane; float s[4];
                if (key <= t) dots4(KS + (size_t)key * 64, qs, s); else { s[0] = s[1] = s[2] = s[3] = -1e30f; }
                sb[nk * 64 + lane] = (f32x4){s[0], s[1], s[2], s[3]};
                if (lane == 0) kbl[nk] = jj * 64;
                ++nk; }
            LDS_WAIT(); __builtin_amdgcn_wave_barrier(); asm volatile("" ::: "memory");
            softmax_pv(sb, kbl, nk, VS, lane, osel);
            nk = 0;
#pragma nounroll
            for (int ch = 0; ch < 8; ++ch) { const int k0 = t - 511 + 64 * ch; if (k0 + 63 < 0) continue;
                const int key = k0 + lane; float s[4];
                if (key >= 0) dots4(KW + (size_t)key * 64, qs, s); else { s[0] = s[1] = s[2] = s[3] = -1e30f; }
                sb[nk * 64 + lane] = (f32x4){s[0], s[1], s[2], s[3]};
                if (lane == 0) kbl[nk] = k0;
                ++nk; }
            LDS_WAIT(); __builtin_amdgcn_wave_barrier(); asm volatile("" ::: "memory");
            softmax_pv(sb, kbl, nk, VW, lane, owin);
#pragma unroll
            for (int h = 0; h < 4; ++h) { const float* gp = GT + (size_t)r * 24 + (kvh * 4 + h) * 3;
                const float o = sigmoidf_(gp[0]) * ocmp[h] + sigmoidf_(gp[1]) * osel[h] + sigmoidf_(gp[2]) * owin[h];
                MIX[(size_t)r * D + 512 + (kvh * 4 + h) * 64 + lane] = (bf16_t)(cvt_pk_bf16(o, 0.f) & 0xffffu); }
            __builtin_amdgcn_wave_barrier(); asm volatile("" ::: "memory");
        }
    }
}


constexpr int AT_KB = 0, AT_VB = 18432, AT_WUN = 36864, AT_OT = 40960;
__device__ __forceinline__ int crow_(int i) { return (i & 3) + 8 * (i >> 2); }
__device__ __forceinline__ float fmax_(float a, float b) { return __builtin_amdgcn_fmed3f(a, b, __builtin_inff()); }
template <int MODE>
__device__ __forceinline__ void attn_tile(const LAS unsigned char* KB, const LAS unsigned char* VB, const bf16x8 (&Qf)[4], f32x16 (&O)[2], float cref, float& l, int tl, int lo, bool rowok, int n, int h) {
    f32x16 S0, S1;
#pragma unroll
    for (int i = 0; i < 16; ++i) { S0[i] = 0.f; S1[i] = 0.f; }
#pragma unroll
    for (int s = 0; s < 4; ++s) { const bf16x8 k0 = *(const LAS bf16x8*)(KB + n * 144 + (16 * s + 8 * h) * 2), k1 = *(const LAS bf16x8*)(KB + (32 + n) * 144 + (16 * s + 8 * h) * 2);
        S0 = MFMA32(k0, Qf[s], S0); S1 = MFMA32(k1, Qf[s], S1); }
    if (MODE != 0) {
#pragma unroll
        for (int i = 0; i < 16; ++i) { const int c0 = crow_(i), c1 = 32 + crow_(i);
            if (MODE == 2) { S0[i] = (c0 <= tl && c0 > lo) ? S0[i] : -1e30f; S1[i] = (c1 <= tl && c1 > lo) ? S1[i] : -1e30f; } } }
    f32x2 ls2 = {0.f, 0.f}; const float crow = (MODE == 1) ? (rowok ? cref : 1e30f) : cref; const f32x2 mr2 = {crow, crow};
#pragma unroll
    for (int i = 0; i < 8; ++i) { f32x2 a = (f32x2){S0[2 * i], S0[2 * i + 1]} - mr2, b = (f32x2){S1[2 * i], S1[2 * i + 1]} - mr2;
        a.x = __builtin_amdgcn_exp2f(a.x); a.y = __builtin_amdgcn_exp2f(a.y); b.x = __builtin_amdgcn_exp2f(b.x); b.y = __builtin_amdgcn_exp2f(b.y);
        S0[2 * i] = a.x; S0[2 * i + 1] = a.y; S1[2 * i] = b.x; S1[2 * i + 1] = b.y; ls2 += a + b; }
    l += ls2.x + ls2.y;
    const bf16x8 P00 = pack8<0>(S0), P01 = pack8<8>(S0), P10 = pack8<0>(S1), P11 = pack8<8>(S1);
    __builtin_amdgcn_sched_barrier(0);
#pragma unroll
    for (int d = 0; d < 2; ++d) { const LAS unsigned char* vb = VB + (32 * d + n) * 144 + 8 * h * 2;
        O[d] = MFMA32(*(const LAS bf16x8*)(vb + 0), P00, O[d]); O[d] = MFMA32(*(const LAS bf16x8*)(vb + 32), P01, O[d]);
        O[d] = MFMA32(*(const LAS bf16x8*)(vb + 64), P10, O[d]); O[d] = MFMA32(*(const LAS bf16x8*)(vb + 96), P11, O[d]); }
}
__device__ __forceinline__ void attn_stage64(LAS unsigned char* lds, const bf16_t* K, const bf16_t* VT, int tid) {
    const int row = tid >> 3, ch = tid & 7;
    const u32x4 kv = *((const u32x4*)K + tid), vv = *(const u32x4*)(VT + (size_t)row * SEQ + ch * 8);
    *(LAS u32x4*)(lds + AT_KB + row * 144 + ch * 16) = kv; *(LAS u32x4*)(lds + AT_VB + row * 144 + ch * 16) = vv;
}
__device__ __forceinline__ void phase_attn_mfma(Frame& F, int layer) {
    const int lane = F.lane, tid = F.tid, n = lane & 31, h = lane >> 5, w = F.wave;
    LAS unsigned char* lds = F.lds; const LAS unsigned char* KB = lds + AT_KB; const LAS unsigned char* VB = lds + AT_VB; volatile LAS unsigned* WUN = (volatile LAS unsigned*)(lds + AT_WUN);
    const bf16_t* QN = (const bf16_t*)(F.ws + WS_Q); const bf16_t* KVb = (const bf16_t*)(F.ws + WS_KV);
    const bf16_t* KC = (const bf16_t*)(F.ws + WS_KC); const bf16_t* VCT = (const bf16_t*)(F.ws + WS_VCT);
    const bf16_t* VST = (const bf16_t*)(F.ws + WS_VST); const bf16_t* VWT = (const bf16_t*)(F.ws + WS_VWT);
    const float* GT = (const float*)(F.ws + WS_GT); bf16_t* MIX = (bf16_t*)(F.ws + WS_MIX);
    float cref;
    { const float gq = fabsf(INP_(I_QG)[layer * 64 + lane]); const float* kg = INP_(I_KG) + layer * 192;
      const float gk = fmaxf(fabsf(kg[lane]), fmaxf(fabsf(kg[64 + lane]), fabsf(kg[128 + lane])));
      const float bound = 1.44269504089f * 8.0f * wave_max(gq) * wave_max(gk); cref = fmaxf(bound - 16.0f, 0.f); }
#pragma nounroll
    for (int ui = 0; ui < 2; ++ui) {
        const int bh = (F.c >> 5) + 8 * ui, tb = ui ? 31 - (F.c & 31) : (F.c & 31);
        if (F.c >= 256) break;
        const int b = bh >> 1, kvh = bh & 1, t0 = tb * 64, cur = tb;
        const int tt = t0 + 8 * w + (n >> 2), hd = n & 3; const size_t r = (size_t)b * SEQ + tt;
        bf16x8 Qf[4]; { const bf16_t* qp = QN + r * 512 + (kvh * 4 + hd) * 64 + 8 * h;
#pragma unroll
            for (int s = 0; s < 4; ++s) Qf[s] = *(const bf16x8*)(qp + 16 * s); }
        {
            float qv[4][8]; float ss = 0.f;
#pragma unroll
            for (int s = 0; s < 4; ++s) { const u32x4 wq = __builtin_bit_cast(u32x4, Qf[s]);
                qv[s][0] = bf_lo(wq.x); qv[s][1] = bf_hi(wq.x); qv[s][2] = bf_lo(wq.y); qv[s][3] = bf_hi(wq.y); qv[s][4] = bf_lo(wq.z); qv[s][5] = bf_hi(wq.z); qv[s][6] = bf_lo(wq.w); qv[s][7] = bf_hi(wq.w);
#pragma unroll
                for (int j = 0; j < 8; ++j) ss += qv[s][j] * qv[s][j]; }
            ss = xsum32(ss);
            const float rsq = rsqf_(ss * (1.0f / 64.0f) + EPS) * (0.125f * 1.44269504089f); const float* qg     = INP_(I_QG) + layer * 64 + 8 * h;
#pragma unroll
            for (int s = 0; s < 4; ++s) { const f32x4 ga = *(const f32x4*)(qg + 16 * s), gb = *(const f32x4*)(qg + 16 * s + 4);
                u32x4 wq; wq.x = pk_bf16(qv[s][0] * rsq * ga.x, qv[s][1] * rsq * ga.y); wq.y = pk_bf16(qv[s][2] * rsq * ga.z, qv[s][3] * rsq * ga.w);
                wq.z = pk_bf16(qv[s][4] * rsq * gb.x, qv[s][5] * rsq * gb.y); wq.w = pk_bf16(qv[s][6] * rsq * gb.z, qv[s][7] * rsq * gb.w); Qf[s] = __builtin_bit_cast(bf16x8, wq); } }
        const float* gp = GT + r * 24 + (kvh * 4 + hd) * 3; const float g0 = sigmoidf_(gp[0]), g1 = sigmoidf_(gp[1]), g2 = sigmoidf_(gp[2]);
        f32x16 Ob[2]; LAS f32x4* OT = (LAS f32x4*)(lds + AT_OT + w * 8192) + lane;
        unsigned tokmask, wmask;
        __syncthreads();
#pragma unroll
        for (int q = 0; q < 2; ++q) { const int i = tid + 512 * q;
            *(LAS u32x4*)(lds + AT_KB + (i >> 3) * 144 + (i & 7) * 16) = *((const u32x4*)(KC + (size_t)bh * 128 * 64) + i);
            *(LAS u32x4*)(lds + AT_VB + (i >> 4) * 272 + (i & 15) * 16) = *((const u32x4*)(VCT + (size_t)bh * 64 * 128) + i); }
        __syncthreads();
        {
            f32x16 S[4];
#pragma unroll
            for (int ta = 0; ta < 4; ++ta) {
#pragma unroll
                for (int i = 0; i < 16; ++i) S[ta][i] = 0.f;
#pragma unroll
                for (int s = 0; s < 4; ++s) S[ta] = MFMA32(*(const LAS bf16x8*)(KB + (32 * ta + n) * 144 + (16 * s + 8 * h) * 2), Qf[s], S[ta]); }
            const int cmax = tt >= 31 ? (((tt - 31) >> 4) > 126 ? 126 : ((tt - 31) >> 4)) : -1, lim = cmax - 4 * h;
            float ls = 0.f;
#pragma unroll
            for (int ta = 0; ta < 4; ++ta)
#pragma unroll
                for (int i = 0; i < 16; ++i) { const float p = (32 * ta + crow_(i) <= lim) ? __builtin_amdgcn_exp2f(S[ta][i] - cref) : 0.f; S[ta][i] = p; ls += p; }
            ls = xsum32(ls);
            const float inv = rcpf_(fmaxf(ls, 1e-30f));
#pragma unroll
            for (int ta = 0; ta < 4; ++ta)
#pragma unroll
                for (int i = 0; i < 16; ++i) S[ta][i] *= inv;
            float val[4][4]; unsigned kk[4];
#pragma unroll
            for (int ta = 0; ta < 4; ++ta)
#pragma unroll
                for (int u = 0; u < 4; ++u) { val[ta][u] = (S[ta][4 * u] + S[ta][4 * u + 1]) + (S[ta][4 * u + 2] + S[ta][4 * u + 3]); }
            {   float xs[4][4];
#pragma unroll
                for (int ta = 0; ta < 4; ++ta)
#pragma unroll
                    for (int u = 0; u < 4; ++u) xs[ta][u] = xget32(S[ta][4 * u + 3], h);
#pragma unroll
                for (int ta = 0; ta < 4; ++ta)
#pragma unroll
                    for (int u = 0; u < 4; ++u) { const float pv0 = (u > 0) ? xs[ta][u > 0 ? u - 1 : 0] : (ta > 0 ? xs[ta > 0 ? ta - 1 : 0][3] : 0.f); val[ta][u] += (h ? xs[ta][u] : pv0); } }
            const bf16x8 P0 = pack8<0>(S[0]), P1 = pack8<8>(S[0]), P2 = pack8<0>(S[1]), P3 = pack8<8>(S[1]), P4 = pack8<0>(S[2]), P5 = pack8<8>(S[2]), P6 = pack8<0>(S[3]), P7 = pack8<8>(S[3]);
            __builtin_amdgcn_sched_barrier(0);
            const bool b0 = (n & 1) != 0, b1 = (n & 2) != 0; const int hd2 = 2 * (n & 3) + h;
#define DPPF(x, ctrl) __builtin_bit_cast(float, __builtin_amdgcn_update_dpp(0, __builtin_bit_cast(int, (x)), (ctrl), 0xF, 0xF, true))
#define DPPU(x, ctrl) ((unsigned)__builtin_amdgcn_update_dpp(0, (int)(x), (ctrl), 0xF, 0xF, true))
#pragma unroll
            for (int ta = 0; ta < 4; ++ta) {
                const float m0 = b0 ? val[ta][1] : val[ta][0], s0 = b0 ? val[ta][0] : val[ta][1], m1 = b0 ? val[ta][3] : val[ta][2], s1 = b0 ? val[ta][2] : val[ta][3];
                const float r0 = m0 + DPPF(s0, 0xB1), r1 = m1 + DPPF(s1, 0xB1);
                const float mm = b1 ? r1 : r0, ss = b1 ? r0 : r1; const float v = mm + DPPF(ss, 0x4E);
                const int G = 8 * ta + hd2; const bool causal = G <= cur, forced = (G == 0) || (G == cur) || (G == cur - 1);
                kk[ta] = causal ? ((forced ? 0x7f000000u : (__float_as_uint(v) & ~31u)) | (unsigned)(31 - G)) : 0u; }
            __builtin_amdgcn_sched_barrier(0);
#pragma unroll
            for (int d = 0; d < 2; ++d) {
#pragma unroll
                for (int i = 0; i < 16; ++i) Ob[d][i] = 0.f;
                const LAS unsigned char* vb = VB + (32 * d + n) * 272 + 8 * h * 2;
                Ob[d] = MFMA32(*(const LAS bf16x8*)(vb + 0), P0, Ob[d]); Ob[d] = MFMA32(*(const LAS bf16x8*)(vb + 32), P1, Ob[d]);
                Ob[d] = MFMA32(*(const LAS bf16x8*)(vb + 64), P2, Ob[d]); Ob[d] = MFMA32(*(const LAS bf16x8*)(vb + 96), P3, Ob[d]);
                Ob[d] = MFMA32(*(const LAS bf16x8*)(vb + 128), P4, Ob[d]); Ob[d] = MFMA32(*(const LAS bf16x8*)(vb + 160), P5, Ob[d]);
                Ob[d] = MFMA32(*(const LAS bf16x8*)(vb + 192), P6, Ob[d]); Ob[d] = MFMA32(*(const LAS bf16x8*)(vb + 224), P7, Ob[d]);
#pragma unroll
                for (int q = 0; q < 4; ++q) OT[(4 * d + q) * 64] = (f32x4){Ob[d][4 * q] * g0, Ob[d][4 * q + 1] * g0, Ob[d][4 * q + 2] * g0, Ob[d][4 * q + 3] * g0}; }
            __builtin_amdgcn_sched_barrier(0);
            unsigned selbits = 0u;
#pragma unroll
            for (int rd = 0; rd < 8; ++rd) { unsigned mk = kk[0] > kk[1] ? kk[0] : kk[1]; { const unsigned m2 = kk[2] > kk[3] ? kk[2] : kk[3]; mk = m2 > mk ? m2 : mk; }
                { const unsigned o = DPPU(mk, 0xB1); mk = o > mk ? o : mk; } { const unsigned o = DPPU(mk, 0x4E); mk = o > mk ? o : mk; }
                mk = xmax32u(mk);
#pragma unroll
                for (int ta = 0; ta < 4; ++ta) { const bool hit = (kk[ta] == mk) && (mk != 0u); selbits |= hit ? ((1u << (8 * ta)) << hd2) : 0u; kk[ta] = hit ? 0u : kk[ta]; } }
            selbits |= DPPU(selbits, 0xB1); selbits |= DPPU(selbits, 0x4E);
            tokmask = xor32u(selbits);
#undef DPPF
#undef DPPU
            unsigned wm = tokmask; wm |= (unsigned)__shfl_xor((int)wm, 4); wm |= (unsigned)__shfl_xor((int)wm, 8); wm |= (unsigned)__shfl_xor((int)wm, 16);
            wmask = (unsigned)__builtin_amdgcn_readfirstlane((int)wm);
            if (lane == 0) WUN[w] = wmask;
        }
        __syncthreads();
        unsigned uall = 0u;
#pragma unroll
        for (int q = 0; q < 8; ++q) uall |= WUN[q];
        uall = (unsigned)__builtin_amdgcn_readfirstlane((int)uall);
        if (PROBE_MASK & 0x6000000u) { if (lane == 0) ((unsigned*)(F.ws + WS_SLOT + 3 * MAXSLOT * 4))[(blockIdx.x * 2 + ui) * 8 + w] = (unsigned)__builtin_popcount(uall) | ((unsigned)__builtin_popcount(wmask) << 8); }
        float l = 0.f;
#pragma unroll
        for (int d = 0; d < 2; ++d)
#pragma unroll
            for (int i = 0; i < 16; ++i) Ob[d][i] = 0.f;
        const int j0 = cur > 8 ? cur - 8 : 0, nwin = cur - j0 + 1, ntile = nwin + __builtin_popcount(uall);
        const int srow = tid >> 3, sch = tid & 7;
        int lidx = 0, cidx = 0; unsigned lmm = uall, cmm = uall; u32x4 rk0, rv0, rk1, rv1, rk2, rv2;
#define AT_NEXT(idx, mm, wh, jj) do { if ((idx) < nwin) { (wh) = 1; (jj) = j0 + (idx); } else { (wh) = 0; (jj) = (mm) ? __builtin_ctz(mm) : 0; (mm) &= (mm) - 1u; } ++(idx); } while (0)
#define AT_LOAD(rk, rv) do { int _wh, _jj; AT_NEXT(lidx, lmm, _wh, _jj); const bf16_t* _kp = KVb + (size_t)(_wh ? 4 : 2) * KVT + ((size_t)bh * SEQ + _jj * 64) * 64; const bf16_t* _vp = (_wh ? VWT : VST) + (size_t)bh * 64 * SEQ + _jj * 64; \
        rk = *((const u32x4*)_kp + tid); rv = *(const u32x4*)(_vp + (size_t)srow * SEQ + sch * 8); } while (0)
#define AT_WRITE(b, rk, rv) do { *(LAS u32x4*)(lds + (b) * 18432 + srow * 144 + sch * 16) = rk; *(LAS u32x4*)(lds + (b) * 18432 + 9216 + srow * 144 + sch * 16) = rv; } while (0)
        AT_LOAD(rk0, rv0); AT_LOAD(rk1, rv1); AT_LOAD(rk2, rv2);
        AT_WRITE(0, rk0, rv0);
        AT_LOAD(rk0, rv0);
#define AT_STEP(i, RK, RV) do { asm volatile("s_waitcnt lgkmcnt(0)" ::: "memory"); __builtin_amdgcn_s_barrier(); asm volatile("" ::: "memory"); \
            AT_WRITE(((i) + 1) & 1, RK, RV); AT_LOAD(RK, RV); \
            int wh, j; AT_NEXT(cidx, cmm, wh, j); \
            if (i == nwin) { \
                const float lt = xsum32(l), sc = g2 * rcpf_(fmaxf(lt, 1e-30f)); \
_Pragma("unroll") \
                for (int d = 0; d < 2; ++d) \
_Pragma("unroll") \
                    for (int q = 0; q < 4; ++q) { f32x4 o = OT[(4 * d + q) * 64]; o.x += Ob[d][4 * q] * sc; o.y += Ob[d][4 * q + 1] * sc; o.z += Ob[d][4 * q + 2] * sc; o.w += Ob[d][4 * q + 3] * sc; OT[(4 * d + q) * 64] = o; \
                        Ob[d][4 * q] = 0.f; Ob[d][4 * q + 1] = 0.f; Ob[d][4 * q + 2] = 0.f; Ob[d][4 * q + 3] = 0.f; } \
                l = 0.f; } \
            const LAS unsigned char* kb = lds + (i & 1) * 18432; const LAS unsigned char* vb = kb + 9216; \
            const int tl = tt - 64 * j - 4 * h; \
            if (wh) { if (j == cur || j == cur - 8) attn_tile<2>(kb, vb, Qf, Ob, cref, l, tl, j == cur - 8 ? tl - 512 : -100000, true, n, h); else attn_tile<0>(kb, vb, Qf, Ob, cref, l, 0, 0, true, n, h); } \
            else if ((wmask >> j) & 1u) { const bool rowok = ((tokmask >> j) & 1u) != 0u; \
                if (j == cur) attn_tile<2>(kb, vb, Qf, Ob, cref, l, rowok ? tl : -1, -100000, true, n, h); else attn_tile<1>(kb, vb, Qf, Ob, cref, l, 0, 0, rowok, n, h); } \
        } while (0)
#pragma nounroll
        for (int i = 0; i < ntile; i += 3) { AT_STEP(i, rk1, rv1); if (i + 1 >= ntile) break; AT_STEP(i + 1, rk2, rv2); if (i + 2 >= ntile) break; AT_STEP(i + 2, rk0, rv0); }
#undef AT_STEP
#undef AT_NEXT
#undef AT_LOAD
#undef AT_WRITE
        { const float lt = xsum32(l), sc = g1 * rcpf_(fmaxf(lt, 1e-30f));
          bf16_t* op = MIX + r * D + 512 + (kvh * 4 + hd) * 64 + 4 * h;
#pragma unroll
          for (int d = 0; d < 2; ++d)
#pragma unroll
            for (int u = 0; u < 4; ++u) { const f32x4 o = OT[(4 * d + u) * 64]; u32x2 ov; ov.x = pk_bf16(o.x + Ob[d][4 * u] * sc, o.y + Ob[d][4 * u + 1] * sc); ov.y = pk_bf16(o.z + Ob[d][4 * u + 2] * sc, o.w + Ob[d][4 * u + 3] * sc);
                *(u32x2*)(op + 32 * d + 8 * u) = ov; } }
    }
}

__device__ __forceinline__ int build_ptab(Frame& F) {
    LAS int* ptab = (LAS int*)(F.lds + PTAB_OFF);
    const unsigned* cnt = (const unsigned*)(F.ws + WS_CTL) + CW_CNT;
    if (F.tid < 64) {
        const int e = F.tid; const unsigned c = (e < NE) ? __hip_atomic_load(cnt + 64 * e, __ATOMIC_RELAXED, __HIP_MEMORY_SCOPE_AGENT) : 0u;
        const int n = (int)((c + 255u) >> 8); int incl = n;
#pragma unroll
        for (int o = 1; o < 8; o <<= 1) { const int t = __shfl_up(incl, o); if (e >= o) incl += t; }
        const int excl = incl - n;
        if (e < NE) { ptab[MAXPAN + 8 + e] = excl * 256; for (int i = 0; i < n && excl + i < MAXPAN; ++i) ptab[excl + i] = e; }
        if (e == NE - 1) ptab[MAXPAN] = incl < MAXPAN ? incl : MAXPAN; }
    __syncthreads();
    return ptab[MAXPAN];
}

template <unsigned KM> __global__ void __launch_bounds__(NTHR, 2) fwd(Args args) {
    extern __shared__ __attribute__((aligned(16))) unsigned char lds_raw[];
    Frame F; F.lds = (LAS unsigned char*)lds_raw; F.tid = threadIdx.x; F.lane = F.tid & 63; F.wave = __builtin_amdgcn_readfirstlane(F.tid >> 6);
    F.G = gridDim.x; F.c = blockIdx.x; F.in = args.in; F.out = args.out; F.ws = args.ws;
    volatile LAS unsigned* MISC = (volatile LAS unsigned*)(F.lds + MISC_OFF);
    if (F.tid < 64) MISC[F.tid] = 0u;
    __syncthreads();
    unsigned* ctl = (unsigned*)(F.ws + WS_CTL);
#if MK_PER_PHASE
#define SEAM() do {} while (0)
#else
    XcdBarrier bar = xcd_barrier_post(ctl + CW_BAR, MISC);
#define SEAM() xcd_barrier(bar)
#endif
    const int lo = args.ph_lo, hi = args.ph_hi;
#define KON(kind) (((KM) >> (kind)) & 1u)
#define IN(k) (lo <= (k) && (k) < hi)
#define gw (F.c * NWAVES + F.wave)
#define NGW (F.G * NWAVES)
#define XB ((bf16_t*)(F.ws + WS_XB))
#define RS ((float*)(F.ws + WS_RSTD))

    if (KON(0) && IN(0)) { FRESH_TID(F); PMARK(0); phase_prologue(F); SEAM(); }

    for (int layer = 0; layer < 2; ++layer) {
        const int pb = 1 + 12 * layer;
        if (KON(1) && IN(pb + 0)) { FRESH_TID(F); PMARK(pb + 0);
            pg8::Gemm g{XB, (const bf16_t*)(F.ws + WS_WIN) + (size_t)layer * INP * D, D, D, D}; pg8::SchedGrid S; S.init(M / 256, INP / 256, F.G, F.c, D, D);
            EpiIn E{RS, (bf16_t*)(F.ws + WS_U), (bf16_t*)(F.ws + WS_Q), (bf16_t*)(F.ws + WS_KV), (float*)(F.ws + WS_GT), layer ? (const float*)(F.ws + WS_PSS) : nullptr, (LAS float*)(F.lds + RSL_OFF)};
            pg8::gemm_phase(F.lds, g, S, E); moe_conv_slot(F, layer == 0 ? 0 : 2); SEAM();
        }
        if (KON(2) && IN(pb + 1)) { FRESH_TID(F); PMARK(pb + 1);
            { pg8::Gemm g{(const bf16_t*)(F.ws + WS_KV), (const bf16_t*)(F.ws + WS_WC1), 256, 1024, 2048}; SchedCmp S{F.G, F.c, layer};
              EpiH1 E{(float*)(F.ws + WS_H1)}; pg8::gemm_phase(F.lds, g, S, E); }
            if (F.G >= 256) { if (F.c >= 128) vtrans_items(F, (F.c - 128) * NWAVES + F.wave, (F.G - 128) * NWAVES); }
            else vtrans_items(F, gw, NGW);
#ifdef ATTN_REF
            norm_rows64((bf16_t*)(F.ws + WS_Q), M * 8, INP_(I_QG) + layer * 64, 0.125f, gw, NGW, F.lane);
#endif
            norm_rows64((bf16_t*)(F.ws + WS_KV) + 2 * KVT, NBH * SEQ, INP_(I_KG) + layer * 192 + 64, 1.0f, gw, NGW, F.lane);
            norm_rows64((bf16_t*)(F.ws + WS_KV) + 4 * KVT, NBH * SEQ, INP_(I_KG) + layer * 192 + 128, 1.0f, gw, NGW, F.lane);
            SEAM();
        }
        if (KON(3) && IN(pb + 2)) { FRESH_TID(F); PMARK(pb + 2); for (int cu = F.c; cu < 512; cu += F.G) conv_unit(F, layer, cu); PMARK(30); phase_cmp2(F, layer); SEAM(); }
#ifndef ATTN_REF
        if (KON(4) && IN(pb + 3)) { FRESH_TID(F); PMARK(pb + 3); phase_attn_mfma(F, layer); SEAM(); }
#else
        if (KON(4) && IN(pb + 3)) { FRESH_TID(F); PMARK(pb + 3); phase_attn_ref(F, layer); SEAM(); }
#endif
        if (KON(5) && IN(pb + 4)) { FRESH_TID(F); PMARK(pb + 4);
            pg8::Gemm g{(const bf16_t*)(F.ws + WS_MIX), (const bf16_t*)(F.ws + WS_WOUT) + (size_t)layer * D * D, D, D, D}; pg8::SchedGrid S; S.init(M / 256, D / 256, F.G, F.c, D, D);
            { EpiRes<true> E{XB, XB, layer == 0 ? (float*)(F.ws + WS_PSS) : nullptr}; pg8::gemm_phase(F.lds, g, S, E); }
            SEAM();
        }
        if (KON(6) && IN(pb + 5) && layer == 1) { FRESH_TID(F); PMARK(pb + 5);
            f32x4 v[4];
            {
                const float* RT = (const float*)(F.ws + WS_RT); unsigned* cnt = ctl + CW_CNT; int* ROUTE = (int*)(F.ws + WS_ROUTE);
                int* stok = (int*)(F.ws + WS_SLOT);
                const int cb0 = __builtin_amdgcn_readfirstlane((int)blockIdx.x * NTHR);
#pragma nounroll
                for (int i = cb0 + F.tid; i < MAXSLOT; i += F.G * NTHR) stok[i] = -1;
                LAS f32x4* RTL = (LAS f32x4*)F.lds;
                { f32x4 sv[4];
#pragma unroll
                  for (int q = 0; q < 4; ++q) sv[q] = *((const f32x4*)RT + F.tid + q * NTHR);
#pragma unroll
                  for (int q = 0; q < 4; ++q) RTL[F.tid + q * NTHR] = sv[q]; }
                __syncthreads();
#pragma nounroll
                for (int mb0 = 0; mb0 < M; mb0 += 8 * NGW) { const int mb = mb0 + gw;
                    int me0 = -1, me1 = -1; float mw0 = 0.f, mw1 = 0.f;
#pragma nounroll
                    for (int i4 = 0; i4 < 8; i4 += 4) {
                        f32x4 xv[4][4];
#pragma unroll
                        for (int q = 0; q < 4; ++q) { const int m = mb + (i4 + q) * NGW; const u32x2* xr = (const u32x2*)(XB + (size_t)(m < M ? m : 0) * D) + F.lane;
#pragma unroll
                            for (int j = 0; j < 4; ++j) { const u32x2 wv = xr[64 * j]; xv[q][j] = (f32x4){bf_lo(wv.x), bf_hi(wv.x), bf_lo(wv.y), bf_hi(wv.y)}; } }
#pragma unroll
                        for (int q = 0; q < 4; ++q) { const int i = i4 + q, m = mb + i * NGW; if (m >= M) break;
                            f32x2e ss2 = {0.f, 0.f};
#pragma unroll
                            for (int j = 0; j < 4; ++j) { const f32x2e xl = LO2(xv[q][j]), xh = HI2(xv[q][j]); ss2 = __builtin_elementwise_fma(xl, xl, ss2); ss2 = __builtin_elementwise_fma(xh, xh, ss2); }
                            const float rs = rsqf_(wave_sum_u(ss2.x + ss2.y) * (1.0f / D) + EPS);
                            if (F.lane == 0) RS[m] = rs;
                            float lg[8];
#pragma unroll
                            for (int e = 0; e < 8; ++e) { f32x2e sd2 = {0.f, 0.f};
#pragma unroll
                                for (int j = 0; j < 4; ++j) { const f32x4 wv = RTL[e * 256 + 64 * j + F.lane]; sd2 = __builtin_elementwise_fma(LO2(xv[q][j]), LO2(wv), sd2); sd2 = __builtin_elementwise_fma(HI2(xv[q][j]), HI2(wv), sd2); }
                                lg[e] = wave_sum_u(sd2.x + sd2.y); }
                            int e0 = 0; float l0 = lg[0];
#pragma unroll
                            for (int e = 1; e < 8; ++e) if (lg[e] > l0) { l0 = lg[e]; e0 = e; }
                            int e1 = -1; float l1 = -3.0e38f;
#pragma unroll
                            for (int e = 0; e < 8; ++e) if (e != e0 && lg[e] > l1) { l1 = lg[e]; e1 = e; }
                            const float p1 = __expf((l1 - l0) * rs), w0 = rcpf_(1.0f + p1), w1 = p1 * w0;
                            if (F.lane == i) { me0 = e0; me1 = e1; mw0 = w0; mw1 = w1; } } }
                    int r0 = 0, r1 = 0, c_mine = 0; const unsigned long long low = (1ull << F.lane) - 1ull;
#pragma unroll
                    for (int e = 0; e < 8; ++e) { const unsigned long long b0 = __ballot(me0 == e), b1 = __ballot(me1 == e);
                        if (me0 == e) r0 = __popcll(b0 & low) + __popcll(b1 & low); if (me1 == e) r1 = __popcll(b0 & low) + __popcll(b1 & low);
                        if (F.lane == e) c_mine = __popcll(b0) + __popcll(b1); }
                    LAS int* WC = (LAS int*)(F.lds + 32768);
                    if (F.lane < 8) WC[F.wave * 8 + F.lane] = c_mine;
                    __syncthreads();
                    if (F.wave == 0 && F.lane < 8) { int tot = 0;
#pragma unroll
                        for (int ww = 0; ww < 8; ++ww) tot += WC[ww * 8 + F.lane];
                        WC[64 + F.lane] = tot > 0 ? (int)atomicAdd(cnt + 64 * F.lane, (unsigned)tot) : 0; }
                    __syncthreads();
                    int basev = 0;
                    if (F.lane < 8) { basev = WC[64 + F.lane];
#pragma unroll
                        for (int ww = 0; ww < 8; ++ww) basev += (ww < F.wave) ? WC[ww * 8 + F.lane] : 0; }
                    __syncthreads();
                    const int b0v = __shfl(basev, me0 < 0 ? 0 : me0), b1v = __shfl(basev, me1 < 0 ? 0 : me1);
                    if (me0 >= 0) { const int m = mb + F.lane * NGW; int* rp = ROUTE + (size_t)m * 6; rp[0] = me0; rp[1] = b0v + r0; rp[2] = me1; rp[3] = b1v + r1; rp[4] = __float_as_int(mw0); rp[5] = __float_as_int(mw1); }
                }
            }
            SEAM();
        }
        if (layer == 0) {
            if (KON(7) && IN(pb + 6)) { FRESH_TID(F); PMARK(pb + 6);
                pg8::Gemm g{XB, (const bf16_t*)(F.ws + WS_WF1), D, D, D}; pg8::SchedGrid S; S.init(M / 256, 2 * DFF / 256, F.G, F.c, D, D);
                EpiGlu E{RS, (bf16_t*)(F.ws + WS_ACT), DFF, 0, (const float*)(F.ws + WS_PSS), (LAS float*)(F.lds + RSL_OFF)}; pg8::gemm_phase(F.lds, g, S, E); moe_conv_slot(F, 1); SEAM();
            }
            if (KON(8) && IN(pb + 7)) { FRESH_TID(F); PMARK(pb + 7);
                pg8::Gemm g{(const bf16_t*)(F.ws + WS_ACT), (const bf16_t*)(F.ws + WS_WF2), DFF, DFF, DFF}; pg8::SchedGrid S; S.init(M / 256, D / 256, F.G, F.c, DFF, DFF);
                EpiRes<true> E{XB, XB, (float*)(F.ws + WS_PSS)}; pg8::gemm_phase(F.lds, g, S, E); SEAM();
            }
        } else {
            if (KON(10) && IN(pb + 6)) { FRESH_TID(F); PMARK(pb + 6);
                build_ptab(F); const LAS int* ptab = (const LAS int*)(F.lds + PTAB_OFF);
                const int* ROUTE = (const int*)(F.ws + WS_ROUTE); int* stok = (int*)(F.ws + WS_SLOT); float* sw = (float*)(stok + MAXSLOT); float* srs = sw + MAXSLOT; unsigned char* XS8 = F.ws + WS_XS;
#pragma nounroll
                for (int mb = gw; mb < M; mb += 4 * NGW) {
                    int rt[4][6]; u32x4 ra[4], rb[4];
#pragma unroll
                    for (int q = 0; q < 4; ++q) { const int m = mb + q * NGW < M ? mb + q * NGW : 0; const int* rp = ROUTE + (size_t)m * 6;
#pragma unroll
                        for (int z = 0; z < 6; ++z) rt[q][z] = rp[z];
                        const u32x4* src = (const u32x4*)(XB + (size_t)m * D) + F.lane; ra[q] = src[0]; rb[q] = src[64]; }
#pragma unroll
                    for (int q = 0; q < 4; ++q) { const int m = mb + q * NGW; if (m >= M) break;
#pragma unroll
                        for (int k = 0; k < 2; ++k) { const int e = rt[q][2 * k], pos = rt[q][2 * k + 1], slot = ptab[MAXPAN + 8 + e] + pos; unsigned char* drow = XS8 + (size_t)slot * D + 8 * F.lane;
                            *(u32x2*)drow = pk8_fp8(bf_lo(ra[q].x), bf_hi(ra[q].x), bf_lo(ra[q].y), bf_hi(ra[q].y), bf_lo(ra[q].z), bf_hi(ra[q].z), bf_lo(ra[q].w), bf_hi(ra[q].w));
                            *(u32x2*)(drow + 512) = pk8_fp8(bf_lo(rb[q].x), bf_hi(rb[q].x), bf_lo(rb[q].y), bf_hi(rb[q].y), bf_lo(rb[q].z), bf_hi(rb[q].z), bf_lo(rb[q].w), bf_hi(rb[q].w));
                            if (F.lane == 0) { stok[slot] = m * 2 + k; sw[slot] = __int_as_float(rt[q][4 + k]); srs[slot] = RS[m]; } } } }
                SEAM();
            }
            if (KON(11) && IN(pb + 7)) { FRESH_TID(F); PMARK(pb + 7);
                const int npan = build_ptab(F); const MoePlan P = moe_plan(npan, F.G);
                const int* stok = (const int*)(F.ws + WS_SLOT); const float* srs = (const float*)(stok + 2 * MAXSLOT);
                pg8::Gemm8 g{F.ws + WS_XS, F.ws + WS_WM1, D, D, D}; SchedMoe1R S{F.G, F.c, 0, P.N1, 1 << 20, 0, (const LAS int*)(F.lds + PTAB_OFF)};
                EpiGlu8 E{srs, F.ws + WS_ACTM, DFE, 1.0f / MOE_S1};
                pg8::gemm_phase8(F.lds, g, S, E); SEAM();
            }
            if (KON(12) && IN(pb + 8)) { FRESH_TID(F); PMARK(pb + 8);
                const int npan = build_ptab(F); const MoePlan P = moe_plan(npan, F.G);
                const int* stok = (const int*)(F.ws + WS_SLOT); const float* sw = (const float*)(stok + MAXSLOT); const float* srs = (const float*)(stok + 2 * MAXSLOT);
                { pg8::Gemm8 g{F.ws + WS_ACTM, F.ws + WS_WM2, DFE, DFE, DFE}; SchedMoe2R S{F.G, F.c, 0, P.PA, (const LAS int*)(F.lds + PTAB_OFF)};
                  EpiMoe2 E{stok, sw, (bf16_t*)(F.ws + WS_Y0), (bf16_t*)(F.ws + WS_Y1), 0, 1.0f / MOE_S2}; pg8::gemm_phase8(F.lds, g, S, E); }
                if (P.N1 < P.nup) { pg8::Gemm8 g{F.ws + WS_XS, F.ws + WS_WM1, D, D, D}; SchedMoe1R S{F.G, F.c, P.N1, P.nup, P.qa, P.n2, (const LAS int*)(F.lds + PTAB_OFF)};
                  EpiGlu8 E{srs, F.ws + WS_ACTM, DFE, 1.0f / MOE_S1}; pg8::gemm_phase8(F.lds, g, S, E); }
                SEAM();
            }
            if (KON(12) && IN(pb + 9)) { FRESH_TID(F); PMARK(pb + 9);
                const int npan = build_ptab(F); const MoePlan P = moe_plan(npan, F.G);
                const int* stok = (const int*)(F.ws + WS_SLOT); const float* sw = (const float*)(stok + MAXSLOT);
                if (P.PA < npan) { pg8::Gemm8 g{F.ws + WS_ACTM, F.ws + WS_WM2, DFE, DFE, DFE}; SchedMoe2R S{F.G, F.c, P.PA, npan - P.PA, (const LAS int*)(F.lds + PTAB_OFF)};
                  EpiMoe2 E{stok, sw, (bf16_t*)(F.ws + WS_Y0), (bf16_t*)(F.ws + WS_Y1), 0, 1.0f / MOE_S2}; pg8::gemm_phase8(F.lds, g, S, E); }
                SEAM();
            }
            if (KON(13) && IN(pb + 11)) { FRESH_TID(F); PMARK(pb + 11);
                const bf16_t* Y0 = (const bf16_t*)(F.ws + WS_Y0); const bf16_t* Y1 = (const bf16_t*)(F.ws + WS_Y1);
#pragma nounroll
                for (int mb = gw; mb < M; mb += 2 * NGW) { f32x4 x[2][4]; u32x2 ya[2][4], yb[2][4];
#pragma unroll
                    for (int q = 0; q < 2; ++q) { const int m = mb + q * NGW < M ? mb + q * NGW : 0; const u32x2* xr = (const u32x2*)(XB + (size_t)m * D) + F.lane; const u32x2* y0 = (const u32x2*)(Y0 + (size_t)m * D) + F.lane; const u32x2* y1 = (const u32x2*)(Y1 + (size_t)m * D) + F.lane;
#pragma unroll
                        for (int j = 0; j < 4; ++j) { const u32x2 wv = xr[64 * j]; x[q][j] = (f32x4){bf_lo(wv.x), bf_hi(wv.x), bf_lo(wv.y), bf_hi(wv.y)}; ya[q][j] = y0[64 * j]; yb[q][j] = y1[64 * j]; } }
#pragma unroll
                    for (int q = 0; q < 2; ++q) { const int m = mb + q * NGW; if (m >= M) break; f32x4* xr = (f32x4*)(F.out + (size_t)m * D) + F.lane;
#pragma unroll
                        for (int j = 0; j < 4; ++j) { f32x4 o = x[q][j]; const u32x2 a = ya[q][j], b2 = yb[q][j];
                            o.x += bf_lo(a.x) + bf_lo(b2.x); o.y += bf_hi(a.x) + bf_hi(b2.x); o.z += bf_lo(a.y) + bf_lo(b2.y); o.w += bf_hi(a.y) + bf_hi(b2.y); xr[64 * j] = o; } } }
            }
        }
    }
#undef gw
#undef NGW
#undef XB
#undef RS
    PMARK(99);
    if ((PROBE_MASK & 0x6000000u) && blockIdx.x == 0 && threadIdx.x == 0) { const unsigned* st = (const unsigned*)(F.ws + WS_SLOT + 3 * MAXSLOT * 4); unsigned long long tot = 0; for (int i = 0; i < 512 * 8; ++i) { const unsigned v = st[i]; tot += (PROBE_MASK & 0x2000000u) ? (v & 255u) : (v >> 8); }
        *(volatile LAS unsigned long long*)(F.lds + MISC_OFF + 160) += tot * 25ull / 4096ull * 10ull; }
    if (PROBE_MASK != 0u && blockIdx.x == 0 && threadIdx.x == 0) { const unsigned long long acc = *(volatile LAS unsigned long long*)(F.lds + MISC_OFF + 160), t1 = __builtin_amdgcn_s_memrealtime() + 4ull * acc; while (__builtin_amdgcn_s_memrealtime() < t1) __builtin_amdgcn_s_sleep(8); }
#undef IN
}

constexpr int NPHASE = 25;
template <unsigned KM> static bool setup_kernel(int& per_cu) {
    if (hipFuncSetAttribute((const void*)fwd<KM>, hipFuncAttributeMaxDynamicSharedMemorySize, LDS_BYTES) != hipSuccess) return false;
    if (hipOccupancyMaxActiveBlocksPerMultiprocessor(&per_cu, (const void*)fwd<KM>, NTHR, LDS_BYTES) != hipSuccess) per_cu = 0;
    (void)hipGetLastError(); return true;
}
template <unsigned KM> static void launch_kind(int grid, const Args& a, hipStream_t stream) { hipLaunchKernelGGL(fwd<KM>, dim3(grid), dim3(NTHR), LDS_BYTES, stream, a); }
extern "C" void kernel_launch(void* const* d_in, const int* in_sizes, int n_in, void* d_out, int out_size, void* d_ws, size_t ws_size, hipStream_t stream) {
    static int grid = 0;
    if (grid == 0) {
        if (n_in != 28 || in_sizes[0] != M * D || out_size != M * D || ws_size < WS_END) { fprintf(stderr, "kernel_launch: unexpected shapes / workspace (n_in %d, ws %zu, need %zu)\n", n_in, ws_size, (size_t)WS_END); grid = -1; return; }
        int dev = 0, cus = 0, per_cu = 0; bool ok = true;
        if (hipGetDevice(&dev) != hipSuccess || hipDeviceGetAttribute(&cus, hipDeviceAttributeMultiprocessorCount, dev) != hipSuccess) { grid = -1; return; }
#if MK_PER_PHASE
        ok = ok && setup_kernel<1u << 0>(per_cu) && setup_kernel<1u << 1>(per_cu) && setup_kernel<1u << 2>(per_cu) && setup_kernel<1u << 3>(per_cu) && setup_kernel<1u << 4>(per_cu) && setup_kernel<1u << 5>(per_cu) && setup_kernel<1u << 6>(per_cu)
             && setup_kernel<1u << 7>(per_cu) && setup_kernel<1u << 8>(per_cu) && setup_kernel<1u << 9>(per_cu) && setup_kernel<1u << 10>(per_cu) && setup_kernel<1u << 11>(per_cu) && setup_kernel<1u << 12>(per_cu) && setup_kernel<1u << 13>(per_cu);
#else
        ok = ok && setup_kernel<0xffffffffu>(per_cu);
#endif
        if (!ok) { fprintf(stderr, "kernel_launch: hipFuncSetAttribute failed\n"); grid = -1; return; }
        if (per_cu < 1) fprintf(stderr, "kernel_launch: occupancy query says %d\n", per_cu);
        grid = cus;
    }
    if (grid < 0) return;
    (void)hipMemsetAsync((char*)d_ws + WS_CTL, 0, CTL_BYTES, stream);
    Args a{};
    for (int i = 0; i < 28; ++i) a.in[i] = (const float*)d_in[i];
    a.out = (float*)d_out; a.ws = (unsigned char*)d_ws;
#if MK_PER_PHASE
    static const int phases[] = {0, 1, 2, 3, 4, 5, 7, 8, 13, 14, 15, 16, 17, 18, 19, 20, 21, 24};
    static const int kinds[]  = {0, 1, 2, 3, 4, 5, 7, 8,  1,  2,  3,  4,  5,  6, 10, 11, 12, 13};
    for (int i = 0; i < (int)(sizeof(phases) / sizeof(int)); ++i) { a.ph_lo = phases[i]; a.ph_hi = phases[i] + 1;
        switch (kinds[i]) {
            case 0: launch_kind<1u << 0>(grid, a, stream); break; case 1: launch_kind<1u << 1>(grid, a, stream); break; case 2: launch_kind<1u << 2>(grid, a, stream); break;
            case 3: launch_kind<1u << 3>(grid, a, stream); break; case 4: launch_kind<1u << 4>(grid, a, stream); break; case 5: launch_kind<1u << 5>(grid, a, stream); break;
            case 6: launch_kind<1u << 6>(grid, a, stream); break; case 7: launch_kind<1u << 7>(grid, a, stream); break; case 8: launch_kind<1u << 8>(grid, a, stream); break;
            case 9: launch_kind<1u << 9>(grid, a, stream); break; case 10: launch_kind<1u << 10>(grid, a, stream); break; case 11: launch_kind<1u << 11>(grid, a, stream); break;
            case 12: launch_kind<1u << 12>(grid, a, stream); break; default: launch_kind<1u << 13>(grid, a, stream); break; } }
#else
    a.ph_lo = 0; a.ph_hi = NPHASE; launch_kind<0xffffffffu>(grid, a, stream);
#endif
}
```

```cpp
#include <hip/hip_runtime.h>
#include <cstdio>
#include <cstdint>

#ifndef MK_PER_PHASE
#define MK_PER_PHASE 0
#endif

#ifndef PROBE_MASK
#define PROBE_MASK 0u
#endif
#define LAS __attribute__((address_space(3)))
typedef unsigned short bf16_t;
typedef short bf16x8 __attribute__((ext_vector_type(8)));
typedef float f32x4 __attribute__((ext_vector_type(4)));
typedef float f32x2 __attribute__((ext_vector_type(2)));
typedef unsigned u32x4 __attribute__((ext_vector_type(4)));
typedef unsigned u32x2 __attribute__((ext_vector_type(2)));

constexpr int D = 1024, NB = 8, SEQ = 2048, M = NB * SEQ;
constexpr int INW = 2328, INP = 2560;
constexpr int CW = 512, CKW = 31, DH = 64, NKV = 2, NBH = NB * NKV;
constexpr int NCMP = 127, CHID = 256;
constexpr int DFF = 2816, NE = 8, DFE = 3584;
constexpr int MAXPAN = 136, MAXSLOT = MAXPAN * 256, CHUNKP = 72;
constexpr float EPS = 1e-6f;

constexpr size_t MiB = 1u << 20;
constexpr size_t WS_CTL = 0, CTL_BYTES = 2 * MiB;
constexpr size_t WS_H1 = 342 * MiB;
constexpr size_t WS_WIN = 12 * MiB;
constexpr size_t WS_WC1 = 22 * MiB;
constexpr size_t WS_WOUT = 26 * MiB;
constexpr size_t WS_WF1 = 30 * MiB;
constexpr size_t WS_WF2 = 41 * MiB;
constexpr size_t WS_RT = 47 * MiB;
constexpr size_t WS_WM1 = 48 * MiB;
constexpr size_t WS_WM2 = 160 * MiB;
constexpr size_t WS_XB = 216 * MiB;
constexpr size_t WS_RSTD = 248 * MiB;
constexpr size_t WS_GT = WS_RSTD + 65536;
constexpr size_t WS_ROUTE = WS_GT + (size_t)M * 24 * 4;
constexpr size_t WS_PSS = 250 * MiB;
constexpr size_t WS_KC = 251 * MiB;
constexpr size_t WS_VC = WS_KC + 262144;
constexpr size_t WS_VCT = WS_KC + 524288;
constexpr size_t WS_VST = 2 * MiB, WS_VWT = 6 * MiB;
constexpr size_t WS_U = 252 * MiB;
constexpr size_t WS_Q = 268 * MiB;
constexpr size_t WS_KV = 284 * MiB;
constexpr size_t KVT = (size_t)NBH * SEQ * DH;
constexpr size_t WS_MIX = 310 * MiB;
constexpr size_t WS_ACT = 342 * MiB;
constexpr size_t WS_XS = 252 * MiB;
constexpr size_t WS_ACTM = 320 * MiB;
constexpr int CAPE = 16384;
constexpr size_t WS_REC = 270 * MiB;
constexpr size_t WS_SLOT = 447 * MiB;
constexpr size_t WS_Y0 = 288 * MiB, WS_Y1 = 12 * MiB;
constexpr size_t WS_END = 448 * MiB;
constexpr int CW_BAR = 4096;
constexpr int CW_CNT = 8192;
constexpr int CW_B1P = 16384;

__device__ __forceinline__ unsigned cvt_pk_bf16(float lo, float hi) { unsigned r; asm volatile("v_cvt_pk_bf16_f32 %0, %1, %2" : "=v"(r) : "v"(lo), "v"(hi)); return r; }
__device__ __forceinline__ float bf_lo(unsigned v) { return __uint_as_float(v << 16); }
__device__ __forceinline__ float bf_hi(unsigned v) { return __uint_as_float(v & 0xffff0000u); }
__device__ __forceinline__ float bf2f(bf16_t v) { return __uint_as_float((unsigned)v << 16); }
__device__ __forceinline__ float rcpf_(float x) { return __builtin_amdgcn_rcpf(x); }
__device__ __forceinline__ float rsqf_(float x) { return __builtin_amdgcn_rsqf(x); }
__device__ __forceinline__ float sigmoidf_(float x) { return rcpf_(1.0f + __expf(-x)); }
__device__ __forceinline__ float siluf_(float x) { return x * sigmoidf_(x); }
typedef float f32x2e __attribute__((ext_vector_type(2)));
__device__ __forceinline__ f32x2e glu2_(f32x2e g, f32x2e u, f32x2e nrs, f32x2e rs2) {
    f32x2e e = g * nrs; e.x = __builtin_amdgcn_exp2f(e.x); e.y = __builtin_amdgcn_exp2f(e.y);
    f32x2e d = e + (f32x2e){1.0f, 1.0f}; d.x = __builtin_amdgcn_rcpf(d.x); d.y = __builtin_amdgcn_rcpf(d.y);
    return ((g * u) * rs2) * d; }
__device__ __forceinline__ f32x2e glus2_(f32x2e v, f32x2e g, f32x2e nrs, f32x2e rs1) {
    f32x2e e = g * nrs; e.x = __builtin_amdgcn_exp2f(e.x); e.y = __builtin_amdgcn_exp2f(e.y);
    f32x2e d = e + (f32x2e){1.0f, 1.0f}; d.x = __builtin_amdgcn_rcpf(d.x); d.y = __builtin_amdgcn_rcpf(d.y);
    return (v * rs1) * d; }
#define LO2(v) ((f32x2e){(v)[0], (v)[1]})
#define HI2(v) ((f32x2e){(v)[2], (v)[3]})
__device__ __forceinline__ float wave_sum(float v) {
#pragma unroll
    for (int o = 1; o < 64; o <<= 1) v += __shfl_xor(v, o);
    return v;
}
#define DPP_ADD(v, ctrl) ((v) + __builtin_bit_cast(float, __builtin_amdgcn_update_dpp(0, __builtin_bit_cast(int, (v)), (ctrl), 0xF, 0xF, true)))
__device__ __forceinline__ float wave_sum_u(float v) {
    v = DPP_ADD(v, 0xB1); v = DPP_ADD(v, 0x4E); v = DPP_ADD(v, 0x124); v = DPP_ADD(v, 0x128);
    const int b = __builtin_bit_cast(int, v);
    return (__builtin_bit_cast(float, __builtin_amdgcn_readlane(b, 0)) + __builtin_bit_cast(float, __builtin_amdgcn_readlane(b, 16))) + (__builtin_bit_cast(float, __builtin_amdgcn_readlane(b, 32)) + __builtin_bit_cast(float, __builtin_amdgcn_readlane(b, 48)));
}
typedef unsigned u32x2s __attribute__((ext_vector_type(2)));
__device__ __forceinline__ float xsum32(float v) { const unsigned b = __float_as_uint(v); const auto r = __builtin_amdgcn_permlane32_swap(b, b, false, false); return __uint_as_float(r[0]) + __uint_as_float(r[1]); }
__device__ __forceinline__ unsigned xmax32u(unsigned v) { const auto r = __builtin_amdgcn_permlane32_swap(v, v, false, false); return r[0] > r[1] ? r[0] : r[1]; }
__device__ __forceinline__ unsigned xor32u(unsigned v) { const auto r = __builtin_amdgcn_permlane32_swap(v, v, false, false); return r[0] | r[1]; }
__device__ __forceinline__ float xget32(float v, int h) { const unsigned b = __float_as_uint(v); const auto r = __builtin_amdgcn_permlane32_swap(b, b, false, false); return __uint_as_float(h ? r[0] : r[1]); }
__device__ __forceinline__ float wave_max(float v) {
#pragma unroll
    for (int o = 1; o < 64; o <<= 1) v = fmaxf(v, __shfl_xor(v, o));
    return v;
}
#define LDS_WAIT() asm volatile("s_waitcnt lgkmcnt(0)" ::: "memory")
typedef float f32x16 __attribute__((ext_vector_type(16)));
typedef __bf16 bf16v2 __attribute__((ext_vector_type(2)));
#define MFMA32(a, b, c) __builtin_amdgcn_mfma_f32_32x32x16_bf16((a), (b), (c), 0, 0, 0)
__device__ __forceinline__ unsigned pk_bf16(float lo, float hi) { const f32x2 v = {lo, hi}; return __builtin_bit_cast(unsigned, __builtin_convertvector(v, bf16v2)); }
template <int S8> __device__ __forceinline__ bf16x8 pack8(const f32x16& p) { u32x4 w; w.x = pk_bf16(p[S8], p[S8 + 1]); w.y = pk_bf16(p[S8 + 2], p[S8 + 3]); w.z = pk_bf16(p[S8 + 4], p[S8 + 5]); w.w = pk_bf16(p[S8 + 6], p[S8 + 7]); return __builtin_bit_cast(bf16x8, w); }
__device__ __forceinline__ u32x2 pk8_fp8(float a0, float a1, float a2, float a3, float a4, float a5, float a6, float a7) {
    int w0 = 0, w1 = 0; w0 = __builtin_amdgcn_cvt_pk_fp8_f32(a0, a1, w0, false); w0 = __builtin_amdgcn_cvt_pk_fp8_f32(a2, a3, w0, true);
    w1 = __builtin_amdgcn_cvt_pk_fp8_f32(a4, a5, w1, false); w1 = __builtin_amdgcn_cvt_pk_fp8_f32(a6, a7, w1, true); return (u32x2){(unsigned)w0, (unsigned)w1}; }
__device__ __forceinline__ int swap23(int v) { return (v & ~12) | ((v & 4) << 1) | ((v & 8) >> 1); }

constexpr int PX_OFF = 136 + 24;
constexpr int CAPG = 2048;
__device__ __forceinline__ int rec_index(const __attribute__((address_space(3))) int* px, int e, int p) { int x = 0;
#pragma unroll
    for (int g = 1; g < 8; ++g) x += (p >= px[e * 8 + g]) ? 1 : 0;
    return (e * 8 + x) * CAPG + p - px[e * 8 + x]; }
constexpr int TOKT_OFF = 131072 + 4096, TOKT_UNITS = 12;
namespace pg8 {
constexpr int BM = 256, BK = 64, HALF = 128, HTB = HALF * BK * 2, STAGE_BYTES = 8 * HTB, NXCD = 8, WGM = 8;
__device__ __forceinline__ int lds_byte(int r, int c) { const int st = (r >> 4) * 2 + (c >> 5), rr = r & 15, cc = c & 31, ob = rr * 64 + cc * 2; return st * 1024 + (ob ^ (((ob >> 9) & 1) << 5)); }
__device__ __forceinline__ void stage_rc(int b, int& R, int& C) { const int st = b / 1024, sb = b % 1024, swz = sb ^ (((sb >> 9) & 1) << 5); R = (st >> 1) * 16 + swz / 64; C = (st & 1) * 32 + (swz % 64) / 2; }
__device__ __forceinline__ int perm32(int rho) { const int n = rho >> 4, i = rho & 15; return 8 * (i >> 2) + 4 * n + (i & 3); }

struct Unit { int pm, pn; size_t aoff, boff; int sb, nv, ex; };
struct Gemm { const bf16_t* A; const bf16_t* Bt; int K, lda, ldb; };

struct SchedGrid {
    int nM, nN, nwg, G, c; size_t astr, bstr;
    __device__ __forceinline__ void init(int nM_, int nN_, int G_, int c_, int lda, int ldb) { nM = nM_; nN = nN_; nwg = nM * nN; G = G_; c = c_; astr = (size_t)BM * lda * 2; bstr = (size_t)BM * ldb * 2; }
    __device__ __forceinline__ bool next(int i, Unit& u) const {
        const long L = (long)i * G + c; if (L >= nwg) return false;
        int wgid = (int)L; { const int q = nwg / NXCD, r = nwg % NXCD, xcd = wgid % NXCD, off = wgid / NXCD; wgid = (xcd < r ? xcd * (q + 1) : r * (q + 1) + (xcd - r) * q) + off; }
        const int nig = WGM * nN, gid = wgid / nig, fm = gid * WGM, gsz = (nM - fm) < WGM ? (nM - fm) : WGM;
        u.pm = fm + ((wgid % nig) % gsz); u.pn = (wgid % nig) / gsz; u.aoff = (size_t)u.pm * astr; u.boff = (size_t)u.pn * bstr; return true;
    }
};

template <class Epi, class Sched>
__device__ __forceinline__ void gemm_phase(LAS unsigned char* lds, const Gemm g, const Sched& S, const Epi& E) {
    int tid = threadIdx.x; asm volatile("" : "+v"(tid));
    const int wid = __builtin_amdgcn_readfirstlane(tid >> 6), lane = tid & 63, wr = wid >> 2, wc = wid & 3, fr = lane & 15, fq = lane >> 4;
    const int K = g.K, nt = K / BK;
    unsigned voffA[2], voffB[2];
#pragma unroll
    for (int i = 0; i < 2; ++i) { int R, C; stage_rc(tid * 16 + i * 8192, R, C); const int Rb = Epi::PERM ? ((R & ~31) + perm32(R & 31)) : R;
        voffA[i] = (unsigned)(R * g.lda + C) * 2u; voffB[i] = (unsigned)(Rb * g.ldb + C) * 2u; }
    const size_t kstep = (size_t)(BK * 2);
    const size_t hstepA = (size_t)HALF * g.lda * 2, hstepB = (size_t)HALF * g.ldb * 2;
    const unsigned ldsw = (unsigned)wid * 1024u;
    const int aoff = lds_byte(wr * 64 + fr, fq * 8), boff = lds_byte(wc * 32 + fr, fq * 8);
#define PG8_SA(b, h) (((b) * 2 + (h)) * HTB)
#define PG8_SB(b, h) ((4 + (b) * 2 + (h)) * HTB)
#define PG8_STAGE(bufoff, gbase, voff) do { _Pragma("unroll") for (int _i = 0; _i < 2; ++_i) \
        __builtin_amdgcn_global_load_lds((const unsigned*)((const char*)(gbase) + (voff)[_i]), (LAS unsigned*)(lds + (bufoff) + ldsw + _i * 8192), 16, 0, 0); } while (0)
#define PG8_LDA(dst, b, h) do { _Pragma("unroll") for (int m = 0; m < 4; ++m) _Pragma("unroll") for (int k = 0; k < 2; ++k) dst[m][k] = *(const LAS bf16x8*)(lds + PG8_SA(b, h) + aoff + m * 2048 + k * 1024); } while (0)
#define PG8_LDB(dst, b, h) do { _Pragma("unroll") for (int n = 0; n < 2; ++n) _Pragma("unroll") for (int k = 0; k < 2; ++k) dst[n][k] = *(const LAS bf16x8*)(lds + PG8_SB(b, h) + boff + n * 2048 + k * 1024); } while (0)
#define PG8_MMA(ai, bj, At, Bt) do { __builtin_amdgcn_s_setprio(1); _Pragma("unroll") for (int m = 0; m < 4; ++m) _Pragma("unroll") for (int n = 0; n < 2; ++n) _Pragma("unroll") for (int k = 0; k < 2; ++k) \
        acc[ai][bj][m][n] = __builtin_amdgcn_mfma_f32_16x16x32_bf16(Bt[n][k], At[m][k], acc[ai][bj][m][n], 0, 0, 0); __builtin_amdgcn_s_setprio(0); } while (0)
#define PG8_WAIT_V(n) asm volatile("s_waitcnt vmcnt(" #n ")" ::: "memory")
#define PG8_WAIT_L(n) asm volatile("s_waitcnt lgkmcnt(" #n ")" ::: "memory")
#define PG8_BAR __builtin_amdgcn_s_barrier()
#define PG8_SCHED __builtin_amdgcn_sched_barrier(0)
    Unit cur, nxt; int ui = 0;
    if (!S.next(0, cur)) return;
    E.init(S);
    f32x4 acc[2][2][4][2];
#pragma unroll
    for (int a = 0; a < 2; ++a)
#pragma unroll
        for (int b = 0; b < 2; ++b)
#pragma unroll
            for (int m = 0; m < 4; ++m)
#pragma unroll
                for (int n = 0; n < 2; ++n) acc[a][b][m][n] = (f32x4){0.f, 0.f, 0.f, 0.f};
    bf16x8 At[4][2], B0[2][2], B1[2][2];
    const char* cA = (const char*)g.A + cur.aoff; const char* cB = (const char*)g.Bt + cur.boff;
    typename Epi::Pre pre; E.prefetch(cur, wr, fr, pre);
    PG8_STAGE(PG8_SB(0, 0), cB, voffB); PG8_STAGE(PG8_SA(0, 0), cA, voffA); PG8_STAGE(PG8_SB(0, 1), cB + hstepB, voffB); PG8_STAGE(PG8_SA(0, 1), cA + hstepA, voffA);
    if (wr == 1) PG8_BAR;
    PG8_WAIT_V(4); PG8_BAR;
    PG8_STAGE(PG8_SB(1, 0), cB + kstep, voffB); PG8_STAGE(PG8_SA(1, 0), cA + kstep, voffA); PG8_STAGE(PG8_SB(1, 1), cB + hstepB + kstep, voffB);
    PG8_WAIT_V(6); PG8_BAR;
    for (;;) {
        const bool has_next = S.next(ui + 1, nxt);
        const char* nA = has_next ? (const char*)g.A + nxt.aoff : cA; const char* nB = has_next ? (const char*)g.Bt + nxt.boff : cB;
#pragma nounroll
        for (int t = 0; t < nt; t += 2) {
            const bool last = (t == nt - 2);
            const char* a1 = cA + (size_t)(t + 1) * kstep;
            const char* a2 = last ? nA : cA + (size_t)(t + 2) * kstep; const char* b2 = last ? nB : cB + (size_t)(t + 2) * kstep;
            const char* a3 = a2 + kstep; const char* b3 = b2 + kstep;
            PG8_LDB(B0, 0, 0); PG8_SCHED; PG8_LDA(At, 0, 0); PG8_STAGE(PG8_SA(1, 1), a1 + hstepA, voffA);
            PG8_WAIT_L(8); PG8_BAR; PG8_WAIT_L(0); PG8_MMA(0, 0, At, B0); PG8_BAR; PG8_SCHED;
            PG8_LDB(B1, 0, 1); PG8_STAGE(PG8_SB(0, 0), b2, voffB);
            PG8_BAR; PG8_WAIT_L(0); PG8_MMA(0, 1, At, B1); PG8_BAR;
            PG8_LDA(At, 0, 1); PG8_STAGE(PG8_SA(0, 0), a2, voffA);
            PG8_BAR; PG8_WAIT_L(0); PG8_MMA(1, 0, At, B0); PG8_BAR; PG8_SCHED;
            PG8_STAGE(PG8_SB(0, 1), b2 + hstepB, voffB);
            PG8_WAIT_V(6); PG8_BAR; PG8_MMA(1, 1, At, B1); PG8_BAR;
            PG8_LDB(B0, 1, 0); PG8_SCHED; PG8_LDA(At, 1, 0); PG8_STAGE(PG8_SA(0, 1), a2 + hstepA, voffA);
            PG8_WAIT_L(8); PG8_BAR; PG8_WAIT_L(0); PG8_MMA(0, 0, At, B0); PG8_BAR; PG8_SCHED;
            PG8_LDB(B1, 1, 1); PG8_STAGE(PG8_SB(1, 0), b3, voffB);
            PG8_BAR; PG8_WAIT_L(0); PG8_MMA(0, 1, At, B1); PG8_BAR;
            PG8_LDA(At, 1, 1); PG8_STAGE(PG8_SA(1, 0), a3, voffA);
            PG8_BAR; PG8_WAIT_L(0); PG8_MMA(1, 0, At, B0); PG8_BAR; PG8_SCHED;
            PG8_STAGE(PG8_SB(1, 1), b3 + hstepB, voffB);
            PG8_WAIT_V(6); PG8_BAR; PG8_MMA(1, 1, At, B1); PG8_BAR;
        }
        E(acc, cur, wr, wc, fr, fq, pre);
        if (!has_next) break;
        E.prefetch(nxt, wr, fr, pre);
#pragma unroll
        for (int a = 0; a < 2; ++a)
#pragma unroll
            for (int b = 0; b < 2; ++b)
#pragma unroll
                for (int m = 0; m < 4; ++m)
#pragma unroll
                    for (int n = 0; n < 2; ++n) acc[a][b][m][n] = (f32x4){0.f, 0.f, 0.f, 0.f};
        cur = nxt; cA = nA; cB = nB; ++ui;
    }
    PG8_WAIT_V(0);
    if (wr == 0) PG8_BAR;
    PG8_BAR;
#undef PG8_SA
#undef PG8_SB
#undef PG8_STAGE
#undef PG8_LDA
#undef PG8_LDB
#undef PG8_MMA
#undef PG8_WAIT_V
#undef PG8_WAIT_L
#undef PG8_BAR
#undef PG8_SCHED
}
struct Gemm8 { const unsigned char* A; const unsigned char* Bt; int K, lda, ldb; };
typedef int i32x4 __attribute__((ext_vector_type(4)));
typedef int i32x8 __attribute__((ext_vector_type(8)));
template <bool GATH, class Epi, class Sched>
__device__ __forceinline__ void gemm_phase8(LAS unsigned char* lds, const Gemm8 g, const Sched& S, const Epi& E) {
    int tid = threadIdx.x; asm volatile("" : "+v"(tid));
    const int wid = __builtin_amdgcn_readfirstlane(tid >> 6), lane = tid & 63, wr = wid >> 2, wc = wid & 3, fr = lane & 15, fq = lane >> 4;
    const int nt = g.K / 128;
    unsigned voffA[2], voffB[2];
#pragma unroll
    for (int i = 0; i < 2; ++i) { int R, C; stage_rc(tid * 16 + i * 8192, R, C); const int Rb = Epi::PERM ? ((R & ~31) + perm32(R & 31)) : R;
        voffA[i] = (unsigned)(R * g.lda + C * 2); voffB[i] = (unsigned)(Rb * g.ldb + C * 2); }
    const size_t kstep = (size_t)(BK * 2);
    const size_t hstepA = GATH ? (size_t)0 : (size_t)HALF * g.lda, hstepB = (size_t)HALF * g.ldb;
    unsigned pc[2], pn[2];
    unsigned c2; { int _R, _C; stage_rc(tid * 16, _R, _C); c2 = (unsigned)(_C * 2); }
    const LAS int* TOKT = (const LAS int*)(lds + TOKT_OFF);
#define PG8_TOK(u, ix, R) (((R) < (u).nv) ? ((unsigned)TOKT[(ix) * 256 + (R)] >> 1) : 0u)
#define PG8_GROWS(u, ix, d) do { int _R0, _R1, _C; stage_rc(tid * 16, _R0, _C); stage_rc(tid * 16 + 8192, _R1, _C);     \
        d[0] = PG8_TOK(u, ix, _R0) | (PG8_TOK(u, ix, _R1) << 16); d[1] = PG8_TOK(u, ix, _R0 + HALF) | (PG8_TOK(u, ix, _R1 + HALF) << 16); } while (0)
#define PG8_UNPK(v, p) do { v[0] = ((p & 0xffffu) << 10) + c2; v[1] = ((p >> 16) << 10) + c2; } while (0)
    const unsigned ldsw = (unsigned)wid * 1024u;
    const int aoff = lds_byte(wr * 64 + fr, fq * 8), boff = lds_byte(wc * 32 + fr, fq * 8);
#define PG8_SA(b, h) (((b) * 2 + (h)) * HTB)
#define PG8_SB(b, h) ((4 + (b) * 2 + (h)) * HTB)
#define PG8_STAGE(bufoff, gbase, voff) do { _Pragma("unroll") for (int _i = 0; _i < 2; ++_i) \
        __builtin_amdgcn_global_load_lds((const unsigned*)((const char*)(gbase) + (voff)[_i]), (LAS unsigned*)(lds + (bufoff) + ldsw + _i * 8192), 16, 0, 0); } while (0)
#define PG8_LDA(dst, b, h) do { _Pragma("unroll") for (int m = 0; m < 4; ++m) { const i32x4 _l = *(const LAS i32x4*)(lds + PG8_SA(b, h) + aoff + m * 2048), _h = *(const LAS i32x4*)(lds + PG8_SA(b, h) + aoff + m * 2048 + 1024); dst[m] = __builtin_shufflevector(_l, _h, 0, 1, 2, 3, 4, 5, 6, 7); } } while (0)
#define PG8_LDB(dst, b, h) do { _Pragma("unroll") for (int n = 0; n < 2; ++n) { const i32x4 _l = *(const LAS i32x4*)(lds + PG8_SB(b, h) + boff + n * 2048), _h = *(const LAS i32x4*)(lds + PG8_SB(b, h) + boff + n * 2048 + 1024); dst[n] = __builtin_shufflevector(_l, _h, 0, 1, 2, 3, 4, 5, 6, 7); } } while (0)
#define PG8_MMA(ai, bj, At, Bt) do { __builtin_amdgcn_s_setprio(1); _Pragma("unroll") for (int m = 0; m < 4; ++m) _Pragma("unroll") for (int n = 0; n < 2; ++n) \
        asm volatile("v_mfma_f32_16x16x128_f8f6f4 %0, %1, %2, %0" : "+v"(acc[ai][bj][m][n]) : "v"(Bt[n]), "v"(At[m])); __builtin_amdgcn_s_setprio(0); } while (0)
#define PG8_WAIT_V(n) asm volatile("s_waitcnt vmcnt(" #n ")" ::: "memory")
#define PG8_WAIT_L(n) asm volatile("s_waitcnt lgkmcnt(" #n ")" ::: "memory")
#define PG8_BAR __builtin_amdgcn_s_barrier()
#define PG8_SCHED __builtin_amdgcn_sched_barrier(0)
    Unit cur, nxt; int ui = 0;
    if (!S.next(0, cur)) return;
    E.init(S);
    f32x4 acc[2][2][4][2];
#pragma unroll
    for (int a = 0; a < 2; ++a)
#pragma unroll
        for (int b = 0; b < 2; ++b)
#pragma unroll
            for (int m = 0; m < 4; ++m)
#pragma unroll
                for (int n = 0; n < 2; ++n) acc[a][b][m][n] = (f32x4){0.f, 0.f, 0.f, 0.f};
    i32x8 At[4], B0[2], B1[2];
    const char* cA = (const char*)g.A + (GATH ? (size_t)0 : cur.aoff); const char* cB = (const char*)g.Bt + cur.boff; const char* gA = (const char*)g.A;
    if constexpr (GATH) {
        if (wid < 4) { Unit uu; for (int k = 0; k < TOKT_UNITS && S.next(k, uu); ++k) __builtin_amdgcn_global_load_lds((const unsigned*)(S.rtok + rec_index(S.ptab + PX_OFF, uu.ex, uu.sb + tid)), (LAS unsigned*)(lds + TOKT_OFF + k * 1024 + wid * 256), 4, 0, 0); }
        asm volatile("s_waitcnt vmcnt(0)" ::: "memory"); __builtin_amdgcn_s_barrier(); asm volatile("" ::: "memory");
        PG8_GROWS(cur, 0, pc); pn[0] = pc[0]; pn[1] = pc[1]; }
    typename Epi::Pre pre; E.prefetch(cur, wr, fr, pre);
#define PG8_STAGE_A(buf, ptr, kb, pk) do { if constexpr (GATH) { unsigned _v[2]; PG8_UNPK(_v, pk); PG8_STAGE(buf, gA + (kb), _v); } else PG8_STAGE(buf, ptr, voffA); } while (0)
    PG8_STAGE(PG8_SB(0, 0), cB, voffB); PG8_STAGE_A(PG8_SA(0, 0), cA, 0, pc[0]); PG8_STAGE(PG8_SB(0, 1), cB + hstepB, voffB); PG8_STAGE_A(PG8_SA(0, 1), cA + hstepA, 0, pc[1]);
    if (wr == 1) PG8_BAR;
    PG8_WAIT_V(4); PG8_BAR;
    PG8_STAGE(PG8_SB(1, 0), cB + kstep, voffB); PG8_STAGE_A(PG8_SA(1, 0), cA + kstep, kstep, pc[0]); PG8_STAGE(PG8_SB(1, 1), cB + hstepB + kstep, voffB);
    PG8_WAIT_V(6); PG8_BAR;
    for (;;) {
        const bool has_next = S.next(ui + 1, nxt);
        const char* nA = (has_next && !GATH) ? (const char*)g.A + nxt.aoff : cA; const char* nB = has_next ? (const char*)g.Bt + nxt.boff : cB;
#pragma nounroll
        for (int t = 0; t < nt; t += 2) {
            const bool last = (t == nt - 2);
            const char* a1 = cA + (size_t)(t + 1) * kstep;
            const char* a2 = last ? nA : cA + (size_t)(t + 2) * kstep; const char* b2 = last ? nB : cB + (size_t)(t + 2) * kstep;
            const char* a3 = a2 + kstep; const char* b3 = b2 + kstep;
            const size_t k1 = (size_t)(t + 1) * kstep, k2 = last ? (size_t)0 : (size_t)(t + 2) * kstep, k3 = k2 + kstep;
            unsigned q0 = 0u, q1 = 0u;
            if constexpr (GATH) { q0 = pc[0]; q1 = pc[1];
                if (last && has_next) { asm volatile("" ::: "memory"); PG8_GROWS(nxt, ui + 1, pn); q0 = pn[0]; q1 = pn[1]; } }
            PG8_LDB(B0, 0, 0); PG8_SCHED; PG8_LDA(At, 0, 0); PG8_STAGE_A(PG8_SA(1, 1), a1 + hstepA, k1, pc[1]);
            PG8_WAIT_L(8); PG8_BAR; PG8_WAIT_L(0); PG8_MMA(0, 0, At, B0); PG8_BAR; PG8_SCHED;
            PG8_LDB(B1, 0, 1); PG8_STAGE(PG8_SB(0, 0), b2, voffB);
            PG8_BAR; PG8_WAIT_L(0); PG8_MMA(0, 1, At, B1); PG8_BAR;
            PG8_LDA(At, 0, 1); PG8_STAGE_A(PG8_SA(0, 0), a2, k2, q0);
            PG8_BAR; PG8_WAIT_L(0); PG8_MMA(1, 0, At, B0); PG8_BAR; PG8_SCHED;
            PG8_STAGE(PG8_SB(0, 1), b2 + hstepB, voffB);
            PG8_WAIT_V(6); PG8_BAR; PG8_MMA(1, 1, At, B1); PG8_BAR;
            PG8_LDB(B0, 1, 0); PG8_SCHED; PG8_LDA(At, 1, 0); PG8_STAGE_A(PG8_SA(0, 1), a2 + hstepA, k2, q1);
            PG8_WAIT_L(8); PG8_BAR; PG8_WAIT_L(0); PG8_MMA(0, 0, At, B0); PG8_BAR; PG8_SCHED;
            PG8_LDB(B1, 1, 1); PG8_STAGE(PG8_SB(1, 0), b3, voffB);
            PG8_BAR; PG8_WAIT_L(0); PG8_MMA(0, 1, At, B1); PG8_BAR;
            PG8_LDA(At, 1, 1); PG8_STAGE_A(PG8_SA(1, 0), a3, k3, q0);
            PG8_BAR; PG8_WAIT_L(0); PG8_MMA(1, 0, At, B0); PG8_BAR; PG8_SCHED;
            PG8_STAGE(PG8_SB(1, 1), b3 + hstepB, voffB);
            PG8_WAIT_V(6); PG8_BAR; PG8_MMA(1, 1, At, B1); PG8_BAR;
        }
        E(acc, cur, wr, wc, fr, fq, pre);
        if (!has_next) break;
        E.prefetch(nxt, wr, fr, pre);
#pragma unroll
        for (int a = 0; a < 2; ++a)
#pragma unroll
            for (int b = 0; b < 2; ++b)
#pragma unroll
                for (int m = 0; m < 4; ++m)
#pragma unroll
                    for (int n = 0; n < 2; ++n) acc[a][b][m][n] = (f32x4){0.f, 0.f, 0.f, 0.f};
        cur = nxt; cA = nA; cB = nB; ++ui;
        if constexpr (GATH) { pc[0] = pn[0]; pc[1] = pn[1]; }
    }
    PG8_WAIT_V(0);
    if (wr == 0) PG8_BAR;
    PG8_BAR;
#undef PG8_SA
#undef PG8_SB
#undef PG8_STAGE
#undef PG8_LDA
#undef PG8_LDB
#undef PG8_MMA
#undef PG8_WAIT_V
#undef PG8_WAIT_L
#undef PG8_BAR
#undef PG8_SCHED
#undef PG8_STAGE_A
#undef PG8_GROWS
#undef PG8_TOK
#undef PG8_UNPK
}
}
using pg8::Unit;

#define XB_TMO      128
#define XB_XCNT(j)  (256  + 64 * (j))
#define XB_XSUB(j)  (1280 + 64 * (j))
#define XB_XGEN(j)  (2304 + 64 * (j))
#define XB_TOP      3328
#define XB_TOPGEN   3392
#define XCD_BAR_WORDS 3456
#define XB_SPIN_CAP (1u << 18)
__device__ __forceinline__ unsigned xb_ld(unsigned* p)              { return __hip_atomic_load(p, __ATOMIC_RELAXED, __HIP_MEMORY_SCOPE_AGENT); }
__device__ __forceinline__ unsigned xb_add(unsigned* p, unsigned v) { return __hip_atomic_fetch_add(p, v, __ATOMIC_RELAXED, __HIP_MEMORY_SCOPE_AGENT); }
__device__ __forceinline__ unsigned xb_xcc_id() { return (unsigned)__builtin_amdgcn_s_getreg((3 << 11) | 20) & 0xFu; }
#define XB_SPIN(cond, bar) do { unsigned _sp = 0; while (cond) { __builtin_amdgcn_s_sleep(1); \
    if ((++_sp & 255u) == 0u) { if (xb_ld(&(bar)[XB_TMO])) break; if (_sp > XB_SPIN_CAP) { atomicAdd(&(bar)[XB_TMO], 1u); break; } } } } while (0)
struct XcdBarrier { unsigned* bar; unsigned x; volatile LAS unsigned* st; };
__device__ __forceinline__ XcdBarrier xcd_barrier_post(unsigned* bar, volatile LAS unsigned* st) {
    XcdBarrier b; b.bar = bar; b.x = xb_xcc_id(); b.st = st;
    if (threadIdx.x == 0) (void)xb_add(&bar[XB_XCNT(b.x)], 1u);
    return b;
}
__device__ __forceinline__ void xcd_barrier_complete(unsigned* bar, unsigned x, unsigned& nloc, unsigned& nx) {
    const unsigned G = gridDim.x * gridDim.y * gridDim.z;
    unsigned sum, cnt, mine, sp = 0u;
    for (;;) {
        sum = 0u; cnt = 0u; mine = 0u;
#pragma unroll
        for (unsigned j = 0; j < 16; ++j) { const unsigned c = xb_ld(&bar[XB_XCNT(j)]); sum += c; cnt += (c > 0u) ? 1u : 0u; mine = (j == x) ? c : mine; }
        if (sum == G) break;
        __builtin_amdgcn_s_sleep(1);
        if ((++sp & 255u) == 0u) { if (xb_ld(&bar[XB_TMO])) break; if (sp > XB_SPIN_CAP) { atomicAdd(&bar[XB_TMO], 1u); break; } }
    }
    nloc = mine > 0u ? mine : 1u; nx = cnt > 0u ? cnt : 1u;
}
__device__ __forceinline__ void xcd_barrier(const XcdBarrier& b) {
    asm volatile("s_waitcnt vmcnt(0)" ::: "memory");
    __syncthreads();
    if (threadIdx.x == 0) {
        unsigned* bar = b.bar;
        __builtin_amdgcn_s_waitcnt(0);
        unsigned nloc = b.st[0], nx = b.st[1];
        if (nloc == 0u) { xcd_barrier_complete(bar, b.x, nloc, nx); b.st[0] = nloc; b.st[1] = nx; }
        const unsigned old = xb_add(&bar[XB_XSUB(b.x)], 1u);
        const unsigned gen = old / nloc;
        if (old + 1u == (gen + 1u) * nloc) {
            __builtin_amdgcn_fence(__ATOMIC_RELEASE, "agent");
            asm volatile("s_waitcnt vmcnt(0)" ::: "memory");
            const unsigned og = xb_add(&bar[XB_TOP], 1u);
            const unsigned tg = og / nx;
            if (og + 1u == (tg + 1u) * nx) xb_add(&bar[XB_TOPGEN], 1u);
            else XB_SPIN(xb_ld(&bar[XB_TOPGEN]) == tg, bar);
            __builtin_amdgcn_fence(__ATOMIC_ACQUIRE, "agent");
            xb_add(&bar[XB_XGEN(b.x)], 1u);
            asm volatile("s_waitcnt vmcnt(0)" ::: "memory");
        } else {
            XB_SPIN(xb_ld(&bar[XB_XGEN(b.x)]) == gen, bar);
            __builtin_amdgcn_fence(__ATOMIC_ACQUIRE, "agent");
            asm volatile("s_waitcnt vmcnt(0)" ::: "memory");
        }
    }
    __syncthreads();
}

constexpr int NWAVES = 8, NTHR = 512;
constexpr int LDS_BYTES = 147456;
constexpr int MISC_OFF = 131072;
constexpr int PTAB_OFF = MISC_OFF + 512;

struct Args { const float* in[28]; float* out; unsigned char* ws; int ph_lo, ph_hi; };

struct Frame {
    LAS unsigned char* lds; int tid, lane, wave, G, c;
    const float* const* in; float* out; unsigned char* ws;
};
#define INP_(i) (F.in[i])
#define FRESH_TID(F) do { int _t = threadIdx.x; asm volatile("" : "+v"(_t)); (F).tid = _t; (F).lane = _t & 63; \
    __attribute__((address_space(1))) unsigned char* _w = (__attribute__((address_space(1))) unsigned char*)args.ws; __attribute__((address_space(1))) float* _o = (__attribute__((address_space(1))) float*)args.out; \
    int _g = gridDim.x; asm volatile("" : "+s"(_w), "+s"(_o), "+s"(_g)); (F).ws = (unsigned char*)_w; (F).out = (float*)_o; (F).G = _g; } while (0)
enum { I_X = 0, I_ANG, I_WIN, I_CDW, I_CDB, I_CLG, I_CLB, I_QG, I_KG, I_PK, I_PV, I_KW1, I_KB1, I_KW2, I_KB2, I_VW1, I_VB1, I_VW2, I_VB2, I_WOUT, I_FNG, I_DW1, I_DW3, I_DW2, I_RW, I_MW1, I_MW3, I_MW2 };

#define PMARK(id) do { if (PROBE_MASK != 0u && blockIdx.x == 0 && threadIdx.x == 0) { volatile LAS unsigned long long* _a = (volatile LAS unsigned long long*)(F.lds + MISC_OFF + 160); volatile LAS unsigned* _o = (volatile LAS unsigned*)(F.lds + MISC_OFF + 168); \
    const unsigned long long _t = __builtin_amdgcn_s_memrealtime(); if (*_o) { *_a += _t; *_o = 0u; } if ((id) < 32 && ((PROBE_MASK >> (id)) & 1u)) { *_a -= _t; *_o = 1u; } } } while (0)
static_assert(TOKT_OFF == MISC_OFF + 4096 && TOKT_OFF + TOKT_UNITS * 1024 <= LDS_BYTES, "row-record table");
constexpr int RSL_OFF = MISC_OFF + 2048;
__device__ __forceinline__ void rstd_from_partials(const float* pss, int pm, LAS float* tab) {
    int t = threadIdx.x; asm volatile("" : "+v"(t));
    const int row = t >> 1, hf = t & 1;
    const f32x4 a = *(const f32x4*)(pss + (size_t)(pm * 256 + row) * 16 + hf * 8), b = *(const f32x4*)(pss + (size_t)(pm * 256 + row) * 16 + hf * 8 + 4);
    float sq = ((a.x + a.y) + (a.z + a.w)) + ((b.x + b.y) + (b.z + b.w)); sq += __shfl_xor(sq, 1);
    if (hf == 0) tab[row] = rsqf_(sq * (1.0f / D) + EPS);
}
constexpr int RSU = 8;
template <class Sched>
__device__ __forceinline__ void rstd_tables(const float* pss, const float* rstd, const Sched& S, LAS float* tab) {
    int t = threadIdx.x; asm volatile("" : "+v"(t));
    const int row = t >> 1, hf = t & 1; Unit u;
    if (pss) { f32x4 a[RSU], b[RSU];
#pragma unroll
        for (int k = 0; k < RSU; ++k) { const int pm = S.next(k, u) ? u.pm : 0; a[k] = *(const f32x4*)(pss + (size_t)(pm * 256 + row) * 16 + hf * 8); b[k] = *(const f32x4*)(pss + (size_t)(pm * 256 + row) * 16 + hf * 8 + 4); }
#pragma unroll
        for (int k = 0; k < RSU; ++k) { float sq = ((a[k].x + a[k].y) + (a[k].z + a[k].w)) + ((b[k].x + b[k].y) + (b[k].z + b[k].w)); sq += __shfl_xor(sq, 1); if (hf == 0) tab[k * 256 + row] = rsqf_(sq * (1.0f / D) + EPS); } }
    else { float v[RSU];
#pragma unroll
        for (int k = 0; k < RSU; ++k) { const int pm = S.next(k, u) ? u.pm : 0; v[k] = rstd[pm * 256 + (t & 255)]; }
#pragma unroll
        for (int k = 0; k < RSU; ++k) if (t < 256) tab[k * 256 + t] = v[k]; }
    asm volatile("s_waitcnt lgkmcnt(0)" ::: "memory"); __builtin_amdgcn_s_barrier(); asm volatile("" ::: "memory");
}
struct EpiIn {
    static constexpr bool PERM = true;
    const float* rstd; bf16_t* U; bf16_t* Q; bf16_t* KV; float* GT; const float* pss; LAS float* rsl;
    struct Pre { int par = -1; };
    template <class Sched> __device__ __forceinline__ void init(const Sched& S) const { rstd_tables(pss, rstd, S, rsl); }
    __device__ __forceinline__ void prefetch(const Unit& u, int wr, int fr, Pre& p) const {
        ++p.par; if (p.par >= RSU) { LAS float* tab = rsl + (p.par % RSU) * 256;
            if (pss) rstd_from_partials(pss, u.pm, tab); else { int t = threadIdx.x; asm volatile("" : "+v"(t)); if (t < 256) tab[t] = rstd[u.pm * 256 + t]; } } }
    __device__ __forceinline__ void operator()(const f32x4 (&acc)[2][2][4][2], const Unit& u, int wr, int wc, int fr, int fq, const Pre& pre) const {
        const int row0 = u.pm * 256 + wr * 64 + fr, cl = wc * 32 + 8 * fq;
        if (u.pn < 4) {
#pragma unroll
            for (int ai = 0; ai < 2; ++ai)
#pragma unroll
                for (int m = 0; m < 4; ++m) { const int r = row0 + ai * 128 + m * 16; const float rs = rsl[(pre.par % RSU) * 256 + wr * 64 + fr + ai * 128 + m * 16];
                    const f32x4 v0 = acc[ai][0][m][0], v1 = acc[ai][0][m][1], g0 = acc[ai][1][m][0], g1 = acc[ai][1][m][1];
                    const float nr = rs * -1.44269504089f; const f32x2e nrs = {nr, nr}, rs1 = {rs, rs};
                    const f32x2e o0 = glus2_(LO2(v0), LO2(g0), nrs, rs1), o1 = glus2_(HI2(v0), HI2(g0), nrs, rs1), o2 = glus2_(LO2(v1), LO2(g1), nrs, rs1), o3 = glus2_(HI2(v1), HI2(g1), nrs, rs1);
                    u32x4 w; w.x = cvt_pk_bf16(o0.x, o0.y); w.y = cvt_pk_bf16(o1.x, o1.y); w.z = cvt_pk_bf16(o2.x, o2.y); w.w = cvt_pk_bf16(o3.x, o3.y);
                    *(u32x4*)(U + (size_t)r * CW + u.pn * 128 + cl) = w; asm volatile("" ::: "memory"); }
        } else if (u.pn < 6) {
#pragma unroll
            for (int ai = 0; ai < 2; ++ai)
#pragma unroll
                for (int m = 0; m < 4; ++m) { const int r = row0 + ai * 128 + m * 16; const float rs = rsl[(pre.par % RSU) * 256 + wr * 64 + fr + ai * 128 + m * 16];
#pragma unroll
                    for (int bj = 0; bj < 2; ++bj) { const f32x4 v0 = acc[ai][bj][m][0] * rs, v1 = acc[ai][bj][m][1] * rs;
                        u32x4 w; w.x = cvt_pk_bf16(v0[0], v0[1]); w.y = cvt_pk_bf16(v0[2], v0[3]); w.z = cvt_pk_bf16(v1[0], v1[1]); w.w = cvt_pk_bf16(v1[2], v1[3]);
                        *(u32x4*)(Q + (size_t)r * 512 + (u.pn - 4) * 256 + bj * 128 + cl) = w; } asm volatile("" ::: "memory"); }
        } else if (u.pn < 9) {
            const int h = wc >> 1, d0 = 32 * (wc & 1) + 8 * fq;
#pragma unroll
            for (int ai = 0; ai < 2; ++ai)
#pragma unroll
                for (int m = 0; m < 4; ++m) { const int r = row0 + ai * 128 + m * 16; const float rs = rsl[(pre.par % RSU) * 256 + wr * 64 + fr + ai * 128 + m * 16]; const int b = r >> 11, t = r & 2047;
#pragma unroll
                    for (int bj = 0; bj < 2; ++bj) { const int tq = 2 * (u.pn - 6) + bj; const f32x4 v0 = acc[ai][bj][m][0] * rs, v1 = acc[ai][bj][m][1] * rs;
                        u32x4 w; w.x = cvt_pk_bf16(v0[0], v0[1]); w.y = cvt_pk_bf16(v0[2], v0[3]); w.z = cvt_pk_bf16(v1[0], v1[1]); w.w = cvt_pk_bf16(v1[2], v1[3]);
                        *(u32x4*)(KV + (size_t)tq * KVT + ((size_t)(b * 2 + h) * SEQ + t) * DH + d0) = w; } asm volatile("" ::: "memory"); }
        } else {
            if (wc == 0 && fq < 3) {
#pragma unroll
                for (int ai = 0; ai < 2; ++ai)
#pragma unroll
                    for (int m = 0; m < 4; ++m) { const int r = row0 + ai * 128 + m * 16; const float rs = rsl[(pre.par % RSU) * 256 + wr * 64 + fr + ai * 128 + m * 16];
                        *(f32x4*)(GT + (size_t)r * 24 + 8 * fq) = acc[ai][0][m][0] * rs; *(f32x4*)(GT + (size_t)r * 24 + 8 * fq + 4) = acc[ai][0][m][1] * rs; }
            }
        }
    }
};
typedef _Float16 h16x2 __attribute__((ext_vector_type(2)));
__device__ __forceinline__ unsigned pk_f16(float a, float b) { const f32x2 v = {a, b}; return __builtin_bit_cast(unsigned, __builtin_convertvector(v, h16x2)); }
__device__ __forceinline__ f32x2 up_f16(unsigned w) { return __builtin_convertvector(__builtin_bit_cast(h16x2, w), f32x2); }
struct EpiH1 {
    static constexpr bool PERM = true;
    unsigned short* H;
    struct Pre {}; __device__ __forceinline__ void prefetch(const Unit&, int, int, Pre&) const {}
    template <class Sched> __device__ __forceinline__ void init(const Sched&) const {}
    __device__ __forceinline__ void operator()(const f32x4 (&acc)[2][2][4][2], const Unit& u, int wr, int wc, int fr, int fq, const Pre&) const {
        const int row0 = u.pm * 256 + wr * 64 + fr, col0 = wc * 32 + 8 * fq; const int kv = u.pn >> 3, sp = u.pn & 7;
#pragma unroll
        for (int ai = 0; ai < 2; ++ai)
#pragma unroll
            for (int m = 0; m < 4; ++m) { unsigned short* rowp = H + (((size_t)sp * 2 + kv) * 2048 + row0 + ai * 128 + m * 16) * 256 + col0;
#pragma unroll
                for (int bj = 0; bj < 2; ++bj) { const f32x4 v0 = acc[ai][bj][m][0], v1 = acc[ai][bj][m][1];
                    u32x4 w; w.x = pk_f16(v0[0], v0[1]); w.y = pk_f16(v0[2], v0[3]); w.z = pk_f16(v1[0], v1[1]); w.w = pk_f16(v1[2], v1[3]); *(u32x4*)(rowp + bj * 128) = w; } }
    }
};
template <bool BF> struct EpiRes {
    static constexpr bool PERM = true;
    const void* base; bf16_t* xb; float* pss;
    struct Pre {}; __device__ __forceinline__ void prefetch(const Unit&, int, int, Pre&) const {}
    template <class Sched> __device__ __forceinline__ void init(const Sched&) const {}
    __device__ __forceinline__ void operator()(const f32x4 (&acc)[2][2][4][2], const Unit& u, int wr, int wc, int fr, int fq, const Pre&) const {
        const int row0 = u.pm * 256 + wr * 64 + fr, col0 = u.pn * 256 + wc * 32 + 8 * fq;
#pragma unroll
        for (int ai = 0; ai < 2; ++ai) { u32x4 raw[4][2];
#pragma unroll
            for (int m = 0; m < 4; ++m) { const size_t off = (size_t)(row0 + ai * 128 + m * 16) * D + col0;
#pragma unroll
                for (int bj = 0; bj < 2; ++bj) raw[m][bj] = *(const u32x4*)((const bf16_t*)base + off + bj * 128); }
#pragma unroll
            for (int m = 0; m < 4; ++m) { const size_t off = (size_t)(row0 + ai * 128 + m * 16) * D + col0; float ss = 0.f;
#pragma unroll
                for (int bj = 0; bj < 2; ++bj) { const u32x4 r = raw[m][bj];
                    const f32x4 v0 = (f32x4){bf_lo(r.x), bf_hi(r.x), bf_lo(r.y), bf_hi(r.y)} + acc[ai][bj][m][0], v1 = (f32x4){bf_lo(r.z), bf_hi(r.z), bf_lo(r.w), bf_hi(r.w)} + acc[ai][bj][m][1];
                    u32x4 w; w.x = cvt_pk_bf16(v0[0], v0[1]); w.y = cvt_pk_bf16(v0[2], v0[3]); w.z = cvt_pk_bf16(v1[0], v1[1]); w.w = cvt_pk_bf16(v1[2], v1[3]);
                    *(u32x4*)(xb + off + bj * 128) = w;
                    ss += ((v0[0] * v0[0] + v0[1] * v0[1]) + (v0[2] * v0[2] + v0[3] * v0[3])) + ((v1[0] * v1[0] + v1[1] * v1[1]) + (v1[2] * v1[2] + v1[3] * v1[3])); }
                if (pss) { ss += __shfl_xor(ss, 16); ss += __shfl_xor(ss, 32);
                    if (fq == 0) pss[(size_t)(row0 + ai * 128 + m * 16) * 16 + u.pn * 4 + wc] = ss; } } }
    }
};
struct EpiGlu {
    static constexpr bool PERM = true;
    const float* rstd; bf16_t* O; int ldo; int rowbase;
    const float* pss; LAS float* rsl;
    struct Pre { int par = -1; };
    template <class Sched> __device__ __forceinline__ void init(const Sched& S) const { rstd_tables(pss, nullptr, S, rsl); }
    __device__ __forceinline__ void prefetch(const Unit& u, int wr, int fr, Pre& p) const { ++p.par; if (p.par >= RSU) rstd_from_partials(pss, u.pm, rsl + (p.par % RSU) * 256); }
    __device__ __forceinline__ void operator()(const f32x4 (&acc)[2][2][4][2], const Unit& u, int wr, int wc, int fr, int fq, const Pre& pre) const {
        const int row0 = u.pm * 256 + wr * 64 + fr, cl = u.pn * 128 + wc * 32 + 8 * fq;
#pragma unroll
        for (int ai = 0; ai < 2; ++ai)
#pragma unroll
            for (int m = 0; m < 4; ++m) { const int r = row0 + ai * 128 + m * 16; const float rs = rsl[(pre.par % RSU) * 256 + wr * 64 + fr + ai * 128 + m * 16];
                const f32x4 g0 = acc[ai][0][m][0], g1 = acc[ai][0][m][1], u0 = acc[ai][1][m][0], u1 = acc[ai][1][m][1];
                const float nr = rs * -1.44269504089f, r2 = rs * rs; const f32x2e nrs = {nr, nr}, rs2 = {r2, r2};
                const f32x2e o0 = glu2_(LO2(g0), LO2(u0), nrs, rs2), o1 = glu2_(HI2(g0), HI2(u0), nrs, rs2), o2 = glu2_(LO2(g1), LO2(u1), nrs, rs2), o3 = glu2_(HI2(g1), HI2(u1), nrs, rs2);
                u32x4 w; w.x = cvt_pk_bf16(o0.x, o0.y); w.y = cvt_pk_bf16(o1.x, o1.y); w.z = cvt_pk_bf16(o2.x, o2.y); w.w = cvt_pk_bf16(o3.x, o3.y);
                *(u32x4*)(O + (size_t)r * ldo + cl) = w; }
    }
};
struct EpiGlu8 {
    static constexpr bool PERM = true;
    const float* rstd; unsigned char* O; int ldo; float sc; LAS float* rsl;
    struct Pre {}; __device__ __forceinline__ void prefetch(const Unit&, int, int, Pre&) const {}
    template <class Sched> __device__ __forceinline__ void init(const Sched&) const {}
    __device__ __forceinline__ void operator()(const f32x4 (&acc)[2][2][4][2], const Unit& u, int wr, int wc, int fr, int fq, const Pre& pre) const {
        const int row0 = u.pm * 256 + wr * 64 + fr, cl = u.pn * 128 + wc * 32 + 8 * fq;
#pragma unroll
        for (int ai = 0; ai < 2; ++ai)
#pragma unroll
            for (int m = 0; m < 4; ++m) { const int r = row0 + ai * 128 + m * 16; const float rs = sc;
                const f32x4 g0 = acc[ai][0][m][0], g1 = acc[ai][0][m][1], u0 = acc[ai][1][m][0], u1 = acc[ai][1][m][1];
                const float nr = rs * -1.44269504089f, r2 = rs * rs; const f32x2e nrs = {nr, nr}, rs2 = {r2, r2};
                const f32x2e o0 = glu2_(LO2(g0), LO2(u0), nrs, rs2), o1 = glu2_(HI2(g0), HI2(u0), nrs, rs2), o2 = glu2_(LO2(g1), LO2(u1), nrs, rs2), o3 = glu2_(HI2(g1), HI2(u1), nrs, rs2);
                *(u32x2*)(O + (size_t)r * ldo + cl) = pk8_fp8(o0.x, o0.y, o1.x, o1.y, o2.x, o2.y, o3.x, o3.y); }
    }
};
struct EpiMoe2 {
    static constexpr bool PERM = true;
    const int* stok; const float* sw; bf16_t* Y0; bf16_t* Y1; int rowbase; float sc; const LAS int* px;
    struct Pre {}; __device__ __forceinline__ void prefetch(const Unit&, int, int, Pre&) const {}
    template <class Sched> __device__ __forceinline__ void init(const Sched&) const {}
    __device__ __forceinline__ void operator()(const f32x4 (&acc)[2][2][4][2], const Unit& u, int wr, int wc, int fr, int fq, const Pre&) const {
        const int row0 = u.pm * 256 + wr * 64 + fr, cl = u.pn * 256 + wc * 32 + 8 * fq;
        int tks[8]; float ws[8];
#pragma unroll
        for (int q = 0; q < 8; ++q) { const int rl = wr * 64 + fr + (q >> 2) * 128 + (q & 3) * 16; const bool ok = rl < u.nv; const int r = rec_index(px, u.ex, u.sb + (ok ? rl : 0)); const int tq = stok[r]; tks[q] = ok ? tq : -1; ws[q] = sw[r]; }
#pragma unroll
        for (int ai = 0; ai < 2; ++ai)
#pragma unroll
            for (int m = 0; m < 4; ++m) { const int tk = tks[ai * 4 + m]; const float w = ws[ai * 4 + m] * sc;
                if (tk >= 0) { bf16_t* dst = ((tk & 1) ? Y1 : Y0) + (size_t)(tk >> 1) * D + cl;
#pragma unroll
                    for (int bj = 0; bj < 2; ++bj) { const f32x4 v0 = acc[ai][bj][m][0] * w, v1 = acc[ai][bj][m][1] * w;
                        u32x4 o; o.x = cvt_pk_bf16(v0[0], v0[1]); o.y = cvt_pk_bf16(v0[2], v0[3]); o.z = cvt_pk_bf16(v1[0], v1[1]); o.w = cvt_pk_bf16(v1[2], v1[3]);
                        *(u32x4*)(dst + bj * 128) = o; } } }
    }
};

struct SchedCmp {
    int G, c, layer;
    __device__ __forceinline__ bool next(int i, Unit& u) const {
        const int L = i * G + c; if (L >= 128) return false;
        const int kv = L >> 6, pm = (L >> 3) & 7, s = L & 7;
        u.pm = pm; u.pn = kv * 8 + s; u.aoff = ((size_t)kv * KVT + (size_t)pm * 256 * 1024 + s * 256) * 2; u.boff = ((size_t)(layer * 2 + kv) * 256 * 2048 + s * 256) * 2; return true;
    }
};
struct SchedMoe1 {
    int G, c, p0, np; const LAS int* ptab;
    __device__ __forceinline__ bool next(int i, Unit& u) const {
        const int L = i * G + c; if (L >= np * 28) return false;
        const int j = L / np, pl = L % np, e = ptab[p0 + pl];
        u.pm = pl; u.pn = j; u.aoff = (size_t)(p0 + pl) * 256 * 1024 * 2; u.boff = ((size_t)e * 7168 + (size_t)j * 256) * 1024 * 2; return true;
    }
};
struct SchedMoe2 {
    int G, c, p0, np; const LAS int* ptab;
    __device__ __forceinline__ bool next(int i, Unit& u) const {
        const int L = i * G + c; if (L >= np * 4) return false;
        const int j = L / np, pl = L % np, e = ptab[p0 + pl];
        u.pm = pl; u.pn = j; u.aoff = (size_t)pl * 256 * DFE * 2; u.boff = ((size_t)e * 1024 + (size_t)j * 256) * DFE * 2; return true;
    }
};

struct SchedMoe1F {
    int G, c, np; const LAS int* ptab;
    __device__ __forceinline__ bool next(int i, Unit& u) const {
        const int L = i * G + c; if (L >= np * 28) return false;
        const int pl = L / 28, j = L % 28, e = ptab[pl];
        u.pm = pl; u.pn = j; u.aoff = (size_t)pl * 256 * 1024; u.boff = ((size_t)e * 7168 + (size_t)j * 256) * 1024; return true;
    }
};
struct SchedMoe2F {
    int G, c, np; const LAS int* ptab;
    __device__ __forceinline__ bool next(int i, Unit& u) const {
        const int L = i * G + c; if (L >= np * 4) return false;
        const int pl = L >> 2, j = L & 3, e = ptab[pl];
        u.pm = pl; u.pn = j; u.aoff = (size_t)pl * 256 * DFE; u.boff = ((size_t)e * 1024 + (size_t)j * 256) * DFE; return true;
    }
};

struct MoePlan { int N1, PA, nup, qa, n2; };
__device__ __forceinline__ MoePlan moe_plan(int np, int G) {
    MoePlan P; const bool split = (G == 256) && np >= 128 && np <= 136;
    P.nup = 28 * np; P.N1 = split ? 2048 : P.nup; P.PA = split ? np - 64 : np;
    const int r1 = P.nup - P.N1, nA = 4 * P.PA; P.n2 = (split && nA > G) ? nA - G : 0;
    const int R = (r1 + 3 * P.n2 + G - 1) / G; P.qa = R > 3 ? R - 3 : 0; return P; }
struct SchedMoe1R {
    int G, c, L0, ntot, qa, n2; const LAS int* ptab; const int* rtok; int ib;
    __device__ __forceinline__ bool next(int i_, Unit& u) const {
        if (i_ >= TOKT_UNITS) return false; const int i = i_ + ib;
        int L; if (i < qa) L = L0 + i * G + c; else { if (c < n2) return false; L = L0 + qa * G + (i - qa) * (G - n2) + (c - n2); }
        if (L >= ntot) return false;
        const int pl = L / 28, j = L % 28, e = ptab[pl], p0e = pl * 256 - ptab[MAXPAN + 8 + e], left = ptab[MAXPAN + 16 + e] - p0e;
        u.pm = pl; u.pn = j; u.aoff = 0; u.boff = ((size_t)e * 7168 + (size_t)j * 256) * 1024; u.sb = p0e; u.ex = e; u.nv = left < 256 ? left : 256; return true;
    }
};
struct SchedMoe2R {
    int G, c, p0, np; const LAS int* ptab;
    __device__ __forceinline__ bool next(int i, Unit& u) const {
        const int L = i * G + c; if (L >= np * 4) return false;
        const int pl = p0 + (L >> 2), j = L & 3, e = ptab[pl], p0e = pl * 256 - ptab[MAXPAN + 8 + e], left = ptab[MAXPAN + 16 + e] - p0e;
        u.pm = pl; u.pn = j; u.aoff = (size_t)pl * 256 * DFE; u.boff = ((size_t)e * 1024 + (size_t)j * 256) * DFE; u.sb = p0e; u.ex = e; u.nv = left < 256 ? left : 256; return true;
    }
};

struct TwP { const float* W; const float* gv; bf16_t* WT; int ldw, n0, nvalid, k0, ldk, kind, h; float f8sc; float* rso; };
__device__ __forceinline__ TwP tw_job(int r, const float* W, int ldw, int nblk, int nvalid, bf16_t* WT, int ldk, int kind, int h, const float* gv) {
    TwP P; P.W = W; P.gv = gv; P.WT = WT; P.ldw = ldw; P.n0 = 256 * (r % nblk); P.nvalid = nvalid; P.k0 = 64 * (r / nblk); P.ldk = ldk; P.kind = kind; P.h = h; P.f8sc = 0.f; P.rso = nullptr; return P; }
__device__ __forceinline__ void tw_load(const TwP& P, f32x4 (&tv)[8], int wave, int lane) {
    if (P.kind == 3) {
#pragma unroll
        for (int i = 0; i < 8; ++i) tv[i] = *((const f32x4*)(P.W + (size_t)(P.k0 + 2 * wave + (i >> 2)) * D) + 64 * (i & 3) + lane);
        return; }
    const int n = P.n0 + 4 * lane; const float* src = P.W + (size_t)(P.k0 + 8 * wave) * P.ldw + n;
#pragma unroll
    for (int i = 0; i < 8; ++i) tv[i] = (n < P.nvalid) ? *(const f32x4*)(src + (size_t)i * P.ldw) : (f32x4){0.f, 0.f, 0.f, 0.f};
}
__device__ __forceinline__ void tw_store(const TwP& P, f32x4 (&tv)[8], LAS unsigned char* tile, int wave, int lane) {
    if (P.kind == 3) {
#pragma unroll
        for (int q = 0; q < 2; ++q) { const int row = P.k0 + 2 * wave + q; float ss = 0.f;
#pragma unroll
            for (int j = 0; j < 4; ++j) { const f32x4 v = tv[4 * q + j]; ss += (v.x * v.x + v.y * v.y) + (v.z * v.z + v.w * v.w); }
            const float rstd = rsqf_(wave_sum_u(ss) * (1.0f / D) + EPS);
            u32x2* o8 = (u32x2*)(P.WT + (size_t)row * D) + lane;
#pragma unroll
            for (int j = 0; j < 4; ++j) { const f32x4 v = tv[4 * q + j]; u32x2 w; w.x = cvt_pk_bf16(v.x, v.y); w.y = cvt_pk_bf16(v.z, v.w); o8[64 * j] = w; }
            if (lane == 0) P.rso[row] = rstd; }
        return; }
    if (P.gv) {
#pragma unroll
        for (int i = 0; i < 8; ++i) tv[i] *= P.gv[P.k0 + 8 * wave + i]; }
    const int ng = P.n0 + 32 * wave; size_t drow;
    if (P.kind == 0) drow = ng;
    else if (P.kind == 1) drow = 256 * (ng / 128) + 128 * P.h + (ng % 128);
    else { if (ng < 512) drow = 256 * (ng / 128) + (ng % 128); else if (ng < 1024) { const int cc = ng - 512; drow = 256 * (cc / 128) + 128 + (cc % 128); } else drow = ng; }
    if (P.f8sc != 0.f) {
        const float sc = P.f8sc;
#pragma unroll
        for (int c = 0; c < 4; ++c) *(LAS u32x2*)(tile + (4 * lane + c) * 80 + 8 * wave) = pk8_fp8(tv[0][c] * sc, tv[1][c] * sc, tv[2][c] * sc, tv[3][c] * sc, tv[4][c] * sc, tv[5][c] * sc, tv[6][c] * sc, tv[7][c] * sc);
        __syncthreads();
#pragma unroll
        for (int j = 0; j < 2; ++j) { const int r = (lane >> 2) + 16 * j, ch = lane & 3;
            *(u32x4*)((unsigned char*)P.WT + (drow + r) * (size_t)P.ldk + P.k0 + 16 * ch) = *(const LAS u32x4*)(tile + (32 * wave + r) * 80 + 16 * ch); }
        __syncthreads();
        return; }
#pragma unroll
    for (int c = 0; c < 4; ++c) { u32x4 o; o.x = cvt_pk_bf16(tv[0][c], tv[1][c]); o.y = cvt_pk_bf16(tv[2][c], tv[3][c]); o.z = cvt_pk_bf16(tv[4][c], tv[5][c]); o.w = cvt_pk_bf16(tv[6][c], tv[7][c]);
        *(LAS u32x4*)(tile + (4 * lane + c) * 144 + 16 * wave) = o; }
    __syncthreads();
#pragma unroll
    for (int j = 0; j < 4; ++j) { const int r = (lane >> 3) + 8 * j, c = lane & 7;
        *(u32x4*)(P.WT + (drow + r) * (size_t)P.ldk + P.k0 + 8 * c) = *(const LAS u32x4*)(tile + (32 * wave + r) * 144 + 16 * c); }
    __syncthreads();
}
#define TW_RUN(NIT, JOB) do { const int _n = (NIT); if (_n > 0) { TwP _pa, _pb; f32x4 _ta[8], _tb[8]; JOB(_pa, 0); tw_load(_pa, _ta, F.wave, F.lane); \
    _Pragma("nounroll") for (int _i = 0; _i < _n; _i += 2) { const bool _h2 = _i + 1 < _n, _h3 = _i + 2 < _n; \
        if (_h2) { JOB(_pb, _i + 1); tw_load(_pb, _tb, F.wave, F.lane); } tw_store(_pa, _ta, F.lds, F.wave, F.lane); if (!_h2) break; \
        if (_h3) { JOB(_pa, _i + 2); tw_load(_pa, _ta, F.wave, F.lane); } tw_store(_pb, _tb, F.lds, F.wave, F.lane); } } } while (0)
__device__ __forceinline__ void xprep_row(const float* xrow, bf16_t* orow, float* rstd_out, int lane, f32x4 (&v)[4]) {
    const f32x4* xr = (const f32x4*)xrow + lane; float s = 0.f;
#pragma unroll
    for (int j = 0; j < 4; ++j) { v[j] = xr[64 * j]; s += (v[j].x * v[j].x + v[j].y * v[j].y) + (v[j].z * v[j].z + v[j].w * v[j].w); }
    const float rstd = rsqf_(wave_sum_u(s) * (1.0f / D) + EPS);
    if (orow) { u32x2* o8 = (u32x2*)orow + lane;
#pragma unroll
        for (int j = 0; j < 4; ++j) { u32x2 w; w.x = cvt_pk_bf16(v[j].x, v[j].y); w.y = cvt_pk_bf16(v[j].z, v[j].w); o8[64 * j] = w; } }
    if (lane == 0) *rstd_out = rstd;
}

constexpr float MOE_S1 = 64.f, MOE_S2 = 128.f;
constexpr int MOE_SLOT_A = 8, MOE_SLOT_B = 10, MOE_SLOTTED = 128 * (2 * MOE_SLOT_A + MOE_SLOT_B);
constexpr int MOE_ITEMS = 24 * 224;
__device__ __forceinline__ TwP moe_conv_job(Frame& F, int r) {
    constexpr int J_M1 = 16 * 14, J_M2 = 56 * 4;
    unsigned char* WM1 = F.ws + WS_WM1; unsigned char* WM2 = F.ws + WS_WM2;
    if (r < 16 * J_M1) { const int q = r / J_M1, e = q >> 1, h = q & 1; TwP P = tw_job(r % J_M1, (h ? INP_(I_MW3) : INP_(I_MW1)) + (size_t)e * D * DFE, DFE, 14, DFE, (bf16_t*)(WM1 + (size_t)e * 7168 * D), D, 1, h, INP_(I_FNG) + D); P.f8sc = MOE_S1; return P; }
    r -= 16 * J_M1; const int e = r / J_M2; TwP P = tw_job(r % J_M2, INP_(I_MW2) + (size_t)e * DFE * D, D, 4, D, (bf16_t*)(WM2 + (size_t)e * D * DFE), DFE, 0, 0, nullptr); P.f8sc = MOE_S2; return P;
}
__device__ __forceinline__ void moe_conv_slot(Frame& F, int slot) {
    if (F.G != 256 || F.c < 128) return;
    { int _t = threadIdx.x; asm volatile("" : "+v"(_t)); F.tid = _t; F.lane = _t & 63; }
    const int nslot = (slot == 1) ? MOE_SLOT_B : MOE_SLOT_A;
    int base = 128 * (slot == 0 ? 0 : slot == 1 ? MOE_SLOT_A : MOE_SLOT_A + MOE_SLOT_B) + ((int)blockIdx.x - 128); asm volatile("" : "+s"(base));
#define MJOB(P, i) P = moe_conv_job(F, base + (i) * 128)
    TW_RUN(nslot, MJOB);
#undef MJOB
}
constexpr int MOE_ATTN_ALL = 2, MOE_ATTN_ITEMS = 256 + 256 * MOE_ATTN_ALL;
__device__ __forceinline__ int moe_attn_n(int tb) { return MOE_ATTN_ALL + (tb < 8 ? (8 - tb) >> 1 : tb > 23 ? (tb - 23) >> 1 : 0); }
__device__ __forceinline__ void moe_conv_attn(Frame& F, int layer) {
    if (F.G != 256) return;
    const int tb = F.c & 31, n = moe_attn_n(tb); if (n == 0) return;
    int pre = 0;
#pragma nounroll
    for (int t = 0; t < tb; ++t) pre += moe_attn_n(t);
    __syncthreads();
    { int _t = threadIdx.x; asm volatile("" : "+v"(_t)); F.tid = _t; F.lane = _t & 63; }
    int base = MOE_SLOTTED + layer * MOE_ATTN_ITEMS + (F.c >> 5) * (MOE_ATTN_ITEMS / 8) + pre; asm volatile("" : "+s"(base));
#define MJOB(P, i) P = moe_conv_job(F, base + (i))
    TW_RUN(n, MJOB);
#undef MJOB
}
__device__ __forceinline__ void xprep_rows4(const float* X, bf16_t* XBo, float* RSo, int m, int ms, int lane) {
    f32x4 v[4][4];
#pragma unroll
    for (int q = 0; q < 4; ++q) { const int mm = m + q * ms; const f32x4* xr = (const f32x4*)(X + (size_t)(mm < M ? mm : 0) * D) + lane;
#pragma unroll
        for (int j = 0; j < 4; ++j) v[q][j] = xr[64 * j]; }
#pragma unroll
    for (int q = 0; q < 4; ++q) { const int mm = m + q * ms; if (mm >= M) break; float s = 0.f;
#pragma unroll
        for (int j = 0; j < 4; ++j) s += (v[q][j].x * v[q][j].x + v[q][j].y * v[q][j].y) + (v[q][j].z * v[q][j].z + v[q][j].w * v[q][j].w);
        const float rstd = rsqf_(wave_sum_u(s) * (1.0f / D) + EPS);
        u32x2* o8 = (u32x2*)(XBo + (size_t)mm * D) + lane;
#pragma unroll
        for (int j = 0; j < 4; ++j) { u32x2 w; w.x = cvt_pk_bf16(v[q][j].x, v[q][j].y); w.y = cvt_pk_bf16(v[q][j].z, v[q][j].w); o8[64 * j] = w; }
        if (lane == 0) RSo[mm] = rstd; }
}
__device__ __forceinline__ void phase_prologue(Frame& F) {
    const int gw = F.c * NWAVES + F.wave, NGW = F.G * NWAVES;
    bf16_t* WIN = (bf16_t*)(F.ws + WS_WIN); bf16_t* WC1 = (bf16_t*)(F.ws + WS_WC1); bf16_t* WOUT = (bf16_t*)(F.ws + WS_WOUT); bf16_t* WF1 = (bf16_t*)(F.ws + WS_WF1); bf16_t* WF2 = (bf16_t*)(F.ws + WS_WF2);
    constexpr int J_IN = 16 * 10, J_C1 = 32, J_OUT = 16 * 4, J_F1 = 16 * 11, J_F2 = 44 * 4;
    constexpr int NSMALL = 2 * J_IN + 4 * J_C1 + 2 * J_OUT + 2 * J_F1 + J_F2;
    const int moe0 = (F.G == 256) ? MOE_SLOTTED + 2 * MOE_ATTN_ITEMS : 0; const int nitems = NSMALL + MOE_ITEMS - moe0 + M / 16;
#define P0_JOB(P, i) do { int r = F.c + (i) * F.G; \
        if (r < 2 * J_IN) { const int l = r / J_IN; P = tw_job(r % J_IN, INP_(I_WIN) + (size_t)l * D * INW, INW, 10, INW, WIN + (size_t)l * INP * D, D, 2, 0, INP_(I_ANG) + l * D); break; } r -= 2 * J_IN; \
        if (r < 4 * J_C1) { const int q = r / J_C1, l = q >> 1, kv = q & 1; P = tw_job(r % J_C1, (kv ? INP_(I_VW1) : INP_(I_KW1)) + (size_t)l * 2048 * 256, 256, 1, 256, WC1 + (size_t)(l * 2 + kv) * 256 * 2048, 2048, 0, 0, nullptr); break; } r -= 4 * J_C1; \
        if (r < 2 * J_OUT) { const int l = r / J_OUT; P = tw_job(r % J_OUT, INP_(I_WOUT) + (size_t)l * D * D, D, 4, D, WOUT + (size_t)l * D * D, D, 0, 0, nullptr); break; } r -= 2 * J_OUT; \
        if (r < 2 * J_F1) { const int h = r / J_F1; P = tw_job(r % J_F1, (h ? INP_(I_DW3) : INP_(I_DW1)), DFF, 11, DFF, WF1, D, 1, h, INP_(I_FNG)); break; } r -= 2 * J_F1; \
        if (r < J_F2) { P = tw_job(r, INP_(I_DW2), D, 4, D, WF2, DFF, 0, 0, nullptr); break; } r -= J_F2; \
        if (r < MOE_ITEMS - moe0) { P = moe_conv_job(F, r + moe0); break; } r -= MOE_ITEMS - moe0; \
        P = tw_job(0, INP_(I_X), D, 1, D, (bf16_t*)(F.ws + WS_XB), D, 3, 0, nullptr); P.k0 = 16 * r; P.rso = (float*)(F.ws + WS_RSTD); } while (0)
    TW_RUN((nitems - F.c + F.G - 1) / F.G, P0_JOB);
#undef P0_JOB
    { float* RT = (float*)(F.ws + WS_RT); const int gt = F.c * NTHR + F.tid; if (gt < 8192) { const int e = gt >> 10, k = gt & 1023; RT[gt] = INP_(I_RW)[k * 8 + e] * INP_(I_FNG)[D + k]; } }
    { float* B1P = (float*)(F.ws + WS_CTL) + CW_B1P; LAS float* ps = (LAS float*)F.lds;
      for (int it = F.c; it < 128; it += F.G) { const int kc = it & 7, jb = (it >> 3) & 3, kv = (it >> 5) & 1, l = it >> 6; const int j = jb * 64 + F.lane, kb = kc * 256 + 32 * F.wave;
          const float* w1 = (kv ? INP_(I_VW1) : INP_(I_KW1)) + (size_t)l * 2048 * 256; const float* pos = (kv ? INP_(I_PV) : INP_(I_PK)) + l * 2048;
          float wv[32];
#pragma unroll
          for (int k = 0; k < 32; ++k) wv[k] = w1[(size_t)(kb + k) * 256 + j];
          float sp = 0.f;
#pragma unroll
          for (int k = 0; k < 32; ++k) sp += pos[kb + k] * wv[k];
          ps[F.wave * 64 + F.lane] = sp;
          __syncthreads();
          if (F.wave == 0) { float t = (kc == 0) ? (kv ? INP_(I_VB1) : INP_(I_KB1))[l * 256 + j] : 0.f;
#pragma unroll
              for (int ww = 0; ww < 8; ++ww) t += ps[ww * 64 + F.lane];
              B1P[kc * 1024 + (l * 2 + kv) * 256 + j] = t; }
          __syncthreads(); } }
}

__device__ __forceinline__ void norm_rows64(bf16_t* buf, int nrows, const float* g, float scale, int gw, int NGW, int lane) {
    const int sub = lane & 7; float gv[8];
#pragma unroll
    for (int j = 0; j < 8; ++j) gv[j] = g[sub * 8 + j] * scale;
    for (int it = gw; it < nrows / 8; it += NGW) { u32x4* p = (u32x4*)(buf + ((size_t)it * 8 + (lane >> 3)) * 64) + sub; const u32x4 v = *p;
        float f[8] = {bf_lo(v.x), bf_hi(v.x), bf_lo(v.y), bf_hi(v.y), bf_lo(v.z), bf_hi(v.z), bf_lo(v.w), bf_hi(v.w)}; float s = 0.f;
#pragma unroll
        for (int j = 0; j < 8; ++j) s += f[j] * f[j];
        s += __shfl_xor(s, 1); s += __shfl_xor(s, 2); s += __shfl_xor(s, 4);
        const float rs = rsqf_(s * (1.0f / 64.0f) + EPS);
        u32x4 o; o.x = cvt_pk_bf16(f[0] * rs * gv[0], f[1] * rs * gv[1]); o.y = cvt_pk_bf16(f[2] * rs * gv[2], f[3] * rs * gv[3]); o.z = cvt_pk_bf16(f[4] * rs * gv[4], f[5] * rs * gv[5]); o.w = cvt_pk_bf16(f[6] * rs * gv[6], f[7] * rs * gv[7]);
        *p = o; }
}
__device__ __forceinline__ void norm_rows64_x2(bf16_t* bufA, const float* gA, bf16_t* bufB, const float* gB, int nrows, int gw, int NGW, int lane) {
    const int sub = lane & 7; float ga[8], gb[8];
#pragma unroll
    for (int j = 0; j < 8; ++j) { ga[j] = gA[sub * 8 + j]; gb[j] = gB[sub * 8 + j]; }
    const int nit = nrows / 8;
#pragma nounroll
    for (int it0 = gw; it0 < nit; it0 += 4 * NGW) { u32x4 v[2][4];
#pragma unroll
        for (int q = 0; q < 4; ++q) { const int it = it0 + q * NGW < nit ? it0 + q * NGW : it0; const size_t off = ((size_t)it * 8 + (lane >> 3)) * 64; v[0][q] = *((const u32x4*)(bufA + off) + sub); v[1][q] = *((const u32x4*)(bufB + off) + sub); }
#pragma unroll
        for (int tn = 0; tn < 2; ++tn)
#pragma unroll
            for (int q = 0; q < 4; ++q) { const int it = it0 + q * NGW; if (it >= nit) break; const u32x4 x = v[tn][q];
                const float f[8] = {bf_lo(x.x), bf_hi(x.x), bf_lo(x.y), bf_hi(x.y), bf_lo(x.z), bf_hi(x.z), bf_lo(x.w), bf_hi(x.w)}; float sq = 0.f;
#pragma unroll
                for (int j = 0; j < 8; ++j) sq += f[j] * f[j];
                sq = DPP_ADD(sq, 0xB1); sq = DPP_ADD(sq, 0x4E); sq = DPP_ADD(sq, 0x141);
                const float rs = rsqf_(sq * (1.0f / 64.0f) + EPS); const float* gg = tn ? gb : ga;
                u32x4 o; o.x = cvt_pk_bf16(f[0] * rs * gg[0], f[1] * rs * gg[1]); o.y = cvt_pk_bf16(f[2] * rs * gg[2], f[3] * rs * gg[3]); o.z = cvt_pk_bf16(f[4] * rs * gg[4], f[5] * rs * gg[5]); o.w = cvt_pk_bf16(f[6] * rs * gg[6], f[7] * rs * gg[7]);
                *((u32x4*)((tn ? bufB : bufA) + ((size_t)it * 8 + (lane >> 3)) * 64) + sub) = o; } }
}
__device__ __forceinline__ float sum32_(float v, bool) {
    v = DPP_ADD(v, 0xB1); v = DPP_ADD(v, 0x4E); v = DPP_ADD(v, 0x124); v = DPP_ADD(v, 0x128);
    return v + __shfl_xor(v, 16);
}
__device__ __forceinline__ void conv_units(Frame& F, int layer) {
    int tid = F.tid; asm volatile("" : "+v"(tid));
    const bf16_t* U = (const bf16_t*)(F.ws + WS_U); bf16_t* MIX = (bf16_t*)(F.ws + WS_MIX);
    LAS u32x4* L4 = (LAS u32x4*)F.lds;
    const int cp = tid & 255, th = tid >> 8; const bool hi = (tid & 32) != 0; const LAS unsigned* LW = (const LAS unsigned*)F.lds;
    if (F.c >= 512) return;
    f32x2 w[CKW];
#pragma unroll
    for (int k = 0; k < CKW; ++k) w[k] = *(const f32x2*)(INP_(I_CDW) + (size_t)layer * CKW * CW + k * CW + 2 * cp);
    const f32x2 cb = *(const f32x2*)(INP_(I_CDB) + layer * CW + 2 * cp), lg = *(const f32x2*)(INP_(I_CLG) + layer * CW + 2 * cp), lb = *(const f32x2*)(INP_(I_CLB) + layer * CW + 2 * cp);
    u32x4 sv[8];
#define CONV_LOAD(cu_) do { const int _b = (cu_) >> 6, _t0 = ((cu_) & 63) * 32; _Pragma("unroll") for (int q = 0; q < 8; ++q) { const int i = tid + q * NTHR, row = i >> 6, ch = i & 63, t = _t0 - 30 + row; \
        const bool ok = (i < 62 * 64) && (t >= 0); const u32x4 ld = *(const u32x4*)(U + (size_t)(_b * SEQ + (ok ? t : 0)) * CW + (ok ? ch : 0) * 8); sv[q] = ok ? ld : (u32x4){0u, 0u, 0u, 0u}; } } while (0)
    CONV_LOAD(F.c);
    __syncthreads();
#pragma nounroll
    for (int cu = F.c; cu < 512; cu += F.G) { const int b = cu >> 6, t0 = (cu & 63) * 32;
#pragma unroll
        for (int q = 0; q < 8; ++q) { const int i = tid + q * NTHR; if (i < 62 * 64) L4[i] = sv[q]; }
        __syncthreads();
        { const int nx = cu + F.G < 512 ? cu + F.G : cu; CONV_LOAD(nx); }
#pragma nounroll
        for (int hf = 0; hf < 2; ++hf) { const int tl0 = th * 16 + hf * 8;
            f32x2 in[38];
#pragma unroll
            for (int i = 0; i < 38; ++i) { const unsigned v = LW[(tl0 + i) * 256 + cp]; in[i] = (f32x2){bf_lo(v), bf_hi(v)}; }
            f32x2 acc[8];
#pragma unroll
            for (int t = 0; t < 8; ++t) { acc[t] = cb;
#pragma unroll
                for (int k = 0; k < CKW; ++k) acc[t] += w[k] * in[t + k]; }
            unsigned wq[8];
#pragma unroll
            for (int t = 0; t < 8; ++t) {
                const float s = sum32_(acc[t].x + acc[t].y, hi), q = sum32_(acc[t].x * acc[t].x + acc[t].y * acc[t].y, hi);
                const float mu = s * (1.0f / 64.0f), var = fmaxf(q * (1.0f / 64.0f) - mu * mu, 0.f), rs = rsqf_(var + EPS);
                const float a0 = (acc[t].x - mu) * rs * lg.x + lb.x, a1 = (acc[t].y - mu) * rs * lg.y + lb.y;
                wq[t] = cvt_pk_bf16(siluf_(a0), siluf_(a1)); }
            const bool od = (tid & 1) != 0;
#pragma unroll
            for (int t = 0; t < 8; t += 2) { const unsigned snd = od ? wq[t] : wq[t + 1]; const unsigned rcv = (unsigned)__builtin_amdgcn_update_dpp(0, (int)snd, 0xB1, 0xF, 0xF, true);
                u32x2 o; o.x = od ? rcv : wq[t]; o.y = od ? wq[t + 1] : rcv;
                *(u32x2*)(MIX + (size_t)(b * SEQ + t0 + tl0 + t + (od ? 1 : 0)) * D + 2 * (cp & ~1)) = o; }
        }
        __syncthreads();
    }
#undef CONV_LOAD
}
__device__ __forceinline__ void vtrans_items(Frame& F, int gw, int NGW) {
    const int lane = F.lane;
    LAS unsigned char* scr = F.lds + F.wave * 9216;
    for (int it = gw; it < 1024; it += NGW) { const int ten = it >> 9, bh = (it >> 5) & 15, kb = it & 31;
        const bf16_t* V = (const bf16_t*)(F.ws + WS_KV) + (size_t)(ten ? 5 : 3) * KVT + ((size_t)bh * SEQ + kb * 64) * 64; bf16_t* VT = (bf16_t*)(F.ws + (ten ? WS_VWT : WS_VST)) + (size_t)bh * 64 * SEQ + kb * 64;
#pragma unroll
        for (int c = 0; c < 8; ++c) *(LAS u32x4*)(scr + lane * 144 + c * 16) = *((const u32x4*)(V + (size_t)lane * 64) + c);
        LDS_WAIT(); __builtin_amdgcn_wave_barrier(); asm volatile("" ::: "memory");
#pragma unroll
        for (int c = 0; c < 8; ++c) { unsigned w[4];
#pragma unroll
            for (int q = 0; q < 4; ++q) { const int v0 = 8 * c + 2 * q, k0 = swap23(v0), k1 = swap23(v0 + 1);
                w[q] = (unsigned)*(const LAS bf16_t*)(scr + k0 * 144 + lane * 2) | ((unsigned)*(const LAS bf16_t*)(scr + k1 * 144 + lane * 2) << 16); }
            *((u32x4*)(VT + (size_t)lane * SEQ) + c) = (u32x4){w[0], w[1], w[2], w[3]}; }
        LDS_WAIT(); __builtin_amdgcn_wave_barrier(); asm volatile("" ::: "memory");
    }
}
__device__ __forceinline__ void phase_cmp2(Frame& F, int layer) {
    const int lane = F.lane, w = F.wave, k0 = 32 * w;
    const unsigned short* H1 = (const unsigned short*)(F.ws + WS_H1); const float* B1P = (const float*)(F.ws + WS_CTL) + CW_B1P + layer * 512;
    LAS float* part = (LAS float*)F.lds;
#pragma nounroll
    for (int un = F.c; un < 256; un += F.G) { const int kv = un >> 7, R0 = (un & 127) * 16;
        const float* w2 = (kv ? INP_(I_VW2) : INP_(I_KW2)) + (size_t)layer * 16384 + (size_t)k0 * 64 + lane;
        float w2r[32];
#pragma unroll
        for (int j = 0; j < 32; ++j) w2r[j] = w2[j * 64];
        const int r16 = lane >> 2, kq8 = 8 * (lane & 3);
        f32x4 bs0 = {0.f, 0.f, 0.f, 0.f}, bs1 = {0.f, 0.f, 0.f, 0.f}, x0 = {0.f, 0.f, 0.f, 0.f}, x1 = {0.f, 0.f, 0.f, 0.f};
        {   u32x4 hp[8]; f32x4 bp[8][2];
#pragma unroll
            for (int sp = 0; sp < 8; ++sp) { hp[sp] = *(const u32x4*)(H1 + ((size_t)kv * 2048 + R0 + r16) * 256 + k0 + kq8 + (size_t)sp * 2 * 2048 * 256);
                const float* bpp = B1P + sp * 1024 + kv * 256 + k0 + kq8; bp[sp][0] = *(const f32x4*)bpp; bp[sp][1] = *(const f32x4*)(bpp + 4); }
#pragma unroll
            for (int sp = 0; sp < 8; ++sp) { const f32x2 a = up_f16(hp[sp].x), b2 = up_f16(hp[sp].y), c = up_f16(hp[sp].z), d = up_f16(hp[sp].w);
                x0 += (f32x4){a.x, a.y, b2.x, b2.y}; x1 += (f32x4){c.x, c.y, d.x, d.y}; bs0 += bp[sp][0]; bs1 += bp[sp][1]; } }
        float hx8[8];
#pragma unroll
        for (int j = 0; j < 4; ++j) { hx8[j] = siluf_(x0[j] + bs0[j]); hx8[4 + j] = siluf_(x1[j] + bs1[j]); }
        float acc[16];
#pragma unroll
        for (int r = 0; r < 16; ++r) { float a = 0.f;
#pragma unroll
            for (int j = 0; j < 32; ++j) a += __builtin_bit_cast(float, __builtin_amdgcn_readlane(__builtin_bit_cast(int, hx8[j & 7]), 4 * r + (j >> 3))) * w2r[j];
            acc[r] = a; }
#pragma unroll
        for (int r = 0; r < 16; ++r) part[(w * 16 + r) * 64 + lane] = acc[r];
        __syncthreads();
#pragma unroll
        for (int rr = 0; rr < 2; ++rr) { const int r = 2 * w + rr, R = R0 + r;
            float a = (kv ? INP_(I_VB2) : INP_(I_KB2))[layer * 64 + lane];
#pragma unroll
            for (int ww = 0; ww < 8; ++ww) a += part[(ww * 16 + r) * 64 + lane];
            if ((R & 127) == 127) a = 0.f;
            else if (kv == 0) { const float ms = wave_sum_u(a * a) * (1.0f / 64.0f); a = a * (rsqf_(ms + EPS)) * INP_(I_KG)[layer * 192 + lane]; }
            const bf16_t ab = (bf16_t)(cvt_pk_bf16(a, 0.f) & 0xffffu);
            ((bf16_t*)(F.ws + (kv ? WS_VC : WS_KC)))[(size_t)R * 64 + lane] = ab;
            if (kv) ((bf16_t*)(F.ws + WS_VCT))[((size_t)(R >> 7) * 64 + lane) * 128 + swap23(R & 127)] = ab; }
        __syncthreads();
    }
}

__device__ __forceinline__ void dots4(const bf16_t* krow, const LAS float* qs, float (&s)[4]) {
    s[0] = s[1] = s[2] = s[3] = 0.f;
#pragma nounroll
    for (int c = 0; c < 8; ++c) { const u32x4 v = *((const u32x4*)krow + c);
        const float f[8] = {bf_lo(v.x), bf_hi(v.x), bf_lo(v.y), bf_hi(v.y), bf_lo(v.z), bf_hi(v.z), bf_lo(v.w), bf_hi(v.w)};
#pragma unroll
        for (int h = 0; h < 4; ++h) { const f32x4 q0 = *(const LAS f32x4*)(qs + h * 64 + c * 8), q1 = *(const LAS f32x4*)(qs + h * 64 + c * 8 + 4);
            s[h] += (f[0] * q0.x + f[1] * q0.y) + (f[2] * q0.z + f[3] * q0.w) + (f[4] * q1.x + f[5] * q1.y) + (f[6] * q1.z + f[7] * q1.w); } }
}
__device__ __forceinline__ void softmax_pv(LAS f32x4* sb, const LAS int* kb, int nk, const bf16_t* V, int lane, float (&o)[4]) {
    float m[4] = {-1e30f, -1e30f, -1e30f, -1e30f};
#pragma nounroll
    for (int c = 0; c < nk; ++c) { const f32x4 s = sb[c * 64 + lane]; m[0] = fmaxf(m[0], s.x); m[1] = fmaxf(m[1], s.y); m[2] = fmaxf(m[2], s.z); m[3] = fmaxf(m[3], s.w); }
#pragma unroll
    for (int h = 0; h < 4; ++h) m[h] = wave_max(m[h]);
    float sum[4] = {0.f, 0.f, 0.f, 0.f};
#pragma nounroll
    for (int c = 0; c < nk; ++c) { const f32x4 s = sb[c * 64 + lane]; f32x4 p;
        p.x = s.x > -1e29f ? __expf(s.x - m[0]) : 0.f; p.y = s.y > -1e29f ? __expf(s.y - m[1]) : 0.f; p.z = s.z > -1e29f ? __expf(s.z - m[2]) : 0.f; p.w = s.w > -1e29f ? __expf(s.w - m[3]) : 0.f;
        sum[0] += p.x; sum[1] += p.y; sum[2] += p.z; sum[3] += p.w; sb[c * 64 + lane] = p; }
    float inv[4];
#pragma unroll
    for (int h = 0; h < 4; ++h) inv[h] = rcpf_(fmaxf(wave_sum(sum[h]), 1e-30f));
    LDS_WAIT(); __builtin_amdgcn_wave_barrier(); asm volatile("" ::: "memory");
    o[0] = o[1] = o[2] = o[3] = 0.f;
#pragma nounroll
    for (int c = 0; c < nk; ++c) { const int k0 = kb[c];
#pragma unroll 4
        for (int kk = 0; kk < 64; ++kk) { int key = k0 + kk; key = key < 0 ? 0 : (key > SEQ - 1 ? SEQ - 1 : key);
            const f32x4 p = sb[c * 64 + kk]; const float v = bf2f(V[(size_t)key * 64 + lane]);
            o[0] += p.x * v; o[1] += p.y * v; o[2] += p.z * v; o[3] += p.w * v; } }
#pragma unroll
    for (int h = 0; h < 4; ++h) o[h] *= inv[h];
    __builtin_amdgcn_wave_barrier(); asm volatile("" ::: "memory");
}
__device__ __forceinline__ void phase_attn_ref(Frame& F, int layer) {
    const int lane = F.lane;
    LAS unsigned char* wl = F.lds + F.wave * 12288;
    LAS float* qs = (LAS float*)wl;
    LAS f32x4* pc = (LAS f32x4*)(wl + 1024);
    LAS float* psum = (LAS float*)(wl + 3072);
    LAS int* kbl = (LAS int*)(wl + 3584);
    LAS f32x4* sb = (LAS f32x4*)(wl + 4096);
    const bf16_t* QN = (const bf16_t*)(F.ws + WS_Q); const bf16_t* KVb = (const bf16_t*)(F.ws + WS_KV);
    const bf16_t* KC = (const bf16_t*)(F.ws + WS_KC); const bf16_t* VC = (const bf16_t*)(F.ws + WS_VC);
    const float* GT = (const float*)(F.ws + WS_GT); bf16_t* MIX = (bf16_t*)(F.ws + WS_MIX);
#pragma nounroll
    for (int un = F.c; un < NBH * 64; un += F.G) {
        const int bh = un >> 6, tile = un & 63, b = bh >> 1, kvh = bh & 1;
        const bf16_t* KS = KVb + 2 * KVT + (size_t)bh * SEQ * 64; const bf16_t* VS = KVb + 3 * KVT + (size_t)bh * SEQ * 64;
        const bf16_t* KW = KVb + 4 * KVT + (size_t)bh * SEQ * 64; const bf16_t* VW = KVb + 5 * KVT + (size_t)bh * SEQ * 64;
#pragma nounroll
        for (int ti = 0; ti < 4; ++ti) {
            const int t = tile * 32 + F.wave * 4 + ti, r = b * SEQ + t;
#pragma unroll
            for (int h = 0; h < 4; ++h) qs[h * 64 + lane] = bf2f(QN[(size_t)r * 512 + (kvh * 4 + h) * 64 + lane]);
            LDS_WAIT(); __builtin_amdgcn_wave_barrier(); asm volatile("" ::: "memory");
            float sc[2][4]; bool vc[2];
#pragma unroll
            for (int u = 0; u < 2; ++u) { const int c = lane + 64 * u; vc[u] = (c < NCMP) && (16 * c + 31 <= t);
                if (vc[u]) dots4(KC + ((size_t)bh * 128 + c) * 64, qs, sc[u]); else { sc[u][0] = sc[u][1] = sc[u][2] = sc[u][3] = -1e30f; } }
            float pr[2][4];
#pragma unroll
            for (int h = 0; h < 4; ++h) { const float mx = wave_max(fmaxf(sc[0][h], sc[1][h]));
                pr[0][h] = vc[0] ? __expf(sc[0][h] - mx) : 0.f; pr[1][h] = vc[1] ? __expf(sc[1][h] - mx) : 0.f;
                const float inv = rcpf_(fmaxf(wave_sum(pr[0][h] + pr[1][h]), 1e-30f)); pr[0][h] *= inv; pr[1][h] *= inv; }
#pragma unroll
            for (int u = 0; u < 2; ++u) { pc[lane + 64 * u] = (f32x4){pr[u][0], pr[u][1], pr[u][2], pr[u][3]}; psum[lane + 64 * u] = (pr[u][0] + pr[u][1]) + (pr[u][2] + pr[u][3]); }
            LDS_WAIT(); __builtin_amdgcn_wave_barrier(); asm volatile("" ::: "memory");
            const int j = lane & 31, cur = t >> 6; float imp = 0.f;
#pragma unroll
            for (int cc = -1; cc <= 3; ++cc) { const int c = 4 * j + cc; if (c >= 0 && c < NCMP) imp += psum[c]; }
            const bool causal = (j * 64 <= t), forced = (j == 0) || (j == cur) || (j == cur - 1);
            const float score = causal ? (forced ? imp + 1e4f : imp) : -1e30f;
            int rank = 0;
#pragma unroll
            for (int i = 0; i < 32; ++i) { const float si = __shfl(score, i); rank += (si > score || (si == score && i < j)) ? 1 : 0; }
            const unsigned selmask = (unsigned)__ballot(lane < 32 && rank < 8 && causal);
            float ocmp[4] = {0.f, 0.f, 0.f, 0.f};
            { const int nvc = t >= 31 ? (((t - 31) >> 4) + 1 > NCMP ? NCMP : ((t - 31) >> 4) + 1) : 0;
#pragma unroll 4
              for (int c = 0; c < nvc; ++c) { const f32x4 p = pc[c]; const float v = bf2f(VC[((size_t)bh * 128 + c) * 64 + lane]); ocmp[0] += p.x * v; ocmp[1] += p.y * v; ocmp[2] += p.z * v; ocmp[3] += p.w * v; } }
            __builtin_amdgcn_wave_barrier(); asm volatile("" ::: "memory");
            int nk = 0; float osel[4], owin[4];
#pragma nounroll
            for (unsigned mm = selmask; mm != 0u && nk < 8; mm &= mm - 1u) { const int jj = __builtin_ctz(mm);
                const int key = jj * 64 + lane; float s[4];
                if (key <= t) dots4(KS + (size_t)key * 64, qs, s); else { s[0] = s[1] = s[2] = s[3] = -1e30f; }
                sb[nk * 64 + lane] = (f32x4){s[0], s[1], s[2], s[3]};
                if (lane == 0) kbl[nk] = jj * 64;
                ++nk; }
            LDS_WAIT(); __builtin_amdgcn_wave_barrier(); asm volatile("" ::: "memory");
            softmax_pv(sb, kbl, nk, VS, lane, osel);
            nk = 0;
#pragma nounroll
            for (int ch = 0; ch < 8; ++ch) { const int k0 = t - 511 + 64 * ch; if (k0 + 63 < 0) continue;
                const int key = k0 + lane; float s[4];
                if (key >= 0) dots4(KW + (size_t)key * 64, qs, s); else { s[0] = s[1] = s[2] = s[3] = -1e30f; }
                sb[nk * 64 + lane] = (f32x4){s[0], s[1], s[2], s[3]};
                if (lane == 0) kbl[nk] = k0;
                ++nk; }
            LDS_WAIT(); __builtin_amdgcn_wave_barrier(); asm volatile("" ::: "memory");
            softmax_pv(sb, kbl, nk, VW, lane, owin);
#pragma unroll
            for (int h = 0; h < 4; ++h) { const float* gp = GT + (size_t)r * 24 + (kvh * 4 + h) * 3;
                const float o = sigmoidf_(gp[0]) * ocmp[h] + sigmoidf_(gp[1]) * osel[h] + sigmoidf_(gp[2]) * owin[h];
                MIX[(size_t)r * D + 512 + (kvh * 4 + h) * 64 + lane] = (bf16_t)(cvt_pk_bf16(o, 0.f) & 0xffffu); }
            __builtin_amdgcn_wave_barrier(); asm volatile("" ::: "memory");
        }
    }
}


constexpr int AT_KB = 0, AT_VB = 18432, AT_WUN = 36864, AT_OT = 40960;
__device__ __forceinline__ int crow_(int i) { return (i & 3) + 8 * (i >> 2); }
__device__ __forceinline__ float fmax_(float a, float b) { return __builtin_amdgcn_fmed3f(a, b, __builtin_inff()); }
template <int MODE>
__device__ __forceinline__ void attn_tile(const LAS unsigned char* KB, const LAS unsigned char* VB, const bf16x8 (&Qf)[4], f32x16 (&O)[2], float cref, float& l, int tl, int lo, bool rowok, int n, int h) {
    f32x16 S0, S1;
#pragma unroll
    for (int i = 0; i < 16; ++i) { S0[i] = 0.f; S1[i] = 0.f; }
#pragma unroll
    for (int s = 0; s < 4; ++s) { const bf16x8 k0 = *(const LAS bf16x8*)(KB + n * 144 + (16 * s + 8 * h) * 2), k1 = *(const LAS bf16x8*)(KB + (32 + n) * 144 + (16 * s + 8 * h) * 2);
        S0 = MFMA32(k0, Qf[s], S0); S1 = MFMA32(k1, Qf[s], S1); }
    if (MODE != 0) {
#pragma unroll
        for (int i = 0; i < 16; ++i) { const int c0 = crow_(i), c1 = 32 + crow_(i);
            if (MODE == 2) { S0[i] = (c0 <= tl && c0 > lo) ? S0[i] : -1e30f; S1[i] = (c1 <= tl && c1 > lo) ? S1[i] : -1e30f; } } }
    f32x2 ls2 = {0.f, 0.f}; const float crow = (MODE == 1) ? (rowok ? cref : 1e30f) : cref; const f32x2 mr2 = {crow, crow};
#pragma unroll
    for (int i = 0; i < 8; ++i) { f32x2 a = (f32x2){S0[2 * i], S0[2 * i + 1]} - mr2, b = (f32x2){S1[2 * i], S1[2 * i + 1]} - mr2;
        a.x = __builtin_amdgcn_exp2f(a.x); a.y = __builtin_amdgcn_exp2f(a.y); b.x = __builtin_amdgcn_exp2f(b.x); b.y = __builtin_amdgcn_exp2f(b.y);
        S0[2 * i] = a.x; S0[2 * i + 1] = a.y; S1[2 * i] = b.x; S1[2 * i + 1] = b.y; ls2 += a + b; }
    l += ls2.x + ls2.y;
    const bf16x8 P00 = pack8<0>(S0), P01 = pack8<8>(S0), P10 = pack8<0>(S1), P11 = pack8<8>(S1);
    __builtin_amdgcn_sched_barrier(0);
#pragma unroll
    for (int d = 0; d < 2; ++d) { const LAS unsigned char* vb = VB + (32 * d + n) * 144 + 8 * h * 2;
        O[d] = MFMA32(*(const LAS bf16x8*)(vb + 0), P00, O[d]); O[d] = MFMA32(*(const LAS bf16x8*)(vb + 32), P01, O[d]);
        O[d] = MFMA32(*(const LAS bf16x8*)(vb + 64), P10, O[d]); O[d] = MFMA32(*(const LAS bf16x8*)(vb + 96), P11, O[d]); }
}
__device__ __forceinline__ void attn_stage64(LAS unsigned char* lds, const bf16_t* K, const bf16_t* VT, int tid) {
    const int row = tid >> 3, ch = tid & 7;
    const u32x4 kv = *((const u32x4*)K + tid), vv = *(const u32x4*)(VT + (size_t)row * SEQ + ch * 8);
    *(LAS u32x4*)(lds + AT_KB + row * 144 + ch * 16) = kv; *(LAS u32x4*)(lds + AT_VB + row * 144 + ch * 16) = vv;
}
__device__ __forceinline__ void phase_attn_mfma(Frame& F, int layer) {
    const int lane = F.lane, tid = F.tid, n = lane & 31, h = lane >> 5, w = F.wave;
    LAS unsigned char* lds = F.lds; const LAS unsigned char* KB = lds + AT_KB; const LAS unsigned char* VB = lds + AT_VB; volatile LAS unsigned* WUN = (volatile LAS unsigned*)(lds + AT_WUN);
    const bf16_t* QN = (const bf16_t*)(F.ws + WS_Q); const bf16_t* KVb = (const bf16_t*)(F.ws + WS_KV);
    const bf16_t* KC = (const bf16_t*)(F.ws + WS_KC); const bf16_t* VCT = (const bf16_t*)(F.ws + WS_VCT);
    const bf16_t* VST = (const bf16_t*)(F.ws + WS_VST); const bf16_t* VWT = (const bf16_t*)(F.ws + WS_VWT);
    const float* GT = (const float*)(F.ws + WS_GT); bf16_t* MIX = (bf16_t*)(F.ws + WS_MIX);
    float cref;
    { const float gq = fabsf(INP_(I_QG)[layer * 64 + lane]); const float* kg = INP_(I_KG) + layer * 192;
      const float gk = fmaxf(fabsf(kg[lane]), fmaxf(fabsf(kg[64 + lane]), fabsf(kg[128 + lane])));
      const float bound = 1.44269504089f * 8.0f * wave_max(gq) * wave_max(gk); cref = fmaxf(bound - 16.0f, 0.f); }
#pragma nounroll
    for (int ui = 0; ui < 2; ++ui) {
        const int bh = (F.c >> 5) + 8 * ui, tb = ui ? 31 - (F.c & 31) : (F.c & 31);
        if (F.c >= 256) break;
        const int b = bh >> 1, kvh = bh & 1, t0 = tb * 64, cur = tb;
        const int tt = t0 + 8 * w + (n >> 2), hd = n & 3; const size_t r = (size_t)b * SEQ + tt;
        bf16x8 Qf[4]; { const bf16_t* qp = QN + r * 512 + (kvh * 4 + hd) * 64 + 8 * h;
#pragma unroll
            for (int s = 0; s < 4; ++s) Qf[s] = *(const bf16x8*)(qp + 16 * s); }
        {
            float qv[4][8]; float ss = 0.f;
#pragma unroll
            for (int s = 0; s < 4; ++s) { const u32x4 wq = __builtin_bit_cast(u32x4, Qf[s]);
                qv[s][0] = bf_lo(wq.x); qv[s][1] = bf_hi(wq.x); qv[s][2] = bf_lo(wq.y); qv[s][3] = bf_hi(wq.y); qv[s][4] = bf_lo(wq.z); qv[s][5] = bf_hi(wq.z); qv[s][6] = bf_lo(wq.w); qv[s][7] = bf_hi(wq.w);
#pragma unroll
                for (int j = 0; j < 8; ++j) ss += qv[s][j] * qv[s][j]; }
            ss = xsum32(ss);
            const float rsq = rsqf_(ss * (1.0f / 64.0f) + EPS) * (0.125f * 1.44269504089f); const float* qg     = INP_(I_QG) + layer * 64 + 8 * h;
#pragma unroll
            for (int s = 0; s < 4; ++s) { const f32x4 ga = *(const f32x4*)(qg + 16 * s), gb = *(const f32x4*)(qg + 16 * s + 4);
                u32x4 wq; wq.x = pk_bf16(qv[s][0] * rsq * ga.x, qv[s][1] * rsq * ga.y); wq.y = pk_bf16(qv[s][2] * rsq * ga.z, qv[s][3] * rsq * ga.w);
                wq.z = pk_bf16(qv[s][4] * rsq * gb.x, qv[s][5] * rsq * gb.y); wq.w = pk_bf16(qv[s][6] * rsq * gb.z, qv[s][7] * rsq * gb.w); Qf[s] = __builtin_bit_cast(bf16x8, wq); } }
        const float* gp = GT + r * 24 + (kvh * 4 + hd) * 3; const float g0 = sigmoidf_(gp[0]), g1 = sigmoidf_(gp[1]), g2 = sigmoidf_(gp[2]);
        f32x16 Ob[2]; LAS f32x4* OT = (LAS f32x4*)(lds + AT_OT + w * 8192) + lane;
        unsigned tokmask, wmask;
        __syncthreads();
#pragma unroll
        for (int q = 0; q < 2; ++q) { const int i = tid + 512 * q;
            *(LAS u32x4*)(lds + AT_KB + (i >> 3) * 144 + (i & 7) * 16) = *((const u32x4*)(KC + (size_t)bh * 128 * 64) + i);
            *(LAS u32x4*)(lds + AT_VB + (i >> 4) * 272 + (i & 15) * 16) = *((const u32x4*)(VCT + (size_t)bh * 64 * 128) + i); }
        __syncthreads();
        {
            f32x16 S[4];
#pragma unroll
            for (int ta = 0; ta < 4; ++ta) {
#pragma unroll
                for (int i = 0; i < 16; ++i) S[ta][i] = 0.f;
#pragma unroll
                for (int s = 0; s < 4; ++s) S[ta] = MFMA32(*(const LAS bf16x8*)(KB + (32 * ta + n) * 144 + (16 * s + 8 * h) * 2), Qf[s], S[ta]); }
            const int cmax = tt >= 31 ? (((tt - 31) >> 4) > 126 ? 126 : ((tt - 31) >> 4)) : -1, lim = cmax - 4 * h;
            float ls = 0.f;
#pragma unroll
            for (int ta = 0; ta < 4; ++ta)
#pragma unroll
                for (int i = 0; i < 16; ++i) { const float p = (32 * ta + crow_(i) <= lim) ? __builtin_amdgcn_exp2f(S[ta][i] - cref) : 0.f; S[ta][i] = p; ls += p; }
            ls = xsum32(ls);
            const float inv = rcpf_(fmaxf(ls, 1e-30f));
#pragma unroll
            for (int ta = 0; ta < 4; ++ta)
#pragma unroll
                for (int i = 0; i < 16; ++i) S[ta][i] *= inv;
            float val[4][4]; unsigned kk[4];
#pragma unroll
            for (int ta = 0; ta < 4; ++ta)
#pragma unroll
                for (int u = 0; u < 4; ++u) { val[ta][u] = (S[ta][4 * u] + S[ta][4 * u + 1]) + (S[ta][4 * u + 2] + S[ta][4 * u + 3]); }
            {   float xs[4][4];
#pragma unroll
                for (int ta = 0; ta < 4; ++ta)
#pragma unroll
                    for (int u = 0; u < 4; ++u) xs[ta][u] = xget32(S[ta][4 * u + 3], h);
#pragma unroll
                for (int ta = 0; ta < 4; ++ta)
#pragma unroll
                    for (int u = 0; u < 4; ++u) { const float pv0 = (u > 0) ? xs[ta][u > 0 ? u - 1 : 0] : (ta > 0 ? xs[ta > 0 ? ta - 1 : 0][3] : 0.f); val[ta][u] += (h ? xs[ta][u] : pv0); } }
            const bf16x8 P0 = pack8<0>(S[0]), P1 = pack8<8>(S[0]), P2 = pack8<0>(S[1]), P3 = pack8<8>(S[1]), P4 = pack8<0>(S[2]), P5 = pack8<8>(S[2]), P6 = pack8<0>(S[3]), P7 = pack8<8>(S[3]);
            __builtin_amdgcn_sched_barrier(0);
            const bool b0 = (n & 1) != 0, b1 = (n & 2) != 0; const int hd2 = 2 * (n & 3) + h;
#define DPPF(x, ctrl) __builtin_bit_cast(float, __builtin_amdgcn_update_dpp(0, __builtin_bit_cast(int, (x)), (ctrl), 0xF, 0xF, true))
#define DPPU(x, ctrl) ((unsigned)__builtin_amdgcn_update_dpp(0, (int)(x), (ctrl), 0xF, 0xF, true))
#pragma unroll
            for (int ta = 0; ta < 4; ++ta) {
                const float m0 = b0 ? val[ta][1] : val[ta][0], s0 = b0 ? val[ta][0] : val[ta][1], m1 = b0 ? val[ta][3] : val[ta][2], s1 = b0 ? val[ta][2] : val[ta][3];
                const float r0 = m0 + DPPF(s0, 0xB1), r1 = m1 + DPPF(s1, 0xB1);
                const float mm = b1 ? r1 : r0, ss = b1 ? r0 : r1; const float v = mm + DPPF(ss, 0x4E);
                const int G = 8 * ta + hd2; const bool causal = G <= cur, forced = (G == 0) || (G == cur) || (G == cur - 1);
                kk[ta] = causal ? ((forced ? 0x7f000000u : (__float_as_uint(v) & ~31u)) | (unsigned)(31 - G)) : 0u; }
            __builtin_amdgcn_sched_barrier(0);
#pragma unroll
            for (int d = 0; d < 2; ++d) {
#pragma unroll
                for (int i = 0; i < 16; ++i) Ob[d][i] = 0.f;
                const LAS unsigned char* vb = VB + (32 * d + n) * 272 + 8 * h * 2;
                Ob[d] = MFMA32(*(const LAS bf16x8*)(vb + 0), P0, Ob[d]); Ob[d] = MFMA32(*(const LAS bf16x8*)(vb + 32), P1, Ob[d]);
                Ob[d] = MFMA32(*(const LAS bf16x8*)(vb + 64), P2, Ob[d]); Ob[d] = MFMA32(*(const LAS bf16x8*)(vb + 96), P3, Ob[d]);
                Ob[d] = MFMA32(*(const LAS bf16x8*)(vb + 128), P4, Ob[d]); Ob[d] = MFMA32(*(const LAS bf16x8*)(vb + 160), P5, Ob[d]);
                Ob[d] = MFMA32(*(const LAS bf16x8*)(vb + 192), P6, Ob[d]); Ob[d] = MFMA32(*(const LAS bf16x8*)(vb + 224), P7, Ob[d]);
#pragma unroll
                for (int q = 0; q < 4; ++q) OT[(4 * d + q) * 64] = (f32x4){Ob[d][4 * q] * g0, Ob[d][4 * q + 1] * g0, Ob[d][4 * q + 2] * g0, Ob[d][4 * q + 3] * g0}; }
            __builtin_amdgcn_sched_barrier(0);
            unsigned selbits = 0u;
#pragma unroll
            for (int rd = 0; rd < 8; ++rd) { unsigned mk = kk[0] > kk[1] ? kk[0] : kk[1]; { const unsigned m2 = kk[2] > kk[3] ? kk[2] : kk[3]; mk = m2 > mk ? m2 : mk; }
                { const unsigned o = DPPU(mk, 0xB1); mk = o > mk ? o : mk; } { const unsigned o = DPPU(mk, 0x4E); mk = o > mk ? o : mk; }
                mk = xmax32u(mk);
#pragma unroll
                for (int ta = 0; ta < 4; ++ta) { const bool hit = (kk[ta] == mk) && (mk != 0u); selbits |= hit ? ((1u << (8 * ta)) << hd2) : 0u; kk[ta] = hit ? 0u : kk[ta]; } }
            selbits |= DPPU(selbits, 0xB1); selbits |= DPPU(selbits, 0x4E);
            tokmask = xor32u(selbits);
#undef DPPF
#undef DPPU
            unsigned wm = tokmask; wm |= (unsigned)__shfl_xor((int)wm, 4); wm |= (unsigned)__shfl_xor((int)wm, 8); wm |= (unsigned)__shfl_xor((int)wm, 16);
            wmask = (unsigned)__builtin_amdgcn_readfirstlane((int)wm);
            if (lane == 0) WUN[w] = wmask;
        }
        __syncthreads();
        unsigned uall = 0u;
#pragma unroll
        for (int q = 0; q < 8; ++q) uall |= WUN[q];
        uall = (unsigned)__builtin_amdgcn_readfirstlane((int)uall);
        if (PROBE_MASK & 0x6000000u) { if (lane == 0) ((unsigned*)(F.ws + WS_SLOT + 3 * MAXSLOT * 4))[(blockIdx.x * 2 + ui) * 8 + w] = (unsigned)__builtin_popcount(uall) | ((unsigned)__builtin_popcount(wmask) << 8); }
        float l = 0.f;
#pragma unroll
        for (int d = 0; d < 2; ++d)
#pragma unroll
            for (int i = 0; i < 16; ++i) Ob[d][i] = 0.f;
        const int j0 = cur > 8 ? cur - 8 : 0, nwin = cur - j0 + 1, ntile = nwin + __builtin_popcount(uall);
        const int srow = tid >> 3, sch = tid & 7;
        int lidx = 0, cidx = 0; unsigned lmm = uall, cmm = uall; u32x4 rk0, rv0, rk1, rv1, rk2, rv2;
#define AT_NEXT(idx, mm, wh, jj) do { if ((idx) < nwin) { (wh) = 1; (jj) = j0 + (idx); } else { (wh) = 0; (jj) = (mm) ? __builtin_ctz(mm) : 0; (mm) &= (mm) - 1u; } ++(idx); } while (0)
#define AT_LOAD(rk, rv) do { int _wh, _jj; AT_NEXT(lidx, lmm, _wh, _jj); const bf16_t* _kp = KVb + (size_t)(_wh ? 4 : 2) * KVT + ((size_t)bh * SEQ + _jj * 64) * 64; const bf16_t* _vp = (_wh ? VWT : VST) + (size_t)bh * 64 * SEQ + _jj * 64; \
        rk = *((const u32x4*)_kp + tid); rv = *(const u32x4*)(_vp + (size_t)srow * SEQ + sch * 8); } while (0)
#define AT_WRITE(b, rk, rv) do { *(LAS u32x4*)(lds + (b) * 18432 + srow * 144 + sch * 16) = rk; *(LAS u32x4*)(lds + (b) * 18432 + 9216 + srow * 144 + sch * 16) = rv; } while (0)
        AT_LOAD(rk0, rv0); AT_LOAD(rk1, rv1); AT_LOAD(rk2, rv2);
        AT_WRITE(0, rk0, rv0);
        AT_LOAD(rk0, rv0);
#define AT_STEP(i, RK, RV) do { asm volatile("s_waitcnt lgkmcnt(0)" ::: "memory"); __builtin_amdgcn_s_barrier(); asm volatile("" ::: "memory"); \
            AT_WRITE(((i) + 1) & 1, RK, RV); AT_LOAD(RK, RV); \
            int wh, j; AT_NEXT(cidx, cmm, wh, j); \
            if (i == nwin) { \
                const float lt = xsum32(l), sc = g2 * rcpf_(fmaxf(lt, 1e-30f)); \
_Pragma("unroll") \
                for (int d = 0; d < 2; ++d) \
_Pragma("unroll") \
                    for (int q = 0; q < 4; ++q) { f32x4 o = OT[(4 * d + q) * 64]; o.x += Ob[d][4 * q] * sc; o.y += Ob[d][4 * q + 1] * sc; o.z += Ob[d][4 * q + 2] * sc; o.w += Ob[d][4 * q + 3] * sc; OT[(4 * d + q) * 64] = o; \
                        Ob[d][4 * q] = 0.f; Ob[d][4 * q + 1] = 0.f; Ob[d][4 * q + 2] = 0.f; Ob[d][4 * q + 3] = 0.f; } \
                l = 0.f; } \
            const LAS unsigned char* kb = lds + (i & 1) * 18432; const LAS unsigned char* vb = kb + 9216; \
            const int tl = tt - 64 * j - 4 * h; \
            if (wh) { if (j == cur || j == cur - 8) attn_tile<2>(kb, vb, Qf, Ob, cref, l, tl, j == cur - 8 ? tl - 512 : -100000, true, n, h); else attn_tile<0>(kb, vb, Qf, Ob, cref, l, 0, 0, true, n, h); } \
            else if ((wmask >> j) & 1u) { const bool rowok = ((tokmask >> j) & 1u) != 0u; \
                if (j == cur) attn_tile<2>(kb, vb, Qf, Ob, cref, l, rowok ? tl : -1, -100000, true, n, h); else attn_tile<1>(kb, vb, Qf, Ob, cref, l, 0, 0, rowok, n, h); } \
        } while (0)
#pragma nounroll
        for (int i = 0; i < ntile; i += 3) { AT_STEP(i, rk1, rv1); if (i + 1 >= ntile) break; AT_STEP(i + 1, rk2, rv2); if (i + 2 >= ntile) break; AT_STEP(i + 2, rk0, rv0); }
#undef AT_STEP
#undef AT_NEXT
#undef AT_LOAD
#undef AT_WRITE
        { const float lt = xsum32(l), sc = g1 * rcpf_(fmaxf(lt, 1e-30f));
          bf16_t* op = MIX + r * D + 512 + (kvh * 4 + hd) * 64 + 4 * h;
#pragma unroll
          for (int d = 0; d < 2; ++d)
#pragma unroll
            for (int u = 0; u < 4; ++u) { const f32x4 o = OT[(4 * d + u) * 64]; u32x2 ov; ov.x = pk_bf16(o.x + Ob[d][4 * u] * sc, o.y + Ob[d][4 * u + 1] * sc); ov.y = pk_bf16(o.z + Ob[d][4 * u + 2] * sc, o.w + Ob[d][4 * u + 3] * sc);
                *(u32x2*)(op + 32 * d + 8 * u) = ov; } }
    }
}

__device__ __forceinline__ int build_ptab(Frame& F) {
    LAS int* ptab = (LAS int*)(F.lds + PTAB_OFF);
    const unsigned* cnt = (const unsigned*)(F.ws + WS_CTL) + CW_CNT;
    if (F.tid < 64) {
        const int l = F.tid; const int v = (int)__hip_atomic_load(cnt + 64 * l, __ATOMIC_RELAXED, __HIP_MEMORY_SCOPE_AGENT);
        int gi = v;
#pragma unroll
        for (int o = 1; o < 8; o <<= 1) { const int t = __shfl_up(gi, o); if ((l & 7) >= o) gi += t; }
        ptab[PX_OFF + l] = gi - v;
        const int e = l; const unsigned c = (unsigned)__shfl(gi, (8 * e + 7) & 63);
        const int n = (e < NE) ? (int)((c + 255u) >> 8) : 0; int incl = n;
#pragma unroll
        for (int o = 1; o < 8; o <<= 1) { const int t = __shfl_up(incl, o); if (e >= o) incl += t; }
        const int excl = incl - n;
        if (e < NE) { ptab[MAXPAN + 8 + e] = excl * 256; ptab[MAXPAN + 16 + e] = (int)c; for (int i = 0; i < n && excl + i < MAXPAN; ++i) ptab[excl + i] = e; }
        if (e == NE - 1) ptab[MAXPAN] = incl < MAXPAN ? incl : MAXPAN; }
    __syncthreads();
    return ptab[MAXPAN];
}

template <unsigned KM> __global__ void __launch_bounds__(NTHR, 2) fwd(Args args) {
    extern __shared__ __attribute__((aligned(16))) unsigned char lds_raw[];
    Frame F; F.lds = (LAS unsigned char*)lds_raw; F.tid = threadIdx.x; F.lane = F.tid & 63; F.wave = __builtin_amdgcn_readfirstlane(F.tid >> 6);
    F.G = gridDim.x; F.c = blockIdx.x; F.in = args.in; F.out = args.out; F.ws = args.ws;
    volatile LAS unsigned* MISC = (volatile LAS unsigned*)(F.lds + MISC_OFF);
    if (F.tid < 64) MISC[F.tid] = 0u;
    __syncthreads();
    unsigned* ctl = (unsigned*)(F.ws + WS_CTL);
#if MK_PER_PHASE
#define SEAM() do {} while (0)
#else
    XcdBarrier bar = xcd_barrier_post(ctl + CW_BAR, MISC);
#define SEAM() xcd_barrier(bar)
#endif
    const int lo = args.ph_lo, hi = args.ph_hi;
#define KON(kind) (((KM) >> (kind)) & 1u)
#define IN(k) (lo <= (k) && (k) < hi)
#define gw (F.c * NWAVES + F.wave)
#define NGW (F.G * NWAVES)
#define XB ((bf16_t*)(F.ws + WS_XB))
#define RS ((float*)(F.ws + WS_RSTD))

    if (KON(0) && IN(0)) { FRESH_TID(F); PMARK(0); phase_prologue(F); SEAM(); }

    for (int layer = 0; layer < 2; ++layer) {
        const int pb = 1 + 12 * layer;
        if (KON(1) && IN(pb + 0)) { FRESH_TID(F); PMARK(pb + 0);
            pg8::Gemm g{XB, (const bf16_t*)(F.ws + WS_WIN) + (size_t)layer * INP * D, D, D, D}; pg8::SchedGrid S; S.init(M / 256, INP / 256, F.G, F.c, D, D);
            EpiIn E{RS, (bf16_t*)(F.ws + WS_U), (bf16_t*)(F.ws + WS_Q), (bf16_t*)(F.ws + WS_KV), (float*)(F.ws + WS_GT), layer ? (const float*)(F.ws + WS_PSS) : nullptr, (LAS float*)(F.lds + TOKT_OFF)};
            pg8::gemm_phase(F.lds, g, S, E); moe_conv_slot(F, layer == 0 ? 0 : 2); SEAM();
        }
        if (KON(2) && IN(pb + 1)) { FRESH_TID(F); PMARK(pb + 1);
            { pg8::Gemm g{(const bf16_t*)(F.ws + WS_KV), (const bf16_t*)(F.ws + WS_WC1), 256, 1024, 2048}; SchedCmp S{F.G, F.c, layer};
              EpiH1 E{(unsigned short*)(F.ws + WS_H1)}; pg8::gemm_phase(F.lds, g, S, E); }
            bf16_t* KS = (bf16_t*)(F.ws + WS_KV) + 2 * KVT; bf16_t* KW = (bf16_t*)(F.ws + WS_KV) + 4 * KVT; const float* kg = INP_(I_KG) + layer * 192;
            if (F.G >= 256) { if (F.c >= 128) { const int g2 = (F.c - 128) * NWAVES + F.wave, n2 = (F.G - 128) * NWAVES; vtrans_items(F, g2, n2); norm_rows64_x2(KS, kg + 64, KW, kg + 128, NBH * SEQ, g2, n2, F.lane); } }
            else { vtrans_items(F, gw, NGW); norm_rows64_x2(KS, kg + 64, KW, kg + 128, NBH * SEQ, gw, NGW, F.lane); }
#ifdef ATTN_REF
            norm_rows64((bf16_t*)(F.ws + WS_Q), M * 8, INP_(I_QG) + layer * 64, 0.125f, gw, NGW, F.lane);
#endif
            { FRESH_TID(F); conv_units(F, layer); }
            SEAM();
        }
        if (KON(3) && IN(pb + 2)) { FRESH_TID(F); PMARK(pb + 2); PMARK(30); phase_cmp2(F, layer); SEAM(); }
#ifndef ATTN_REF
        if (KON(4) && IN(pb + 3)) { FRESH_TID(F); PMARK(pb + 3); phase_attn_mfma(F, layer); moe_conv_attn(F, layer); SEAM(); }
#else
        if (KON(4) && IN(pb + 3)) { FRESH_TID(F); PMARK(pb + 3); phase_attn_ref(F, layer); SEAM(); }
#endif
        if (KON(5) && IN(pb + 4)) { FRESH_TID(F); PMARK(pb + 4);
            pg8::Gemm g{(const bf16_t*)(F.ws + WS_MIX), (const bf16_t*)(F.ws + WS_WOUT) + (size_t)layer * D * D, D, D, D}; pg8::SchedGrid S; S.init(M / 256, D / 256, F.G, F.c, D, D);
            { EpiRes<true> E{XB, XB, layer == 0 ? (float*)(F.ws + WS_PSS) : nullptr}; pg8::gemm_phase(F.lds, g, S, E); }
            SEAM();
        }
        if (KON(6) && IN(pb + 5) && layer == 1) { FRESH_TID(F); PMARK(pb + 5);
            {
                const float* RT = (const float*)(F.ws + WS_RT); unsigned* cnt = ctl + CW_CNT;
                int* rtok = (int*)(F.ws + WS_REC); float* rw = (float*)(rtok + 8 * CAPE); float* rrs = rw + 8 * CAPE; unsigned char* XB8 = F.ws + WS_XS;
                constexpr int RPITCH = 2064;
                LAS unsigned char* lds = F.lds; LAS int* RES = (LAS int*)(lds + 53248); LAS float* RSLR = (LAS float*)(lds + 54272); LAS int* WC = (LAS int*)(lds + 55296);
#pragma unroll
                for (int q = 0; q < 16; ++q) { const int idx = F.tid + q * NTHR, e = idx >> 10, k = idx & 1023; const float w = RT[idx];
                    const unsigned hi = cvt_pk_bf16(w, 0.f) & 0xffffu; const float r1 = w - __uint_as_float(hi << 16);
                    const unsigned mid = cvt_pk_bf16(r1, 0.f) & 0xffffu; const float r2 = r1 - __uint_as_float(mid << 16);
                    const unsigned lo = cvt_pk_bf16(r2, 0.f) & 0xffffu;
                    *(LAS bf16_t*)(lds + (0 * 8 + e) * RPITCH + k * 2) = (bf16_t)hi; *(LAS bf16_t*)(lds + (1 * 8 + e) * RPITCH + k * 2) = (bf16_t)mid; *(LAS bf16_t*)(lds + (2 * 8 + e) * RPITCH + k * 2) = (bf16_t)lo; }
                __syncthreads();
#pragma nounroll
                for (int rb = F.c * 64; rb < M; rb += F.G * 64) {
                    if (F.wave < 4) {
                        const int rr = F.lane & 15, kq = F.lane >> 4; const bf16_t* xrow = XB + (size_t)(rb + 16 * F.wave + rr) * D + 8 * kq;
                        bf16x8 af[32];
#pragma unroll
                        for (int T = 0; T < 32; ++T) af[T] = *(const bf16x8*)(xrow + 32 * T);
                        f32x4 acc = {0.f, 0.f, 0.f, 0.f};
                        const LAS unsigned char* bb = lds + (F.lane & 7) * RPITCH + 16 * kq;
#pragma unroll
                        for (int T = 0; T < 32; ++T)
#pragma unroll
                            for (int part = 0; part < 3; ++part) acc = __builtin_amdgcn_mfma_f32_16x16x32_bf16(af[T], *(const LAS bf16x8*)(bb + part * 8 * RPITCH + 64 * T), acc, 0, 0, 0);
#define RKEYMAX(x) do { unsigned _o; _o = (unsigned)__builtin_amdgcn_update_dpp(0, (int)(x), 0xB1, 0xF, 0xF, true); x = _o > x ? _o : x; _o = (unsigned)__builtin_amdgcn_update_dpp(0, (int)(x), 0x4E, 0xF, 0xF, true); x = _o > x ? _o : x; \
                            _o = (unsigned)__builtin_amdgcn_update_dpp(0, (int)(x), 0x141, 0xF, 0xF, true); x = _o > x ? _o : x; _o = (unsigned)__builtin_amdgcn_update_dpp(0, (int)(x), 0x140, 0xF, 0xF, true); x = _o > x ? _o : x; } while (0)
#pragma unroll
                        for (int t = 0; t < 4; ++t) { const unsigned u = __float_as_uint(acc[t]); const unsigned ky = ((u ^ ((u >> 31) ? 0xFFFFFFFFu : 0x80000000u)) & ~7u) | (unsigned)(7 - (F.lane & 7));
                            unsigned m1 = ky; RKEYMAX(m1);
                            unsigned m2 = ((ky & 7u) == (m1 & 7u)) ? 0u : ky; RKEYMAX(m2);
                            if (rr == 0) { const unsigned k1 = m1 & ~7u, k2 = m2 & ~7u; const unsigned v1 = (k1 & 0x80000000u) ? (k1 ^ 0x80000000u) : ~k1, v2 = (k2 & 0x80000000u) ? (k2 ^ 0x80000000u) : ~k2;
                                LAS int* rp = RES + (16 * F.wave + 4 * kq + t) * 4; rp[0] = 7 - (int)(m1 & 7u); rp[1] = 7 - (int)(m2 & 7u); rp[2] = (int)v1; rp[3] = (int)v2; } }
#undef RKEYMAX
                    } else {
                        const int hw = F.wave - 4;
#pragma nounroll
                        for (int i8 = 0; i8 < 16; i8 += 8) { u32x2 raw[8][4];
#pragma unroll
                            for (int q = 0; q < 8; ++q) { const u32x2* xr = (const u32x2*)(XB + (size_t)(rb + 16 * hw + i8 + q) * D) + F.lane;
#pragma unroll
                                for (int j = 0; j < 4; ++j) raw[q][j] = xr[64 * j]; }
#pragma unroll
                            for (int q = 0; q < 8; ++q) { const int m = rb + 16 * hw + i8 + q; f32x4 xv[4]; f32x2e ss2 = {0.f, 0.f};
#pragma unroll
                                for (int j = 0; j < 4; ++j) { const u32x2 wv = raw[q][j]; xv[j] = (f32x4){bf_lo(wv.x), bf_hi(wv.x), bf_lo(wv.y), bf_hi(wv.y)};
                                    ss2 = __builtin_elementwise_fma(LO2(xv[j]), LO2(xv[j]), ss2); ss2 = __builtin_elementwise_fma(HI2(xv[j]), HI2(xv[j]), ss2); }
                                const float rs = rsqf_(wave_sum_u(ss2.x + ss2.y) * (1.0f / D) + EPS);
                                unsigned* x8 = (unsigned*)(XB8 + (size_t)m * D) + F.lane;
#pragma unroll
                                for (int j = 0; j < 4; ++j) { const f32x4 xn = xv[j] * rs; int w8 = 0; w8 = __builtin_amdgcn_cvt_pk_fp8_f32(xn.x, xn.y, w8, false); w8 = __builtin_amdgcn_cvt_pk_fp8_f32(xn.z, xn.w, w8, true); x8[64 * j] = (unsigned)w8; }
                                if (F.lane == 0) RSLR[16 * hw + i8 + q] = rs; } }
                    }
                    __syncthreads();
                    int me0 = -1, me1 = -1; float mw0 = 0.f, mw1 = 0.f, mrs = 0.f;
                    if (F.wave < 4 && F.lane < 16) { const LAS int* rp = RES + (16 * F.wave + F.lane) * 4; me0 = rp[0]; me1 = rp[1]; const float l0 = __int_as_float(rp[2]), l1 = __int_as_float(rp[3]); mrs = RSLR[16 * F.wave + F.lane];
                        const float p1 = __expf((l1 - l0) * mrs); mw0 = rcpf_(1.0f + p1); mw1 = p1 * mw0; }
                    int r0 = 0, r1 = 0, c_mine = 0; const unsigned long long low = (1ull << F.lane) - 1ull;
#pragma unroll
                    for (int e = 0; e < 8; ++e) { const unsigned long long b0 = __ballot(me0 == e), b1 = __ballot(me1 == e);
                        if (me0 == e) r0 = __popcll(b0 & low) + __popcll(b1 & low); if (me1 == e) r1 = __popcll(b0 & low) + __popcll(b1 & low);
                        if (F.lane == e) c_mine = __popcll(b0) + __popcll(b1); }
                    if (F.lane < 8) WC[F.wave * 8 + F.lane] = c_mine;
                    __syncthreads();
                    if (F.wave == 0 && F.lane < 8) { int tot = 0;
#pragma unroll
                        for (int ww = 0; ww < 8; ++ww) tot += WC[ww * 8 + F.lane];
                        WC[64 + F.lane] = tot > 0 ? (int)atomicAdd(cnt + 64 * (F.lane * 8 + (F.c & 7)), (unsigned)tot) : 0; }
                    __syncthreads();
                    int basev = 0;
                    if (F.lane < 8) { basev = WC[64 + F.lane];
#pragma unroll
                        for (int ww = 0; ww < 8; ++ww) basev += (ww < F.wave) ? WC[ww * 8 + F.lane] : 0; }
                    __syncthreads();
                    const int b0v = __shfl(basev, me0 < 0 ? 0 : me0), b1v = __shfl(basev, me1 < 0 ? 0 : me1);
                    if (me0 >= 0) { const int m = rb + 16 * F.wave + F.lane, i0 = (me0 * 8 + (F.c & 7)) * CAPG + b0v + r0, i1 = (me1 * 8 + (F.c & 7)) * CAPG + b1v + r1;
                        rtok[i0] = m * 2; rw[i0] = mw0; rrs[i0] = mrs; rtok[i1] = m * 2 + 1; rw[i1] = mw1; rrs[i1] = mrs; }
                }
            }
            SEAM();
        }
        if (layer == 0) {
            if (KON(7) && IN(pb + 6)) { FRESH_TID(F); PMARK(pb + 6);
                pg8::Gemm g{XB, (const bf16_t*)(F.ws + WS_WF1), D, D, D}; pg8::SchedGrid S; S.init(M / 256, 2 * DFF / 256, F.G, F.c, D, D);
                EpiGlu E{RS, (bf16_t*)(F.ws + WS_ACT), DFF, 0, (const float*)(F.ws + WS_PSS), (LAS float*)(F.lds + TOKT_OFF)}; pg8::gemm_phase(F.lds, g, S, E); moe_conv_slot(F, 1); SEAM();
            }
            if (KON(8) && IN(pb + 7)) { FRESH_TID(F); PMARK(pb + 7);
                pg8::Gemm g{(const bf16_t*)(F.ws + WS_ACT), (const bf16_t*)(F.ws + WS_WF2), DFF, DFF, DFF}; pg8::SchedGrid S; S.init(M / 256, D / 256, F.G, F.c, DFF, DFF);
                EpiRes<true> E{XB, XB, (float*)(F.ws + WS_PSS)}; pg8::gemm_phase(F.lds, g, S, E); SEAM();
            }
        } else {
            if (KON(11) && IN(pb + 7)) { FRESH_TID(F); PMARK(pb + 7);
                const int npan = build_ptab(F); const MoePlan P = moe_plan(npan, F.G);
                const int* stok = (const int*)(F.ws + WS_REC); const float* srs = (const float*)(stok + 2 * 8 * CAPE);
                pg8::Gemm8 g{F.ws + WS_XS, F.ws + WS_WM1, D, D, D}; SchedMoe1R S{F.G, F.c, 0, P.N1, 1 << 20, 0, (const LAS int*)(F.lds + PTAB_OFF), stok, 0};
                EpiGlu8 E{srs, F.ws + WS_ACTM, DFE, 1.0f / MOE_S1, (LAS float*)(F.lds + RSL_OFF)};
                for (;;) { Unit t0; if (!S.next(0, t0)) break; pg8::gemm_phase8<true>(F.lds, g, S, E); S.ib += TOKT_UNITS; }
                SEAM();
            }
            if (KON(12) && IN(pb + 8)) { FRESH_TID(F); PMARK(pb + 8);
                const int npan = build_ptab(F); const MoePlan P = moe_plan(npan, F.G);
                const int* stok = (const int*)(F.ws + WS_REC); const float* sw = (const float*)(stok + 8 * CAPE); const float* srs = (const float*)(stok + 2 * 8 * CAPE);
                { pg8::Gemm8 g{F.ws + WS_ACTM, F.ws + WS_WM2, DFE, DFE, DFE}; SchedMoe2R S{F.G, F.c, 0, P.PA, (const LAS int*)(F.lds + PTAB_OFF)};
                  EpiMoe2 E{stok, sw, (bf16_t*)(F.ws + WS_Y0), (bf16_t*)(F.ws + WS_Y1), 0, 1.0f / MOE_S2, (const LAS int*)(F.lds + PTAB_OFF) + PX_OFF}; pg8::gemm_phase8<false>(F.lds, g, S, E); }
                if (P.N1 < P.nup) { pg8::Gemm8 g{F.ws + WS_XS, F.ws + WS_WM1, D, D, D}; SchedMoe1R S{F.G, F.c, P.N1, P.nup, P.qa, P.n2, (const LAS int*)(F.lds + PTAB_OFF), stok, 0};
                  EpiGlu8 E{srs, F.ws + WS_ACTM, DFE, 1.0f / MOE_S1, (LAS float*)(F.lds + RSL_OFF)}; for (;;) { Unit t0; if (!S.next(0, t0)) break; pg8::gemm_phase8<true>(F.lds, g, S, E); S.ib += TOKT_UNITS; } }
                SEAM();
            }
            if (KON(12) && IN(pb + 9)) { FRESH_TID(F); PMARK(pb + 9);
                const int npan = build_ptab(F); const MoePlan P = moe_plan(npan, F.G);
                const int* stok = (const int*)(F.ws + WS_REC); const float* sw = (const float*)(stok + 8 * CAPE);
                if (P.PA < npan) { pg8::Gemm8 g{F.ws + WS_ACTM, F.ws + WS_WM2, DFE, DFE, DFE}; SchedMoe2R S{F.G, F.c, P.PA, npan - P.PA, (const LAS int*)(F.lds + PTAB_OFF)};
                  EpiMoe2 E{stok, sw, (bf16_t*)(F.ws + WS_Y0), (bf16_t*)(F.ws + WS_Y1), 0, 1.0f / MOE_S2, (const LAS int*)(F.lds + PTAB_OFF) + PX_OFF}; pg8::gemm_phase8<false>(F.lds, g, S, E); }
                SEAM();
            }
            if (KON(13) && IN(pb + 11)) { FRESH_TID(F); PMARK(pb + 11);
                const bf16_t* Y0 = (const bf16_t*)(F.ws + WS_Y0); const bf16_t* Y1 = (const bf16_t*)(F.ws + WS_Y1);
#pragma nounroll
                for (int mb = gw; mb < M; mb += 2 * NGW) { f32x4 x[2][4]; u32x2 ya[2][4], yb[2][4];
#pragma unroll
                    for (int q = 0; q < 2; ++q) { const int m = mb + q * NGW < M ? mb + q * NGW : 0; const u32x2* xr = (const u32x2*)(XB + (size_t)m * D) + F.lane; const u32x2* y0 = (const u32x2*)(Y0 + (size_t)m * D) + F.lane; const u32x2* y1 = (const u32x2*)(Y1 + (size_t)m * D) + F.lane;
#pragma unroll
                        for (int j = 0; j < 4; ++j) { const u32x2 wv = xr[64 * j]; x[q][j] = (f32x4){bf_lo(wv.x), bf_hi(wv.x), bf_lo(wv.y), bf_hi(wv.y)}; ya[q][j] = y0[64 * j]; yb[q][j] = y1[64 * j]; } }
#pragma unroll
                    for (int q = 0; q < 2; ++q) { const int m = mb + q * NGW; if (m >= M) break; f32x4* xr = (f32x4*)(F.out + (size_t)m * D) + F.lane;
#pragma unroll
                        for (int j = 0; j < 4; ++j) { f32x4 o = x[q][j]; const u32x2 a = ya[q][j], b2 = yb[q][j];
                            o.x += bf_lo(a.x) + bf_lo(b2.x); o.y += bf_hi(a.x) + bf_hi(b2.x); o.z += bf_lo(a.y) + bf_lo(b2.y); o.w += bf_hi(a.y) + bf_hi(b2.y); xr[64 * j] = o; } } }
            }
        }
    }
#undef gw
#undef NGW
#undef XB
#undef RS
    PMARK(99);
    if ((PROBE_MASK & 0x6000000u) && blockIdx.x == 0 && threadIdx.x == 0) { const unsigned* st = (const unsigned*)(F.ws + WS_SLOT + 3 * MAXSLOT * 4); unsigned long long tot = 0; for (int i = 0; i < 512 * 8; ++i) { const unsigned v = st[i]; tot += (PROBE_MASK & 0x2000000u) ? (v & 255u) : (v >> 8); }
        *(volatile LAS unsigned long long*)(F.lds + MISC_OFF + 160) += tot * 25ull / 4096ull * 10ull; }
    if (PROBE_MASK != 0u && blockIdx.x == 0 && threadIdx.x == 0) { const unsigned long long acc = *(volatile LAS unsigned long long*)(F.lds + MISC_OFF + 160), t1 = __builtin_amdgcn_s_memrealtime() + 4ull * acc; while (__builtin_amdgcn_s_memrealtime() < t1) __builtin_amdgcn_s_sleep(8); }
#undef IN
}

constexpr int NPHASE = 25;
template <unsigned KM> static bool setup_kernel(int& per_cu) {
    if (hipFuncSetAttribute((const void*)fwd<KM>, hipFuncAttributeMaxDynamicSharedMemorySize, LDS_BYTES) != hipSuccess) return false;
    if (hipOccupancyMaxActiveBlocksPerMultiprocessor(&per_cu, (const void*)fwd<KM>, NTHR, LDS_BYTES) != hipSuccess) per_cu = 0;
    (void)hipGetLastError(); return true;
}
template <unsigned KM> static void launch_kind(int grid, const Args& a, hipStream_t stream) { hipLaunchKernelGGL(fwd<KM>, dim3(grid), dim3(NTHR), LDS_BYTES, stream, a); }
extern "C" void kernel_launch(void* const* d_in, const int* in_sizes, int n_in, void* d_out, int out_size, void* d_ws, size_t ws_size, hipStream_t stream) {
    static int grid = 0;
    if (grid == 0) {
        if (n_in != 28 || in_sizes[0] != M * D || out_size != M * D || ws_size < WS_END) { fprintf(stderr, "kernel_launch: unexpected shapes / workspace (n_in %d, ws %zu, need %zu)\n", n_in, ws_size, (size_t)WS_END); grid = -1; return; }
        int dev = 0, cus = 0, per_cu = 0; bool ok = true;
        if (hipGetDevice(&dev) != hipSuccess || hipDeviceGetAttribute(&cus, hipDeviceAttributeMultiprocessorCount, dev) != hipSuccess) { grid = -1; return; }
#if MK_PER_PHASE
        ok = ok && setup_kernel<1u << 0>(per_cu) && setup_kernel<1u << 1>(per_cu) && setup_kernel<1u << 2>(per_cu) && setup_kernel<1u << 3>(per_cu) && setup_kernel<1u << 4>(per_cu) && setup_kernel<1u << 5>(per_cu) && setup_kernel<1u << 6>(per_cu)
             && setup_kernel<1u << 7>(per_cu) && setup_kernel<1u << 8>(per_cu) && setup_kernel<1u << 9>(per_cu) && setup_kernel<1u << 10>(per_cu) && setup_kernel<1u << 11>(per_cu) && setup_kernel<1u << 12>(per_cu) && setup_kernel<1u << 13>(per_cu);
#else
        ok = ok && setup_kernel<0xffffffffu>(per_cu);
#endif
        if (!ok) { fprintf(stderr, "kernel_launch: hipFuncSetAttribute failed\n"); grid = -1; return; }
        if (per_cu < 1) fprintf(stderr, "kernel_launch: occupancy query says %d\n", per_cu);
        grid = cus;
    }
    if (grid < 0) return;
    (void)hipMemsetAsync((char*)d_ws + WS_CTL + (size_t)CW_BAR * 4, 0, (size_t)(CW_B1P - CW_BAR) * 4, stream);
    Args a{};
    for (int i = 0; i < 28; ++i) a.in[i] = (const float*)d_in[i];
    a.out = (float*)d_out; a.ws = (unsigned char*)d_ws;
#if MK_PER_PHASE
    static const int phases[] = {0, 1, 2, 3, 4, 5, 7, 8, 13, 14, 15, 16, 17, 18, 19, 20, 21, 24};
    static const int kinds[]  = {0, 1, 2, 3, 4, 5, 7, 8,  1,  2,  3,  4,  5,  6, 10, 11, 12, 13};
    for (int i = 0; i < (int)(sizeof(phases) / sizeof(int)); ++i) { a.ph_lo = phases[i]; a.ph_hi = phases[i] + 1;
        switch (kinds[i]) {
            case 0: launch_kind<1u << 0>(grid, a, stream); break; case 1: launch_kind<1u << 1>(grid, a, stream); break; case 2: launch_kind<1u << 2>(grid, a, stream); break;
            case 3: launch_kind<1u << 3>(grid, a, stream); break; case 4: launch_kind<1u << 4>(grid, a, stream); break; case 5: launch_kind<1u << 5>(grid, a, stream); break;
            case 6: launch_kind<1u << 6>(grid, a, stream); break; case 7: launch_kind<1u << 7>(grid, a, stream); break; case 8: launch_kind<1u << 8>(grid, a, stream); break;
            case 9: launch_kind<1u << 9>(grid, a, stream); break; case 10: launch_kind<1u << 10>(grid, a, stream); break; case 11: launch_kind<1u << 11>(grid, a, stream); break;
            case 12: launch_kind<1u << 12>(grid, a, stream); break; default: launch_kind<1u << 13>(grid, a, stream); break; } }
#else
    a.ph_lo = 0; a.ph_hi = NPHASE; launch_kind<0xffffffffu>(grid, a, stream);
#endif
}
```
